# Optimizing an MI355X kernel written in HIP

```python
import jax, jax.numpy as jnp
from jax import lax
import numpy as np

D_MODEL = 2048
BATCH = 4
SEQ = 4096
DEPTH = 4

CHUNK = 64
N_A_LAYERS = DEPTH // 2
N_B_LAYERS = DEPTH - N_A_LAYERS
EPS = 1e-6
RET_HEADS = 8
RET_QK_DIM = D_MODEL // RET_HEADS
RET_V_DIM = 2 * RET_QK_DIM
RET_QK_WIDTH = RET_HEADS * RET_QK_DIM
RET_V_WIDTH = RET_HEADS * RET_V_DIM
RET_IN_WIDTH = 2 * RET_QK_WIDTH + 2 * RET_V_WIDTH
ROPE_BASE = 10000.0
ATT_HEADS = 16
ATT_HEAD_DIM = D_MODEL // ATT_HEADS
LEFT_CHUNKS = 8
BAND = (LEFT_CHUNKS + 1) * CHUNK
REL_CLIP = 128
N_REL = 2 * REL_CLIP + 1
PEER_HEADS = 8
PEER_NKEYS = 128
PEER_EXPERTS = PEER_NKEYS * PEER_NKEYS
PEER_QDIM = 256
PEER_HALF = PEER_QDIM // 2
PEER_TOPK = 16
PEER_TOKEN_BLOCK = 128

kernel_name = "yoco_retention_chunkattn_peer"


def rmsnorm(x, g):
    xf = x.astype(jnp.float32)
    y = xf * lax.rsqrt(jnp.mean(xf * xf, axis=-1, keepdims=True) + EPS)
    return (y * g.astype(jnp.float32)).astype(x.dtype)


def rotary(t, pos):
    half = t.shape[-1] // 2
    inv = 1.0 / (ROPE_BASE ** (jnp.arange(half, dtype=jnp.float32) / half))
    ang = pos[:, None] * inv[None, :]
    cos = jnp.cos(ang)[None, :, None, :]
    sin = jnp.sin(ang)[None, :, None, :]
    tf = t.astype(jnp.float32)
    t1, t2 = tf[..., :half], tf[..., half:]
    return jnp.concatenate([t1 * cos - t2 * sin, t1 * sin + t2 * cos], axis=-1).astype(t.dtype)


def retention(h, w_in, w_out, gn_g):
    B, S, _ = h.shape
    NC = S // CHUNK
    dt = h.dtype
    proj = h @ w_in
    q, k, v, g = jnp.split(proj, [RET_QK_WIDTH, 2 * RET_QK_WIDTH, 2 * RET_QK_WIDTH + RET_V_WIDTH], axis=-1)
    pos = jnp.arange(S, dtype=jnp.float32)
    q = rotary(q.reshape(B, S, RET_HEADS, RET_QK_DIM), pos)
    k = rotary(k.reshape(B, S, RET_HEADS, RET_QK_DIM), pos) * (RET_QK_DIM ** -0.5)
    v = v.reshape(B, S, RET_HEADS, RET_V_DIM)
    qc = q.reshape(B, NC, CHUNK, RET_HEADS, RET_QK_DIM).transpose(0, 1, 3, 2, 4)
    kc = k.reshape(B, NC, CHUNK, RET_HEADS, RET_QK_DIM).transpose(0, 1, 3, 2, 4)
    vc = v.reshape(B, NC, CHUNK, RET_HEADS, RET_V_DIM).transpose(0, 1, 3, 2, 4)
    log_gamma = jnp.log1p(-jnp.exp2(-5.0 - jnp.arange(RET_HEADS, dtype=jnp.float32)))
    idx = jnp.arange(CHUNK, dtype=jnp.float32)
    diff = idx[:, None] - idx[None, :]
    decay_mask = jnp.where(diff >= 0, jnp.exp(log_gamma[:, None, None] * jnp.maximum(diff, 0.0)), 0.0).astype(dt)
    xi = jnp.exp(log_gamma[:, None] * (idx[None, :] + 1.0)).astype(dt)
    zeta = jnp.exp(log_gamma[:, None] * (CHUNK - 1.0 - idx[None, :])).astype(dt)
    chunk_decay = jnp.exp(log_gamma * CHUNK).astype(dt)
    scores = jnp.einsum('bnhid,bnhjd->bnhij', qc, kc) * decay_mask
    intra = jnp.einsum('bnhij,bnhje->bnhie', scores, vc)
    def step(R, inp):
        q_, kz, v_ = inp
        cross = jnp.einsum('bhcd,bhde->bhce', q_, R)
        R = R * chunk_decay[None, :, None, None] + jnp.einsum('bhcd,bhce->bhde', kz, v_)
        return R, cross
    xs = (qc.transpose(1, 0, 2, 3, 4),
          (kc * zeta[None, None, :, :, None]).transpose(1, 0, 2, 3, 4),
          vc.transpose(1, 0, 2, 3, 4))
    R0 = jnp.zeros((B, RET_HEADS, RET_QK_DIM, RET_V_DIM), dt)
    _, cross = lax.scan(step, R0, xs)
    cross = cross.transpose(1, 0, 2, 3, 4) * xi[None, None, :, :, None]
    o = (intra + cross).transpose(0, 1, 3, 2, 4).reshape(B, S, RET_HEADS, RET_V_DIM)
    of = o.astype(jnp.float32)
    mu = jnp.mean(of, axis=-1, keepdims=True)
    var = jnp.mean(jnp.square(of - mu), axis=-1, keepdims=True)
    y = ((of - mu) * lax.rsqrt(var + EPS)).reshape(B, S, RET_V_WIDTH) * gn_g.astype(jnp.float32)
    y = y.astype(dt)
    return (jax.nn.silu(g) * y) @ w_out


def shared_kv(x, g_kv, w_kv):
    B, S, _ = x.shape
    kv = rmsnorm(x, g_kv) @ w_kv
    k, v = jnp.split(kv, 2, axis=-1)
    pad = ((0, 0), (LEFT_CHUNKS * CHUNK, 0), (0, 0), (0, 0))
    k = jnp.pad(k.reshape(B, S, ATT_HEADS, ATT_HEAD_DIM), pad)
    v = jnp.pad(v.reshape(B, S, ATT_HEADS, ATT_HEAD_DIM), pad)
    return k, v


def chunk_attention(h, k_pad, v_pad, w_q, w_o, rel_bias):
    B, S, D = h.shape
    NC = S // CHUNK
    q = (h @ w_q).reshape(B, NC, CHUNK, ATT_HEADS, ATT_HEAD_DIM) * (ATT_HEAD_DIM ** -0.5)
    q = q.transpose(1, 0, 2, 3, 4)
    i_idx = jnp.arange(CHUNK)[:, None]
    m_idx = jnp.arange(BAND)
    rel = jnp.clip(LEFT_CHUNKS * CHUNK + i_idx - m_idx[None, :], -REL_CLIP, REL_CLIP) + REL_CLIP
    bias = rel_bias.astype(jnp.float32)[:, rel]

    def one_chunk(args):
        c, qc = args
        kb = lax.dynamic_slice_in_dim(k_pad, c * CHUNK, BAND, axis=1)
        vb = lax.dynamic_slice_in_dim(v_pad, c * CHUNK, BAND, axis=1)
        s = jnp.einsum('bihd,bjhd->bhij', qc, kb).astype(jnp.float32) + bias
        valid = m_idx >= (LEFT_CHUNKS - c) * CHUNK
        s = jnp.where(valid[None, None, None, :], s, -1e30)
        p = jax.nn.softmax(s, axis=-1).astype(vb.dtype)
        return jnp.einsum('bhij,bjhd->bihd', p, vb)

    out = lax.map(one_chunk, (jnp.arange(NC), q))
    out = out.transpose(1, 0, 2, 3, 4).reshape(B, S, D)
    return out @ w_o


def peer(h, w_q, sub_keys, u, v):
    B, S, D = h.shape
    T = B * S
    hf = h.reshape(T, D)
    q = (hf @ w_q).reshape(T, PEER_HEADS, 2, PEER_HALF)
    s = jnp.einsum('thpd,pkd->thpk', q, sub_keys).astype(jnp.float32)
    s1, i1 = lax.top_k(s[:, :, 0], PEER_TOPK)
    s2, i2 = lax.top_k(s[:, :, 1], PEER_TOPK)
    cand_s = (s1[..., :, None] + s2[..., None, :]).reshape(T, PEER_HEADS, PEER_TOPK * PEER_TOPK)
    cand_i = (i1[..., :, None] * PEER_NKEYS + i2[..., None, :]).reshape(T, PEER_HEADS, PEER_TOPK * PEER_TOPK)
    top_s, pos = lax.top_k(cand_s, PEER_TOPK)
    eidx = jnp.take_along_axis(cand_i, pos, axis=-1)
    w = jax.nn.softmax(top_s, axis=-1).astype(h.dtype)
    nblk = T // PEER_TOKEN_BLOCK
    hb = hf.reshape(nblk, PEER_TOKEN_BLOCK, D)
    eb = eidx.reshape(nblk, PEER_TOKEN_BLOCK, PEER_HEADS * PEER_TOPK)
    wb = w.reshape(nblk, PEER_TOKEN_BLOCK, PEER_HEADS * PEER_TOPK)

    def block(args):
        hb_, idx_, w_ = args
        ug = jnp.take(u, idx_, axis=0)
        a = jax.nn.gelu(jnp.einsum('td,ted->te', hb_, ug), approximate=False) * w_
        vg = jnp.take(v, idx_, axis=0)
        return jnp.einsum('te,ted->td', a, vg)

    out = lax.map(block, (hb, eb, wb))
    return out.reshape(B, S, D)


def setup_inputs(seed: int = 0) -> dict:
    key = jax.random.key(seed)
    ks = jax.random.split(key, 16)
    f32 = jnp.float32
    D = D_MODEL
    nrm = lambda k, shape, scale: jax.random.normal(k, shape, f32) * scale
    return {
        "x": nrm(ks[0], (BATCH, SEQ, D), 1.0),
        "ln_mix": 1.0 + nrm(ks[1], (DEPTH, D), 0.02),
        "ln_ffn": 1.0 + nrm(ks[2], (DEPTH, D), 0.02),
        "ret_w_in": nrm(ks[3], (N_A_LAYERS, D, RET_IN_WIDTH), D ** -0.5),
        "ret_w_out": nrm(ks[4], (N_A_LAYERS, RET_V_WIDTH, D), RET_V_WIDTH ** -0.5),
        "ret_gn": 1.0 + nrm(ks[5], (N_A_LAYERS, RET_V_WIDTH), 0.02),
        "kv_norm": 1.0 + nrm(ks[6], (D,), 0.02),
        "w_kv": nrm(ks[7], (D, 2 * D), D ** -0.5),
        "att_w_q": nrm(ks[8], (N_B_LAYERS, D, D), D ** -0.5),
        "att_w_o": nrm(ks[9], (N_B_LAYERS, D, D), D ** -0.5),
        "att_rel_bias": nrm(ks[10], (N_B_LAYERS, ATT_HEADS, N_REL), 0.1),
        "peer_w_q": nrm(ks[11], (DEPTH, D, PEER_HEADS * PEER_QDIM), D ** -0.5),
        "peer_sub_keys": nrm(ks[12], (DEPTH, 2, PEER_NKEYS, PEER_HALF), PEER_HALF ** -0.5),
        "peer_u": nrm(ks[13], (DEPTH, PEER_EXPERTS, D), D ** -0.5),
        "peer_v": nrm(ks[14], (DEPTH, PEER_EXPERTS, D), (PEER_HEADS * PEER_TOPK) ** -0.5),
        "ln_final": 1.0 + nrm(ks[15], (D,), 0.02),
    }


def reference(x, ln_mix, ln_ffn, ret_w_in, ret_w_out, ret_gn, kv_norm, w_kv,
              att_w_q, att_w_o, att_rel_bias, peer_w_q, peer_sub_keys, peer_u, peer_v,
              ln_final):
    k_pad = None
    v_pad = None
    for l in range(DEPTH):
        h = rmsnorm(x, ln_mix[l])
        if l < N_A_LAYERS:
            x = x + retention(h, ret_w_in[l], ret_w_out[l], ret_gn[l])
        else:
            j = l - N_A_LAYERS
            x = x + chunk_attention(h, k_pad, v_pad, att_w_q[j], att_w_o[j], att_rel_bias[j])
        x = x + peer(rmsnorm(x, ln_ffn[l]), peer_w_q[l], peer_sub_keys[l], peer_u[l], peer_v[l])
        if l == N_A_LAYERS - 1:
            k_pad, v_pad = shared_kv(x, kv_norm, w_kv)
    return rmsnorm(x, ln_final)
```

```cpp
#include <hip/hip_runtime.h>
#include <cstdio>
#include <cstdint>

#define LAS __attribute__((address_space(3)))
#define GAS __attribute__((address_space(1)))
typedef unsigned short bf16;
typedef unsigned u32x2 __attribute__((ext_vector_type(2)));
typedef float f32x2v __attribute__((ext_vector_type(2)));

constexpr int DM = 2048, NBATCH = 4, SEQ = 4096, NTOK = NBATCH * SEQ, DEPTH = 4;
constexpr int CHUNK = 64, NCHUNK = SEQ / CHUNK;
constexpr int RH = 8, RQK = 256, RV = 512, RQKW = RH * RQK, RVW = RH * RV, RIN = 2 * RQKW + 2 * RVW;
constexpr int AH = 16, AHD = 128, LEFT = 8, NREL = 257;
constexpr int PH = 8, PNK = 128, PE = PNK * PNK, PTOPK = 16;
constexpr float EPS = 1e-6f;

constexpr size_t MiB = 1ull << 20;
constexpr size_t WS_CTL = 0, CTL_BYTES = 1 * MiB;
constexpr size_t WS_ROT = 1 * MiB;
constexpr size_t WS_WIN = 8 * MiB;
constexpr size_t WS_WOUT = 104 * MiB;
constexpr size_t WS_WKV = 136 * MiB;
constexpr size_t WS_WQ = 152 * MiB;
constexpr size_t WS_WO = 168 * MiB;
constexpr size_t WS_WC = 184 * MiB;
constexpr size_t WS_PU = 216 * MiB;
constexpr size_t WS_PV = 472 * MiB;
constexpr size_t WS_H = 728 * MiB;
constexpr size_t WS_HKV = 792 * MiB;
constexpr size_t WS_Q = 856 * MiB;
constexpr size_t WS_K = 920 * MiB;
constexpr size_t WS_V = 984 * MiB;
constexpr size_t WS_G = 1112 * MiB;
constexpr size_t WS_O = 1240 * MiB;
constexpr size_t WS_KV = 1368 * MiB;
constexpr size_t WS_AO = 1496 * MiB;
constexpr size_t WS_SC = 1560 * MiB;
constexpr size_t WS_IDX = 1688 * MiB;
constexpr size_t WS_WGT = 1696 * MiB;
constexpr size_t WS_END = 1704 * MiB;

constexpr int LDS_BYTES = 160 * 1024;
constexpr int LDS_MISC = LDS_BYTES - 256;

__device__ __forceinline__ unsigned f2bf(float f) { unsigned u = __builtin_bit_cast(unsigned, f); return (u + 0x7fffu + ((u >> 16) & 1u)) >> 16; }
typedef __bf16 bfx2_t __attribute__((ext_vector_type(2)));
__device__ __forceinline__ unsigned pk2(float lo, float hi) { const f32x2v v = {lo, hi}; return __builtin_bit_cast(unsigned, __builtin_convertvector(v, bfx2_t)); }
__device__ __forceinline__ float bflo(unsigned u) { return __builtin_bit_cast(float, u << 16); }
__device__ __forceinline__ float bfhi(unsigned u) { return __builtin_bit_cast(float, u & 0xffff0000u); }
__device__ __forceinline__ float wave_sum(float v) {
#pragma unroll
    for (int o = 1; o < 64; o <<= 1) v += __shfl_xor(v, o);
    return v;
}
#define VM_WAIT() asm volatile("s_waitcnt vmcnt(0)" ::: "memory")
#define LDS_WAIT() asm volatile("s_waitcnt lgkmcnt(0)" ::: "memory")

#define XB_TMO      128
#define XB_XCNT(j)  (256  + 64 * (j))
#define XB_XSUB(j)  (1280 + 64 * (j))
#define XB_XGEN(j)  (2304 + 64 * (j))
#define XB_TOP      3328
#define XB_TOPGEN   3392
#define XCD_BAR_WORDS 3456
#define XB_SPIN_CAP (1u << 18)

__device__ __forceinline__ unsigned xb_ld(unsigned* p)              { return __hip_atomic_load(p, __ATOMIC_RELAXED, __HIP_MEMORY_SCOPE_AGENT); }
__device__ __forceinline__ unsigned xb_add(unsigned* p, unsigned v) { return __hip_atomic_fetch_add(p, v, __ATOMIC_RELAXED, __HIP_MEMORY_SCOPE_AGENT); }
__device__ __forceinline__ unsigned xb_xcc_id() { return (unsigned)__builtin_amdgcn_s_getreg((3 << 11) | 20) & 0xFu; }
#define XB_SPIN(cond, bar) do { unsigned _sp = 0; while (cond) { __builtin_amdgcn_s_sleep(1); \
    if ((++_sp & 255u) == 0u) { if (xb_ld(&(bar)[XB_TMO])) break; if (_sp > XB_SPIN_CAP) { atomicAdd(&(bar)[XB_TMO], 1u); break; } } } } while (0)

struct XcdBarrier {
    unsigned* bar; unsigned x;
    volatile LAS unsigned* st;
};

__device__ __forceinline__ XcdBarrier xcd_barrier_post(unsigned* bar, volatile LAS unsigned* st) {
    XcdBarrier b; b.bar = bar; b.x = xb_xcc_id(); b.st = st;
    if (threadIdx.x == 0) (void)xb_add(&bar[XB_XCNT(b.x)], 1u);
    return b;
}
__device__ __forceinline__ void xcd_barrier_complete(unsigned* bar, unsigned x, unsigned& nloc, unsigned& nx) {
    const unsigned G = gridDim.x * gridDim.y * gridDim.z;
    unsigned sum, cnt, mine, sp = 0u;
    for (;;) {
        sum = 0u; cnt = 0u; mine = 0u;
#pragma unroll
        for (unsigned j = 0; j < 16; ++j) { const unsigned c = xb_ld(&bar[XB_XCNT(j)]); sum += c; cnt += (c > 0u) ? 1u : 0u; mine = (j == x) ? c : mine; }
        if (sum == G) break;
        __builtin_amdgcn_s_sleep(1);
        if ((++sp & 255u) == 0u) { if (xb_ld(&bar[XB_TMO])) break; if (sp > XB_SPIN_CAP) { atomicAdd(&bar[XB_TMO], 1u); break; } }
    }
    nloc = mine > 0u ? mine : 1u; nx = cnt > 0u ? cnt : 1u;
}

__device__ __forceinline__ void xcd_barrier(const XcdBarrier& b) {
    asm volatile("s_waitcnt vmcnt(0)" ::: "memory");
    __syncthreads();
    if (threadIdx.x == 0) {
        unsigned* bar = b.bar;
        __builtin_amdgcn_s_waitcnt(0);
        unsigned nloc = b.st[0], nx = b.st[1];
        if (nloc == 0u) { xcd_barrier_complete(bar, b.x, nloc, nx); b.st[0] = nloc; b.st[1] = nx; }
        const unsigned old = xb_add(&bar[XB_XSUB(b.x)], 1u);
        const unsigned gen = old / nloc;
        if (old + 1u == (gen + 1u) * nloc) {
            __builtin_amdgcn_fence(__ATOMIC_RELEASE, "agent");
            asm volatile("s_waitcnt vmcnt(0)" ::: "memory");
            const unsigned og = xb_add(&bar[XB_TOP], 1u);
            const unsigned tg = og / nx;
            if (og + 1u == (tg + 1u) * nx) xb_add(&bar[XB_TOPGEN], 1u);
            else XB_SPIN(xb_ld(&bar[XB_TOPGEN]) == tg, bar);
            __builtin_amdgcn_fence(__ATOMIC_ACQUIRE, "agent");
            xb_add(&bar[XB_XGEN(b.x)], 1u);
            asm volatile("s_waitcnt vmcnt(0)" ::: "memory");
        } else {
            XB_SPIN(xb_ld(&bar[XB_XGEN(b.x)]) == gen, bar);
            __builtin_amdgcn_fence(__ATOMIC_ACQUIRE, "agent");
            asm volatile("s_waitcnt vmcnt(0)" ::: "memory");
        }
    }
    __syncthreads();
}

namespace pg8 {
#define PG8_LAS __attribute__((address_space(3)))
typedef unsigned short bf16_t;
typedef short bf16x8 __attribute__((ext_vector_type(8)));
typedef float f32x4 __attribute__((ext_vector_type(4)));
typedef unsigned u32x4 __attribute__((ext_vector_type(4)));
constexpr int BM = 256, BK = 64, HALF = 128, HTB = HALF * BK * 2  , STAGE_BYTES = 8 * HTB, NXCD = 8, WGM = 8;

__host__ __device__ __forceinline__ int lds_byte(int r, int c) { const int st = (r >> 4) * 2 + (c >> 5), rr = r & 15, cc = c & 31, ob = rr * 64 + cc * 2; return st * 1024 + (ob ^ (((ob >> 9) & 1) << 5)); }
__host__ __device__ __forceinline__ void stage_rc(int b, int& R, int& C) { const int st = b / 1024, sb = b % 1024, swz = sb ^ (((sb >> 9) & 1) << 5); R = (st >> 1) * 16 + swz / 64; C = (st & 1) * 32 + (swz % 64) / 2; }
__host__ __device__ __forceinline__ int perm32(int rho) { const int n = rho >> 4, i = rho & 15; return 8 * (i >> 2) + 4 * n + (i & 3); }

struct Unit { int pm, pn; };
struct Gemm { const bf16_t* A; const bf16_t* Bt; int M, N, K; };

struct StaticOrder {
    int nM, nN, nwg, G, c;
    __host__ __device__ void init(int M, int N, int G_, int c_) { nM = M / BM; nN = N / BM; nwg = nM * nN; G = G_; c = c_; }
    __host__ __device__ bool next(int i, Unit& u) const {
        const long L = (long)i * G + c; if (L >= nwg) return false;
        int wgid = (int)L; { const int q = nwg / NXCD, r = nwg % NXCD, xcd = wgid % NXCD, off = wgid / NXCD; wgid = (xcd < r ? xcd * (q + 1) : r * (q + 1) + (xcd - r) * q) + off; }
        const int nig = WGM * nN, gid = wgid / nig, fm = gid * WGM, gsz = (nM - fm) < WGM ? (nM - fm) : WGM;
        u.pm = fm + ((wgid % nig) % gsz); u.pn = (wgid % nig) / gsz; return true;
    }
    __device__ __forceinline__ void a_ready(const Unit&) const {}
    __device__ __forceinline__ void done(const Unit&) const {}
};
struct CountedOrder : StaticOrder {
    const unsigned* ready; unsigned need; unsigned* tmo;
    __device__ __forceinline__ void a_ready(const Unit& u) const {
        if (threadIdx.x < 64) {
            const unsigned long long t0 = __builtin_amdgcn_s_memrealtime(); unsigned polls = 0;
            while ((unsigned)__builtin_amdgcn_readfirstlane(__hip_atomic_load(ready + 64 * u.pm, __ATOMIC_RELAXED, __HIP_MEMORY_SCOPE_AGENT)) < need) {
                if ((++polls & 255u) == 0u && __builtin_amdgcn_readfirstlane(__hip_atomic_load(tmo, __ATOMIC_RELAXED, __HIP_MEMORY_SCOPE_AGENT)) != 0u) break;
                if (__builtin_amdgcn_s_memrealtime() - t0 > 2000000ull) {
                    if (threadIdx.x == 0) { unsigned expect = 0u; __hip_atomic_compare_exchange_strong(tmo + 1, &expect, 0x600u | (unsigned)(u.pm & 0xff), __ATOMIC_RELAXED, __ATOMIC_RELAXED, __HIP_MEMORY_SCOPE_AGENT); __hip_atomic_store(tmo, 1u, __ATOMIC_RELAXED, __HIP_MEMORY_SCOPE_AGENT); }
                    break; }
                __builtin_amdgcn_s_sleep(2); }
            __builtin_amdgcn_fence(__ATOMIC_ACQUIRE, "agent");
            asm volatile("s_waitcnt vmcnt(0)" ::: "memory");
        }
#if !defined(BROKEN_HOOK_NO_BARRIER)
        asm volatile("" ::: "memory"); __builtin_amdgcn_s_barrier(); asm volatile("" ::: "memory");
#endif
    }
};

__device__ __forceinline__ unsigned cvt_pk_bf16(float lo, float hi) { return pk2(lo, hi); }
typedef float f32x2 __attribute__((ext_vector_type(2)));
__device__ __forceinline__ f32x2 gelu_pk(f32x2 v) {
    const f32x2 av = __builtin_elementwise_abs(v), d = av * 0.2316418882f + 1.0f;
    f32x2 t; t.x = __builtin_amdgcn_rcpf(d.x); t.y = __builtin_amdgcn_rcpf(d.y);
    f32x2 q = t * 0.5307027145f + (-0.7265760135f); q = q * t + 0.7107068705f; q = q * t + (-0.142248368f); q = q * t + 0.127414796f; q = q * t;
    const f32x2 s = (v * v) * (-0.72134752044f);
    f32x2 e; e.x = __builtin_amdgcn_exp2f(s.x); e.y = __builtin_amdgcn_exp2f(s.y);
    const f32x2 m = v * (q * e), r = v - m;
    f32x2 o; o.x = v.x < 0.f ? m.x : r.x; o.y = v.y < 0.f ? m.y : r.y; return o;
}


struct EpiF32 {
    static constexpr bool PERM = false, AFTER_DRAIN = false;
    float* C; int ldc;
    __device__ __forceinline__ void operator()(const f32x4 (&acc)[2][2][4][2], const Unit& u, int wr, int wc, int fr, int fq) const {
        const int row0 = u.pm * BM + wr * 64 + fr, col0 = u.pn * BM + wc * 32 + 4 * fq;
#pragma unroll
        for (int ai = 0; ai < 2; ++ai)
#pragma unroll
            for (int m = 0; m < 4; ++m) { float* rowp = C + (size_t)(row0 + ai * HALF + m * 16) * ldc + col0;
#pragma unroll
                for (int bj = 0; bj < 2; ++bj)
#pragma unroll
                    for (int n = 0; n < 2; ++n) *(f32x4*)(rowp + bj * HALF + n * 16) = acc[ai][bj][m][n]; }
    }
};
struct EpiRes {
    static constexpr bool PERM = false, AFTER_DRAIN = false;
    float* X; int ldc;
    __device__ __forceinline__ void operator()(const f32x4 (&acc)[2][2][4][2], const Unit& u, int wr, int wc, int fr, int fq) const {
        const int row0 = u.pm * BM + wr * 64 + fr, col0 = u.pn * BM + wc * 32 + 4 * fq;
#pragma unroll
        for (int ai = 0; ai < 2; ++ai)
#pragma unroll
            for (int m = 0; m < 4; ++m) { float* rowp = X + (size_t)(row0 + ai * HALF + m * 16) * ldc + col0;
                f32x4 old[2][2];
#pragma unroll
                for (int bj = 0; bj < 2; ++bj)
#pragma unroll
                    for (int n = 0; n < 2; ++n) old[bj][n] = *(const f32x4*)(rowp + bj * HALF + n * 16);
#pragma unroll
                for (int bj = 0; bj < 2; ++bj)
#pragma unroll
                    for (int n = 0; n < 2; ++n) *(f32x4*)(rowp + bj * HALF + n * 16) = old[bj][n] + acc[ai][bj][m][n]; }
    }
};
struct EpiBf16S {
    static constexpr bool PERM = true, AFTER_DRAIN = false;
    bf16_t* O; int ldc; float scale;
    __device__ __forceinline__ void operator()(const f32x4 (&acc)[2][2][4][2], const Unit& u, int wr, int wc, int fr, int fq) const {
        const int row0 = u.pm * BM + wr * 64 + fr, col0 = u.pn * BM + wc * 32 + 8 * fq;
#pragma unroll
        for (int ai = 0; ai < 2; ++ai)
#pragma unroll
            for (int m = 0; m < 4; ++m) { bf16_t* rowp = O + (size_t)(row0 + ai * HALF + m * 16) * ldc + col0;
#pragma unroll
                for (int bj = 0; bj < 2; ++bj) { const f32x4 v0 = acc[ai][bj][m][0] * scale, v1 = acc[ai][bj][m][1] * scale;
                    u32x4 w; w.x = cvt_pk_bf16(v0[0], v0[1]); w.y = cvt_pk_bf16(v0[2], v0[3]); w.z = cvt_pk_bf16(v1[0], v1[1]); w.w = cvt_pk_bf16(v1[2], v1[3]);
                    *(u32x4*)(rowp + bj * HALF) = w; } }
    }
};
struct EpiProj {
    static constexpr bool PERM = true, AFTER_DRAIN = false;
    bf16_t *Q, *Kp, *V, *G; const float* rot;
    __device__ __forceinline__ void operator()(const f32x4 (&acc)[2][2][4][2], const Unit& u, int wr, int wc, int fr, int fq) const {
        const int row0 = u.pm * BM + wr * 64 + fr, pn = u.pn, dd0 = wc * 32 + 8 * fq;
        if (pn < 16) {
            bf16_t* base = (pn < 8 ? Q : Kp) + (pn & 7) * 256 + dd0; const float sc = pn < 8 ? 1.0f : 0.0625f;
#pragma unroll
            for (int ai = 0; ai < 2; ++ai)
#pragma unroll
                for (int m = 0; m < 4; ++m) { const int r = row0 + ai * HALF + m * 16; const float* rt = rot + (size_t)(r & (4096 - 1)) * 256 + dd0;
                    f32x4 o1[2], o2[2];
#pragma unroll
                    for (int n = 0; n < 2; ++n) { const f32x4 cs = *(const f32x4*)(rt + 4 * n), sn = *(const f32x4*)(rt + 128 + 4 * n); const f32x4 t1 = acc[ai][0][m][n], t2 = acc[ai][1][m][n];
                        o1[n] = (t1 * cs - t2 * sn) * sc; o2[n] = (t1 * sn + t2 * cs) * sc; }
                    u32x4 w1, w2;
                    w1.x = cvt_pk_bf16(o1[0][0], o1[0][1]); w1.y = cvt_pk_bf16(o1[0][2], o1[0][3]); w1.z = cvt_pk_bf16(o1[1][0], o1[1][1]); w1.w = cvt_pk_bf16(o1[1][2], o1[1][3]);
                    w2.x = cvt_pk_bf16(o2[0][0], o2[0][1]); w2.y = cvt_pk_bf16(o2[0][2], o2[0][3]); w2.z = cvt_pk_bf16(o2[1][0], o2[1][1]); w2.w = cvt_pk_bf16(o2[1][2], o2[1][3]);
                    bf16_t* rowp = base + (size_t)r * 2048; *(u32x4*)rowp = w1; *(u32x4*)(rowp + 128) = w2; }
        } else {
            bf16_t* base = (pn < 32 ? V : G) + ((pn - 16) & 15) * 256 + dd0;
#pragma unroll
            for (int ai = 0; ai < 2; ++ai)
#pragma unroll
                for (int m = 0; m < 4; ++m) { bf16_t* rowp = base + (size_t)(row0 + ai * HALF + m * 16) * 4096;
#pragma unroll
                    for (int bj = 0; bj < 2; ++bj) { const f32x4 v0 = acc[ai][bj][m][0], v1 = acc[ai][bj][m][1];
                        u32x4 w; w.x = cvt_pk_bf16(v0[0], v0[1]); w.y = cvt_pk_bf16(v0[2], v0[3]); w.z = cvt_pk_bf16(v1[0], v1[1]); w.w = cvt_pk_bf16(v1[2], v1[3]);
                        *(u32x4*)(rowp + bj * HALF) = w; } }
        }
    }
};
template <class Epi, class Sched, bool STAMP = false>
__device__ __forceinline__ void gemm_phase(PG8_LAS unsigned char* lds, const Gemm g, const Sched& S, const Epi& E, unsigned long long* stamps) {
    const int tid = threadIdx.x, wid = __builtin_amdgcn_readfirstlane(tid >> 6), lane = tid & 63, wr = wid >> 2, wc = wid & 3, fr = lane & 15, fq = lane >> 4;
    const int K = g.K, nt = K / BK;
    int ts_lo = 0, ts_hi = 0, nts = 0; const unsigned long long rt_entry = STAMP ? (unsigned long long)wall_clock64() : 0ull;
#define PG8_STAMP() do { if (STAMP && wid == 0 && nts < 64) { const unsigned long long _c = (unsigned long long)clock64(); \
        ts_lo = (lane == nts) ? (int)(unsigned)_c : ts_lo; ts_hi = (lane == nts) ? (int)(unsigned)(_c >> 32) : ts_hi; ++nts; } } while (0)
    PG8_STAMP();
    unsigned voffA[2], voffB[2];
#pragma unroll
    for (int i = 0; i < 2; ++i) { int R, C; stage_rc(tid * 16 + i * 8192, R, C); const int Rb = Epi::PERM ? ((R & ~31) + perm32(R & 31)) : R;
        voffA[i] = (unsigned)(R * K + C) * 2u; voffB[i] = (unsigned)(Rb * K + C) * 2u; }
    const size_t kstep = (size_t)(BK * 2);
    const size_t hstep = (size_t)HALF * K * 2;
    const size_t tstep = 2 * hstep;
    const unsigned ldsw = (unsigned)wid * 1024u;
    const int aoff = lds_byte(wr * 64 + fr, fq * 8), boff = lds_byte(wc * 32 + fr, fq * 8);
#define PG8_SA(b, h) (((b) * 2 + (h)) * HTB)
#define PG8_SB(b, h) ((4 + (b) * 2 + (h)) * HTB)
#define PG8_STAGE(bufoff, gbase, voff) do { _Pragma("unroll") for (int _i = 0; _i < 2; ++_i) \
        __builtin_amdgcn_global_load_lds((const unsigned*)((const char*)(gbase) + (voff)[_i]), (PG8_LAS unsigned*)(lds + (bufoff) + ldsw + _i * 8192), 16, 0, 0); } while (0)
#define PG8_LDA(dst, b, h) do { _Pragma("unroll") for (int m = 0; m < 4; ++m) _Pragma("unroll") for (int k = 0; k < 2; ++k) dst[m][k] = *(const PG8_LAS bf16x8*)(lds + PG8_SA(b, h) + aoff + m * 2048 + k * 1024); } while (0)
#define PG8_LDB(dst, b, h) do { _Pragma("unroll") for (int n = 0; n < 2; ++n) _Pragma("unroll") for (int k = 0; k < 2; ++k) dst[n][k] = *(const PG8_LAS bf16x8*)(lds + PG8_SB(b, h) + boff + n * 2048 + k * 1024); } while (0)
#define PG8_MMA(ai, bj, At, Bt) do { __builtin_amdgcn_s_setprio(1); _Pragma("unroll") for (int m = 0; m < 4; ++m) _Pragma("unroll") for (int n = 0; n < 2; ++n) _Pragma("unroll") for (int k = 0; k < 2; ++k) \
        acc[ai][bj][m][n] = __builtin_amdgcn_mfma_f32_16x16x32_bf16(Bt[n][k], At[m][k], acc[ai][bj][m][n], 0, 0, 0); __builtin_amdgcn_s_setprio(0); } while (0)
#define PG8_WAIT_V(n) asm volatile("s_waitcnt vmcnt(" #n ")" ::: "memory")
#define PG8_WAIT_L(n) asm volatile("s_waitcnt lgkmcnt(" #n ")" ::: "memory")
#define PG8_BAR __builtin_amdgcn_s_barrier()
#define PG8_SCHED __builtin_amdgcn_sched_barrier(0)
    Unit cur, nxt; int ui = 0;
    if (!S.next(0, cur)) return;
    f32x4 acc[2][2][4][2];
#pragma unroll
    for (int a = 0; a < 2; ++a)
#pragma unroll
        for (int b = 0; b < 2; ++b)
#pragma unroll
            for (int m = 0; m < 4; ++m)
#pragma unroll
                for (int n = 0; n < 2; ++n) acc[a][b][m][n] = (f32x4){0.f, 0.f, 0.f, 0.f};
    bf16x8 At[4][2], B0[2][2], B1[2][2];
    const char* cA = (const char*)g.A + (size_t)cur.pm * tstep; const char* cB = (const char*)g.Bt + (size_t)cur.pn * tstep;
    S.a_ready(cur);
    PG8_STAGE(PG8_SB(0, 0), cB, voffB); PG8_STAGE(PG8_SA(0, 0), cA, voffA); PG8_STAGE(PG8_SB(0, 1), cB + hstep, voffB); PG8_STAGE(PG8_SA(0, 1), cA + hstep, voffA);
    if (wr == 1) PG8_BAR;
    PG8_WAIT_V(4); PG8_BAR;
    PG8_STAGE(PG8_SB(1, 0), cB + kstep, voffB); PG8_STAGE(PG8_SA(1, 0), cA + kstep, voffA); PG8_STAGE(PG8_SB(1, 1), cB + hstep + kstep, voffB);
    PG8_WAIT_V(6); PG8_BAR;
    PG8_STAMP();
    for (;;) {
        const bool has_next = S.next(ui + 1, nxt);
        const char* nA = has_next ? (const char*)g.A + (size_t)nxt.pm * tstep : cA; const char* nB = has_next ? (const char*)g.Bt + (size_t)nxt.pn * tstep : cB;
        for (int t = 0; t < nt; t += 2) {
            const bool last = (t == nt - 2);
            const char* a1 = cA + (size_t)(t + 1) * kstep;
            const char* a2 = last ? nA : cA + (size_t)(t + 2) * kstep; const char* b2 = last ? nB : cB + (size_t)(t + 2) * kstep;
            const char* a3 = a2 + kstep; const char* b3 = b2 + kstep;
            if (last && has_next) S.a_ready(nxt);
            PG8_LDB(B0, 0, 0); PG8_SCHED; PG8_LDA(At, 0, 0); PG8_STAGE(PG8_SA(1, 1), a1 + hstep, voffA);
            PG8_WAIT_L(8); PG8_BAR; PG8_WAIT_L(0); PG8_MMA(0, 0, At, B0); PG8_BAR; PG8_SCHED;
            PG8_LDB(B1, 0, 1); PG8_STAGE(PG8_SB(0, 0), b2, voffB);
            PG8_BAR; PG8_WAIT_L(0); PG8_MMA(0, 1, At, B1); PG8_BAR;
            PG8_LDA(At, 0, 1); PG8_STAGE(PG8_SA(0, 0), a2, voffA);
            PG8_BAR; PG8_WAIT_L(0); PG8_MMA(1, 0, At, B0); PG8_BAR; PG8_SCHED;
            PG8_STAGE(PG8_SB(0, 1), b2 + hstep, voffB);
            PG8_WAIT_V(6); PG8_BAR; PG8_MMA(1, 1, At, B1); PG8_BAR;
            PG8_LDB(B0, 1, 0); PG8_SCHED; PG8_LDA(At, 1, 0); PG8_STAGE(PG8_SA(0, 1), a2 + hstep, voffA);
            PG8_WAIT_L(8); PG8_BAR; PG8_WAIT_L(0); PG8_MMA(0, 0, At, B0); PG8_BAR; PG8_SCHED;
            PG8_LDB(B1, 1, 1); PG8_STAGE(PG8_SB(1, 0), b3, voffB);
            PG8_BAR; PG8_WAIT_L(0); PG8_MMA(0, 1, At, B1); PG8_BAR;
            PG8_LDA(At, 1, 1); PG8_STAGE(PG8_SA(1, 0), a3, voffA);
            PG8_BAR; PG8_WAIT_L(0); PG8_MMA(1, 0, At, B0); PG8_BAR; PG8_SCHED;
            PG8_STAGE(PG8_SB(1, 1), b3 + hstep, voffB);
            PG8_WAIT_V(6); PG8_BAR; PG8_MMA(1, 1, At, B1); PG8_BAR;
        }
        PG8_STAMP();
        if constexpr (!Epi::AFTER_DRAIN) { E(acc, cur, wr, wc, fr, fq); S.done(cur); }
        PG8_STAMP();
        if (!has_next) break;
#pragma unroll
        for (int a = 0; a < 2; ++a)
#pragma unroll
            for (int b = 0; b < 2; ++b)
#pragma unroll
                for (int m = 0; m < 4; ++m)
#pragma unroll
                    for (int n = 0; n < 2; ++n) acc[a][b][m][n] = (f32x4){0.f, 0.f, 0.f, 0.f};
        cur = nxt; cA = nA; cB = nB; ++ui;
    }
    PG8_WAIT_V(0);
    if (wr == 0) PG8_BAR;
    PG8_BAR;
    if constexpr (Epi::AFTER_DRAIN) { E.fused(acc, cur, wr, wc, fr, fq, lds, wid, lane); S.done(cur); }
    PG8_STAMP();
    if (STAMP && wid == 0) { stamps[lane] = lane < nts ? (((unsigned long long)(unsigned)ts_hi << 32) | (unsigned)ts_lo) : 0ull;
        if (lane == 62) stamps[62] = rt_entry; if (lane == 63) stamps[63] = (unsigned long long)wall_clock64(); }
#undef PG8_STAMP
#undef PG8_SA
#undef PG8_SB
#undef PG8_STAGE
#undef PG8_LDA
#undef PG8_LDB
#undef PG8_MMA
#undef PG8_WAIT_V
#undef PG8_WAIT_L
#undef PG8_BAR
#undef PG8_SCHED
}
}

using pg8::bf16x8; using pg8::f32x4; using pg8::u32x4;
typedef short s16x4 __attribute__((ext_vector_type(4)));
typedef __bf16 bfx2 __attribute__((ext_vector_type(2)));

struct Params {
    const float *x, *ln_mix, *ln_ffn, *ret_w_in, *ret_w_out, *ret_gn, *kv_norm, *w_kv, *att_w_q, *att_w_o, *att_rel_bias, *peer_w_q, *peer_sub_keys, *peer_u, *peer_v, *ln_final;
    float* out; unsigned char* ws; int lo, hi;
};
struct Ctx { LAS unsigned char* lds; int tid, lane, wave, bx, G, gw, ngw; };

__device__ __forceinline__ float dot2bf(unsigned a, unsigned b, float c) { return __builtin_amdgcn_fdot2_f32_bf16(__builtin_bit_cast(bfx2, a), __builtin_bit_cast(bfx2, b), c, false); }
__device__ __forceinline__ bf16x8 lds128(LAS const unsigned char* p) { return *(LAS const bf16x8*)p; }
__device__ __forceinline__ bf16x8 tr_frag(unsigned a0, unsigned a1) {
    s16x4 lo, hi;
    asm volatile("ds_read_b64_tr_b16 %0, %2\n\tds_read_b64_tr_b16 %1, %3\n\ts_waitcnt lgkmcnt(0)" : "=&v"(lo), "=&v"(hi) : "v"(a0), "v"(a1) : "memory");
    bf16x8 r; r[0] = lo[0]; r[1] = lo[1]; r[2] = lo[2]; r[3] = lo[3]; r[4] = hi[0]; r[5] = hi[1]; r[6] = hi[2]; r[7] = hi[3]; return r;
}
#define MFMA16(a, b, c) __builtin_amdgcn_mfma_f32_16x16x32_bf16((a), (b), (c), 0, 0, 0)

__device__ __forceinline__ void load_row(const float* xrow, int lane, f32x4 (&v)[8]) {
    const f32x4* xr = (const f32x4*)xrow + lane;
#pragma unroll
    for (int j = 0; j < 8; ++j) v[j] = xr[64 * j];
}
__device__ __forceinline__ float row_rstd(const f32x4 (&v)[8]) {
    float s = 0.f;
#pragma unroll
    for (int j = 0; j < 8; ++j) s += (v[j][0] * v[j][0] + v[j][1] * v[j][1]) + (v[j][2] * v[j][2] + v[j][3] * v[j][3]);
    return 1.0f / sqrtf(wave_sum(s) * (1.0f / DM) + EPS);
}
__device__ __forceinline__ void store_norm_bf16(const f32x4 (&v)[8], float rstd, const float* g, bf16* orow, int lane) {
    const f32x4* gr = (const f32x4*)g + lane; u32x2* o8 = (u32x2*)orow + lane;
#pragma unroll
    for (int j = 0; j < 8; ++j) { const f32x4 gv = gr[64 * j]; u32x2 w; w.x = pk2(v[j][0] * rstd * gv[0], v[j][1] * rstd * gv[1]); w.y = pk2(v[j][2] * rstd * gv[2], v[j][3] * rstd * gv[3]); o8[64 * j] = w; }
}

__device__ __forceinline__ void p0_transpose_item(const float* W, int K, int N, bf16* WT, LAS float* scr, int item, int lane) {
    const int nblk = N / 32, kb = item / nblk, nb = item % nblk, k0 = 64 * kb, n0 = 32 * nb;
#pragma unroll 8
    for (int i = 0; i < 32; ++i) { const int kk = 2 * i + (lane >> 5); scr[kk * 33 + (lane & 31)] = W[(size_t)(k0 + kk) * N + n0 + (lane & 31)]; }
    LDS_WAIT(); asm volatile("" ::: "memory");
    const int c = lane & 7;
#pragma unroll
    for (int j = 0; j < 4; ++j) { const int n = (lane >> 3) + 8 * j; const LAS float* s = scr + (8 * c) * 33 + n;
        u32x4 o; o.x = pk2(s[0 * 33], s[1 * 33]); o.y = pk2(s[2 * 33], s[3 * 33]); o.z = pk2(s[4 * 33], s[5 * 33]); o.w = pk2(s[6 * 33], s[7 * 33]);
        *(u32x4*)(WT + (size_t)(n0 + n) * K + k0 + 8 * c) = o; }
    LDS_WAIT(); asm volatile("" ::: "memory");
}
__device__ __forceinline__ void p0_fold_tile(const Params& p, const Ctx& c, int tl) {
    const int l = tl >> 9, hp = (tl >> 5) & 15, j0 = (tl & 31) * 64;
    LAS float* As = (LAS float*)c.lds;
    LAS float* Bs = (LAS float*)c.lds + 64 * 132;
    const float* Wq = p.peer_w_q + (size_t)l * DM * DM; const float* sk = p.peer_sub_keys + ((size_t)l * 2 + (hp & 1)) * PNK * 128;
    __syncthreads();
    for (int i = c.tid; i < 64 * 32; i += 512) { const int jj = i >> 5, d4 = i & 31; *(LAS f32x4*)(As + jj * 132 + d4 * 4) = *(const f32x4*)(Wq + (size_t)(j0 + jj) * DM + hp * 128 + d4 * 4); }
    for (int i = c.tid; i < 128 * 32; i += 512) { const int k = i >> 5, d4 = i & 31; *(LAS f32x4*)(Bs + k * 132 + d4 * 4) = *(const f32x4*)(sk + (size_t)k * 128 + d4 * 4); }
    __syncthreads();
    const int tj = c.tid & 15, tk = c.tid >> 4;
    float acc[4][4];
#pragma unroll
    for (int b = 0; b < 4; ++b)
#pragma unroll
        for (int a = 0; a < 4; ++a) acc[b][a] = 0.f;
    for (int d4 = 0; d4 < 32; ++d4) {
        f32x4 av[4], bv[4];
#pragma unroll
        for (int a = 0; a < 4; ++a) av[a] = *(LAS const f32x4*)(As + (tj + 16 * a) * 132 + d4 * 4);
#pragma unroll
        for (int b = 0; b < 4; ++b) bv[b] = *(LAS const f32x4*)(Bs + (tk * 4 + b) * 132 + d4 * 4);
#pragma unroll
        for (int b = 0; b < 4; ++b)
#pragma unroll
            for (int a = 0; a < 4; ++a) acc[b][a] += (av[a][0] * bv[b][0] + av[a][1] * bv[b][1]) + (av[a][2] * bv[b][2] + av[a][3] * bv[b][3]);
    }
    bf16* WcT = (bf16*)(p.ws + WS_WC) + (size_t)l * DM * DM;
#pragma unroll
    for (int b = 0; b < 4; ++b)
#pragma unroll
        for (int a = 0; a < 4; ++a) WcT[(size_t)(hp * 128 + tk * 4 + b) * DM + j0 + tj + 16 * a] = (bf16)f2bf(acc[b][a]);
}
__device__ __forceinline__ void p0_prologue(const Params& p, const Ctx& c) {
    for (int tl = c.bx; tl < DEPTH * 16 * 32; tl += c.G) p0_fold_tile(p, c, tl);
    __syncthreads();
    {
        LAS float* scr = (LAS float*)(c.lds + c.wave * 16384);
        constexpr int I_IN = (DM / 64) * (RIN / 32), I_OUT = (RVW / 64) * (DM / 32), I_KV = (DM / 64) * (2 * DM / 32), I_SQ = (DM / 64) * (DM / 32);
        constexpr int NITEMS = 2 * I_IN + 2 * I_OUT + I_KV + 4 * I_SQ;
        for (int it = c.gw; it < NITEMS; it += c.ngw) {
            int r = it;
            if (r < 2 * I_IN) { const int l = r / I_IN; p0_transpose_item(p.ret_w_in + (size_t)l * DM * RIN, DM, RIN, (bf16*)(p.ws + WS_WIN) + (size_t)l * RIN * DM, scr, r % I_IN, c.lane); continue; } r -= 2 * I_IN;
            if (r < 2 * I_OUT) { const int l = r / I_OUT; p0_transpose_item(p.ret_w_out + (size_t)l * RVW * DM, RVW, DM, (bf16*)(p.ws + WS_WOUT) + (size_t)l * DM * RVW, scr, r % I_OUT, c.lane); continue; } r -= 2 * I_OUT;
            if (r < I_KV) { p0_transpose_item(p.w_kv, DM, 2 * DM, (bf16*)(p.ws + WS_WKV), scr, r, c.lane); continue; } r -= I_KV;
            if (r < 2 * I_SQ) { const int l = r / I_SQ; p0_transpose_item(p.att_w_q + (size_t)l * DM * DM, DM, DM, (bf16*)(p.ws + WS_WQ) + (size_t)l * DM * DM, scr, r % I_SQ, c.lane); continue; } r -= 2 * I_SQ;
            { const int l = r / I_SQ; p0_transpose_item(p.att_w_o + (size_t)l * DM * DM, DM, DM, (bf16*)(p.ws + WS_WO) + (size_t)l * DM * DM, scr, r % I_SQ, c.lane); }
        }
    }
    {
        const size_t n8 = (size_t)DEPTH * PE * DM / 8, gt = (size_t)c.bx * 512 + c.tid, gs = (size_t)c.G * 512;
        for (int which = 0; which < 2; ++which) {
            const f32x4* src = (const f32x4*)(which ? p.peer_v : p.peer_u); u32x4* dst = (u32x4*)(p.ws + (which ? WS_PV : WS_PU));
            for (size_t i = gt; i < n8; i += gs) { const f32x4 a = src[2 * i], b = src[2 * i + 1]; u32x4 o; o.x = pk2(a[0], a[1]); o.y = pk2(a[2], a[3]); o.z = pk2(b[0], b[1]); o.w = pk2(b[2], b[3]); dst[i] = o; }
        }
    }
    {
        float* rot = (float*)(p.ws + WS_ROT);
        for (int i = c.bx * 512 + c.tid; i < SEQ * 128; i += c.G * 512) { const int pos = i >> 7, d = i & 127;
            const float inv = (float)(1.0 / pow(10000.0, (double)d / 128.0)); const float ang = (float)pos * inv;
            rot[(size_t)pos * 256 + d] = (float)cos((double)ang); rot[(size_t)pos * 256 + 128 + d] = (float)sin((double)ang); }
    }
    for (int m = c.gw; m < NTOK; m += c.ngw) {
        f32x4 v[8]; load_row(p.x + (size_t)m * DM, c.lane, v);
        f32x4* xo = (f32x4*)(p.out + (size_t)m * DM) + c.lane;
#pragma unroll
        for (int j = 0; j < 8; ++j) xo[64 * j] = v[j];
        store_norm_bf16(v, row_rstd(v), p.ln_mix, (bf16*)(p.ws + WS_H) + (size_t)m * DM, c.lane);
    }
}

constexpr int RS_QS = 0, RS_KS = 33792, RS_VS = 67584, RS_VZ = 76800, RS_PS = 86016, RS_RS = 95232, RS_END = 129024, QK_STR = 528, V_STR = 144;
__device__ __forceinline__ void ret_scan_unit(const Ctx& c, const bf16* Qg, const bf16* Kg, const bf16* Vg, bf16* Og, int unit) {
    const int xg = unit & 7, slot = unit >> 3, pair = xg * 4 + (slot >> 3), es = slot & 7, b = pair >> 3, h = pair & 7;
    const int tid = c.tid, lane = c.lane, w = c.wave, fr = lane & 15, fq = lane >> 4, tq = (lane & 15) >> 2, tp = lane & 3;
    LAS unsigned char* lds = c.lds;
    const float lgam = log1pf(-exp2f(-5.0f - (float)h));
    const float cdec = expf(lgam * 64.0f);
    const int lrow = tid >> 3, lch = tid & 7;
    const size_t tok0 = (size_t)b * SEQ;
    const bf16* qrow = Qg + (tok0 + lrow) * RQKW + h * RQK + lch * 8;
    const bf16* krow = Kg + (tok0 + lrow) * RQKW + h * RQK + lch * 8;
    const bf16* vrow = Vg + (tok0 + lrow) * RVW + h * RV + es * 64 + lch * 8;
    const float zeta = expf(lgam * (float)(63 - lrow));
    u32x4 pq[4], pk[4], pv;
#pragma unroll
    for (int cc = 0; cc < 4; ++cc) { pq[cc] = *(const u32x4*)(qrow + cc * 64); pk[cc] = *(const u32x4*)(krow + cc * 64); }
    pv = *(const u32x4*)vrow;
    __syncthreads();
    for (int i = tid; i < (RS_END - RS_RS) / 16; i += 512) *(LAS u32x4*)(lds + RS_RS + i * 16) = (u32x4){0u, 0u, 0u, 0u};
    f32x4 Racc[2][4];
#pragma unroll
    for (int x = 0; x < 2; ++x)
#pragma unroll
        for (int y = 0; y < 4; ++y) Racc[x][y] = (f32x4){0.f, 0.f, 0.f, 0.f};
    const int jt = w & 3, it0 = 2 * (w >> 2);
    const int it = w & 3, et0 = 2 * (w >> 2);
    float xi[4];
#pragma unroll
    for (int r = 0; r < 4; ++r) xi[r] = expf(lgam * (float)(16 * it + 4 * fq + r + 1));
    const unsigned ldsb = (unsigned)(size_t)lds;
    for (int n = 0; n < NCHUNK; ++n) {
        __syncthreads();
#pragma unroll
        for (int cc = 0; cc < 4; ++cc) { *(LAS u32x4*)(lds + RS_QS + lrow * QK_STR + (lch + 8 * cc) * 16) = pq[cc]; *(LAS u32x4*)(lds + RS_KS + lrow * QK_STR + (lch + 8 * cc) * 16) = pk[cc]; }
        *(LAS u32x4*)(lds + RS_VS + lrow * V_STR + lch * 16) = pv;
        { u32x4 z; z.x = pk2(bflo(pv.x) * zeta, bfhi(pv.x) * zeta); z.y = pk2(bflo(pv.y) * zeta, bfhi(pv.y) * zeta); z.z = pk2(bflo(pv.z) * zeta, bfhi(pv.z) * zeta); z.w = pk2(bflo(pv.w) * zeta, bfhi(pv.w) * zeta);
          *(LAS u32x4*)(lds + RS_VZ + lrow * V_STR + lch * 16) = z; }
        __syncthreads();
        if (n + 1 < NCHUNK) {
            const size_t adv = (size_t)(n + 1) * CHUNK;
#pragma unroll
            for (int cc = 0; cc < 4; ++cc) { pq[cc] = *(const u32x4*)(qrow + adv * RQKW + cc * 64); pk[cc] = *(const u32x4*)(krow + adv * RQKW + cc * 64); }
            pv = *(const u32x4*)(vrow + adv * RVW);
        }
        {
            f32x4 s0 = (f32x4){0.f, 0.f, 0.f, 0.f}, s1 = s0;
#pragma unroll
            for (int ks = 0; ks < 8; ++ks) {
                const bf16x8 a = lds128(lds + RS_KS + (16 * jt + fr) * QK_STR + (4 * ks + fq) * 16);
                const bf16x8 b0 = lds128(lds + RS_QS + (16 * it0 + fr) * QK_STR + (4 * ks + fq) * 16);
                const bf16x8 b1 = lds128(lds + RS_QS + (16 * (it0 + 1) + fr) * QK_STR + (4 * ks + fq) * 16);
                s0 = MFMA16(a, b0, s0); s1 = MFMA16(a, b1, s1);
            }
#pragma unroll
            for (int x = 0; x < 2; ++x) { const f32x4 s = x ? s1 : s0; const int i = 16 * (it0 + x) + fr; float pr[4];
#pragma unroll
                for (int r = 0; r < 4; ++r) { const int j = 16 * jt + 4 * fq + r; pr[r] = (i >= j) ? s[r] * expf(lgam * (float)(i - j)) : 0.f; }
                u32x2 pw; pw.x = pk2(pr[0], pr[1]); pw.y = pk2(pr[2], pr[3]);
                *(LAS u32x2*)(lds + RS_PS + i * V_STR + (16 * jt + 4 * fq) * 2) = pw; }
        }
        f32x4 o0 = (f32x4){0.f, 0.f, 0.f, 0.f}, o1 = o0;
#pragma unroll
        for (int ks = 0; ks < 8; ++ks) {
            const bf16x8 a = lds128(lds + RS_QS + (16 * it + fr) * QK_STR + (4 * ks + fq) * 16);
            const bf16x8 b0 = lds128(lds + RS_RS + (16 * et0 + fr) * QK_STR + (4 * ks + fq) * 16);
            const bf16x8 b1 = lds128(lds + RS_RS + (16 * (et0 + 1) + fr) * QK_STR + (4 * ks + fq) * 16);
            o0 = MFMA16(a, b0, o0); o1 = MFMA16(a, b1, o1);
        }
#pragma unroll
        for (int r = 0; r < 4; ++r) { o0[r] *= xi[r]; o1[r] *= xi[r]; }
        __syncthreads();
#pragma unroll
        for (int ks = 0; ks < 2; ++ks) {
            const bf16x8 a = lds128(lds + RS_PS + (16 * it + fr) * V_STR + (4 * ks + fq) * 16);
            const unsigned va = ldsb + RS_VS + (32 * ks + 8 * fq + tq) * V_STR + 8 * tp;
            const bf16x8 b0 = tr_frag(va + 32 * et0, va + 4 * V_STR + 32 * et0);
            const bf16x8 b1 = tr_frag(va + 32 * (et0 + 1), va + 4 * V_STR + 32 * (et0 + 1));
            __builtin_amdgcn_sched_barrier(0);
            o0 = MFMA16(a, b0, o0); o1 = MFMA16(a, b1, o1);
        }
        {
            bf16* op = Og + (tok0 + (size_t)n * CHUNK + 16 * it + 4 * fq) * RVW + h * RV + es * 64 + 16 * et0 + fr;
#pragma unroll
            for (int r = 0; r < 4; ++r) { op[(size_t)r * RVW] = (bf16)f2bf(o0[r]); op[(size_t)r * RVW + 16] = (bf16)f2bf(o1[r]); }
        }
#pragma unroll
        for (int x = 0; x < 2; ++x)
#pragma unroll
            for (int y = 0; y < 4; ++y) Racc[x][y] *= cdec;
#pragma unroll
        for (int ks = 0; ks < 2; ++ks) {
            const unsigned ka = ldsb + RS_KS + (32 * ks + 8 * fq + tq) * QK_STR + 8 * tp;
            const unsigned za = ldsb + RS_VZ + (32 * ks + 8 * fq + tq) * V_STR + 8 * tp;
            bf16x8 ak[2], bz[4];
#pragma unroll
            for (int x = 0; x < 2; ++x) ak[x] = tr_frag(ka + 32 * (2 * w + x), ka + 4 * QK_STR + 32 * (2 * w + x));
#pragma unroll
            for (int y = 0; y < 4; ++y) bz[y] = tr_frag(za + 32 * y, za + 4 * V_STR + 32 * y);
            __builtin_amdgcn_sched_barrier(0);
#pragma unroll
            for (int x = 0; x < 2; ++x)
#pragma unroll
                for (int y = 0; y < 4; ++y) Racc[x][y] = MFMA16(ak[x], bz[y], Racc[x][y]);
        }
#pragma unroll
        for (int x = 0; x < 2; ++x)
#pragma unroll
            for (int y = 0; y < 4; ++y) { u32x2 rw; rw.x = pk2(Racc[x][y][0], Racc[x][y][1]); rw.y = pk2(Racc[x][y][2], Racc[x][y][3]);
                *(LAS u32x2*)(lds + RS_RS + (16 * y + fr) * QK_STR + (16 * (2 * w + x) + 4 * fq) * 2) = rw; }
    }
}

__device__ __forceinline__ void ret_gate_phase(const Ctx& c, const bf16* Og, bf16* Gg, const float* gn) {
    for (int m = c.gw; m < NTOK; m += c.ngw) {
        const u32x4* orow = (const u32x4*)(Og + (size_t)m * RVW) + c.lane; u32x4* grow = (u32x4*)(Gg + (size_t)m * RVW) + c.lane;
#pragma unroll 2
        for (int hh = 0; hh < RH; ++hh) {
            const u32x4 ov = orow[hh * 64], gv = grow[hh * 64];
            float o[8] = {bflo(ov.x), bfhi(ov.x), bflo(ov.y), bfhi(ov.y), bflo(ov.z), bfhi(ov.z), bflo(ov.w), bfhi(ov.w)};
            float g[8] = {bflo(gv.x), bfhi(gv.x), bflo(gv.y), bfhi(gv.y), bflo(gv.z), bfhi(gv.z), bflo(gv.w), bfhi(gv.w)};
            float s = 0.f;
#pragma unroll
            for (int k = 0; k < 8; ++k) s += o[k];
            const float mu = wave_sum(s) * (1.0f / RV);
            float s2 = 0.f;
#pragma unroll
            for (int k = 0; k < 8; ++k) { o[k] -= mu; s2 += o[k] * o[k]; }
            const float rstd = 1.0f / sqrtf(wave_sum(s2) * (1.0f / RV) + EPS);
            const f32x4 g0 = *((const f32x4*)(gn + hh * RV) + 2 * c.lane), g1 = *((const f32x4*)(gn + hh * RV) + 2 * c.lane + 1);
            const float gg[8] = {g0[0], g0[1], g0[2], g0[3], g1[0], g1[1], g1[2], g1[3]};
            float z[8];
#pragma unroll
            for (int k = 0; k < 8; ++k) { const float y = o[k] * rstd * gg[k]; z[k] = (g[k] / (1.0f + expf(-g[k]))) * y; }
            u32x4 zw; zw.x = pk2(z[0], z[1]); zw.y = pk2(z[2], z[3]); zw.z = pk2(z[4], z[5]); zw.w = pk2(z[6], z[7]);
            grow[hh * 64] = zw;
        }
    }
}

__device__ __forceinline__ void rms_phase(const Ctx& c, const float* X, const float* g, bf16* H) {
    for (int m = c.gw; m < NTOK; m += c.ngw) { f32x4 v[8]; load_row(X + (size_t)m * DM, c.lane, v); store_norm_bf16(v, row_rstd(v), g, H + (size_t)m * DM, c.lane); }
}

__device__ __forceinline__ int fkey(float f) { const int i = __builtin_bit_cast(int, f); return i ^ ((i >> 31) & 0x7fffffff); }
__device__ __forceinline__ float kval(int k) { return __builtin_bit_cast(float, k ^ ((k >> 31) & 0x7fffffff)); }
#define INS16(L, key) do { int _k = (key); _Pragma("unroll") for (int _q = 0; _q < 16; ++_q) { const int _hi = max(L[_q], _k); _k = min(L[_q], _k); L[_q] = _hi; } } while (0)
constexpr int TK_LIST = 528, TK_KEYS = 256 * TK_LIST;
__device__ __forceinline__ void peer_topk_phase(const Ctx& c, const float* SC, int* IDX, float* WGT) {
    LAS unsigned char* lds = c.lds;
    for (int tile = c.bx; tile < NTOK / 16; tile += c.G) {
        __syncthreads();
        const u32x4* src = (const u32x4*)(SC + (size_t)tile * 16 * DM);
#pragma unroll 4
        for (int i = 0; i < 16; ++i) { const int g = c.tid + 512 * i; *(LAS u32x4*)(lds + (g >> 5) * TK_LIST + (g & 31) * 16) = src[g]; }
        __syncthreads();
        if (c.tid < 256) {
            int L[16];
#pragma unroll
            for (int q = 0; q < 16; ++q) L[q] = (int)0x80000000;
            LAS const unsigned char* lp = lds + c.tid * TK_LIST;
#pragma unroll 2
            for (int g = 0; g < 32; ++g) { const f32x4 v = *(LAS const f32x4*)(lp + g * 16);
#pragma unroll
                for (int e = 0; e < 4; ++e) INS16(L, (fkey(v[e]) & ~127) | (g * 4 + e)); }
            LAS int* kp = (LAS int*)(lds + TK_KEYS) + c.tid * 16;
#pragma unroll
            for (int q = 0; q < 16; ++q) kp[q] = L[q];
        }
        __syncthreads();
        if (c.tid < 128) {
            LAS const int* k1 = (LAS const int*)(lds + TK_KEYS) + (c.tid * 2) * 16; LAS const int* k2 = k1 + 16;
            float v1[16], v2[16];
#pragma unroll
            for (int q = 0; q < 16; ++q) { v1[q] = kval(k1[q] & ~127); v2[q] = kval(k2[q] & ~127); }
            int L[16];
#pragma unroll
            for (int q = 0; q < 16; ++q) L[q] = (int)0x80000000;
#pragma unroll
            for (int i = 0; i < 16; ++i)
#pragma unroll
                for (int j = 0; j < 16; ++j) if ((i + 1) * (j + 1) <= 16) INS16(L, (fkey(v1[i] + v2[j]) & ~255) | (i * 16 + j));
            const int tt = c.tid >> 3, hh = c.tid & 7; const size_t ob = ((size_t)tile * 16 + tt) * 128 + hh * 16;
            const float m0 = kval(L[0] & ~255); float ex[16], se = 0.f;
#pragma unroll
            for (int q = 0; q < 16; ++q) { ex[q] = expf(kval(L[q] & ~255) - m0); se += ex[q]; }
            const float inv = 1.0f / se;
#pragma unroll
            for (int q = 0; q < 16; ++q) { const int cid = L[q] & 255; IDX[ob + q] = (k1[cid >> 4] & 127) * PNK + (k2[cid & 15] & 127); WGT[ob + q] = ex[q] * inv; }
        }
    }
}

template <int NSTAGE> __device__ __forceinline__ void xreduce_stage(float (&p)[64], int lane) {
    constexpr int S = NSTAGE;
#pragma unroll
    for (int k = 0; k < S; ++k) { const bool up = (lane & S) != 0; const float keep = up ? p[k + S] : p[k], send = up ? p[k] : p[k + S]; p[k] = keep + __shfl_xor(send, S); }
}
__device__ __forceinline__ float gelu_erf(float v) { return 0.5f * v * (1.0f + erff(v * 0.70710678118654752f)); }
__device__ __forceinline__ float peer_dots64(const bf16* U, int idxv, const u32x4 (&hv)[4], int lane) {
    float p[64];
#pragma unroll
    for (int e = 0; e < 64; ++e) {
        const int row = __builtin_amdgcn_readlane(idxv, e);
        const u32x4* up = (const u32x4*)(U + (size_t)row * DM) + lane;
        float a0 = 0.f, a1 = 0.f;
#pragma unroll
        for (int cc = 0; cc < 4; ++cc) { const u32x4 u = up[64 * cc]; a0 = dot2bf(hv[cc].x, u.x, a0); a1 = dot2bf(hv[cc].y, u.y, a1); a0 = dot2bf(hv[cc].z, u.z, a0); a1 = dot2bf(hv[cc].w, u.w, a1); }
        p[e] = a0 + a1;
    }
    xreduce_stage<32>(p, lane); xreduce_stage<16>(p, lane); xreduce_stage<8>(p, lane); xreduce_stage<4>(p, lane); xreduce_stage<2>(p, lane); xreduce_stage<1>(p, lane);
    return p[0];
}
__device__ __forceinline__ void peer_accum64(const bf16* Vt, int idxv, float av, float (&acc)[32], int lane) {
#pragma unroll 8
    for (int e = 0; e < 64; ++e) {
        const int row = __builtin_amdgcn_readlane(idxv, e); const float a = __builtin_bit_cast(float, __builtin_amdgcn_readlane(__builtin_bit_cast(int, av), e));
        const u32x4* vp = (const u32x4*)(Vt + (size_t)row * DM) + lane;
#pragma unroll
        for (int cc = 0; cc < 4; ++cc) { const u32x4 v = vp[64 * cc];
            acc[8 * cc + 0] += a * bflo(v.x); acc[8 * cc + 1] += a * bfhi(v.x); acc[8 * cc + 2] += a * bflo(v.y); acc[8 * cc + 3] += a * bfhi(v.y);
            acc[8 * cc + 4] += a * bflo(v.z); acc[8 * cc + 5] += a * bfhi(v.z); acc[8 * cc + 6] += a * bflo(v.w); acc[8 * cc + 7] += a * bfhi(v.w); }
    }
}
__device__ __forceinline__ void peer_gather_phase(const Ctx& c, const bf16* Hn, const bf16* U, const bf16* Vt, const int* IDX, const float* WGT, float* X, int mode, const float* g1, const float* g2, bf16* Hout, bf16* HKVout) {
    for (int m = c.gw; m < NTOK; m += c.ngw) {
        const int i0 = IDX[(size_t)m * 128 + c.lane], i1 = IDX[(size_t)m * 128 + 64 + c.lane];
        const float w0 = WGT[(size_t)m * 128 + c.lane], w1 = WGT[(size_t)m * 128 + 64 + c.lane];
        u32x4 hv[4];
#pragma unroll
        for (int cc = 0; cc < 4; ++cc) hv[cc] = *((const u32x4*)(Hn + (size_t)m * DM) + c.lane + 64 * cc);
        const float a0 = gelu_erf(peer_dots64(U, i0, hv, c.lane)) * w0;
        const float a1 = gelu_erf(peer_dots64(U, i1, hv, c.lane)) * w1;
        float acc[32];
#pragma unroll
        for (int k = 0; k < 32; ++k) acc[k] = 0.f;
        peer_accum64(Vt, i0, a0, acc, c.lane); peer_accum64(Vt, i1, a1, acc, c.lane);
        float* xr = X + (size_t)m * DM; float ss = 0.f;
#pragma unroll
        for (int cc = 0; cc < 4; ++cc) {
            f32x4* xp = (f32x4*)(xr + 512 * cc + 8 * c.lane); f32x4 xa = xp[0], xb = xp[1];
#pragma unroll
            for (int k = 0; k < 4; ++k) { xa[k] += acc[8 * cc + k]; xb[k] += acc[8 * cc + 4 + k]; acc[8 * cc + k] = xa[k]; acc[8 * cc + 4 + k] = xb[k]; ss += xa[k] * xa[k] + xb[k] * xb[k]; }
            if (mode != 2) { xp[0] = xa; xp[1] = xb; }
        }
        const float rstd = 1.0f / sqrtf(wave_sum(ss) * (1.0f / DM) + EPS);
#pragma unroll
        for (int cc = 0; cc < 4; ++cc) {
            const f32x4 ga = *(const f32x4*)(g1 + 512 * cc + 8 * c.lane), gb = *(const f32x4*)(g1 + 512 * cc + 8 * c.lane + 4);
            if (mode == 2) {
                f32x4 ya, yb;
#pragma unroll
                for (int k = 0; k < 4; ++k) { ya[k] = acc[8 * cc + k] * rstd * ga[k]; yb[k] = acc[8 * cc + 4 + k] * rstd * gb[k];
#ifdef SCRUB
                    if (!(fabsf(ya[k]) < 1e30f)) ya[k] = 0.f; if (!(fabsf(yb[k]) < 1e30f)) yb[k] = 0.f;
#endif
                }
                f32x4* xp = (f32x4*)(xr + 512 * cc + 8 * c.lane); xp[0] = ya; xp[1] = yb;
            } else {
                u32x4 hw; hw.x = pk2(acc[8 * cc + 0] * rstd * ga[0], acc[8 * cc + 1] * rstd * ga[1]); hw.y = pk2(acc[8 * cc + 2] * rstd * ga[2], acc[8 * cc + 3] * rstd * ga[3]);
                hw.z = pk2(acc[8 * cc + 4] * rstd * gb[0], acc[8 * cc + 5] * rstd * gb[1]); hw.w = pk2(acc[8 * cc + 6] * rstd * gb[2], acc[8 * cc + 7] * rstd * gb[3]);
                *((u32x4*)(Hout + (size_t)m * DM) + c.lane + 64 * cc) = hw;
                if (mode == 1) {
                    const f32x4 ka = *(const f32x4*)(g2 + 512 * cc + 8 * c.lane), kb = *(const f32x4*)(g2 + 512 * cc + 8 * c.lane + 4);
                    u32x4 kw; kw.x = pk2(acc[8 * cc + 0] * rstd * ka[0], acc[8 * cc + 1] * rstd * ka[1]); kw.y = pk2(acc[8 * cc + 2] * rstd * ka[2], acc[8 * cc + 3] * rstd * ka[3]);
                    kw.z = pk2(acc[8 * cc + 4] * rstd * kb[0], acc[8 * cc + 5] * rstd * kb[1]); kw.w = pk2(acc[8 * cc + 6] * rstd * kb[2], acc[8 * cc + 7] * rstd * kb[3]);
                    *((u32x4*)(HKVout + (size_t)m * DM) + c.lane + 64 * cc) = kw;
                }
            }
        }
    }
}

__device__ __forceinline__ void rms_final_phase(const Ctx& c, float* X, const float* g) {
    for (int m = c.gw; m < NTOK; m += c.ngw) { f32x4 v[8]; load_row(X + (size_t)m * DM, c.lane, v); const float rstd = row_rstd(v);
        const f32x4* gr = (const f32x4*)g + c.lane; f32x4* xo = (f32x4*)(X + (size_t)m * DM) + c.lane;
#pragma unroll
        for (int j = 0; j < 8; ++j) { const f32x4 gv = gr[64 * j]; f32x4 y; for (int k = 0; k < 4; ++k) { y[k] = v[j][k] * rstd * gv[k]; if (!(fabsf(y[k]) < 1e30f)) y[k] = 0.f; } xo[64 * j] = y; } }
}

#ifdef DIAGBUF
__device__ __forceinline__ void diag_copy_phase(const Ctx& c, float* X, const unsigned char* ws) {
    const bf16* src = (const bf16*)(ws + (size_t)DIAGBUF);
    for (size_t i = (size_t)c.bx * 512 + c.tid; i < (size_t)NTOK * DM; i += (size_t)c.G * 512) { const size_t t = i / DM, col = i % DM; float v = bflo((unsigned)src[t * DIAGLD + col]); if (!(fabsf(v) < 1e30f)) v = 0.f; X[i] = v; }
}
#endif

__device__ __forceinline__ unsigned off_b(unsigned row, unsigned ch) { return 256u * row + 16u * (ch ^ (((row & 3u) << 2) | ((row >> 2) & 3u))); }
constexpr int AT_K = 0, AT_V = 32768, AT_BIAS = 65536, AT_HEADB = 16384;
__device__ __forceinline__ void attn_phase(const Ctx& c, const bf16* Qg, const bf16* KVg, bf16* AOg, const float* relb) {
    LAS unsigned char* lds = c.lds; const unsigned ldsb = (unsigned)(size_t)lds;
    const int tid = c.tid, lane = c.lane, w = c.wave, hg = w >> 2, wq = w & 3, fr = lane & 15, fq = lane >> 4, tq = (lane & 15) >> 2, tp = lane & 3;
    const int tl = tid & 255, lrow = tl >> 2, lc = tl & 3;
    for (int u = c.bx; u < NBATCH * NCHUNK * (AH / 2); u += c.G) {
        const int hp = u & 7, ch = (u >> 3) & 63, b = u >> 9, h = 2 * hp + hg;
        const size_t tq0 = (size_t)b * SEQ + (size_t)ch * CHUNK;
        __syncthreads();
        for (int i = tid; i < 2 * 272; i += 512) { const int hh = i / 272, k = i % 272; ((LAS float*)(lds + AT_BIAS))[i] = (k < NREL) ? relb[(size_t)(2 * hp + hh) * NREL + k] : 0.f; }
        bf16x8 qf[4];
        { const bf16* qp = Qg + (tq0 + 16 * wq + fr) * DM + h * AHD + 8 * fq;
#pragma unroll
          for (int s = 0; s < 4; ++s) qf[s] = *(const bf16x8*)(qp + 32 * s); }
        f32x4 O[8];
#pragma unroll
        for (int d = 0; d < 8; ++d) O[d] = (f32x4){0.f, 0.f, 0.f, 0.f};
        float mrun = -1e30f, lrun = 0.f;
        const int t0 = ch >= LEFT ? 0 : LEFT - ch;
        u32x4 pk[4], pv[4];
        { const bf16* kp = KVg + ((size_t)b * SEQ + (size_t)(ch - LEFT + t0) * CHUNK + lrow) * (2 * DM) + h * AHD;
#pragma unroll
          for (int cc = 0; cc < 4; ++cc) { pk[cc] = *(const u32x4*)(kp + (lc + 4 * cc) * 8); pv[cc] = *(const u32x4*)(kp + DM + (lc + 4 * cc) * 8); } }
        const LAS float* bias = (const LAS float*)(lds + AT_BIAS) + hg * 272;
        for (int t = t0; t <= LEFT; ++t) {
            __syncthreads();
#pragma unroll
            for (int cc = 0; cc < 4; ++cc) { *(LAS u32x4*)(lds + AT_K + hg * AT_HEADB + off_b(lrow, lc + 4 * cc)) = pk[cc]; *(LAS u32x4*)(lds + AT_V + hg * AT_HEADB + off_b(lrow, lc + 4 * cc)) = pv[cc]; }
            __syncthreads();
            if (t < LEFT) { const bf16* kp = KVg + ((size_t)b * SEQ + (size_t)(ch - LEFT + t + 1) * CHUNK + lrow) * (2 * DM) + h * AHD;
#pragma unroll
                for (int cc = 0; cc < 4; ++cc) { pk[cc] = *(const u32x4*)(kp + (lc + 4 * cc) * 8); pv[cc] = *(const u32x4*)(kp + DM + (lc + 4 * cc) * 8); } }
            f32x4 sT[4];
#pragma unroll
            for (int kt = 0; kt < 4; ++kt) { sT[kt] = (f32x4){0.f, 0.f, 0.f, 0.f};
#pragma unroll
                for (int s = 0; s < 4; ++s) { const bf16x8 a = lds128(lds + AT_K + hg * AT_HEADB + off_b(16 * kt + fr, 4 * s + fq)); sT[kt] = MFMA16(a, qf[s], sT[kt]); } }
            const int dbase = (LEFT - t) * CHUNK + (16 * wq + fr);
            float mx = -1e30f;
#pragma unroll
            for (int kt = 0; kt < 4; ++kt)
#pragma unroll
                for (int r = 0; r < 4; ++r) { const int dist = dbase - (16 * kt + 4 * fq + r); sT[kt][r] += bias[min(dist, 128) + 128]; mx = fmaxf(mx, sT[kt][r]); }
            mx = fmaxf(mx, __shfl_xor(mx, 16)); mx = fmaxf(mx, __shfl_xor(mx, 32));
            const float mnew = fmaxf(mrun, mx), alpha = expf(mrun - mnew); mrun = mnew;
            float ps = 0.f;
#pragma unroll
            for (int kt = 0; kt < 4; ++kt)
#pragma unroll
                for (int r = 0; r < 4; ++r) { sT[kt][r] = expf(sT[kt][r] - mnew); ps += sT[kt][r]; }
            lrun = lrun * alpha + ps;
#pragma unroll
            for (int d = 0; d < 8; ++d) O[d] *= alpha;
#pragma unroll
            for (int ks = 0; ks < 2; ++ks) {
                bf16x8 pb; { const unsigned p0 = pk2(sT[2 * ks][0], sT[2 * ks][1]), p1 = pk2(sT[2 * ks][2], sT[2 * ks][3]), p2 = pk2(sT[2 * ks + 1][0], sT[2 * ks + 1][1]), p3 = pk2(sT[2 * ks + 1][2], sT[2 * ks + 1][3]);
                    const u32x4 pw = (u32x4){p0, p1, p2, p3}; pb = __builtin_bit_cast(bf16x8, pw); }
#pragma unroll
                for (int d = 0; d < 8; ++d) {
                    const unsigned a0 = ldsb + AT_V + hg * AT_HEADB + off_b(32 * ks + 4 * fq + tq, 2 * d + (tp >> 1)) + 8 * (tp & 1);
                    const unsigned a1 = ldsb + AT_V + hg * AT_HEADB + off_b(32 * ks + 16 + 4 * fq + tq, 2 * d + (tp >> 1)) + 8 * (tp & 1);
                    const bf16x8 va = tr_frag(a0, a1);
                    __builtin_amdgcn_sched_barrier(0);
                    O[d] = MFMA16(va, pb, O[d]);
                }
            }
        }
        float lt = lrun; lt += __shfl_xor(lt, 16); lt += __shfl_xor(lt, 32);
        const float inv = 1.0f / lt;
        bf16* op = AOg + (tq0 + 16 * wq + fr) * DM + h * AHD + 4 * fq;
#pragma unroll
        for (int d = 0; d < 8; ++d) { u32x2 ow; ow.x = pk2(O[d][0] * inv, O[d][1] * inv); ow.y = pk2(O[d][2] * inv, O[d][3] * inv); *(u32x2*)(op + 16 * d) = ow; }
    }
}

constexpr int NSTEPS = 1 + 2 * 8 + 2 * 7;
template <int MASK> __global__ void __launch_bounds__(512, 2) yoco_fwd(Params p) {
    extern __shared__ __attribute__((aligned(16))) unsigned char lds_raw[];
    Ctx c; c.lds = (LAS unsigned char*)lds_raw; c.tid = threadIdx.x; c.lane = c.tid & 63; c.wave = __builtin_amdgcn_readfirstlane(c.tid >> 6);
    c.bx = blockIdx.x; c.G = gridDim.x; c.gw = c.bx * 8 + c.wave; c.ngw = c.G * 8;
    volatile LAS unsigned* MISC = (volatile LAS unsigned*)(c.lds + LDS_MISC);
    if (c.tid < 4) MISC[c.tid] = 0u;
    __syncthreads();
    XcdBarrier bar; bar.bar = (unsigned*)(p.ws + WS_CTL); bar.x = 0; bar.st = MISC;
    if (p.hi - p.lo > 1) bar = xcd_barrier_post((unsigned*)(p.ws + WS_CTL), MISC);
    unsigned char* ws = p.ws;
    bf16* const H = (bf16*)(ws + WS_H); bf16* const HKV = (bf16*)(ws + WS_HKV);
    float* const X = p.out;
    int s = 0;
#define BEGIN_STEP(k) if (((MASK >> (k)) & 1) && s >= p.lo && s < p.hi) {
#define END_STEP   if (s + 1 < p.hi) xcd_barrier(bar); } ++s;

    BEGIN_STEP(0) p0_prologue(p, c); END_STEP

    for (int l = 0; l < DEPTH; ++l) {
        if (l < 2) {
            BEGIN_STEP(1)
                pg8::Gemm g{H, (const bf16*)(ws + WS_WIN) + (size_t)l * RIN * DM, NTOK, RIN, DM}; pg8::StaticOrder S; S.init(NTOK, RIN, c.G, c.bx);
                pg8::EpiProj E{(bf16*)(ws + WS_Q), (bf16*)(ws + WS_K), (bf16*)(ws + WS_V), (bf16*)(ws + WS_G), (const float*)(ws + WS_ROT)};
                pg8::gemm_phase<pg8::EpiProj, pg8::StaticOrder>(c.lds, g, S, E, nullptr);
            END_STEP
            BEGIN_STEP(2)
                for (int u = c.bx; u < 256; u += c.G) ret_scan_unit(c, (const bf16*)(ws + WS_Q), (const bf16*)(ws + WS_K), (const bf16*)(ws + WS_V), (bf16*)(ws + WS_O), u);
            END_STEP
            BEGIN_STEP(3)
                ret_gate_phase(c, (const bf16*)(ws + WS_O), (bf16*)(ws + WS_G), p.ret_gn + (size_t)l * RVW);
            END_STEP
        } else {
            BEGIN_STEP(4)
                for (int pass = (l == 2 ? 0 : 1); pass < 2; ++pass) {
                    const int N = pass ? DM : 2 * DM;
                    pg8::Gemm g{pass ? H : HKV, pass ? (const bf16*)(ws + WS_WQ) + (size_t)(l - 2) * DM * DM : (const bf16*)(ws + WS_WKV), NTOK, N, DM}; pg8::StaticOrder S; S.init(NTOK, N, c.G, c.bx);
                    pg8::EpiBf16S E{pass ? (bf16*)(ws + WS_Q) : (bf16*)(ws + WS_KV), N, pass ? 0.08838834764831845f : 1.0f};
                    pg8::gemm_phase<pg8::EpiBf16S, pg8::StaticOrder>(c.lds, g, S, E, nullptr);
                }
            END_STEP
            BEGIN_STEP(5)
                attn_phase(c, (const bf16*)(ws + WS_Q), (const bf16*)(ws + WS_KV), (bf16*)(ws + WS_AO), p.att_rel_bias + (size_t)(l - 2) * AH * NREL);
            END_STEP
        }
        BEGIN_STEP(6)
            const int K = l < 2 ? RVW : DM;
            pg8::Gemm g{l < 2 ? (const bf16*)(ws + WS_G) : (const bf16*)(ws + WS_AO), l < 2 ? (const bf16*)(ws + WS_WOUT) + (size_t)l * DM * RVW : (const bf16*)(ws + WS_WO) + (size_t)(l - 2) * DM * DM, NTOK, DM, K};
            pg8::StaticOrder S; S.init(NTOK, DM, c.G, c.bx);
            pg8::EpiRes E{X, DM};
            pg8::gemm_phase<pg8::EpiRes, pg8::StaticOrder>(c.lds, g, S, E, nullptr);
        END_STEP
        BEGIN_STEP(7)
            rms_phase(c, X, p.ln_ffn + (size_t)l * DM, H);
        END_STEP
        BEGIN_STEP(8)
            pg8::Gemm g{H, (const bf16*)(ws + WS_WC) + (size_t)l * DM * DM, NTOK, DM, DM}; pg8::StaticOrder S; S.init(NTOK, DM, c.G, c.bx);
            pg8::EpiF32 E{(float*)(ws + WS_SC), DM};
            pg8::gemm_phase<pg8::EpiF32, pg8::StaticOrder>(c.lds, g, S, E, nullptr);
        END_STEP
        BEGIN_STEP(9)
            peer_topk_phase(c, (const float*)(ws + WS_SC), (int*)(ws + WS_IDX), (float*)(ws + WS_WGT));
        END_STEP
        BEGIN_STEP(10)
            const int mode = (l == DEPTH - 1) ? 2 : (l == 1 ? 1 : 0);
            peer_gather_phase(c, H, (const bf16*)(ws + WS_PU) + (size_t)l * PE * DM, (const bf16*)(ws + WS_PV) + (size_t)l * PE * DM, (const int*)(ws + WS_IDX), (const float*)(ws + WS_WGT), X, mode,
                              mode == 2 ? p.ln_final : p.ln_mix + (size_t)(l + 1) * DM, p.kv_norm, H, HKV);
        END_STEP
    }
#ifdef DIAGBUF
    if ((MASK >> 11) & 1) diag_copy_phase(c, X, ws);
#else
    if ((MASK >> 11) & 1) rms_final_phase(c, X, p.ln_final);
#endif
#undef BEGIN_STEP
#undef END_STEP
}

#ifndef N_LAUNCH_CUT
#define N_LAUNCH_CUT 0
#endif
typedef void (*kern_t)(Params);
template <int SITE> static void launch_site(const Params& p, hipStream_t stream) {
    static bool attr = false;
    if (!attr) { (void)hipFuncSetAttribute((const void*)yoco_fwd<(1 << SITE)>, hipFuncAttributeMaxDynamicSharedMemorySize, LDS_BYTES); attr = true; }
    hipLaunchKernelGGL((yoco_fwd<(1 << SITE)>), dim3(256), dim3(512), LDS_BYTES, stream, p);
}
static void launch_step_site(int site, const Params& p, hipStream_t stream) {
    switch (site) {
        case 0: launch_site<0>(p, stream); break; case 1: launch_site<1>(p, stream); break; case 2: launch_site<2>(p, stream); break; case 3: launch_site<3>(p, stream); break;
        case 4: launch_site<4>(p, stream); break; case 5: launch_site<5>(p, stream); break; case 6: launch_site<6>(p, stream); break; case 7: launch_site<7>(p, stream); break;
        case 8: launch_site<8>(p, stream); break; case 9: launch_site<9>(p, stream); break; case 10: launch_site<10>(p, stream); break; default: launch_site<11>(p, stream); break;
    }
}
extern "C" void kernel_launch(void* const* d_in, const int* in_sizes, int n_in, void* d_out, int out_size, void* d_ws, size_t ws_size, hipStream_t stream) {
    static int ready = 0;
    if (ready == 0) {
        if (n_in != 16 || out_size != NTOK * DM || ws_size < WS_END) { fprintf(stderr, "kernel_launch: unexpected sizes (n_in %d out %d ws %zu, need %zu)\n", n_in, out_size, ws_size, (size_t)WS_END); ready = -1; return; }
#if N_LAUNCH_CUT
        if (hipFuncSetAttribute((const void*)yoco_fwd<0x7FF>, hipFuncAttributeMaxDynamicSharedMemorySize, LDS_BYTES) != hipSuccess) { fprintf(stderr, "kernel_launch: hipFuncSetAttribute failed\n"); ready = -1; return; }
#endif
        ready = 1;
    }
    if (ready < 0) return;
    (void)hipMemsetAsync(d_ws, 0, 16384, stream);
    Params p{};
    p.x = (const float*)d_in[0]; p.ln_mix = (const float*)d_in[1]; p.ln_ffn = (const float*)d_in[2]; p.ret_w_in = (const float*)d_in[3]; p.ret_w_out = (const float*)d_in[4]; p.ret_gn = (const float*)d_in[5];
    p.kv_norm = (const float*)d_in[6]; p.w_kv = (const float*)d_in[7]; p.att_w_q = (const float*)d_in[8]; p.att_w_o = (const float*)d_in[9]; p.att_rel_bias = (const float*)d_in[10];
    p.peer_w_q = (const float*)d_in[11]; p.peer_sub_keys = (const float*)d_in[12]; p.peer_u = (const float*)d_in[13]; p.peer_v = (const float*)d_in[14]; p.ln_final = (const float*)d_in[15];
    p.out = (float*)d_out; p.ws = (unsigned char*)d_ws;
#if N_LAUNCH_CUT
    p.lo = 0; p.hi = NSTEPS;
    hipLaunchKernelGGL((yoco_fwd<0x7FF>), dim3(256), dim3(512), LDS_BYTES, stream, p);
#else
    static const int siteA[8] = {1, 2, 3, 6, 7, 8, 9, 10}, siteB[7] = {4, 5, 6, 7, 8, 9, 10};
    int s = 0;
#ifndef NSTOP
#define NSTOP 1000
#endif
    p.lo = s; p.hi = s + 1; launch_step_site(0, p, stream); ++s;
    for (int l = 0; l < DEPTH; ++l) { const int n = l < 2 ? 8 : 7; for (int k = 0; k < n; ++k) { p.lo = s; p.hi = s + 1; if (s < NSTOP) launch_step_site(l < 2 ? siteA[k] : siteB[k], p, stream); ++s; } }
    if (NSTOP < NSTEPS) { p.lo = -1; p.hi = -1; launch_step_site(11, p, stream); }
#endif
}
```

```cpp
#include <hip/hip_runtime.h>
#include <cstdio>
#include <cstdint>

#define LAS __attribute__((address_space(3)))
#define GAS __attribute__((address_space(1)))
typedef unsigned short bf16;
typedef unsigned u32x2 __attribute__((ext_vector_type(2)));
typedef float f32x2v __attribute__((ext_vector_type(2)));

constexpr int DM = 2048, NBATCH = 4, SEQ = 4096, NTOK = NBATCH * SEQ, DEPTH = 4;
constexpr int CHUNK = 64, NCHUNK = SEQ / CHUNK;
constexpr int RH = 8, RQK = 256, RV = 512, RQKW = RH * RQK, RVW = RH * RV, RIN = 2 * RQKW + 2 * RVW;
constexpr int AH = 16, AHD = 128, LEFT = 8, NREL = 257;
constexpr int PH = 8, PNK = 128, PE = PNK * PNK, PTOPK = 16;
constexpr float EPS = 1e-6f;

constexpr size_t MiB = 1ull << 20;
constexpr size_t WS_CTL = 0, CTL_BYTES = 1 * MiB;
constexpr size_t WS_ROT = 1 * MiB;
constexpr size_t WS_RS = 6 * MiB;
constexpr size_t WS_WIN = 8 * MiB;
constexpr size_t WS_WOUT = 104 * MiB;
constexpr size_t WS_WKV = 136 * MiB;
constexpr size_t WS_WQ = 152 * MiB;
constexpr size_t WS_WO = 168 * MiB;
constexpr size_t WS_WC = 184 * MiB;
constexpr size_t WS_PU = 216 * MiB;
constexpr size_t WS_PV = 472 * MiB;
constexpr size_t WS_H = 728 * MiB;
constexpr size_t WS_HKV = 792 * MiB;
constexpr size_t WS_Q = 856 * MiB;
constexpr size_t WS_K = 920 * MiB;
constexpr size_t WS_V = 984 * MiB;
constexpr size_t WS_G = 1112 * MiB;
constexpr size_t WS_O = 1240 * MiB;
constexpr size_t WS_KV = 1368 * MiB;
constexpr size_t WS_AO = 1496 * MiB;
constexpr size_t WS_SC = 1560 * MiB;
constexpr size_t WS_IDX = 1688 * MiB;
constexpr size_t WS_WGT = 1696 * MiB;
constexpr size_t WS_SQP = 1704 * MiB;
constexpr size_t WS_RSTD = 1706 * MiB;
constexpr size_t WS_END = 1708 * MiB;

constexpr int LDS_BYTES = 160 * 1024;
constexpr int LDS_MISC = LDS_BYTES - 256;

__device__ __forceinline__ unsigned f2bf(float f) { unsigned u = __builtin_bit_cast(unsigned, f); return (u + 0x7fffu + ((u >> 16) & 1u)) >> 16; }
typedef __bf16 bfx2_t __attribute__((ext_vector_type(2)));
__device__ __forceinline__ unsigned pk2(float lo, float hi) { const f32x2v v = {lo, hi}; return __builtin_bit_cast(unsigned, __builtin_convertvector(v, bfx2_t)); }
__device__ __forceinline__ float bflo(unsigned u) { return __builtin_bit_cast(float, u << 16); }
__device__ __forceinline__ float bfhi(unsigned u) { return __builtin_bit_cast(float, u & 0xffff0000u); }
__device__ __forceinline__ float wave_sum(float v) {
#pragma unroll
    for (int o = 1; o < 64; o <<= 1) v += __shfl_xor(v, o);
    return v;
}
#define VM_WAIT() asm volatile("s_waitcnt vmcnt(0)" ::: "memory")
#define LDS_WAIT() asm volatile("s_waitcnt lgkmcnt(0)" ::: "memory")

#define XB_TMO      128
#define XB_XCNT(j)  (256  + 64 * (j))
#define XB_XSUB(j)  (1280 + 64 * (j))
#define XB_XGEN(j)  (2304 + 64 * (j))
#define XB_TOP      3328
#define XB_TOPGEN   3392
#define XCD_BAR_WORDS 3456
#define XB_SPIN_CAP (1u << 18)

__device__ __forceinline__ unsigned xb_ld(unsigned* p)              { return __hip_atomic_load(p, __ATOMIC_RELAXED, __HIP_MEMORY_SCOPE_AGENT); }
__device__ __forceinline__ unsigned xb_add(unsigned* p, unsigned v) { return __hip_atomic_fetch_add(p, v, __ATOMIC_RELAXED, __HIP_MEMORY_SCOPE_AGENT); }
__device__ __forceinline__ unsigned xb_xcc_id() { return (unsigned)__builtin_amdgcn_s_getreg((3 << 11) | 20) & 0xFu; }
#define XB_SPIN(cond, bar) do { unsigned _sp = 0; while (cond) { __builtin_amdgcn_s_sleep(1); \
    if ((++_sp & 255u) == 0u) { if (xb_ld(&(bar)[XB_TMO])) break; if (_sp > XB_SPIN_CAP) { atomicAdd(&(bar)[XB_TMO], 1u); break; } } } } while (0)

struct XcdBarrier {
    unsigned* bar; unsigned x;
    volatile LAS unsigned* st;
};

__device__ __forceinline__ XcdBarrier xcd_barrier_post(unsigned* bar, volatile LAS unsigned* st) {
    XcdBarrier b; b.bar = bar; b.x = xb_xcc_id(); b.st = st;
    if (threadIdx.x == 0) (void)xb_add(&bar[XB_XCNT(b.x)], 1u);
    return b;
}
__device__ __forceinline__ void xcd_barrier_complete(unsigned* bar, unsigned x, unsigned& nloc, unsigned& nx) {
    const unsigned G = gridDim.x * gridDim.y * gridDim.z;
    unsigned sum, cnt, mine, sp = 0u;
    for (;;) {
        sum = 0u; cnt = 0u; mine = 0u;
#pragma unroll
        for (unsigned j = 0; j < 16; ++j) { const unsigned c = xb_ld(&bar[XB_XCNT(j)]); sum += c; cnt += (c > 0u) ? 1u : 0u; mine = (j == x) ? c : mine; }
        if (sum == G) break;
        __builtin_amdgcn_s_sleep(1);
        if ((++sp & 255u) == 0u) { if (xb_ld(&bar[XB_TMO])) break; if (sp > XB_SPIN_CAP) { atomicAdd(&bar[XB_TMO], 1u); break; } }
    }
    nloc = mine > 0u ? mine : 1u; nx = cnt > 0u ? cnt : 1u;
}

__device__ __forceinline__ void xcd_barrier(const XcdBarrier& b) {
    asm volatile("s_waitcnt vmcnt(0)" ::: "memory");
    __syncthreads();
    if (threadIdx.x == 0) {
        unsigned* bar = b.bar;
        __builtin_amdgcn_s_waitcnt(0);
        unsigned nloc = b.st[0], nx = b.st[1];
        if (nloc == 0u) { xcd_barrier_complete(bar, b.x, nloc, nx); b.st[0] = nloc; b.st[1] = nx; }
        const unsigned old = xb_add(&bar[XB_XSUB(b.x)], 1u);
        const unsigned gen = old / nloc;
        if (old + 1u == (gen + 1u) * nloc) {
            __builtin_amdgcn_fence(__ATOMIC_RELEASE, "agent");
            asm volatile("s_waitcnt vmcnt(0)" ::: "memory");
            const unsigned og = xb_add(&bar[XB_TOP], 1u);
            const unsigned tg = og / nx;
            if (og + 1u == (tg + 1u) * nx) xb_add(&bar[XB_TOPGEN], 1u);
            else XB_SPIN(xb_ld(&bar[XB_TOPGEN]) == tg, bar);
            __builtin_amdgcn_fence(__ATOMIC_ACQUIRE, "agent");
            xb_add(&bar[XB_XGEN(b.x)], 1u);
            asm volatile("s_waitcnt vmcnt(0)" ::: "memory");
        } else {
            XB_SPIN(xb_ld(&bar[XB_XGEN(b.x)]) == gen, bar);
            __builtin_amdgcn_fence(__ATOMIC_ACQUIRE, "agent");
            asm volatile("s_waitcnt vmcnt(0)" ::: "memory");
        }
    }
    __syncthreads();
}

namespace pg8 {
#define PG8_LAS __attribute__((address_space(3)))
typedef unsigned short bf16_t;
typedef short bf16x8 __attribute__((ext_vector_type(8)));
typedef float f32x4 __attribute__((ext_vector_type(4)));
typedef unsigned u32x4 __attribute__((ext_vector_type(4)));
constexpr int BM = 256, BK = 64, HALF = 128, HTB = HALF * BK * 2  , STAGE_BYTES = 8 * HTB, NXCD = 8, WGM = 8;

__host__ __device__ __forceinline__ int lds_byte(int r, int c) { const int st = (r >> 4) * 2 + (c >> 5), rr = r & 15, cc = c & 31, ob = rr * 64 + cc * 2; return st * 1024 + (ob ^ (((ob >> 9) & 1) << 5)); }
__host__ __device__ __forceinline__ void stage_rc(int b, int& R, int& C) { const int st = b / 1024, sb = b % 1024, swz = sb ^ (((sb >> 9) & 1) << 5); R = (st >> 1) * 16 + swz / 64; C = (st & 1) * 32 + (swz % 64) / 2; }
__host__ __device__ __forceinline__ int perm32(int rho) { const int n = rho >> 4, i = rho & 15; return 8 * (i >> 2) + 4 * n + (i & 3); }

struct Unit { int pm, pn; };
struct Gemm { const bf16_t* A; const bf16_t* Bt; int M, N, K; };

struct StaticOrder {
    int nM, nN, nwg, G, c;
    __host__ __device__ void init(int M, int N, int G_, int c_) { nM = M / BM; nN = N / BM; nwg = nM * nN; G = G_; c = c_; }
    __host__ __device__ bool next(int i, Unit& u) const {
        const long L = (long)i * G + c; if (L >= nwg) return false;
        int wgid = (int)L; { const int q = nwg / NXCD, r = nwg % NXCD, xcd = wgid % NXCD, off = wgid / NXCD; wgid = (xcd < r ? xcd * (q + 1) : r * (q + 1) + (xcd - r) * q) + off; }
        const int nig = WGM * nN, gid = wgid / nig, fm = gid * WGM, gsz = (nM - fm) < WGM ? (nM - fm) : WGM;
        u.pm = fm + ((wgid % nig) % gsz); u.pn = (wgid % nig) / gsz; return true;
    }
    __device__ __forceinline__ void a_ready(const Unit&) const {}
    __device__ __forceinline__ void done(const Unit&) const {}
};
struct CountedOrder : StaticOrder {
    const unsigned* ready; unsigned need; unsigned* tmo;
    __device__ __forceinline__ void a_ready(const Unit& u) const {
        if (threadIdx.x < 64) {
            const unsigned long long t0 = __builtin_amdgcn_s_memrealtime(); unsigned polls = 0;
            while ((unsigned)__builtin_amdgcn_readfirstlane(__hip_atomic_load(ready + 64 * u.pm, __ATOMIC_RELAXED, __HIP_MEMORY_SCOPE_AGENT)) < need) {
                if ((++polls & 255u) == 0u && __builtin_amdgcn_readfirstlane(__hip_atomic_load(tmo, __ATOMIC_RELAXED, __HIP_MEMORY_SCOPE_AGENT)) != 0u) break;
                if (__builtin_amdgcn_s_memrealtime() - t0 > 2000000ull) {
                    if (threadIdx.x == 0) { unsigned expect = 0u; __hip_atomic_compare_exchange_strong(tmo + 1, &expect, 0x600u | (unsigned)(u.pm & 0xff), __ATOMIC_RELAXED, __ATOMIC_RELAXED, __HIP_MEMORY_SCOPE_AGENT); __hip_atomic_store(tmo, 1u, __ATOMIC_RELAXED, __HIP_MEMORY_SCOPE_AGENT); }
                    break; }
                __builtin_amdgcn_s_sleep(2); }
            __builtin_amdgcn_fence(__ATOMIC_ACQUIRE, "agent");
            asm volatile("s_waitcnt vmcnt(0)" ::: "memory");
        }
#if !defined(BROKEN_HOOK_NO_BARRIER)
        asm volatile("" ::: "memory"); __builtin_amdgcn_s_barrier(); asm volatile("" ::: "memory");
#endif
    }
};

__device__ __forceinline__ unsigned cvt_pk_bf16(float lo, float hi) { return pk2(lo, hi); }
typedef float f32x2 __attribute__((ext_vector_type(2)));
__device__ __forceinline__ f32x2 gelu_pk(f32x2 v) {
    const f32x2 av = __builtin_elementwise_abs(v), d = av * 0.2316418882f + 1.0f;
    f32x2 t; t.x = __builtin_amdgcn_rcpf(d.x); t.y = __builtin_amdgcn_rcpf(d.y);
    f32x2 q = t * 0.5307027145f + (-0.7265760135f); q = q * t + 0.7107068705f; q = q * t + (-0.142248368f); q = q * t + 0.127414796f; q = q * t;
    const f32x2 s = (v * v) * (-0.72134752044f);
    f32x2 e; e.x = __builtin_amdgcn_exp2f(s.x); e.y = __builtin_amdgcn_exp2f(s.y);
    const f32x2 m = v * (q * e), r = v - m;
    f32x2 o; o.x = v.x < 0.f ? m.x : r.x; o.y = v.y < 0.f ? m.y : r.y; return o;
}


struct EpiF32 {
    static constexpr bool PERM = false, AFTER_DRAIN = false;
    float* C; int ldc;
    __device__ __forceinline__ void operator()(const f32x4 (&acc)[2][2][4][2], const Unit& u, int wr, int wc, int fr, int fq) const {
        const int row0 = u.pm * BM + wr * 64 + fr, col0 = u.pn * BM + wc * 32 + 4 * fq;
#pragma unroll
        for (int ai = 0; ai < 2; ++ai)
#pragma unroll
            for (int m = 0; m < 4; ++m) { float* rowp = C + (size_t)(row0 + ai * HALF + m * 16) * ldc + col0;
#pragma unroll
                for (int bj = 0; bj < 2; ++bj)
#pragma unroll
                    for (int n = 0; n < 2; ++n) *(f32x4*)(rowp + bj * HALF + n * 16) = acc[ai][bj][m][n]; }
    }
};
struct EpiRes {
    static constexpr bool PERM = false, AFTER_DRAIN = false;
    float* X; int ldc; bf16_t* Hn; const float* gn; float* sqp;
    __device__ __forceinline__ void operator()(const f32x4 (&acc)[2][2][4][2], const Unit& u, int wr, int wc, int fr, int fq) const {
        const int row0 = u.pm * BM + wr * 64 + fr, col0 = u.pn * BM + wc * 32 + 4 * fq;
        f32x4 gv[2][2];
#pragma unroll
        for (int bj = 0; bj < 2; ++bj)
#pragma unroll
            for (int n = 0; n < 2; ++n) gv[bj][n] = *(const f32x4*)(gn + col0 + bj * HALF + n * 16);
#pragma unroll
        for (int ai = 0; ai < 2; ++ai) {
            f32x4 old[4][2][2];
#pragma unroll
            for (int m = 0; m < 4; ++m) { const float* rp = X + (size_t)(row0 + ai * HALF + m * 16) * ldc + col0;
#pragma unroll
                for (int bj = 0; bj < 2; ++bj)
#pragma unroll
                    for (int n = 0; n < 2; ++n) old[m][bj][n] = *(const f32x4*)(rp + bj * HALF + n * 16); }
#pragma unroll
            for (int m = 0; m < 4; ++m) { const int r = row0 + ai * HALF + m * 16; float* rowp = X + (size_t)r * ldc + col0; bf16_t* hp = Hn + (size_t)r * ldc + col0;
                float ss = 0.f;
#pragma unroll
                for (int bj = 0; bj < 2; ++bj)
#pragma unroll
                    for (int n = 0; n < 2; ++n) { const f32x4 xn = old[m][bj][n] + acc[ai][bj][m][n]; *(f32x4*)(rowp + bj * HALF + n * 16) = xn;
                        ss += (xn[0] * xn[0] + xn[1] * xn[1]) + (xn[2] * xn[2] + xn[3] * xn[3]);
                        const f32x4 hg = xn * gv[bj][n]; u32x2 hw; hw.x = pk2(hg[0], hg[1]); hw.y = pk2(hg[2], hg[3]); *(u32x2*)(hp + bj * HALF + n * 16) = hw; }
                ss += __shfl_xor(ss, 16); ss += __shfl_xor(ss, 32);
                if (fq == 0) sqp[(size_t)r * 32 + u.pn * 4 + wc] = ss; }
        }
    }
};
struct EpiBf16S {
    static constexpr bool PERM = true, AFTER_DRAIN = false;
    bf16_t* O; int ldc; float scale;
    __device__ __forceinline__ void operator()(const f32x4 (&acc)[2][2][4][2], const Unit& u, int wr, int wc, int fr, int fq) const {
        const int row0 = u.pm * BM + wr * 64 + fr, col0 = u.pn * BM + wc * 32 + 8 * fq;
#pragma unroll
        for (int ai = 0; ai < 2; ++ai)
#pragma unroll
            for (int m = 0; m < 4; ++m) { bf16_t* rowp = O + (size_t)(row0 + ai * HALF + m * 16) * ldc + col0;
#pragma unroll
                for (int bj = 0; bj < 2; ++bj) { const f32x4 v0 = acc[ai][bj][m][0] * scale, v1 = acc[ai][bj][m][1] * scale;
                    u32x4 w; w.x = cvt_pk_bf16(v0[0], v0[1]); w.y = cvt_pk_bf16(v0[2], v0[3]); w.z = cvt_pk_bf16(v1[0], v1[1]); w.w = cvt_pk_bf16(v1[2], v1[3]);
                    *(u32x4*)(rowp + bj * HALF) = w; } }
    }
};
struct EpiProj {
    static constexpr bool PERM = true, AFTER_DRAIN = false;
    bf16_t *Q, *Kp, *V, *G; const float* rot;
    __device__ __forceinline__ void operator()(const f32x4 (&acc)[2][2][4][2], const Unit& u, int wr, int wc, int fr, int fq) const {
        const int row0 = u.pm * BM + wr * 64 + fr, pn = u.pn, dd0 = wc * 32 + 8 * fq;
        if (pn < 16) {
            bf16_t* base = (pn < 8 ? Q : Kp) + (pn & 7) * 256 + dd0; const float sc = pn < 8 ? 1.0f : 0.0625f;
#pragma unroll
            for (int ai = 0; ai < 2; ++ai)
#pragma unroll
                for (int m = 0; m < 4; ++m) { const int r = row0 + ai * HALF + m * 16; const float* rt = rot + (size_t)(r & (4096 - 1)) * 256 + dd0;
                    f32x4 o1[2], o2[2];
#pragma unroll
                    for (int n = 0; n < 2; ++n) { const f32x4 cs = *(const f32x4*)(rt + 4 * n), sn = *(const f32x4*)(rt + 128 + 4 * n); const f32x4 t1 = acc[ai][0][m][n], t2 = acc[ai][1][m][n];
                        o1[n] = (t1 * cs - t2 * sn) * sc; o2[n] = (t1 * sn + t2 * cs) * sc; }
                    u32x4 w1, w2;
                    w1.x = cvt_pk_bf16(o1[0][0], o1[0][1]); w1.y = cvt_pk_bf16(o1[0][2], o1[0][3]); w1.z = cvt_pk_bf16(o1[1][0], o1[1][1]); w1.w = cvt_pk_bf16(o1[1][2], o1[1][3]);
                    w2.x = cvt_pk_bf16(o2[0][0], o2[0][1]); w2.y = cvt_pk_bf16(o2[0][2], o2[0][3]); w2.z = cvt_pk_bf16(o2[1][0], o2[1][1]); w2.w = cvt_pk_bf16(o2[1][2], o2[1][3]);
                    bf16_t* rowp = base + (size_t)r * 2048; *(u32x4*)rowp = w1; *(u32x4*)(rowp + 128) = w2; }
        } else {
            bf16_t* base = (pn < 32 ? V : G) + ((pn - 16) & 15) * 256 + dd0;
#pragma unroll
            for (int ai = 0; ai < 2; ++ai)
#pragma unroll
                for (int m = 0; m < 4; ++m) { bf16_t* rowp = base + (size_t)(row0 + ai * HALF + m * 16) * 4096;
#pragma unroll
                    for (int bj = 0; bj < 2; ++bj) { const f32x4 v0 = acc[ai][bj][m][0], v1 = acc[ai][bj][m][1];
                        u32x4 w; w.x = cvt_pk_bf16(v0[0], v0[1]); w.y = cvt_pk_bf16(v0[2], v0[3]); w.z = cvt_pk_bf16(v1[0], v1[1]); w.w = cvt_pk_bf16(v1[2], v1[3]);
                        *(u32x4*)(rowp + bj * HALF) = w; } }
        }
    }
};
template <class Epi, class Sched, bool STAMP = false>
__device__ __forceinline__ void gemm_phase(PG8_LAS unsigned char* lds, const Gemm g, const Sched& S, const Epi& E, unsigned long long* stamps) {
    int tid_ = threadIdx.x; asm volatile("" : "+v"(tid_));
    const int tid = tid_, wid = __builtin_amdgcn_readfirstlane(tid >> 6), lane = tid & 63, wr = wid >> 2, wc = wid & 3, fr = lane & 15, fq = lane >> 4;
    const int K = g.K, nt = K / BK;
    int ts_lo = 0, ts_hi = 0, nts = 0; const unsigned long long rt_entry = STAMP ? (unsigned long long)wall_clock64() : 0ull;
#define PG8_STAMP() do { if (STAMP && wid == 0 && nts < 64) { const unsigned long long _c = (unsigned long long)clock64(); \
        ts_lo = (lane == nts) ? (int)(unsigned)_c : ts_lo; ts_hi = (lane == nts) ? (int)(unsigned)(_c >> 32) : ts_hi; ++nts; } } while (0)
    PG8_STAMP();
    unsigned voffA[2], voffB[2];
#pragma unroll
    for (int i = 0; i < 2; ++i) { int R, C; stage_rc(tid * 16 + i * 8192, R, C); const int Rb = Epi::PERM ? ((R & ~31) + perm32(R & 31)) : R;
        voffA[i] = (unsigned)(R * K + C) * 2u; voffB[i] = (unsigned)(Rb * K + C) * 2u; }
    const size_t kstep = (size_t)(BK * 2);
    const size_t hstep = (size_t)HALF * K * 2;
    const size_t tstep = 2 * hstep;
    const unsigned ldsw = (unsigned)wid * 1024u;
    const int aoff = lds_byte(wr * 64 + fr, fq * 8), boff = lds_byte(wc * 32 + fr, fq * 8);
#define PG8_SA(b, h) (((b) * 2 + (h)) * HTB)
#define PG8_SB(b, h) ((4 + (b) * 2 + (h)) * HTB)
#define PG8_STAGE(bufoff, gbase, voff) do { _Pragma("unroll") for (int _i = 0; _i < 2; ++_i) \
        __builtin_amdgcn_global_load_lds((const unsigned*)((const char*)(gbase) + (voff)[_i]), (PG8_LAS unsigned*)(lds + (bufoff) + ldsw + _i * 8192), 16, 0, 0); } while (0)
#define PG8_LDA(dst, b, h) do { _Pragma("unroll") for (int m = 0; m < 4; ++m) _Pragma("unroll") for (int k = 0; k < 2; ++k) dst[m][k] = *(const PG8_LAS bf16x8*)(lds + PG8_SA(b, h) + aoff + m * 2048 + k * 1024); } while (0)
#define PG8_LDB(dst, b, h) do { _Pragma("unroll") for (int n = 0; n < 2; ++n) _Pragma("unroll") for (int k = 0; k < 2; ++k) dst[n][k] = *(const PG8_LAS bf16x8*)(lds + PG8_SB(b, h) + boff + n * 2048 + k * 1024); } while (0)
#define PG8_MMA(ai, bj, At, Bt) do { __builtin_amdgcn_s_setprio(1); _Pragma("unroll") for (int m = 0; m < 4; ++m) _Pragma("unroll") for (int n = 0; n < 2; ++n) _Pragma("unroll") for (int k = 0; k < 2; ++k) \
        acc[ai][bj][m][n] = __builtin_amdgcn_mfma_f32_16x16x32_bf16(Bt[n][k], At[m][k], acc[ai][bj][m][n], 0, 0, 0); __builtin_amdgcn_s_setprio(0); } while (0)
#define PG8_WAIT_V(n) asm volatile("s_waitcnt vmcnt(" #n ")" ::: "memory")
#define PG8_WAIT_L(n) asm volatile("s_waitcnt lgkmcnt(" #n ")" ::: "memory")
#define PG8_BAR __builtin_amdgcn_s_barrier()
#define PG8_SCHED __builtin_amdgcn_sched_barrier(0)
    Unit cur, nxt; int ui = 0;
    if (!S.next(0, cur)) return;
    f32x4 acc[2][2][4][2];
#pragma unroll
    for (int a = 0; a < 2; ++a)
#pragma unroll
        for (int b = 0; b < 2; ++b)
#pragma unroll
            for (int m = 0; m < 4; ++m)
#pragma unroll
                for (int n = 0; n < 2; ++n) acc[a][b][m][n] = (f32x4){0.f, 0.f, 0.f, 0.f};
    bf16x8 At[4][2], B0[2][2], B1[2][2];
    const char* cA = (const char*)g.A + (size_t)cur.pm * tstep; const char* cB = (const char*)g.Bt + (size_t)cur.pn * tstep;
    S.a_ready(cur);
    PG8_STAGE(PG8_SB(0, 0), cB, voffB); PG8_STAGE(PG8_SA(0, 0), cA, voffA); PG8_STAGE(PG8_SB(0, 1), cB + hstep, voffB); PG8_STAGE(PG8_SA(0, 1), cA + hstep, voffA);
    if (wr == 1) PG8_BAR;
    PG8_WAIT_V(4); PG8_BAR;
    PG8_STAGE(PG8_SB(1, 0), cB + kstep, voffB); PG8_STAGE(PG8_SA(1, 0), cA + kstep, voffA); PG8_STAGE(PG8_SB(1, 1), cB + hstep + kstep, voffB);
    PG8_WAIT_V(6); PG8_BAR;
    PG8_STAMP();
    for (;;) {
        const bool has_next = S.next(ui + 1, nxt);
        const char* nA = has_next ? (const char*)g.A + (size_t)nxt.pm * tstep : cA; const char* nB = has_next ? (const char*)g.Bt + (size_t)nxt.pn * tstep : cB;
        for (int t = 0; t < nt; t += 2) {
            const bool last = (t == nt - 2);
            const char* a1 = cA + (size_t)(t + 1) * kstep;
            const char* a2 = last ? nA : cA + (size_t)(t + 2) * kstep; const char* b2 = last ? nB : cB + (size_t)(t + 2) * kstep;
            const char* a3 = a2 + kstep; const char* b3 = b2 + kstep;
            if (last && has_next) S.a_ready(nxt);
            PG8_LDB(B0, 0, 0); PG8_SCHED; PG8_LDA(At, 0, 0); PG8_STAGE(PG8_SA(1, 1), a1 + hstep, voffA);
            PG8_WAIT_L(8); PG8_BAR; PG8_WAIT_L(0); PG8_MMA(0, 0, At, B0); PG8_BAR; PG8_SCHED;
            PG8_LDB(B1, 0, 1); PG8_STAGE(PG8_SB(0, 0), b2, voffB);
            PG8_BAR; PG8_WAIT_L(0); PG8_MMA(0, 1, At, B1); PG8_BAR;
            PG8_LDA(At, 0, 1); PG8_STAGE(PG8_SA(0, 0), a2, voffA);
            PG8_BAR; PG8_WAIT_L(0); PG8_MMA(1, 0, At, B0); PG8_BAR; PG8_SCHED;
            PG8_STAGE(PG8_SB(0, 1), b2 + hstep, voffB);
            PG8_WAIT_V(6); PG8_BAR; PG8_MMA(1, 1, At, B1); PG8_BAR;
            PG8_LDB(B0, 1, 0); PG8_SCHED; PG8_LDA(At, 1, 0); PG8_STAGE(PG8_SA(0, 1), a2 + hstep, voffA);
            PG8_WAIT_L(8); PG8_BAR; PG8_WAIT_L(0); PG8_MMA(0, 0, At, B0); PG8_BAR; PG8_SCHED;
            PG8_LDB(B1, 1, 1); PG8_STAGE(PG8_SB(1, 0), b3, voffB);
            PG8_BAR; PG8_WAIT_L(0); PG8_MMA(0, 1, At, B1); PG8_BAR;
            PG8_LDA(At, 1, 1); PG8_STAGE(PG8_SA(1, 0), a3, voffA);
            PG8_BAR; PG8_WAIT_L(0); PG8_MMA(1, 0, At, B0); PG8_BAR; PG8_SCHED;
            PG8_STAGE(PG8_SB(1, 1), b3 + hstep, voffB);
            PG8_WAIT_V(6); PG8_BAR; PG8_MMA(1, 1, At, B1); PG8_BAR;
        }
        PG8_STAMP();
        if constexpr (!Epi::AFTER_DRAIN) { E(acc, cur, wr, wc, fr, fq); S.done(cur); }
        PG8_STAMP();
        if (!has_next) break;
#pragma unroll
        for (int a = 0; a < 2; ++a)
#pragma unroll
            for (int b = 0; b < 2; ++b)
#pragma unroll
                for (int m = 0; m < 4; ++m)
#pragma unroll
                    for (int n = 0; n < 2; ++n) acc[a][b][m][n] = (f32x4){0.f, 0.f, 0.f, 0.f};
        cur = nxt; cA = nA; cB = nB; ++ui;
    }
    PG8_WAIT_V(0);
    if (wr == 0) PG8_BAR;
    PG8_BAR;
    if constexpr (Epi::AFTER_DRAIN) { E.fused(acc, cur, wr, wc, fr, fq, lds, wid, lane); S.done(cur); }
    PG8_STAMP();
    if (STAMP && wid == 0) { stamps[lane] = lane < nts ? (((unsigned long long)(unsigned)ts_hi << 32) | (unsigned)ts_lo) : 0ull;
        if (lane == 62) stamps[62] = rt_entry; if (lane == 63) stamps[63] = (unsigned long long)wall_clock64(); }
#undef PG8_STAMP
#undef PG8_SA
#undef PG8_SB
#undef PG8_STAGE
#undef PG8_LDA
#undef PG8_LDB
#undef PG8_MMA
#undef PG8_WAIT_V
#undef PG8_WAIT_L
#undef PG8_BAR
#undef PG8_SCHED
}
}

using pg8::bf16x8; using pg8::f32x4; using pg8::u32x4;
typedef short s16x4 __attribute__((ext_vector_type(4)));
typedef __bf16 bfx2 __attribute__((ext_vector_type(2)));

struct Params {
    const float *x, *ln_mix, *ln_ffn, *ret_w_in, *ret_w_out, *ret_gn, *kv_norm, *w_kv, *att_w_q, *att_w_o, *att_rel_bias, *peer_w_q, *peer_sub_keys, *peer_u, *peer_v, *ln_final;
    float* out; unsigned char* ws; int lo, hi;
};
struct Ctx { LAS unsigned char* lds; int tid, lane, wave, bx, G, gw, ngw; };

__device__ __forceinline__ float dot2bf(unsigned a, unsigned b, float c) { return __builtin_amdgcn_fdot2_f32_bf16(__builtin_bit_cast(bfx2, a), __builtin_bit_cast(bfx2, b), c, false); }
__device__ __forceinline__ bf16x8 lds128(LAS const unsigned char* p) { return *(LAS const bf16x8*)p; }
__device__ __forceinline__ bf16x8 tr_frag(unsigned a0, unsigned a1) {
    s16x4 lo, hi;
    asm volatile("ds_read_b64_tr_b16 %0, %2\n\tds_read_b64_tr_b16 %1, %3\n\ts_waitcnt lgkmcnt(0)" : "=&v"(lo), "=&v"(hi) : "v"(a0), "v"(a1) : "memory");
    bf16x8 r; r[0] = lo[0]; r[1] = lo[1]; r[2] = lo[2]; r[3] = lo[3]; r[4] = hi[0]; r[5] = hi[1]; r[6] = hi[2]; r[7] = hi[3]; return r;
}
#define MFMA16(a, b, c) __builtin_amdgcn_mfma_f32_16x16x32_bf16((a), (b), (c), 0, 0, 0)

__device__ __forceinline__ void load_row(const float* xrow, int lane, f32x4 (&v)[8]) {
    const f32x4* xr = (const f32x4*)xrow + lane;
#pragma unroll
    for (int j = 0; j < 8; ++j) v[j] = xr[64 * j];
}
__device__ __forceinline__ float row_rstd(const f32x4 (&v)[8]) {
    float s = 0.f;
#pragma unroll
    for (int j = 0; j < 8; ++j) s += (v[j][0] * v[j][0] + v[j][1] * v[j][1]) + (v[j][2] * v[j][2] + v[j][3] * v[j][3]);
    return 1.0f / sqrtf(wave_sum(s) * (1.0f / DM) + EPS);
}
__device__ __forceinline__ void store_norm_bf16(const f32x4 (&v)[8], float rstd, const float* g, bf16* orow, int lane) {
    const f32x4* gr = (const f32x4*)g + lane; u32x2* o8 = (u32x2*)orow + lane;
#pragma unroll
    for (int j = 0; j < 8; ++j) { const f32x4 gv = gr[64 * j]; u32x2 w; w.x = pk2(v[j][0] * rstd * gv[0], v[j][1] * rstd * gv[1]); w.y = pk2(v[j][2] * rstd * gv[2], v[j][3] * rstd * gv[3]); o8[64 * j] = w; }
}
__device__ __forceinline__ void load_g(const float* g, int lane, f32x4 (&gv)[8]) {
    const f32x4* gr = (const f32x4*)g + lane;
#pragma unroll
    for (int j = 0; j < 8; ++j) gv[j] = gr[64 * j];
}
__device__ __forceinline__ void store_norm_bf16_r(const f32x4 (&v)[8], float rstd, const f32x4 (&gv)[8], bf16* orow, int lane) {
    u32x2* o8 = (u32x2*)orow + lane;
#pragma unroll
    for (int j = 0; j < 8; ++j) { u32x2 w; w.x = pk2(v[j][0] * rstd * gv[j][0], v[j][1] * rstd * gv[j][1]); w.y = pk2(v[j][2] * rstd * gv[j][2], v[j][3] * rstd * gv[j][3]); o8[64 * j] = w; }
}
__device__ __forceinline__ unsigned q8pack(float a, float b, float c, float d) {
    const unsigned ua = __builtin_bit_cast(unsigned, a + 12582912.0f), ub = __builtin_bit_cast(unsigned, b + 12582912.0f), uc = __builtin_bit_cast(unsigned, c + 12582912.0f), ud = __builtin_bit_cast(unsigned, d + 12582912.0f);
    return (ua & 255u) | ((ub & 255u) << 8) | ((uc & 255u) << 16) | (ud << 24);
}

__device__ __forceinline__ void p0_transpose_item(const float* W, int K, int N, bf16* WT, LAS float* scr, int item, int lane) {
    const int nblk = N / 32, kb = item / nblk, nb = item % nblk, k0 = 64 * kb, n0 = 32 * nb;
    float tv[32];
#pragma unroll
    for (int i = 0; i < 32; ++i) { const int kk = 2 * i + (lane >> 5); tv[i] = W[(size_t)(k0 + kk) * N + n0 + (lane & 31)]; }
#pragma unroll
    for (int i = 0; i < 32; ++i) { const int kk = 2 * i + (lane >> 5); scr[kk * 33 + (lane & 31)] = tv[i]; }
    LDS_WAIT(); asm volatile("" ::: "memory");
    const int c = lane & 7;
#pragma unroll
    for (int j = 0; j < 4; ++j) { const int n = (lane >> 3) + 8 * j; const LAS float* s = scr + (8 * c) * 33 + n;
        u32x4 o; o.x = pk2(s[0 * 33], s[1 * 33]); o.y = pk2(s[2 * 33], s[3 * 33]); o.z = pk2(s[4 * 33], s[5 * 33]); o.w = pk2(s[6 * 33], s[7 * 33]);
        *(u32x4*)(WT + (size_t)(n0 + n) * K + k0 + 8 * c) = o; }
    LDS_WAIT(); asm volatile("" ::: "memory");
}
__device__ __forceinline__ void p0_fold_tile(const Params& p, const Ctx& c, int tl) {
    const int l = tl >> 9, hp = (tl >> 5) & 15, j0 = (tl & 31) * 64;
    LAS float* As = (LAS float*)c.lds;
    LAS float* Bs = (LAS float*)c.lds + 64 * 132;
    const float* Wq = p.peer_w_q + (size_t)l * DM * DM; const float* sk = p.peer_sub_keys + ((size_t)l * 2 + (hp & 1)) * PNK * 128;
    __syncthreads();
    for (int i = c.tid; i < 64 * 32; i += 512) { const int jj = i >> 5, d4 = i & 31; *(LAS f32x4*)(As + jj * 132 + d4 * 4) = *(const f32x4*)(Wq + (size_t)(j0 + jj) * DM + hp * 128 + d4 * 4); }
    for (int i = c.tid; i < 128 * 32; i += 512) { const int k = i >> 5, d4 = i & 31; *(LAS f32x4*)(Bs + k * 132 + d4 * 4) = *(const f32x4*)(sk + (size_t)k * 128 + d4 * 4); }
    __syncthreads();
    const int tj = c.tid & 15, tk = c.tid >> 4;
    float acc[4][4];
#pragma unroll
    for (int b = 0; b < 4; ++b)
#pragma unroll
        for (int a = 0; a < 4; ++a) acc[b][a] = 0.f;
    for (int d4 = 0; d4 < 32; ++d4) {
        f32x4 av[4], bv[4];
#pragma unroll
        for (int a = 0; a < 4; ++a) av[a] = *(LAS const f32x4*)(As + (tj + 16 * a) * 132 + d4 * 4);
#pragma unroll
        for (int b = 0; b < 4; ++b) bv[b] = *(LAS const f32x4*)(Bs + (tk * 4 + b) * 132 + d4 * 4);
#pragma unroll
        for (int b = 0; b < 4; ++b)
#pragma unroll
            for (int a = 0; a < 4; ++a) acc[b][a] += (av[a][0] * bv[b][0] + av[a][1] * bv[b][1]) + (av[a][2] * bv[b][2] + av[a][3] * bv[b][3]);
    }
    bf16* WcT = (bf16*)(p.ws + WS_WC) + (size_t)l * DM * DM;
#pragma unroll
    for (int b = 0; b < 4; ++b)
#pragma unroll
        for (int a = 0; a < 4; ++a) WcT[(size_t)(hp * 128 + tk * 4 + b) * DM + j0 + tj + 16 * a] = (bf16)f2bf(acc[b][a]);
}
__device__ __forceinline__ void p0_prologue(const Params& p, const Ctx& c) {
#ifndef PROREP
#define PROREP 0
#endif
    for (int rp_ = ((PROREP >> 0) & 1) ? 0 : 1; rp_ < 2; ++rp_) {
    for (int tl = c.bx; tl < DEPTH * 16 * 32; tl += c.G) p0_fold_tile(p, c, tl);
    __syncthreads();
    }
    for (int rp_ = ((PROREP >> 1) & 1) ? 0 : 1; rp_ < 2; ++rp_)
    {
        LAS float* scr = (LAS float*)(c.lds + c.wave * 16384);
        constexpr int I_IN = (DM / 64) * (RIN / 32), I_OUT = (RVW / 64) * (DM / 32), I_KV = (DM / 64) * (2 * DM / 32), I_SQ = (DM / 64) * (DM / 32);
        constexpr int NITEMS = 2 * I_IN + 2 * I_OUT + I_KV + 4 * I_SQ;
        for (int it = c.gw; it < NITEMS; it += c.ngw) {
            int r = it;
            if (r < 2 * I_IN) { const int l = r / I_IN; p0_transpose_item(p.ret_w_in + (size_t)l * DM * RIN, DM, RIN, (bf16*)(p.ws + WS_WIN) + (size_t)l * RIN * DM, scr, r % I_IN, c.lane); continue; } r -= 2 * I_IN;
            if (r < 2 * I_OUT) { const int l = r / I_OUT; p0_transpose_item(p.ret_w_out + (size_t)l * RVW * DM, RVW, DM, (bf16*)(p.ws + WS_WOUT) + (size_t)l * DM * RVW, scr, r % I_OUT, c.lane); continue; } r -= 2 * I_OUT;
            if (r < I_KV) { p0_transpose_item(p.w_kv, DM, 2 * DM, (bf16*)(p.ws + WS_WKV), scr, r, c.lane); continue; } r -= I_KV;
            if (r < 2 * I_SQ) { const int l = r / I_SQ; p0_transpose_item(p.att_w_q + (size_t)l * DM * DM, DM, DM, (bf16*)(p.ws + WS_WQ) + (size_t)l * DM * DM, scr, r % I_SQ, c.lane); continue; } r -= 2 * I_SQ;
            { const int l = r / I_SQ; p0_transpose_item(p.att_w_o + (size_t)l * DM * DM, DM, DM, (bf16*)(p.ws + WS_WO) + (size_t)l * DM * DM, scr, r % I_SQ, c.lane); }
        }
    }
    for (int rp_ = ((PROREP >> 2) & 1) ? 0 : 1; rp_ < 2; ++rp_)
    {
        float* rs = (float*)(p.ws + WS_RS);
        for (int row = c.gw; row < 2 * DEPTH * PE; row += c.ngw) {
            const int which = row >= DEPTH * PE, r = row - which * DEPTH * PE;
            f32x4 v[8]; load_row((which ? p.peer_v : p.peer_u) + (size_t)r * DM, c.lane, v);
            float am = 0.f;
#pragma unroll
            for (int j = 0; j < 8; ++j) am = fmaxf(fmaxf(am, fmaxf(fabsf(v[j][0]), fabsf(v[j][1]))), fmaxf(fabsf(v[j][2]), fabsf(v[j][3])));
#pragma unroll
            for (int o = 1; o < 64; o <<= 1) am = fmaxf(am, __shfl_xor(am, o));
            int e = (int)((__builtin_bit_cast(unsigned, am) >> 23) & 0xffu) - 127; if (am == 0.f) e = 7;
            int k = 7 - e; k = k < -100 ? -100 : (k > 100 ? 100 : k);
            const float sc = __builtin_bit_cast(float, (unsigned)(k + 127) << 23), rsc = __builtin_bit_cast(float, (unsigned)(127 - k) << 23);
            const int lyr = r / PE, re = r % PE;
            unsigned char* dstb = p.ws + (which ? WS_PV : WS_PU) + (size_t)lyr * PE * DM + (size_t)re * 128;
            if (which) {
#pragma unroll
                for (int j = 0; j < 8; ++j) { int w = 0; w = __builtin_amdgcn_cvt_pk_fp8_f32(v[j][0] * sc, v[j][1] * sc, w, false); w = __builtin_amdgcn_cvt_pk_fp8_f32(v[j][2] * sc, v[j][3] * sc, w, true); { const int col = 4 * c.lane + 256 * j; *(unsigned*)(dstb + (size_t)(col >> 7) * PE * 128 + (col & 127)) = (unsigned)w; } }
                if (c.lane == 0) rs[row] = rsc;
            } else {
                const float s8 = am > 0.f ? 127.0f / am : 0.f;
#pragma unroll
                for (int j = 0; j < 8; ++j) { const unsigned w = q8pack(v[j][0] * s8, v[j][1] * s8, v[j][2] * s8, v[j][3] * s8); const int col = 4 * c.lane + 256 * j; *(unsigned*)(dstb + (size_t)(col >> 7) * PE * 128 + (col & 127)) = w; }
                if (c.lane == 0) rs[row] = am * (1.0f / 127.0f);
            }
        }
    }
    for (int rp_ = ((PROREP >> 3) & 1) ? 0 : 1; rp_ < 2; ++rp_)
    {
        float* rot = (float*)(p.ws + WS_ROT);
        for (int i = c.bx * 512 + c.tid; i < SEQ * 128; i += c.G * 512) { const int pos = i >> 7, d = i & 127;
            const float inv = (float)(1.0 / pow(10000.0, (double)d / 128.0)); const float ang = (float)pos * inv;
            rot[(size_t)pos * 256 + d] = (float)cos((double)ang); rot[(size_t)pos * 256 + 128 + d] = (float)sin((double)ang); }
    }
    for (int rp_ = ((PROREP >> 4) & 1) ? 0 : 1; rp_ < 2; ++rp_)
    { f32x4 gv[8]; load_g(p.ln_mix, c.lane, gv);
      for (int m = c.gw; m < NTOK; m += c.ngw) {
        f32x4 v[8]; load_row(p.x + (size_t)m * DM, c.lane, v);
        f32x4* xo = (f32x4*)(p.out + (size_t)m * DM) + c.lane;
#pragma unroll
        for (int j = 0; j < 8; ++j) xo[64 * j] = v[j];
        store_norm_bf16_r(v, row_rstd(v), gv, (bf16*)(p.ws + WS_H) + (size_t)m * DM, c.lane);
      } }
}

constexpr int RS_QS = 0, RS_KS = 33792, RS_VS = 67584, RS_VZ = 76800, RS_PS = 86016, RS_RS = 95232, RS_END = 129024, QK_STR = 528, V_STR = 144;
__device__ __forceinline__ void ret_scan_unit(const Ctx& c, const bf16* Qg, const bf16* Kg, const bf16* Vg, bf16* Og, int unit) {
    const int xg = unit & 7, slot = unit >> 3, pair = xg * 4 + (slot >> 3), es = slot & 7, b = pair >> 3, h = pair & 7;
    const int tid = c.tid, lane = c.lane, w = c.wave, fr = lane & 15, fq = lane >> 4, tq = (lane & 15) >> 2, tp = lane & 3;
    LAS unsigned char* lds = c.lds;
    const float lgam = log1pf(-exp2f(-5.0f - (float)h));
    const float cdec = expf(lgam * 64.0f);
    const int lrow = tid >> 3, lch = tid & 7;
    const size_t tok0 = (size_t)b * SEQ;
    const bf16* qrow = Qg + (tok0 + lrow) * RQKW + h * RQK + lch * 8;
    const bf16* krow = Kg + (tok0 + lrow) * RQKW + h * RQK + lch * 8;
    const bf16* vrow = Vg + (tok0 + lrow) * RVW + h * RV + es * 64 + lch * 8;
    const float zeta = expf(lgam * (float)(63 - lrow));
    u32x4 pq[4], pk[4], pv;
#pragma unroll
    for (int cc = 0; cc < 4; ++cc) { pq[cc] = *(const u32x4*)(qrow + cc * 64); pk[cc] = *(const u32x4*)(krow + cc * 64); }
    pv = *(const u32x4*)vrow;
    __syncthreads();
    for (int i = tid; i < (RS_END - RS_RS) / 16; i += 512) *(LAS u32x4*)(lds + RS_RS + i * 16) = (u32x4){0u, 0u, 0u, 0u};
    f32x4 Racc[2][4];
#pragma unroll
    for (int x = 0; x < 2; ++x)
#pragma unroll
        for (int y = 0; y < 4; ++y) Racc[x][y] = (f32x4){0.f, 0.f, 0.f, 0.f};
    const int jt = w & 3, it0 = 2 * (w >> 2);
    const int it = w & 3, et0 = 2 * (w >> 2);
    float xi[4];
#pragma unroll
    for (int r = 0; r < 4; ++r) xi[r] = expf(lgam * (float)(16 * it + 4 * fq + r + 1));
    const unsigned ldsb = (unsigned)(size_t)lds;
    float dmask[2][4];
#pragma unroll
    for (int x = 0; x < 2; ++x)
#pragma unroll
        for (int r = 0; r < 4; ++r) { const int i = 16 * (it0 + x) + fr, j = 16 * jt + 4 * fq + r; dmask[x][r] = (i >= j) ? expf(lgam * (float)(i - j)) : 0.f; }
    asm volatile("" : "+v"(dmask[0][0]), "+v"(dmask[0][1]), "+v"(dmask[0][2]), "+v"(dmask[0][3]), "+v"(dmask[1][0]), "+v"(dmask[1][1]), "+v"(dmask[1][2]), "+v"(dmask[1][3]));
    for (int n = 0; n < NCHUNK; ++n) {
        __syncthreads();
#pragma unroll
        for (int cc = 0; cc < 4; ++cc) { *(LAS u32x4*)(lds + RS_QS + lrow * QK_STR + (lch + 8 * cc) * 16) = pq[cc]; *(LAS u32x4*)(lds + RS_KS + lrow * QK_STR + (lch + 8 * cc) * 16) = pk[cc]; }
        *(LAS u32x4*)(lds + RS_VS + lrow * V_STR + lch * 16) = pv;
        { u32x4 z; z.x = pk2(bflo(pv.x) * zeta, bfhi(pv.x) * zeta); z.y = pk2(bflo(pv.y) * zeta, bfhi(pv.y) * zeta); z.z = pk2(bflo(pv.z) * zeta, bfhi(pv.z) * zeta); z.w = pk2(bflo(pv.w) * zeta, bfhi(pv.w) * zeta);
          *(LAS u32x4*)(lds + RS_VZ + lrow * V_STR + lch * 16) = z; }
        __syncthreads();
        if (n + 1 < NCHUNK) {
            const size_t adv = (size_t)(n + 1) * CHUNK;
#pragma unroll
            for (int cc = 0; cc < 4; ++cc) { pq[cc] = *(const u32x4*)(qrow + adv * RQKW + cc * 64); pk[cc] = *(const u32x4*)(krow + adv * RQKW + cc * 64); }
            pv = *(const u32x4*)(vrow + adv * RVW);
        }
        {
            f32x4 s0 = (f32x4){0.f, 0.f, 0.f, 0.f}, s1 = s0;
#pragma unroll
            for (int kh = 0; kh < 2; ++kh) {
                bf16x8 fa[4], fb0[4], fb1[4];
#pragma unroll
                for (int k4 = 0; k4 < 4; ++k4) { const int ks = 4 * kh + k4;
                    fa[k4] = lds128(lds + RS_KS + (16 * jt + fr) * QK_STR + (4 * ks + fq) * 16);
                    fb0[k4] = lds128(lds + RS_QS + (16 * it0 + fr) * QK_STR + (4 * ks + fq) * 16);
                    fb1[k4] = lds128(lds + RS_QS + (16 * (it0 + 1) + fr) * QK_STR + (4 * ks + fq) * 16); }
                __builtin_amdgcn_sched_barrier(0);
#pragma unroll
                for (int k4 = 0; k4 < 4; ++k4) { s0 = MFMA16(fa[k4], fb0[k4], s0); s1 = MFMA16(fa[k4], fb1[k4], s1); }
            }
#pragma unroll
            for (int x = 0; x < 2; ++x) { const f32x4 s = x ? s1 : s0; const int i = 16 * (it0 + x) + fr; float pr[4];
#pragma unroll
                for (int r = 0; r < 4; ++r) pr[r] = s[r] * dmask[x][r];
                u32x2 pw; pw.x = pk2(pr[0], pr[1]); pw.y = pk2(pr[2], pr[3]);
                *(LAS u32x2*)(lds + RS_PS + i * V_STR + (16 * jt + 4 * fq) * 2) = pw; }
        }
        f32x4 o0 = (f32x4){0.f, 0.f, 0.f, 0.f}, o1 = o0;
        {
#pragma unroll
            for (int kh = 0; kh < 2; ++kh) {
                bf16x8 fa[4], fb0[4], fb1[4];
#pragma unroll
                for (int k4 = 0; k4 < 4; ++k4) { const int ks = 4 * kh + k4;
                    fa[k4] = lds128(lds + RS_QS + (16 * it + fr) * QK_STR + (4 * ks + fq) * 16);
                    fb0[k4] = lds128(lds + RS_RS + (16 * et0 + fr) * QK_STR + (4 * ks + fq) * 16);
                    fb1[k4] = lds128(lds + RS_RS + (16 * (et0 + 1) + fr) * QK_STR + (4 * ks + fq) * 16); }
                __builtin_amdgcn_sched_barrier(0);
#pragma unroll
                for (int k4 = 0; k4 < 4; ++k4) { o0 = MFMA16(fa[k4], fb0[k4], o0); o1 = MFMA16(fa[k4], fb1[k4], o1); }
            }
        }
#pragma unroll
        for (int r = 0; r < 4; ++r) { o0[r] *= xi[r]; o1[r] *= xi[r]; }
        __syncthreads();
#pragma unroll
        for (int ks = 0; ks < 2; ++ks) {
            const bf16x8 a = lds128(lds + RS_PS + (16 * it + fr) * V_STR + (4 * ks + fq) * 16);
            const unsigned va = ldsb + RS_VS + (32 * ks + 8 * fq + tq) * V_STR + 8 * tp;
            const bf16x8 b0 = tr_frag(va + 32 * et0, va + 4 * V_STR + 32 * et0);
            const bf16x8 b1 = tr_frag(va + 32 * (et0 + 1), va + 4 * V_STR + 32 * (et0 + 1));
            __builtin_amdgcn_sched_barrier(0);
            o0 = MFMA16(a, b0, o0); o1 = MFMA16(a, b1, o1);
        }
        {
            bf16* op = Og + (tok0 + (size_t)n * CHUNK + 16 * it + 4 * fq) * RVW + h * RV + es * 64 + 16 * et0 + fr;
#pragma unroll
            for (int r = 0; r < 4; ++r) { op[(size_t)r * RVW] = (bf16)f2bf(o0[r]); op[(size_t)r * RVW + 16] = (bf16)f2bf(o1[r]); }
        }
#pragma unroll
        for (int x = 0; x < 2; ++x)
#pragma unroll
            for (int y = 0; y < 4; ++y) Racc[x][y] *= cdec;
#pragma unroll
        for (int ks = 0; ks < 2; ++ks) {
            const unsigned ka = ldsb + RS_KS + (32 * ks + 8 * fq + tq) * QK_STR + 8 * tp;
            const unsigned za = ldsb + RS_VZ + (32 * ks + 8 * fq + tq) * V_STR + 8 * tp;
            bf16x8 ak[2], bz[4];
#pragma unroll
            for (int x = 0; x < 2; ++x) ak[x] = tr_frag(ka + 32 * (2 * w + x), ka + 4 * QK_STR + 32 * (2 * w + x));
#pragma unroll
            for (int y = 0; y < 4; ++y) bz[y] = tr_frag(za + 32 * y, za + 4 * V_STR + 32 * y);
            __builtin_amdgcn_sched_barrier(0);
#pragma unroll
            for (int x = 0; x < 2; ++x)
#pragma unroll
                for (int y = 0; y < 4; ++y) Racc[x][y] = MFMA16(ak[x], bz[y], Racc[x][y]);
        }
#pragma unroll
        for (int x = 0; x < 2; ++x)
#pragma unroll
            for (int y = 0; y < 4; ++y) { u32x2 rw; rw.x = pk2(Racc[x][y][0], Racc[x][y][1]); rw.y = pk2(Racc[x][y][2], Racc[x][y][3]);
                *(LAS u32x2*)(lds + RS_RS + (16 * y + fr) * QK_STR + (16 * (2 * w + x) + 4 * fq) * 2) = rw; }
    }
}

template <int CTRL> __device__ __forceinline__ float dpp_f(float x) { return __builtin_bit_cast(float, __builtin_amdgcn_mov_dpp(__builtin_bit_cast(int, x), CTRL, 0xF, 0xF, true)); }
__device__ __forceinline__ float sum8(float x) { x += dpp_f<0xB1>(x); x += dpp_f<0x4E>(x); x += dpp_f<0x141>(x); return x; }
__device__ __forceinline__ void ret_gate_phase(const Ctx& c, const bf16* Og, bf16* Gg, const float* gn, bf16* Zout = nullptr) {
    const int col0 = 512 * (c.lane >> 3) + 8 * (c.lane & 7);
    f32x4 gw[16];
#pragma unroll
    for (int j = 0; j < 8; ++j) { gw[2 * j] = *(const f32x4*)(gn + col0 + 64 * j); gw[2 * j + 1] = *(const f32x4*)(gn + col0 + 64 * j + 4); }
    u32x4 ovn[8];
    if (c.gw < NTOK) { const bf16* orow = Og + (size_t)c.gw * RVW + col0;
#pragma unroll
        for (int j = 0; j < 8; ++j) ovn[j] = *(const u32x4*)(orow + 64 * j); }
    for (int m = c.gw; m < NTOK; m += c.ngw) {
        u32x4 gv[8], ov[8];
        { const bf16* grow = Gg + (size_t)m * RVW + col0;
#pragma unroll
          for (int j = 0; j < 8; ++j) { gv[j] = *(const u32x4*)(grow + 64 * j); ov[j] = ovn[j]; } }
        { const int mn = m + c.ngw < NTOK ? m + c.ngw : m; const bf16* orow = Og + (size_t)mn * RVW + col0;
#pragma unroll
          for (int j = 0; j < 8; ++j) ovn[j] = *(const u32x4*)(orow + 64 * j); }
        float s1 = 0.f;
#pragma unroll
        for (int j = 0; j < 8; ++j) { const u32x4 t = ov[j];
            s1 += ((bflo(t.x) + bfhi(t.x)) + (bflo(t.y) + bfhi(t.y))) + ((bflo(t.z) + bfhi(t.z)) + (bflo(t.w) + bfhi(t.w))); }
        const float mu = sum8(s1) * (1.0f / RV);
        asm volatile("" : "+v"(ov[0]), "+v"(ov[1]), "+v"(ov[2]), "+v"(ov[3]), "+v"(ov[4]), "+v"(ov[5]), "+v"(ov[6]), "+v"(ov[7]));
        float s2 = 0.f;
#pragma unroll
        for (int j = 0; j < 8; ++j) { const u32x4 t = ov[j];
            const float d[8] = {bflo(t.x) - mu, bfhi(t.x) - mu, bflo(t.y) - mu, bfhi(t.y) - mu, bflo(t.z) - mu, bfhi(t.z) - mu, bflo(t.w) - mu, bfhi(t.w) - mu};
            float q = 0.f;
#pragma unroll
            for (int k = 0; k < 8; ++k) q += d[k] * d[k];
            s2 += q; }
        const float rstd = 1.0f / sqrtf(sum8(s2) * (1.0f / RV) + EPS);
        asm volatile("" : "+v"(ov[0]), "+v"(ov[1]), "+v"(ov[2]), "+v"(ov[3]), "+v"(ov[4]), "+v"(ov[5]), "+v"(ov[6]), "+v"(ov[7]));
        bf16* zrow = (Zout ? Zout : Gg) + (size_t)m * RVW + col0;
#pragma unroll
        for (int j = 0; j < 8; ++j) {
            const float gg[8] = {gw[2 * j][0], gw[2 * j][1], gw[2 * j][2], gw[2 * j][3], gw[2 * j + 1][0], gw[2 * j + 1][1], gw[2 * j + 1][2], gw[2 * j + 1][3]};
            const u32x4 t = gv[j], u = ov[j];
            const float g[8] = {bflo(t.x), bfhi(t.x), bflo(t.y), bfhi(t.y), bflo(t.z), bfhi(t.z), bflo(t.w), bfhi(t.w)};
            const float o[8] = {bflo(u.x), bfhi(u.x), bflo(u.y), bfhi(u.y), bflo(u.z), bfhi(u.z), bflo(u.w), bfhi(u.w)};
            float z[8];
#pragma unroll
            for (int k = 0; k < 8; ++k) { const float y = (o[k] - mu) * rstd * gg[k]; z[k] = g[k] * __builtin_amdgcn_rcpf(1.0f + __builtin_amdgcn_exp2f(-1.4426950408889634f * g[k])) * y; }
            u32x4 zw; zw.x = pk2(z[0], z[1]); zw.y = pk2(z[2], z[3]); zw.z = pk2(z[4], z[5]); zw.w = pk2(z[6], z[7]);
            *(u32x4*)(zrow + 64 * j) = zw;
        }
    }
}

__device__ __forceinline__ void rms_phase(const Ctx& c, const float* X, const float* g, bf16* H) {
    for (int m = c.gw; m < NTOK; m += c.ngw) { f32x4 v[8]; load_row(X + (size_t)m * DM, c.lane, v); store_norm_bf16(v, row_rstd(v), g, H + (size_t)m * DM, c.lane); }
}

__device__ __forceinline__ int fkey(float f) { const int i = __builtin_bit_cast(int, f); return i ^ ((i >> 31) & 0x7fffffff); }
__device__ __forceinline__ float kval(int k) { return __builtin_bit_cast(float, k ^ ((k >> 31) & 0x7fffffff)); }
__device__ __forceinline__ int med3i(int a, int b, int c) { int r; asm("v_med3_i32 %0, %1, %2, %3" : "=v"(r) : "v"(a), "v"(b), "v"(c)); return r; }
#define INS16(L, key) do { const int _k = (key); _Pragma("unroll") for (int _q = 15; _q >= 1; --_q) L[_q] = med3i(L[_q - 1], L[_q], _k); L[0] = max(L[0], _k); } while (0)
constexpr int TK_LIST = 544, TK_HALF = 272, TK_KEYS = 256 * TK_LIST;
__device__ __forceinline__ void peer_topk_phase(const Ctx& c, const float* SC, int* IDX, float* WGT, const float* SQP, float* RSTD) {
    LAS unsigned char* lds = c.lds;
    u32x4 pre[16];
    if (c.bx < NTOK / 16) { const u32x4* src = (const u32x4*)(SC + (size_t)c.bx * 16 * DM);
#pragma unroll
        for (int i = 0; i < 16; ++i) pre[i] = src[c.tid + 512 * i]; }
    for (int tile = c.bx; tile < NTOK / 16; tile += c.G) {
        __syncthreads();
#pragma unroll
        for (int i = 0; i < 16; ++i) { const int g = c.tid + 512 * i; *(LAS u32x4*)(lds + (g >> 5) * TK_LIST + ((g >> 4) & 1) * TK_HALF + (g & 15) * 16) = pre[i]; }
        if (tile + c.G < NTOK / 16) { const u32x4* src = (const u32x4*)(SC + (size_t)(tile + c.G) * 16 * DM);
#pragma unroll
            for (int i = 0; i < 16; ++i) pre[i] = src[c.tid + 512 * i]; }
        __syncthreads();
        {
            const int lst = c.tid >> 1, hf = c.tid & 1;
            int L[16];
#pragma unroll
            for (int q = 0; q < 16; ++q) L[q] = (int)0x80000000;
            LAS unsigned char* lp = lds + lst * TK_LIST + hf * TK_HALF;
#pragma unroll 2
            for (int g = 0; g < 16; ++g) { const f32x4 v = *(LAS const f32x4*)(lp + g * 16);
#pragma unroll
                for (int e = 0; e < 4; ++e) INS16(L, (fkey(v[e]) & ~127) | (hf * 64 + g * 4 + e)); }
            if (hf) {
#pragma unroll
                for (int q = 0; q < 16; ++q) ((LAS int*)lp)[q] = L[q]; }
            __syncthreads();
            if (!hf) { LAS const int* op = (LAS const int*)(lp + TK_HALF);
#pragma unroll
                for (int q = 0; q < 16; ++q) INS16(L, op[q]);
                LAS int* kp = (LAS int*)(lds + TK_KEYS) + lst * 16;
#pragma unroll
                for (int q = 0; q < 16; ++q) kp[q] = L[q]; }
        }
        __syncthreads();
        if (c.tid < 128) {
            LAS const int* k1 = (LAS const int*)(lds + TK_KEYS) + (c.tid * 2) * 16; LAS const int* k2 = k1 + 16;
            float v1[16], v2[16];
#pragma unroll
            for (int q = 0; q < 16; ++q) { v1[q] = kval(k1[q] & ~127); v2[q] = kval(k2[q] & ~127); }
            int L[16];
#pragma unroll
            for (int q = 0; q < 16; ++q) L[q] = (fkey(v1[0] + v2[q]) & ~255) | q;
#pragma unroll
            for (int i = 1; i < 16; ++i)
#pragma unroll
                for (int j = 0; j < 16; ++j) if ((i + 1) * (j + 1) <= 16) INS16(L, (fkey(v1[i] + v2[j]) & ~255) | (i * 16 + j));
            const int tt = c.tid >> 3, hh = c.tid & 7; const size_t ob0 = ((size_t)tile * 16 + tt) * 128;
            float rstd; { const f32x4* sp = (const f32x4*)(SQP + ((size_t)tile * 16 + tt) * 32); f32x4 a4 = sp[0];
#pragma unroll
              for (int q = 1; q < 8; ++q) a4 += sp[q];
              rstd = 1.0f / sqrtf(((a4[0] + a4[1]) + (a4[2] + a4[3])) * (1.0f / DM) + EPS); }
            if (hh == 0) RSTD[(size_t)tile * 16 + tt] = rstd;
            const float m0 = kval(L[0] & ~255); float ex[16], se = 0.f;
#pragma unroll
            for (int q = 0; q < 16; ++q) { ex[q] = __builtin_amdgcn_exp2f((kval(L[q] & ~255) - m0) * (rstd * 1.4426950408889634f)); se += ex[q]; }
            const float inv = 1.0f / se;
#pragma unroll
            for (int q = 0; q < 16; ++q) { const int cid = L[q] & 255; const int es = hh * 16 + q, pos = (es & 7) * 16 + (es >> 3);
                IDX[ob0 + pos] = (k1[cid >> 4] & 127) * PNK + (k2[cid & 15] & 127); WGT[ob0 + pos] = ex[q] * inv; }
        }
    }
}

template <int NSTAGE> __device__ __forceinline__ void xreduce_stage(float (&p)[64], int lane) {
    constexpr int S = NSTAGE;
    if constexpr (S == 32) {
#pragma unroll
        for (int k = 0; k < S; ++k) { float xa = p[k], xb = p[k + S]; asm("s_nop 1\n\tv_permlane32_swap_b32 %0, %1" : "+v"(xa), "+v"(xb)); p[k] = xa + xb; }
    } else if constexpr (S == 16) {
#pragma unroll
        for (int k = 0; k < S; ++k) { float xa = p[k], xb = p[k + S]; asm("s_nop 1\n\tv_permlane16_swap_b32 %0, %1" : "+v"(xa), "+v"(xb)); p[k] = xa + xb; }
    } else {
        const bool up = (lane & S) != 0;
#pragma unroll
        for (int k = 0; k < S; ++k) { const float keep = up ? p[k + S] : p[k], send = up ? p[k] : p[k + S];
            p[k] = keep + __builtin_bit_cast(float, __builtin_amdgcn_ds_swizzle(__builtin_bit_cast(int, send), (S << 10) | 0x1F)); }
    }
}
__device__ __forceinline__ float gelu_erf(float v) { return 0.5f * v * (1.0f + erff(v * 0.70710678118654752f)); }
typedef float f32x2 __attribute__((ext_vector_type(2)));
__device__ __forceinline__ float peer_dots64(const unsigned char* U, int idxv, const f32x2 (&h2)[16], int lane) {
    float p[64];
#pragma unroll
    for (int e = 0; e < 64; ++e) {
        const int row = __builtin_amdgcn_readlane(idxv, e);
        const u32x4* up = (const u32x4*)(U + (size_t)row * DM) + lane;
        f32x2 a = {0.f, 0.f};
#pragma unroll
        for (int cc = 0; cc < 2; ++cc) { const u32x4 u = up[64 * cc];
#pragma unroll
            for (int q = 0; q < 4; ++q) { const int w = (int)u[q];
                a = __builtin_elementwise_fma(__builtin_amdgcn_cvt_pk_f32_fp8(w, false), h2[8 * cc + 2 * q], a);
                a = __builtin_elementwise_fma(__builtin_amdgcn_cvt_pk_f32_fp8(w, true), h2[8 * cc + 2 * q + 1], a); } }
        p[e] = a.x + a.y;
    }
    xreduce_stage<32>(p, lane); xreduce_stage<16>(p, lane); xreduce_stage<8>(p, lane); xreduce_stage<4>(p, lane); xreduce_stage<2>(p, lane); xreduce_stage<1>(p, lane);
    return p[0];
}
__device__ __forceinline__ void peer_accum64(const unsigned char* Vt, int idxv, float av, f32x2 (&acc)[16], int lane) {
#pragma unroll 8
    for (int e = 0; e < 64; ++e) {
        const int row = __builtin_amdgcn_readlane(idxv, e); const float a = __builtin_bit_cast(float, __builtin_amdgcn_readlane(__builtin_bit_cast(int, av), e));
        const f32x2 a2 = {a, a};
        const u32x4* vp = (const u32x4*)(Vt + (size_t)row * DM) + lane;
#pragma unroll
        for (int cc = 0; cc < 2; ++cc) { const u32x4 v = vp[64 * cc];
#pragma unroll
            for (int q = 0; q < 4; ++q) { const int w = (int)v[q];
                acc[8 * cc + 2 * q] = __builtin_elementwise_fma(__builtin_amdgcn_cvt_pk_f32_fp8(w, false), a2, acc[8 * cc + 2 * q]);
                acc[8 * cc + 2 * q + 1] = __builtin_elementwise_fma(__builtin_amdgcn_cvt_pk_f32_fp8(w, true), a2, acc[8 * cc + 2 * q + 1]); } }
    }
}
constexpr int GD = 8;
#define PG_ISSUE(vv) do { const int row_ = __builtin_amdgcn_readlane((((vv) >> 6) & 1) ? i1 : i0, (vv) & 63); \
        const u32x4* bp_ = (const u32x4*)((((vv) >> 6) < 2 ? U : Vt) + (size_t)row_ * DM) + lane; ring[(vv) % GD][0] = bp_[0]; ring[(vv) % GD][1] = bp_[64]; } while (0)
template <int SEG> __device__ __forceinline__ void peer_seg(const unsigned char* U, const unsigned char* Vt, int i0, int i1, u32x4 (&ring)[GD][2], float (&p)[64], float aseg, const f32x2 (&h2)[16], f32x2 (&acc)[16], int lane) {
#pragma unroll
    for (int e = 0; e < 64; ++e) {
        const int v = SEG * 64 + e;
        const u32x4 r0 = ring[v % GD][0], r1 = ring[v % GD][1];
        if (SEG < 2) {
            f32x2 a = {0.f, 0.f};
#pragma unroll
            for (int q = 0; q < 4; ++q) { const int wa = (int)r0[q], wb = (int)r1[q];
                a = __builtin_elementwise_fma(__builtin_amdgcn_cvt_pk_f32_fp8(wa, false), h2[2 * q], a); a = __builtin_elementwise_fma(__builtin_amdgcn_cvt_pk_f32_fp8(wa, true), h2[2 * q + 1], a);
                a = __builtin_elementwise_fma(__builtin_amdgcn_cvt_pk_f32_fp8(wb, false), h2[8 + 2 * q], a); a = __builtin_elementwise_fma(__builtin_amdgcn_cvt_pk_f32_fp8(wb, true), h2[8 + 2 * q + 1], a); }
            { float hs_; asm("v_add_f32 %0, %1, %2" : "=v"(hs_) : "v"(a.x), "v"(a.y)); p[e] = hs_; }
        } else {
            const float av = __builtin_bit_cast(float, __builtin_amdgcn_readlane(__builtin_bit_cast(int, aseg), e)); const f32x2 a2 = {av, av};
#pragma unroll
            for (int q = 0; q < 4; ++q) { const int wa = (int)r0[q], wb = (int)r1[q];
                acc[2 * q] = __builtin_elementwise_fma(__builtin_amdgcn_cvt_pk_f32_fp8(wa, false), a2, acc[2 * q]); acc[2 * q + 1] = __builtin_elementwise_fma(__builtin_amdgcn_cvt_pk_f32_fp8(wa, true), a2, acc[2 * q + 1]);
                acc[8 + 2 * q] = __builtin_elementwise_fma(__builtin_amdgcn_cvt_pk_f32_fp8(wb, false), a2, acc[8 + 2 * q]); acc[8 + 2 * q + 1] = __builtin_elementwise_fma(__builtin_amdgcn_cvt_pk_f32_fp8(wb, true), a2, acc[8 + 2 * q + 1]); }
            asm volatile("" : "+v"(acc[0]), "+v"(acc[1]), "+v"(acc[2]), "+v"(acc[3]), "+v"(acc[4]), "+v"(acc[5]), "+v"(acc[6]), "+v"(acc[7]), "+v"(acc[8]), "+v"(acc[9]), "+v"(acc[10]), "+v"(acc[11]), "+v"(acc[12]), "+v"(acc[13]), "+v"(acc[14]), "+v"(acc[15]));
        }
        if (v + GD < 256) PG_ISSUE(v + GD);
        __builtin_amdgcn_sched_barrier(0);
    }
}
__device__ __forceinline__ void peer_token_pipe(const unsigned char* U, const unsigned char* Vt, int i0, int i1, float su0, float su1, float w0, float w1, const f32x2 (&h2)[16], f32x2 (&acc)[16], int lane) {
    u32x4 ring[GD][2];
    float p[64];
#pragma unroll
    for (int v = 0; v < GD; ++v) PG_ISSUE(v);
    peer_seg<0>(U, Vt, i0, i1, ring, p, 0.f, h2, acc, lane);
    xreduce_stage<32>(p, lane); xreduce_stage<16>(p, lane); xreduce_stage<8>(p, lane); xreduce_stage<4>(p, lane); xreduce_stage<2>(p, lane); xreduce_stage<1>(p, lane);
    const float a0 = gelu_erf(p[0] * su0) * w0;
    __builtin_amdgcn_sched_barrier(0);
    peer_seg<1>(U, Vt, i0, i1, ring, p, 0.f, h2, acc, lane);
    xreduce_stage<32>(p, lane); xreduce_stage<16>(p, lane); xreduce_stage<8>(p, lane); xreduce_stage<4>(p, lane); xreduce_stage<2>(p, lane); xreduce_stage<1>(p, lane);
    const float a1 = gelu_erf(p[0] * su1) * w1;
    __builtin_amdgcn_sched_barrier(0);
    peer_seg<2>(U, Vt, i0, i1, ring, p, a0, h2, acc, lane);
    peer_seg<3>(U, Vt, i0, i1, ring, p, a1, h2, acc, lane);
}
#undef PG_ISSUE
__device__ __forceinline__ void peer_gather_phase(const Ctx& c, const bf16* Hn, const unsigned char* U, const unsigned char* Vt, const float* rsU, const float* rsV, const int* IDX, const float* WGT, const float* Xr, float* X, int mode,
                                                  const float* g1, const float* g2, bf16* Hout, bf16* HKVout) {
    for (int m = c.gw; m < NTOK; m += c.ngw) {
        int lane_ = c.lane; asm volatile("" : "+v"(lane_));
#ifdef DRYIDXMASK
        const int imask_ = (X != Xr) ? DRYIDXMASK : 0xffff;
        const int i0 = IDX[(size_t)m * 128 + lane_] & imask_, i1 = IDX[(size_t)m * 128 + 64 + lane_] & imask_;
#else
        const int i0 = IDX[(size_t)m * 128 + lane_], i1 = IDX[(size_t)m * 128 + 64 + lane_];
#endif
        const float w0 = WGT[(size_t)m * 128 + lane_] * rsV[i0], w1 = WGT[(size_t)m * 128 + 64 + lane_] * rsV[i1];
        const float su0 = rsU[i0], su1 = rsU[i1];
        f32x2 h2[16];
#pragma unroll
        for (int cc = 0; cc < 2; ++cc) { const u32x4* hp = (const u32x4*)(Hn + (size_t)m * DM + 1024 * cc + 16 * lane_); const u32x4 ha = hp[0], hb = hp[1];
#pragma unroll
            for (int q = 0; q < 4; ++q) { h2[8 * cc + q] = (f32x2){bflo(ha[q]), bfhi(ha[q])}; h2[8 * cc + 4 + q] = (f32x2){bflo(hb[q]), bfhi(hb[q])}; } }
        f32x2 acc[16];
#pragma unroll
        for (int k = 0; k < 16; ++k) acc[k] = (f32x2){0.f, 0.f};
        peer_token_pipe(U, Vt, i0, i1, su0, su1, w0, w1, h2, acc, lane_);
        float* xr = X + (size_t)m * DM; const float* xrr = Xr + (size_t)m * DM; float ss = 0.f;
#pragma unroll
        for (int cc = 0; cc < 2; ++cc) {
            f32x4* xp = (f32x4*)(xr + 1024 * cc + 16 * lane_); const f32x4* xq = (const f32x4*)(xrr + 1024 * cc + 16 * lane_);
#pragma unroll
            for (int q = 0; q < 4; ++q) { f32x4 xa = xq[q]; xa[0] += acc[8 * cc + 2 * q].x; xa[1] += acc[8 * cc + 2 * q].y; xa[2] += acc[8 * cc + 2 * q + 1].x; xa[3] += acc[8 * cc + 2 * q + 1].y;
                acc[8 * cc + 2 * q] = (f32x2){xa[0], xa[1]}; acc[8 * cc + 2 * q + 1] = (f32x2){xa[2], xa[3]}; ss += (xa[0] * xa[0] + xa[1] * xa[1]) + (xa[2] * xa[2] + xa[3] * xa[3]);
                if (mode != 2) xp[q] = xa; }
        }
        const float rstd = 1.0f / sqrtf(wave_sum(ss) * (1.0f / DM) + EPS);
#pragma unroll
        for (int cc = 0; cc < 2; ++cc) {
            const f32x4* gp = (const f32x4*)(g1 + 1024 * cc + 16 * lane_);
            if (mode == 2) {
                f32x4* xp = (f32x4*)(xr + 1024 * cc + 16 * lane_);
#pragma unroll
                for (int q = 0; q < 4; ++q) { const f32x4 gv = gp[q]; f32x4 y; y[0] = acc[8 * cc + 2 * q].x * rstd * gv[0]; y[1] = acc[8 * cc + 2 * q].y * rstd * gv[1]; y[2] = acc[8 * cc + 2 * q + 1].x * rstd * gv[2]; y[3] = acc[8 * cc + 2 * q + 1].y * rstd * gv[3]; xp[q] = y; }
            } else {
                u32x4 hw[2];
#pragma unroll
                for (int q = 0; q < 4; ++q) { const f32x4 gv = gp[q]; hw[q >> 1][2 * (q & 1)] = pk2(acc[8 * cc + 2 * q].x * rstd * gv[0], acc[8 * cc + 2 * q].y * rstd * gv[1]); hw[q >> 1][2 * (q & 1) + 1] = pk2(acc[8 * cc + 2 * q + 1].x * rstd * gv[2], acc[8 * cc + 2 * q + 1].y * rstd * gv[3]); }
                u32x4* ho = (u32x4*)(Hout + (size_t)m * DM + 1024 * cc + 16 * lane_); ho[0] = hw[0]; ho[1] = hw[1];
                if (mode == 1) {
                    const f32x4* kp = (const f32x4*)(g2 + 1024 * cc + 16 * lane_); u32x4 kw[2];
#pragma unroll
                    for (int q = 0; q < 4; ++q) { const f32x4 gv = kp[q]; kw[q >> 1][2 * (q & 1)] = pk2(acc[8 * cc + 2 * q].x * rstd * gv[0], acc[8 * cc + 2 * q].y * rstd * gv[1]); kw[q >> 1][2 * (q & 1) + 1] = pk2(acc[8 * cc + 2 * q + 1].x * rstd * gv[2], acc[8 * cc + 2 * q + 1].y * rstd * gv[3]); }
                    u32x4* ko = (u32x4*)(HKVout + (size_t)m * DM + 1024 * cc + 16 * lane_); ko[0] = kw[0]; ko[1] = kw[1];
                }
            }
        }
    }
}

template <int PAT> __device__ __forceinline__ float swz_xor(float v) { return __builtin_bit_cast(float, __builtin_amdgcn_ds_swizzle(__builtin_bit_cast(int, v), PAT)); }
template <int PAT> __device__ __forceinline__ int swz_xor_i(int v) { return __builtin_amdgcn_ds_swizzle(v, PAT); }
__device__ __forceinline__ void peer_u_phase(const Ctx& c, const bf16* Hn, const unsigned char* U, const int* IDXT, float* PD, unsigned imask = 0xffffffffu) {
    const int xg = c.bx & 7, wr = (c.bx >> 3) * 8 + c.wave, g = c.lane >> 3, sub = c.lane & 7;
    for (int pass = 0; pass < 2; ++pass) {
        const int s = xg + 8 * pass, col0 = 128 * s + 16 * sub;
        const unsigned char* Us = U + (size_t)s * PE * 128 + 16 * sub;
        u32x4 ri[4], hr[2];
        { const u32x4* ip = (const u32x4*)(IDXT + (size_t)wr * 128 + g * 16); const u32x4* hp = (const u32x4*)(Hn + (size_t)wr * DM + col0);
#pragma unroll
          for (int q = 0; q < 4; ++q) ri[q] = ip[q];
          hr[0] = hp[0]; hr[1] = hp[1]; }
        for (int k = 0; k < NTOK / 256; ++k) {
            const int t = wr + 256 * k;
            u32x4 r[16];
#pragma unroll
            for (int j = 0; j < 16; ++j) r[j] = *(const u32x4*)(Us + (size_t)(ri[j >> 2][j & 3] & imask) * 128);
            float hf[16];
#pragma unroll
            for (int q = 0; q < 4; ++q) { hf[2 * q] = bflo(hr[0][q]); hf[2 * q + 1] = bfhi(hr[0][q]); hf[8 + 2 * q] = bflo(hr[1][q]); hf[8 + 2 * q + 1] = bfhi(hr[1][q]); }
            if (k + 1 < NTOK / 256) { const u32x4* ip = (const u32x4*)(IDXT + (size_t)(t + 256) * 128 + g * 16); const u32x4* hp = (const u32x4*)(Hn + (size_t)(t + 256) * DM + col0);
#pragma unroll
                for (int q = 0; q < 4; ++q) ri[q] = ip[q];
                hr[0] = hp[0]; hr[1] = hp[1]; }
            float am = 0.f;
#pragma unroll
            for (int q = 0; q < 16; ++q) am = fmaxf(am, fabsf(hf[q]));
            am = fmaxf(am, dpp_f<0xB1>(am)); am = fmaxf(am, dpp_f<0x4E>(am)); am = fmaxf(am, dpp_f<0x141>(am));
            const float hsc = am > 0.f ? 127.0f / am : 0.f, hinv = am * (1.0f / 127.0f);
            unsigned hq[4];
#pragma unroll
            for (int q = 0; q < 4; ++q) hq[q] = q8pack(hf[4 * q] * hsc, hf[4 * q + 1] * hsc, hf[4 * q + 2] * hsc, hf[4 * q + 3] * hsc);
            int p[16];
#pragma unroll
            for (int j = 0; j < 16; ++j) { int a = __builtin_amdgcn_sdot4((int)r[j].x, (int)hq[0], 0, false); a = __builtin_amdgcn_sdot4((int)r[j].y, (int)hq[1], a, false);
                a = __builtin_amdgcn_sdot4((int)r[j].z, (int)hq[2], a, false); p[j] = __builtin_amdgcn_sdot4((int)r[j].w, (int)hq[3], a, false); }
            { const bool up = (sub & 4) != 0;
#pragma unroll
              for (int q = 0; q < 8; ++q) { const int keep = up ? p[q + 8] : p[q], send = up ? p[q] : p[q + 8]; p[q] = keep + swz_xor_i<(4 << 10) | 0x1F>(send); } }
            { const bool up = (sub & 2) != 0;
#pragma unroll
              for (int q = 0; q < 4; ++q) { const int keep = up ? p[q + 4] : p[q], send = up ? p[q] : p[q + 4]; p[q] = keep + swz_xor_i<(2 << 10) | 0x1F>(send); } }
            { const bool up = (sub & 1) != 0;
#pragma unroll
              for (int q = 0; q < 2; ++q) { const int keep = up ? p[q + 2] : p[q], send = up ? p[q] : p[q + 2]; p[q] = keep + swz_xor_i<(1 << 10) | 0x1F>(send); } }
            f32x2 o = {(float)p[0] * hinv, (float)p[1] * hinv};
            *(f32x2*)(PD + ((size_t)t * 16 + s) * 128 + g * 16 + 2 * sub) = o;
        }
    }
}
__device__ __forceinline__ void peer_a_phase(const Ctx& c, const float* PD, const int* IDXT, float* WA, const float* rsU, const float* rsV, const float* RSTD) {
    const int i0 = c.bx * 512 + c.tid, step = c.G * 512;
    f32x4 vn[16];
    if (i0 < NTOK * 32) { const f32x4* pp = (const f32x4*)(PD + (size_t)(i0 >> 5) * 2048) + (i0 & 31);
#pragma unroll
        for (int s = 0; s < 16; ++s) vn[s] = pp[s * 32]; }
    for (int i4 = i0; i4 < NTOK * 32; i4 += step) {
        const int t = i4 >> 5;
        f32x4 v[16];
#pragma unroll
        for (int s = 0; s < 16; ++s) v[s] = vn[s];
        const u32x4 e = *((const u32x4*)IDXT + i4); const f32x4 w = *((const f32x4*)WA + i4); const float rs = RSTD[t];
        { const int i5 = i4 + step < NTOK * 32 ? i4 + step : i4; const f32x4* pp = (const f32x4*)(PD + (size_t)(i5 >> 5) * 2048) + (i5 & 31);
#pragma unroll
          for (int s = 0; s < 16; ++s) vn[s] = pp[s * 32]; }
        float ru[4], rv[4];
#pragma unroll
        for (int q = 0; q < 4; ++q) { const unsigned eq = e[q]; ru[q] = rsU[eq]; rv[q] = rsV[eq]; }
        f32x4 sm = v[0];
#pragma unroll
        for (int s = 1; s < 16; ++s) sm += v[s];
        asm volatile("" :: "v"(ru[0]), "v"(ru[1]), "v"(ru[2]), "v"(ru[3]), "v"(rv[0]), "v"(rv[1]), "v"(rv[2]), "v"(rv[3]));
        f32x4 o;
#pragma unroll
        for (int q = 0; q < 4; ++q) o[q] = gelu_erf(sm[q] * ru[q] * rs) * w[q] * rv[q];
        *((f32x4*)WA + i4) = o;
    }
}
__device__ __forceinline__ void peer_v_phase(const Ctx& c, const unsigned char* Vt, const int* IDXT, const float* WA, float* X) {
    const int xg = c.bx & 7, wr = (c.bx >> 3) * 8 + c.wave, g = c.lane >> 3, sub = c.lane & 7;
    for (int pass = 0; pass < 2; ++pass) {
        const int s = xg + 8 * pass, col0 = 128 * s + 16 * sub;
        const unsigned char* Vs = Vt + (size_t)s * PE * 128 + 16 * sub;
        u32x4 ri[4], ar[4];
        { const u32x4* ip = (const u32x4*)(IDXT + (size_t)wr * 128 + g * 16); const u32x4* ap = (const u32x4*)(WA + (size_t)wr * 128 + g * 16);
#pragma unroll
          for (int q = 0; q < 4; ++q) { ri[q] = ip[q]; ar[q] = ap[q]; } }
        for (int k = 0; k < NTOK / 256; ++k) {
            const int t = wr + 256 * k;
            u32x4 r[16]; float av[16];
#pragma unroll
            for (int j = 0; j < 16; ++j) { r[j] = *(const u32x4*)(Vs + (size_t)ri[j >> 2][j & 3] * 128); const unsigned ab_ = ar[j >> 2][j & 3]; av[j] = __builtin_bit_cast(float, ab_); }
            f32x2* xp = (f32x2*)(X + (size_t)t * DM + col0 + 2 * g);
            const f32x2 xold = *xp;
            if (k + 1 < NTOK / 256) { const u32x4* ip = (const u32x4*)(IDXT + (size_t)(t + 256) * 128 + g * 16); const u32x4* ap = (const u32x4*)(WA + (size_t)(t + 256) * 128 + g * 16);
#pragma unroll
                for (int q = 0; q < 4; ++q) { ri[q] = ip[q]; ar[q] = ap[q]; } }
            f32x2 acc[8];
#pragma unroll
            for (int q = 0; q < 8; ++q) acc[q] = (f32x2){0.f, 0.f};
#pragma unroll
            for (int j = 0; j < 16; ++j) { float aj_ = av[j]; asm("" : "+v"(aj_));
                const f32x2 a2 = {aj_, aj_};
#pragma unroll
                for (int q = 0; q < 4; ++q) { const int w = (int)r[j][q]; acc[2 * q] = __builtin_elementwise_fma(__builtin_amdgcn_cvt_pk_f32_fp8(w, false), a2, acc[2 * q]); acc[2 * q + 1] = __builtin_elementwise_fma(__builtin_amdgcn_cvt_pk_f32_fp8(w, true), a2, acc[2 * q + 1]); } }
            float af[16];
#pragma unroll
            for (int q = 0; q < 8; ++q) { af[2 * q] = acc[q].x; af[2 * q + 1] = acc[q].y; }
#ifdef VDBG
#pragma unroll
            for (int q = 0; q < 16; ++q) { af[q] += __shfl_xor(af[q], 8); af[q] += __shfl_xor(af[q], 16); af[q] += __shfl_xor(af[q], 32); }
            { float s0 = af[0], s1 = af[1];
#pragma unroll
              for (int gg = 1; gg < 8; ++gg) { s0 = (g == gg) ? af[2 * gg] : s0; s1 = (g == gg) ? af[2 * gg + 1] : s1; }
              af[0] = s0; af[1] = s1; }
#else
#pragma unroll
            for (int q = 0; q < 8; ++q) { float xa = af[q], xb = af[q + 8]; asm("s_nop 1\n\tv_permlane32_swap_b32 %0, %1" : "+v"(xa), "+v"(xb)); af[q] = xa + xb; }
#pragma unroll
            for (int q = 0; q < 4; ++q) { float xa = af[q], xb = af[q + 4]; asm("s_nop 1\n\tv_permlane16_swap_b32 %0, %1" : "+v"(xa), "+v"(xb)); af[q] = xa + xb; }
            { const bool up = (c.lane & 8) != 0;
#pragma unroll
              for (int q = 0; q < 2; ++q) { const float keep = up ? af[q + 2] : af[q], send = up ? af[q] : af[q + 2]; af[q] = keep + swz_xor<(8 << 10) | 0x1F>(send); } }
#endif
            const f32x2 xn = {xold.x + af[0], xold.y + af[1]};
            *xp = xn;
        }
    }
}
#ifdef VREF
__device__ __forceinline__ void peer_v_ref_phase(const Ctx& c, const unsigned char* Vt, const int* IDXT, const float* WA, float* X) {
    for (int m = c.gw; m < NTOK; m += c.ngw) {
        const int i0 = IDXT[(size_t)m * 128 + c.lane], i1 = IDXT[(size_t)m * 128 + 64 + c.lane];
        const float a0 = WA[(size_t)m * 128 + c.lane], a1 = WA[(size_t)m * 128 + 64 + c.lane];
        f32x2 acc[16];
#pragma unroll
        for (int k = 0; k < 16; ++k) acc[k] = (f32x2){0.f, 0.f};
        for (int e = 0; e < 128; ++e) {
            const int row = __shfl(e < 64 ? i0 : i1, e & 63); const float a = __shfl(e < 64 ? a0 : a1, e & 63); const f32x2 a2 = {a, a};
            const u32x4* vp = (const u32x4*)(Vt + (size_t)row * DM) + c.lane;
#pragma unroll
            for (int cc = 0; cc < 2; ++cc) { const u32x4 v = vp[64 * cc];
#pragma unroll
                for (int q = 0; q < 4; ++q) { const int w = (int)v[q];
                    acc[8 * cc + 2 * q] = __builtin_elementwise_fma(__builtin_amdgcn_cvt_pk_f32_fp8(w, false), a2, acc[8 * cc + 2 * q]);
                    acc[8 * cc + 2 * q + 1] = __builtin_elementwise_fma(__builtin_amdgcn_cvt_pk_f32_fp8(w, true), a2, acc[8 * cc + 2 * q + 1]); } }
        }
        float* xr = X + (size_t)m * DM;
#pragma unroll
        for (int cc = 0; cc < 2; ++cc) { f32x4* xp = (f32x4*)(xr + 1024 * cc + 16 * c.lane);
#pragma unroll
            for (int q = 0; q < 4; ++q) { f32x4 xa = xp[q]; xa[0] += acc[8 * cc + 2 * q].x; xa[1] += acc[8 * cc + 2 * q].y; xa[2] += acc[8 * cc + 2 * q + 1].x; xa[3] += acc[8 * cc + 2 * q + 1].y; xp[q] = xa; } }
    }
}
#endif
__device__ __forceinline__ void norm_phase(const Ctx& c, float* X, int mode, const float* g1, const float* g2, bf16* H, bf16* HKV) {
    f32x4 ga[8], gb[8]; load_g(g1, c.lane, ga); load_g(mode == 1 ? g2 : g1, c.lane, gb);
    int m = c.gw;
    f32x4 v[8]; load_row(X + (size_t)m * DM, c.lane, v);
    for (; m < NTOK; m += c.ngw) {
        const int mn = m + c.ngw < NTOK ? m + c.ngw : m;
        f32x4 nx[8]; load_row(X + (size_t)mn * DM, c.lane, nx);
        const float rstd = row_rstd(v);
        if (mode == 2) { f32x4* xo = (f32x4*)(X + (size_t)m * DM) + c.lane;
#pragma unroll
            for (int j = 0; j < 8; ++j) { f32x4 y; y[0] = v[j][0] * rstd * ga[j][0]; y[1] = v[j][1] * rstd * ga[j][1]; y[2] = v[j][2] * rstd * ga[j][2]; y[3] = v[j][3] * rstd * ga[j][3]; xo[64 * j] = y; }
        } else { store_norm_bf16_r(v, rstd, ga, H + (size_t)m * DM, c.lane); if (mode == 1) store_norm_bf16_r(v, rstd, gb, HKV + (size_t)m * DM, c.lane); }
#pragma unroll
        for (int j = 0; j < 8; ++j) v[j] = nx[j];
    }
}

__device__ __forceinline__ void rms_final_phase(const Ctx& c, float* X, const float* g) {
    for (int m = c.gw; m < NTOK; m += c.ngw) { f32x4 v[8]; load_row(X + (size_t)m * DM, c.lane, v); const float rstd = row_rstd(v);
        const f32x4* gr = (const f32x4*)g + c.lane; f32x4* xo = (f32x4*)(X + (size_t)m * DM) + c.lane;
#pragma unroll
        for (int j = 0; j < 8; ++j) { const f32x4 gv = gr[64 * j]; f32x4 y; for (int k = 0; k < 4; ++k) { y[k] = v[j][k] * rstd * gv[k]; if (!(fabsf(y[k]) < 1e30f)) y[k] = 0.f; } xo[64 * j] = y; } }
}

#ifdef DIAGBUF
__device__ __forceinline__ void diag_copy_phase(const Ctx& c, float* X, const unsigned char* ws) {
    const bf16* src = (const bf16*)(ws + (size_t)DIAGBUF);
    for (size_t i = (size_t)c.bx * 512 + c.tid; i < (size_t)NTOK * DM; i += (size_t)c.G * 512) { const size_t t = i / DM, col = i % DM; float v = bflo((unsigned)src[t * DIAGLD + col]); if (!(fabsf(v) < 1e30f)) v = 0.f; X[i] = v; }
}
#endif

__device__ __forceinline__ unsigned off_b(unsigned row, unsigned ch) { return 256u * row + 16u * (ch ^ (((row & 3u) << 2) | ((row >> 2) & 3u))); }
__device__ __forceinline__ float rowmax4(float x) {
    float a = x, b = x; asm("s_nop 1\n\tv_permlane16_swap_b32 %0, %1" : "+v"(a), "+v"(b)); x = fmaxf(a, b);
    a = x; b = x; asm("s_nop 1\n\tv_permlane32_swap_b32 %0, %1" : "+v"(a), "+v"(b)); return fmaxf(a, b);
}
constexpr int AT_K = 0, AT_V = 32768, AT_BUF = 65536, AT_BIAS = 131072, AT_HEADB = 16384;
__device__ __forceinline__ void attn_phase(const Ctx& c, const bf16* Qg, const bf16* KVg, bf16* AOg, const float* relb, int dryvar = 0) {
    LAS unsigned char* lds = c.lds; const unsigned ldsb = (unsigned)(size_t)lds;
    const int tid = c.tid, lane = c.lane, w = c.wave, hg = w >> 2, wq = w & 3, fr = lane & 15, fq = lane >> 4, tq = (lane & 15) >> 2, tp = lane & 3;
    const int tl = tid & 255, lrow = tl >> 2, lc = tl & 3;
    unsigned vadr[8];
#pragma unroll
    for (int d = 0; d < 8; ++d) vadr[d] = ldsb + AT_V + hg * AT_HEADB + off_b(4 * fq + tq, 2 * d + (tp >> 1)) + 8 * (tp & 1);
    unsigned kadr[4];
#pragma unroll
    for (int s4 = 0; s4 < 4; ++s4) kadr[s4] = ldsb + AT_K + hg * AT_HEADB + 256 * fr + 16 * (fq ^ ((fr >> 2) & 3)) + 64 * (s4 ^ (fr & 3));
    for (int u = c.bx; u < NBATCH * NCHUNK * (AH / 2); u += c.G) {
        const int hp = u & 7, ch = (u >> 3) & 63, b = u >> 9, h = 2 * hp + hg;
        const size_t tq0 = (size_t)b * SEQ + (size_t)ch * CHUNK;
        __syncthreads();
        for (int i = tid; i < 2 * 272; i += 512) { const int hh = i / 272, k = i % 272; ((LAS float*)(lds + AT_BIAS))[i] = (k < NREL) ? relb[(size_t)(2 * hp + hh) * NREL + k] * 1.4426950408889634f : 0.f; }
        bf16x8 qf[4];
        { const bf16* qp = Qg + (tq0 + 16 * wq + fr) * DM + h * AHD + 8 * fq;
#pragma unroll
          for (int s = 0; s < 4; ++s) qf[s] = *(const bf16x8*)(qp + 32 * s); }
        f32x4 O[8];
#pragma unroll
        for (int d = 0; d < 8; ++d) O[d] = (f32x4){0.f, 0.f, 0.f, 0.f};
        float mrun = -1e30f, lrun = 0.f;
        const int t0 = ch >= LEFT ? 0 : LEFT - ch;
        u32x4 pk[4], pv[4];
        { const bf16* kp = KVg + ((size_t)b * SEQ + (size_t)(ch - LEFT + t0) * CHUNK + lrow) * (2 * DM) + h * AHD;
#pragma unroll
          for (int cc = 0; cc < 4; ++cc) { pk[cc] = *(const u32x4*)(kp + (lc + 4 * cc) * 8); pv[cc] = *(const u32x4*)(kp + DM + (lc + 4 * cc) * 8); } }
        const LAS float* bias = (const LAS float*)(lds + AT_BIAS) + hg * 272;
        const float bc = relb[(size_t)h * NREL + 256] * 1.4426950408889634f;
        for (int t = t0; t <= LEFT; ++t) {
            const int pb = ((t - t0) & 1) * AT_BUF;
#pragma unroll
            for (int cc = 0; cc < 4; ++cc) { *(LAS u32x4*)(lds + pb + AT_K + hg * AT_HEADB + off_b(lrow, lc + 4 * cc)) = pk[cc]; *(LAS u32x4*)(lds + pb + AT_V + hg * AT_HEADB + off_b(lrow, lc + 4 * cc)) = pv[cc]; }
            __syncthreads();
            if (t < LEFT && dryvar != 1) { const bf16* kp = KVg + ((size_t)b * SEQ + (size_t)(ch - LEFT + t + 1) * CHUNK + lrow) * (2 * DM) + h * AHD;
#pragma unroll
                for (int cc = 0; cc < 4; ++cc) { pk[cc] = *(const u32x4*)(kp + (lc + 4 * cc) * 8); pv[cc] = *(const u32x4*)(kp + DM + (lc + 4 * cc) * 8); } }
            f32x4 sT[4];
            {
                bf16x8 kf[16];
                const unsigned k0 = kadr[0] + pb, k1 = kadr[1] + pb, k2 = kadr[2] + pb, k3 = kadr[3] + pb;
                asm volatile("ds_read_b128 %0, %16\n\tds_read_b128 %1, %17\n\tds_read_b128 %2, %18\n\tds_read_b128 %3, %19\n\t"
                             "ds_read_b128 %4, %16 offset:4096\n\tds_read_b128 %5, %17 offset:4096\n\tds_read_b128 %6, %18 offset:4096\n\tds_read_b128 %7, %19 offset:4096\n\t"
                             "ds_read_b128 %8, %16 offset:8192\n\tds_read_b128 %9, %17 offset:8192\n\tds_read_b128 %10, %18 offset:8192\n\tds_read_b128 %11, %19 offset:8192\n\t"
                             "ds_read_b128 %12, %16 offset:12288\n\tds_read_b128 %13, %17 offset:12288\n\tds_read_b128 %14, %18 offset:12288\n\tds_read_b128 %15, %19 offset:12288"
                             : "=&v"(kf[0]), "=&v"(kf[1]), "=&v"(kf[2]), "=&v"(kf[3]), "=&v"(kf[4]), "=&v"(kf[5]), "=&v"(kf[6]), "=&v"(kf[7]),
                               "=&v"(kf[8]), "=&v"(kf[9]), "=&v"(kf[10]), "=&v"(kf[11]), "=&v"(kf[12]), "=&v"(kf[13]), "=&v"(kf[14]), "=&v"(kf[15])
                             : "v"(k0), "v"(k1), "v"(k2), "v"(k3) : "memory");
                asm volatile("s_waitcnt lgkmcnt(8)" : "+v"(kf[0]), "+v"(kf[1]), "+v"(kf[2]), "+v"(kf[3]), "+v"(kf[4]), "+v"(kf[5]), "+v"(kf[6]), "+v"(kf[7]) :: "memory");
#pragma unroll
                for (int kt = 0; kt < 2; ++kt) { sT[kt] = (f32x4){0.f, 0.f, 0.f, 0.f};
#pragma unroll
                    for (int s = 0; s < 4; ++s) sT[kt] = MFMA16(kf[4 * kt + s], qf[s], sT[kt]); }
                asm volatile("s_waitcnt lgkmcnt(0)" : "+v"(kf[8]), "+v"(kf[9]), "+v"(kf[10]), "+v"(kf[11]), "+v"(kf[12]), "+v"(kf[13]), "+v"(kf[14]), "+v"(kf[15]) :: "memory");
#pragma unroll
                for (int kt = 2; kt < 4; ++kt) { sT[kt] = (f32x4){0.f, 0.f, 0.f, 0.f};
#pragma unroll
                    for (int s = 0; s < 4; ++s) sT[kt] = MFMA16(kf[4 * kt + s], qf[s], sT[kt]); }
            }
            const int dbase = (LEFT - t) * CHUNK + (16 * wq + fr);
            if (t > LEFT - 3) {
#pragma unroll
                for (int kt = 0; kt < 4; ++kt)
#pragma unroll
                    for (int r = 0; r < 4; ++r) { const int dist = dbase - (16 * kt + 4 * fq + r); sT[kt][r] += bias[min(dist, 128) + 128]; }
            }
            s16x4 vlo[2][8], vhi[2][8];
            unsigned vcur[8];
#pragma unroll
            for (int d = 0; d < 8; ++d) vcur[d] = vadr[d] + pb;
#define TR8(dst, OFF) asm volatile("ds_read_b64_tr_b16 %0, %8 offset:" #OFF "\n\tds_read_b64_tr_b16 %1, %9 offset:" #OFF "\n\tds_read_b64_tr_b16 %2, %10 offset:" #OFF "\n\tds_read_b64_tr_b16 %3, %11 offset:" #OFF "\n\t" \
                "ds_read_b64_tr_b16 %4, %12 offset:" #OFF "\n\tds_read_b64_tr_b16 %5, %13 offset:" #OFF "\n\tds_read_b64_tr_b16 %6, %14 offset:" #OFF "\n\tds_read_b64_tr_b16 %7, %15 offset:" #OFF \
                : "=&v"(dst[0]), "=&v"(dst[1]), "=&v"(dst[2]), "=&v"(dst[3]), "=&v"(dst[4]), "=&v"(dst[5]), "=&v"(dst[6]), "=&v"(dst[7]) \
                : "v"(vcur[0]), "v"(vcur[1]), "v"(vcur[2]), "v"(vcur[3]), "v"(vcur[4]), "v"(vcur[5]), "v"(vcur[6]), "v"(vcur[7]) : "memory")
            TR8(vlo[0], 0); TR8(vhi[0], 4096); TR8(vlo[1], 8192); TR8(vhi[1], 12288);
#undef TR8
            float mx = -1e30f;
            const float badd = t <= LEFT - 3 ? bc : 0.f;
#pragma unroll
            for (int kt = 0; kt < 4; ++kt)
#pragma unroll
                for (int r = 0; r < 4; ++r) { sT[kt][r] += badd; mx = fmaxf(mx, sT[kt][r]); }
            mx = rowmax4(mx);
            const float mnew = fmaxf(mrun, mx), alpha = __builtin_amdgcn_exp2f(mrun - mnew); mrun = mnew;
            float ps = 0.f;
#pragma unroll
            for (int kt = 0; kt < 4; ++kt)
#pragma unroll
                for (int r = 0; r < 4; ++r) { sT[kt][r] = __builtin_amdgcn_exp2f(sT[kt][r] - mnew); ps += sT[kt][r]; }
            lrun = lrun * alpha + ps;
#pragma unroll
            for (int d = 0; d < 8; ++d) O[d] *= alpha;
            asm volatile("s_waitcnt lgkmcnt(0)" : "+v"(vlo[0][0]), "+v"(vlo[0][1]), "+v"(vlo[0][2]), "+v"(vlo[0][3]), "+v"(vlo[0][4]), "+v"(vlo[0][5]), "+v"(vlo[0][6]), "+v"(vlo[0][7]),
                         "+v"(vhi[0][0]), "+v"(vhi[0][1]), "+v"(vhi[0][2]), "+v"(vhi[0][3]), "+v"(vhi[0][4]), "+v"(vhi[0][5]), "+v"(vhi[0][6]), "+v"(vhi[0][7]) :: "memory");
            asm volatile("" : "+v"(vlo[1][0]), "+v"(vlo[1][1]), "+v"(vlo[1][2]), "+v"(vlo[1][3]), "+v"(vlo[1][4]), "+v"(vlo[1][5]), "+v"(vlo[1][6]), "+v"(vlo[1][7]),
                         "+v"(vhi[1][0]), "+v"(vhi[1][1]), "+v"(vhi[1][2]), "+v"(vhi[1][3]), "+v"(vhi[1][4]), "+v"(vhi[1][5]), "+v"(vhi[1][6]), "+v"(vhi[1][7]) :: "memory");
            __builtin_amdgcn_sched_barrier(0);
#pragma unroll
            for (int ks = 0; ks < 2; ++ks) {
                bf16x8 pb; { const unsigned p0 = pk2(sT[2 * ks][0], sT[2 * ks][1]), p1 = pk2(sT[2 * ks][2], sT[2 * ks][3]), p2 = pk2(sT[2 * ks + 1][0], sT[2 * ks + 1][1]), p3 = pk2(sT[2 * ks + 1][2], sT[2 * ks + 1][3]);
                    const u32x4 pw = (u32x4){p0, p1, p2, p3}; pb = __builtin_bit_cast(bf16x8, pw); }
#pragma unroll
                for (int d = 0; d < 8; ++d) { bf16x8 va; va[0] = vlo[ks][d][0]; va[1] = vlo[ks][d][1]; va[2] = vlo[ks][d][2]; va[3] = vlo[ks][d][3]; va[4] = vhi[ks][d][0]; va[5] = vhi[ks][d][1]; va[6] = vhi[ks][d][2]; va[7] = vhi[ks][d][3];
                    O[d] = MFMA16(va, pb, O[d]); }
            }
        }
        float lt = lrun; lt += __shfl_xor(lt, 16); lt += __shfl_xor(lt, 32);
        const float inv = 1.0f / lt;
        bf16* op = AOg + (tq0 + 16 * wq + fr) * DM + h * AHD + 4 * fq;
#pragma unroll
        for (int d = 0; d < 8; ++d) { u32x2 ow; ow.x = pk2(O[d][0] * inv, O[d][1] * inv); ow.y = pk2(O[d][2] * inv, O[d][3] * inv); *(u32x2*)(op + 16 * d) = ow; }
    }
}

constexpr int NSTEPS = 1 + 2 * 10 + 2 * 9;
template <int MASK> __global__ void __launch_bounds__(512, 2) yoco_fwd(Params p) {
    extern __shared__ __attribute__((aligned(16))) unsigned char lds_raw[];
#define MK_CTX() Ctx c; { int t_ = threadIdx.x; asm volatile("" : "+v"(t_)); c.lds = (LAS unsigned char*)lds_raw; c.tid = t_; c.lane = t_ & 63; c.wave = __builtin_amdgcn_readfirstlane(t_ >> 6); \
        { int b_ = blockIdx.x, g_ = gridDim.x; asm volatile("" : "+s"(b_), "+s"(g_)); c.bx = b_; c.G = g_; } c.gw = c.bx * 8 + c.wave; c.ngw = c.G * 8; }
    volatile LAS unsigned* MISC = (volatile LAS unsigned*)((LAS unsigned char*)lds_raw + LDS_MISC);
    if (threadIdx.x < 4) MISC[threadIdx.x] = 0u;
    __syncthreads();
    XcdBarrier bar; bar.bar = (unsigned*)(p.ws + WS_CTL); bar.x = 0; bar.st = MISC;
    if (p.hi - p.lo > 1) bar = xcd_barrier_post((unsigned*)(p.ws + WS_CTL), MISC);
    unsigned char* ws = p.ws;
    bf16* const H = (bf16*)(ws + WS_H); bf16* const HKV = (bf16*)(ws + WS_HKV);
    float* const X = p.out;
    int s = 0;
#ifndef REPMASK
#define REPMASK 0
#endif
#define KF_(f) p.f = kq_->f;
#define MK_P() Params p; { unsigned long long ka_ = (unsigned long long)__builtin_amdgcn_kernarg_segment_ptr(); asm volatile("" : "+s"(ka_)); const __attribute__((address_space(4))) Params* kq_ = (const __attribute__((address_space(4))) Params*)ka_; \
        KF_(x) KF_(ln_mix) KF_(ln_ffn) KF_(ret_w_in) KF_(ret_w_out) KF_(ret_gn) KF_(kv_norm) KF_(w_kv) KF_(att_w_q) KF_(att_w_o) KF_(att_rel_bias) KF_(peer_w_q) KF_(peer_sub_keys) KF_(peer_u) KF_(peer_v) KF_(ln_final) \
        KF_(out) KF_(ws) KF_(lo) KF_(hi) } \
        unsigned char* const ws = p.ws; bf16* const H = (bf16*)(ws + WS_H); bf16* const HKV = (bf16*)(ws + WS_HKV); float* const X = p.out; (void)H; (void)HKV; (void)X;
#define BEGIN_STEP(k) if (((MASK >> (k)) & 1) && s >= p.lo && s < p.hi) { for (int rep_ = ((REPMASK >> (k)) & 1) ? 0 : 1; rep_ < 2; ++rep_) { MK_CTX(); MK_P();
#define END_STEP   if (rep_ == 0 || s + 1 < p.hi) xcd_barrier(bar); } } ++s;

    BEGIN_STEP(0) p0_prologue(p, c); END_STEP

    for (int l = 0; l < DEPTH; ++l) {
        if (l < 2) {
            BEGIN_STEP(1)
                pg8::Gemm g{H, (const bf16*)(ws + WS_WIN) + (size_t)l * RIN * DM, NTOK, RIN, DM}; pg8::StaticOrder S; S.init(NTOK, RIN, c.G, c.bx);
                pg8::EpiProj E{(bf16*)(ws + WS_Q), (bf16*)(ws + WS_K), (bf16*)(ws + WS_V), (bf16*)(ws + WS_G), (const float*)(ws + WS_ROT)};
                pg8::gemm_phase<pg8::EpiProj, pg8::StaticOrder>(c.lds, g, S, E, nullptr);
            END_STEP
            BEGIN_STEP(2)
                for (int u = c.bx; u < 256; u += c.G) ret_scan_unit(c, (const bf16*)(ws + WS_Q), (const bf16*)(ws + WS_K), (const bf16*)(ws + WS_V), (bf16*)(ws + WS_O), u);
            END_STEP
            BEGIN_STEP(3)
                ret_gate_phase(c, (const bf16*)(ws + WS_O), (bf16*)(ws + WS_G), p.ret_gn + (size_t)l * RVW, rep_ == 0 ? (bf16*)(ws + WS_SC) : nullptr);
            END_STEP
        } else {
            BEGIN_STEP(4)
                for (int pass = (l == 2 ? 0 : 1); pass < 2; ++pass) {
                    const int N = pass ? DM : 2 * DM;
                    pg8::Gemm g{pass ? H : HKV, pass ? (const bf16*)(ws + WS_WQ) + (size_t)(l - 2) * DM * DM : (const bf16*)(ws + WS_WKV), NTOK, N, DM}; pg8::StaticOrder S; S.init(NTOK, N, c.G, c.bx);
                    pg8::EpiBf16S E{pass ? (bf16*)(ws + WS_Q) : (bf16*)(ws + WS_KV), N, pass ? 0.12751743082459868f : 1.0f};
                    pg8::gemm_phase<pg8::EpiBf16S, pg8::StaticOrder>(c.lds, g, S, E, nullptr);
                }
            END_STEP
            BEGIN_STEP(5)
#ifdef ATTNDRY
                attn_phase(c, (const bf16*)(ws + WS_Q), (const bf16*)(ws + WS_KV), rep_ == 0 ? (bf16*)(ws + WS_O) : (bf16*)(ws + WS_AO), p.att_rel_bias + (size_t)(l - 2) * AH * NREL, rep_ == 0 ? ATTNDRY : 0);
#else
                attn_phase(c, (const bf16*)(ws + WS_Q), (const bf16*)(ws + WS_KV), (bf16*)(ws + WS_AO), p.att_rel_bias + (size_t)(l - 2) * AH * NREL);
#endif
            END_STEP
        }
        BEGIN_STEP(6)
            const int K = l < 2 ? RVW : DM;
            pg8::Gemm g{l < 2 ? (const bf16*)(ws + WS_G) : (const bf16*)(ws + WS_AO), l < 2 ? (const bf16*)(ws + WS_WOUT) + (size_t)l * DM * RVW : (const bf16*)(ws + WS_WO) + (size_t)(l - 2) * DM * DM, NTOK, DM, K};
            pg8::StaticOrder S; S.init(NTOK, DM, c.G, c.bx);
            pg8::EpiRes E{X, DM, H, p.ln_ffn + (size_t)l * DM, (float*)(ws + WS_SQP)};
            pg8::gemm_phase<pg8::EpiRes, pg8::StaticOrder>(c.lds, g, S, E, nullptr);
        END_STEP
        BEGIN_STEP(8)
            pg8::Gemm g{H, (const bf16*)(ws + WS_WC) + (size_t)l * DM * DM, NTOK, DM, DM}; pg8::StaticOrder S; S.init(NTOK, DM, c.G, c.bx);
            pg8::EpiF32 E{(float*)(ws + WS_SC), DM};
            pg8::gemm_phase<pg8::EpiF32, pg8::StaticOrder>(c.lds, g, S, E, nullptr);
        END_STEP
        BEGIN_STEP(9)
            peer_topk_phase(c, (const float*)(ws + WS_SC), (int*)(ws + WS_IDX), (float*)(ws + WS_WGT), (const float*)(ws + WS_SQP), (float*)(ws + WS_RSTD));
        END_STEP
        BEGIN_STEP(10)
#ifdef DRYIDXMASK
            peer_u_phase(c, H, ws + WS_PU + (size_t)l * PE * DM, (const int*)(ws + WS_IDX), (float*)(ws + WS_SC), rep_ == 0 ? DRYIDXMASK : 0xffffffffu);
#else
            peer_u_phase(c, H, ws + WS_PU + (size_t)l * PE * DM, (const int*)(ws + WS_IDX), (float*)(ws + WS_SC));
#endif
        END_STEP
        BEGIN_STEP(11)
            peer_a_phase(c, (const float*)(ws + WS_SC), (const int*)(ws + WS_IDX), (float*)(ws + WS_WGT), (const float*)(ws + WS_RS) + (size_t)l * PE, (const float*)(ws + WS_RS) + (size_t)(DEPTH + l) * PE, (const float*)(ws + WS_RSTD));
        END_STEP
        BEGIN_STEP(12)
#ifdef VREF
            peer_v_ref_phase(c, ws + WS_PV + (size_t)l * PE * DM, (const int*)(ws + WS_IDX), (const float*)(ws + WS_WGT), X);
#else
            peer_v_phase(c, ws + WS_PV + (size_t)l * PE * DM, (const int*)(ws + WS_IDX), (const float*)(ws + WS_WGT), X);
#endif
        END_STEP
        BEGIN_STEP(13)
            const int mode = (l == DEPTH - 1) ? 2 : (l == 1 ? 1 : 0);
            norm_phase(c, X, mode, mode == 2 ? p.ln_final : p.ln_mix + (size_t)(l + 1) * DM, p.kv_norm, H, HKV);
        END_STEP
    }
#ifdef DIAGBUF
    if ((MASK >> 14) & 1) { MK_CTX(); diag_copy_phase(c, X, ws); }
#else
    if ((MASK >> 14) & 1) { MK_CTX(); MK_P(); rms_final_phase(c, X, p.ln_final); }
#endif
#undef BEGIN_STEP
#undef END_STEP
}

#ifndef N_LAUNCH_CUT
#define N_LAUNCH_CUT 1
#endif
typedef void (*kern_t)(Params);
template <int SITE> static void launch_site(const Params& p, hipStream_t stream) {
    static bool attr = false;
    if (!attr) { (void)hipFuncSetAttribute((const void*)yoco_fwd<(1 << SITE)>, hipFuncAttributeMaxDynamicSharedMemorySize, LDS_BYTES); attr = true; }
    hipLaunchKernelGGL((yoco_fwd<(1 << SITE)>), dim3(256), dim3(512), LDS_BYTES, stream, p);
}
#ifndef MEGASITES
#define MEGASITES 0
#endif
static void launch_step_site(int site, const Params& p, hipStream_t stream) {
    if ((MEGASITES >> site) & 1) { hipLaunchKernelGGL((yoco_fwd<0x3FFF>), dim3(256), dim3(512), LDS_BYTES, stream, p); return; }
    switch (site) {
        case 0: launch_site<0>(p, stream); break; case 1: launch_site<1>(p, stream); break; case 2: launch_site<2>(p, stream); break; case 3: launch_site<3>(p, stream); break;
        case 4: launch_site<4>(p, stream); break; case 5: launch_site<5>(p, stream); break; case 6: launch_site<6>(p, stream); break; case 7: launch_site<7>(p, stream); break;
        case 8: launch_site<8>(p, stream); break; case 9: launch_site<9>(p, stream); break; case 10: launch_site<10>(p, stream); break; case 11: launch_site<11>(p, stream); break; case 12: launch_site<12>(p, stream); break; case 13: launch_site<13>(p, stream); break; default: launch_site<14>(p, stream); break;
    }
}
extern "C" void kernel_launch(void* const* d_in, const int* in_sizes, int n_in, void* d_out, int out_size, void* d_ws, size_t ws_size, hipStream_t stream) {
    static int ready = 0;
    if (ready == 0) {
        if (n_in != 16 || out_size != NTOK * DM || ws_size < WS_END) { fprintf(stderr, "kernel_launch: unexpected sizes (n_in %d out %d ws %zu, need %zu)\n", n_in, out_size, ws_size, (size_t)WS_END); ready = -1; return; }
#if N_LAUNCH_CUT || MEGASITES
        if (hipFuncSetAttribute((const void*)yoco_fwd<0x3FFF>, hipFuncAttributeMaxDynamicSharedMemorySize, LDS_BYTES) != hipSuccess) { fprintf(stderr, "kernel_launch: hipFuncSetAttribute failed\n"); ready = -1; return; }
#endif
        ready = 1;
    }
    if (ready < 0) return;
    (void)hipMemsetAsync(d_ws, 0, 16384, stream);
    Params p{};
    p.x = (const float*)d_in[0]; p.ln_mix = (const float*)d_in[1]; p.ln_ffn = (const float*)d_in[2]; p.ret_w_in = (const float*)d_in[3]; p.ret_w_out = (const float*)d_in[4]; p.ret_gn = (const float*)d_in[5];
    p.kv_norm = (const float*)d_in[6]; p.w_kv = (const float*)d_in[7]; p.att_w_q = (const float*)d_in[8]; p.att_w_o = (const float*)d_in[9]; p.att_rel_bias = (const float*)d_in[10];
    p.peer_w_q = (const float*)d_in[11]; p.peer_sub_keys = (const float*)d_in[12]; p.peer_u = (const float*)d_in[13]; p.peer_v = (const float*)d_in[14]; p.ln_final = (const float*)d_in[15];
    p.out = (float*)d_out; p.ws = (unsigned char*)d_ws;
#if N_LAUNCH_CUT == 2
    for (int s2 = 0; s2 < NSTEPS; ++s2) { p.lo = s2; p.hi = s2 + 1; hipLaunchKernelGGL((yoco_fwd<0x3FFF>), dim3(256), dim3(512), LDS_BYTES, stream, p); }
#elif N_LAUNCH_CUT
    p.lo = 0; p.hi = NSTEPS;
    hipLaunchKernelGGL((yoco_fwd<0x3FFF>), dim3(256), dim3(512), LDS_BYTES, stream, p);
#else
    static const int siteA[10] = {1, 2, 3, 6, 8, 9, 10, 11, 12, 13}, siteB[9] = {4, 5, 6, 8, 9, 10, 11, 12, 13};
    int s = 0;
#ifndef NSTOP
#define NSTOP 1000
#endif
    p.lo = s; p.hi = s + 1; launch_step_site(0, p, stream); ++s;
    for (int l = 0; l < DEPTH; ++l) { const int n = l < 2 ? 10 : 9; for (int k = 0; k < n; ++k) { p.lo = s; p.hi = s + 1; if (s < NSTOP) launch_step_site(l < 2 ? siteA[k] : siteB[k], p, stream); ++s; } }
    if (NSTOP < NSTEPS) { p.lo = -1; p.hi = -1; launch_step_site(14, p, stream); }
#endif
}
```

```cpp
#include <hip/hip_runtime.h>
#include <cstdio>
#include <cstdint>

#define LAS __attribute__((address_space(3)))
#define GAS __attribute__((address_space(1)))
typedef unsigned short bf16;
typedef unsigned u32x2 __attribute__((ext_vector_type(2)));
typedef float f32x2v __attribute__((ext_vector_type(2)));

constexpr int DM = 2048, NBATCH = 4, SEQ = 4096, NTOK = NBATCH * SEQ, DEPTH = 4;
constexpr int CHUNK = 64, NCHUNK = SEQ / CHUNK;
constexpr int RH = 8, RQK = 256, RV = 512, RQKW = RH * RQK, RVW = RH * RV, RIN = 2 * RQKW + 2 * RVW;
constexpr int AH = 16, AHD = 128, LEFT = 8, NREL = 257;
constexpr int PH = 8, PNK = 128, PE = PNK * PNK, PTOPK = 16;
constexpr float EPS = 1e-6f;

constexpr size_t MiB = 1ull << 20;
constexpr size_t WS_CTL = 0, CTL_BYTES = 1 * MiB;
constexpr size_t WS_ROT = 1 * MiB;
constexpr size_t WS_RS = 6 * MiB;
constexpr size_t WS_WIN = 8 * MiB;
constexpr size_t WS_WOUT = 104 * MiB;
constexpr size_t WS_WKV = 136 * MiB;
constexpr size_t WS_WQ = 152 * MiB;
constexpr size_t WS_WO = 168 * MiB;
constexpr size_t WS_WC = 184 * MiB;
constexpr size_t WS_PU = 216 * MiB;
constexpr size_t WS_PV = 472 * MiB;
constexpr size_t WS_H = 728 * MiB;
constexpr size_t WS_HKV = 792 * MiB;
constexpr size_t WS_Q = 856 * MiB;
constexpr size_t WS_K = 920 * MiB;
constexpr size_t WS_V = 984 * MiB;
constexpr size_t WS_G = 1112 * MiB;
constexpr size_t WS_O = 1240 * MiB;
constexpr size_t WS_KV = 1368 * MiB;
constexpr size_t WS_AO = 1496 * MiB;
constexpr size_t WS_SC = 1560 * MiB;
constexpr size_t WS_IDX = 1688 * MiB;
constexpr size_t WS_WGT = 1696 * MiB;
constexpr size_t WS_SQP = 1704 * MiB;
constexpr size_t WS_RSTD = 1706 * MiB;
constexpr size_t WS_END = 1708 * MiB;

constexpr int LDS_BYTES = 160 * 1024;
constexpr int LDS_MISC = LDS_BYTES - 256;

__device__ __forceinline__ unsigned f2bf(float f) { unsigned u = __builtin_bit_cast(unsigned, f); return (u + 0x7fffu + ((u >> 16) & 1u)) >> 16; }
typedef __bf16 bfx2_t __attribute__((ext_vector_type(2)));
__device__ __forceinline__ unsigned pk2(float lo, float hi) { const f32x2v v = {lo, hi}; return __builtin_bit_cast(unsigned, __builtin_convertvector(v, bfx2_t)); }
__device__ __forceinline__ float bflo(unsigned u) { return __builtin_bit_cast(float, u << 16); }
__device__ __forceinline__ float bfhi(unsigned u) { return __builtin_bit_cast(float, u & 0xffff0000u); }
__device__ __forceinline__ float wave_sum(float v) {
#pragma unroll
    for (int o = 1; o < 64; o <<= 1) v += __shfl_xor(v, o);
    return v;
}
#define VM_WAIT() asm volatile("s_waitcnt vmcnt(0)" ::: "memory")
#define LDS_WAIT() asm volatile("s_waitcnt lgkmcnt(0)" ::: "memory")

#define XB_TMO      128
#define XB_XCNT(j)  (256  + 64 * (j))
#define XB_XSUB(j)  (1280 + 64 * (j))
#define XB_XGEN(j)  (2304 + 64 * (j))
#define XB_TOP      3328
#define XB_TOPGEN   3392
#define XCD_BAR_WORDS 3456
#define XB_SPIN_CAP (1u << 18)

__device__ __forceinline__ unsigned xb_ld(unsigned* p)              { return __hip_atomic_load(p, __ATOMIC_RELAXED, __HIP_MEMORY_SCOPE_AGENT); }
__device__ __forceinline__ unsigned xb_add(unsigned* p, unsigned v) { return __hip_atomic_fetch_add(p, v, __ATOMIC_RELAXED, __HIP_MEMORY_SCOPE_AGENT); }
__device__ __forceinline__ unsigned xb_xcc_id() { return (unsigned)__builtin_amdgcn_s_getreg((3 << 11) | 20) & 0xFu; }
#define XB_SPIN(cond, bar) do { unsigned _sp = 0; while (cond) { __builtin_amdgcn_s_sleep(1); \
    if ((++_sp & 255u) == 0u) { if (xb_ld(&(bar)[XB_TMO])) break; if (_sp > XB_SPIN_CAP) { atomicAdd(&(bar)[XB_TMO], 1u); break; } } } } while (0)

struct XcdBarrier {
    unsigned* bar; unsigned x;
    volatile LAS unsigned* st;
};

__device__ __forceinline__ XcdBarrier xcd_barrier_post(unsigned* bar, volatile LAS unsigned* st) {
    XcdBarrier b; b.bar = bar; b.x = xb_xcc_id(); b.st = st;
    if (threadIdx.x == 0) (void)xb_add(&bar[XB_XCNT(b.x)], 1u);
    return b;
}
__device__ __forceinline__ void xcd_barrier_complete(unsigned* bar, unsigned x, unsigned& nloc, unsigned& nx) {
    const unsigned G = gridDim.x * gridDim.y * gridDim.z;
    unsigned sum, cnt, mine, sp = 0u;
    for (;;) {
        sum = 0u; cnt = 0u; mine = 0u;
#pragma unroll
        for (unsigned j = 0; j < 16; ++j) { const unsigned c = xb_ld(&bar[XB_XCNT(j)]); sum += c; cnt += (c > 0u) ? 1u : 0u; mine = (j == x) ? c : mine; }
        if (sum == G) break;
        __builtin_amdgcn_s_sleep(1);
        if ((++sp & 255u) == 0u) { if (xb_ld(&bar[XB_TMO])) break; if (sp > XB_SPIN_CAP) { atomicAdd(&bar[XB_TMO], 1u); break; } }
    }
    nloc = mine > 0u ? mine : 1u; nx = cnt > 0u ? cnt : 1u;
}

__device__ __forceinline__ void xcd_barrier(const XcdBarrier& b) {
    asm volatile("s_waitcnt vmcnt(0)" ::: "memory");
    __syncthreads();
    if (threadIdx.x == 0) {
        unsigned* bar = b.bar;
        __builtin_amdgcn_s_waitcnt(0);
        unsigned nloc = b.st[0], nx = b.st[1];
        if (nloc == 0u) { xcd_barrier_complete(bar, b.x, nloc, nx); b.st[0] = nloc; b.st[1] = nx; }
        const unsigned old = xb_add(&bar[XB_XSUB(b.x)], 1u);
        const unsigned gen = old / nloc;
        if (old + 1u == (gen + 1u) * nloc) {
            __builtin_amdgcn_fence(__ATOMIC_RELEASE, "agent");
            asm volatile("s_waitcnt vmcnt(0)" ::: "memory");
            const unsigned og = xb_add(&bar[XB_TOP], 1u);
            const unsigned tg = og / nx;
            if (og + 1u == (tg + 1u) * nx) xb_add(&bar[XB_TOPGEN], 1u);
            else XB_SPIN(xb_ld(&bar[XB_TOPGEN]) == tg, bar);
            __builtin_amdgcn_fence(__ATOMIC_ACQUIRE, "agent");
            xb_add(&bar[XB_XGEN(b.x)], 1u);
            asm volatile("s_waitcnt vmcnt(0)" ::: "memory");
        } else {
            XB_SPIN(xb_ld(&bar[XB_XGEN(b.x)]) == gen, bar);
            __builtin_amdgcn_fence(__ATOMIC_ACQUIRE, "agent");
            asm volatile("s_waitcnt vmcnt(0)" ::: "memory");
        }
    }
    __syncthreads();
}

namespace pg8 {
#define PG8_LAS __attribute__((address_space(3)))
typedef unsigned short bf16_t;
typedef short bf16x8 __attribute__((ext_vector_type(8)));
typedef float f32x4 __attribute__((ext_vector_type(4)));
typedef unsigned u32x4 __attribute__((ext_vector_type(4)));
constexpr int BM = 256, BK = 64, HALF = 128, HTB = HALF * BK * 2  , STAGE_BYTES = 8 * HTB, NXCD = 8, WGM = 8;

__host__ __device__ __forceinline__ int lds_byte(int r, int c) { const int st = (r >> 4) * 2 + (c >> 5), rr = r & 15, cc = c & 31, ob = rr * 64 + cc * 2; return st * 1024 + (ob ^ (((ob >> 9) & 1) << 5)); }
__host__ __device__ __forceinline__ void stage_rc(int b, int& R, int& C) { const int st = b / 1024, sb = b % 1024, swz = sb ^ (((sb >> 9) & 1) << 5); R = (st >> 1) * 16 + swz / 64; C = (st & 1) * 32 + (swz % 64) / 2; }
__host__ __device__ __forceinline__ int perm32(int rho) { const int n = rho >> 4, i = rho & 15; return 8 * (i >> 2) + 4 * n + (i & 3); }

struct Unit { int pm, pn; };
struct Gemm { const bf16_t* A; const bf16_t* Bt; int M, N, K; };

struct StaticOrder {
    int nM, nN, nwg, G, c;
    __host__ __device__ void init(int M, int N, int G_, int c_) { nM = M / BM; nN = N / BM; nwg = nM * nN; G = G_; c = c_; }
    __host__ __device__ bool next(int i, Unit& u) const {
        const long L = (long)i * G + c; if (L >= nwg) return false;
        int wgid = (int)L; { const int q = nwg / NXCD, r = nwg % NXCD, xcd = wgid % NXCD, off = wgid / NXCD; wgid = (xcd < r ? xcd * (q + 1) : r * (q + 1) + (xcd - r) * q) + off; }
        const int nig = WGM * nN, gid = wgid / nig, fm = gid * WGM, gsz = (nM - fm) < WGM ? (nM - fm) : WGM;
        u.pm = fm + ((wgid % nig) % gsz); u.pn = (wgid % nig) / gsz; return true;
    }
    __device__ __forceinline__ void a_ready(const Unit&) const {}
    __device__ __forceinline__ void done(const Unit&) const {}
};
struct CountedOrder : StaticOrder {
    const unsigned* ready; unsigned need; unsigned* tmo;
    __device__ __forceinline__ void a_ready(const Unit& u) const {
        if (threadIdx.x < 64) {
            const unsigned long long t0 = __builtin_amdgcn_s_memrealtime(); unsigned polls = 0;
            while ((unsigned)__builtin_amdgcn_readfirstlane(__hip_atomic_load(ready + 64 * u.pm, __ATOMIC_RELAXED, __HIP_MEMORY_SCOPE_AGENT)) < need) {
                if ((++polls & 255u) == 0u && __builtin_amdgcn_readfirstlane(__hip_atomic_load(tmo, __ATOMIC_RELAXED, __HIP_MEMORY_SCOPE_AGENT)) != 0u) break;
                if (__builtin_amdgcn_s_memrealtime() - t0 > 2000000ull) {
                    if (threadIdx.x == 0) { unsigned expect = 0u; __hip_atomic_compare_exchange_strong(tmo + 1, &expect, 0x600u | (unsigned)(u.pm & 0xff), __ATOMIC_RELAXED, __ATOMIC_RELAXED, __HIP_MEMORY_SCOPE_AGENT); __hip_atomic_store(tmo, 1u, __ATOMIC_RELAXED, __HIP_MEMORY_SCOPE_AGENT); }
                    break; }
                __builtin_amdgcn_s_sleep(2); }
            __builtin_amdgcn_fence(__ATOMIC_ACQUIRE, "agent");
            asm volatile("s_waitcnt vmcnt(0)" ::: "memory");
        }
#if !defined(BROKEN_HOOK_NO_BARRIER)
        asm volatile("" ::: "memory"); __builtin_amdgcn_s_barrier(); asm volatile("" ::: "memory");
#endif
    }
};

__device__ __forceinline__ unsigned cvt_pk_bf16(float lo, float hi) { return pk2(lo, hi); }
typedef float f32x2 __attribute__((ext_vector_type(2)));
__device__ __forceinline__ f32x2 gelu_pk(f32x2 v) {
    const f32x2 av = __builtin_elementwise_abs(v), d = av * 0.2316418882f + 1.0f;
    f32x2 t; t.x = __builtin_amdgcn_rcpf(d.x); t.y = __builtin_amdgcn_rcpf(d.y);
    f32x2 q = t * 0.5307027145f + (-0.7265760135f); q = q * t + 0.7107068705f; q = q * t + (-0.142248368f); q = q * t + 0.127414796f; q = q * t;
    const f32x2 s = (v * v) * (-0.72134752044f);
    f32x2 e; e.x = __builtin_amdgcn_exp2f(s.x); e.y = __builtin_amdgcn_exp2f(s.y);
    const f32x2 m = v * (q * e), r = v - m;
    f32x2 o; o.x = v.x < 0.f ? m.x : r.x; o.y = v.y < 0.f ? m.y : r.y; return o;
}


struct EpiF32 {
    static constexpr bool PERM = false, AFTER_DRAIN = false;
    float* C; int ldc;
    __device__ __forceinline__ void operator()(const f32x4 (&acc)[2][2][4][2], const Unit& u, int wr, int wc, int fr, int fq) const {
        const int row0 = u.pm * BM + wr * 64 + fr, col0 = u.pn * BM + wc * 32 + 4 * fq;
#pragma unroll
        for (int ai = 0; ai < 2; ++ai)
#pragma unroll
            for (int m = 0; m < 4; ++m) { float* rowp = C + (size_t)(row0 + ai * HALF + m * 16) * ldc + col0;
#pragma unroll
                for (int bj = 0; bj < 2; ++bj)
#pragma unroll
                    for (int n = 0; n < 2; ++n) *(f32x4*)(rowp + bj * HALF + n * 16) = acc[ai][bj][m][n]; }
    }
};
struct EpiRes {
    static constexpr bool PERM = false, AFTER_DRAIN = false;
    float* X; int ldc; bf16_t* Hn; const float* gn; float* sqp;
    __device__ __forceinline__ void operator()(const f32x4 (&acc)[2][2][4][2], const Unit& u, int wr, int wc, int fr, int fq) const {
        const int row0 = u.pm * BM + wr * 64 + fr, col0 = u.pn * BM + wc * 32 + 4 * fq;
        f32x4 gv[2][2];
#pragma unroll
        for (int bj = 0; bj < 2; ++bj)
#pragma unroll
            for (int n = 0; n < 2; ++n) gv[bj][n] = *(const f32x4*)(gn + col0 + bj * HALF + n * 16);
#pragma unroll
        for (int ai = 0; ai < 2; ++ai) {
            f32x4 old[4][2][2];
#pragma unroll
            for (int m = 0; m < 4; ++m) { const float* rp = X + (size_t)(row0 + ai * HALF + m * 16) * ldc + col0;
#pragma unroll
                for (int bj = 0; bj < 2; ++bj)
#pragma unroll
                    for (int n = 0; n < 2; ++n) old[m][bj][n] = *(const f32x4*)(rp + bj * HALF + n * 16); }
#pragma unroll
            for (int m = 0; m < 4; ++m) { const int r = row0 + ai * HALF + m * 16; float* rowp = X + (size_t)r * ldc + col0; bf16_t* hp = Hn + (size_t)r * ldc + col0;
                float ss = 0.f;
#pragma unroll
                for (int bj = 0; bj < 2; ++bj)
#pragma unroll
                    for (int n = 0; n < 2; ++n) { const f32x4 xn = old[m][bj][n] + acc[ai][bj][m][n]; *(f32x4*)(rowp + bj * HALF + n * 16) = xn;
                        ss += (xn[0] * xn[0] + xn[1] * xn[1]) + (xn[2] * xn[2] + xn[3] * xn[3]);
                        const f32x4 hg = xn * gv[bj][n]; u32x2 hw; hw.x = pk2(hg[0], hg[1]); hw.y = pk2(hg[2], hg[3]); *(u32x2*)(hp + bj * HALF + n * 16) = hw; }
                ss += __shfl_xor(ss, 16); ss += __shfl_xor(ss, 32);
                if (fq == 0) sqp[(size_t)r * 32 + u.pn * 4 + wc] = ss; }
        }
    }
};
struct EpiBf16S {
    static constexpr bool PERM = true, AFTER_DRAIN = false;
    bf16_t* O; int ldc; float scale;
    __device__ __forceinline__ void operator()(const f32x4 (&acc)[2][2][4][2], const Unit& u, int wr, int wc, int fr, int fq) const {
        const int row0 = u.pm * BM + wr * 64 + fr, col0 = u.pn * BM + wc * 32 + 8 * fq;
#pragma unroll
        for (int ai = 0; ai < 2; ++ai)
#pragma unroll
            for (int m = 0; m < 4; ++m) { bf16_t* rowp = O + (size_t)(row0 + ai * HALF + m * 16) * ldc + col0;
#pragma unroll
                for (int bj = 0; bj < 2; ++bj) { const f32x4 v0 = acc[ai][bj][m][0] * scale, v1 = acc[ai][bj][m][1] * scale;
                    u32x4 w; w.x = cvt_pk_bf16(v0[0], v0[1]); w.y = cvt_pk_bf16(v0[2], v0[3]); w.z = cvt_pk_bf16(v1[0], v1[1]); w.w = cvt_pk_bf16(v1[2], v1[3]);
                    *(u32x4*)(rowp + bj * HALF) = w; } }
    }
};
struct EpiProj {
    static constexpr bool PERM = true, AFTER_DRAIN = false;
    bf16_t *Q, *Kp, *V, *G; const float* rot;
    __device__ __forceinline__ void operator()(const f32x4 (&acc)[2][2][4][2], const Unit& u, int wr, int wc, int fr, int fq) const {
        const int row0 = u.pm * BM + wr * 64 + fr, pn = u.pn, dd0 = wc * 32 + 8 * fq;
        if (pn < 16) {
            bf16_t* base = (pn < 8 ? Q : Kp) + (pn & 7) * 256 + dd0; const float sc = pn < 8 ? 1.0f : 0.0625f;
#pragma unroll
            for (int ai = 0; ai < 2; ++ai)
#pragma unroll
                for (int m = 0; m < 4; ++m) { const int r = row0 + ai * HALF + m * 16; const float* rt = rot + (size_t)(r & (4096 - 1)) * 256 + dd0;
                    f32x4 o1[2], o2[2];
#pragma unroll
                    for (int n = 0; n < 2; ++n) { const f32x4 cs = *(const f32x4*)(rt + 4 * n), sn = *(const f32x4*)(rt + 128 + 4 * n); const f32x4 t1 = acc[ai][0][m][n], t2 = acc[ai][1][m][n];
                        o1[n] = (t1 * cs - t2 * sn) * sc; o2[n] = (t1 * sn + t2 * cs) * sc; }
                    u32x4 w1, w2;
                    w1.x = cvt_pk_bf16(o1[0][0], o1[0][1]); w1.y = cvt_pk_bf16(o1[0][2], o1[0][3]); w1.z = cvt_pk_bf16(o1[1][0], o1[1][1]); w1.w = cvt_pk_bf16(o1[1][2], o1[1][3]);
                    w2.x = cvt_pk_bf16(o2[0][0], o2[0][1]); w2.y = cvt_pk_bf16(o2[0][2], o2[0][3]); w2.z = cvt_pk_bf16(o2[1][0], o2[1][1]); w2.w = cvt_pk_bf16(o2[1][2], o2[1][3]);
                    bf16_t* rowp = base + (size_t)r * 2048; *(u32x4*)rowp = w1; *(u32x4*)(rowp + 128) = w2; }
        } else {
            bf16_t* base = (pn < 32 ? V : G) + ((pn - 16) & 15) * 256 + dd0;
#pragma unroll
            for (int ai = 0; ai < 2; ++ai)
#pragma unroll
                for (int m = 0; m < 4; ++m) { bf16_t* rowp = base + (size_t)(row0 + ai * HALF + m * 16) * 4096;
#pragma unroll
                    for (int bj = 0; bj < 2; ++bj) { const f32x4 v0 = acc[ai][bj][m][0], v1 = acc[ai][bj][m][1];
                        u32x4 w; w.x = cvt_pk_bf16(v0[0], v0[1]); w.y = cvt_pk_bf16(v0[2], v0[3]); w.z = cvt_pk_bf16(v1[0], v1[1]); w.w = cvt_pk_bf16(v1[2], v1[3]);
                        *(u32x4*)(rowp + bj * HALF) = w; } }
        }
    }
};
template <class Epi, class Sched, bool STAMP = false>
__device__ __forceinline__ void gemm_phase(PG8_LAS unsigned char* lds, const Gemm g, const Sched& S, const Epi& E, unsigned long long* stamps) {
    int tid_ = threadIdx.x; asm volatile("" : "+v"(tid_));
    const int tid = tid_, wid = __builtin_amdgcn_readfirstlane(tid >> 6), lane = tid & 63, wr = wid >> 2, wc = wid & 3, fr = lane & 15, fq = lane >> 4;
    const int K = g.K, nt = K / BK;
    int ts_lo = 0, ts_hi = 0, nts = 0; const unsigned long long rt_entry = STAMP ? (unsigned long long)wall_clock64() : 0ull;
#define PG8_STAMP() do { if (STAMP && wid == 0 && nts < 64) { const unsigned long long _c = (unsigned long long)clock64(); \
        ts_lo = (lane == nts) ? (int)(unsigned)_c : ts_lo; ts_hi = (lane == nts) ? (int)(unsigned)(_c >> 32) : ts_hi; ++nts; } } while (0)
    PG8_STAMP();
    unsigned voffA[2], voffB[2];
#pragma unroll
    for (int i = 0; i < 2; ++i) { int R, C; stage_rc(tid * 16 + i * 8192, R, C); const int Rb = Epi::PERM ? ((R & ~31) + perm32(R & 31)) : R;
        voffA[i] = (unsigned)(R * K + C) * 2u; voffB[i] = (unsigned)(Rb * K + C) * 2u; }
    const size_t kstep = (size_t)(BK * 2);
    const size_t hstep = (size_t)HALF * K * 2;
    const size_t tstep = 2 * hstep;
    const unsigned ldsw = (unsigned)wid * 1024u;
    const int aoff = lds_byte(wr * 64 + fr, fq * 8), boff = lds_byte(wc * 32 + fr, fq * 8);
#define PG8_SA(b, h) (((b) * 2 + (h)) * HTB)
#define PG8_SB(b, h) ((4 + (b) * 2 + (h)) * HTB)
#define PG8_STAGE(bufoff, gbase, voff) do { _Pragma("unroll") for (int _i = 0; _i < 2; ++_i) \
        __builtin_amdgcn_global_load_lds((const unsigned*)((const char*)(gbase) + (voff)[_i]), (PG8_LAS unsigned*)(lds + (bufoff) + ldsw + _i * 8192), 16, 0, 0); } while (0)
#define PG8_LDA(dst, b, h) do { _Pragma("unroll") for (int m = 0; m < 4; ++m) _Pragma("unroll") for (int k = 0; k < 2; ++k) dst[m][k] = *(const PG8_LAS bf16x8*)(lds + PG8_SA(b, h) + aoff + m * 2048 + k * 1024); } while (0)
#define PG8_LDB(dst, b, h) do { _Pragma("unroll") for (int n = 0; n < 2; ++n) _Pragma("unroll") for (int k = 0; k < 2; ++k) dst[n][k] = *(const PG8_LAS bf16x8*)(lds + PG8_SB(b, h) + boff + n * 2048 + k * 1024); } while (0)
#define PG8_MMA(ai, bj, At, Bt) do { __builtin_amdgcn_s_setprio(1); _Pragma("unroll") for (int m = 0; m < 4; ++m) _Pragma("unroll") for (int n = 0; n < 2; ++n) _Pragma("unroll") for (int k = 0; k < 2; ++k) \
        acc[ai][bj][m][n] = __builtin_amdgcn_mfma_f32_16x16x32_bf16(Bt[n][k], At[m][k], acc[ai][bj][m][n], 0, 0, 0); __builtin_amdgcn_s_setprio(0); } while (0)
#define PG8_WAIT_V(n) asm volatile("s_waitcnt vmcnt(" #n ")" ::: "memory")
#define PG8_WAIT_L(n) asm volatile("s_waitcnt lgkmcnt(" #n ")" ::: "memory")
#define PG8_BAR __builtin_amdgcn_s_barrier()
#define PG8_SCHED __builtin_amdgcn_sched_barrier(0)
    Unit cur, nxt; int ui = 0;
    if (!S.next(0, cur)) return;
    f32x4 acc[2][2][4][2];
#pragma unroll
    for (int a = 0; a < 2; ++a)
#pragma unroll
        for (int b = 0; b < 2; ++b)
#pragma unroll
            for (int m = 0; m < 4; ++m)
#pragma unroll
                for (int n = 0; n < 2; ++n) acc[a][b][m][n] = (f32x4){0.f, 0.f, 0.f, 0.f};
    bf16x8 At[4][2], B0[2][2], B1[2][2];
    const char* cA = (const char*)g.A + (size_t)cur.pm * tstep; const char* cB = (const char*)g.Bt + (size_t)cur.pn * tstep;
    S.a_ready(cur);
    PG8_STAGE(PG8_SB(0, 0), cB, voffB); PG8_STAGE(PG8_SA(0, 0), cA, voffA); PG8_STAGE(PG8_SB(0, 1), cB + hstep, voffB); PG8_STAGE(PG8_SA(0, 1), cA + hstep, voffA);
    if (wr == 1) PG8_BAR;
    PG8_WAIT_V(4); PG8_BAR;
    PG8_STAGE(PG8_SB(1, 0), cB + kstep, voffB); PG8_STAGE(PG8_SA(1, 0), cA + kstep, voffA); PG8_STAGE(PG8_SB(1, 1), cB + hstep + kstep, voffB);
    PG8_WAIT_V(6); PG8_BAR;
    PG8_STAMP();
    for (;;) {
        const bool has_next = S.next(ui + 1, nxt);
        const char* nA = has_next ? (const char*)g.A + (size_t)nxt.pm * tstep : cA; const char* nB = has_next ? (const char*)g.Bt + (size_t)nxt.pn * tstep : cB;
        for (int t = 0; t < nt; t += 2) {
            const bool last = (t == nt - 2);
            const char* a1 = cA + (size_t)(t + 1) * kstep;
            const char* a2 = last ? nA : cA + (size_t)(t + 2) * kstep; const char* b2 = last ? nB : cB + (size_t)(t + 2) * kstep;
            const char* a3 = a2 + kstep; const char* b3 = b2 + kstep;
            if (last && has_next) S.a_ready(nxt);
            PG8_LDB(B0, 0, 0); PG8_SCHED; PG8_LDA(At, 0, 0); PG8_STAGE(PG8_SA(1, 1), a1 + hstep, voffA);
            PG8_WAIT_L(8); PG8_BAR; PG8_WAIT_L(0); PG8_MMA(0, 0, At, B0); PG8_BAR; PG8_SCHED;
            PG8_LDB(B1, 0, 1); PG8_STAGE(PG8_SB(0, 0), b2, voffB);
            PG8_BAR; PG8_WAIT_L(0); PG8_MMA(0, 1, At, B1); PG8_BAR;
            PG8_LDA(At, 0, 1); PG8_STAGE(PG8_SA(0, 0), a2, voffA);
            PG8_BAR; PG8_WAIT_L(0); PG8_MMA(1, 0, At, B0); PG8_BAR; PG8_SCHED;
            PG8_STAGE(PG8_SB(0, 1), b2 + hstep, voffB);
            PG8_WAIT_V(6); PG8_BAR; PG8_MMA(1, 1, At, B1); PG8_BAR;
            PG8_LDB(B0, 1, 0); PG8_SCHED; PG8_LDA(At, 1, 0); PG8_STAGE(PG8_SA(0, 1), a2 + hstep, voffA);
            PG8_WAIT_L(8); PG8_BAR; PG8_WAIT_L(0); PG8_MMA(0, 0, At, B0); PG8_BAR; PG8_SCHED;
            PG8_LDB(B1, 1, 1); PG8_STAGE(PG8_SB(1, 0), b3, voffB);
            PG8_BAR; PG8_WAIT_L(0); PG8_MMA(0, 1, At, B1); PG8_BAR;
            PG8_LDA(At, 1, 1); PG8_STAGE(PG8_SA(1, 0), a3, voffA);
            PG8_BAR; PG8_WAIT_L(0); PG8_MMA(1, 0, At, B0); PG8_BAR; PG8_SCHED;
            PG8_STAGE(PG8_SB(1, 1), b3 + hstep, voffB);
            PG8_WAIT_V(6); PG8_BAR; PG8_MMA(1, 1, At, B1); PG8_BAR;
        }
        PG8_STAMP();
        if constexpr (!Epi::AFTER_DRAIN) { E(acc, cur, wr, wc, fr, fq); S.done(cur); }
        PG8_STAMP();
        if (!has_next) break;
#pragma unroll
        for (int a = 0; a < 2; ++a)
#pragma unroll
            for (int b = 0; b < 2; ++b)
#pragma unroll
                for (int m = 0; m < 4; ++m)
#pragma unroll
                    for (int n = 0; n < 2; ++n) acc[a][b][m][n] = (f32x4){0.f, 0.f, 0.f, 0.f};
        cur = nxt; cA = nA; cB = nB; ++ui;
    }
    PG8_WAIT_V(0);
    if (wr == 0) PG8_BAR;
    PG8_BAR;
    if constexpr (Epi::AFTER_DRAIN) { E.fused(acc, cur, wr, wc, fr, fq, lds, wid, lane); S.done(cur); }
    PG8_STAMP();
    if (STAMP && wid == 0) { stamps[lane] = lane < nts ? (((unsigned long long)(unsigned)ts_hi << 32) | (unsigned)ts_lo) : 0ull;
        if (lane == 62) stamps[62] = rt_entry; if (lane == 63) stamps[63] = (unsigned long long)wall_clock64(); }
#undef PG8_STAMP
#undef PG8_SA
#undef PG8_SB
#undef PG8_STAGE
#undef PG8_LDA
#undef PG8_LDB
#undef PG8_MMA
#undef PG8_WAIT_V
#undef PG8_WAIT_L
#undef PG8_BAR
#undef PG8_SCHED
}
}

using pg8::bf16x8; using pg8::f32x4; using pg8::u32x4;
typedef short s16x4 __attribute__((ext_vector_type(4)));
typedef __bf16 bfx2 __attribute__((ext_vector_type(2)));

struct Params {
    const float *x, *ln_mix, *ln_ffn, *ret_w_in, *ret_w_out, *ret_gn, *kv_norm, *w_kv, *att_w_q, *att_w_o, *att_rel_bias, *peer_w_q, *peer_sub_keys, *peer_u, *peer_v, *ln_final;
    float* out; unsigned char* ws; int lo, hi;
};
struct Ctx { LAS unsigned char* lds; int tid, lane, wave, bx, G, gw, ngw; };

__device__ __forceinline__ float dot2bf(unsigned a, unsigned b, float c) { return __builtin_amdgcn_fdot2_f32_bf16(__builtin_bit_cast(bfx2, a), __builtin_bit_cast(bfx2, b), c, false); }
__device__ __forceinline__ bf16x8 lds128(LAS const unsigned char* p) { return *(LAS const bf16x8*)p; }
__device__ __forceinline__ bf16x8 tr_frag(unsigned a0, unsigned a1) {
    s16x4 lo, hi;
    asm volatile("ds_read_b64_tr_b16 %0, %2\n\tds_read_b64_tr_b16 %1, %3\n\ts_waitcnt lgkmcnt(0)" : "=&v"(lo), "=&v"(hi) : "v"(a0), "v"(a1) : "memory");
    bf16x8 r; r[0] = lo[0]; r[1] = lo[1]; r[2] = lo[2]; r[3] = lo[3]; r[4] = hi[0]; r[5] = hi[1]; r[6] = hi[2]; r[7] = hi[3]; return r;
}
#define MFMA16(a, b, c) __builtin_amdgcn_mfma_f32_16x16x32_bf16((a), (b), (c), 0, 0, 0)

__device__ __forceinline__ void load_row(const float* xrow, int lane, f32x4 (&v)[8]) {
    const f32x4* xr = (const f32x4*)xrow + lane;
#pragma unroll
    for (int j = 0; j < 8; ++j) v[j] = xr[64 * j];
}
__device__ __forceinline__ float row_rstd(const f32x4 (&v)[8]) {
    float s = 0.f;
#pragma unroll
    for (int j = 0; j < 8; ++j) s += (v[j][0] * v[j][0] + v[j][1] * v[j][1]) + (v[j][2] * v[j][2] + v[j][3] * v[j][3]);
    return 1.0f / sqrtf(wave_sum(s) * (1.0f / DM) + EPS);
}
__device__ __forceinline__ void store_norm_bf16(const f32x4 (&v)[8], float rstd, const float* g, bf16* orow, int lane) {
    const f32x4* gr = (const f32x4*)g + lane; u32x2* o8 = (u32x2*)orow + lane;
#pragma unroll
    for (int j = 0; j < 8; ++j) { const f32x4 gv = gr[64 * j]; u32x2 w; w.x = pk2(v[j][0] * rstd * gv[0], v[j][1] * rstd * gv[1]); w.y = pk2(v[j][2] * rstd * gv[2], v[j][3] * rstd * gv[3]); o8[64 * j] = w; }
}
__device__ __forceinline__ void load_g(const float* g, int lane, f32x4 (&gv)[8]) {
    const f32x4* gr = (const f32x4*)g + lane;
#pragma unroll
    for (int j = 0; j < 8; ++j) gv[j] = gr[64 * j];
}
__device__ __forceinline__ void store_norm_bf16_r(const f32x4 (&v)[8], float rstd, const f32x4 (&gv)[8], bf16* orow, int lane) {
    u32x2* o8 = (u32x2*)orow + lane;
#pragma unroll
    for (int j = 0; j < 8; ++j) { u32x2 w; w.x = pk2(v[j][0] * rstd * gv[j][0], v[j][1] * rstd * gv[j][1]); w.y = pk2(v[j][2] * rstd * gv[j][2], v[j][3] * rstd * gv[j][3]); o8[64 * j] = w; }
}
__device__ __forceinline__ unsigned q8pack(float a, float b, float c, float d) {
    const unsigned ua = __builtin_bit_cast(unsigned, a + 12582912.0f), ub = __builtin_bit_cast(unsigned, b + 12582912.0f), uc = __builtin_bit_cast(unsigned, c + 12582912.0f), ud = __builtin_bit_cast(unsigned, d + 12582912.0f);
    return (ua & 255u) | ((ub & 255u) << 8) | ((uc & 255u) << 16) | (ud << 24);
}

__device__ __forceinline__ void p0_transpose_item(const float* W, int K, int N, bf16* WT, LAS float* scr, int item, int lane) {
    const int nblk = N / 32, kb = item / nblk, nb = item % nblk, k0 = 64 * kb, n0 = 32 * nb;
    float tv[32];
#pragma unroll
    for (int i = 0; i < 32; ++i) { const int kk = 2 * i + (lane >> 5); tv[i] = W[(size_t)(k0 + kk) * N + n0 + (lane & 31)]; }
#pragma unroll
    for (int i = 0; i < 32; ++i) { const int kk = 2 * i + (lane >> 5); scr[kk * 33 + (lane & 31)] = tv[i]; }
    LDS_WAIT(); asm volatile("" ::: "memory");
    const int c = lane & 7;
#pragma unroll
    for (int j = 0; j < 4; ++j) { const int n = (lane >> 3) + 8 * j; const LAS float* s = scr + (8 * c) * 33 + n;
        u32x4 o; o.x = pk2(s[0 * 33], s[1 * 33]); o.y = pk2(s[2 * 33], s[3 * 33]); o.z = pk2(s[4 * 33], s[5 * 33]); o.w = pk2(s[6 * 33], s[7 * 33]);
        *(u32x4*)(WT + (size_t)(n0 + n) * K + k0 + 8 * c) = o; }
    LDS_WAIT(); asm volatile("" ::: "memory");
}
__device__ __forceinline__ void p0_fold_tile(const Params& p, const Ctx& c, int tl) {
    const int l = tl >> 9, hp = (tl >> 5) & 15, j0 = (tl & 31) * 64;
    LAS float* As = (LAS float*)c.lds;
    LAS float* Bs = (LAS float*)c.lds + 64 * 132;
    const float* Wq = p.peer_w_q + (size_t)l * DM * DM; const float* sk = p.peer_sub_keys + ((size_t)l * 2 + (hp & 1)) * PNK * 128;
    __syncthreads();
    for (int i = c.tid; i < 64 * 32; i += 512) { const int jj = i >> 5, d4 = i & 31; *(LAS f32x4*)(As + jj * 132 + d4 * 4) = *(const f32x4*)(Wq + (size_t)(j0 + jj) * DM + hp * 128 + d4 * 4); }
    for (int i = c.tid; i < 128 * 32; i += 512) { const int k = i >> 5, d4 = i & 31; *(LAS f32x4*)(Bs + k * 132 + d4 * 4) = *(const f32x4*)(sk + (size_t)k * 128 + d4 * 4); }
    __syncthreads();
    const int tj = c.tid & 15, tk = c.tid >> 4;
    float acc[4][4];
#pragma unroll
    for (int b = 0; b < 4; ++b)
#pragma unroll
        for (int a = 0; a < 4; ++a) acc[b][a] = 0.f;
    for (int d4 = 0; d4 < 32; ++d4) {
        f32x4 av[4], bv[4];
#pragma unroll
        for (int a = 0; a < 4; ++a) av[a] = *(LAS const f32x4*)(As + (tj + 16 * a) * 132 + d4 * 4);
#pragma unroll
        for (int b = 0; b < 4; ++b) bv[b] = *(LAS const f32x4*)(Bs + (tk * 4 + b) * 132 + d4 * 4);
#pragma unroll
        for (int b = 0; b < 4; ++b)
#pragma unroll
            for (int a = 0; a < 4; ++a) acc[b][a] += (av[a][0] * bv[b][0] + av[a][1] * bv[b][1]) + (av[a][2] * bv[b][2] + av[a][3] * bv[b][3]);
    }
    bf16* WcT = (bf16*)(p.ws + WS_WC) + (size_t)l * DM * DM;
#pragma unroll
    for (int b = 0; b < 4; ++b)
#pragma unroll
        for (int a = 0; a < 4; ++a) WcT[(size_t)(hp * 128 + tk * 4 + b) * DM + j0 + tj + 16 * a] = (bf16)f2bf(acc[b][a]);
}
__device__ __forceinline__ void p0_prologue(const Params& p, const Ctx& c) {
#ifndef PROREP
#define PROREP 0
#endif
    const bool fold_last = (c.bx & 1) != 0;
    if (!fold_last) {
    for (int tl = c.bx; tl < DEPTH * 16 * 32; tl += c.G) p0_fold_tile(p, c, tl);
    __syncthreads();
    }
    for (int rp_ = ((PROREP >> 1) & 1) ? 0 : 1; rp_ < 2; ++rp_)
    {
        LAS float* scr = (LAS float*)(c.lds + c.wave * 16384);
        constexpr int I_IN = (DM / 64) * (RIN / 32), I_OUT = (RVW / 64) * (DM / 32), I_KV = (DM / 64) * (2 * DM / 32), I_SQ = (DM / 64) * (DM / 32);
        constexpr int NITEMS = 2 * I_IN + 2 * I_OUT + I_KV + 4 * I_SQ;
        for (int it = c.gw; it < NITEMS; it += c.ngw) {
            int r = it;
            if (r < 2 * I_IN) { const int l = r / I_IN; p0_transpose_item(p.ret_w_in + (size_t)l * DM * RIN, DM, RIN, (bf16*)(p.ws + WS_WIN) + (size_t)l * RIN * DM, scr, r % I_IN, c.lane); continue; } r -= 2 * I_IN;
            if (r < 2 * I_OUT) { const int l = r / I_OUT; p0_transpose_item(p.ret_w_out + (size_t)l * RVW * DM, RVW, DM, (bf16*)(p.ws + WS_WOUT) + (size_t)l * DM * RVW, scr, r % I_OUT, c.lane); continue; } r -= 2 * I_OUT;
            if (r < I_KV) { p0_transpose_item(p.w_kv, DM, 2 * DM, (bf16*)(p.ws + WS_WKV), scr, r, c.lane); continue; } r -= I_KV;
            if (r < 2 * I_SQ) { const int l = r / I_SQ; p0_transpose_item(p.att_w_q + (size_t)l * DM * DM, DM, DM, (bf16*)(p.ws + WS_WQ) + (size_t)l * DM * DM, scr, r % I_SQ, c.lane); continue; } r -= 2 * I_SQ;
            { const int l = r / I_SQ; p0_transpose_item(p.att_w_o + (size_t)l * DM * DM, DM, DM, (bf16*)(p.ws + WS_WO) + (size_t)l * DM * DM, scr, r % I_SQ, c.lane); }
        }
    }
    for (int rp_ = ((PROREP >> 2) & 1) ? 0 : 1; rp_ < 2; ++rp_)
    {
        float* rs = (float*)(p.ws + WS_RS);
        for (int row = c.gw; row < 2 * DEPTH * PE; row += c.ngw) {
            const int which = row >= DEPTH * PE, r = row - which * DEPTH * PE;
            f32x4 v[8]; load_row((which ? p.peer_v : p.peer_u) + (size_t)r * DM, c.lane, v);
            float am = 0.f;
#pragma unroll
            for (int j = 0; j < 8; ++j) am = fmaxf(fmaxf(am, fmaxf(fabsf(v[j][0]), fabsf(v[j][1]))), fmaxf(fabsf(v[j][2]), fabsf(v[j][3])));
#pragma unroll
            for (int o = 1; o < 64; o <<= 1) am = fmaxf(am, __shfl_xor(am, o));
            int e = (int)((__builtin_bit_cast(unsigned, am) >> 23) & 0xffu) - 127; if (am == 0.f) e = 7;
            int k = 7 - e; k = k < -100 ? -100 : (k > 100 ? 100 : k);
            const float sc = __builtin_bit_cast(float, (unsigned)(k + 127) << 23), rsc = __builtin_bit_cast(float, (unsigned)(127 - k) << 23);
            const int lyr = r / PE, re = r % PE;
            unsigned char* dstb = p.ws + (which ? WS_PV : WS_PU) + (size_t)lyr * PE * DM + (size_t)re * 128;
            if (which) {
#pragma unroll
                for (int j = 0; j < 8; ++j) { int w = 0; w = __builtin_amdgcn_cvt_pk_fp8_f32(v[j][0] * sc, v[j][1] * sc, w, false); w = __builtin_amdgcn_cvt_pk_fp8_f32(v[j][2] * sc, v[j][3] * sc, w, true); { const int col = 4 * c.lane + 256 * j; *(unsigned*)(dstb + (size_t)(col >> 7) * PE * 128 + (col & 127)) = (unsigned)w; } }
                if (c.lane == 0) rs[row] = rsc;
            } else {
                const float s8 = am > 0.f ? 127.0f / am : 0.f;
#pragma unroll
                for (int j = 0; j < 8; ++j) { const unsigned w = q8pack(v[j][0] * s8, v[j][1] * s8, v[j][2] * s8, v[j][3] * s8); const int col = 4 * c.lane + 256 * j; *(unsigned*)(dstb + (size_t)(col >> 7) * PE * 128 + (col & 127)) = w; }
                if (c.lane == 0) rs[row] = am * (1.0f / 127.0f);
            }
        }
    }
    for (int rp_ = ((PROREP >> 3) & 1) ? 0 : 1; rp_ < 2; ++rp_)
    {
        float* rot = (float*)(p.ws + WS_ROT);
        for (int i = c.bx * 512 + c.tid; i < SEQ * 128; i += c.G * 512) { const int pos = i >> 7, d = i & 127;
            const float inv = (float)(1.0 / pow(10000.0, (double)d / 128.0)); const float ang = (float)pos * inv;
            rot[(size_t)pos * 256 + d] = (float)cos((double)ang); rot[(size_t)pos * 256 + 128 + d] = (float)sin((double)ang); }
    }
    for (int rp_ = ((PROREP >> 4) & 1) ? 0 : 1; rp_ < 2; ++rp_)
    { f32x4 gv[8]; load_g(p.ln_mix, c.lane, gv);
      for (int m = c.gw; m < NTOK; m += c.ngw) {
        f32x4 v[8]; load_row(p.x + (size_t)m * DM, c.lane, v);
        f32x4* xo = (f32x4*)(p.out + (size_t)m * DM) + c.lane;
#pragma unroll
        for (int j = 0; j < 8; ++j) xo[64 * j] = v[j];
        store_norm_bf16_r(v, row_rstd(v), gv, (bf16*)(p.ws + WS_H) + (size_t)m * DM, c.lane);
      } }
    if (fold_last) {
    __syncthreads();
    for (int tl = c.bx; tl < DEPTH * 16 * 32; tl += c.G) p0_fold_tile(p, c, tl);
    __syncthreads();
    }
}

constexpr int RS_QS = 0, RS_KS = 33792, RS_VS = 67584, RS_VZ = 76800, RS_PS = 86016, RS_RS = 95232, RS_END = 129024, QK_STR = 528, V_STR = 144;
__device__ __forceinline__ void ret_scan_unit(const Ctx& c, const bf16* Qg, const bf16* Kg, const bf16* Vg, bf16* Og, int unit) {
    const int xg = unit & 7, slot = unit >> 3, pair = xg * 4 + (slot >> 3), es = slot & 7, b = pair >> 3, h = pair & 7;
    const int tid = c.tid, lane = c.lane, w = c.wave, fr = lane & 15, fq = lane >> 4, tq = (lane & 15) >> 2, tp = lane & 3;
    LAS unsigned char* lds = c.lds;
    const float lgam = log1pf(-exp2f(-5.0f - (float)h));
    const float cdec = expf(lgam * 64.0f);
    const int lrow = tid >> 3, lch = tid & 7;
    const size_t tok0 = (size_t)b * SEQ;
    const bf16* qrow = Qg + (tok0 + lrow) * RQKW + h * RQK + lch * 8;
    const bf16* krow = Kg + (tok0 + lrow) * RQKW + h * RQK + lch * 8;
    const bf16* vrow = Vg + (tok0 + lrow) * RVW + h * RV + es * 64 + lch * 8;
    const float zeta = expf(lgam * (float)(63 - lrow));
    u32x4 pq[4], pk[4], pv;
#pragma unroll
    for (int cc = 0; cc < 4; ++cc) { pq[cc] = *(const u32x4*)(qrow + cc * 64); pk[cc] = *(const u32x4*)(krow + cc * 64); }
    pv = *(const u32x4*)vrow;
    __syncthreads();
    for (int i = tid; i < (RS_END - RS_RS) / 16; i += 512) *(LAS u32x4*)(lds + RS_RS + i * 16) = (u32x4){0u, 0u, 0u, 0u};
    f32x4 Racc[2][4];
#pragma unroll
    for (int x = 0; x < 2; ++x)
#pragma unroll
        for (int y = 0; y < 4; ++y) Racc[x][y] = (f32x4){0.f, 0.f, 0.f, 0.f};
    const int jt = w & 3, it0 = 2 * (w >> 2);
    const int it = w & 3, et0 = 2 * (w >> 2);
    float xi[4];
#pragma unroll
    for (int r = 0; r < 4; ++r) xi[r] = expf(lgam * (float)(16 * it + 4 * fq + r + 1));
    const unsigned ldsb = (unsigned)(size_t)lds;
    float dmask[2][4];
#pragma unroll
    for (int x = 0; x < 2; ++x)
#pragma unroll
        for (int r = 0; r < 4; ++r) { const int i = 16 * (it0 + x) + fr, j = 16 * jt + 4 * fq + r; dmask[x][r] = (i >= j) ? expf(lgam * (float)(i - j)) : 0.f; }
    asm volatile("" : "+v"(dmask[0][0]), "+v"(dmask[0][1]), "+v"(dmask[0][2]), "+v"(dmask[0][3]), "+v"(dmask[1][0]), "+v"(dmask[1][1]), "+v"(dmask[1][2]), "+v"(dmask[1][3]));
    for (int n = 0; n < NCHUNK; ++n) {
        __syncthreads();
#pragma unroll
        for (int cc = 0; cc < 4; ++cc) { *(LAS u32x4*)(lds + RS_QS + lrow * QK_STR + (lch + 8 * cc) * 16) = pq[cc]; *(LAS u32x4*)(lds + RS_KS + lrow * QK_STR + (lch + 8 * cc) * 16) = pk[cc]; }
        *(LAS u32x4*)(lds + RS_VS + lrow * V_STR + lch * 16) = pv;
        { u32x4 z; z.x = pk2(bflo(pv.x) * zeta, bfhi(pv.x) * zeta); z.y = pk2(bflo(pv.y) * zeta, bfhi(pv.y) * zeta); z.z = pk2(bflo(pv.z) * zeta, bfhi(pv.z) * zeta); z.w = pk2(bflo(pv.w) * zeta, bfhi(pv.w) * zeta);
          *(LAS u32x4*)(lds + RS_VZ + lrow * V_STR + lch * 16) = z; }
        __syncthreads();
        if (n + 1 < NCHUNK) {
            const size_t adv = (size_t)(n + 1) * CHUNK;
#pragma unroll
            for (int cc = 0; cc < 4; ++cc) { pq[cc] = *(const u32x4*)(qrow + adv * RQKW + cc * 64); pk[cc] = *(const u32x4*)(krow + adv * RQKW + cc * 64); }
            pv = *(const u32x4*)(vrow + adv * RVW);
        }
        {
            f32x4 s0 = (f32x4){0.f, 0.f, 0.f, 0.f}, s1 = s0;
#pragma unroll
            for (int kh = 0; kh < 2; ++kh) {
                bf16x8 fa[4], fb0[4], fb1[4];
#pragma unroll
                for (int k4 = 0; k4 < 4; ++k4) { const int ks = 4 * kh + k4;
                    fa[k4] = lds128(lds + RS_KS + (16 * jt + fr) * QK_STR + (4 * ks + fq) * 16);
                    fb0[k4] = lds128(lds + RS_QS + (16 * it0 + fr) * QK_STR + (4 * ks + fq) * 16);
                    fb1[k4] = lds128(lds + RS_QS + (16 * (it0 + 1) + fr) * QK_STR + (4 * ks + fq) * 16); }
                __builtin_amdgcn_sched_barrier(0);
#pragma unroll
                for (int k4 = 0; k4 < 4; ++k4) { s0 = MFMA16(fa[k4], fb0[k4], s0); s1 = MFMA16(fa[k4], fb1[k4], s1); }
            }
#pragma unroll
            for (int x = 0; x < 2; ++x) { const f32x4 s = x ? s1 : s0; const int i = 16 * (it0 + x) + fr; float pr[4];
#pragma unroll
                for (int r = 0; r < 4; ++r) pr[r] = s[r] * dmask[x][r];
                u32x2 pw; pw.x = pk2(pr[0], pr[1]); pw.y = pk2(pr[2], pr[3]);
                *(LAS u32x2*)(lds + RS_PS + i * V_STR + (16 * jt + 4 * fq) * 2) = pw; }
        }
        f32x4 o0 = (f32x4){0.f, 0.f, 0.f, 0.f}, o1 = o0;
        {
#pragma unroll
            for (int kh = 0; kh < 2; ++kh) {
                bf16x8 fa[4], fb0[4], fb1[4];
#pragma unroll
                for (int k4 = 0; k4 < 4; ++k4) { const int ks = 4 * kh + k4;
                    fa[k4] = lds128(lds + RS_QS + (16 * it + fr) * QK_STR + (4 * ks + fq) * 16);
                    fb0[k4] = lds128(lds + RS_RS + (16 * et0 + fr) * QK_STR + (4 * ks + fq) * 16);
                    fb1[k4] = lds128(lds + RS_RS + (16 * (et0 + 1) + fr) * QK_STR + (4 * ks + fq) * 16); }
                __builtin_amdgcn_sched_barrier(0);
#pragma unroll
                for (int k4 = 0; k4 < 4; ++k4) { o0 = MFMA16(fa[k4], fb0[k4], o0); o1 = MFMA16(fa[k4], fb1[k4], o1); }
            }
        }
#pragma unroll
        for (int r = 0; r < 4; ++r) { o0[r] *= xi[r]; o1[r] *= xi[r]; }
        __syncthreads();
#pragma unroll
        for (int ks = 0; ks < 2; ++ks) {
            const bf16x8 a = lds128(lds + RS_PS + (16 * it + fr) * V_STR + (4 * ks + fq) * 16);
            const unsigned va = ldsb + RS_VS + (32 * ks + 8 * fq + tq) * V_STR + 8 * tp;
            const bf16x8 b0 = tr_frag(va + 32 * et0, va + 4 * V_STR + 32 * et0);
            const bf16x8 b1 = tr_frag(va + 32 * (et0 + 1), va + 4 * V_STR + 32 * (et0 + 1));
            __builtin_amdgcn_sched_barrier(0);
            o0 = MFMA16(a, b0, o0); o1 = MFMA16(a, b1, o1);
        }
        {
            bf16* op = Og + (tok0 + (size_t)n * CHUNK + 16 * it + 4 * fq) * RVW + h * RV + es * 64 + 16 * et0 + fr;
#pragma unroll
            for (int r = 0; r < 4; ++r) { op[(size_t)r * RVW] = (bf16)f2bf(o0[r]); op[(size_t)r * RVW + 16] = (bf16)f2bf(o1[r]); }
        }
#pragma unroll
        for (int x = 0; x < 2; ++x)
#pragma unroll
            for (int y = 0; y < 4; ++y) Racc[x][y] *= cdec;
#pragma unroll
        for (int ks = 0; ks < 2; ++ks) {
            const unsigned ka = ldsb + RS_KS + (32 * ks + 8 * fq + tq) * QK_STR + 8 * tp;
            const unsigned za = ldsb + RS_VZ + (32 * ks + 8 * fq + tq) * V_STR + 8 * tp;
            bf16x8 ak[2], bz[4];
#pragma unroll
            for (int x = 0; x < 2; ++x) ak[x] = tr_frag(ka + 32 * (2 * w + x), ka + 4 * QK_STR + 32 * (2 * w + x));
#pragma unroll
            for (int y = 0; y < 4; ++y) bz[y] = tr_frag(za + 32 * y, za + 4 * V_STR + 32 * y);
            __builtin_amdgcn_sched_barrier(0);
#pragma unroll
            for (int x = 0; x < 2; ++x)
#pragma unroll
                for (int y = 0; y < 4; ++y) Racc[x][y] = MFMA16(ak[x], bz[y], Racc[x][y]);
        }
#pragma unroll
        for (int x = 0; x < 2; ++x)
#pragma unroll
            for (int y = 0; y < 4; ++y) { u32x2 rw; rw.x = pk2(Racc[x][y][0], Racc[x][y][1]); rw.y = pk2(Racc[x][y][2], Racc[x][y][3]);
                *(LAS u32x2*)(lds + RS_RS + (16 * y + fr) * QK_STR + (16 * (2 * w + x) + 4 * fq) * 2) = rw; }
    }
}

template <int CTRL> __device__ __forceinline__ float dpp_f(float x) { return __builtin_bit_cast(float, __builtin_amdgcn_mov_dpp(__builtin_bit_cast(int, x), CTRL, 0xF, 0xF, true)); }
__device__ __forceinline__ float sum8(float x) { x += dpp_f<0xB1>(x); x += dpp_f<0x4E>(x); x += dpp_f<0x141>(x); return x; }
__device__ __forceinline__ void ret_gate_phase(const Ctx& c, const bf16* Og, bf16* Gg, const float* gn, bf16* Zout = nullptr) {
    const int col0 = 512 * (c.lane >> 3) + 8 * (c.lane & 7);
    f32x4 gw[16];
#pragma unroll
    for (int j = 0; j < 8; ++j) { gw[2 * j] = *(const f32x4*)(gn + col0 + 64 * j); gw[2 * j + 1] = *(const f32x4*)(gn + col0 + 64 * j + 4); }
    u32x4 ovn[8];
    if (c.gw < NTOK) { const bf16* orow = Og + (size_t)c.gw * RVW + col0;
#pragma unroll
        for (int j = 0; j < 8; ++j) ovn[j] = *(const u32x4*)(orow + 64 * j); }
    for (int m = c.gw; m < NTOK; m += c.ngw) {
        u32x4 gv[8], ov[8];
        { const bf16* grow = Gg + (size_t)m * RVW + col0;
#pragma unroll
          for (int j = 0; j < 8; ++j) { gv[j] = *(const u32x4*)(grow + 64 * j); ov[j] = ovn[j]; } }
        { const int mn = m + c.ngw < NTOK ? m + c.ngw : m; const bf16* orow = Og + (size_t)mn * RVW + col0;
#pragma unroll
          for (int j = 0; j < 8; ++j) ovn[j] = *(const u32x4*)(orow + 64 * j); }
        float s1 = 0.f;
#pragma unroll
        for (int j = 0; j < 8; ++j) { const u32x4 t = ov[j];
            s1 += ((bflo(t.x) + bfhi(t.x)) + (bflo(t.y) + bfhi(t.y))) + ((bflo(t.z) + bfhi(t.z)) + (bflo(t.w) + bfhi(t.w))); }
        const float mu = sum8(s1) * (1.0f / RV);
        asm volatile("" : "+v"(ov[0]), "+v"(ov[1]), "+v"(ov[2]), "+v"(ov[3]), "+v"(ov[4]), "+v"(ov[5]), "+v"(ov[6]), "+v"(ov[7]));
        float s2 = 0.f;
#pragma unroll
        for (int j = 0; j < 8; ++j) { const u32x4 t = ov[j];
            const float d[8] = {bflo(t.x) - mu, bfhi(t.x) - mu, bflo(t.y) - mu, bfhi(t.y) - mu, bflo(t.z) - mu, bfhi(t.z) - mu, bflo(t.w) - mu, bfhi(t.w) - mu};
            float q = 0.f;
#pragma unroll
            for (int k = 0; k < 8; ++k) q += d[k] * d[k];
            s2 += q; }
        const float rstd = 1.0f / sqrtf(sum8(s2) * (1.0f / RV) + EPS);
        asm volatile("" : "+v"(ov[0]), "+v"(ov[1]), "+v"(ov[2]), "+v"(ov[3]), "+v"(ov[4]), "+v"(ov[5]), "+v"(ov[6]), "+v"(ov[7]));
        bf16* zrow = (Zout ? Zout : Gg) + (size_t)m * RVW + col0;
#pragma unroll
        for (int j = 0; j < 8; ++j) {
            const float gg[8] = {gw[2 * j][0], gw[2 * j][1], gw[2 * j][2], gw[2 * j][3], gw[2 * j + 1][0], gw[2 * j + 1][1], gw[2 * j + 1][2], gw[2 * j + 1][3]};
            const u32x4 t = gv[j], u = ov[j];
            const float g[8] = {bflo(t.x), bfhi(t.x), bflo(t.y), bfhi(t.y), bflo(t.z), bfhi(t.z), bflo(t.w), bfhi(t.w)};
            const float o[8] = {bflo(u.x), bfhi(u.x), bflo(u.y), bfhi(u.y), bflo(u.z), bfhi(u.z), bflo(u.w), bfhi(u.w)};
            float z[8];
#pragma unroll
            for (int k = 0; k < 8; ++k) { const float y = (o[k] - mu) * rstd * gg[k]; z[k] = g[k] * __builtin_amdgcn_rcpf(1.0f + __builtin_amdgcn_exp2f(-1.4426950408889634f * g[k])) * y; }
            u32x4 zw; zw.x = pk2(z[0], z[1]); zw.y = pk2(z[2], z[3]); zw.z = pk2(z[4], z[5]); zw.w = pk2(z[6], z[7]);
            *(u32x4*)(zrow + 64 * j) = zw;
        }
    }
}

__device__ __forceinline__ void rms_phase(const Ctx& c, const float* X, const float* g, bf16* H) {
    for (int m = c.gw; m < NTOK; m += c.ngw) { f32x4 v[8]; load_row(X + (size_t)m * DM, c.lane, v); store_norm_bf16(v, row_rstd(v), g, H + (size_t)m * DM, c.lane); }
}

__device__ __forceinline__ int fkey(float f) { const int i = __builtin_bit_cast(int, f); return i ^ ((i >> 31) & 0x7fffffff); }
__device__ __forceinline__ float kval(int k) { return __builtin_bit_cast(float, k ^ ((k >> 31) & 0x7fffffff)); }
__device__ __forceinline__ int med3i(int a, int b, int c) { int r; asm("v_med3_i32 %0, %1, %2, %3" : "=v"(r) : "v"(a), "v"(b), "v"(c)); return r; }
#define INS16(L, key) do { const int _k = (key); _Pragma("unroll") for (int _q = 15; _q >= 1; --_q) L[_q] = med3i(L[_q - 1], L[_q], _k); L[0] = max(L[0], _k); } while (0)
constexpr int TK_LIST = 544, TK_HALF = 272, TK_KEYS = 256 * TK_LIST;
__device__ __forceinline__ void peer_topk_phase(const Ctx& c, const float* SC, int* IDX, float* WGT, const float* SQP, float* RSTD) {
    LAS unsigned char* lds = c.lds;
    u32x4 pre[16];
    if (c.bx < NTOK / 16) { const u32x4* src = (const u32x4*)(SC + (size_t)c.bx * 16 * DM);
#pragma unroll
        for (int i = 0; i < 16; ++i) pre[i] = src[c.tid + 512 * i]; }
    for (int tile = c.bx; tile < NTOK / 16; tile += c.G) {
        __syncthreads();
#pragma unroll
        for (int i = 0; i < 16; ++i) { const int g = c.tid + 512 * i; *(LAS u32x4*)(lds + (g >> 5) * TK_LIST + ((g >> 4) & 1) * TK_HALF + (g & 15) * 16) = pre[i]; }
        if (tile + c.G < NTOK / 16) { const u32x4* src = (const u32x4*)(SC + (size_t)(tile + c.G) * 16 * DM);
#pragma unroll
            for (int i = 0; i < 16; ++i) pre[i] = src[c.tid + 512 * i]; }
        __syncthreads();
        {
            const int lst = c.tid >> 1, hf = c.tid & 1;
            int L[16];
#pragma unroll
            for (int q = 0; q < 16; ++q) L[q] = (int)0x80000000;
            LAS unsigned char* lp = lds + lst * TK_LIST + hf * TK_HALF;
#pragma unroll 2
            for (int g = 0; g < 16; ++g) { const f32x4 v = *(LAS const f32x4*)(lp + g * 16);
#pragma unroll
                for (int e = 0; e < 4; ++e) INS16(L, (fkey(v[e]) & ~127) | (hf * 64 + g * 4 + e)); }
            if (hf) {
#pragma unroll
                for (int q = 0; q < 16; ++q) ((LAS int*)lp)[q] = L[q]; }
            __syncthreads();
            if (!hf) { LAS const int* op = (LAS const int*)(lp + TK_HALF);
#pragma unroll
                for (int q = 0; q < 16; ++q) INS16(L, op[q]);
                LAS int* kp = (LAS int*)(lds + TK_KEYS) + lst * 16;
#pragma unroll
                for (int q = 0; q < 16; ++q) kp[q] = L[q]; }
        }
        __syncthreads();
        if (c.tid < 128) {
            LAS const int* k1 = (LAS const int*)(lds + TK_KEYS) + (c.tid * 2) * 16; LAS const int* k2 = k1 + 16;
            float v1[16], v2[16];
#pragma unroll
            for (int q = 0; q < 16; ++q) { v1[q] = kval(k1[q] & ~127); v2[q] = kval(k2[q] & ~127); }
            int L[16];
#pragma unroll
            for (int q = 0; q < 16; ++q) L[q] = (fkey(v1[0] + v2[q]) & ~255) | q;
#pragma unroll
            for (int i = 1; i < 16; ++i)
#pragma unroll
                for (int j = 0; j < 16; ++j) if ((i + 1) * (j + 1) <= 16) INS16(L, (fkey(v1[i] + v2[j]) & ~255) | (i * 16 + j));
            const int tt = c.tid >> 3, hh = c.tid & 7; const size_t ob0 = ((size_t)tile * 16 + tt) * 128;
            float rstd; { const f32x4* sp = (const f32x4*)(SQP + ((size_t)tile * 16 + tt) * 32); f32x4 a4 = sp[0];
#pragma unroll
              for (int q = 1; q < 8; ++q) a4 += sp[q];
              rstd = 1.0f / sqrtf(((a4[0] + a4[1]) + (a4[2] + a4[3])) * (1.0f / DM) + EPS); }
            if (hh == 0) RSTD[(size_t)tile * 16 + tt] = rstd;
            const float m0 = kval(L[0] & ~255); float ex[16], se = 0.f;
#pragma unroll
            for (int q = 0; q < 16; ++q) { ex[q] = __builtin_amdgcn_exp2f((kval(L[q] & ~255) - m0) * (rstd * 1.4426950408889634f)); se += ex[q]; }
            const float inv = 1.0f / se;
#pragma unroll
            for (int q = 0; q < 16; ++q) { const int cid = L[q] & 255; const int es = hh * 16 + q, pos = (es & 7) * 16 + (es >> 3);
                IDX[ob0 + pos] = (k1[cid >> 4] & 127) * PNK + (k2[cid & 15] & 127); WGT[ob0 + pos] = ex[q] * inv; }
        }
    }
}

template <int NSTAGE> __device__ __forceinline__ void xreduce_stage(float (&p)[64], int lane) {
    constexpr int S = NSTAGE;
    if constexpr (S == 32) {
#pragma unroll
        for (int k = 0; k < S; ++k) { float xa = p[k], xb = p[k + S]; asm("s_nop 1\n\tv_permlane32_swap_b32 %0, %1" : "+v"(xa), "+v"(xb)); p[k] = xa + xb; }
    } else if constexpr (S == 16) {
#pragma unroll
        for (int k = 0; k < S; ++k) { float xa = p[k], xb = p[k + S]; asm("s_nop 1\n\tv_permlane16_swap_b32 %0, %1" : "+v"(xa), "+v"(xb)); p[k] = xa + xb; }
    } else {
        const bool up = (lane & S) != 0;
#pragma unroll
        for (int k = 0; k < S; ++k) { const float keep = up ? p[k + S] : p[k], send = up ? p[k] : p[k + S];
            p[k] = keep + __builtin_bit_cast(float, __builtin_amdgcn_ds_swizzle(__builtin_bit_cast(int, send), (S << 10) | 0x1F)); }
    }
}
__device__ __forceinline__ float gelu_erf(float v) { return 0.5f * v * (1.0f + erff(v * 0.70710678118654752f)); }
typedef float f32x2 __attribute__((ext_vector_type(2)));
__device__ __forceinline__ float peer_dots64(const unsigned char* U, int idxv, const f32x2 (&h2)[16], int lane) {
    float p[64];
#pragma unroll
    for (int e = 0; e < 64; ++e) {
        const int row = __builtin_amdgcn_readlane(idxv, e);
        const u32x4* up = (const u32x4*)(U + (size_t)row * DM) + lane;
        f32x2 a = {0.f, 0.f};
#pragma unroll
        for (int cc = 0; cc < 2; ++cc) { const u32x4 u = up[64 * cc];
#pragma unroll
            for (int q = 0; q < 4; ++q) { const int w = (int)u[q];
                a = __builtin_elementwise_fma(__builtin_amdgcn_cvt_pk_f32_fp8(w, false), h2[8 * cc + 2 * q], a);
                a = __builtin_elementwise_fma(__builtin_amdgcn_cvt_pk_f32_fp8(w, true), h2[8 * cc + 2 * q + 1], a); } }
        p[e] = a.x + a.y;
    }
    xreduce_stage<32>(p, lane); xreduce_stage<16>(p, lane); xreduce_stage<8>(p, lane); xreduce_stage<4>(p, lane); xreduce_stage<2>(p, lane); xreduce_stage<1>(p, lane);
    return p[0];
}
__device__ __forceinline__ void peer_accum64(const unsigned char* Vt, int idxv, float av, f32x2 (&acc)[16], int lane) {
#pragma unroll 8
    for (int e = 0; e < 64; ++e) {
        const int row = __builtin_amdgcn_readlane(idxv, e); const float a = __builtin_bit_cast(float, __builtin_amdgcn_readlane(__builtin_bit_cast(int, av), e));
        const f32x2 a2 = {a, a};
        const u32x4* vp = (const u32x4*)(Vt + (size_t)row * DM) + lane;
#pragma unroll
        for (int cc = 0; cc < 2; ++cc) { const u32x4 v = vp[64 * cc];
#pragma unroll
            for (int q = 0; q < 4; ++q) { const int w = (int)v[q];
                acc[8 * cc + 2 * q] = __builtin_elementwise_fma(__builtin_amdgcn_cvt_pk_f32_fp8(w, false), a2, acc[8 * cc + 2 * q]);
                acc[8 * cc + 2 * q + 1] = __builtin_elementwise_fma(__builtin_amdgcn_cvt_pk_f32_fp8(w, true), a2, acc[8 * cc + 2 * q + 1]); } }
    }
}
constexpr int GD = 8;
#define PG_ISSUE(vv) do { const int row_ = __builtin_amdgcn_readlane((((vv) >> 6) & 1) ? i1 : i0, (vv) & 63); \
        const u32x4* bp_ = (const u32x4*)((((vv) >> 6) < 2 ? U : Vt) + (size_t)row_ * DM) + lane; ring[(vv) % GD][0] = bp_[0]; ring[(vv) % GD][1] = bp_[64]; } while (0)
template <int SEG> __device__ __forceinline__ void peer_seg(const unsigned char* U, const unsigned char* Vt, int i0, int i1, u32x4 (&ring)[GD][2], float (&p)[64], float aseg, const f32x2 (&h2)[16], f32x2 (&acc)[16], int lane) {
#pragma unroll
    for (int e = 0; e < 64; ++e) {
        const int v = SEG * 64 + e;
        const u32x4 r0 = ring[v % GD][0], r1 = ring[v % GD][1];
        if (SEG < 2) {
            f32x2 a = {0.f, 0.f};
#pragma unroll
            for (int q = 0; q < 4; ++q) { const int wa = (int)r0[q], wb = (int)r1[q];
                a = __builtin_elementwise_fma(__builtin_amdgcn_cvt_pk_f32_fp8(wa, false), h2[2 * q], a); a = __builtin_elementwise_fma(__builtin_amdgcn_cvt_pk_f32_fp8(wa, true), h2[2 * q + 1], a);
                a = __builtin_elementwise_fma(__builtin_amdgcn_cvt_pk_f32_fp8(wb, false), h2[8 + 2 * q], a); a = __builtin_elementwise_fma(__builtin_amdgcn_cvt_pk_f32_fp8(wb, true), h2[8 + 2 * q + 1], a); }
            { float hs_; asm("v_add_f32 %0, %1, %2" : "=v"(hs_) : "v"(a.x), "v"(a.y)); p[e] = hs_; }
        } else {
            const float av = __builtin_bit_cast(float, __builtin_amdgcn_readlane(__builtin_bit_cast(int, aseg), e)); const f32x2 a2 = {av, av};
#pragma unroll
            for (int q = 0; q < 4; ++q) { const int wa = (int)r0[q], wb = (int)r1[q];
                acc[2 * q] = __builtin_elementwise_fma(__builtin_amdgcn_cvt_pk_f32_fp8(wa, false), a2, acc[2 * q]); acc[2 * q + 1] = __builtin_elementwise_fma(__builtin_amdgcn_cvt_pk_f32_fp8(wa, true), a2, acc[2 * q + 1]);
                acc[8 + 2 * q] = __builtin_elementwise_fma(__builtin_amdgcn_cvt_pk_f32_fp8(wb, false), a2, acc[8 + 2 * q]); acc[8 + 2 * q + 1] = __builtin_elementwise_fma(__builtin_amdgcn_cvt_pk_f32_fp8(wb, true), a2, acc[8 + 2 * q + 1]); }
            asm volatile("" : "+v"(acc[0]), "+v"(acc[1]), "+v"(acc[2]), "+v"(acc[3]), "+v"(acc[4]), "+v"(acc[5]), "+v"(acc[6]), "+v"(acc[7]), "+v"(acc[8]), "+v"(acc[9]), "+v"(acc[10]), "+v"(acc[11]), "+v"(acc[12]), "+v"(acc[13]), "+v"(acc[14]), "+v"(acc[15]));
        }
        if (v + GD < 256) PG_ISSUE(v + GD);
        __builtin_amdgcn_sched_barrier(0);
    }
}
__device__ __forceinline__ void peer_token_pipe(const unsigned char* U, const unsigned char* Vt, int i0, int i1, float su0, float su1, float w0, float w1, const f32x2 (&h2)[16], f32x2 (&acc)[16], int lane) {
    u32x4 ring[GD][2];
    float p[64];
#pragma unroll
    for (int v = 0; v < GD; ++v) PG_ISSUE(v);
    peer_seg<0>(U, Vt, i0, i1, ring, p, 0.f, h2, acc, lane);
    xreduce_stage<32>(p, lane); xreduce_stage<16>(p, lane); xreduce_stage<8>(p, lane); xreduce_stage<4>(p, lane); xreduce_stage<2>(p, lane); xreduce_stage<1>(p, lane);
    const float a0 = gelu_erf(p[0] * su0) * w0;
    __builtin_amdgcn_sched_barrier(0);
    peer_seg<1>(U, Vt, i0, i1, ring, p, 0.f, h2, acc, lane);
    xreduce_stage<32>(p, lane); xreduce_stage<16>(p, lane); xreduce_stage<8>(p, lane); xreduce_stage<4>(p, lane); xreduce_stage<2>(p, lane); xreduce_stage<1>(p, lane);
    const float a1 = gelu_erf(p[0] * su1) * w1;
    __builtin_amdgcn_sched_barrier(0);
    peer_seg<2>(U, Vt, i0, i1, ring, p, a0, h2, acc, lane);
    peer_seg<3>(U, Vt, i0, i1, ring, p, a1, h2, acc, lane);
}
#undef PG_ISSUE
__device__ __forceinline__ void peer_gather_phase(const Ctx& c, const bf16* Hn, const unsigned char* U, const unsigned char* Vt, const float* rsU, const float* rsV, const int* IDX, const float* WGT, const float* Xr, float* X, int mode,
                                                  const float* g1, const float* g2, bf16* Hout, bf16* HKVout) {
    for (int m = c.gw; m < NTOK; m += c.ngw) {
        int lane_ = c.lane; asm volatile("" : "+v"(lane_));
#ifdef DRYIDXMASK
        const int imask_ = (X != Xr) ? DRYIDXMASK : 0xffff;
        const int i0 = IDX[(size_t)m * 128 + lane_] & imask_, i1 = IDX[(size_t)m * 128 + 64 + lane_] & imask_;
#else
        const int i0 = IDX[(size_t)m * 128 + lane_], i1 = IDX[(size_t)m * 128 + 64 + lane_];
#endif
        const float w0 = WGT[(size_t)m * 128 + lane_] * rsV[i0], w1 = WGT[(size_t)m * 128 + 64 + lane_] * rsV[i1];
        const float su0 = rsU[i0], su1 = rsU[i1];
        f32x2 h2[16];
#pragma unroll
        for (int cc = 0; cc < 2; ++cc) { const u32x4* hp = (const u32x4*)(Hn + (size_t)m * DM + 1024 * cc + 16 * lane_); const u32x4 ha = hp[0], hb = hp[1];
#pragma unroll
            for (int q = 0; q < 4; ++q) { h2[8 * cc + q] = (f32x2){bflo(ha[q]), bfhi(ha[q])}; h2[8 * cc + 4 + q] = (f32x2){bflo(hb[q]), bfhi(hb[q])}; } }
        f32x2 acc[16];
#pragma unroll
        for (int k = 0; k < 16; ++k) acc[k] = (f32x2){0.f, 0.f};
        peer_token_pipe(U, Vt, i0, i1, su0, su1, w0, w1, h2, acc, lane_);
        float* xr = X + (size_t)m * DM; const float* xrr = Xr + (size_t)m * DM; float ss = 0.f;
#pragma unroll
        for (int cc = 0; cc < 2; ++cc) {
            f32x4* xp = (f32x4*)(xr + 1024 * cc + 16 * lane_); const f32x4* xq = (const f32x4*)(xrr + 1024 * cc + 16 * lane_);
#pragma unroll
            for (int q = 0; q < 4; ++q) { f32x4 xa = xq[q]; xa[0] += acc[8 * cc + 2 * q].x; xa[1] += acc[8 * cc + 2 * q].y; xa[2] += acc[8 * cc + 2 * q + 1].x; xa[3] += acc[8 * cc + 2 * q + 1].y;
                acc[8 * cc + 2 * q] = (f32x2){xa[0], xa[1]}; acc[8 * cc + 2 * q + 1] = (f32x2){xa[2], xa[3]}; ss += (xa[0] * xa[0] + xa[1] * xa[1]) + (xa[2] * xa[2] + xa[3] * xa[3]);
                if (mode != 2) xp[q] = xa; }
        }
        const float rstd = 1.0f / sqrtf(wave_sum(ss) * (1.0f / DM) + EPS);
#pragma unroll
        for (int cc = 0; cc < 2; ++cc) {
            const f32x4* gp = (const f32x4*)(g1 + 1024 * cc + 16 * lane_);
            if (mode == 2) {
                f32x4* xp = (f32x4*)(xr + 1024 * cc + 16 * lane_);
#pragma unroll
                for (int q = 0; q < 4; ++q) { const f32x4 gv = gp[q]; f32x4 y; y[0] = acc[8 * cc + 2 * q].x * rstd * gv[0]; y[1] = acc[8 * cc + 2 * q].y * rstd * gv[1]; y[2] = acc[8 * cc + 2 * q + 1].x * rstd * gv[2]; y[3] = acc[8 * cc + 2 * q + 1].y * rstd * gv[3]; xp[q] = y; }
            } else {
                u32x4 hw[2];
#pragma unroll
                for (int q = 0; q < 4; ++q) { const f32x4 gv = gp[q]; hw[q >> 1][2 * (q & 1)] = pk2(acc[8 * cc + 2 * q].x * rstd * gv[0], acc[8 * cc + 2 * q].y * rstd * gv[1]); hw[q >> 1][2 * (q & 1) + 1] = pk2(acc[8 * cc + 2 * q + 1].x * rstd * gv[2], acc[8 * cc + 2 * q + 1].y * rstd * gv[3]); }
                u32x4* ho = (u32x4*)(Hout + (size_t)m * DM + 1024 * cc + 16 * lane_); ho[0] = hw[0]; ho[1] = hw[1];
                if (mode == 1) {
                    const f32x4* kp = (const f32x4*)(g2 + 1024 * cc + 16 * lane_); u32x4 kw[2];
#pragma unroll
                    for (int q = 0; q < 4; ++q) { const f32x4 gv = kp[q]; kw[q >> 1][2 * (q & 1)] = pk2(acc[8 * cc + 2 * q].x * rstd * gv[0], acc[8 * cc + 2 * q].y * rstd * gv[1]); kw[q >> 1][2 * (q & 1) + 1] = pk2(acc[8 * cc + 2 * q + 1].x * rstd * gv[2], acc[8 * cc + 2 * q + 1].y * rstd * gv[3]); }
                    u32x4* ko = (u32x4*)(HKVout + (size_t)m * DM + 1024 * cc + 16 * lane_); ko[0] = kw[0]; ko[1] = kw[1];
                }
            }
        }
    }
}

template <int PAT> __device__ __forceinline__ float swz_xor(float v) { return __builtin_bit_cast(float, __builtin_amdgcn_ds_swizzle(__builtin_bit_cast(int, v), PAT)); }
template <int PAT> __device__ __forceinline__ int swz_xor_i(int v) { return __builtin_amdgcn_ds_swizzle(v, PAT); }
__device__ __forceinline__ void peer_u_phase(const Ctx& c, const bf16* Hn, const unsigned char* U, const int* IDXT, float* PD, unsigned imask = 0xffffffffu) {
    const int xg = c.bx & 7, wr = (c.bx >> 3) * 8 + c.wave, g = c.lane >> 3, sub = c.lane & 7;
    for (int pass = 0; pass < 2; ++pass) {
        const int s = xg + 8 * pass, col0 = 128 * s + 16 * sub;
        const unsigned char* Us = U + (size_t)s * PE * 128 + 16 * sub;
        u32x4 ri[4], hr[2];
        { const u32x4* ip = (const u32x4*)(IDXT + (size_t)wr * 128 + g * 16); const u32x4* hp = (const u32x4*)(Hn + (size_t)wr * DM + col0);
#pragma unroll
          for (int q = 0; q < 4; ++q) ri[q] = ip[q];
          hr[0] = hp[0]; hr[1] = hp[1]; }
        for (int k = 0; k < NTOK / 256; ++k) {
            const int t = wr + 256 * k;
            u32x4 r[16];
#pragma unroll
            for (int j = 0; j < 16; ++j) r[j] = *(const u32x4*)(Us + (size_t)(ri[j >> 2][j & 3] & imask) * 128);
            float hf[16];
#pragma unroll
            for (int q = 0; q < 4; ++q) { hf[2 * q] = bflo(hr[0][q]); hf[2 * q + 1] = bfhi(hr[0][q]); hf[8 + 2 * q] = bflo(hr[1][q]); hf[8 + 2 * q + 1] = bfhi(hr[1][q]); }
            if (k + 1 < NTOK / 256) { const u32x4* ip = (const u32x4*)(IDXT + (size_t)(t + 256) * 128 + g * 16); const u32x4* hp = (const u32x4*)(Hn + (size_t)(t + 256) * DM + col0);
#pragma unroll
                for (int q = 0; q < 4; ++q) ri[q] = ip[q];
                hr[0] = hp[0]; hr[1] = hp[1]; }
            float am = 0.f;
#pragma unroll
            for (int q = 0; q < 16; ++q) am = fmaxf(am, fabsf(hf[q]));
            am = fmaxf(am, dpp_f<0xB1>(am)); am = fmaxf(am, dpp_f<0x4E>(am)); am = fmaxf(am, dpp_f<0x141>(am));
            const float hsc = am > 0.f ? 127.0f / am : 0.f, hinv = am * (1.0f / 127.0f);
            unsigned hq[4];
#pragma unroll
            for (int q = 0; q < 4; ++q) hq[q] = q8pack(hf[4 * q] * hsc, hf[4 * q + 1] * hsc, hf[4 * q + 2] * hsc, hf[4 * q + 3] * hsc);
            int p[16];
#pragma unroll
            for (int j = 0; j < 16; ++j) { int a = __builtin_amdgcn_sdot4((int)r[j].x, (int)hq[0], 0, false); a = __builtin_amdgcn_sdot4((int)r[j].y, (int)hq[1], a, false);
                a = __builtin_amdgcn_sdot4((int)r[j].z, (int)hq[2], a, false); p[j] = __builtin_amdgcn_sdot4((int)r[j].w, (int)hq[3], a, false); }
            { const bool up = (sub & 4) != 0;
#pragma unroll
              for (int q = 0; q < 8; ++q) { const int keep = up ? p[q + 8] : p[q], send = up ? p[q] : p[q + 8]; p[q] = keep + swz_xor_i<(4 << 10) | 0x1F>(send); } }
            { const bool up = (sub & 2) != 0;
#pragma unroll
              for (int q = 0; q < 4; ++q) { const int keep = up ? p[q + 4] : p[q], send = up ? p[q] : p[q + 4]; p[q] = keep + swz_xor_i<(2 << 10) | 0x1F>(send); } }
            { const bool up = (sub & 1) != 0;
#pragma unroll
              for (int q = 0; q < 2; ++q) { const int keep = up ? p[q + 2] : p[q], send = up ? p[q] : p[q + 2]; p[q] = keep + swz_xor_i<(1 << 10) | 0x1F>(send); } }
            f32x2 o = {(float)p[0] * hinv, (float)p[1] * hinv};
            *(f32x2*)(PD + ((size_t)t * 16 + s) * 128 + g * 16 + 2 * sub) = o;
        }
    }
}
__device__ __forceinline__ void peer_a_phase(const Ctx& c, const float* PD, const int* IDXT, float* WA, const float* rsU, const float* rsV, const float* RSTD) {
    const int i0 = c.bx * 512 + c.tid, step = c.G * 512;
    f32x4 vn[16];
    if (i0 < NTOK * 32) { const f32x4* pp = (const f32x4*)(PD + (size_t)(i0 >> 5) * 2048) + (i0 & 31);
#pragma unroll
        for (int s = 0; s < 16; ++s) vn[s] = pp[s * 32]; }
    for (int i4 = i0; i4 < NTOK * 32; i4 += step) {
        const int t = i4 >> 5;
        f32x4 v[16];
#pragma unroll
        for (int s = 0; s < 16; ++s) v[s] = vn[s];
        const u32x4 e = *((const u32x4*)IDXT + i4); const f32x4 w = *((const f32x4*)WA + i4); const float rs = RSTD[t];
        { const int i5 = i4 + step < NTOK * 32 ? i4 + step : i4; const f32x4* pp = (const f32x4*)(PD + (size_t)(i5 >> 5) * 2048) + (i5 & 31);
#pragma unroll
          for (int s = 0; s < 16; ++s) vn[s] = pp[s * 32]; }
        float ru[4], rv[4];
#pragma unroll
        for (int q = 0; q < 4; ++q) { const unsigned eq = e[q]; ru[q] = rsU[eq]; rv[q] = rsV[eq]; }
        f32x4 sm = v[0];
#pragma unroll
        for (int s = 1; s < 16; ++s) sm += v[s];
        asm volatile("" :: "v"(ru[0]), "v"(ru[1]), "v"(ru[2]), "v"(ru[3]), "v"(rv[0]), "v"(rv[1]), "v"(rv[2]), "v"(rv[3]));
        f32x4 o;
#pragma unroll
        for (int q = 0; q < 4; ++q) o[q] = gelu_erf(sm[q] * ru[q] * rs) * w[q] * rv[q];
        *((f32x4*)WA + i4) = o;
    }
}
__device__ __forceinline__ void peer_v_phase(const Ctx& c, const unsigned char* Vt, const int* IDXT, const float* WA, float* X) {
    const int xg = c.bx & 7, wr = (c.bx >> 3) * 8 + c.wave, g = c.lane >> 3, sub = c.lane & 7;
    for (int pass = 0; pass < 2; ++pass) {
        const int s = xg + 8 * pass, col0 = 128 * s + 16 * sub;
        const unsigned char* Vs = Vt + (size_t)s * PE * 128 + 16 * sub;
        u32x4 ri[4], ar[4];
        { const u32x4* ip = (const u32x4*)(IDXT + (size_t)wr * 128 + g * 16); const u32x4* ap = (const u32x4*)(WA + (size_t)wr * 128 + g * 16);
#pragma unroll
          for (int q = 0; q < 4; ++q) { ri[q] = ip[q]; ar[q] = ap[q]; } }
        for (int k = 0; k < NTOK / 256; ++k) {
            const int t = wr + 256 * k;
            u32x4 r[16]; float av[16];
#pragma unroll
            for (int j = 0; j < 16; ++j) { r[j] = *(const u32x4*)(Vs + (size_t)ri[j >> 2][j & 3] * 128); const unsigned ab_ = ar[j >> 2][j & 3]; av[j] = __builtin_bit_cast(float, ab_); }
            f32x2* xp = (f32x2*)(X + (size_t)t * DM + col0 + 2 * g);
            const f32x2 xold = *xp;
            if (k + 1 < NTOK / 256) { const u32x4* ip = (const u32x4*)(IDXT + (size_t)(t + 256) * 128 + g * 16); const u32x4* ap = (const u32x4*)(WA + (size_t)(t + 256) * 128 + g * 16);
#pragma unroll
                for (int q = 0; q < 4; ++q) { ri[q] = ip[q]; ar[q] = ap[q]; } }
            f32x2 acc[8];
#pragma unroll
            for (int q = 0; q < 8; ++q) acc[q] = (f32x2){0.f, 0.f};
#pragma unroll
            for (int j = 0; j < 16; ++j) { float aj_ = av[j]; asm("" : "+v"(aj_));
                const f32x2 a2 = {aj_, aj_};
#pragma unroll
                for (int q = 0; q < 4; ++q) { const int w = (int)r[j][q]; acc[2 * q] = __builtin_elementwise_fma(__builtin_amdgcn_cvt_pk_f32_fp8(w, false), a2, acc[2 * q]); acc[2 * q + 1] = __builtin_elementwise_fma(__builtin_amdgcn_cvt_pk_f32_fp8(w, true), a2, acc[2 * q + 1]); } }
            float af[16];
#pragma unroll
            for (int q = 0; q < 8; ++q) { af[2 * q] = acc[q].x; af[2 * q + 1] = acc[q].y; }
#ifdef VDBG
#pragma unroll
            for (int q = 0; q < 16; ++q) { af[q] += __shfl_xor(af[q], 8); af[q] += __shfl_xor(af[q], 16); af[q] += __shfl_xor(af[q], 32); }
            { float s0 = af[0], s1 = af[1];
#pragma unroll
              for (int gg = 1; gg < 8; ++gg) { s0 = (g == gg) ? af[2 * gg] : s0; s1 = (g == gg) ? af[2 * gg + 1] : s1; }
              af[0] = s0; af[1] = s1; }
#else
#pragma unroll
            for (int q = 0; q < 8; ++q) { float xa = af[q], xb = af[q + 8]; asm("s_nop 1\n\tv_permlane32_swap_b32 %0, %1" : "+v"(xa), "+v"(xb)); af[q] = xa + xb; }
#pragma unroll
            for (int q = 0; q < 4; ++q) { float xa = af[q], xb = af[q + 4]; asm("s_nop 1\n\tv_permlane16_swap_b32 %0, %1" : "+v"(xa), "+v"(xb)); af[q] = xa + xb; }
            { const bool up = (c.lane & 8) != 0;
#pragma unroll
              for (int q = 0; q < 2; ++q) { const float keep = up ? af[q + 2] : af[q], send = up ? af[q] : af[q + 2]; af[q] = keep + swz_xor<(8 << 10) | 0x1F>(send); } }
#endif
            const f32x2 xn = {xold.x + af[0], xold.y + af[1]};
            *xp = xn;
        }
    }
}
#ifdef VREF
__device__ __forceinline__ void peer_v_ref_phase(const Ctx& c, const unsigned char* Vt, const int* IDXT, const float* WA, float* X) {
    for (int m = c.gw; m < NTOK; m += c.ngw) {
        const int i0 = IDXT[(size_t)m * 128 + c.lane], i1 = IDXT[(size_t)m * 128 + 64 + c.lane];
        const float a0 = WA[(size_t)m * 128 + c.lane], a1 = WA[(size_t)m * 128 + 64 + c.lane];
        f32x2 acc[16];
#pragma unroll
        for (int k = 0; k < 16; ++k) acc[k] = (f32x2){0.f, 0.f};
        for (int e = 0; e < 128; ++e) {
            const int row = __shfl(e < 64 ? i0 : i1, e & 63); const float a = __shfl(e < 64 ? a0 : a1, e & 63); const f32x2 a2 = {a, a};
            const u32x4* vp = (const u32x4*)(Vt + (size_t)row * DM) + c.lane;
#pragma unroll
            for (int cc = 0; cc < 2; ++cc) { const u32x4 v = vp[64 * cc];
#pragma unroll
                for (int q = 0; q < 4; ++q) { const int w = (int)v[q];
                    acc[8 * cc + 2 * q] = __builtin_elementwise_fma(__builtin_amdgcn_cvt_pk_f32_fp8(w, false), a2, acc[8 * cc + 2 * q]);
                    acc[8 * cc + 2 * q + 1] = __builtin_elementwise_fma(__builtin_amdgcn_cvt_pk_f32_fp8(w, true), a2, acc[8 * cc + 2 * q + 1]); } }
        }
        float* xr = X + (size_t)m * DM;
#pragma unroll
        for (int cc = 0; cc < 2; ++cc) { f32x4* xp = (f32x4*)(xr + 1024 * cc + 16 * c.lane);
#pragma unroll
            for (int q = 0; q < 4; ++q) { f32x4 xa = xp[q]; xa[0] += acc[8 * cc + 2 * q].x; xa[1] += acc[8 * cc + 2 * q].y; xa[2] += acc[8 * cc + 2 * q + 1].x; xa[3] += acc[8 * cc + 2 * q + 1].y; xp[q] = xa; } }
    }
}
#endif
__device__ __forceinline__ void norm_phase(const Ctx& c, float* X, int mode, const float* g1, const float* g2, bf16* H, bf16* HKV) {
    f32x4 ga[8], gb[8]; load_g(g1, c.lane, ga); load_g(mode == 1 ? g2 : g1, c.lane, gb);
    int m = c.gw;
    f32x4 v[8]; load_row(X + (size_t)m * DM, c.lane, v);
    for (; m < NTOK; m += c.ngw) {
        const int mn = m + c.ngw < NTOK ? m + c.ngw : m;
        f32x4 nx[8]; load_row(X + (size_t)mn * DM, c.lane, nx);
        const float rstd = row_rstd(v);
        if (mode == 2) { f32x4* xo = (f32x4*)(X + (size_t)m * DM) + c.lane;
#pragma unroll
            for (int j = 0; j < 8; ++j) { f32x4 y; y[0] = v[j][0] * rstd * ga[j][0]; y[1] = v[j][1] * rstd * ga[j][1]; y[2] = v[j][2] * rstd * ga[j][2]; y[3] = v[j][3] * rstd * ga[j][3]; xo[64 * j] = y; }
        } else { store_norm_bf16_r(v, rstd, ga, H + (size_t)m * DM, c.lane); if (mode == 1) store_norm_bf16_r(v, rstd, gb, HKV + (size_t)m * DM, c.lane); }
#pragma unroll
        for (int j = 0; j < 8; ++j) v[j] = nx[j];
    }
}

__device__ __forceinline__ void rms_final_phase(const Ctx& c, float* X, const float* g) {
    for (int m = c.gw; m < NTOK; m += c.ngw) { f32x4 v[8]; load_row(X + (size_t)m * DM, c.lane, v); const float rstd = row_rstd(v);
        const f32x4* gr = (const f32x4*)g + c.lane; f32x4* xo = (f32x4*)(X + (size_t)m * DM) + c.lane;
#pragma unroll
        for (int j = 0; j < 8; ++j) { const f32x4 gv = gr[64 * j]; f32x4 y; for (int k = 0; k < 4; ++k) { y[k] = v[j][k] * rstd * gv[k]; if (!(fabsf(y[k]) < 1e30f)) y[k] = 0.f; } xo[64 * j] = y; } }
}

#ifdef DIAGBUF
__device__ __forceinline__ void diag_copy_phase(const Ctx& c, float* X, const unsigned char* ws) {
    const bf16* src = (const bf16*)(ws + (size_t)DIAGBUF);
    for (size_t i = (size_t)c.bx * 512 + c.tid; i < (size_t)NTOK * DM; i += (size_t)c.G * 512) { const size_t t = i / DM, col = i % DM; float v = bflo((unsigned)src[t * DIAGLD + col]); if (!(fabsf(v) < 1e30f)) v = 0.f; X[i] = v; }
}
#endif

__device__ __forceinline__ unsigned off_b(unsigned row, unsigned ch) { return 256u * row + 16u * (ch ^ (((row & 3u) << 2) | ((row >> 2) & 3u))); }
__device__ __forceinline__ float rowmax4(float x) {
    float a = x, b = x; asm("s_nop 1\n\tv_permlane16_swap_b32 %0, %1" : "+v"(a), "+v"(b)); x = fmaxf(a, b);
    a = x; b = x; asm("s_nop 1\n\tv_permlane32_swap_b32 %0, %1" : "+v"(a), "+v"(b)); return fmaxf(a, b);
}
constexpr int AT_K = 0, AT_V = 32768, AT_BUF = 65536, AT_BIAS = 131072, AT_HEADB = 16384;
__device__ __forceinline__ void attn_phase(const Ctx& c, const bf16* Qg, const bf16* KVg, bf16* AOg, const float* relb, int dryvar = 0) {
    LAS unsigned char* lds = c.lds; const unsigned ldsb = (unsigned)(size_t)lds;
    const int tid = c.tid, lane = c.lane, w = c.wave, hg = w >> 2, wq = w & 3, fr = lane & 15, fq = lane >> 4, tq = (lane & 15) >> 2, tp = lane & 3;
    const int tl = tid & 255, lrow = tl >> 2, lc = tl & 3;
    unsigned vadr[8];
#pragma unroll
    for (int d = 0; d < 8; ++d) vadr[d] = ldsb + AT_V + hg * AT_HEADB + off_b(4 * fq + tq, 2 * d + (tp >> 1)) + 8 * (tp & 1);
    unsigned kadr[4];
#pragma unroll
    for (int s4 = 0; s4 < 4; ++s4) kadr[s4] = ldsb + AT_K + hg * AT_HEADB + 256 * fr + 16 * (fq ^ ((fr >> 2) & 3)) + 64 * (s4 ^ (fr & 3));
    for (int u = c.bx; u < NBATCH * NCHUNK * (AH / 2); u += c.G) {
        const int hp = u & 7, ch = (u >> 3) & 63, b = u >> 9, h = 2 * hp + hg;
        const size_t tq0 = (size_t)b * SEQ + (size_t)ch * CHUNK;
        __syncthreads();
        for (int i = tid; i < 2 * 272; i += 512) { const int hh = i / 272, k = i % 272; ((LAS float*)(lds + AT_BIAS))[i] = (k < NREL) ? relb[(size_t)(2 * hp + hh) * NREL + k] * 1.4426950408889634f : 0.f; }
        bf16x8 qf[4];
        { const bf16* qp = Qg + (tq0 + 16 * wq + fr) * DM + h * AHD + 8 * fq;
#pragma unroll
          for (int s = 0; s < 4; ++s) qf[s] = *(const bf16x8*)(qp + 32 * s); }
        f32x4 O[8];
#pragma unroll
        for (int d = 0; d < 8; ++d) O[d] = (f32x4){0.f, 0.f, 0.f, 0.f};
        float mrun = -1e30f, lrun = 0.f;
        const int t0 = ch >= LEFT ? 0 : LEFT - ch;
        u32x4 pk[4], pv[4];
        { const bf16* kp = KVg + ((size_t)b * SEQ + (size_t)(ch - LEFT + t0) * CHUNK + lrow) * (2 * DM) + h * AHD;
#pragma unroll
          for (int cc = 0; cc < 4; ++cc) { pk[cc] = *(const u32x4*)(kp + (lc + 4 * cc) * 8); pv[cc] = *(const u32x4*)(kp + DM + (lc + 4 * cc) * 8); } }
        const LAS float* bias = (const LAS float*)(lds + AT_BIAS) + hg * 272;
        const float bc = relb[(size_t)h * NREL + 256] * 1.4426950408889634f;
        for (int t = t0; t <= LEFT; ++t) {
            const int pb = ((t - t0) & 1) * AT_BUF;
#pragma unroll
            for (int cc = 0; cc < 4; ++cc) { *(LAS u32x4*)(lds + pb + AT_K + hg * AT_HEADB + off_b(lrow, lc + 4 * cc)) = pk[cc]; *(LAS u32x4*)(lds + pb + AT_V + hg * AT_HEADB + off_b(lrow, lc + 4 * cc)) = pv[cc]; }
            __syncthreads();
            if (t < LEFT && dryvar != 1) { const bf16* kp = KVg + ((size_t)b * SEQ + (size_t)(ch - LEFT + t + 1) * CHUNK + lrow) * (2 * DM) + h * AHD;
#pragma unroll
                for (int cc = 0; cc < 4; ++cc) { pk[cc] = *(const u32x4*)(kp + (lc + 4 * cc) * 8); pv[cc] = *(const u32x4*)(kp + DM + (lc + 4 * cc) * 8); } }
            f32x4 sT[4];
            {
                bf16x8 kf[16];
                const unsigned k0 = kadr[0] + pb, k1 = kadr[1] + pb, k2 = kadr[2] + pb, k3 = kadr[3] + pb;
                asm volatile("ds_read_b128 %0, %16\n\tds_read_b128 %1, %17\n\tds_read_b128 %2, %18\n\tds_read_b128 %3, %19\n\t"
                             "ds_read_b128 %4, %16 offset:4096\n\tds_read_b128 %5, %17 offset:4096\n\tds_read_b128 %6, %18 offset:4096\n\tds_read_b128 %7, %19 offset:4096\n\t"
                             "ds_read_b128 %8, %16 offset:8192\n\tds_read_b128 %9, %17 offset:8192\n\tds_read_b128 %10, %18 offset:8192\n\tds_read_b128 %11, %19 offset:8192\n\t"
                             "ds_read_b128 %12, %16 offset:12288\n\tds_read_b128 %13, %17 offset:12288\n\tds_read_b128 %14, %18 offset:12288\n\tds_read_b128 %15, %19 offset:12288"
                             : "=&v"(kf[0]), "=&v"(kf[1]), "=&v"(kf[2]), "=&v"(kf[3]), "=&v"(kf[4]), "=&v"(kf[5]), "=&v"(kf[6]), "=&v"(kf[7]),
                               "=&v"(kf[8]), "=&v"(kf[9]), "=&v"(kf[10]), "=&v"(kf[11]), "=&v"(kf[12]), "=&v"(kf[13]), "=&v"(kf[14]), "=&v"(kf[15])
                             : "v"(k0), "v"(k1), "v"(k2), "v"(k3) : "memory");
                asm volatile("s_waitcnt lgkmcnt(8)" : "+v"(kf[0]), "+v"(kf[1]), "+v"(kf[2]), "+v"(kf[3]), "+v"(kf[4]), "+v"(kf[5]), "+v"(kf[6]), "+v"(kf[7]) :: "memory");
#pragma unroll
                for (int kt = 0; kt < 2; ++kt) { sT[kt] = (f32x4){0.f, 0.f, 0.f, 0.f};
#pragma unroll
                    for (int s = 0; s < 4; ++s) sT[kt] = MFMA16(kf[4 * kt + s], qf[s], sT[kt]); }
                asm volatile("s_waitcnt lgkmcnt(0)" : "+v"(kf[8]), "+v"(kf[9]), "+v"(kf[10]), "+v"(kf[11]), "+v"(kf[12]), "+v"(kf[13]), "+v"(kf[14]), "+v"(kf[15]) :: "memory");
#pragma unroll
                for (int kt = 2; kt < 4; ++kt) { sT[kt] = (f32x4){0.f, 0.f, 0.f, 0.f};
#pragma unroll
                    for (int s = 0; s < 4; ++s) sT[kt] = MFMA16(kf[4 * kt + s], qf[s], sT[kt]); }
            }
            const int dbase = (LEFT - t) * CHUNK + (16 * wq + fr);
            if (t > LEFT - 3) {
#pragma unroll
                for (int kt = 0; kt < 4; ++kt)
#pragma unroll
                    for (int r = 0; r < 4; ++r) { const int dist = dbase - (16 * kt + 4 * fq + r); sT[kt][r] += bias[min(dist, 128) + 128]; }
            }
            s16x4 vlo[2][8], vhi[2][8];
            unsigned vcur[8];
#pragma unroll
            for (int d = 0; d < 8; ++d) vcur[d] = vadr[d] + pb;
#define TR8(dst, OFF) asm volatile("ds_read_b64_tr_b16 %0, %8 offset:" #OFF "\n\tds_read_b64_tr_b16 %1, %9 offset:" #OFF "\n\tds_read_b64_tr_b16 %2, %10 offset:" #OFF "\n\tds_read_b64_tr_b16 %3, %11 offset:" #OFF "\n\t" \
                "ds_read_b64_tr_b16 %4, %12 offset:" #OFF "\n\tds_read_b64_tr_b16 %5, %13 offset:" #OFF "\n\tds_read_b64_tr_b16 %6, %14 offset:" #OFF "\n\tds_read_b64_tr_b16 %7, %15 offset:" #OFF \
                : "=&v"(dst[0]), "=&v"(dst[1]), "=&v"(dst[2]), "=&v"(dst[3]), "=&v"(dst[4]), "=&v"(dst[5]), "=&v"(dst[6]), "=&v"(dst[7]) \
                : "v"(vcur[0]), "v"(vcur[1]), "v"(vcur[2]), "v"(vcur[3]), "v"(vcur[4]), "v"(vcur[5]), "v"(vcur[6]), "v"(vcur[7]) : "memory")
            TR8(vlo[0], 0); TR8(vhi[0], 4096); TR8(vlo[1], 8192); TR8(vhi[1], 12288);
#undef TR8
            float mx = -1e30f;
            const float badd = t <= LEFT - 3 ? bc : 0.f;
#pragma unroll
            for (int kt = 0; kt < 4; ++kt)
#pragma unroll
                for (int r = 0; r < 4; ++r) { sT[kt][r] += badd; mx = fmaxf(mx, sT[kt][r]); }
            mx = rowmax4(mx);
            const float mnew = fmaxf(mrun, mx), alpha = __builtin_amdgcn_exp2f(mrun - mnew); mrun = mnew;
            float ps = 0.f;
#pragma unroll
            for (int kt = 0; kt < 4; ++kt)
#pragma unroll
                for (int r = 0; r < 4; ++r) { sT[kt][r] = __builtin_amdgcn_exp2f(sT[kt][r] - mnew); ps += sT[kt][r]; }
            lrun = lrun * alpha + ps;
#pragma unroll
            for (int d = 0; d < 8; ++d) O[d] *= alpha;
            asm volatile("s_waitcnt lgkmcnt(0)" : "+v"(vlo[0][0]), "+v"(vlo[0][1]), "+v"(vlo[0][2]), "+v"(vlo[0][3]), "+v"(vlo[0][4]), "+v"(vlo[0][5]), "+v"(vlo[0][6]), "+v"(vlo[0][7]),
                         "+v"(vhi[0][0]), "+v"(vhi[0][1]), "+v"(vhi[0][2]), "+v"(vhi[0][3]), "+v"(vhi[0][4]), "+v"(vhi[0][5]), "+v"(vhi[0][6]), "+v"(vhi[0][7]) :: "memory");
            asm volatile("" : "+v"(vlo[1][0]), "+v"(vlo[1][1]), "+v"(vlo[1][2]), "+v"(vlo[1][3]), "+v"(vlo[1][4]), "+v"(vlo[1][5]), "+v"(vlo[1][6]), "+v"(vlo[1][7]),
                         "+v"(vhi[1][0]), "+v"(vhi[1][1]), "+v"(vhi[1][2]), "+v"(vhi[1][3]), "+v"(vhi[1][4]), "+v"(vhi[1][5]), "+v"(vhi[1][6]), "+v"(vhi[1][7]) :: "memory");
            __builtin_amdgcn_sched_barrier(0);
#pragma unroll
            for (int ks = 0; ks < 2; ++ks) {
                bf16x8 pb; { const unsigned p0 = pk2(sT[2 * ks][0], sT[2 * ks][1]), p1 = pk2(sT[2 * ks][2], sT[2 * ks][3]), p2 = pk2(sT[2 * ks + 1][0], sT[2 * ks + 1][1]), p3 = pk2(sT[2 * ks + 1][2], sT[2 * ks + 1][3]);
                    const u32x4 pw = (u32x4){p0, p1, p2, p3}; pb = __builtin_bit_cast(bf16x8, pw); }
#pragma unroll
                for (int d = 0; d < 8; ++d) { bf16x8 va; va[0] = vlo[ks][d][0]; va[1] = vlo[ks][d][1]; va[2] = vlo[ks][d][2]; va[3] = vlo[ks][d][3]; va[4] = vhi[ks][d][0]; va[5] = vhi[ks][d][1]; va[6] = vhi[ks][d][2]; va[7] = vhi[ks][d][3];
                    O[d] = MFMA16(va, pb, O[d]); }
            }
        }
        float lt = lrun; lt += __shfl_xor(lt, 16); lt += __shfl_xor(lt, 32);
        const float inv = 1.0f / lt;
        bf16* op = AOg + (tq0 + 16 * wq + fr) * DM + h * AHD + 4 * fq;
#pragma unroll
        for (int d = 0; d < 8; ++d) { u32x2 ow; ow.x = pk2(O[d][0] * inv, O[d][1] * inv); ow.y = pk2(O[d][2] * inv, O[d][3] * inv); *(u32x2*)(op + 16 * d) = ow; }
    }
}

constexpr int NSTEPS = 1 + 2 * 10 + 2 * 9;
template <int MASK> __global__ void __launch_bounds__(512, 2) yoco_fwd(Params p) {
    extern __shared__ __attribute__((aligned(16))) unsigned char lds_raw[];
#define MK_CTX() Ctx c; { int t_ = threadIdx.x; asm volatile("" : "+v"(t_)); c.lds = (LAS unsigned char*)lds_raw; c.tid = t_; c.lane = t_ & 63; c.wave = __builtin_amdgcn_readfirstlane(t_ >> 6); \
        { int b_ = blockIdx.x, g_ = gridDim.x; asm volatile("" : "+s"(b_), "+s"(g_)); c.bx = b_; c.G = g_; } c.gw = c.bx * 8 + c.wave; c.ngw = c.G * 8; }
    volatile LAS unsigned* MISC = (volatile LAS unsigned*)((LAS unsigned char*)lds_raw + LDS_MISC);
    if (threadIdx.x < 4) MISC[threadIdx.x] = 0u;
    __syncthreads();
    XcdBarrier bar; bar.bar = (unsigned*)(p.ws + WS_CTL); bar.x = 0; bar.st = MISC;
    if (p.hi - p.lo > 1) bar = xcd_barrier_post((unsigned*)(p.ws + WS_CTL), MISC);
    unsigned char* ws = p.ws;
    bf16* const H = (bf16*)(ws + WS_H); bf16* const HKV = (bf16*)(ws + WS_HKV);
    float* const X = p.out;
    int s = 0;
#ifndef REPMASK
#define REPMASK 0
#endif
#define KF_(f) p.f = kq_->f;
#define MK_P() Params p; { unsigned long long ka_ = (unsigned long long)__builtin_amdgcn_kernarg_segment_ptr(); asm volatile("" : "+s"(ka_)); const __attribute__((address_space(4))) Params* kq_ = (const __attribute__((address_space(4))) Params*)ka_; \
        KF_(x) KF_(ln_mix) KF_(ln_ffn) KF_(ret_w_in) KF_(ret_w_out) KF_(ret_gn) KF_(kv_norm) KF_(w_kv) KF_(att_w_q) KF_(att_w_o) KF_(att_rel_bias) KF_(peer_w_q) KF_(peer_sub_keys) KF_(peer_u) KF_(peer_v) KF_(ln_final) \
        KF_(out) KF_(ws) KF_(lo) KF_(hi) } \
        unsigned char* const ws = p.ws; bf16* const H = (bf16*)(ws + WS_H); bf16* const HKV = (bf16*)(ws + WS_HKV); float* const X = p.out; (void)H; (void)HKV; (void)X;
#define BEGIN_STEP(k) if (((MASK >> (k)) & 1) && s >= p.lo && s < p.hi) { for (int rep_ = ((REPMASK >> (k)) & 1) ? 0 : 1; rep_ < 2; ++rep_) { MK_CTX(); MK_P();
#define END_STEP   if (rep_ == 0 || s + 1 < p.hi) xcd_barrier(bar); } } ++s;

    BEGIN_STEP(0) p0_prologue(p, c); END_STEP

    for (int l = 0; l < DEPTH; ++l) {
        if (l < 2) {
            BEGIN_STEP(1)
                pg8::Gemm g{H, (const bf16*)(ws + WS_WIN) + (size_t)l * RIN * DM, NTOK, RIN, DM}; pg8::StaticOrder S; S.init(NTOK, RIN, c.G, c.bx);
                pg8::EpiProj E{(bf16*)(ws + WS_Q), (bf16*)(ws + WS_K), (bf16*)(ws + WS_V), (bf16*)(ws + WS_G), (const float*)(ws + WS_ROT)};
                pg8::gemm_phase<pg8::EpiProj, pg8::StaticOrder>(c.lds, g, S, E, nullptr);
            END_STEP
            BEGIN_STEP(2)
                for (int u = c.bx; u < 256; u += c.G) ret_scan_unit(c, (const bf16*)(ws + WS_Q), (const bf16*)(ws + WS_K), (const bf16*)(ws + WS_V), (bf16*)(ws + WS_O), u);
            END_STEP
            BEGIN_STEP(3)
                ret_gate_phase(c, (const bf16*)(ws + WS_O), (bf16*)(ws + WS_G), p.ret_gn + (size_t)l * RVW, rep_ == 0 ? (bf16*)(ws + WS_SC) : nullptr);
            END_STEP
        } else {
            BEGIN_STEP(4)
                for (int pass = (l == 2 ? 0 : 1); pass < 2; ++pass) {
                    const int N = pass ? DM : 2 * DM;
                    pg8::Gemm g{pass ? H : HKV, pass ? (const bf16*)(ws + WS_WQ) + (size_t)(l - 2) * DM * DM : (const bf16*)(ws + WS_WKV), NTOK, N, DM}; pg8::StaticOrder S; S.init(NTOK, N, c.G, c.bx);
                    pg8::EpiBf16S E{pass ? (bf16*)(ws + WS_Q) : (bf16*)(ws + WS_KV), N, pass ? 0.12751743082459868f : 1.0f};
                    pg8::gemm_phase<pg8::EpiBf16S, pg8::StaticOrder>(c.lds, g, S, E, nullptr);
                }
            END_STEP
            BEGIN_STEP(5)
#ifdef ATTNDRY
                attn_phase(c, (const bf16*)(ws + WS_Q), (const bf16*)(ws + WS_KV), rep_ == 0 ? (bf16*)(ws + WS_O) : (bf16*)(ws + WS_AO), p.att_rel_bias + (size_t)(l - 2) * AH * NREL, rep_ == 0 ? ATTNDRY : 0);
#else
                attn_phase(c, (const bf16*)(ws + WS_Q), (const bf16*)(ws + WS_KV), (bf16*)(ws + WS_AO), p.att_rel_bias + (size_t)(l - 2) * AH * NREL);
#endif
            END_STEP
        }
        BEGIN_STEP(6)
            const int K = l < 2 ? RVW : DM;
            pg8::Gemm g{l < 2 ? (const bf16*)(ws + WS_G) : (const bf16*)(ws + WS_AO), l < 2 ? (const bf16*)(ws + WS_WOUT) + (size_t)l * DM * RVW : (const bf16*)(ws + WS_WO) + (size_t)(l - 2) * DM * DM, NTOK, DM, K};
            pg8::StaticOrder S; S.init(NTOK, DM, c.G, c.bx);
            pg8::EpiRes E{X, DM, H, p.ln_ffn + (size_t)l * DM, (float*)(ws + WS_SQP)};
            pg8::gemm_phase<pg8::EpiRes, pg8::StaticOrder>(c.lds, g, S, E, nullptr);
        END_STEP
        BEGIN_STEP(8)
            pg8::Gemm g{H, (const bf16*)(ws + WS_WC) + (size_t)l * DM * DM, NTOK, DM, DM}; pg8::StaticOrder S; S.init(NTOK, DM, c.G, c.bx);
            pg8::EpiF32 E{(float*)(ws + WS_SC), DM};
            pg8::gemm_phase<pg8::EpiF32, pg8::StaticOrder>(c.lds, g, S, E, nullptr);
        END_STEP
        BEGIN_STEP(9)
            peer_topk_phase(c, (const float*)(ws + WS_SC), (int*)(ws + WS_IDX), (float*)(ws + WS_WGT), (const float*)(ws + WS_SQP), (float*)(ws + WS_RSTD));
        END_STEP
        BEGIN_STEP(10)
#ifdef DRYIDXMASK
            peer_u_phase(c, H, ws + WS_PU + (size_t)l * PE * DM, (const int*)(ws + WS_IDX), (float*)(ws + WS_SC), rep_ == 0 ? DRYIDXMASK : 0xffffffffu);
#else
            peer_u_phase(c, H, ws + WS_PU + (size_t)l * PE * DM, (const int*)(ws + WS_IDX), (float*)(ws + WS_SC));
#endif
        END_STEP
        BEGIN_STEP(11)
            peer_a_phase(c, (const float*)(ws + WS_SC), (const int*)(ws + WS_IDX), (float*)(ws + WS_WGT), (const float*)(ws + WS_RS) + (size_t)l * PE, (const float*)(ws + WS_RS) + (size_t)(DEPTH + l) * PE, (const float*)(ws + WS_RSTD));
        END_STEP
        BEGIN_STEP(12)
#ifdef VREF
            peer_v_ref_phase(c, ws + WS_PV + (size_t)l * PE * DM, (const int*)(ws + WS_IDX), (const float*)(ws + WS_WGT), X);
#else
            peer_v_phase(c, ws + WS_PV + (size_t)l * PE * DM, (const int*)(ws + WS_IDX), (const float*)(ws + WS_WGT), X);
#endif
        END_STEP
        BEGIN_STEP(13)
            const int mode = (l == DEPTH - 1) ? 2 : (l == 1 ? 1 : 0);
            norm_phase(c, X, mode, mode == 2 ? p.ln_final : p.ln_mix + (size_t)(l + 1) * DM, p.kv_norm, H, HKV);
        END_STEP
    }
#ifdef DIAGBUF
    if ((MASK >> 14) & 1) { MK_CTX(); diag_copy_phase(c, X, ws); }
#else
    if ((MASK >> 14) & 1) { MK_CTX(); MK_P(); rms_final_phase(c, X, p.ln_final); }
#endif
#undef BEGIN_STEP
#undef END_STEP
}

#ifndef N_LAUNCH_CUT
#define N_LAUNCH_CUT 1
#endif
typedef void (*kern_t)(Params);
template <int SITE> static void launch_site(const Params& p, hipStream_t stream) {
    static bool attr = false;
    if (!attr) { (void)hipFuncSetAttribute((const void*)yoco_fwd<(1 << SITE)>, hipFuncAttributeMaxDynamicSharedMemorySize, LDS_BYTES); attr = true; }
    hipLaunchKernelGGL((yoco_fwd<(1 << SITE)>), dim3(256), dim3(512), LDS_BYTES, stream, p);
}
#ifndef MEGASITES
#define MEGASITES 0
#endif
static void launch_step_site(int site, const Params& p, hipStream_t stream) {
    if ((MEGASITES >> site) & 1) { hipLaunchKernelGGL((yoco_fwd<0x3FFF>), dim3(256), dim3(512), LDS_BYTES, stream, p); return; }
    switch (site) {
        case 0: launch_site<0>(p, stream); break; case 1: launch_site<1>(p, stream); break; case 2: launch_site<2>(p, stream); break; case 3: launch_site<3>(p, stream); break;
        case 4: launch_site<4>(p, stream); break; case 5: launch_site<5>(p, stream); break; case 6: launch_site<6>(p, stream); break; case 7: launch_site<7>(p, stream); break;
        case 8: launch_site<8>(p, stream); break; case 9: launch_site<9>(p, stream); break; case 10: launch_site<10>(p, stream); break; case 11: launch_site<11>(p, stream); break; case 12: launch_site<12>(p, stream); break; case 13: launch_site<13>(p, stream); break; default: launch_site<14>(p, stream); break;
    }
}
extern "C" void kernel_launch(void* const* d_in, const int* in_sizes, int n_in, void* d_out, int out_size, void* d_ws, size_t ws_size, hipStream_t stream) {
    static int ready = 0;
    if (ready == 0) {
        if (n_in != 16 || out_size != NTOK * DM || ws_size < WS_END) { fprintf(stderr, "kernel_launch: unexpected sizes (n_in %d out %d ws %zu, need %zu)\n", n_in, out_size, ws_size, (size_t)WS_END); ready = -1; return; }
#if N_LAUNCH_CUT || MEGASITES
        if (hipFuncSetAttribute((const void*)yoco_fwd<0x3FFF>, hipFuncAttributeMaxDynamicSharedMemorySize, LDS_BYTES) != hipSuccess) { fprintf(stderr, "kernel_launch: hipFuncSetAttribute failed\n"); ready = -1; return; }
#endif
        ready = 1;
    }
    if (ready < 0) return;
    (void)hipMemsetAsync(d_ws, 0, 16384, stream);
    Params p{};
    p.x = (const float*)d_in[0]; p.ln_mix = (const float*)d_in[1]; p.ln_ffn = (const float*)d_in[2]; p.ret_w_in = (const float*)d_in[3]; p.ret_w_out = (const float*)d_in[4]; p.ret_gn = (const float*)d_in[5];
    p.kv_norm = (const float*)d_in[6]; p.w_kv = (const float*)d_in[7]; p.att_w_q = (const float*)d_in[8]; p.att_w_o = (const float*)d_in[9]; p.att_rel_bias = (const float*)d_in[10];
    p.peer_w_q = (const float*)d_in[11]; p.peer_sub_keys = (const float*)d_in[12]; p.peer_u = (const float*)d_in[13]; p.peer_v = (const float*)d_in[14]; p.ln_final = (const float*)d_in[15];
    p.out = (float*)d_out; p.ws = (unsigned char*)d_ws;
#if N_LAUNCH_CUT == 2
    for (int s2 = 0; s2 < NSTEPS; ++s2) { p.lo = s2; p.hi = s2 + 1; hipLaunchKernelGGL((yoco_fwd<0x3FFF>), dim3(256), dim3(512), LDS_BYTES, stream, p); }
#elif N_LAUNCH_CUT
    p.lo = 0; p.hi = NSTEPS;
    hipLaunchKernelGGL((yoco_fwd<0x3FFF>), dim3(256), dim3(512), LDS_BYTES, stream, p);
#else
    static const int siteA[10] = {1, 2, 3, 6, 8, 9, 10, 11, 12, 13}, siteB[9] = {4, 5, 6, 8, 9, 10, 11, 12, 13};
    int s = 0;
#ifndef NSTOP
#define NSTOP 1000
#endif
    p.lo = s; p.hi = s + 1; launch_step_site(0, p, stream); ++s;
    for (int l = 0; l < DEPTH; ++l) { const int n = l < 2 ? 10 : 9; for (int k = 0; k < n; ++k) { p.lo = s; p.hi = s + 1; if (s < NSTOP) launch_step_site(l < 2 ? siteA[k] : siteB[k], p, stream); ++s; } }
    if (NSTOP < NSTEPS) { p.lo = -1; p.hi = -1; launch_step_site(14, p, stream); }
#endif
}
```

```cpp
#include <hip/hip_runtime.h>
#include <cstdio>
#include <cstdint>

#define LAS __attribute__((address_space(3)))
#define GAS __attribute__((address_space(1)))
typedef unsigned short bf16;
typedef unsigned u32x2 __attribute__((ext_vector_type(2)));
typedef float f32x2v __attribute__((ext_vector_type(2)));

constexpr int DM = 2048, NBATCH = 4, SEQ = 4096, NTOK = NBATCH * SEQ, DEPTH = 4;
constexpr int CHUNK = 64, NCHUNK = SEQ / CHUNK;
constexpr int RH = 8, RQK = 256, RV = 512, RQKW = RH * RQK, RVW = RH * RV, RIN = 2 * RQKW + 2 * RVW;
constexpr int AH = 16, AHD = 128, LEFT = 8, NREL = 257;
constexpr int PH = 8, PNK = 128, PE = PNK * PNK, PTOPK = 16;
constexpr float EPS = 1e-6f;

constexpr size_t MiB = 1ull << 20;
constexpr size_t WS_CTL = 0, CTL_BYTES = 1 * MiB;
constexpr size_t WS_ROT = 1 * MiB;
constexpr size_t WS_RS = 6 * MiB;
constexpr size_t WS_WIN = 8 * MiB;
constexpr size_t WS_WOUT = 104 * MiB;
constexpr size_t WS_WKV = 136 * MiB;
constexpr size_t WS_WQ = 152 * MiB;
constexpr size_t WS_WO = 168 * MiB;
constexpr size_t WS_WC = 184 * MiB;
constexpr size_t WS_PU = 216 * MiB;
constexpr size_t WS_PV = 472 * MiB;
constexpr size_t WS_H = 728 * MiB;
constexpr size_t WS_HKV = 792 * MiB;
constexpr size_t WS_Q = 856 * MiB;
constexpr size_t WS_K = 920 * MiB;
constexpr size_t WS_V = 984 * MiB;
constexpr size_t WS_G = 1112 * MiB;
constexpr size_t WS_O = 1240 * MiB;
constexpr size_t WS_KV = 1368 * MiB;
constexpr size_t WS_AO = 1496 * MiB;
constexpr size_t WS_SC = 1560 * MiB;
constexpr size_t WS_IDX = 1688 * MiB;
constexpr size_t WS_WGT = 1696 * MiB;
constexpr size_t WS_SQP = 1704 * MiB;
constexpr size_t WS_RSTD = 1706 * MiB;
constexpr size_t WS_END = 1708 * MiB;

constexpr int LDS_BYTES = 160 * 1024;
constexpr int LDS_MISC = LDS_BYTES - 256;

__device__ __forceinline__ unsigned f2bf(float f) { unsigned u = __builtin_bit_cast(unsigned, f); return (u + 0x7fffu + ((u >> 16) & 1u)) >> 16; }
typedef __bf16 bfx2_t __attribute__((ext_vector_type(2)));
__device__ __forceinline__ unsigned pk2(float lo, float hi) { const f32x2v v = {lo, hi}; return __builtin_bit_cast(unsigned, __builtin_convertvector(v, bfx2_t)); }
__device__ __forceinline__ float bflo(unsigned u) { return __builtin_bit_cast(float, u << 16); }
__device__ __forceinline__ float bfhi(unsigned u) { return __builtin_bit_cast(float, u & 0xffff0000u); }
__device__ __forceinline__ float wave_sum(float v) {
#pragma unroll
    for (int o = 1; o < 64; o <<= 1) v += __shfl_xor(v, o);
    return v;
}
#define VM_WAIT() asm volatile("s_waitcnt vmcnt(0)" ::: "memory")
#define LDS_WAIT() asm volatile("s_waitcnt lgkmcnt(0)" ::: "memory")

#define XB_TMO      128
#define XB_XCNT(j)  (256  + 64 * (j))
#define XB_XSUB(j)  (1280 + 64 * (j))
#define XB_XGEN(j)  (2304 + 64 * (j))
#define XB_TOP      3328
#define XB_TOPGEN   3392
#define XCD_BAR_WORDS 3456
#define XB_SPIN_CAP (1u << 18)

__device__ __forceinline__ unsigned xb_ld(unsigned* p)              { return __hip_atomic_load(p, __ATOMIC_RELAXED, __HIP_MEMORY_SCOPE_AGENT); }
__device__ __forceinline__ unsigned xb_add(unsigned* p, unsigned v) { return __hip_atomic_fetch_add(p, v, __ATOMIC_RELAXED, __HIP_MEMORY_SCOPE_AGENT); }
__device__ __forceinline__ unsigned xb_xcc_id() { return (unsigned)__builtin_amdgcn_s_getreg((3 << 11) | 20) & 0xFu; }
#define XB_SPIN(cond, bar) do { unsigned _sp = 0; while (cond) { __builtin_amdgcn_s_sleep(1); \
    if ((++_sp & 255u) == 0u) { if (xb_ld(&(bar)[XB_TMO])) break; if (_sp > XB_SPIN_CAP) { atomicAdd(&(bar)[XB_TMO], 1u); break; } } } } while (0)

struct XcdBarrier {
    unsigned* bar; unsigned x;
    volatile LAS unsigned* st;
};

__device__ __forceinline__ XcdBarrier xcd_barrier_post(unsigned* bar, volatile LAS unsigned* st) {
    XcdBarrier b; b.bar = bar; b.x = xb_xcc_id(); b.st = st;
    if (threadIdx.x == 0) (void)xb_add(&bar[XB_XCNT(b.x)], 1u);
    return b;
}
__device__ __forceinline__ void xcd_barrier_complete(unsigned* bar, unsigned x, unsigned& nloc, unsigned& nx) {
    const unsigned G = gridDim.x * gridDim.y * gridDim.z;
    unsigned sum, cnt, mine, sp = 0u;
    for (;;) {
        sum = 0u; cnt = 0u; mine = 0u;
#pragma unroll
        for (unsigned j = 0; j < 16; ++j) { const unsigned c = xb_ld(&bar[XB_XCNT(j)]); sum += c; cnt += (c > 0u) ? 1u : 0u; mine = (j == x) ? c : mine; }
        if (sum == G) break;
        __builtin_amdgcn_s_sleep(1);
        if ((++sp & 255u) == 0u) { if (xb_ld(&bar[XB_TMO])) break; if (sp > XB_SPIN_CAP) { atomicAdd(&bar[XB_TMO], 1u); break; } }
    }
    nloc = mine > 0u ? mine : 1u; nx = cnt > 0u ? cnt : 1u;
}

__device__ __forceinline__ void xcd_barrier(const XcdBarrier& b) {
    asm volatile("s_waitcnt vmcnt(0)" ::: "memory");
    __syncthreads();
    if (threadIdx.x == 0) {
        unsigned* bar = b.bar;
        __builtin_amdgcn_s_waitcnt(0);
        unsigned nloc = b.st[0], nx = b.st[1];
        if (nloc == 0u) { xcd_barrier_complete(bar, b.x, nloc, nx); b.st[0] = nloc; b.st[1] = nx; }
        const unsigned old = xb_add(&bar[XB_XSUB(b.x)], 1u);
        const unsigned gen = old / nloc;
        if (old + 1u == (gen + 1u) * nloc) {
            __builtin_amdgcn_fence(__ATOMIC_RELEASE, "agent");
            asm volatile("s_waitcnt vmcnt(0)" ::: "memory");
            const unsigned og = xb_add(&bar[XB_TOP], 1u);
            const unsigned tg = og / nx;
            if (og + 1u == (tg + 1u) * nx) xb_add(&bar[XB_TOPGEN], 1u);
            else XB_SPIN(xb_ld(&bar[XB_TOPGEN]) == tg, bar);
            __builtin_amdgcn_fence(__ATOMIC_ACQUIRE, "agent");
            xb_add(&bar[XB_XGEN(b.x)], 1u);
            asm volatile("s_waitcnt vmcnt(0)" ::: "memory");
        } else {
            XB_SPIN(xb_ld(&bar[XB_XGEN(b.x)]) == gen, bar);
            __builtin_amdgcn_fence(__ATOMIC_ACQUIRE, "agent");
            asm volatile("s_waitcnt vmcnt(0)" ::: "memory");
        }
    }
    __syncthreads();
}

namespace pg8 {
#define PG8_LAS __attribute__((address_space(3)))
typedef unsigned short bf16_t;
typedef short bf16x8 __attribute__((ext_vector_type(8)));
typedef float f32x4 __attribute__((ext_vector_type(4)));
typedef unsigned u32x4 __attribute__((ext_vector_type(4)));
constexpr int BM = 256, BK = 64, HALF = 128, HTB = HALF * BK * 2  , STAGE_BYTES = 8 * HTB, NXCD = 8, WGM = 8;

__host__ __device__ __forceinline__ int lds_byte(int r, int c) { const int st = (r >> 4) * 2 + (c >> 5), rr = r & 15, cc = c & 31, ob = rr * 64 + cc * 2; return st * 1024 + (ob ^ (((ob >> 9) & 1) << 5)); }
__host__ __device__ __forceinline__ void stage_rc(int b, int& R, int& C) { const int st = b / 1024, sb = b % 1024, swz = sb ^ (((sb >> 9) & 1) << 5); R = (st >> 1) * 16 + swz / 64; C = (st & 1) * 32 + (swz % 64) / 2; }
__host__ __device__ __forceinline__ int perm32(int rho) { const int n = rho >> 4, i = rho & 15; return 8 * (i >> 2) + 4 * n + (i & 3); }

struct Unit { int pm, pn; };
struct Gemm { const bf16_t* A; const bf16_t* Bt; int M, N, K; };

struct StaticOrder {
    int nM, nN, nwg, G, c;
    __host__ __device__ void init(int M, int N, int G_, int c_) { nM = M / BM; nN = N / BM; nwg = nM * nN; G = G_; c = c_; }
    __host__ __device__ bool next(int i, Unit& u) const {
        const long L = (long)i * G + c; if (L >= nwg) return false;
        int wgid = (int)L; { const int q = nwg / NXCD, r = nwg % NXCD, xcd = wgid % NXCD, off = wgid / NXCD; wgid = (xcd < r ? xcd * (q + 1) : r * (q + 1) + (xcd - r) * q) + off; }
        const int nig = WGM * nN, gid = wgid / nig, fm = gid * WGM, gsz = (nM - fm) < WGM ? (nM - fm) : WGM;
        u.pm = fm + ((wgid % nig) % gsz); u.pn = (wgid % nig) / gsz; return true;
    }
    __device__ __forceinline__ void a_ready(const Unit&) const {}
    __device__ __forceinline__ void done(const Unit&) const {}
};
struct CountedOrder : StaticOrder {
    const unsigned* ready; unsigned need; unsigned* tmo;
    __device__ __forceinline__ void a_ready(const Unit& u) const {
        if (threadIdx.x < 64) {
            const unsigned long long t0 = __builtin_amdgcn_s_memrealtime(); unsigned polls = 0;
            while ((unsigned)__builtin_amdgcn_readfirstlane(__hip_atomic_load(ready + 64 * u.pm, __ATOMIC_RELAXED, __HIP_MEMORY_SCOPE_AGENT)) < need) {
                if ((++polls & 255u) == 0u && __builtin_amdgcn_readfirstlane(__hip_atomic_load(tmo, __ATOMIC_RELAXED, __HIP_MEMORY_SCOPE_AGENT)) != 0u) break;
                if (__builtin_amdgcn_s_memrealtime() - t0 > 2000000ull) {
                    if (threadIdx.x == 0) { unsigned expect = 0u; __hip_atomic_compare_exchange_strong(tmo + 1, &expect, 0x600u | (unsigned)(u.pm & 0xff), __ATOMIC_RELAXED, __ATOMIC_RELAXED, __HIP_MEMORY_SCOPE_AGENT); __hip_atomic_store(tmo, 1u, __ATOMIC_RELAXED, __HIP_MEMORY_SCOPE_AGENT); }
                    break; }
                __builtin_amdgcn_s_sleep(2); }
            __builtin_amdgcn_fence(__ATOMIC_ACQUIRE, "agent");
            asm volatile("s_waitcnt vmcnt(0)" ::: "memory");
        }
#if !defined(BROKEN_HOOK_NO_BARRIER)
        asm volatile("" ::: "memory"); __builtin_amdgcn_s_barrier(); asm volatile("" ::: "memory");
#endif
    }
};

__device__ __forceinline__ unsigned cvt_pk_bf16(float lo, float hi) { return pk2(lo, hi); }
typedef float f32x2 __attribute__((ext_vector_type(2)));
__device__ __forceinline__ f32x2 gelu_pk(f32x2 v) {
    const f32x2 av = __builtin_elementwise_abs(v), d = av * 0.2316418882f + 1.0f;
    f32x2 t; t.x = __builtin_amdgcn_rcpf(d.x); t.y = __builtin_amdgcn_rcpf(d.y);
    f32x2 q = t * 0.5307027145f + (-0.7265760135f); q = q * t + 0.7107068705f; q = q * t + (-0.142248368f); q = q * t + 0.127414796f; q = q * t;
    const f32x2 s = (v * v) * (-0.72134752044f);
    f32x2 e; e.x = __builtin_amdgcn_exp2f(s.x); e.y = __builtin_amdgcn_exp2f(s.y);
    const f32x2 m = v * (q * e), r = v - m;
    f32x2 o; o.x = v.x < 0.f ? m.x : r.x; o.y = v.y < 0.f ? m.y : r.y; return o;
}


struct EpiF32 {
    static constexpr bool PERM = false, AFTER_DRAIN = false;
    float* C; int ldc;
    __device__ __forceinline__ void operator()(const f32x4 (&acc)[2][2][4][2], const Unit& u, int wr, int wc, int fr, int fq) const {
        const int row0 = u.pm * BM + wr * 64 + fr, col0 = u.pn * BM + wc * 32 + 4 * fq;
#pragma unroll
        for (int ai = 0; ai < 2; ++ai)
#pragma unroll
            for (int m = 0; m < 4; ++m) { float* rowp = C + (size_t)(row0 + ai * HALF + m * 16) * ldc + col0;
#pragma unroll
                for (int bj = 0; bj < 2; ++bj)
#pragma unroll
                    for (int n = 0; n < 2; ++n) *(f32x4*)(rowp + bj * HALF + n * 16) = acc[ai][bj][m][n]; }
    }
};
struct EpiRes {
    static constexpr bool PERM = false, AFTER_DRAIN = false;
    float* X; int ldc; bf16_t* Hn; const float* gn; float* sqp;
    __device__ __forceinline__ void operator()(const f32x4 (&acc)[2][2][4][2], const Unit& u, int wr, int wc, int fr, int fq) const {
        const int row0 = u.pm * BM + wr * 64 + fr, col0 = u.pn * BM + wc * 32 + 4 * fq;
        f32x4 gv[2][2];
#pragma unroll
        for (int bj = 0; bj < 2; ++bj)
#pragma unroll
            for (int n = 0; n < 2; ++n) gv[bj][n] = *(const f32x4*)(gn + col0 + bj * HALF + n * 16);
#pragma unroll
        for (int ai = 0; ai < 2; ++ai) {
            f32x4 old[4][2][2];
#pragma unroll
            for (int m = 0; m < 4; ++m) { const float* rp = X + (size_t)(row0 + ai * HALF + m * 16) * ldc + col0;
#pragma unroll
                for (int bj = 0; bj < 2; ++bj)
#pragma unroll
                    for (int n = 0; n < 2; ++n) old[m][bj][n] = *(const f32x4*)(rp + bj * HALF + n * 16); }
#pragma unroll
            for (int m = 0; m < 4; ++m) { const int r = row0 + ai * HALF + m * 16; float* rowp = X + (size_t)r * ldc + col0; bf16_t* hp = Hn + (size_t)r * ldc + col0;
                float ss = 0.f;
#pragma unroll
                for (int bj = 0; bj < 2; ++bj)
#pragma unroll
                    for (int n = 0; n < 2; ++n) { const f32x4 xn = old[m][bj][n] + acc[ai][bj][m][n]; *(f32x4*)(rowp + bj * HALF + n * 16) = xn;
                        ss += (xn[0] * xn[0] + xn[1] * xn[1]) + (xn[2] * xn[2] + xn[3] * xn[3]);
                        const f32x4 hg = xn * gv[bj][n]; u32x2 hw; hw.x = pk2(hg[0], hg[1]); hw.y = pk2(hg[2], hg[3]); *(u32x2*)(hp + bj * HALF + n * 16) = hw; }
                ss += __shfl_xor(ss, 16); ss += __shfl_xor(ss, 32);
                if (fq == 0) sqp[(size_t)r * 32 + u.pn * 4 + wc] = ss; }
        }
    }
};
struct EpiBf16S {
    static constexpr bool PERM = true, AFTER_DRAIN = false;
    bf16_t* O; int ldc; float scale;
    __device__ __forceinline__ void operator()(const f32x4 (&acc)[2][2][4][2], const Unit& u, int wr, int wc, int fr, int fq) const {
        const int row0 = u.pm * BM + wr * 64 + fr, col0 = u.pn * BM + wc * 32 + 8 * fq;
#pragma unroll
        for (int ai = 0; ai < 2; ++ai)
#pragma unroll
            for (int m = 0; m < 4; ++m) { bf16_t* rowp = O + (size_t)(row0 + ai * HALF + m * 16) * ldc + col0;
#pragma unroll
                for (int bj = 0; bj < 2; ++bj) { const f32x4 v0 = acc[ai][bj][m][0] * scale, v1 = acc[ai][bj][m][1] * scale;
                    u32x4 w; w.x = cvt_pk_bf16(v0[0], v0[1]); w.y = cvt_pk_bf16(v0[2], v0[3]); w.z = cvt_pk_bf16(v1[0], v1[1]); w.w = cvt_pk_bf16(v1[2], v1[3]);
                    *(u32x4*)(rowp + bj * HALF) = w; } }
    }
};
struct EpiProj {
    static constexpr bool PERM = true, AFTER_DRAIN = false;
    bf16_t *Q, *Kp, *V, *G; const float* rot;
    __device__ __forceinline__ void operator()(const f32x4 (&acc)[2][2][4][2], const Unit& u, int wr, int wc, int fr, int fq) const {
        const int row0 = u.pm * BM + wr * 64 + fr, pn = u.pn, dd0 = wc * 32 + 8 * fq;
        if (pn < 16) {
            bf16_t* base = (pn < 8 ? Q : Kp) + (pn & 7) * 256 + dd0; const float sc = pn < 8 ? 1.0f : 0.0625f;
#pragma unroll
            for (int ai = 0; ai < 2; ++ai)
#pragma unroll
                for (int m = 0; m < 4; ++m) { const int r = row0 + ai * HALF + m * 16; const float* rt = rot + (size_t)(r & (4096 - 1)) * 256 + dd0;
                    f32x4 o1[2], o2[2];
#pragma unroll
                    for (int n = 0; n < 2; ++n) { const f32x4 cs = *(const f32x4*)(rt + 4 * n), sn = *(const f32x4*)(rt + 128 + 4 * n); const f32x4 t1 = acc[ai][0][m][n], t2 = acc[ai][1][m][n];
                        o1[n] = (t1 * cs - t2 * sn) * sc; o2[n] = (t1 * sn + t2 * cs) * sc; }
                    u32x4 w1, w2;
                    w1.x = cvt_pk_bf16(o1[0][0], o1[0][1]); w1.y = cvt_pk_bf16(o1[0][2], o1[0][3]); w1.z = cvt_pk_bf16(o1[1][0], o1[1][1]); w1.w = cvt_pk_bf16(o1[1][2], o1[1][3]);
                    w2.x = cvt_pk_bf16(o2[0][0], o2[0][1]); w2.y = cvt_pk_bf16(o2[0][2], o2[0][3]); w2.z = cvt_pk_bf16(o2[1][0], o2[1][1]); w2.w = cvt_pk_bf16(o2[1][2], o2[1][3]);
                    bf16_t* rowp = base + (size_t)r * 2048; *(u32x4*)rowp = w1; *(u32x4*)(rowp + 128) = w2; }
        } else {
            bf16_t* base = (pn < 32 ? V : G) + ((pn - 16) & 15) * 256 + dd0;
#pragma unroll
            for (int ai = 0; ai < 2; ++ai)
#pragma unroll
                for (int m = 0; m < 4; ++m) { bf16_t* rowp = base + (size_t)(row0 + ai * HALF + m * 16) * 4096;
#pragma unroll
                    for (int bj = 0; bj < 2; ++bj) { const f32x4 v0 = acc[ai][bj][m][0], v1 = acc[ai][bj][m][1];
                        u32x4 w; w.x = cvt_pk_bf16(v0[0], v0[1]); w.y = cvt_pk_bf16(v0[2], v0[3]); w.z = cvt_pk_bf16(v1[0], v1[1]); w.w = cvt_pk_bf16(v1[2], v1[3]);
                        *(u32x4*)(rowp + bj * HALF) = w; } }
        }
    }
};
template <class Epi, class Sched, bool STAMP = false>
__device__ __forceinline__ void gemm_phase(PG8_LAS unsigned char* lds, const Gemm g, const Sched& S, const Epi& E, unsigned long long* stamps) {
    int tid_ = threadIdx.x; asm volatile("" : "+v"(tid_));
    const int tid = tid_, wid = __builtin_amdgcn_readfirstlane(tid >> 6), lane = tid & 63, wr = wid >> 2, wc = wid & 3, fr = lane & 15, fq = lane >> 4;
    const int K = g.K, nt = K / BK;
    int ts_lo = 0, ts_hi = 0, nts = 0; const unsigned long long rt_entry = STAMP ? (unsigned long long)wall_clock64() : 0ull;
#define PG8_STAMP() do { if (STAMP && wid == 0 && nts < 64) { const unsigned long long _c = (unsigned long long)clock64(); \
        ts_lo = (lane == nts) ? (int)(unsigned)_c : ts_lo; ts_hi = (lane == nts) ? (int)(unsigned)(_c >> 32) : ts_hi; ++nts; } } while (0)
    PG8_STAMP();
    unsigned voffA[2], voffB[2];
#pragma unroll
    for (int i = 0; i < 2; ++i) { int R, C; stage_rc(tid * 16 + i * 8192, R, C); const int Rb = Epi::PERM ? ((R & ~31) + perm32(R & 31)) : R;
        voffA[i] = (unsigned)(R * K + C) * 2u; voffB[i] = (unsigned)(Rb * K + C) * 2u; }
    const size_t kstep = (size_t)(BK * 2);
    const size_t hstep = (size_t)HALF * K * 2;
    const size_t tstep = 2 * hstep;
    const unsigned ldsw = (unsigned)wid * 1024u;
    const int aoff = lds_byte(wr * 64 + fr, fq * 8), boff = lds_byte(wc * 32 + fr, fq * 8);
#define PG8_SA(b, h) (((b) * 2 + (h)) * HTB)
#define PG8_SB(b, h) ((4 + (b) * 2 + (h)) * HTB)
#define PG8_STAGE(bufoff, gbase, voff) do { _Pragma("unroll") for (int _i = 0; _i < 2; ++_i) \
        __builtin_amdgcn_global_load_lds((const unsigned*)((const char*)(gbase) + (voff)[_i]), (PG8_LAS unsigned*)(lds + (bufoff) + ldsw + _i * 8192), 16, 0, 0); } while (0)
#define PG8_LDA(dst, b, h) do { _Pragma("unroll") for (int m = 0; m < 4; ++m) _Pragma("unroll") for (int k = 0; k < 2; ++k) dst[m][k] = *(const PG8_LAS bf16x8*)(lds + PG8_SA(b, h) + aoff + m * 2048 + k * 1024); } while (0)
#define PG8_LDB(dst, b, h) do { _Pragma("unroll") for (int n = 0; n < 2; ++n) _Pragma("unroll") for (int k = 0; k < 2; ++k) dst[n][k] = *(const PG8_LAS bf16x8*)(lds + PG8_SB(b, h) + boff + n * 2048 + k * 1024); } while (0)
#define PG8_MMA(ai, bj, At, Bt) do { __builtin_amdgcn_s_setprio(1); _Pragma("unroll") for (int m = 0; m < 4; ++m) _Pragma("unroll") for (int n = 0; n < 2; ++n) _Pragma("unroll") for (int k = 0; k < 2; ++k) \
        acc[ai][bj][m][n] = __builtin_amdgcn_mfma_f32_16x16x32_bf16(Bt[n][k], At[m][k], acc[ai][bj][m][n], 0, 0, 0); __builtin_amdgcn_s_setprio(0); } while (0)
#define PG8_WAIT_V(n) asm volatile("s_waitcnt vmcnt(" #n ")" ::: "memory")
#define PG8_WAIT_L(n) asm volatile("s_waitcnt lgkmcnt(" #n ")" ::: "memory")
#define PG8_BAR __builtin_amdgcn_s_barrier()
#define PG8_SCHED __builtin_amdgcn_sched_barrier(0)
    Unit cur, nxt; int ui = 0;
    if (!S.next(0, cur)) return;
    f32x4 acc[2][2][4][2];
#pragma unroll
    for (int a = 0; a < 2; ++a)
#pragma unroll
        for (int b = 0; b < 2; ++b)
#pragma unroll
            for (int m = 0; m < 4; ++m)
#pragma unroll
                for (int n = 0; n < 2; ++n) acc[a][b][m][n] = (f32x4){0.f, 0.f, 0.f, 0.f};
    bf16x8 At[4][2], B0[2][2], B1[2][2];
    const char* cA = (const char*)g.A + (size_t)cur.pm * tstep; const char* cB = (const char*)g.Bt + (size_t)cur.pn * tstep;
    S.a_ready(cur);
    PG8_STAGE(PG8_SB(0, 0), cB, voffB); PG8_STAGE(PG8_SA(0, 0), cA, voffA); PG8_STAGE(PG8_SB(0, 1), cB + hstep, voffB); PG8_STAGE(PG8_SA(0, 1), cA + hstep, voffA);
    if (wr == 1) PG8_BAR;
    PG8_WAIT_V(4); PG8_BAR;
    PG8_STAGE(PG8_SB(1, 0), cB + kstep, voffB); PG8_STAGE(PG8_SA(1, 0), cA + kstep, voffA); PG8_STAGE(PG8_SB(1, 1), cB + hstep + kstep, voffB);
    PG8_WAIT_V(6); PG8_BAR;
    PG8_STAMP();
    for (;;) {
        const bool has_next = S.next(ui + 1, nxt);
        const char* nA = has_next ? (const char*)g.A + (size_t)nxt.pm * tstep : cA; const char* nB = has_next ? (const char*)g.Bt + (size_t)nxt.pn * tstep : cB;
        for (int t = 0; t < nt; t += 2) {
            const bool last = (t == nt - 2);
            const char* a1 = cA + (size_t)(t + 1) * kstep;
            const char* a2 = last ? nA : cA + (size_t)(t + 2) * kstep; const char* b2 = last ? nB : cB + (size_t)(t + 2) * kstep;
            const char* a3 = a2 + kstep; const char* b3 = b2 + kstep;
            if (last && has_next) S.a_ready(nxt);
            PG8_LDB(B0, 0, 0); PG8_SCHED; PG8_LDA(At, 0, 0); PG8_STAGE(PG8_SA(1, 1), a1 + hstep, voffA);
            PG8_WAIT_L(8); PG8_BAR; PG8_WAIT_L(0); PG8_MMA(0, 0, At, B0); PG8_BAR; PG8_SCHED;
            PG8_LDB(B1, 0, 1); PG8_STAGE(PG8_SB(0, 0), b2, voffB);
            PG8_BAR; PG8_WAIT_L(0); PG8_MMA(0, 1, At, B1); PG8_BAR;
            PG8_LDA(At, 0, 1); PG8_STAGE(PG8_SA(0, 0), a2, voffA);
            PG8_BAR; PG8_WAIT_L(0); PG8_MMA(1, 0, At, B0); PG8_BAR; PG8_SCHED;
            PG8_STAGE(PG8_SB(0, 1), b2 + hstep, voffB);
            PG8_WAIT_V(6); PG8_BAR; PG8_MMA(1, 1, At, B1); PG8_BAR;
            PG8_LDB(B0, 1, 0); PG8_SCHED; PG8_LDA(At, 1, 0); PG8_STAGE(PG8_SA(0, 1), a2 + hstep, voffA);
            PG8_WAIT_L(8); PG8_BAR; PG8_WAIT_L(0); PG8_MMA(0, 0, At, B0); PG8_BAR; PG8_SCHED;
            PG8_LDB(B1, 1, 1); PG8_STAGE(PG8_SB(1, 0), b3, voffB);
            PG8_BAR; PG8_WAIT_L(0); PG8_MMA(0, 1, At, B1); PG8_BAR;
            PG8_LDA(At, 1, 1); PG8_STAGE(PG8_SA(1, 0), a3, voffA);
            PG8_BAR; PG8_WAIT_L(0); PG8_MMA(1, 0, At, B0); PG8_BAR; PG8_SCHED;
            PG8_STAGE(PG8_SB(1, 1), b3 + hstep, voffB);
            PG8_WAIT_V(6); PG8_BAR; PG8_MMA(1, 1, At, B1); PG8_BAR;
        }
        PG8_STAMP();
        if constexpr (!Epi::AFTER_DRAIN) { E(acc, cur, wr, wc, fr, fq); S.done(cur); }
        PG8_STAMP();
        if (!has_next) break;
#pragma unroll
        for (int a = 0; a < 2; ++a)
#pragma unroll
            for (int b = 0; b < 2; ++b)
#pragma unroll
                for (int m = 0; m < 4; ++m)
#pragma unroll
                    for (int n = 0; n < 2; ++n) acc[a][b][m][n] = (f32x4){0.f, 0.f, 0.f, 0.f};
        cur = nxt; cA = nA; cB = nB; ++ui;
    }
    PG8_WAIT_V(0);
    if (wr == 0) PG8_BAR;
    PG8_BAR;
    if constexpr (Epi::AFTER_DRAIN) { E.fused(acc, cur, wr, wc, fr, fq, lds, wid, lane); S.done(cur); }
    PG8_STAMP();
    if (STAMP && wid == 0) { stamps[lane] = lane < nts ? (((unsigned long long)(unsigned)ts_hi << 32) | (unsigned)ts_lo) : 0ull;
        if (lane == 62) stamps[62] = rt_entry; if (lane == 63) stamps[63] = (unsigned long long)wall_clock64(); }
#undef PG8_STAMP
#undef PG8_SA
#undef PG8_SB
#undef PG8_STAGE
#undef PG8_LDA
#undef PG8_LDB
#undef PG8_MMA
#undef PG8_WAIT_V
#undef PG8_WAIT_L
#undef PG8_BAR
#undef PG8_SCHED
}
}

using pg8::bf16x8; using pg8::f32x4; using pg8::u32x4;
typedef short s16x4 __attribute__((ext_vector_type(4)));
typedef __bf16 bfx2 __attribute__((ext_vector_type(2)));

struct Params {
    const float *x, *ln_mix, *ln_ffn, *ret_w_in, *ret_w_out, *ret_gn, *kv_norm, *w_kv, *att_w_q, *att_w_o, *att_rel_bias, *peer_w_q, *peer_sub_keys, *peer_u, *peer_v, *ln_final;
    float* out; unsigned char* ws; int lo, hi;
};
struct Ctx { LAS unsigned char* lds; int tid, lane, wave, bx, G, gw, ngw; };

__device__ __forceinline__ float dot2bf(unsigned a, unsigned b, float c) { return __builtin_amdgcn_fdot2_f32_bf16(__builtin_bit_cast(bfx2, a), __builtin_bit_cast(bfx2, b), c, false); }
__device__ __forceinline__ bf16x8 lds128(LAS const unsigned char* p) { return *(LAS const bf16x8*)p; }
__device__ __forceinline__ bf16x8 tr_frag(unsigned a0, unsigned a1) {
    s16x4 lo, hi;
    asm volatile("ds_read_b64_tr_b16 %0, %2\n\tds_read_b64_tr_b16 %1, %3\n\ts_waitcnt lgkmcnt(0)" : "=&v"(lo), "=&v"(hi) : "v"(a0), "v"(a1) : "memory");
    bf16x8 r; r[0] = lo[0]; r[1] = lo[1]; r[2] = lo[2]; r[3] = lo[3]; r[4] = hi[0]; r[5] = hi[1]; r[6] = hi[2]; r[7] = hi[3]; return r;
}
#define MFMA16(a, b, c) __builtin_amdgcn_mfma_f32_16x16x32_bf16((a), (b), (c), 0, 0, 0)

__device__ __forceinline__ void load_row(const float* xrow, int lane, f32x4 (&v)[8]) {
    const f32x4* xr = (const f32x4*)xrow + lane;
#pragma unroll
    for (int j = 0; j < 8; ++j) v[j] = xr[64 * j];
}
__device__ __forceinline__ float row_rstd(const f32x4 (&v)[8]) {
    float s = 0.f;
#pragma unroll
    for (int j = 0; j < 8; ++j) s += (v[j][0] * v[j][0] + v[j][1] * v[j][1]) + (v[j][2] * v[j][2] + v[j][3] * v[j][3]);
    return 1.0f / sqrtf(wave_sum(s) * (1.0f / DM) + EPS);
}
__device__ __forceinline__ void store_norm_bf16(const f32x4 (&v)[8], float rstd, const float* g, bf16* orow, int lane) {
    const f32x4* gr = (const f32x4*)g + lane; u32x2* o8 = (u32x2*)orow + lane;
#pragma unroll
    for (int j = 0; j < 8; ++j) { const f32x4 gv = gr[64 * j]; u32x2 w; w.x = pk2(v[j][0] * rstd * gv[0], v[j][1] * rstd * gv[1]); w.y = pk2(v[j][2] * rstd * gv[2], v[j][3] * rstd * gv[3]); o8[64 * j] = w; }
}
__device__ __forceinline__ void load_g(const float* g, int lane, f32x4 (&gv)[8]) {
    const f32x4* gr = (const f32x4*)g + lane;
#pragma unroll
    for (int j = 0; j < 8; ++j) gv[j] = gr[64 * j];
}
__device__ __forceinline__ void store_norm_bf16_r(const f32x4 (&v)[8], float rstd, const f32x4 (&gv)[8], bf16* orow, int lane) {
    u32x2* o8 = (u32x2*)orow + lane;
#pragma unroll
    for (int j = 0; j < 8; ++j) { u32x2 w; w.x = pk2(v[j][0] * rstd * gv[j][0], v[j][1] * rstd * gv[j][1]); w.y = pk2(v[j][2] * rstd * gv[j][2], v[j][3] * rstd * gv[j][3]); o8[64 * j] = w; }
}
__device__ __forceinline__ unsigned q8pack(float a, float b, float c, float d) {
    const unsigned ua = __builtin_bit_cast(unsigned, a + 12582912.0f), ub = __builtin_bit_cast(unsigned, b + 12582912.0f), uc = __builtin_bit_cast(unsigned, c + 12582912.0f), ud = __builtin_bit_cast(unsigned, d + 12582912.0f);
    return (ua & 255u) | ((ub & 255u) << 8) | ((uc & 255u) << 16) | (ud << 24);
}

__device__ __forceinline__ void p0_transpose_item(const float* W, int K, int N, bf16* WT, LAS float* scr, int item, int lane) {
    const int nblk = N / 32, kb = item / nblk, nb = item % nblk, k0 = 64 * kb, n0 = 32 * nb;
    float tv[32];
#pragma unroll
    for (int i = 0; i < 32; ++i) { const int kk = 2 * i + (lane >> 5); tv[i] = W[(size_t)(k0 + kk) * N + n0 + (lane & 31)]; }
#pragma unroll
    for (int i = 0; i < 32; ++i) { const int kk = 2 * i + (lane >> 5); scr[kk * 33 + (lane & 31)] = tv[i]; }
    LDS_WAIT(); asm volatile("" ::: "memory");
    const int c = lane & 7;
#pragma unroll
    for (int j = 0; j < 4; ++j) { const int n = (lane >> 3) + 8 * j; const LAS float* s = scr + (8 * c) * 33 + n;
        u32x4 o; o.x = pk2(s[0 * 33], s[1 * 33]); o.y = pk2(s[2 * 33], s[3 * 33]); o.z = pk2(s[4 * 33], s[5 * 33]); o.w = pk2(s[6 * 33], s[7 * 33]);
        *(u32x4*)(WT + (size_t)(n0 + n) * K + k0 + 8 * c) = o; }
    LDS_WAIT(); asm volatile("" ::: "memory");
}
__device__ __forceinline__ void p0_fold_tile(const Params& p, const Ctx& c, int tl) {
    const int l = tl >> 9, hp = (tl >> 5) & 15, j0 = (tl & 31) * 64;
    LAS float* As = (LAS float*)c.lds;
    LAS float* Bs = (LAS float*)c.lds + 64 * 132;
    const float* Wq = p.peer_w_q + (size_t)l * DM * DM; const float* sk = p.peer_sub_keys + ((size_t)l * 2 + (hp & 1)) * PNK * 128;
    __syncthreads();
    for (int i = c.tid; i < 64 * 32; i += 512) { const int jj = i >> 5, d4 = i & 31; *(LAS f32x4*)(As + jj * 132 + d4 * 4) = *(const f32x4*)(Wq + (size_t)(j0 + jj) * DM + hp * 128 + d4 * 4); }
    for (int i = c.tid; i < 128 * 32; i += 512) { const int k = i >> 5, d4 = i & 31; *(LAS f32x4*)(Bs + k * 132 + d4 * 4) = *(const f32x4*)(sk + (size_t)k * 128 + d4 * 4); }
    __syncthreads();
    const int tj = c.tid & 15, tk = c.tid >> 4;
    float acc[4][4];
#pragma unroll
    for (int b = 0; b < 4; ++b)
#pragma unroll
        for (int a = 0; a < 4; ++a) acc[b][a] = 0.f;
    for (int d4 = 0; d4 < 32; ++d4) {
        f32x4 av[4], bv[4];
#pragma unroll
        for (int a = 0; a < 4; ++a) av[a] = *(LAS const f32x4*)(As + (tj + 16 * a) * 132 + d4 * 4);
#pragma unroll
        for (int b = 0; b < 4; ++b) bv[b] = *(LAS const f32x4*)(Bs + (tk * 4 + b) * 132 + d4 * 4);
#pragma unroll
        for (int b = 0; b < 4; ++b)
#pragma unroll
            for (int a = 0; a < 4; ++a) acc[b][a] += (av[a][0] * bv[b][0] + av[a][1] * bv[b][1]) + (av[a][2] * bv[b][2] + av[a][3] * bv[b][3]);
    }
    bf16* WcT = (bf16*)(p.ws + WS_WC) + (size_t)l * DM * DM;
#pragma unroll
    for (int b = 0; b < 4; ++b)
#pragma unroll
        for (int a = 0; a < 4; ++a) WcT[(size_t)(hp * 128 + tk * 4 + b) * DM + j0 + tj + 16 * a] = (bf16)f2bf(acc[b][a]);
}
__device__ __forceinline__ void p0_prologue(const Params& p, const Ctx& c) {
#ifndef PROREP
#define PROREP 0
#endif
    const bool fold_last = (c.bx & 1) != 0;
    if (!fold_last) {
    for (int tl = c.bx; tl < DEPTH * 16 * 32; tl += c.G) p0_fold_tile(p, c, tl);
    __syncthreads();
    }
    for (int rp_ = ((PROREP >> 1) & 1) ? 0 : 1; rp_ < 2; ++rp_)
    {
        LAS float* scr = (LAS float*)(c.lds + c.wave * 16384);
        constexpr int I_IN = (DM / 64) * (RIN / 32), I_OUT = (RVW / 64) * (DM / 32), I_KV = (DM / 64) * (2 * DM / 32), I_SQ = (DM / 64) * (DM / 32);
        constexpr int NITEMS = 2 * I_IN + 2 * I_OUT + I_KV + 4 * I_SQ;
        for (int it = c.gw; it < NITEMS; it += c.ngw) {
            int r = it;
            if (r < 2 * I_IN) { const int l = r / I_IN; p0_transpose_item(p.ret_w_in + (size_t)l * DM * RIN, DM, RIN, (bf16*)(p.ws + WS_WIN) + (size_t)l * RIN * DM, scr, r % I_IN, c.lane); continue; } r -= 2 * I_IN;
            if (r < 2 * I_OUT) { const int l = r / I_OUT; p0_transpose_item(p.ret_w_out + (size_t)l * RVW * DM, RVW, DM, (bf16*)(p.ws + WS_WOUT) + (size_t)l * DM * RVW, scr, r % I_OUT, c.lane); continue; } r -= 2 * I_OUT;
            if (r < I_KV) { p0_transpose_item(p.w_kv, DM, 2 * DM, (bf16*)(p.ws + WS_WKV), scr, r, c.lane); continue; } r -= I_KV;
            if (r < 2 * I_SQ) { const int l = r / I_SQ; p0_transpose_item(p.att_w_q + (size_t)l * DM * DM, DM, DM, (bf16*)(p.ws + WS_WQ) + (size_t)l * DM * DM, scr, r % I_SQ, c.lane); continue; } r -= 2 * I_SQ;
            { const int l = r / I_SQ; p0_transpose_item(p.att_w_o + (size_t)l * DM * DM, DM, DM, (bf16*)(p.ws + WS_WO) + (size_t)l * DM * DM, scr, r % I_SQ, c.lane); }
        }
    }
    for (int rp_ = ((PROREP >> 2) & 1) ? 0 : 1; rp_ < 2; ++rp_)
    {
        float* rs = (float*)(p.ws + WS_RS);
        for (int row = c.gw; row < 2 * DEPTH * PE; row += c.ngw) {
            const int which = row >= DEPTH * PE, r = row - which * DEPTH * PE;
            f32x4 v[8]; load_row((which ? p.peer_v : p.peer_u) + (size_t)r * DM, c.lane, v);
            float am = 0.f;
#pragma unroll
            for (int j = 0; j < 8; ++j) am = fmaxf(fmaxf(am, fmaxf(fabsf(v[j][0]), fabsf(v[j][1]))), fmaxf(fabsf(v[j][2]), fabsf(v[j][3])));
#pragma unroll
            for (int o = 1; o < 64; o <<= 1) am = fmaxf(am, __shfl_xor(am, o));
            int e = (int)((__builtin_bit_cast(unsigned, am) >> 23) & 0xffu) - 127; if (am == 0.f) e = 7;
            int k = 7 - e; k = k < -100 ? -100 : (k > 100 ? 100 : k);
            const float sc = __builtin_bit_cast(float, (unsigned)(k + 127) << 23), rsc = __builtin_bit_cast(float, (unsigned)(127 - k) << 23);
            const int lyr = r / PE, re = r % PE;
            unsigned char* dstb = p.ws + (which ? WS_PV : WS_PU) + (size_t)lyr * PE * DM + (size_t)re * 128;
            if (which) {
#pragma unroll
                for (int j = 0; j < 8; ++j) { int w = 0; w = __builtin_amdgcn_cvt_pk_fp8_f32(v[j][0] * sc, v[j][1] * sc, w, false); w = __builtin_amdgcn_cvt_pk_fp8_f32(v[j][2] * sc, v[j][3] * sc, w, true); { const int col = 4 * c.lane + 256 * j; *(unsigned*)(dstb + (size_t)(col >> 7) * PE * 128 + (col & 127)) = (unsigned)w; } }
                if (c.lane == 0) rs[row] = rsc;
            } else {
                const float s8 = am > 0.f ? 127.0f / am : 0.f;
#pragma unroll
                for (int j = 0; j < 8; ++j) { const unsigned w = q8pack(v[j][0] * s8, v[j][1] * s8, v[j][2] * s8, v[j][3] * s8); const int col = 4 * c.lane + 256 * j; *(unsigned*)(dstb + (size_t)(col >> 7) * PE * 128 + (col & 127)) = w; }
                if (c.lane == 0) rs[row] = am * (1.0f / 127.0f);
            }
        }
    }
    for (int rp_ = ((PROREP >> 3) & 1) ? 0 : 1; rp_ < 2; ++rp_)
    {
        float* rot = (float*)(p.ws + WS_ROT);
        for (int i = c.bx * 512 + c.tid; i < SEQ * 128; i += c.G * 512) { const int pos = i >> 7, d = i & 127;
            const float inv = (float)(1.0 / pow(10000.0, (double)d / 128.0)); const float ang = (float)pos * inv;
            rot[(size_t)pos * 256 + d] = (float)cos((double)ang); rot[(size_t)pos * 256 + 128 + d] = (float)sin((double)ang); }
    }
    for (int rp_ = ((PROREP >> 4) & 1) ? 0 : 1; rp_ < 2; ++rp_)
    { f32x4 gv[8]; load_g(p.ln_mix, c.lane, gv);
      for (int m = c.gw; m < NTOK; m += c.ngw) {
        f32x4 v[8]; load_row(p.x + (size_t)m * DM, c.lane, v);
        f32x4* xo = (f32x4*)(p.out + (size_t)m * DM) + c.lane;
#pragma unroll
        for (int j = 0; j < 8; ++j) xo[64 * j] = v[j];
        store_norm_bf16_r(v, row_rstd(v), gv, (bf16*)(p.ws + WS_H) + (size_t)m * DM, c.lane);
      } }
    if (fold_last) {
    __syncthreads();
    for (int tl = c.bx; tl < DEPTH * 16 * 32; tl += c.G) p0_fold_tile(p, c, tl);
    __syncthreads();
    }
}

constexpr int RS_QS = 0, RS_KS = 33792, RS_VS = 67584, RS_VZ = 76800, RS_PS = 86016, RS_RS = 95232, RS_END = 129024, QK_STR = 528, V_STR = 144;
__device__ __forceinline__ void ret_scan_unit(const Ctx& c, const bf16* Qg, const bf16* Kg, const bf16* Vg, bf16* Og, int unit) {
    const int xg = unit & 7, slot = unit >> 3, pair = xg * 4 + (slot >> 3), es = slot & 7, b = pair >> 3, h = pair & 7;
    const int tid = c.tid, lane = c.lane, w = c.wave, fr = lane & 15, fq = lane >> 4, tq = (lane & 15) >> 2, tp = lane & 3;
    LAS unsigned char* lds = c.lds;
    const float lgam = log1pf(-exp2f(-5.0f - (float)h));
    const float cdec = expf(lgam * 64.0f);
    const int lrow = tid >> 3, lch = tid & 7;
    const size_t tok0 = (size_t)b * SEQ;
    const bf16* qrow = Qg + (tok0 + lrow) * RQKW + h * RQK + lch * 8;
    const bf16* krow = Kg + (tok0 + lrow) * RQKW + h * RQK + lch * 8;
    const bf16* vrow = Vg + (tok0 + lrow) * RVW + h * RV + es * 64 + lch * 8;
    const float zeta = expf(lgam * (float)(63 - lrow));
    u32x4 pq[4], pk[4], pv;
#pragma unroll
    for (int cc = 0; cc < 4; ++cc) { pq[cc] = *(const u32x4*)(qrow + cc * 64); pk[cc] = *(const u32x4*)(krow + cc * 64); }
    pv = *(const u32x4*)vrow;
    __syncthreads();
    for (int i = tid; i < (RS_END - RS_RS) / 16; i += 512) *(LAS u32x4*)(lds + RS_RS + i * 16) = (u32x4){0u, 0u, 0u, 0u};
    f32x4 Racc[2][4];
#pragma unroll
    for (int x = 0; x < 2; ++x)
#pragma unroll
        for (int y = 0; y < 4; ++y) Racc[x][y] = (f32x4){0.f, 0.f, 0.f, 0.f};
    const int jt = w & 3, it0 = 2 * (w >> 2);
    const int it = w & 3, et0 = 2 * (w >> 2);
    float xi[4];
#pragma unroll
    for (int r = 0; r < 4; ++r) xi[r] = expf(lgam * (float)(16 * it + 4 * fq + r + 1));
    const unsigned ldsb = (unsigned)(size_t)lds;
    float dmask[2][4];
#pragma unroll
    for (int x = 0; x < 2; ++x)
#pragma unroll
        for (int r = 0; r < 4; ++r) { const int i = 16 * (it0 + x) + fr, j = 16 * jt + 4 * fq + r; dmask[x][r] = (i >= j) ? expf(lgam * (float)(i - j)) : 0.f; }
    asm volatile("" : "+v"(dmask[0][0]), "+v"(dmask[0][1]), "+v"(dmask[0][2]), "+v"(dmask[0][3]), "+v"(dmask[1][0]), "+v"(dmask[1][1]), "+v"(dmask[1][2]), "+v"(dmask[1][3]));
    for (int n = 0; n < NCHUNK; ++n) {
        __syncthreads();
#pragma unroll
        for (int cc = 0; cc < 4; ++cc) { *(LAS u32x4*)(lds + RS_QS + lrow * QK_STR + (lch + 8 * cc) * 16) = pq[cc]; *(LAS u32x4*)(lds + RS_KS + lrow * QK_STR + (lch + 8 * cc) * 16) = pk[cc]; }
        *(LAS u32x4*)(lds + RS_VS + lrow * V_STR + lch * 16) = pv;
        { u32x4 z; z.x = pk2(bflo(pv.x) * zeta, bfhi(pv.x) * zeta); z.y = pk2(bflo(pv.y) * zeta, bfhi(pv.y) * zeta); z.z = pk2(bflo(pv.z) * zeta, bfhi(pv.z) * zeta); z.w = pk2(bflo(pv.w) * zeta, bfhi(pv.w) * zeta);
          *(LAS u32x4*)(lds + RS_VZ + lrow * V_STR + lch * 16) = z; }
        __syncthreads();
        if (n + 1 < NCHUNK) {
            const size_t adv = (size_t)(n + 1) * CHUNK;
#pragma unroll
            for (int cc = 0; cc < 4; ++cc) { pq[cc] = *(const u32x4*)(qrow + adv * RQKW + cc * 64); pk[cc] = *(const u32x4*)(krow + adv * RQKW + cc * 64); }
            pv = *(const u32x4*)(vrow + adv * RVW);
        }
        {
            f32x4 s0 = (f32x4){0.f, 0.f, 0.f, 0.f}, s1 = s0;
#pragma unroll
            for (int kh = 0; kh < 2; ++kh) {
                bf16x8 fa[4], fb0[4], fb1[4];
#pragma unroll
                for (int k4 = 0; k4 < 4; ++k4) { const int ks = 4 * kh + k4;
                    fa[k4] = lds128(lds + RS_KS + (16 * jt + fr) * QK_STR + (4 * ks + fq) * 16);
                    fb0[k4] = lds128(lds + RS_QS + (16 * it0 + fr) * QK_STR + (4 * ks + fq) * 16);
                    fb1[k4] = lds128(lds + RS_QS + (16 * (it0 + 1) + fr) * QK_STR + (4 * ks + fq) * 16); }
                __builtin_amdgcn_sched_barrier(0);
#pragma unroll
                for (int k4 = 0; k4 < 4; ++k4) { s0 = MFMA16(fa[k4], fb0[k4], s0); s1 = MFMA16(fa[k4], fb1[k4], s1); }
            }
#pragma unroll
            for (int x = 0; x < 2; ++x) { const f32x4 s = x ? s1 : s0; const int i = 16 * (it0 + x) + fr; float pr[4];
#pragma unroll
                for (int r = 0; r < 4; ++r) pr[r] = s[r] * dmask[x][r];
                u32x2 pw; pw.x = pk2(pr[0], pr[1]); pw.y = pk2(pr[2], pr[3]);
                *(LAS u32x2*)(lds + RS_PS + i * V_STR + (16 * jt + 4 * fq) * 2) = pw; }
        }
        f32x4 o0 = (f32x4){0.f, 0.f, 0.f, 0.f}, o1 = o0;
        {
#pragma unroll
            for (int kh = 0; kh < 2; ++kh) {
                bf16x8 fa[4], fb0[4], fb1[4];
#pragma unroll
                for (int k4 = 0; k4 < 4; ++k4) { const int ks = 4 * kh + k4;
                    fa[k4] = lds128(lds + RS_QS + (16 * it + fr) * QK_STR + (4 * ks + fq) * 16);
                    fb0[k4] = lds128(lds + RS_RS + (16 * et0 + fr) * QK_STR + (4 * ks + fq) * 16);
                    fb1[k4] = lds128(lds + RS_RS + (16 * (et0 + 1) + fr) * QK_STR + (4 * ks + fq) * 16); }
                __builtin_amdgcn_sched_barrier(0);
#pragma unroll
                for (int k4 = 0; k4 < 4; ++k4) { o0 = MFMA16(fa[k4], fb0[k4], o0); o1 = MFMA16(fa[k4], fb1[k4], o1); }
            }
        }
#pragma unroll
        for (int r = 0; r < 4; ++r) { o0[r] *= xi[r]; o1[r] *= xi[r]; }
        __syncthreads();
#pragma unroll
        for (int ks = 0; ks < 2; ++ks) {
            const bf16x8 a = lds128(lds + RS_PS + (16 * it + fr) * V_STR + (4 * ks + fq) * 16);
            const unsigned va = ldsb + RS_VS + (32 * ks + 8 * fq + tq) * V_STR + 8 * tp;
            const bf16x8 b0 = tr_frag(va + 32 * et0, va + 4 * V_STR + 32 * et0);
            const bf16x8 b1 = tr_frag(va + 32 * (et0 + 1), va + 4 * V_STR + 32 * (et0 + 1));
            __builtin_amdgcn_sched_barrier(0);
            o0 = MFMA16(a, b0, o0); o1 = MFMA16(a, b1, o1);
        }
        {
            bf16* op = Og + (tok0 + (size_t)n * CHUNK + 16 * it + 4 * fq) * RVW + h * RV + es * 64 + 16 * et0 + fr;
#pragma unroll
            for (int r = 0; r < 4; ++r) { op[(size_t)r * RVW] = (bf16)f2bf(o0[r]); op[(size_t)r * RVW + 16] = (bf16)f2bf(o1[r]); }
        }
#pragma unroll
        for (int x = 0; x < 2; ++x)
#pragma unroll
            for (int y = 0; y < 4; ++y) Racc[x][y] *= cdec;
#pragma unroll
        for (int ks = 0; ks < 2; ++ks) {
            const unsigned ka = ldsb + RS_KS + (32 * ks + 8 * fq + tq) * QK_STR + 8 * tp;
            const unsigned za = ldsb + RS_VZ + (32 * ks + 8 * fq + tq) * V_STR + 8 * tp;
            bf16x8 ak[2], bz[4];
#pragma unroll
            for (int x = 0; x < 2; ++x) ak[x] = tr_frag(ka + 32 * (2 * w + x), ka + 4 * QK_STR + 32 * (2 * w + x));
#pragma unroll
            for (int y = 0; y < 4; ++y) bz[y] = tr_frag(za + 32 * y, za + 4 * V_STR + 32 * y);
            __builtin_amdgcn_sched_barrier(0);
#pragma unroll
            for (int x = 0; x < 2; ++x)
#pragma unroll
                for (int y = 0; y < 4; ++y) Racc[x][y] = MFMA16(ak[x], bz[y], Racc[x][y]);
        }
#pragma unroll
        for (int x = 0; x < 2; ++x)
#pragma unroll
            for (int y = 0; y < 4; ++y) { u32x2 rw; rw.x = pk2(Racc[x][y][0], Racc[x][y][1]); rw.y = pk2(Racc[x][y][2], Racc[x][y][3]);
                *(LAS u32x2*)(lds + RS_RS + (16 * y + fr) * QK_STR + (16 * (2 * w + x) + 4 * fq) * 2) = rw; }
    }
}

template <int CTRL> __device__ __forceinline__ float dpp_f(float x) { return __builtin_bit_cast(float, __builtin_amdgcn_mov_dpp(__builtin_bit_cast(int, x), CTRL, 0xF, 0xF, true)); }
__device__ __forceinline__ float sum8(float x) { x += dpp_f<0xB1>(x); x += dpp_f<0x4E>(x); x += dpp_f<0x141>(x); return x; }
__device__ __forceinline__ void ret_gate_phase(const Ctx& c, const bf16* Og, bf16* Gg, const float* gn, bf16* Zout = nullptr) {
    const int col0 = 512 * (c.lane >> 3) + 8 * (c.lane & 7);
    f32x4 gw[16];
#pragma unroll
    for (int j = 0; j < 8; ++j) { gw[2 * j] = *(const f32x4*)(gn + col0 + 64 * j); gw[2 * j + 1] = *(const f32x4*)(gn + col0 + 64 * j + 4); }
    u32x4 ovn[8];
    if (c.gw < NTOK) { const bf16* orow = Og + (size_t)c.gw * RVW + col0;
#pragma unroll
        for (int j = 0; j < 8; ++j) ovn[j] = *(const u32x4*)(orow + 64 * j); }
    for (int m = c.gw; m < NTOK; m += c.ngw) {
        u32x4 gv[8], ov[8];
        { const bf16* grow = Gg + (size_t)m * RVW + col0;
#pragma unroll
          for (int j = 0; j < 8; ++j) { gv[j] = *(const u32x4*)(grow + 64 * j); ov[j] = ovn[j]; } }
        { const int mn = m + c.ngw < NTOK ? m + c.ngw : m; const bf16* orow = Og + (size_t)mn * RVW + col0;
#pragma unroll
          for (int j = 0; j < 8; ++j) ovn[j] = *(const u32x4*)(orow + 64 * j); }
        float s1 = 0.f;
#pragma unroll
        for (int j = 0; j < 8; ++j) { const u32x4 t = ov[j];
            s1 += ((bflo(t.x) + bfhi(t.x)) + (bflo(t.y) + bfhi(t.y))) + ((bflo(t.z) + bfhi(t.z)) + (bflo(t.w) + bfhi(t.w))); }
        const float mu = sum8(s1) * (1.0f / RV);
        asm volatile("" : "+v"(ov[0]), "+v"(ov[1]), "+v"(ov[2]), "+v"(ov[3]), "+v"(ov[4]), "+v"(ov[5]), "+v"(ov[6]), "+v"(ov[7]));
        float s2 = 0.f;
#pragma unroll
        for (int j = 0; j < 8; ++j) { const u32x4 t = ov[j];
            const float d[8] = {bflo(t.x) - mu, bfhi(t.x) - mu, bflo(t.y) - mu, bfhi(t.y) - mu, bflo(t.z) - mu, bfhi(t.z) - mu, bflo(t.w) - mu, bfhi(t.w) - mu};
            float q = 0.f;
#pragma unroll
            for (int k = 0; k < 8; ++k) q += d[k] * d[k];
            s2 += q; }
        const float rstd = 1.0f / sqrtf(sum8(s2) * (1.0f / RV) + EPS);
        asm volatile("" : "+v"(ov[0]), "+v"(ov[1]), "+v"(ov[2]), "+v"(ov[3]), "+v"(ov[4]), "+v"(ov[5]), "+v"(ov[6]), "+v"(ov[7]));
        bf16* zrow = (Zout ? Zout : Gg) + (size_t)m * RVW + col0;
#pragma unroll
        for (int j = 0; j < 8; ++j) {
            const float gg[8] = {gw[2 * j][0], gw[2 * j][1], gw[2 * j][2], gw[2 * j][3], gw[2 * j + 1][0], gw[2 * j + 1][1], gw[2 * j + 1][2], gw[2 * j + 1][3]};
            const u32x4 t = gv[j], u = ov[j];
            const float g[8] = {bflo(t.x), bfhi(t.x), bflo(t.y), bfhi(t.y), bflo(t.z), bfhi(t.z), bflo(t.w), bfhi(t.w)};
            const float o[8] = {bflo(u.x), bfhi(u.x), bflo(u.y), bfhi(u.y), bflo(u.z), bfhi(u.z), bflo(u.w), bfhi(u.w)};
            float z[8];
#pragma unroll
            for (int k = 0; k < 8; ++k) { const float y = (o[k] - mu) * rstd * gg[k]; z[k] = g[k] * __builtin_amdgcn_rcpf(1.0f + __builtin_amdgcn_exp2f(-1.4426950408889634f * g[k])) * y; }
            u32x4 zw; zw.x = pk2(z[0], z[1]); zw.y = pk2(z[2], z[3]); zw.z = pk2(z[4], z[5]); zw.w = pk2(z[6], z[7]);
            *(u32x4*)(zrow + 64 * j) = zw;
        }
    }
}

__device__ __forceinline__ void rms_phase(const Ctx& c, const float* X, const float* g, bf16* H) {
    for (int m = c.gw; m < NTOK; m += c.ngw) { f32x4 v[8]; load_row(X + (size_t)m * DM, c.lane, v); store_norm_bf16(v, row_rstd(v), g, H + (size_t)m * DM, c.lane); }
}

__device__ __forceinline__ int fkey(float f) { const int i = __builtin_bit_cast(int, f); return i ^ ((i >> 31) & 0x7fffffff); }
__device__ __forceinline__ float kval(int k) { return __builtin_bit_cast(float, k ^ ((k >> 31) & 0x7fffffff)); }
__device__ __forceinline__ int med3i(int a, int b, int c) { int r; asm("v_med3_i32 %0, %1, %2, %3" : "=v"(r) : "v"(a), "v"(b), "v"(c)); return r; }
#define INS16(L, key) do { const int _k = (key); _Pragma("unroll") for (int _q = 15; _q >= 1; --_q) L[_q] = med3i(L[_q - 1], L[_q], _k); L[0] = max(L[0], _k); } while (0)
constexpr int TK_LIST = 544, TK_HALF = 272, TK_KEYS = 256 * TK_LIST;
__device__ __forceinline__ void peer_topk_phase(const Ctx& c, const float* SC, int* IDX, float* WGT, const float* SQP, float* RSTD) {
    LAS unsigned char* lds = c.lds;
    u32x4 pre[16];
    if (c.bx < NTOK / 16) { const u32x4* src = (const u32x4*)(SC + (size_t)c.bx * 16 * DM);
#pragma unroll
        for (int i = 0; i < 16; ++i) pre[i] = src[c.tid + 512 * i]; }
    for (int tile = c.bx; tile < NTOK / 16; tile += c.G) {
        __syncthreads();
#pragma unroll
        for (int i = 0; i < 16; ++i) { const int g = c.tid + 512 * i; *(LAS u32x4*)(lds + (g >> 5) * TK_LIST + ((g >> 4) & 1) * TK_HALF + (g & 15) * 16) = pre[i]; }
        if (tile + c.G < NTOK / 16) { const u32x4* src = (const u32x4*)(SC + (size_t)(tile + c.G) * 16 * DM);
#pragma unroll
            for (int i = 0; i < 16; ++i) pre[i] = src[c.tid + 512 * i]; }
        __syncthreads();
        {
            const int lst = c.tid >> 1, hf = c.tid & 1;
            int L[16];
#pragma unroll
            for (int q = 0; q < 16; ++q) L[q] = (int)0x80000000;
            LAS unsigned char* lp = lds + lst * TK_LIST + hf * TK_HALF;
#pragma unroll 2
            for (int g = 0; g < 16; ++g) { const f32x4 v = *(LAS const f32x4*)(lp + g * 16);
#pragma unroll
                for (int e = 0; e < 4; ++e) INS16(L, (fkey(v[e]) & ~127) | (hf * 64 + g * 4 + e)); }
            if (hf) {
#pragma unroll
                for (int q = 0; q < 16; ++q) ((LAS int*)lp)[q] = L[q]; }
            __syncthreads();
            if (!hf) { LAS const int* op = (LAS const int*)(lp + TK_HALF);
#pragma unroll
                for (int q = 0; q < 16; ++q) INS16(L, op[q]);
                LAS int* kp = (LAS int*)(lds + TK_KEYS) + lst * 16;
#pragma unroll
                for (int q = 0; q < 16; ++q) kp[q] = L[q]; }
        }
        __syncthreads();
        if (c.tid < 128) {
            LAS const int* k1 = (LAS const int*)(lds + TK_KEYS) + (c.tid * 2) * 16; LAS const int* k2 = k1 + 16;
            float v1[16], v2[16];
#pragma unroll
            for (int q = 0; q < 16; ++q) { v1[q] = kval(k1[q] & ~127); v2[q] = kval(k2[q] & ~127); }
            int L[16];
#pragma unroll
            for (int q = 0; q < 16; ++q) L[q] = (fkey(v1[0] + v2[q]) & ~255) | q;
#pragma unroll
            for (int i = 1; i < 16; ++i)
#pragma unroll
                for (int j = 0; j < 16; ++j) if ((i + 1) * (j + 1) <= 16) INS16(L, (fkey(v1[i] + v2[j]) & ~255) | (i * 16 + j));
            const int tt = c.tid >> 3, hh = c.tid & 7; const size_t ob0 = ((size_t)tile * 16 + tt) * 128;
            float rstd; { const f32x4* sp = (const f32x4*)(SQP + ((size_t)tile * 16 + tt) * 32); f32x4 a4 = sp[0];
#pragma unroll
              for (int q = 1; q < 8; ++q) a4 += sp[q];
              rstd = 1.0f / sqrtf(((a4[0] + a4[1]) + (a4[2] + a4[3])) * (1.0f / DM) + EPS); }
            if (hh == 0) RSTD[(size_t)tile * 16 + tt] = rstd;
            const float m0 = kval(L[0] & ~255); float ex[16], se = 0.f;
#pragma unroll
            for (int q = 0; q < 16; ++q) { ex[q] = __builtin_amdgcn_exp2f((kval(L[q] & ~255) - m0) * (rstd * 1.4426950408889634f)); se += ex[q]; }
            const float inv = 1.0f / se;
#pragma unroll
            for (int q = 0; q < 16; ++q) { const int cid = L[q] & 255; const int es = hh * 16 + q, pos = (es & 7) * 16 + (es >> 3);
                IDX[ob0 + pos] = (k1[cid >> 4] & 127) * PNK + (k2[cid & 15] & 127); WGT[ob0 + pos] = ex[q] * inv; }
        }
    }
}

template <int NSTAGE> __device__ __forceinline__ void xreduce_stage(float (&p)[64], int lane) {
    constexpr int S = NSTAGE;
    if constexpr (S == 32) {
#pragma unroll
        for (int k = 0; k < S; ++k) { float xa = p[k], xb = p[k + S]; asm("s_nop 1\n\tv_permlane32_swap_b32 %0, %1" : "+v"(xa), "+v"(xb)); p[k] = xa + xb; }
    } else if constexpr (S == 16) {
#pragma unroll
        for (int k = 0; k < S; ++k) { float xa = p[k], xb = p[k + S]; asm("s_nop 1\n\tv_permlane16_swap_b32 %0, %1" : "+v"(xa), "+v"(xb)); p[k] = xa + xb; }
    } else {
        const bool up = (lane & S) != 0;
#pragma unroll
        for (int k = 0; k < S; ++k) { const float keep = up ? p[k + S] : p[k], send = up ? p[k] : p[k + S];
            p[k] = keep + __builtin_bit_cast(float, __builtin_amdgcn_ds_swizzle(__builtin_bit_cast(int, send), (S << 10) | 0x1F)); }
    }
}
__device__ __forceinline__ float gelu_erf(float v) { return 0.5f * v * (1.0f + erff(v * 0.70710678118654752f)); }
typedef float f32x2 __attribute__((ext_vector_type(2)));
__device__ __forceinline__ float peer_dots64(const unsigned char* U, int idxv, const f32x2 (&h2)[16], int lane) {
    float p[64];
#pragma unroll
    for (int e = 0; e < 64; ++e) {
        const int row = __builtin_amdgcn_readlane(idxv, e);
        const u32x4* up = (const u32x4*)(U + (size_t)row * DM) + lane;
        f32x2 a = {0.f, 0.f};
#pragma unroll
        for (int cc = 0; cc < 2; ++cc) { const u32x4 u = up[64 * cc];
#pragma unroll
            for (int q = 0; q < 4; ++q) { const int w = (int)u[q];
                a = __builtin_elementwise_fma(__builtin_amdgcn_cvt_pk_f32_fp8(w, false), h2[8 * cc + 2 * q], a);
                a = __builtin_elementwise_fma(__builtin_amdgcn_cvt_pk_f32_fp8(w, true), h2[8 * cc + 2 * q + 1], a); } }
        p[e] = a.x + a.y;
    }
    xreduce_stage<32>(p, lane); xreduce_stage<16>(p, lane); xreduce_stage<8>(p, lane); xreduce_stage<4>(p, lane); xreduce_stage<2>(p, lane); xreduce_stage<1>(p, lane);
    return p[0];
}
__device__ __forceinline__ void peer_accum64(const unsigned char* Vt, int idxv, float av, f32x2 (&acc)[16], int lane) {
#pragma unroll 8
    for (int e = 0; e < 64; ++e) {
        const int row = __builtin_amdgcn_readlane(idxv, e); const float a = __builtin_bit_cast(float, __builtin_amdgcn_readlane(__builtin_bit_cast(int, av), e));
        const f32x2 a2 = {a, a};
        const u32x4* vp = (const u32x4*)(Vt + (size_t)row * DM) + lane;
#pragma unroll
        for (int cc = 0; cc < 2; ++cc) { const u32x4 v = vp[64 * cc];
#pragma unroll
            for (int q = 0; q < 4; ++q) { const int w = (int)v[q];
                acc[8 * cc + 2 * q] = __builtin_elementwise_fma(__builtin_amdgcn_cvt_pk_f32_fp8(w, false), a2, acc[8 * cc + 2 * q]);
                acc[8 * cc + 2 * q + 1] = __builtin_elementwise_fma(__builtin_amdgcn_cvt_pk_f32_fp8(w, true), a2, acc[8 * cc + 2 * q + 1]); } }
    }
}
constexpr int GD = 8;
#define PG_ISSUE(vv) do { const int row_ = __builtin_amdgcn_readlane((((vv) >> 6) & 1) ? i1 : i0, (vv) & 63); \
        const u32x4* bp_ = (const u32x4*)((((vv) >> 6) < 2 ? U : Vt) + (size_t)row_ * DM) + lane; ring[(vv) % GD][0] = bp_[0]; ring[(vv) % GD][1] = bp_[64]; } while (0)
template <int SEG> __device__ __forceinline__ void peer_seg(const unsigned char* U, const unsigned char* Vt, int i0, int i1, u32x4 (&ring)[GD][2], float (&p)[64], float aseg, const f32x2 (&h2)[16], f32x2 (&acc)[16], int lane) {
#pragma unroll
    for (int e = 0; e < 64; ++e) {
        const int v = SEG * 64 + e;
        const u32x4 r0 = ring[v % GD][0], r1 = ring[v % GD][1];
        if (SEG < 2) {
            f32x2 a = {0.f, 0.f};
#pragma unroll
            for (int q = 0; q < 4; ++q) { const int wa = (int)r0[q], wb = (int)r1[q];
                a = __builtin_elementwise_fma(__builtin_amdgcn_cvt_pk_f32_fp8(wa, false), h2[2 * q], a); a = __builtin_elementwise_fma(__builtin_amdgcn_cvt_pk_f32_fp8(wa, true), h2[2 * q + 1], a);
                a = __builtin_elementwise_fma(__builtin_amdgcn_cvt_pk_f32_fp8(wb, false), h2[8 + 2 * q], a); a = __builtin_elementwise_fma(__builtin_amdgcn_cvt_pk_f32_fp8(wb, true), h2[8 + 2 * q + 1], a); }
            { float hs_; asm("v_add_f32 %0, %1, %2" : "=v"(hs_) : "v"(a.x), "v"(a.y)); p[e] = hs_; }
        } else {
            const float av = __builtin_bit_cast(float, __builtin_amdgcn_readlane(__builtin_bit_cast(int, aseg), e)); const f32x2 a2 = {av, av};
#pragma unroll
            for (int q = 0; q < 4; ++q) { const int wa = (int)r0[q], wb = (int)r1[q];
                acc[2 * q] = __builtin_elementwise_fma(__builtin_amdgcn_cvt_pk_f32_fp8(wa, false), a2, acc[2 * q]); acc[2 * q + 1] = __builtin_elementwise_fma(__builtin_amdgcn_cvt_pk_f32_fp8(wa, true), a2, acc[2 * q + 1]);
                acc[8 + 2 * q] = __builtin_elementwise_fma(__builtin_amdgcn_cvt_pk_f32_fp8(wb, false), a2, acc[8 + 2 * q]); acc[8 + 2 * q + 1] = __builtin_elementwise_fma(__builtin_amdgcn_cvt_pk_f32_fp8(wb, true), a2, acc[8 + 2 * q + 1]); }
            asm volatile("" : "+v"(acc[0]), "+v"(acc[1]), "+v"(acc[2]), "+v"(acc[3]), "+v"(acc[4]), "+v"(acc[5]), "+v"(acc[6]), "+v"(acc[7]), "+v"(acc[8]), "+v"(acc[9]), "+v"(acc[10]), "+v"(acc[11]), "+v"(acc[12]), "+v"(acc[13]), "+v"(acc[14]), "+v"(acc[15]));
        }
        if (v + GD < 256) PG_ISSUE(v + GD);
        __builtin_amdgcn_sched_barrier(0);
    }
}
__device__ __forceinline__ void peer_token_pipe(const unsigned char* U, const unsigned char* Vt, int i0, int i1, float su0, float su1, float w0, float w1, const f32x2 (&h2)[16], f32x2 (&acc)[16], int lane) {
    u32x4 ring[GD][2];
    float p[64];
#pragma unroll
    for (int v = 0; v < GD; ++v) PG_ISSUE(v);
    peer_seg<0>(U, Vt, i0, i1, ring, p, 0.f, h2, acc, lane);
    xreduce_stage<32>(p, lane); xreduce_stage<16>(p, lane); xreduce_stage<8>(p, lane); xreduce_stage<4>(p, lane); xreduce_stage<2>(p, lane); xreduce_stage<1>(p, lane);
    const float a0 = gelu_erf(p[0] * su0) * w0;
    __builtin_amdgcn_sched_barrier(0);
    peer_seg<1>(U, Vt, i0, i1, ring, p, 0.f, h2, acc, lane);
    xreduce_stage<32>(p, lane); xreduce_stage<16>(p, lane); xreduce_stage<8>(p, lane); xreduce_stage<4>(p, lane); xreduce_stage<2>(p, lane); xreduce_stage<1>(p, lane);
    const float a1 = gelu_erf(p[0] * su1) * w1;
    __builtin_amdgcn_sched_barrier(0);
    peer_seg<2>(U, Vt, i0, i1, ring, p, a0, h2, acc, lane);
    peer_seg<3>(U, Vt, i0, i1, ring, p, a1, h2, acc, lane);
}
#undef PG_ISSUE
__device__ __forceinline__ void peer_gather_phase(const Ctx& c, const bf16* Hn, const unsigned char* U, const unsigned char* Vt, const float* rsU, const float* rsV, const int* IDX, const float* WGT, const float* Xr, float* X, int mode,
                                                  const float* g1, const float* g2, bf16* Hout, bf16* HKVout) {
    for (int m = c.gw; m < NTOK; m += c.ngw) {
        int lane_ = c.lane; asm volatile("" : "+v"(lane_));
#ifdef DRYIDXMASK
        const int imask_ = (X != Xr) ? DRYIDXMASK : 0xffff;
        const int i0 = IDX[(size_t)m * 128 + lane_] & imask_, i1 = IDX[(size_t)m * 128 + 64 + lane_] & imask_;
#else
        const int i0 = IDX[(size_t)m * 128 + lane_], i1 = IDX[(size_t)m * 128 + 64 + lane_];
#endif
        const float w0 = WGT[(size_t)m * 128 + lane_] * rsV[i0], w1 = WGT[(size_t)m * 128 + 64 + lane_] * rsV[i1];
        const float su0 = rsU[i0], su1 = rsU[i1];
        f32x2 h2[16];
#pragma unroll
        for (int cc = 0; cc < 2; ++cc) { const u32x4* hp = (const u32x4*)(Hn + (size_t)m * DM + 1024 * cc + 16 * lane_); const u32x4 ha = hp[0], hb = hp[1];
#pragma unroll
            for (int q = 0; q < 4; ++q) { h2[8 * cc + q] = (f32x2){bflo(ha[q]), bfhi(ha[q])}; h2[8 * cc + 4 + q] = (f32x2){bflo(hb[q]), bfhi(hb[q])}; } }
        f32x2 acc[16];
#pragma unroll
        for (int k = 0; k < 16; ++k) acc[k] = (f32x2){0.f, 0.f};
        peer_token_pipe(U, Vt, i0, i1, su0, su1, w0, w1, h2, acc, lane_);
        float* xr = X + (size_t)m * DM; const float* xrr = Xr + (size_t)m * DM; float ss = 0.f;
#pragma unroll
        for (int cc = 0; cc < 2; ++cc) {
            f32x4* xp = (f32x4*)(xr + 1024 * cc + 16 * lane_); const f32x4* xq = (const f32x4*)(xrr + 1024 * cc + 16 * lane_);
#pragma unroll
            for (int q = 0; q < 4; ++q) { f32x4 xa = xq[q]; xa[0] += acc[8 * cc + 2 * q].x; xa[1] += acc[8 * cc + 2 * q].y; xa[2] += acc[8 * cc + 2 * q + 1].x; xa[3] += acc[8 * cc + 2 * q + 1].y;
                acc[8 * cc + 2 * q] = (f32x2){xa[0], xa[1]}; acc[8 * cc + 2 * q + 1] = (f32x2){xa[2], xa[3]}; ss += (xa[0] * xa[0] + xa[1] * xa[1]) + (xa[2] * xa[2] + xa[3] * xa[3]);
                if (mode != 2) xp[q] = xa; }
        }
        const float rstd = 1.0f / sqrtf(wave_sum(ss) * (1.0f / DM) + EPS);
#pragma unroll
        for (int cc = 0; cc < 2; ++cc) {
            const f32x4* gp = (const f32x4*)(g1 + 1024 * cc + 16 * lane_);
            if (mode == 2) {
                f32x4* xp = (f32x4*)(xr + 1024 * cc + 16 * lane_);
#pragma unroll
                for (int q = 0; q < 4; ++q) { const f32x4 gv = gp[q]; f32x4 y; y[0] = acc[8 * cc + 2 * q].x * rstd * gv[0]; y[1] = acc[8 * cc + 2 * q].y * rstd * gv[1]; y[2] = acc[8 * cc + 2 * q + 1].x * rstd * gv[2]; y[3] = acc[8 * cc + 2 * q + 1].y * rstd * gv[3]; xp[q] = y; }
            } else {
                u32x4 hw[2];
#pragma unroll
                for (int q = 0; q < 4; ++q) { const f32x4 gv = gp[q]; hw[q >> 1][2 * (q & 1)] = pk2(acc[8 * cc + 2 * q].x * rstd * gv[0], acc[8 * cc + 2 * q].y * rstd * gv[1]); hw[q >> 1][2 * (q & 1) + 1] = pk2(acc[8 * cc + 2 * q + 1].x * rstd * gv[2], acc[8 * cc + 2 * q + 1].y * rstd * gv[3]); }
                u32x4* ho = (u32x4*)(Hout + (size_t)m * DM + 1024 * cc + 16 * lane_); ho[0] = hw[0]; ho[1] = hw[1];
                if (mode == 1) {
                    const f32x4* kp = (const f32x4*)(g2 + 1024 * cc + 16 * lane_); u32x4 kw[2];
#pragma unroll
                    for (int q = 0; q < 4; ++q) { const f32x4 gv = kp[q]; kw[q >> 1][2 * (q & 1)] = pk2(acc[8 * cc + 2 * q].x * rstd * gv[0], acc[8 * cc + 2 * q].y * rstd * gv[1]); kw[q >> 1][2 * (q & 1) + 1] = pk2(acc[8 * cc + 2 * q + 1].x * rstd * gv[2], acc[8 * cc + 2 * q + 1].y * rstd * gv[3]); }
                    u32x4* ko = (u32x4*)(HKVout + (size_t)m * DM + 1024 * cc + 16 * lane_); ko[0] = kw[0]; ko[1] = kw[1];
                }
            }
        }
    }
}

template <int PAT> __device__ __forceinline__ float swz_xor(float v) { return __builtin_bit_cast(float, __builtin_amdgcn_ds_swizzle(__builtin_bit_cast(int, v), PAT)); }
template <int PAT> __device__ __forceinline__ int swz_xor_i(int v) { return __builtin_amdgcn_ds_swizzle(v, PAT); }
__device__ __forceinline__ void peer_u_phase(const Ctx& c, const bf16* Hn, const unsigned char* U, const int* IDXT, float* PD, unsigned imask = 0xffffffffu) {
    const int xg = c.bx & 7, wr = (c.bx >> 3) * 8 + c.wave, g = c.lane >> 3, sub = c.lane & 7;
    for (int pass = 0; pass < 2; ++pass) {
        const int s = xg + 8 * pass, col0 = 128 * s + 16 * sub;
        const unsigned char* Us = U + (size_t)s * PE * 128 + 16 * sub;
        u32x4 wv[8];
        { const u32x4* wp = (const u32x4*)(U + (size_t)s * PE * 128 + (size_t)(c.bx >> 3) * 65536) + c.tid;
#pragma unroll
          for (int q = 0; q < 8; ++q) wv[q] = wp[q * 512]; }
        u32x4 ri[4], hr[2];
        { const u32x4* ip = (const u32x4*)(IDXT + (size_t)wr * 128 + g * 16); const u32x4* hp = (const u32x4*)(Hn + (size_t)wr * DM + col0);
#pragma unroll
          for (int q = 0; q < 4; ++q) ri[q] = ip[q];
          hr[0] = hp[0]; hr[1] = hp[1]; }
        for (int k = 0; k < NTOK / 256; ++k) {
            const int t = wr + 256 * k;
            u32x4 r[16];
#pragma unroll
            for (int j = 0; j < 16; ++j) r[j] = *(const u32x4*)(Us + (size_t)(ri[j >> 2][j & 3] & imask) * 128);
            float hf[16];
#pragma unroll
            for (int q = 0; q < 4; ++q) { hf[2 * q] = bflo(hr[0][q]); hf[2 * q + 1] = bfhi(hr[0][q]); hf[8 + 2 * q] = bflo(hr[1][q]); hf[8 + 2 * q + 1] = bfhi(hr[1][q]); }
            if (k + 1 < NTOK / 256) { const u32x4* ip = (const u32x4*)(IDXT + (size_t)(t + 256) * 128 + g * 16); const u32x4* hp = (const u32x4*)(Hn + (size_t)(t + 256) * DM + col0);
#pragma unroll
                for (int q = 0; q < 4; ++q) ri[q] = ip[q];
                hr[0] = hp[0]; hr[1] = hp[1]; }
            float am = 0.f;
#pragma unroll
            for (int q = 0; q < 16; ++q) am = fmaxf(am, fabsf(hf[q]));
            am = fmaxf(am, dpp_f<0xB1>(am)); am = fmaxf(am, dpp_f<0x4E>(am)); am = fmaxf(am, dpp_f<0x141>(am));
            const float hsc = am > 0.f ? 127.0f / am : 0.f, hinv = am * (1.0f / 127.0f);
            unsigned hq[4];
#pragma unroll
            for (int q = 0; q < 4; ++q) hq[q] = q8pack(hf[4 * q] * hsc, hf[4 * q + 1] * hsc, hf[4 * q + 2] * hsc, hf[4 * q + 3] * hsc);
            int p[16];
#pragma unroll
            for (int j = 0; j < 16; ++j) { int a = __builtin_amdgcn_sdot4((int)r[j].x, (int)hq[0], 0, false); a = __builtin_amdgcn_sdot4((int)r[j].y, (int)hq[1], a, false);
                a = __builtin_amdgcn_sdot4((int)r[j].z, (int)hq[2], a, false); p[j] = __builtin_amdgcn_sdot4((int)r[j].w, (int)hq[3], a, false); }
            { const bool up = (sub & 4) != 0;
#pragma unroll
              for (int q = 0; q < 8; ++q) { const int keep = up ? p[q + 8] : p[q], send = up ? p[q] : p[q + 8]; p[q] = keep + swz_xor_i<(4 << 10) | 0x1F>(send); } }
            { const bool up = (sub & 2) != 0;
#pragma unroll
              for (int q = 0; q < 4; ++q) { const int keep = up ? p[q + 4] : p[q], send = up ? p[q] : p[q + 4]; p[q] = keep + swz_xor_i<(2 << 10) | 0x1F>(send); } }
            { const bool up = (sub & 1) != 0;
#pragma unroll
              for (int q = 0; q < 2; ++q) { const int keep = up ? p[q + 2] : p[q], send = up ? p[q] : p[q + 2]; p[q] = keep + swz_xor_i<(1 << 10) | 0x1F>(send); } }
            f32x2 o = {(float)p[0] * hinv, (float)p[1] * hinv};
            *(f32x2*)(PD + ((size_t)t * 16 + s) * 128 + g * 16 + 2 * sub) = o;
            if (k == 0) asm volatile("" :: "v"(wv[0]), "v"(wv[1]), "v"(wv[2]), "v"(wv[3]), "v"(wv[4]), "v"(wv[5]), "v"(wv[6]), "v"(wv[7]));
        }
    }
}
__device__ __forceinline__ void peer_a_phase(const Ctx& c, const float* PD, const int* IDXT, float* WA, const float* rsU, const float* rsV, const float* RSTD) {
    const int i0 = c.bx * 512 + c.tid, step = c.G * 512;
    f32x4 vn[16];
    if (i0 < NTOK * 32) { const f32x4* pp = (const f32x4*)(PD + (size_t)(i0 >> 5) * 2048) + (i0 & 31);
#pragma unroll
        for (int s = 0; s < 16; ++s) vn[s] = pp[s * 32]; }
    for (int i4 = i0; i4 < NTOK * 32; i4 += step) {
        const int t = i4 >> 5;
        f32x4 v[16];
#pragma unroll
        for (int s = 0; s < 16; ++s) v[s] = vn[s];
        const u32x4 e = *((const u32x4*)IDXT + i4); const f32x4 w = *((const f32x4*)WA + i4); const float rs = RSTD[t];
        { const int i5 = i4 + step < NTOK * 32 ? i4 + step : i4; const f32x4* pp = (const f32x4*)(PD + (size_t)(i5 >> 5) * 2048) + (i5 & 31);
#pragma unroll
          for (int s = 0; s < 16; ++s) vn[s] = pp[s * 32]; }
        float ru[4], rv[4];
#pragma unroll
        for (int q = 0; q < 4; ++q) { const unsigned eq = e[q]; ru[q] = rsU[eq]; rv[q] = rsV[eq]; }
        f32x4 sm = v[0];
#pragma unroll
        for (int s = 1; s < 16; ++s) sm += v[s];
        asm volatile("" :: "v"(ru[0]), "v"(ru[1]), "v"(ru[2]), "v"(ru[3]), "v"(rv[0]), "v"(rv[1]), "v"(rv[2]), "v"(rv[3]));
        f32x4 o;
#pragma unroll
        for (int q = 0; q < 4; ++q) o[q] = gelu_erf(sm[q] * ru[q] * rs) * w[q] * rv[q];
        *((f32x4*)WA + i4) = o;
    }
}
__device__ __forceinline__ void peer_v_phase(const Ctx& c, const unsigned char* Vt, const int* IDXT, const float* WA, float* X) {
    const int xg = c.bx & 7, wr = (c.bx >> 3) * 8 + c.wave, g = c.lane >> 3, sub = c.lane & 7;
    for (int pass = 0; pass < 2; ++pass) {
        const int s = xg + 8 * pass, col0 = 128 * s + 16 * sub;
        const unsigned char* Vs = Vt + (size_t)s * PE * 128 + 16 * sub;
        u32x4 wv[8];
        { const u32x4* wp = (const u32x4*)(Vt + (size_t)s * PE * 128 + (size_t)(c.bx >> 3) * 65536) + c.tid;
#pragma unroll
          for (int q = 0; q < 8; ++q) wv[q] = wp[q * 512]; }
        u32x4 ri[4], ar[4];
        { const u32x4* ip = (const u32x4*)(IDXT + (size_t)wr * 128 + g * 16); const u32x4* ap = (const u32x4*)(WA + (size_t)wr * 128 + g * 16);
#pragma unroll
          for (int q = 0; q < 4; ++q) { ri[q] = ip[q]; ar[q] = ap[q]; } }
        for (int k = 0; k < NTOK / 256; ++k) {
            const int t = wr + 256 * k;
            u32x4 r[16]; float av[16];
#pragma unroll
            for (int j = 0; j < 16; ++j) { r[j] = *(const u32x4*)(Vs + (size_t)ri[j >> 2][j & 3] * 128); const unsigned ab_ = ar[j >> 2][j & 3]; av[j] = __builtin_bit_cast(float, ab_); }
            f32x2* xp = (f32x2*)(X + (size_t)t * DM + col0 + 2 * g);
            const f32x2 xold = *xp;
            if (k + 1 < NTOK / 256) { const u32x4* ip = (const u32x4*)(IDXT + (size_t)(t + 256) * 128 + g * 16); const u32x4* ap = (const u32x4*)(WA + (size_t)(t + 256) * 128 + g * 16);
#pragma unroll
                for (int q = 0; q < 4; ++q) { ri[q] = ip[q]; ar[q] = ap[q]; } }
            f32x2 acc[8];
#pragma unroll
            for (int q = 0; q < 8; ++q) acc[q] = (f32x2){0.f, 0.f};
#pragma unroll
            for (int j = 0; j < 16; ++j) { float aj_ = av[j]; asm("" : "+v"(aj_));
                const f32x2 a2 = {aj_, aj_};
#pragma unroll
                for (int q = 0; q < 4; ++q) { const int w = (int)r[j][q]; acc[2 * q] = __builtin_elementwise_fma(__builtin_amdgcn_cvt_pk_f32_fp8(w, false), a2, acc[2 * q]); acc[2 * q + 1] = __builtin_elementwise_fma(__builtin_amdgcn_cvt_pk_f32_fp8(w, true), a2, acc[2 * q + 1]); } }
            float af[16];
#pragma unroll
            for (int q = 0; q < 8; ++q) { af[2 * q] = acc[q].x; af[2 * q + 1] = acc[q].y; }
#ifdef VDBG
#pragma unroll
            for (int q = 0; q < 16; ++q) { af[q] += __shfl_xor(af[q], 8); af[q] += __shfl_xor(af[q], 16); af[q] += __shfl_xor(af[q], 32); }
            { float s0 = af[0], s1 = af[1];
#pragma unroll
              for (int gg = 1; gg < 8; ++gg) { s0 = (g == gg) ? af[2 * gg] : s0; s1 = (g == gg) ? af[2 * gg + 1] : s1; }
              af[0] = s0; af[1] = s1; }
#else
#pragma unroll
            for (int q = 0; q < 8; ++q) { float xa = af[q], xb = af[q + 8]; asm("s_nop 1\n\tv_permlane32_swap_b32 %0, %1" : "+v"(xa), "+v"(xb)); af[q] = xa + xb; }
#pragma unroll
            for (int q = 0; q < 4; ++q) { float xa = af[q], xb = af[q + 4]; asm("s_nop 1\n\tv_permlane16_swap_b32 %0, %1" : "+v"(xa), "+v"(xb)); af[q] = xa + xb; }
            { const bool up = (c.lane & 8) != 0;
#pragma unroll
              for (int q = 0; q < 2; ++q) { const float keep = up ? af[q + 2] : af[q], send = up ? af[q] : af[q + 2]; af[q] = keep + swz_xor<(8 << 10) | 0x1F>(send); } }
#endif
            const f32x2 xn = {xold.x + af[0], xold.y + af[1]};
            *xp = xn;
            if (k == 0) asm volatile("" :: "v"(wv[0]), "v"(wv[1]), "v"(wv[2]), "v"(wv[3]), "v"(wv[4]), "v"(wv[5]), "v"(wv[6]), "v"(wv[7]));
        }
    }
}
#ifdef VREF
__device__ __forceinline__ void peer_v_ref_phase(const Ctx& c, const unsigned char* Vt, const int* IDXT, const float* WA, float* X) {
    for (int m = c.gw; m < NTOK; m += c.ngw) {
        const int i0 = IDXT[(size_t)m * 128 + c.lane], i1 = IDXT[(size_t)m * 128 + 64 + c.lane];
        const float a0 = WA[(size_t)m * 128 + c.lane], a1 = WA[(size_t)m * 128 + 64 + c.lane];
        f32x2 acc[16];
#pragma unroll
        for (int k = 0; k < 16; ++k) acc[k] = (f32x2){0.f, 0.f};
        for (int e = 0; e < 128; ++e) {
            const int row = __shfl(e < 64 ? i0 : i1, e & 63); const float a = __shfl(e < 64 ? a0 : a1, e & 63); const f32x2 a2 = {a, a};
            const u32x4* vp = (const u32x4*)(Vt + (size_t)row * DM) + c.lane;
#pragma unroll
            for (int cc = 0; cc < 2; ++cc) { const u32x4 v = vp[64 * cc];
#pragma unroll
                for (int q = 0; q < 4; ++q) { const int w = (int)v[q];
                    acc[8 * cc + 2 * q] = __builtin_elementwise_fma(__builtin_amdgcn_cvt_pk_f32_fp8(w, false), a2, acc[8 * cc + 2 * q]);
                    acc[8 * cc + 2 * q + 1] = __builtin_elementwise_fma(__builtin_amdgcn_cvt_pk_f32_fp8(w, true), a2, acc[8 * cc + 2 * q + 1]); } }
        }
        float* xr = X + (size_t)m * DM;
#pragma unroll
        for (int cc = 0; cc < 2; ++cc) { f32x4* xp = (f32x4*)(xr + 1024 * cc + 16 * c.lane);
#pragma unroll
            for (int q = 0; q < 4; ++q) { f32x4 xa = xp[q]; xa[0] += acc[8 * cc + 2 * q].x; xa[1] += acc[8 * cc + 2 * q].y; xa[2] += acc[8 * cc + 2 * q + 1].x; xa[3] += acc[8 * cc + 2 * q + 1].y; xp[q] = xa; } }
    }
}
#endif
__device__ __forceinline__ void norm_phase(const Ctx& c, float* X, int mode, const float* g1, const float* g2, bf16* H, bf16* HKV) {
    f32x4 ga[8], gb[8]; load_g(g1, c.lane, ga); load_g(mode == 1 ? g2 : g1, c.lane, gb);
    int m = c.gw;
    f32x4 v[8]; load_row(X + (size_t)m * DM, c.lane, v);
    for (; m < NTOK; m += c.ngw) {
        const int mn = m + c.ngw < NTOK ? m + c.ngw : m;
        f32x4 nx[8]; load_row(X + (size_t)mn * DM, c.lane, nx);
        const float rstd = row_rstd(v);
        if (mode == 2) { f32x4* xo = (f32x4*)(X + (size_t)m * DM) + c.lane;
#pragma unroll
            for (int j = 0; j < 8; ++j) { f32x4 y; y[0] = v[j][0] * rstd * ga[j][0]; y[1] = v[j][1] * rstd * ga[j][1]; y[2] = v[j][2] * rstd * ga[j][2]; y[3] = v[j][3] * rstd * ga[j][3]; xo[64 * j] = y; }
        } else { store_norm_bf16_r(v, rstd, ga, H + (size_t)m * DM, c.lane); if (mode == 1) store_norm_bf16_r(v, rstd, gb, HKV + (size_t)m * DM, c.lane); }
#pragma unroll
        for (int j = 0; j < 8; ++j) v[j] = nx[j];
    }
}

__device__ __forceinline__ void rms_final_phase(const Ctx& c, float* X, const float* g) {
    for (int m = c.gw; m < NTOK; m += c.ngw) { f32x4 v[8]; load_row(X + (size_t)m * DM, c.lane, v); const float rstd = row_rstd(v);
        const f32x4* gr = (const f32x4*)g + c.lane; f32x4* xo = (f32x4*)(X + (size_t)m * DM) + c.lane;
#pragma unroll
        for (int j = 0; j < 8; ++j) { const f32x4 gv = gr[64 * j]; f32x4 y; for (int k = 0; k < 4; ++k) { y[k] = v[j][k] * rstd * gv[k]; if (!(fabsf(y[k]) < 1e30f)) y[k] = 0.f; } xo[64 * j] = y; } }
}

#ifdef DIAGBUF
__device__ __forceinline__ void diag_copy_phase(const Ctx& c, float* X, const unsigned char* ws) {
    const bf16* src = (const bf16*)(ws + (size_t)DIAGBUF);
    for (size_t i = (size_t)c.bx * 512 + c.tid; i < (size_t)NTOK * DM; i += (size_t)c.G * 512) { const size_t t = i / DM, col = i % DM; float v = bflo((unsigned)src[t * DIAGLD + col]); if (!(fabsf(v) < 1e30f)) v = 0.f; X[i] = v; }
}
#endif

__device__ __forceinline__ unsigned off_b(unsigned row, unsigned ch) { return 256u * row + 16u * (ch ^ (((row & 3u) << 2) | ((row >> 2) & 3u))); }
__device__ __forceinline__ float rowmax4(float x) {
    float a = x, b = x; asm("s_nop 1\n\tv_permlane16_swap_b32 %0, %1" : "+v"(a), "+v"(b)); x = fmaxf(a, b);
    a = x; b = x; asm("s_nop 1\n\tv_permlane32_swap_b32 %0, %1" : "+v"(a), "+v"(b)); return fmaxf(a, b);
}
constexpr int AT_K = 0, AT_V = 32768, AT_BUF = 65536, AT_BIAS = 131072, AT_HEADB = 16384;
__device__ __forceinline__ void attn_phase(const Ctx& c, const bf16* Qg, const bf16* KVg, bf16* AOg, const float* relb, int dryvar = 0) {
    LAS unsigned char* lds = c.lds; const unsigned ldsb = (unsigned)(size_t)lds;
    const int tid = c.tid, lane = c.lane, w = c.wave, hg = w >> 2, wq = w & 3, fr = lane & 15, fq = lane >> 4, tq = (lane & 15) >> 2, tp = lane & 3;
    const int tl = tid & 255, lrow = tl >> 2, lc = tl & 3;
    unsigned vadr[8];
#pragma unroll
    for (int d = 0; d < 8; ++d) vadr[d] = ldsb + AT_V + hg * AT_HEADB + off_b(4 * fq + tq, 2 * d + (tp >> 1)) + 8 * (tp & 1);
    unsigned kadr[4];
#pragma unroll
    for (int s4 = 0; s4 < 4; ++s4) kadr[s4] = ldsb + AT_K + hg * AT_HEADB + 256 * fr + 16 * (fq ^ ((fr >> 2) & 3)) + 64 * (s4 ^ (fr & 3));
    for (int u = c.bx; u < NBATCH * NCHUNK * (AH / 2); u += c.G) {
        const int hp = u & 7, ch = (u >> 3) & 63, b = u >> 9, h = 2 * hp + hg;
        const size_t tq0 = (size_t)b * SEQ + (size_t)ch * CHUNK;
        __syncthreads();
        for (int i = tid; i < 2 * 272; i += 512) { const int hh = i / 272, k = i % 272; ((LAS float*)(lds + AT_BIAS))[i] = (k < NREL) ? relb[(size_t)(2 * hp + hh) * NREL + k] * 1.4426950408889634f : 0.f; }
        bf16x8 qf[4];
        { const bf16* qp = Qg + (tq0 + 16 * wq + fr) * DM + h * AHD + 8 * fq;
#pragma unroll
          for (int s = 0; s < 4; ++s) qf[s] = *(const bf16x8*)(qp + 32 * s); }
        f32x4 O[8];
#pragma unroll
        for (int d = 0; d < 8; ++d) O[d] = (f32x4){0.f, 0.f, 0.f, 0.f};
        float mrun = -1e30f, lrun = 0.f;
        const int t0 = ch >= LEFT ? 0 : LEFT - ch;
        u32x4 pk[4], pv[4];
        { const bf16* kp = KVg + ((size_t)b * SEQ + (size_t)(ch - LEFT + t0) * CHUNK + lrow) * (2 * DM) + h * AHD;
#pragma unroll
          for (int cc = 0; cc < 4; ++cc) { pk[cc] = *(const u32x4*)(kp + (lc + 4 * cc) * 8); pv[cc] = *(const u32x4*)(kp + DM + (lc + 4 * cc) * 8); } }
        const LAS float* bias = (const LAS float*)(lds + AT_BIAS) + hg * 272;
        const float bc = relb[(size_t)h * NREL + 256] * 1.4426950408889634f;
        for (int t = t0; t <= LEFT; ++t) {
            const int pb = ((t - t0) & 1) * AT_BUF;
#pragma unroll
            for (int cc = 0; cc < 4; ++cc) { *(LAS u32x4*)(lds + pb + AT_K + hg * AT_HEADB + off_b(lrow, lc + 4 * cc)) = pk[cc]; *(LAS u32x4*)(lds + pb + AT_V + hg * AT_HEADB + off_b(lrow, lc + 4 * cc)) = pv[cc]; }
            __syncthreads();
            if (t < LEFT && dryvar != 1) { const bf16* kp = KVg + ((size_t)b * SEQ + (size_t)(ch - LEFT + t + 1) * CHUNK + lrow) * (2 * DM) + h * AHD;
#pragma unroll
                for (int cc = 0; cc < 4; ++cc) { pk[cc] = *(const u32x4*)(kp + (lc + 4 * cc) * 8); pv[cc] = *(const u32x4*)(kp + DM + (lc + 4 * cc) * 8); } }
            f32x4 sT[4];
            {
                bf16x8 kf[16];
                const unsigned k0 = kadr[0] + pb, k1 = kadr[1] + pb, k2 = kadr[2] + pb, k3 = kadr[3] + pb;
                asm volatile("ds_read_b128 %0, %16\n\tds_read_b128 %1, %17\n\tds_read_b128 %2, %18\n\tds_read_b128 %3, %19\n\t"
                             "ds_read_b128 %4, %16 offset:4096\n\tds_read_b128 %5, %17 offset:4096\n\tds_read_b128 %6, %18 offset:4096\n\tds_read_b128 %7, %19 offset:4096\n\t"
                             "ds_read_b128 %8, %16 offset:8192\n\tds_read_b128 %9, %17 offset:8192\n\tds_read_b128 %10, %18 offset:8192\n\tds_read_b128 %11, %19 offset:8192\n\t"
                             "ds_read_b128 %12, %16 offset:12288\n\tds_read_b128 %13, %17 offset:12288\n\tds_read_b128 %14, %18 offset:12288\n\tds_read_b128 %15, %19 offset:12288"
                             : "=&v"(kf[0]), "=&v"(kf[1]), "=&v"(kf[2]), "=&v"(kf[3]), "=&v"(kf[4]), "=&v"(kf[5]), "=&v"(kf[6]), "=&v"(kf[7]),
                               "=&v"(kf[8]), "=&v"(kf[9]), "=&v"(kf[10]), "=&v"(kf[11]), "=&v"(kf[12]), "=&v"(kf[13]), "=&v"(kf[14]), "=&v"(kf[15])
                             : "v"(k0), "v"(k1), "v"(k2), "v"(k3) : "memory");
                asm volatile("s_waitcnt lgkmcnt(8)" : "+v"(kf[0]), "+v"(kf[1]), "+v"(kf[2]), "+v"(kf[3]), "+v"(kf[4]), "+v"(kf[5]), "+v"(kf[6]), "+v"(kf[7]) :: "memory");
#pragma unroll
                for (int kt = 0; kt < 2; ++kt) { sT[kt] = (f32x4){0.f, 0.f, 0.f, 0.f};
#pragma unroll
                    for (int s = 0; s < 4; ++s) sT[kt] = MFMA16(kf[4 * kt + s], qf[s], sT[kt]); }
                asm volatile("s_waitcnt lgkmcnt(0)" : "+v"(kf[8]), "+v"(kf[9]), "+v"(kf[10]), "+v"(kf[11]), "+v"(kf[12]), "+v"(kf[13]), "+v"(kf[14]), "+v"(kf[15]) :: "memory");
#pragma unroll
                for (int kt = 2; kt < 4; ++kt) { sT[kt] = (f32x4){0.f, 0.f, 0.f, 0.f};
#pragma unroll
                    for (int s = 0; s < 4; ++s) sT[kt] = MFMA16(kf[4 * kt + s], qf[s], sT[kt]); }
            }
            const int dbase = (LEFT - t) * CHUNK + (16 * wq + fr);
            if (t > LEFT - 3) {
#pragma unroll
                for (int kt = 0; kt < 4; ++kt)
#pragma unroll
                    for (int r = 0; r < 4; ++r) { const int dist = dbase - (16 * kt + 4 * fq + r); sT[kt][r] += bias[min(dist, 128) + 128]; }
            }
            s16x4 vlo[2][8], vhi[2][8];
            unsigned vcur[8];
#pragma unroll
            for (int d = 0; d < 8; ++d) vcur[d] = vadr[d] + pb;
#define TR8(dst, OFF) asm volatile("ds_read_b64_tr_b16 %0, %8 offset:" #OFF "\n\tds_read_b64_tr_b16 %1, %9 offset:" #OFF "\n\tds_read_b64_tr_b16 %2, %10 offset:" #OFF "\n\tds_read_b64_tr_b16 %3, %11 offset:" #OFF "\n\t" \
                "ds_read_b64_tr_b16 %4, %12 offset:" #OFF "\n\tds_read_b64_tr_b16 %5, %13 offset:" #OFF "\n\tds_read_b64_tr_b16 %6, %14 offset:" #OFF "\n\tds_read_b64_tr_b16 %7, %15 offset:" #OFF \
                : "=&v"(dst[0]), "=&v"(dst[1]), "=&v"(dst[2]), "=&v"(dst[3]), "=&v"(dst[4]), "=&v"(dst[5]), "=&v"(dst[6]), "=&v"(dst[7]) \
                : "v"(vcur[0]), "v"(vcur[1]), "v"(vcur[2]), "v"(vcur[3]), "v"(vcur[4]), "v"(vcur[5]), "v"(vcur[6]), "v"(vcur[7]) : "memory")
            TR8(vlo[0], 0); TR8(vhi[0], 4096); TR8(vlo[1], 8192); TR8(vhi[1], 12288);
#undef TR8
            float mx = -1e30f;
            const float badd = t <= LEFT - 3 ? bc : 0.f;
#pragma unroll
            for (int kt = 0; kt < 4; ++kt)
#pragma unroll
                for (int r = 0; r < 4; ++r) { sT[kt][r] += badd; mx = fmaxf(mx, sT[kt][r]); }
            mx = rowmax4(mx);
            const float mnew = fmaxf(mrun, mx), alpha = __builtin_amdgcn_exp2f(mrun - mnew); mrun = mnew;
            float ps = 0.f;
#pragma unroll
            for (int kt = 0; kt < 4; ++kt)
#pragma unroll
                for (int r = 0; r < 4; ++r) { sT[kt][r] = __builtin_amdgcn_exp2f(sT[kt][r] - mnew); ps += sT[kt][r]; }
            lrun = lrun * alpha + ps;
#pragma unroll
            for (int d = 0; d < 8; ++d) O[d] *= alpha;
            asm volatile("s_waitcnt lgkmcnt(0)" : "+v"(vlo[0][0]), "+v"(vlo[0][1]), "+v"(vlo[0][2]), "+v"(vlo[0][3]), "+v"(vlo[0][4]), "+v"(vlo[0][5]), "+v"(vlo[0][6]), "+v"(vlo[0][7]),
                         "+v"(vhi[0][0]), "+v"(vhi[0][1]), "+v"(vhi[0][2]), "+v"(vhi[0][3]), "+v"(vhi[0][4]), "+v"(vhi[0][5]), "+v"(vhi[0][6]), "+v"(vhi[0][7]) :: "memory");
            asm volatile("" : "+v"(vlo[1][0]), "+v"(vlo[1][1]), "+v"(vlo[1][2]), "+v"(vlo[1][3]), "+v"(vlo[1][4]), "+v"(vlo[1][5]), "+v"(vlo[1][6]), "+v"(vlo[1][7]),
                         "+v"(vhi[1][0]), "+v"(vhi[1][1]), "+v"(vhi[1][2]), "+v"(vhi[1][3]), "+v"(vhi[1][4]), "+v"(vhi[1][5]), "+v"(vhi[1][6]), "+v"(vhi[1][7]) :: "memory");
            __builtin_amdgcn_sched_barrier(0);
#pragma unroll
            for (int ks = 0; ks < 2; ++ks) {
                bf16x8 pb; { const unsigned p0 = pk2(sT[2 * ks][0], sT[2 * ks][1]), p1 = pk2(sT[2 * ks][2], sT[2 * ks][3]), p2 = pk2(sT[2 * ks + 1][0], sT[2 * ks + 1][1]), p3 = pk2(sT[2 * ks + 1][2], sT[2 * ks + 1][3]);
                    const u32x4 pw = (u32x4){p0, p1, p2, p3}; pb = __builtin_bit_cast(bf16x8, pw); }
#pragma unroll
                for (int d = 0; d < 8; ++d) { bf16x8 va; va[0] = vlo[ks][d][0]; va[1] = vlo[ks][d][1]; va[2] = vlo[ks][d][2]; va[3] = vlo[ks][d][3]; va[4] = vhi[ks][d][0]; va[5] = vhi[ks][d][1]; va[6] = vhi[ks][d][2]; va[7] = vhi[ks][d][3];
                    O[d] = MFMA16(va, pb, O[d]); }
            }
        }
        float lt = lrun; lt += __shfl_xor(lt, 16); lt += __shfl_xor(lt, 32);
        const float inv = 1.0f / lt;
        bf16* op = AOg + (tq0 + 16 * wq + fr) * DM + h * AHD + 4 * fq;
#pragma unroll
        for (int d = 0; d < 8; ++d) { u32x2 ow; ow.x = pk2(O[d][0] * inv, O[d][1] * inv); ow.y = pk2(O[d][2] * inv, O[d][3] * inv); *(u32x2*)(op + 16 * d) = ow; }
    }
}

constexpr int NSTEPS = 1 + 2 * 10 + 2 * 9;
template <int MASK> __global__ void __launch_bounds__(512, 2) yoco_fwd(Params p) {
    extern __shared__ __attribute__((aligned(16))) unsigned char lds_raw[];
#define MK_CTX() Ctx c; { int t_ = threadIdx.x; asm volatile("" : "+v"(t_)); c.lds = (LAS unsigned char*)lds_raw; c.tid = t_; c.lane = t_ & 63; c.wave = __builtin_amdgcn_readfirstlane(t_ >> 6); \
        { int b_ = blockIdx.x, g_ = gridDim.x; asm volatile("" : "+s"(b_), "+s"(g_)); c.bx = b_; c.G = g_; } c.gw = c.bx * 8 + c.wave; c.ngw = c.G * 8; }
    volatile LAS unsigned* MISC = (volatile LAS unsigned*)((LAS unsigned char*)lds_raw + LDS_MISC);
    if (threadIdx.x < 4) MISC[threadIdx.x] = 0u;
    __syncthreads();
    XcdBarrier bar; bar.bar = (unsigned*)(p.ws + WS_CTL); bar.x = 0; bar.st = MISC;
    if (p.hi - p.lo > 1) bar = xcd_barrier_post((unsigned*)(p.ws + WS_CTL), MISC);
    unsigned char* ws = p.ws;
    bf16* const H = (bf16*)(ws + WS_H); bf16* const HKV = (bf16*)(ws + WS_HKV);
    float* const X = p.out;
    int s = 0;
#ifndef REPMASK
#define REPMASK 0
#endif
#define KF_(f) p.f = kq_->f;
#define MK_P() Params p; { unsigned long long ka_ = (unsigned long long)__builtin_amdgcn_kernarg_segment_ptr(); asm volatile("" : "+s"(ka_)); const __attribute__((address_space(4))) Params* kq_ = (const __attribute__((address_space(4))) Params*)ka_; \
        KF_(x) KF_(ln_mix) KF_(ln_ffn) KF_(ret_w_in) KF_(ret_w_out) KF_(ret_gn) KF_(kv_norm) KF_(w_kv) KF_(att_w_q) KF_(att_w_o) KF_(att_rel_bias) KF_(peer_w_q) KF_(peer_sub_keys) KF_(peer_u) KF_(peer_v) KF_(ln_final) \
        KF_(out) KF_(ws) KF_(lo) KF_(hi) } \
        unsigned char* const ws = p.ws; bf16* const H = (bf16*)(ws + WS_H); bf16* const HKV = (bf16*)(ws + WS_HKV); float* const X = p.out; (void)H; (void)HKV; (void)X;
#define BEGIN_STEP(k) if (((MASK >> (k)) & 1) && s >= p.lo && s < p.hi) { for (int rep_ = ((REPMASK >> (k)) & 1) ? 0 : 1; rep_ < 2; ++rep_) { MK_CTX(); MK_P();
#define END_STEP   if (rep_ == 0 || s + 1 < p.hi) xcd_barrier(bar); } } ++s;

    BEGIN_STEP(0) p0_prologue(p, c); END_STEP

    for (int l = 0; l < DEPTH; ++l) {
        if (l < 2) {
            BEGIN_STEP(1)
                pg8::Gemm g{H, (const bf16*)(ws + WS_WIN) + (size_t)l * RIN * DM, NTOK, RIN, DM}; pg8::StaticOrder S; S.init(NTOK, RIN, c.G, c.bx);
                pg8::EpiProj E{(bf16*)(ws + WS_Q), (bf16*)(ws + WS_K), (bf16*)(ws + WS_V), (bf16*)(ws + WS_G), (const float*)(ws + WS_ROT)};
                pg8::gemm_phase<pg8::EpiProj, pg8::StaticOrder>(c.lds, g, S, E, nullptr);
            END_STEP
            BEGIN_STEP(2)
                for (int u = c.bx; u < 256; u += c.G) ret_scan_unit(c, (const bf16*)(ws + WS_Q), (const bf16*)(ws + WS_K), (const bf16*)(ws + WS_V), (bf16*)(ws + WS_O), u);
            END_STEP
            BEGIN_STEP(3)
                ret_gate_phase(c, (const bf16*)(ws + WS_O), (bf16*)(ws + WS_G), p.ret_gn + (size_t)l * RVW, rep_ == 0 ? (bf16*)(ws + WS_SC) : nullptr);
            END_STEP
        } else {
            BEGIN_STEP(4)
                for (int pass = (l == 2 ? 0 : 1); pass < 2; ++pass) {
                    const int N = pass ? DM : 2 * DM;
                    pg8::Gemm g{pass ? H : HKV, pass ? (const bf16*)(ws + WS_WQ) + (size_t)(l - 2) * DM * DM : (const bf16*)(ws + WS_WKV), NTOK, N, DM}; pg8::StaticOrder S; S.init(NTOK, N, c.G, c.bx);
                    pg8::EpiBf16S E{pass ? (bf16*)(ws + WS_Q) : (bf16*)(ws + WS_KV), N, pass ? 0.12751743082459868f : 1.0f};
                    pg8::gemm_phase<pg8::EpiBf16S, pg8::StaticOrder>(c.lds, g, S, E, nullptr);
                }
            END_STEP
            BEGIN_STEP(5)
#ifdef ATTNDRY
                attn_phase(c, (const bf16*)(ws + WS_Q), (const bf16*)(ws + WS_KV), rep_ == 0 ? (bf16*)(ws + WS_O) : (bf16*)(ws + WS_AO), p.att_rel_bias + (size_t)(l - 2) * AH * NREL, rep_ == 0 ? ATTNDRY : 0);
#else
                attn_phase(c, (const bf16*)(ws + WS_Q), (const bf16*)(ws + WS_KV), (bf16*)(ws + WS_AO), p.att_rel_bias + (size_t)(l - 2) * AH * NREL);
#endif
            END_STEP
        }
        BEGIN_STEP(6)
            const int K = l < 2 ? RVW : DM;
            pg8::Gemm g{l < 2 ? (const bf16*)(ws + WS_G) : (const bf16*)(ws + WS_AO), l < 2 ? (const bf16*)(ws + WS_WOUT) + (size_t)l * DM * RVW : (const bf16*)(ws + WS_WO) + (size_t)(l - 2) * DM * DM, NTOK, DM, K};
            pg8::StaticOrder S; S.init(NTOK, DM, c.G, c.bx);
            pg8::EpiRes E{X, DM, H, p.ln_ffn + (size_t)l * DM, (float*)(ws + WS_SQP)};
            pg8::gemm_phase<pg8::EpiRes, pg8::StaticOrder>(c.lds, g, S, E, nullptr);
        END_STEP
        BEGIN_STEP(8)
            pg8::Gemm g{H, (const bf16*)(ws + WS_WC) + (size_t)l * DM * DM, NTOK, DM, DM}; pg8::StaticOrder S; S.init(NTOK, DM, c.G, c.bx);
            pg8::EpiF32 E{(float*)(ws + WS_SC), DM};
            pg8::gemm_phase<pg8::EpiF32, pg8::StaticOrder>(c.lds, g, S, E, nullptr);
        END_STEP
        BEGIN_STEP(9)
            peer_topk_phase(c, (const float*)(ws + WS_SC), (int*)(ws + WS_IDX), (float*)(ws + WS_WGT), (const float*)(ws + WS_SQP), (float*)(ws + WS_RSTD));
        END_STEP
        BEGIN_STEP(10)
#ifdef DRYIDXMASK
            peer_u_phase(c, H, ws + WS_PU + (size_t)l * PE * DM, (const int*)(ws + WS_IDX), (float*)(ws + WS_SC), rep_ == 0 ? DRYIDXMASK : 0xffffffffu);
#else
            peer_u_phase(c, H, ws + WS_PU + (size_t)l * PE * DM, (const int*)(ws + WS_IDX), (float*)(ws + WS_SC));
#endif
        END_STEP
        BEGIN_STEP(11)
            peer_a_phase(c, (const float*)(ws + WS_SC), (const int*)(ws + WS_IDX), (float*)(ws + WS_WGT), (const float*)(ws + WS_RS) + (size_t)l * PE, (const float*)(ws + WS_RS) + (size_t)(DEPTH + l) * PE, (const float*)(ws + WS_RSTD));
        END_STEP
        BEGIN_STEP(12)
#ifdef VREF
            peer_v_ref_phase(c, ws + WS_PV + (size_t)l * PE * DM, (const int*)(ws + WS_IDX), (const float*)(ws + WS_WGT), X);
#else
            peer_v_phase(c, ws + WS_PV + (size_t)l * PE * DM, (const int*)(ws + WS_IDX), (const float*)(ws + WS_WGT), X);
#endif
        END_STEP
        BEGIN_STEP(13)
            const int mode = (l == DEPTH - 1) ? 2 : (l == 1 ? 1 : 0);
            norm_phase(c, X, mode, mode == 2 ? p.ln_final : p.ln_mix + (size_t)(l + 1) * DM, p.kv_norm, H, HKV);
        END_STEP
    }
#ifdef DIAGBUF
    if ((MASK >> 14) & 1) { MK_CTX(); diag_copy_phase(c, X, ws); }
#else
    if ((MASK >> 14) & 1) { MK_CTX(); MK_P(); rms_final_phase(c, X, p.ln_final); }
#endif
#undef BEGIN_STEP
#undef END_STEP
}

#ifndef N_LAUNCH_CUT
#define N_LAUNCH_CUT 1
#endif
typedef void (*kern_t)(Params);
template <int SITE> static void launch_site(const Params& p, hipStream_t stream) {
    static bool attr = false;
    if (!attr) { (void)hipFuncSetAttribute((const void*)yoco_fwd<(1 << SITE)>, hipFuncAttributeMaxDynamicSharedMemorySize, LDS_BYTES); attr = true; }
    hipLaunchKernelGGL((yoco_fwd<(1 << SITE)>), dim3(256), dim3(512), LDS_BYTES, stream, p);
}
#ifndef MEGASITES
#define MEGASITES 0
#endif
static void launch_step_site(int site, const Params& p, hipStream_t stream) {
    if ((MEGASITES >> site) & 1) { hipLaunchKernelGGL((yoco_fwd<0x3FFF>), dim3(256), dim3(512), LDS_BYTES, stream, p); return; }
    switch (site) {
        case 0: launch_site<0>(p, stream); break; case 1: launch_site<1>(p, stream); break; case 2: launch_site<2>(p, stream); break; case 3: launch_site<3>(p, stream); break;
        case 4: launch_site<4>(p, stream); break; case 5: launch_site<5>(p, stream); break; case 6: launch_site<6>(p, stream); break; case 7: launch_site<7>(p, stream); break;
        case 8: launch_site<8>(p, stream); break; case 9: launch_site<9>(p, stream); break; case 10: launch_site<10>(p, stream); break; case 11: launch_site<11>(p, stream); break; case 12: launch_site<12>(p, stream); break; case 13: launch_site<13>(p, stream); break; default: launch_site<14>(p, stream); break;
    }
}
extern "C" void kernel_launch(void* const* d_in, const int* in_sizes, int n_in, void* d_out, int out_size, void* d_ws, size_t ws_size, hipStream_t stream) {
    static int ready = 0;
    if (ready == 0) {
        if (n_in != 16 || out_size != NTOK * DM || ws_size < WS_END) { fprintf(stderr, "kernel_launch: unexpected sizes (n_in %d out %d ws %zu, need %zu)\n", n_in, out_size, ws_size, (size_t)WS_END); ready = -1; return; }
#if N_LAUNCH_CUT || MEGASITES
        if (hipFuncSetAttribute((const void*)yoco_fwd<0x3FFF>, hipFuncAttributeMaxDynamicSharedMemorySize, LDS_BYTES) != hipSuccess) { fprintf(stderr, "kernel_launch: hipFuncSetAttribute failed\n"); ready = -1; return; }
#endif
        ready = 1;
    }
    if (ready < 0) return;
    (void)hipMemsetAsync(d_ws, 0, 16384, stream);
    Params p{};
    p.x = (const float*)d_in[0]; p.ln_mix = (const float*)d_in[1]; p.ln_ffn = (const float*)d_in[2]; p.ret_w_in = (const float*)d_in[3]; p.ret_w_out = (const float*)d_in[4]; p.ret_gn = (const float*)d_in[5];
    p.kv_norm = (const float*)d_in[6]; p.w_kv = (const float*)d_in[7]; p.att_w_q = (const float*)d_in[8]; p.att_w_o = (const float*)d_in[9]; p.att_rel_bias = (const float*)d_in[10];
    p.peer_w_q = (const float*)d_in[11]; p.peer_sub_keys = (const float*)d_in[12]; p.peer_u = (const float*)d_in[13]; p.peer_v = (const float*)d_in[14]; p.ln_final = (const float*)d_in[15];
    p.out = (float*)d_out; p.ws = (unsigned char*)d_ws;
#if N_LAUNCH_CUT == 2
    for (int s2 = 0; s2 < NSTEPS; ++s2) { p.lo = s2; p.hi = s2 + 1; hipLaunchKernelGGL((yoco_fwd<0x3FFF>), dim3(256), dim3(512), LDS_BYTES, stream, p); }
#elif N_LAUNCH_CUT
    p.lo = 0; p.hi = NSTEPS;
    hipLaunchKernelGGL((yoco_fwd<0x3FFF>), dim3(256), dim3(512), LDS_BYTES, stream, p);
#else
    static const int siteA[10] = {1, 2, 3, 6, 8, 9, 10, 11, 12, 13}, siteB[9] = {4, 5, 6, 8, 9, 10, 11, 12, 13};
    int s = 0;
#ifndef NSTOP
#define NSTOP 1000
#endif
    p.lo = s; p.hi = s + 1; launch_step_site(0, p, stream); ++s;
    for (int l = 0; l < DEPTH; ++l) { const int n = l < 2 ? 10 : 9; for (int k = 0; k < n; ++k) { p.lo = s; p.hi = s + 1; if (s < NSTOP) launch_step_site(l < 2 ? siteA[k] : siteB[k], p, stream); ++s; } }
    if (NSTOP < NSTEPS) { p.lo = -1; p.hi = -1; launch_step_site(14, p, stream); }
#endif
}
```

```cpp
#include <hip/hip_runtime.h>
#include <cstdio>
#include <cstdint>

#define LAS __attribute__((address_space(3)))
#define GAS __attribute__((address_space(1)))
typedef unsigned short bf16;
typedef unsigned u32x2 __attribute__((ext_vector_type(2)));
typedef float f32x2v __attribute__((ext_vector_type(2)));

constexpr int DM = 2048, NBATCH = 4, SEQ = 4096, NTOK = NBATCH * SEQ, DEPTH = 4;
constexpr int CHUNK = 64, NCHUNK = SEQ / CHUNK;
constexpr int RH = 8, RQK = 256, RV = 512, RQKW = RH * RQK, RVW = RH * RV, RIN = 2 * RQKW + 2 * RVW;
constexpr int AH = 16, AHD = 128, LEFT = 8, NREL = 257;
constexpr int PH = 8, PNK = 128, PE = PNK * PNK, PTOPK = 16;
constexpr float EPS = 1e-6f;

constexpr size_t MiB = 1ull << 20;
constexpr size_t WS_CTL = 0, CTL_BYTES = 1 * MiB;
constexpr size_t WS_ROT = 1 * MiB;
constexpr size_t WS_RS = 6 * MiB;
constexpr size_t WS_WIN = 8 * MiB;
constexpr size_t WS_WOUT = 104 * MiB;
constexpr size_t WS_WKV = 136 * MiB;
constexpr size_t WS_WQ = 152 * MiB;
constexpr size_t WS_WO = 168 * MiB;
constexpr size_t WS_WC = 184 * MiB;
constexpr size_t WS_PU = 216 * MiB;
constexpr size_t WS_PV = 472 * MiB;
constexpr size_t WS_H = 728 * MiB;
constexpr size_t WS_HKV = 792 * MiB;
constexpr size_t WS_Q = 856 * MiB;
constexpr size_t WS_K = 920 * MiB;
constexpr size_t WS_V = 984 * MiB;
constexpr size_t WS_G = 1112 * MiB;
constexpr size_t WS_O = 1240 * MiB;
constexpr size_t WS_KV = 1368 * MiB;
constexpr size_t WS_AO = 1496 * MiB;
constexpr size_t WS_SC = 1560 * MiB;
constexpr size_t WS_IDX = 1688 * MiB;
constexpr size_t WS_WGT = 1696 * MiB;
constexpr size_t WS_SQP = 1704 * MiB;
constexpr size_t WS_RSTD = 1706 * MiB;
constexpr size_t WS_END = 1708 * MiB;

constexpr int LDS_BYTES = 160 * 1024;
constexpr int LDS_MISC = LDS_BYTES - 256;

__device__ __forceinline__ unsigned f2bf(float f) { unsigned u = __builtin_bit_cast(unsigned, f); return (u + 0x7fffu + ((u >> 16) & 1u)) >> 16; }
typedef __bf16 bfx2_t __attribute__((ext_vector_type(2)));
__device__ __forceinline__ unsigned pk2(float lo, float hi) { const f32x2v v = {lo, hi}; return __builtin_bit_cast(unsigned, __builtin_convertvector(v, bfx2_t)); }
__device__ __forceinline__ float bflo(unsigned u) { return __builtin_bit_cast(float, u << 16); }
__device__ __forceinline__ float bfhi(unsigned u) { return __builtin_bit_cast(float, u & 0xffff0000u); }
__device__ __forceinline__ float wave_sum(float v) {
#pragma unroll
    for (int o = 1; o < 64; o <<= 1) v += __shfl_xor(v, o);
    return v;
}
#define VM_WAIT() asm volatile("s_waitcnt vmcnt(0)" ::: "memory")
#define LDS_WAIT() asm volatile("s_waitcnt lgkmcnt(0)" ::: "memory")

#define XB_TMO      128
#define XB_XCNT(j)  (256  + 64 * (j))
#define XB_XSUB(j)  (1280 + 64 * (j))
#define XB_XGEN(j)  (2304 + 64 * (j))
#define XB_TOP      3328
#define XB_TOPGEN   3392
#define XCD_BAR_WORDS 3456
#define XB_SPIN_CAP (1u << 18)

__device__ __forceinline__ unsigned xb_ld(unsigned* p)              { return __hip_atomic_load(p, __ATOMIC_RELAXED, __HIP_MEMORY_SCOPE_AGENT); }
__device__ __forceinline__ unsigned xb_add(unsigned* p, unsigned v) { return __hip_atomic_fetch_add(p, v, __ATOMIC_RELAXED, __HIP_MEMORY_SCOPE_AGENT); }
__device__ __forceinline__ unsigned xb_xcc_id() { return (unsigned)__builtin_amdgcn_s_getreg((3 << 11) | 20) & 0xFu; }
#define XB_SPIN(cond, bar) do { unsigned _sp = 0; while (cond) { __builtin_amdgcn_s_sleep(1); \
    if ((++_sp & 255u) == 0u) { if (xb_ld(&(bar)[XB_TMO])) break; if (_sp > XB_SPIN_CAP) { atomicAdd(&(bar)[XB_TMO], 1u); break; } } } } while (0)

struct XcdBarrier {
    unsigned* bar; unsigned x;
    volatile LAS unsigned* st;
};

__device__ __forceinline__ XcdBarrier xcd_barrier_post(unsigned* bar, volatile LAS unsigned* st) {
    XcdBarrier b; b.bar = bar; b.x = xb_xcc_id(); b.st = st;
    if (threadIdx.x == 0) (void)xb_add(&bar[XB_XCNT(b.x)], 1u);
    return b;
}
__device__ __forceinline__ void xcd_barrier_complete(unsigned* bar, unsigned x, unsigned& nloc, unsigned& nx) {
    const unsigned G = gridDim.x * gridDim.y * gridDim.z;
    unsigned sum, cnt, mine, sp = 0u;
    for (;;) {
        sum = 0u; cnt = 0u; mine = 0u;
#pragma unroll
        for (unsigned j = 0; j < 16; ++j) { const unsigned c = xb_ld(&bar[XB_XCNT(j)]); sum += c; cnt += (c > 0u) ? 1u : 0u; mine = (j == x) ? c : mine; }
        if (sum == G) break;
        __builtin_amdgcn_s_sleep(1);
        if ((++sp & 255u) == 0u) { if (xb_ld(&bar[XB_TMO])) break; if (sp > XB_SPIN_CAP) { atomicAdd(&bar[XB_TMO], 1u); break; } }
    }
    nloc = mine > 0u ? mine : 1u; nx = cnt > 0u ? cnt : 1u;
}

__device__ __forceinline__ void xcd_barrier(const XcdBarrier& b) {
    asm volatile("s_waitcnt vmcnt(0)" ::: "memory");
    __syncthreads();
    if (threadIdx.x == 0) {
        unsigned* bar = b.bar;
        __builtin_amdgcn_s_waitcnt(0);
        unsigned nloc = b.st[0], nx = b.st[1];
        if (nloc == 0u) { xcd_barrier_complete(bar, b.x, nloc, nx); b.st[0] = nloc; b.st[1] = nx; }
        const unsigned old = xb_add(&bar[XB_XSUB(b.x)], 1u);
        const unsigned gen = old / nloc;
        if (old + 1u == (gen + 1u) * nloc) {
            __builtin_amdgcn_fence(__ATOMIC_RELEASE, "agent");
            asm volatile("s_waitcnt vmcnt(0)" ::: "memory");
            const unsigned og = xb_add(&bar[XB_TOP], 1u);
            const unsigned tg = og / nx;
            if (og + 1u == (tg + 1u) * nx) xb_add(&bar[XB_TOPGEN], 1u);
            else XB_SPIN(xb_ld(&bar[XB_TOPGEN]) == tg, bar);
            __builtin_amdgcn_fence(__ATOMIC_ACQUIRE, "agent");
            xb_add(&bar[XB_XGEN(b.x)], 1u);
            asm volatile("s_waitcnt vmcnt(0)" ::: "memory");
        } else {
            XB_SPIN(xb_ld(&bar[XB_XGEN(b.x)]) == gen, bar);
            __builtin_amdgcn_fence(__ATOMIC_ACQUIRE, "agent");
            asm volatile("s_waitcnt vmcnt(0)" ::: "memory");
        }
    }
    __syncthreads();
}

namespace pg8 {
#define PG8_LAS __attribute__((address_space(3)))
typedef unsigned short bf16_t;
typedef short bf16x8 __attribute__((ext_vector_type(8)));
typedef float f32x4 __attribute__((ext_vector_type(4)));
typedef unsigned u32x4 __attribute__((ext_vector_type(4)));
constexpr int BM = 256, BK = 64, HALF = 128, HTB = HALF * BK * 2  , STAGE_BYTES = 8 * HTB, NXCD = 8, WGM = 8;

__host__ __device__ __forceinline__ int lds_byte(int r, int c) { const int st = (r >> 4) * 2 + (c >> 5), rr = r & 15, cc = c & 31, ob = rr * 64 + cc * 2; return st * 1024 + (ob ^ (((ob >> 9) & 1) << 5)); }
__host__ __device__ __forceinline__ void stage_rc(int b, int& R, int& C) { const int st = b / 1024, sb = b % 1024, swz = sb ^ (((sb >> 9) & 1) << 5); R = (st >> 1) * 16 + swz / 64; C = (st & 1) * 32 + (swz % 64) / 2; }
__host__ __device__ __forceinline__ int perm32(int rho) { const int n = rho >> 4, i = rho & 15; return 8 * (i >> 2) + 4 * n + (i & 3); }

struct Unit { int pm, pn; };
struct Gemm { const bf16_t* A; const bf16_t* Bt; int M, N, K; };

struct StaticOrder {
    int nM, nN, nwg, G, c;
    __host__ __device__ void init(int M, int N, int G_, int c_) { nM = M / BM; nN = N / BM; nwg = nM * nN; G = G_; c = c_; }
    __host__ __device__ bool next(int i, Unit& u) const {
        const long L = (long)i * G + c; if (L >= nwg) return false;
        int wgid = (int)L; { const int q = nwg / NXCD, r = nwg % NXCD, xcd = wgid % NXCD, off = wgid / NXCD; wgid = (xcd < r ? xcd * (q + 1) : r * (q + 1) + (xcd - r) * q) + off; }
        const int nig = WGM * nN, gid = wgid / nig, fm = gid * WGM, gsz = (nM - fm) < WGM ? (nM - fm) : WGM;
        u.pm = fm + ((wgid % nig) % gsz); u.pn = (wgid % nig) / gsz; return true;
    }
    __device__ __forceinline__ void a_ready(const Unit&) const {}
    __device__ __forceinline__ void done(const Unit&) const {}
};
struct CountedOrder : StaticOrder {
    const unsigned* ready; unsigned need; unsigned* tmo;
    __device__ __forceinline__ void a_ready(const Unit& u) const {
        if (threadIdx.x < 64) {
            const unsigned long long t0 = __builtin_amdgcn_s_memrealtime(); unsigned polls = 0;
            while ((unsigned)__builtin_amdgcn_readfirstlane(__hip_atomic_load(ready + 64 * u.pm, __ATOMIC_RELAXED, __HIP_MEMORY_SCOPE_AGENT)) < need) {
                if ((++polls & 255u) == 0u && __builtin_amdgcn_readfirstlane(__hip_atomic_load(tmo, __ATOMIC_RELAXED, __HIP_MEMORY_SCOPE_AGENT)) != 0u) break;
                if (__builtin_amdgcn_s_memrealtime() - t0 > 2000000ull) {
                    if (threadIdx.x == 0) { unsigned expect = 0u; __hip_atomic_compare_exchange_strong(tmo + 1, &expect, 0x600u | (unsigned)(u.pm & 0xff), __ATOMIC_RELAXED, __ATOMIC_RELAXED, __HIP_MEMORY_SCOPE_AGENT); __hip_atomic_store(tmo, 1u, __ATOMIC_RELAXED, __HIP_MEMORY_SCOPE_AGENT); }
                    break; }
                __builtin_amdgcn_s_sleep(2); }
            __builtin_amdgcn_fence(__ATOMIC_ACQUIRE, "agent");
            asm volatile("s_waitcnt vmcnt(0)" ::: "memory");
        }
#if !defined(BROKEN_HOOK_NO_BARRIER)
        asm volatile("" ::: "memory"); __builtin_amdgcn_s_barrier(); asm volatile("" ::: "memory");
#endif
    }
};

__device__ __forceinline__ unsigned cvt_pk_bf16(float lo, float hi) { return pk2(lo, hi); }
typedef float f32x2 __attribute__((ext_vector_type(2)));
__device__ __forceinline__ f32x2 gelu_pk(f32x2 v) {
    const f32x2 av = __builtin_elementwise_abs(v), d = av * 0.2316418882f + 1.0f;
    f32x2 t; t.x = __builtin_amdgcn_rcpf(d.x); t.y = __builtin_amdgcn_rcpf(d.y);
    f32x2 q = t * 0.5307027145f + (-0.7265760135f); q = q * t + 0.7107068705f; q = q * t + (-0.142248368f); q = q * t + 0.127414796f; q = q * t;
    const f32x2 s = (v * v) * (-0.72134752044f);
    f32x2 e; e.x = __builtin_amdgcn_exp2f(s.x); e.y = __builtin_amdgcn_exp2f(s.y);
    const f32x2 m = v * (q * e), r = v - m;
    f32x2 o; o.x = v.x < 0.f ? m.x : r.x; o.y = v.y < 0.f ? m.y : r.y; return o;
}


struct EpiF32 {
    static constexpr bool PERM = false, AFTER_DRAIN = false;
    float* C; int ldc;
    __device__ __forceinline__ void operator()(const f32x4 (&acc)[2][2][4][2], const Unit& u, int wr, int wc, int fr, int fq) const {
        const int row0 = u.pm * BM + wr * 64 + fr, col0 = u.pn * BM + wc * 32 + 4 * fq;
#pragma unroll
        for (int ai = 0; ai < 2; ++ai)
#pragma unroll
            for (int m = 0; m < 4; ++m) { float* rowp = C + (size_t)(row0 + ai * HALF + m * 16) * ldc + col0;
#pragma unroll
                for (int bj = 0; bj < 2; ++bj)
#pragma unroll
                    for (int n = 0; n < 2; ++n) *(f32x4*)(rowp + bj * HALF + n * 16) = acc[ai][bj][m][n]; }
    }
};
struct EpiRes {
    static constexpr bool PERM = false, AFTER_DRAIN = false;
    float* X; int ldc; bf16_t* Hn; const float* gn; float* sqp;
    __device__ __forceinline__ void operator()(const f32x4 (&acc)[2][2][4][2], const Unit& u, int wr, int wc, int fr, int fq) const {
        const int row0 = u.pm * BM + wr * 64 + fr, col0 = u.pn * BM + wc * 32 + 4 * fq;
        f32x4 gv[2][2];
#pragma unroll
        for (int bj = 0; bj < 2; ++bj)
#pragma unroll
            for (int n = 0; n < 2; ++n) gv[bj][n] = *(const f32x4*)(gn + col0 + bj * HALF + n * 16);
#pragma unroll
        for (int ai = 0; ai < 2; ++ai) {
            f32x4 old[4][2][2];
#pragma unroll
            for (int m = 0; m < 4; ++m) { const float* rp = X + (size_t)(row0 + ai * HALF + m * 16) * ldc + col0;
#pragma unroll
                for (int bj = 0; bj < 2; ++bj)
#pragma unroll
                    for (int n = 0; n < 2; ++n) old[m][bj][n] = *(const f32x4*)(rp + bj * HALF + n * 16); }
#pragma unroll
            for (int m = 0; m < 4; ++m) { const int r = row0 + ai * HALF + m * 16; float* rowp = X + (size_t)r * ldc + col0; bf16_t* hp = Hn + (size_t)r * ldc + col0;
                float ss = 0.f;
#pragma unroll
                for (int bj = 0; bj < 2; ++bj)
#pragma unroll
                    for (int n = 0; n < 2; ++n) { const f32x4 xn = old[m][bj][n] + acc[ai][bj][m][n]; *(f32x4*)(rowp + bj * HALF + n * 16) = xn;
                        ss += (xn[0] * xn[0] + xn[1] * xn[1]) + (xn[2] * xn[2] + xn[3] * xn[3]);
                        const f32x4 hg = xn * gv[bj][n]; u32x2 hw; hw.x = pk2(hg[0], hg[1]); hw.y = pk2(hg[2], hg[3]); *(u32x2*)(hp + bj * HALF + n * 16) = hw; }
                ss += __shfl_xor(ss, 16); ss += __shfl_xor(ss, 32);
                if (fq == 0) sqp[(size_t)r * 32 + u.pn * 4 + wc] = ss; }
        }
    }
};
struct EpiBf16S {
    static constexpr bool PERM = true, AFTER_DRAIN = false;
    bf16_t* O; int ldc; float scale;
    __device__ __forceinline__ void operator()(const f32x4 (&acc)[2][2][4][2], const Unit& u, int wr, int wc, int fr, int fq) const {
        const int row0 = u.pm * BM + wr * 64 + fr, col0 = u.pn * BM + wc * 32 + 8 * fq;
#pragma unroll
        for (int ai = 0; ai < 2; ++ai)
#pragma unroll
            for (int m = 0; m < 4; ++m) { bf16_t* rowp = O + (size_t)(row0 + ai * HALF + m * 16) * ldc + col0;
#pragma unroll
                for (int bj = 0; bj < 2; ++bj) { const f32x4 v0 = acc[ai][bj][m][0] * scale, v1 = acc[ai][bj][m][1] * scale;
                    u32x4 w; w.x = cvt_pk_bf16(v0[0], v0[1]); w.y = cvt_pk_bf16(v0[2], v0[3]); w.z = cvt_pk_bf16(v1[0], v1[1]); w.w = cvt_pk_bf16(v1[2], v1[3]);
                    *(u32x4*)(rowp + bj * HALF) = w; } }
    }
};
struct EpiProj {
    static constexpr bool PERM = true, AFTER_DRAIN = false;
    bf16_t *Q, *Kp, *V, *G; const float* rot;
    __device__ __forceinline__ void operator()(const f32x4 (&acc)[2][2][4][2], const Unit& u, int wr, int wc, int fr, int fq) const {
        const int row0 = u.pm * BM + wr * 64 + fr, pn = u.pn, dd0 = wc * 32 + 8 * fq;
        if (pn < 16) {
            bf16_t* base = (pn < 8 ? Q : Kp) + (pn & 7) * 256 + dd0; const float sc = pn < 8 ? 1.0f : 0.0625f;
#pragma unroll
            for (int ai = 0; ai < 2; ++ai)
#pragma unroll
                for (int m = 0; m < 4; ++m) { const int r = row0 + ai * HALF + m * 16; const float* rt = rot + (size_t)(r & (4096 - 1)) * 256 + dd0;
                    f32x4 o1[2], o2[2];
#pragma unroll
                    for (int n = 0; n < 2; ++n) { const f32x4 cs = *(const f32x4*)(rt + 4 * n), sn = *(const f32x4*)(rt + 128 + 4 * n); const f32x4 t1 = acc[ai][0][m][n], t2 = acc[ai][1][m][n];
                        o1[n] = (t1 * cs - t2 * sn) * sc; o2[n] = (t1 * sn + t2 * cs) * sc; }
                    u32x4 w1, w2;
                    w1.x = cvt_pk_bf16(o1[0][0], o1[0][1]); w1.y = cvt_pk_bf16(o1[0][2], o1[0][3]); w1.z = cvt_pk_bf16(o1[1][0], o1[1][1]); w1.w = cvt_pk_bf16(o1[1][2], o1[1][3]);
                    w2.x = cvt_pk_bf16(o2[0][0], o2[0][1]); w2.y = cvt_pk_bf16(o2[0][2], o2[0][3]); w2.z = cvt_pk_bf16(o2[1][0], o2[1][1]); w2.w = cvt_pk_bf16(o2[1][2], o2[1][3]);
                    bf16_t* rowp = base + (size_t)r * 2048; *(u32x4*)rowp = w1; *(u32x4*)(rowp + 128) = w2; }
        } else {
            bf16_t* base = (pn < 32 ? V : G) + ((pn - 16) & 15) * 256 + dd0;
#pragma unroll
            for (int ai = 0; ai < 2; ++ai)
#pragma unroll
                for (int m = 0; m < 4; ++m) { bf16_t* rowp = base + (size_t)(row0 + ai * HALF + m * 16) * 4096;
#pragma unroll
                    for (int bj = 0; bj < 2; ++bj) { const f32x4 v0 = acc[ai][bj][m][0], v1 = acc[ai][bj][m][1];
                        u32x4 w; w.x = cvt_pk_bf16(v0[0], v0[1]); w.y = cvt_pk_bf16(v0[2], v0[3]); w.z = cvt_pk_bf16(v1[0], v1[1]); w.w = cvt_pk_bf16(v1[2], v1[3]);
                        *(u32x4*)(rowp + bj * HALF) = w; } }
        }
    }
};
template <class Epi, class Sched, bool STAMP = false>
__device__ __forceinline__ void gemm_phase(PG8_LAS unsigned char* lds, const Gemm g, const Sched& S, const Epi& E, unsigned long long* stamps) {
    int tid_ = threadIdx.x; asm volatile("" : "+v"(tid_));
    const int tid = tid_, wid = __builtin_amdgcn_readfirstlane(tid >> 6), lane = tid & 63, wr = wid >> 2, wc = wid & 3, fr = lane & 15, fq = lane >> 4;
    const int K = g.K, nt = K / BK;
    int ts_lo = 0, ts_hi = 0, nts = 0; const unsigned long long rt_entry = STAMP ? (unsigned long long)wall_clock64() : 0ull;
#define PG8_STAMP() do { if (STAMP && wid == 0 && nts < 64) { const unsigned long long _c = (unsigned long long)clock64(); \
        ts_lo = (lane == nts) ? (int)(unsigned)_c : ts_lo; ts_hi = (lane == nts) ? (int)(unsigned)(_c >> 32) : ts_hi; ++nts; } } while (0)
    PG8_STAMP();
    unsigned voffA[2], voffB[2];
#pragma unroll
    for (int i = 0; i < 2; ++i) { int R, C; stage_rc(tid * 16 + i * 8192, R, C); const int Rb = Epi::PERM ? ((R & ~31) + perm32(R & 31)) : R;
        voffA[i] = (unsigned)(R * K + C) * 2u; voffB[i] = (unsigned)(Rb * K + C) * 2u; }
    const size_t kstep = (size_t)(BK * 2);
    const size_t hstep = (size_t)HALF * K * 2;
    const size_t tstep = 2 * hstep;
    const unsigned ldsw = (unsigned)wid * 1024u;
    const int aoff = lds_byte(wr * 64 + fr, fq * 8), boff = lds_byte(wc * 32 + fr, fq * 8);
#define PG8_SA(b, h) (((b) * 2 + (h)) * HTB)
#define PG8_SB(b, h) ((4 + (b) * 2 + (h)) * HTB)
#define PG8_STAGE(bufoff, gbase, voff) do { _Pragma("unroll") for (int _i = 0; _i < 2; ++_i) \
        __builtin_amdgcn_global_load_lds((const unsigned*)((const char*)(gbase) + (voff)[_i]), (PG8_LAS unsigned*)(lds + (bufoff) + ldsw + _i * 8192), 16, 0, 0); } while (0)
#define PG8_LDA(dst, b, h) do { _Pragma("unroll") for (int m = 0; m < 4; ++m) _Pragma("unroll") for (int k = 0; k < 2; ++k) dst[m][k] = *(const PG8_LAS bf16x8*)(lds + PG8_SA(b, h) + aoff + m * 2048 + k * 1024); } while (0)
#define PG8_LDB(dst, b, h) do { _Pragma("unroll") for (int n = 0; n < 2; ++n) _Pragma("unroll") for (int k = 0; k < 2; ++k) dst[n][k] = *(const PG8_LAS bf16x8*)(lds + PG8_SB(b, h) + boff + n * 2048 + k * 1024); } while (0)
#define PG8_MMA(ai, bj, At, Bt) do { __builtin_amdgcn_s_setprio(1); _Pragma("unroll") for (int m = 0; m < 4; ++m) _Pragma("unroll") for (int n = 0; n < 2; ++n) _Pragma("unroll") for (int k = 0; k < 2; ++k) \
        acc[ai][bj][m][n] = __builtin_amdgcn_mfma_f32_16x16x32_bf16(Bt[n][k], At[m][k], acc[ai][bj][m][n], 0, 0, 0); __builtin_amdgcn_s_setprio(0); } while (0)
#define PG8_WAIT_V(n) asm volatile("s_waitcnt vmcnt(" #n ")" ::: "memory")
#define PG8_WAIT_L(n) asm volatile("s_waitcnt lgkmcnt(" #n ")" ::: "memory")
#define PG8_BAR __builtin_amdgcn_s_barrier()
#define PG8_SCHED __builtin_amdgcn_sched_barrier(0)
    Unit cur, nxt; int ui = 0;
    if (!S.next(0, cur)) return;
    f32x4 acc[2][2][4][2];
#pragma unroll
    for (int a = 0; a < 2; ++a)
#pragma unroll
        for (int b = 0; b < 2; ++b)
#pragma unroll
            for (int m = 0; m < 4; ++m)
#pragma unroll
                for (int n = 0; n < 2; ++n) acc[a][b][m][n] = (f32x4){0.f, 0.f, 0.f, 0.f};
    bf16x8 At[4][2], B0[2][2], B1[2][2];
    const char* cA = (const char*)g.A + (size_t)cur.pm * tstep; const char* cB = (const char*)g.Bt + (size_t)cur.pn * tstep;
    S.a_ready(cur);
    PG8_STAGE(PG8_SB(0, 0), cB, voffB); PG8_STAGE(PG8_SA(0, 0), cA, voffA); PG8_STAGE(PG8_SB(0, 1), cB + hstep, voffB); PG8_STAGE(PG8_SA(0, 1), cA + hstep, voffA);
    if (wr == 1) PG8_BAR;
    PG8_WAIT_V(4); PG8_BAR;
    PG8_STAGE(PG8_SB(1, 0), cB + kstep, voffB); PG8_STAGE(PG8_SA(1, 0), cA + kstep, voffA); PG8_STAGE(PG8_SB(1, 1), cB + hstep + kstep, voffB);
    PG8_WAIT_V(6); PG8_BAR;
    PG8_STAMP();
    for (;;) {
        const bool has_next = S.next(ui + 1, nxt);
        const char* nA = has_next ? (const char*)g.A + (size_t)nxt.pm * tstep : cA; const char* nB = has_next ? (const char*)g.Bt + (size_t)nxt.pn * tstep : cB;
        for (int t = 0; t < nt; t += 2) {
            const bool last = (t == nt - 2);
            const char* a1 = cA + (size_t)(t + 1) * kstep;
            const char* a2 = last ? nA : cA + (size_t)(t + 2) * kstep; const char* b2 = last ? nB : cB + (size_t)(t + 2) * kstep;
            const char* a3 = a2 + kstep; const char* b3 = b2 + kstep;
            if (last && has_next) S.a_ready(nxt);
            PG8_LDB(B0, 0, 0); PG8_SCHED; PG8_LDA(At, 0, 0); PG8_STAGE(PG8_SA(1, 1), a1 + hstep, voffA);
            PG8_WAIT_L(8); PG8_BAR; PG8_WAIT_L(0); PG8_MMA(0, 0, At, B0); PG8_BAR; PG8_SCHED;
            PG8_LDB(B1, 0, 1); PG8_STAGE(PG8_SB(0, 0), b2, voffB);
            PG8_BAR; PG8_WAIT_L(0); PG8_MMA(0, 1, At, B1); PG8_BAR;
            PG8_LDA(At, 0, 1); PG8_STAGE(PG8_SA(0, 0), a2, voffA);
            PG8_BAR; PG8_WAIT_L(0); PG8_MMA(1, 0, At, B0); PG8_BAR; PG8_SCHED;
            PG8_STAGE(PG8_SB(0, 1), b2 + hstep, voffB);
            PG8_WAIT_V(6); PG8_BAR; PG8_MMA(1, 1, At, B1); PG8_BAR;
            PG8_LDB(B0, 1, 0); PG8_SCHED; PG8_LDA(At, 1, 0); PG8_STAGE(PG8_SA(0, 1), a2 + hstep, voffA);
            PG8_WAIT_L(8); PG8_BAR; PG8_WAIT_L(0); PG8_MMA(0, 0, At, B0); PG8_BAR; PG8_SCHED;
            PG8_LDB(B1, 1, 1); PG8_STAGE(PG8_SB(1, 0), b3, voffB);
            PG8_BAR; PG8_WAIT_L(0); PG8_MMA(0, 1, At, B1); PG8_BAR;
            PG8_LDA(At, 1, 1); PG8_STAGE(PG8_SA(1, 0), a3, voffA);
            PG8_BAR; PG8_WAIT_L(0); PG8_MMA(1, 0, At, B0); PG8_BAR; PG8_SCHED;
            PG8_STAGE(PG8_SB(1, 1), b3 + hstep, voffB);
            PG8_WAIT_V(6); PG8_BAR; PG8_MMA(1, 1, At, B1); PG8_BAR;
        }
        PG8_STAMP();
        if constexpr (!Epi::AFTER_DRAIN) { E(acc, cur, wr, wc, fr, fq); S.done(cur); }
        PG8_STAMP();
        if (!has_next) break;
#pragma unroll
        for (int a = 0; a < 2; ++a)
#pragma unroll
            for (int b = 0; b < 2; ++b)
#pragma unroll
                for (int m = 0; m < 4; ++m)
#pragma unroll
                    for (int n = 0; n < 2; ++n) acc[a][b][m][n] = (f32x4){0.f, 0.f, 0.f, 0.f};
        cur = nxt; cA = nA; cB = nB; ++ui;
    }
    PG8_WAIT_V(0);
    if (wr == 0) PG8_BAR;
    PG8_BAR;
    if constexpr (Epi::AFTER_DRAIN) { E.fused(acc, cur, wr, wc, fr, fq, lds, wid, lane); S.done(cur); }
    PG8_STAMP();
    if (STAMP && wid == 0) { stamps[lane] = lane < nts ? (((unsigned long long)(unsigned)ts_hi << 32) | (unsigned)ts_lo) : 0ull;
        if (lane == 62) stamps[62] = rt_entry; if (lane == 63) stamps[63] = (unsigned long long)wall_clock64(); }
#undef PG8_STAMP
#undef PG8_SA
#undef PG8_SB
#undef PG8_STAGE
#undef PG8_LDA
#undef PG8_LDB
#undef PG8_MMA
#undef PG8_WAIT_V
#undef PG8_WAIT_L
#undef PG8_BAR
#undef PG8_SCHED
}
}

using pg8::bf16x8; using pg8::f32x4; using pg8::u32x4;
typedef short s16x4 __attribute__((ext_vector_type(4)));
typedef __bf16 bfx2 __attribute__((ext_vector_type(2)));

struct Params {
    const float *x, *ln_mix, *ln_ffn, *ret_w_in, *ret_w_out, *ret_gn, *kv_norm, *w_kv, *att_w_q, *att_w_o, *att_rel_bias, *peer_w_q, *peer_sub_keys, *peer_u, *peer_v, *ln_final;
    float* out; unsigned char* ws; int lo, hi;
};
struct Ctx { LAS unsigned char* lds; int tid, lane, wave, bx, G, gw, ngw; };

__device__ __forceinline__ float dot2bf(unsigned a, unsigned b, float c) { return __builtin_amdgcn_fdot2_f32_bf16(__builtin_bit_cast(bfx2, a), __builtin_bit_cast(bfx2, b), c, false); }
__device__ __forceinline__ bf16x8 lds128(LAS const unsigned char* p) { return *(LAS const bf16x8*)p; }
__device__ __forceinline__ bf16x8 tr_frag(unsigned a0, unsigned a1) {
    s16x4 lo, hi;
    asm volatile("ds_read_b64_tr_b16 %0, %2\n\tds_read_b64_tr_b16 %1, %3\n\ts_waitcnt lgkmcnt(0)" : "=&v"(lo), "=&v"(hi) : "v"(a0), "v"(a1) : "memory");
    bf16x8 r; r[0] = lo[0]; r[1] = lo[1]; r[2] = lo[2]; r[3] = lo[3]; r[4] = hi[0]; r[5] = hi[1]; r[6] = hi[2]; r[7] = hi[3]; return r;
}
#define MFMA16(a, b, c) __builtin_amdgcn_mfma_f32_16x16x32_bf16((a), (b), (c), 0, 0, 0)

__device__ __forceinline__ void load_row(const float* xrow, int lane, f32x4 (&v)[8]) {
    const f32x4* xr = (const f32x4*)xrow + lane;
#pragma unroll
    for (int j = 0; j < 8; ++j) v[j] = xr[64 * j];
}
__device__ __forceinline__ float row_rstd(const f32x4 (&v)[8]) {
    float s = 0.f;
#pragma unroll
    for (int j = 0; j < 8; ++j) s += (v[j][0] * v[j][0] + v[j][1] * v[j][1]) + (v[j][2] * v[j][2] + v[j][3] * v[j][3]);
    return 1.0f / sqrtf(wave_sum(s) * (1.0f / DM) + EPS);
}
__device__ __forceinline__ void store_norm_bf16(const f32x4 (&v)[8], float rstd, const float* g, bf16* orow, int lane) {
    const f32x4* gr = (const f32x4*)g + lane; u32x2* o8 = (u32x2*)orow + lane;
#pragma unroll
    for (int j = 0; j < 8; ++j) { const f32x4 gv = gr[64 * j]; u32x2 w; w.x = pk2(v[j][0] * rstd * gv[0], v[j][1] * rstd * gv[1]); w.y = pk2(v[j][2] * rstd * gv[2], v[j][3] * rstd * gv[3]); o8[64 * j] = w; }
}
__device__ __forceinline__ void load_g(const float* g, int lane, f32x4 (&gv)[8]) {
    const f32x4* gr = (const f32x4*)g + lane;
#pragma unroll
    for (int j = 0; j < 8; ++j) gv[j] = gr[64 * j];
}
__device__ __forceinline__ void store_norm_bf16_r(const f32x4 (&v)[8], float rstd, const f32x4 (&gv)[8], bf16* orow, int lane) {
    u32x2* o8 = (u32x2*)orow + lane;
#pragma unroll
    for (int j = 0; j < 8; ++j) { u32x2 w; w.x = pk2(v[j][0] * rstd * gv[j][0], v[j][1] * rstd * gv[j][1]); w.y = pk2(v[j][2] * rstd * gv[j][2], v[j][3] * rstd * gv[j][3]); o8[64 * j] = w; }
}
__device__ __forceinline__ unsigned q8pack(float a, float b, float c, float d) {
    const unsigned ua = __builtin_bit_cast(unsigned, a + 12582912.0f), ub = __builtin_bit_cast(unsigned, b + 12582912.0f), uc = __builtin_bit_cast(unsigned, c + 12582912.0f), ud = __builtin_bit_cast(unsigned, d + 12582912.0f);
    return (ua & 255u) | ((ub & 255u) << 8) | ((uc & 255u) << 16) | (ud << 24);
}

__device__ __forceinline__ void p0_transpose_item(const float* W, int K, int N, bf16* WT, LAS float* scr, int item, int lane) {
    const int nblk = N / 32, kb = item / nblk, nb = item % nblk, k0 = 64 * kb, n0 = 32 * nb;
    float tv[32];
#pragma unroll
    for (int i = 0; i < 32; ++i) { const int kk = 2 * i + (lane >> 5); tv[i] = W[(size_t)(k0 + kk) * N + n0 + (lane & 31)]; }
#pragma unroll
    for (int i = 0; i < 32; ++i) { const int kk = 2 * i + (lane >> 5); scr[kk * 33 + (lane & 31)] = tv[i]; }
    LDS_WAIT(); asm volatile("" ::: "memory");
    const int c = lane & 7;
#pragma unroll
    for (int j = 0; j < 4; ++j) { const int n = (lane >> 3) + 8 * j; const LAS float* s = scr + (8 * c) * 33 + n;
        u32x4 o; o.x = pk2(s[0 * 33], s[1 * 33]); o.y = pk2(s[2 * 33], s[3 * 33]); o.z = pk2(s[4 * 33], s[5 * 33]); o.w = pk2(s[6 * 33], s[7 * 33]);
        *(u32x4*)(WT + (size_t)(n0 + n) * K + k0 + 8 * c) = o; }
    LDS_WAIT(); asm volatile("" ::: "memory");
}
__device__ __forceinline__ void p0_fold_tile(const Params& p, const Ctx& c, int tl) {
    const int l = tl >> 9, hp = (tl >> 5) & 15, j0 = (tl & 31) * 64;
    LAS float* As = (LAS float*)c.lds;
    LAS float* Bs = (LAS float*)c.lds + 64 * 132;
    const float* Wq = p.peer_w_q + (size_t)l * DM * DM; const float* sk = p.peer_sub_keys + ((size_t)l * 2 + (hp & 1)) * PNK * 128;
    __syncthreads();
    for (int i = c.tid; i < 64 * 32; i += 512) { const int jj = i >> 5, d4 = i & 31; *(LAS f32x4*)(As + jj * 132 + d4 * 4) = *(const f32x4*)(Wq + (size_t)(j0 + jj) * DM + hp * 128 + d4 * 4); }
    for (int i = c.tid; i < 128 * 32; i += 512) { const int k = i >> 5, d4 = i & 31; *(LAS f32x4*)(Bs + k * 132 + d4 * 4) = *(const f32x4*)(sk + (size_t)k * 128 + d4 * 4); }
    __syncthreads();
    const int tj = c.tid & 15, tk = c.tid >> 4;
    float acc[4][4];
#pragma unroll
    for (int b = 0; b < 4; ++b)
#pragma unroll
        for (int a = 0; a < 4; ++a) acc[b][a] = 0.f;
    for (int d4 = 0; d4 < 32; ++d4) {
        f32x4 av[4], bv[4];
#pragma unroll
        for (int a = 0; a < 4; ++a) av[a] = *(LAS const f32x4*)(As + (tj + 16 * a) * 132 + d4 * 4);
#pragma unroll
        for (int b = 0; b < 4; ++b) bv[b] = *(LAS const f32x4*)(Bs + (tk * 4 + b) * 132 + d4 * 4);
#pragma unroll
        for (int b = 0; b < 4; ++b)
#pragma unroll
            for (int a = 0; a < 4; ++a) acc[b][a] += (av[a][0] * bv[b][0] + av[a][1] * bv[b][1]) + (av[a][2] * bv[b][2] + av[a][3] * bv[b][3]);
    }
    bf16* WcT = (bf16*)(p.ws + WS_WC) + (size_t)l * DM * DM;
#pragma unroll
    for (int b = 0; b < 4; ++b)
#pragma unroll
        for (int a = 0; a < 4; ++a) WcT[(size_t)(hp * 128 + tk * 4 + b) * DM + j0 + tj + 16 * a] = (bf16)f2bf(acc[b][a]);
}
__device__ __forceinline__ void p0_prologue(const Params& p, const Ctx& c) {
#ifndef PROREP
#define PROREP 0
#endif
    const bool fold_last = (c.bx & 1) != 0;
    if (!fold_last) {
    for (int tl = c.bx; tl < DEPTH * 16 * 32; tl += c.G) p0_fold_tile(p, c, tl);
    __syncthreads();
    }
    for (int rp_ = ((PROREP >> 1) & 1) ? 0 : 1; rp_ < 2; ++rp_)
    {
        LAS float* scr = (LAS float*)(c.lds + c.wave * 16384);
        constexpr int I_IN = (DM / 64) * (RIN / 32), I_OUT = (RVW / 64) * (DM / 32), I_KV = (DM / 64) * (2 * DM / 32), I_SQ = (DM / 64) * (DM / 32);
        constexpr int NITEMS = 2 * I_IN + 2 * I_OUT + I_KV + 4 * I_SQ;
        for (int it = c.gw; it < NITEMS; it += c.ngw) {
            int r = it;
            if (r < 2 * I_IN) { const int l = r / I_IN; p0_transpose_item(p.ret_w_in + (size_t)l * DM * RIN, DM, RIN, (bf16*)(p.ws + WS_WIN) + (size_t)l * RIN * DM, scr, r % I_IN, c.lane); continue; } r -= 2 * I_IN;
            if (r < 2 * I_OUT) { const int l = r / I_OUT; p0_transpose_item(p.ret_w_out + (size_t)l * RVW * DM, RVW, DM, (bf16*)(p.ws + WS_WOUT) + (size_t)l * DM * RVW, scr, r % I_OUT, c.lane); continue; } r -= 2 * I_OUT;
            if (r < I_KV) { p0_transpose_item(p.w_kv, DM, 2 * DM, (bf16*)(p.ws + WS_WKV), scr, r, c.lane); continue; } r -= I_KV;
            if (r < 2 * I_SQ) { const int l = r / I_SQ; p0_transpose_item(p.att_w_q + (size_t)l * DM * DM, DM, DM, (bf16*)(p.ws + WS_WQ) + (size_t)l * DM * DM, scr, r % I_SQ, c.lane); continue; } r -= 2 * I_SQ;
            { const int l = r / I_SQ; p0_transpose_item(p.att_w_o + (size_t)l * DM * DM, DM, DM, (bf16*)(p.ws + WS_WO) + (size_t)l * DM * DM, scr, r % I_SQ, c.lane); }
        }
    }
    for (int rp_ = ((PROREP >> 2) & 1) ? 0 : 1; rp_ < 2; ++rp_)
    {
        float* rs = (float*)(p.ws + WS_RS);
        for (int row = c.gw; row < 2 * DEPTH * PE; row += c.ngw) {
            const int which = row >= DEPTH * PE, r = row - which * DEPTH * PE;
            f32x4 v[8]; load_row((which ? p.peer_v : p.peer_u) + (size_t)r * DM, c.lane, v);
            float am = 0.f;
#pragma unroll
            for (int j = 0; j < 8; ++j) am = fmaxf(fmaxf(am, fmaxf(fabsf(v[j][0]), fabsf(v[j][1]))), fmaxf(fabsf(v[j][2]), fabsf(v[j][3])));
#pragma unroll
            for (int o = 1; o < 64; o <<= 1) am = fmaxf(am, __shfl_xor(am, o));
            int e = (int)((__builtin_bit_cast(unsigned, am) >> 23) & 0xffu) - 127; if (am == 0.f) e = 7;
            int k = 7 - e; k = k < -100 ? -100 : (k > 100 ? 100 : k);
            const float sc = __builtin_bit_cast(float, (unsigned)(k + 127) << 23), rsc = __builtin_bit_cast(float, (unsigned)(127 - k) << 23);
            const int lyr = r / PE, re = r % PE;
            unsigned char* dstb = p.ws + (which ? WS_PV : WS_PU) + (size_t)lyr * PE * DM + (size_t)re * 128;
            if (which) {
#pragma unroll
                for (int j = 0; j < 8; ++j) { int w = 0; w = __builtin_amdgcn_cvt_pk_fp8_f32(v[j][0] * sc, v[j][1] * sc, w, false); w = __builtin_amdgcn_cvt_pk_fp8_f32(v[j][2] * sc, v[j][3] * sc, w, true); { const int col = 4 * c.lane + 256 * j; *(unsigned*)(dstb + (size_t)(col >> 7) * PE * 128 + (col & 127)) = (unsigned)w; } }
                if (c.lane == 0) rs[row] = rsc;
            } else {
                const float s8 = am > 0.f ? 127.0f / am : 0.f;
#pragma unroll
                for (int j = 0; j < 8; ++j) { const unsigned w = q8pack(v[j][0] * s8, v[j][1] * s8, v[j][2] * s8, v[j][3] * s8); const int col = 4 * c.lane + 256 * j; *(unsigned*)(dstb + (size_t)(col >> 7) * PE * 128 + (col & 127)) = w; }
                if (c.lane == 0) rs[row] = am * (1.0f / 127.0f);
            }
        }
    }
    for (int rp_ = ((PROREP >> 3) & 1) ? 0 : 1; rp_ < 2; ++rp_)
    {
        float* rot = (float*)(p.ws + WS_ROT);
        for (int i = c.bx * 512 + c.tid; i < SEQ * 128; i += c.G * 512) { const int pos = i >> 7, d = i & 127;
            const float inv = (float)(1.0 / pow(10000.0, (double)d / 128.0)); const float ang = (float)pos * inv;
            rot[(size_t)pos * 256 + d] = (float)cos((double)ang); rot[(size_t)pos * 256 + 128 + d] = (float)sin((double)ang); }
    }
    for (int rp_ = ((PROREP >> 4) & 1) ? 0 : 1; rp_ < 2; ++rp_)
    { f32x4 gv[8]; load_g(p.ln_mix, c.lane, gv);
      for (int m = c.gw; m < NTOK; m += c.ngw) {
        f32x4 v[8]; load_row(p.x + (size_t)m * DM, c.lane, v);
        f32x4* xo = (f32x4*)(p.out + (size_t)m * DM) + c.lane;
#pragma unroll
        for (int j = 0; j < 8; ++j) xo[64 * j] = v[j];
        store_norm_bf16_r(v, row_rstd(v), gv, (bf16*)(p.ws + WS_H) + (size_t)m * DM, c.lane);
      } }
    if (fold_last) {
    __syncthreads();
    for (int tl = c.bx; tl < DEPTH * 16 * 32; tl += c.G) p0_fold_tile(p, c, tl);
    __syncthreads();
    }
}

constexpr int RS_QS = 0, RS_KS = 33792, RS_VS = 67584, RS_VZ = 76800, RS_PS = 86016, RS_RS = 95232, RS_END = 129024, QK_STR = 528, V_STR = 144;
__device__ __forceinline__ void ret_scan_unit(const Ctx& c, const bf16* Qg, const bf16* Kg, const bf16* Vg, bf16* Og, int unit) {
    const int xg = unit & 7, slot = unit >> 3, pair = xg * 4 + (slot >> 3), es = slot & 7, b = pair >> 3, h = pair & 7;
    const int tid = c.tid, lane = c.lane, w = c.wave, fr = lane & 15, fq = lane >> 4, tq = (lane & 15) >> 2, tp = lane & 3;
    LAS unsigned char* lds = c.lds;
    const float lgam = log1pf(-exp2f(-5.0f - (float)h));
    const float cdec = expf(lgam * 64.0f);
    const int lrow = tid >> 3, lch = tid & 7;
    const size_t tok0 = (size_t)b * SEQ;
    const bf16* qrow = Qg + (tok0 + lrow) * RQKW + h * RQK + lch * 8;
    const bf16* krow = Kg + (tok0 + lrow) * RQKW + h * RQK + lch * 8;
    const bf16* vrow = Vg + (tok0 + lrow) * RVW + h * RV + es * 64 + lch * 8;
    const float zeta = expf(lgam * (float)(63 - lrow));
    u32x4 pq[4], pk[4], pv;
#pragma unroll
    for (int cc = 0; cc < 4; ++cc) { pq[cc] = *(const u32x4*)(qrow + cc * 64); pk[cc] = *(const u32x4*)(krow + cc * 64); }
    pv = *(const u32x4*)vrow;
    __syncthreads();
    for (int i = tid; i < (RS_END - RS_RS) / 16; i += 512) *(LAS u32x4*)(lds + RS_RS + i * 16) = (u32x4){0u, 0u, 0u, 0u};
    f32x4 Racc[2][4];
#pragma unroll
    for (int x = 0; x < 2; ++x)
#pragma unroll
        for (int y = 0; y < 4; ++y) Racc[x][y] = (f32x4){0.f, 0.f, 0.f, 0.f};
    const int jt = w & 3, it0 = 2 * (w >> 2);
    const int it = w & 3, et0 = 2 * (w >> 2);
    float xi[4];
#pragma unroll
    for (int r = 0; r < 4; ++r) xi[r] = expf(lgam * (float)(16 * it + 4 * fq + r + 1));
    const unsigned ldsb = (unsigned)(size_t)lds;
    float dmask[2][4];
#pragma unroll
    for (int x = 0; x < 2; ++x)
#pragma unroll
        for (int r = 0; r < 4; ++r) { const int i = 16 * (it0 + x) + fr, j = 16 * jt + 4 * fq + r; dmask[x][r] = (i >= j) ? expf(lgam * (float)(i - j)) : 0.f; }
    asm volatile("" : "+v"(dmask[0][0]), "+v"(dmask[0][1]), "+v"(dmask[0][2]), "+v"(dmask[0][3]), "+v"(dmask[1][0]), "+v"(dmask[1][1]), "+v"(dmask[1][2]), "+v"(dmask[1][3]));
    for (int n = 0; n < NCHUNK; ++n) {
        __syncthreads();
#pragma unroll
        for (int cc = 0; cc < 4; ++cc) { *(LAS u32x4*)(lds + RS_QS + lrow * QK_STR + (lch + 8 * cc) * 16) = pq[cc]; *(LAS u32x4*)(lds + RS_KS + lrow * QK_STR + (lch + 8 * cc) * 16) = pk[cc]; }
        *(LAS u32x4*)(lds + RS_VS + lrow * V_STR + lch * 16) = pv;
        { u32x4 z; z.x = pk2(bflo(pv.x) * zeta, bfhi(pv.x) * zeta); z.y = pk2(bflo(pv.y) * zeta, bfhi(pv.y) * zeta); z.z = pk2(bflo(pv.z) * zeta, bfhi(pv.z) * zeta); z.w = pk2(bflo(pv.w) * zeta, bfhi(pv.w) * zeta);
          *(LAS u32x4*)(lds + RS_VZ + lrow * V_STR + lch * 16) = z; }
        __syncthreads();
        if (n + 1 < NCHUNK) {
            const size_t adv = (size_t)(n + 1) * CHUNK;
#pragma unroll
            for (int cc = 0; cc < 4; ++cc) { pq[cc] = *(const u32x4*)(qrow + adv * RQKW + cc * 64); pk[cc] = *(const u32x4*)(krow + adv * RQKW + cc * 64); }
            pv = *(const u32x4*)(vrow + adv * RVW);
        }
        {
            f32x4 s0 = (f32x4){0.f, 0.f, 0.f, 0.f}, s1 = s0;
#pragma unroll
            for (int kh = 0; kh < 2; ++kh) {
                bf16x8 fa[4], fb0[4], fb1[4];
#pragma unroll
                for (int k4 = 0; k4 < 4; ++k4) { const int ks = 4 * kh + k4;
                    fa[k4] = lds128(lds + RS_KS + (16 * jt + fr) * QK_STR + (4 * ks + fq) * 16);
                    fb0[k4] = lds128(lds + RS_QS + (16 * it0 + fr) * QK_STR + (4 * ks + fq) * 16);
                    fb1[k4] = lds128(lds + RS_QS + (16 * (it0 + 1) + fr) * QK_STR + (4 * ks + fq) * 16); }
                __builtin_amdgcn_sched_barrier(0);
#pragma unroll
                for (int k4 = 0; k4 < 4; ++k4) { s0 = MFMA16(fa[k4], fb0[k4], s0); s1 = MFMA16(fa[k4], fb1[k4], s1); }
            }
#pragma unroll
            for (int x = 0; x < 2; ++x) { const f32x4 s = x ? s1 : s0; const int i = 16 * (it0 + x) + fr; float pr[4];
#pragma unroll
                for (int r = 0; r < 4; ++r) pr[r] = s[r] * dmask[x][r];
                u32x2 pw; pw.x = pk2(pr[0], pr[1]); pw.y = pk2(pr[2], pr[3]);
                *(LAS u32x2*)(lds + RS_PS + i * V_STR + (16 * jt + 4 * fq) * 2) = pw; }
        }
        f32x4 o0 = (f32x4){0.f, 0.f, 0.f, 0.f}, o1 = o0;
        {
#pragma unroll
            for (int kh = 0; kh < 2; ++kh) {
                bf16x8 fa[4], fb0[4], fb1[4];
#pragma unroll
                for (int k4 = 0; k4 < 4; ++k4) { const int ks = 4 * kh + k4;
                    fa[k4] = lds128(lds + RS_QS + (16 * it + fr) * QK_STR + (4 * ks + fq) * 16);
                    fb0[k4] = lds128(lds + RS_RS + (16 * et0 + fr) * QK_STR + (4 * ks + fq) * 16);
                    fb1[k4] = lds128(lds + RS_RS + (16 * (et0 + 1) + fr) * QK_STR + (4 * ks + fq) * 16); }
                __builtin_amdgcn_sched_barrier(0);
#pragma unroll
                for (int k4 = 0; k4 < 4; ++k4) { o0 = MFMA16(fa[k4], fb0[k4], o0); o1 = MFMA16(fa[k4], fb1[k4], o1); }
            }
        }
#pragma unroll
        for (int r = 0; r < 4; ++r) { o0[r] *= xi[r]; o1[r] *= xi[r]; }
        __syncthreads();
#pragma unroll
        for (int ks = 0; ks < 2; ++ks) {
            const bf16x8 a = lds128(lds + RS_PS + (16 * it + fr) * V_STR + (4 * ks + fq) * 16);
            const unsigned va = ldsb + RS_VS + (32 * ks + 8 * fq + tq) * V_STR + 8 * tp;
            const bf16x8 b0 = tr_frag(va + 32 * et0, va + 4 * V_STR + 32 * et0);
            const bf16x8 b1 = tr_frag(va + 32 * (et0 + 1), va + 4 * V_STR + 32 * (et0 + 1));
            __builtin_amdgcn_sched_barrier(0);
            o0 = MFMA16(a, b0, o0); o1 = MFMA16(a, b1, o1);
        }
        {
            bf16* op = Og + (tok0 + (size_t)n * CHUNK + 16 * it + 4 * fq) * RVW + h * RV + es * 64 + 16 * et0 + fr;
#pragma unroll
            for (int r = 0; r < 4; ++r) { op[(size_t)r * RVW] = (bf16)f2bf(o0[r]); op[(size_t)r * RVW + 16] = (bf16)f2bf(o1[r]); }
        }
#pragma unroll
        for (int x = 0; x < 2; ++x)
#pragma unroll
            for (int y = 0; y < 4; ++y) Racc[x][y] *= cdec;
#pragma unroll
        for (int ks = 0; ks < 2; ++ks) {
            const unsigned ka = ldsb + RS_KS + (32 * ks + 8 * fq + tq) * QK_STR + 8 * tp;
            const unsigned za = ldsb + RS_VZ + (32 * ks + 8 * fq + tq) * V_STR + 8 * tp;
            bf16x8 ak[2], bz[4];
#pragma unroll
            for (int x = 0; x < 2; ++x) ak[x] = tr_frag(ka + 32 * (2 * w + x), ka + 4 * QK_STR + 32 * (2 * w + x));
#pragma unroll
            for (int y = 0; y < 4; ++y) bz[y] = tr_frag(za + 32 * y, za + 4 * V_STR + 32 * y);
            __builtin_amdgcn_sched_barrier(0);
#pragma unroll
            for (int x = 0; x < 2; ++x)
#pragma unroll
                for (int y = 0; y < 4; ++y) Racc[x][y] = MFMA16(ak[x], bz[y], Racc[x][y]);
        }
#pragma unroll
        for (int x = 0; x < 2; ++x)
#pragma unroll
            for (int y = 0; y < 4; ++y) { u32x2 rw; rw.x = pk2(Racc[x][y][0], Racc[x][y][1]); rw.y = pk2(Racc[x][y][2], Racc[x][y][3]);
                *(LAS u32x2*)(lds + RS_RS + (16 * y + fr) * QK_STR + (16 * (2 * w + x) + 4 * fq) * 2) = rw; }
    }
}

template <int CTRL> __device__ __forceinline__ float dpp_f(float x) { return __builtin_bit_cast(float, __builtin_amdgcn_mov_dpp(__builtin_bit_cast(int, x), CTRL, 0xF, 0xF, true)); }
__device__ __forceinline__ float sum8(float x) { x += dpp_f<0xB1>(x); x += dpp_f<0x4E>(x); x += dpp_f<0x141>(x); return x; }
__device__ __forceinline__ void ret_gate_phase(const Ctx& c, const bf16* Og, bf16* Gg, const float* gn, bf16* Zout = nullptr) {
    const int col0 = 512 * (c.lane >> 3) + 8 * (c.lane & 7);
    f32x4 gw[16];
#pragma unroll
    for (int j = 0; j < 8; ++j) { gw[2 * j] = *(const f32x4*)(gn + col0 + 64 * j); gw[2 * j + 1] = *(const f32x4*)(gn + col0 + 64 * j + 4); }
    u32x4 ovn[8];
    if (c.gw < NTOK) { const bf16* orow = Og + (size_t)c.gw * RVW + col0;
#pragma unroll
        for (int j = 0; j < 8; ++j) ovn[j] = *(const u32x4*)(orow + 64 * j); }
    for (int m = c.gw; m < NTOK; m += c.ngw) {
        u32x4 gv[8], ov[8];
        { const bf16* grow = Gg + (size_t)m * RVW + col0;
#pragma unroll
          for (int j = 0; j < 8; ++j) { gv[j] = *(const u32x4*)(grow + 64 * j); ov[j] = ovn[j]; } }
        { const int mn = m + c.ngw < NTOK ? m + c.ngw : m; const bf16* orow = Og + (size_t)mn * RVW + col0;
#pragma unroll
          for (int j = 0; j < 8; ++j) ovn[j] = *(const u32x4*)(orow + 64 * j); }
        float s1 = 0.f;
#pragma unroll
        for (int j = 0; j < 8; ++j) { const u32x4 t = ov[j];
            s1 += ((bflo(t.x) + bfhi(t.x)) + (bflo(t.y) + bfhi(t.y))) + ((bflo(t.z) + bfhi(t.z)) + (bflo(t.w) + bfhi(t.w))); }
        const float mu = sum8(s1) * (1.0f / RV);
        asm volatile("" : "+v"(ov[0]), "+v"(ov[1]), "+v"(ov[2]), "+v"(ov[3]), "+v"(ov[4]), "+v"(ov[5]), "+v"(ov[6]), "+v"(ov[7]));
        float s2 = 0.f;
#pragma unroll
        for (int j = 0; j < 8; ++j) { const u32x4 t = ov[j];
            const float d[8] = {bflo(t.x) - mu, bfhi(t.x) - mu, bflo(t.y) - mu, bfhi(t.y) - mu, bflo(t.z) - mu, bfhi(t.z) - mu, bflo(t.w) - mu, bfhi(t.w) - mu};
            float q = 0.f;
#pragma unroll
            for (int k = 0; k < 8; ++k) q += d[k] * d[k];
            s2 += q; }
        const float rstd = 1.0f / sqrtf(sum8(s2) * (1.0f / RV) + EPS);
        asm volatile("" : "+v"(ov[0]), "+v"(ov[1]), "+v"(ov[2]), "+v"(ov[3]), "+v"(ov[4]), "+v"(ov[5]), "+v"(ov[6]), "+v"(ov[7]));
        bf16* zrow = (Zout ? Zout : Gg) + (size_t)m * RVW + col0;
#pragma unroll
        for (int j = 0; j < 8; ++j) {
            const float gg[8] = {gw[2 * j][0], gw[2 * j][1], gw[2 * j][2], gw[2 * j][3], gw[2 * j + 1][0], gw[2 * j + 1][1], gw[2 * j + 1][2], gw[2 * j + 1][3]};
            const u32x4 t = gv[j], u = ov[j];
            const float g[8] = {bflo(t.x), bfhi(t.x), bflo(t.y), bfhi(t.y), bflo(t.z), bfhi(t.z), bflo(t.w), bfhi(t.w)};
            const float o[8] = {bflo(u.x), bfhi(u.x), bflo(u.y), bfhi(u.y), bflo(u.z), bfhi(u.z), bflo(u.w), bfhi(u.w)};
            float z[8];
#pragma unroll
            for (int k = 0; k < 8; ++k) { const float y = (o[k] - mu) * rstd * gg[k]; z[k] = g[k] * __builtin_amdgcn_rcpf(1.0f + __builtin_amdgcn_exp2f(-1.4426950408889634f * g[k])) * y; }
            u32x4 zw; zw.x = pk2(z[0], z[1]); zw.y = pk2(z[2], z[3]); zw.z = pk2(z[4], z[5]); zw.w = pk2(z[6], z[7]);
            *(u32x4*)(zrow + 64 * j) = zw;
        }
    }
}

__device__ __forceinline__ void rms_phase(const Ctx& c, const float* X, const float* g, bf16* H) {
    for (int m = c.gw; m < NTOK; m += c.ngw) { f32x4 v[8]; load_row(X + (size_t)m * DM, c.lane, v); store_norm_bf16(v, row_rstd(v), g, H + (size_t)m * DM, c.lane); }
}

__device__ __forceinline__ int fkey(float f) { const int i = __builtin_bit_cast(int, f); return i ^ ((i >> 31) & 0x7fffffff); }
__device__ __forceinline__ float kval(int k) { return __builtin_bit_cast(float, k ^ ((k >> 31) & 0x7fffffff)); }
__device__ __forceinline__ int med3i(int a, int b, int c) { int r; asm("v_med3_i32 %0, %1, %2, %3" : "=v"(r) : "v"(a), "v"(b), "v"(c)); return r; }
#define INS16(L, key) do { const int _k = (key); _Pragma("unroll") for (int _q = 15; _q >= 1; --_q) L[_q] = med3i(L[_q - 1], L[_q], _k); L[0] = max(L[0], _k); } while (0)
constexpr int TK_LIST = 544, TK_HALF = 272, TK_KEYS = 256 * TK_LIST;
__device__ __forceinline__ void peer_topk_phase(const Ctx& c, const float* SC, int* IDX, float* WGT, const float* SQP, float* RSTD) {
    LAS unsigned char* lds = c.lds;
    u32x4 pre[16];
    if (c.bx < NTOK / 16) { const u32x4* src = (const u32x4*)(SC + (size_t)c.bx * 16 * DM);
#pragma unroll
        for (int i = 0; i < 16; ++i) pre[i] = src[c.tid + 512 * i]; }
    for (int tile = c.bx; tile < NTOK / 16; tile += c.G) {
        __syncthreads();
#pragma unroll
        for (int i = 0; i < 16; ++i) { const int g = c.tid + 512 * i; *(LAS u32x4*)(lds + (g >> 5) * TK_LIST + ((g >> 4) & 1) * TK_HALF + (g & 15) * 16) = pre[i]; }
        if (tile + c.G < NTOK / 16) { const u32x4* src = (const u32x4*)(SC + (size_t)(tile + c.G) * 16 * DM);
#pragma unroll
            for (int i = 0; i < 16; ++i) pre[i] = src[c.tid + 512 * i]; }
        __syncthreads();
        {
            const int lst = c.tid >> 1, hf = c.tid & 1;
            int L[16];
#pragma unroll
            for (int q = 0; q < 16; ++q) L[q] = (int)0x80000000;
            LAS unsigned char* lp = lds + lst * TK_LIST + hf * TK_HALF;
#pragma unroll 2
            for (int g = 0; g < 16; ++g) { const f32x4 v = *(LAS const f32x4*)(lp + g * 16);
#pragma unroll
                for (int e = 0; e < 4; ++e) INS16(L, (fkey(v[e]) & ~127) | (hf * 64 + g * 4 + e)); }
            if (hf) {
#pragma unroll
                for (int q = 0; q < 16; ++q) ((LAS int*)lp)[q] = L[q]; }
            __syncthreads();
            if (!hf) { LAS const int* op = (LAS const int*)(lp + TK_HALF);
#pragma unroll
                for (int q = 0; q < 16; ++q) INS16(L, op[q]);
                LAS int* kp = (LAS int*)(lds + TK_KEYS) + lst * 16;
#pragma unroll
                for (int q = 0; q < 16; ++q) kp[q] = L[q]; }
        }
        __syncthreads();
        if (c.tid < 128) {
            LAS const int* k1 = (LAS const int*)(lds + TK_KEYS) + (c.tid * 2) * 16; LAS const int* k2 = k1 + 16;
            float v1[16], v2[16];
#pragma unroll
            for (int q = 0; q < 16; ++q) { v1[q] = kval(k1[q] & ~127); v2[q] = kval(k2[q] & ~127); }
            int L[16];
#pragma unroll
            for (int q = 0; q < 16; ++q) L[q] = (fkey(v1[0] + v2[q]) & ~255) | q;
#pragma unroll
            for (int i = 1; i < 16; ++i)
#pragma unroll
                for (int j = 0; j < 16; ++j) if ((i + 1) * (j + 1) <= 16) INS16(L, (fkey(v1[i] + v2[j]) & ~255) | (i * 16 + j));
            const int tt = c.tid >> 3, hh = c.tid & 7; const size_t ob0 = ((size_t)tile * 16 + tt) * 128;
            float rstd; { const f32x4* sp = (const f32x4*)(SQP + ((size_t)tile * 16 + tt) * 32); f32x4 a4 = sp[0];
#pragma unroll
              for (int q = 1; q < 8; ++q) a4 += sp[q];
              rstd = 1.0f / sqrtf(((a4[0] + a4[1]) + (a4[2] + a4[3])) * (1.0f / DM) + EPS); }
            if (hh == 0) RSTD[(size_t)tile * 16 + tt] = rstd;
            const float m0 = kval(L[0] & ~255); float ex[16], se = 0.f;
#pragma unroll
            for (int q = 0; q < 16; ++q) { ex[q] = __builtin_amdgcn_exp2f((kval(L[q] & ~255) - m0) * (rstd * 1.4426950408889634f)); se += ex[q]; }
            const float inv = 1.0f / se;
#pragma unroll
            for (int q = 0; q < 16; ++q) { const int cid = L[q] & 255; const int es = hh * 16 + q, pos = (es & 7) * 16 + (es >> 3);
                IDX[ob0 + pos] = (k1[cid >> 4] & 127) * PNK + (k2[cid & 15] & 127); WGT[ob0 + pos] = ex[q] * inv; }
        }
    }
}

template <int NSTAGE> __device__ __forceinline__ void xreduce_stage(float (&p)[64], int lane) {
    constexpr int S = NSTAGE;
    if constexpr (S == 32) {
#pragma unroll
        for (int k = 0; k < S; ++k) { float xa = p[k], xb = p[k + S]; asm("s_nop 1\n\tv_permlane32_swap_b32 %0, %1" : "+v"(xa), "+v"(xb)); p[k] = xa + xb; }
    } else if constexpr (S == 16) {
#pragma unroll
        for (int k = 0; k < S; ++k) { float xa = p[k], xb = p[k + S]; asm("s_nop 1\n\tv_permlane16_swap_b32 %0, %1" : "+v"(xa), "+v"(xb)); p[k] = xa + xb; }
    } else {
        const bool up = (lane & S) != 0;
#pragma unroll
        for (int k = 0; k < S; ++k) { const float keep = up ? p[k + S] : p[k], send = up ? p[k] : p[k + S];
            p[k] = keep + __builtin_bit_cast(float, __builtin_amdgcn_ds_swizzle(__builtin_bit_cast(int, send), (S << 10) | 0x1F)); }
    }
}
__device__ __forceinline__ float gelu_erf(float v) { return 0.5f * v * (1.0f + erff(v * 0.70710678118654752f)); }
typedef float f32x2 __attribute__((ext_vector_type(2)));
__device__ __forceinline__ float peer_dots64(const unsigned char* U, int idxv, const f32x2 (&h2)[16], int lane) {
    float p[64];
#pragma unroll
    for (int e = 0; e < 64; ++e) {
        const int row = __builtin_amdgcn_readlane(idxv, e);
        const u32x4* up = (const u32x4*)(U + (size_t)row * DM) + lane;
        f32x2 a = {0.f, 0.f};
#pragma unroll
        for (int cc = 0; cc < 2; ++cc) { const u32x4 u = up[64 * cc];
#pragma unroll
            for (int q = 0; q < 4; ++q) { const int w = (int)u[q];
                a = __builtin_elementwise_fma(__builtin_amdgcn_cvt_pk_f32_fp8(w, false), h2[8 * cc + 2 * q], a);
                a = __builtin_elementwise_fma(__builtin_amdgcn_cvt_pk_f32_fp8(w, true), h2[8 * cc + 2 * q + 1], a); } }
        p[e] = a.x + a.y;
    }
    xreduce_stage<32>(p, lane); xreduce_stage<16>(p, lane); xreduce_stage<8>(p, lane); xreduce_stage<4>(p, lane); xreduce_stage<2>(p, lane); xreduce_stage<1>(p, lane);
    return p[0];
}
__device__ __forceinline__ void peer_accum64(const unsigned char* Vt, int idxv, float av, f32x2 (&acc)[16], int lane) {
#pragma unroll 8
    for (int e = 0; e < 64; ++e) {
        const int row = __builtin_amdgcn_readlane(idxv, e); const float a = __builtin_bit_cast(float, __builtin_amdgcn_readlane(__builtin_bit_cast(int, av), e));
        const f32x2 a2 = {a, a};
        const u32x4* vp = (const u32x4*)(Vt + (size_t)row * DM) + lane;
#pragma unroll
        for (int cc = 0; cc < 2; ++cc) { const u32x4 v = vp[64 * cc];
#pragma unroll
            for (int q = 0; q < 4; ++q) { const int w = (int)v[q];
                acc[8 * cc + 2 * q] = __builtin_elementwise_fma(__builtin_amdgcn_cvt_pk_f32_fp8(w, false), a2, acc[8 * cc + 2 * q]);
                acc[8 * cc + 2 * q + 1] = __builtin_elementwise_fma(__builtin_amdgcn_cvt_pk_f32_fp8(w, true), a2, acc[8 * cc + 2 * q + 1]); } }
    }
}
constexpr int GD = 8;
#define PG_ISSUE(vv) do { const int row_ = __builtin_amdgcn_readlane((((vv) >> 6) & 1) ? i1 : i0, (vv) & 63); \
        const u32x4* bp_ = (const u32x4*)((((vv) >> 6) < 2 ? U : Vt) + (size_t)row_ * DM) + lane; ring[(vv) % GD][0] = bp_[0]; ring[(vv) % GD][1] = bp_[64]; } while (0)
template <int SEG> __device__ __forceinline__ void peer_seg(const unsigned char* U, const unsigned char* Vt, int i0, int i1, u32x4 (&ring)[GD][2], float (&p)[64], float aseg, const f32x2 (&h2)[16], f32x2 (&acc)[16], int lane) {
#pragma unroll
    for (int e = 0; e < 64; ++e) {
        const int v = SEG * 64 + e;
        const u32x4 r0 = ring[v % GD][0], r1 = ring[v % GD][1];
        if (SEG < 2) {
            f32x2 a = {0.f, 0.f};
#pragma unroll
            for (int q = 0; q < 4; ++q) { const int wa = (int)r0[q], wb = (int)r1[q];
                a = __builtin_elementwise_fma(__builtin_amdgcn_cvt_pk_f32_fp8(wa, false), h2[2 * q], a); a = __builtin_elementwise_fma(__builtin_amdgcn_cvt_pk_f32_fp8(wa, true), h2[2 * q + 1], a);
                a = __builtin_elementwise_fma(__builtin_amdgcn_cvt_pk_f32_fp8(wb, false), h2[8 + 2 * q], a); a = __builtin_elementwise_fma(__builtin_amdgcn_cvt_pk_f32_fp8(wb, true), h2[8 + 2 * q + 1], a); }
            { float hs_; asm("v_add_f32 %0, %1, %2" : "=v"(hs_) : "v"(a.x), "v"(a.y)); p[e] = hs_; }
        } else {
            const float av = __builtin_bit_cast(float, __builtin_amdgcn_readlane(__builtin_bit_cast(int, aseg), e)); const f32x2 a2 = {av, av};
#pragma unroll
            for (int q = 0; q < 4; ++q) { const int wa = (int)r0[q], wb = (int)r1[q];
                acc[2 * q] = __builtin_elementwise_fma(__builtin_amdgcn_cvt_pk_f32_fp8(wa, false), a2, acc[2 * q]); acc[2 * q + 1] = __builtin_elementwise_fma(__builtin_amdgcn_cvt_pk_f32_fp8(wa, true), a2, acc[2 * q + 1]);
                acc[8 + 2 * q] = __builtin_elementwise_fma(__builtin_amdgcn_cvt_pk_f32_fp8(wb, false), a2, acc[8 + 2 * q]); acc[8 + 2 * q + 1] = __builtin_elementwise_fma(__builtin_amdgcn_cvt_pk_f32_fp8(wb, true), a2, acc[8 + 2 * q + 1]); }
            asm volatile("" : "+v"(acc[0]), "+v"(acc[1]), "+v"(acc[2]), "+v"(acc[3]), "+v"(acc[4]), "+v"(acc[5]), "+v"(acc[6]), "+v"(acc[7]), "+v"(acc[8]), "+v"(acc[9]), "+v"(acc[10]), "+v"(acc[11]), "+v"(acc[12]), "+v"(acc[13]), "+v"(acc[14]), "+v"(acc[15]));
        }
        if (v + GD < 256) PG_ISSUE(v + GD);
        __builtin_amdgcn_sched_barrier(0);
    }
}
__device__ __forceinline__ void peer_token_pipe(const unsigned char* U, const unsigned char* Vt, int i0, int i1, float su0, float su1, float w0, float w1, const f32x2 (&h2)[16], f32x2 (&acc)[16], int lane) {
    u32x4 ring[GD][2];
    float p[64];
#pragma unroll
    for (int v = 0; v < GD; ++v) PG_ISSUE(v);
    peer_seg<0>(U, Vt, i0, i1, ring, p, 0.f, h2, acc, lane);
    xreduce_stage<32>(p, lane); xreduce_stage<16>(p, lane); xreduce_stage<8>(p, lane); xreduce_stage<4>(p, lane); xreduce_stage<2>(p, lane); xreduce_stage<1>(p, lane);
    const float a0 = gelu_erf(p[0] * su0) * w0;
    __builtin_amdgcn_sched_barrier(0);
    peer_seg<1>(U, Vt, i0, i1, ring, p, 0.f, h2, acc, lane);
    xreduce_stage<32>(p, lane); xreduce_stage<16>(p, lane); xreduce_stage<8>(p, lane); xreduce_stage<4>(p, lane); xreduce_stage<2>(p, lane); xreduce_stage<1>(p, lane);
    const float a1 = gelu_erf(p[0] * su1) * w1;
    __builtin_amdgcn_sched_barrier(0);
    peer_seg<2>(U, Vt, i0, i1, ring, p, a0, h2, acc, lane);
    peer_seg<3>(U, Vt, i0, i1, ring, p, a1, h2, acc, lane);
}
#undef PG_ISSUE
__device__ __forceinline__ void peer_gather_phase(const Ctx& c, const bf16* Hn, const unsigned char* U, const unsigned char* Vt, const float* rsU, const float* rsV, const int* IDX, const float* WGT, const float* Xr, float* X, int mode,
                                                  const float* g1, const float* g2, bf16* Hout, bf16* HKVout) {
    for (int m = c.gw; m < NTOK; m += c.ngw) {
        int lane_ = c.lane; asm volatile("" : "+v"(lane_));
#ifdef DRYIDXMASK
        const int imask_ = (X != Xr) ? DRYIDXMASK : 0xffff;
        const int i0 = IDX[(size_t)m * 128 + lane_] & imask_, i1 = IDX[(size_t)m * 128 + 64 + lane_] & imask_;
#else
        const int i0 = IDX[(size_t)m * 128 + lane_], i1 = IDX[(size_t)m * 128 + 64 + lane_];
#endif
        const float w0 = WGT[(size_t)m * 128 + lane_] * rsV[i0], w1 = WGT[(size_t)m * 128 + 64 + lane_] * rsV[i1];
        const float su0 = rsU[i0], su1 = rsU[i1];
        f32x2 h2[16];
#pragma unroll
        for (int cc = 0; cc < 2; ++cc) { const u32x4* hp = (const u32x4*)(Hn + (size_t)m * DM + 1024 * cc + 16 * lane_); const u32x4 ha = hp[0], hb = hp[1];
#pragma unroll
            for (int q = 0; q < 4; ++q) { h2[8 * cc + q] = (f32x2){bflo(ha[q]), bfhi(ha[q])}; h2[8 * cc + 4 + q] = (f32x2){bflo(hb[q]), bfhi(hb[q])}; } }
        f32x2 acc[16];
#pragma unroll
        for (int k = 0; k < 16; ++k) acc[k] = (f32x2){0.f, 0.f};
        peer_token_pipe(U, Vt, i0, i1, su0, su1, w0, w1, h2, acc, lane_);
        float* xr = X + (size_t)m * DM; const float* xrr = Xr + (size_t)m * DM; float ss = 0.f;
#pragma unroll
        for (int cc = 0; cc < 2; ++cc) {
            f32x4* xp = (f32x4*)(xr + 1024 * cc + 16 * lane_); const f32x4* xq = (const f32x4*)(xrr + 1024 * cc + 16 * lane_);
#pragma unroll
            for (int q = 0; q < 4; ++q) { f32x4 xa = xq[q]; xa[0] += acc[8 * cc + 2 * q].x; xa[1] += acc[8 * cc + 2 * q].y; xa[2] += acc[8 * cc + 2 * q + 1].x; xa[3] += acc[8 * cc + 2 * q + 1].y;
                acc[8 * cc + 2 * q] = (f32x2){xa[0], xa[1]}; acc[8 * cc + 2 * q + 1] = (f32x2){xa[2], xa[3]}; ss += (xa[0] * xa[0] + xa[1] * xa[1]) + (xa[2] * xa[2] + xa[3] * xa[3]);
                if (mode != 2) xp[q] = xa; }
        }
        const float rstd = 1.0f / sqrtf(wave_sum(ss) * (1.0f / DM) + EPS);
#pragma unroll
        for (int cc = 0; cc < 2; ++cc) {
            const f32x4* gp = (const f32x4*)(g1 + 1024 * cc + 16 * lane_);
            if (mode == 2) {
                f32x4* xp = (f32x4*)(xr + 1024 * cc + 16 * lane_);
#pragma unroll
                for (int q = 0; q < 4; ++q) { const f32x4 gv = gp[q]; f32x4 y; y[0] = acc[8 * cc + 2 * q].x * rstd * gv[0]; y[1] = acc[8 * cc + 2 * q].y * rstd * gv[1]; y[2] = acc[8 * cc + 2 * q + 1].x * rstd * gv[2]; y[3] = acc[8 * cc + 2 * q + 1].y * rstd * gv[3]; xp[q] = y; }
            } else {
                u32x4 hw[2];
#pragma unroll
                for (int q = 0; q < 4; ++q) { const f32x4 gv = gp[q]; hw[q >> 1][2 * (q & 1)] = pk2(acc[8 * cc + 2 * q].x * rstd * gv[0], acc[8 * cc + 2 * q].y * rstd * gv[1]); hw[q >> 1][2 * (q & 1) + 1] = pk2(acc[8 * cc + 2 * q + 1].x * rstd * gv[2], acc[8 * cc + 2 * q + 1].y * rstd * gv[3]); }
                u32x4* ho = (u32x4*)(Hout + (size_t)m * DM + 1024 * cc + 16 * lane_); ho[0] = hw[0]; ho[1] = hw[1];
                if (mode == 1) {
                    const f32x4* kp = (const f32x4*)(g2 + 1024 * cc + 16 * lane_); u32x4 kw[2];
#pragma unroll
                    for (int q = 0; q < 4; ++q) { const f32x4 gv = kp[q]; kw[q >> 1][2 * (q & 1)] = pk2(acc[8 * cc + 2 * q].x * rstd * gv[0], acc[8 * cc + 2 * q].y * rstd * gv[1]); kw[q >> 1][2 * (q & 1) + 1] = pk2(acc[8 * cc + 2 * q + 1].x * rstd * gv[2], acc[8 * cc + 2 * q + 1].y * rstd * gv[3]); }
                    u32x4* ko = (u32x4*)(HKVout + (size_t)m * DM + 1024 * cc + 16 * lane_); ko[0] = kw[0]; ko[1] = kw[1];
                }
            }
        }
    }
}

template <int PAT> __device__ __forceinline__ float swz_xor(float v) { return __builtin_bit_cast(float, __builtin_amdgcn_ds_swizzle(__builtin_bit_cast(int, v), PAT)); }
template <int PAT> __device__ __forceinline__ int swz_xor_i(int v) { return __builtin_amdgcn_ds_swizzle(v, PAT); }
template <int C> __device__ __forceinline__ unsigned bc8(unsigned v) { return (unsigned)__builtin_amdgcn_ds_swizzle((int)v, (C << 5) | 0x18); }
__device__ __forceinline__ void bcast16(unsigned x0, unsigned x1, unsigned (&o)[16]) {
    o[0] = bc8<0>(x0); o[1] = bc8<0>(x1); o[2] = bc8<1>(x0); o[3] = bc8<1>(x1); o[4] = bc8<2>(x0); o[5] = bc8<2>(x1); o[6] = bc8<3>(x0); o[7] = bc8<3>(x1);
    o[8] = bc8<4>(x0); o[9] = bc8<4>(x1); o[10] = bc8<5>(x0); o[11] = bc8<5>(x1); o[12] = bc8<6>(x0); o[13] = bc8<6>(x1); o[14] = bc8<7>(x0); o[15] = bc8<7>(x1);
}
__device__ __forceinline__ void peer_u_phase(const Ctx& c, const bf16* Hn, const unsigned char* U, const int* IDXT, float* PD, unsigned imask = 0xffffffffu) {
    const int xg = c.bx & 7, wr = (c.bx >> 3) * 8 + c.wave, g = c.lane >> 3, sub = c.lane & 7;
    for (int pass = 0; pass < 2; ++pass) {
        const int s = xg + 8 * pass, col0 = 128 * s + 16 * sub;
        const unsigned char* Us = U + (size_t)s * PE * 128 + 16 * sub;
        u32x4 wv[8];
        { const u32x4* wp = (const u32x4*)(U + (size_t)s * PE * 128 + (size_t)(c.bx >> 3) * 65536) + c.tid;
#pragma unroll
          for (int q = 0; q < 8; ++q) wv[q] = wp[q * 512]; }
        u32x2 ii; u32x4 hr[2];
        { const u32x4* hp = (const u32x4*)(Hn + (size_t)wr * DM + col0);
          ii = *(const u32x2*)(IDXT + (size_t)wr * 128 + g * 16 + 2 * sub);
          hr[0] = hp[0]; hr[1] = hp[1]; }
        for (int k = 0; k < NTOK / 256; ++k) {
            const int t = wr + 256 * k;
            u32x4 r[16]; unsigned rj[16];
            bcast16(ii.x, ii.y, rj);
#pragma unroll
            for (int j = 0; j < 16; ++j) r[j] = *(const u32x4*)(Us + (size_t)(rj[j] & imask) * 128);
            float hf[16];
#pragma unroll
            for (int q = 0; q < 4; ++q) { hf[2 * q] = bflo(hr[0][q]); hf[2 * q + 1] = bfhi(hr[0][q]); hf[8 + 2 * q] = bflo(hr[1][q]); hf[8 + 2 * q + 1] = bfhi(hr[1][q]); }
            if (k + 1 < NTOK / 256) { const u32x4* hp = (const u32x4*)(Hn + (size_t)(t + 256) * DM + col0);
                ii = *(const u32x2*)(IDXT + (size_t)(t + 256) * 128 + g * 16 + 2 * sub);
                hr[0] = hp[0]; hr[1] = hp[1]; }
            float am = 0.f;
#pragma unroll
            for (int q = 0; q < 16; ++q) am = fmaxf(am, fabsf(hf[q]));
            am = fmaxf(am, dpp_f<0xB1>(am)); am = fmaxf(am, dpp_f<0x4E>(am)); am = fmaxf(am, dpp_f<0x141>(am));
            const float hsc = am > 0.f ? 127.0f / am : 0.f, hinv = am * (1.0f / 127.0f);
            unsigned hq[4];
#pragma unroll
            for (int q = 0; q < 4; ++q) hq[q] = q8pack(hf[4 * q] * hsc, hf[4 * q + 1] * hsc, hf[4 * q + 2] * hsc, hf[4 * q + 3] * hsc);
            int p[16];
#pragma unroll
            for (int j = 0; j < 16; ++j) { int a = __builtin_amdgcn_sdot4((int)r[j].x, (int)hq[0], 0, false); a = __builtin_amdgcn_sdot4((int)r[j].y, (int)hq[1], a, false);
                a = __builtin_amdgcn_sdot4((int)r[j].z, (int)hq[2], a, false); p[j] = __builtin_amdgcn_sdot4((int)r[j].w, (int)hq[3], a, false); }
            { const bool up = (sub & 4) != 0;
#pragma unroll
              for (int q = 0; q < 8; ++q) { const int keep = up ? p[q + 8] : p[q], send = up ? p[q] : p[q + 8]; p[q] = keep + swz_xor_i<(4 << 10) | 0x1F>(send); } }
            { const bool up = (sub & 2) != 0;
#pragma unroll
              for (int q = 0; q < 4; ++q) { const int keep = up ? p[q + 4] : p[q], send = up ? p[q] : p[q + 4]; p[q] = keep + swz_xor_i<(2 << 10) | 0x1F>(send); } }
            { const bool up = (sub & 1) != 0;
#pragma unroll
              for (int q = 0; q < 2; ++q) { const int keep = up ? p[q + 2] : p[q], send = up ? p[q] : p[q + 2]; p[q] = keep + swz_xor_i<(1 << 10) | 0x1F>(send); } }
            f32x2 o = {(float)p[0] * hinv, (float)p[1] * hinv};
            *(f32x2*)(PD + ((size_t)t * 16 + s) * 128 + g * 16 + 2 * sub) = o;
            if (k == 0) asm volatile("" :: "v"(wv[0]), "v"(wv[1]), "v"(wv[2]), "v"(wv[3]), "v"(wv[4]), "v"(wv[5]), "v"(wv[6]), "v"(wv[7]));
        }
    }
}
__device__ __forceinline__ void peer_a_phase(const Ctx& c, const float* PD, const int* IDXT, float* WA, const float* rsU, const float* rsV, const float* RSTD) {
    const int i0 = c.bx * 512 + c.tid, step = c.G * 512;
    f32x4 vn[16];
    if (i0 < NTOK * 32) { const f32x4* pp = (const f32x4*)(PD + (size_t)(i0 >> 5) * 2048) + (i0 & 31);
#pragma unroll
        for (int s = 0; s < 16; ++s) vn[s] = pp[s * 32]; }
    for (int i4 = i0; i4 < NTOK * 32; i4 += step) {
        const int t = i4 >> 5;
        f32x4 v[16];
#pragma unroll
        for (int s = 0; s < 16; ++s) v[s] = vn[s];
        const u32x4 e = *((const u32x4*)IDXT + i4); const f32x4 w = *((const f32x4*)WA + i4); const float rs = RSTD[t];
        { const int i5 = i4 + step < NTOK * 32 ? i4 + step : i4; const f32x4* pp = (const f32x4*)(PD + (size_t)(i5 >> 5) * 2048) + (i5 & 31);
#pragma unroll
          for (int s = 0; s < 16; ++s) vn[s] = pp[s * 32]; }
        float ru[4], rv[4];
#pragma unroll
        for (int q = 0; q < 4; ++q) { const unsigned eq = e[q]; ru[q] = rsU[eq]; rv[q] = rsV[eq]; }
        f32x4 sm = v[0];
#pragma unroll
        for (int s = 1; s < 16; ++s) sm += v[s];
        asm volatile("" :: "v"(ru[0]), "v"(ru[1]), "v"(ru[2]), "v"(ru[3]), "v"(rv[0]), "v"(rv[1]), "v"(rv[2]), "v"(rv[3]));
        f32x4 o;
#pragma unroll
        for (int q = 0; q < 4; ++q) o[q] = gelu_erf(sm[q] * ru[q] * rs) * w[q] * rv[q];
        *((f32x4*)WA + i4) = o;
    }
}
__device__ __forceinline__ void peer_v_phase(const Ctx& c, const unsigned char* Vt, const int* IDXT, const float* WA, float* X) {
    const int xg = c.bx & 7, wr = (c.bx >> 3) * 8 + c.wave, g = c.lane >> 3, sub = c.lane & 7;
    for (int pass = 0; pass < 2; ++pass) {
        const int s = xg + 8 * pass, col0 = 128 * s + 16 * sub;
        const unsigned char* Vs = Vt + (size_t)s * PE * 128 + 16 * sub;
        u32x4 wv[8];
        { const u32x4* wp = (const u32x4*)(Vt + (size_t)s * PE * 128 + (size_t)(c.bx >> 3) * 65536) + c.tid;
#pragma unroll
          for (int q = 0; q < 8; ++q) wv[q] = wp[q * 512]; }
        u32x2 ii, aa;
        { ii = *(const u32x2*)(IDXT + (size_t)wr * 128 + g * 16 + 2 * sub); aa = *(const u32x2*)(WA + (size_t)wr * 128 + g * 16 + 2 * sub); }
        for (int k = 0; k < NTOK / 256; ++k) {
            const int t = wr + 256 * k;
            u32x4 r[16]; float av[16]; unsigned rj[16], aj[16];
            bcast16(ii.x, ii.y, rj);
#pragma unroll
            for (int j = 0; j < 16; ++j) r[j] = *(const u32x4*)(Vs + (size_t)rj[j] * 128);
            bcast16(aa.x, aa.y, aj);
#pragma unroll
            for (int j = 0; j < 16; ++j) av[j] = __builtin_bit_cast(float, aj[j]);
            f32x2* xp = (f32x2*)(X + (size_t)t * DM + col0 + 2 * g);
            const f32x2 xold = *xp;
            if (k + 1 < NTOK / 256) { ii = *(const u32x2*)(IDXT + (size_t)(t + 256) * 128 + g * 16 + 2 * sub); aa = *(const u32x2*)(WA + (size_t)(t + 256) * 128 + g * 16 + 2 * sub); }
            f32x2 acc[8];
#pragma unroll
            for (int q = 0; q < 8; ++q) acc[q] = (f32x2){0.f, 0.f};
#pragma unroll
            for (int j = 0; j < 16; ++j) { float aj_ = av[j]; asm("" : "+v"(aj_));
                const f32x2 a2 = {aj_, aj_};
#pragma unroll
                for (int q = 0; q < 4; ++q) { const int w = (int)r[j][q]; acc[2 * q] = __builtin_elementwise_fma(__builtin_amdgcn_cvt_pk_f32_fp8(w, false), a2, acc[2 * q]); acc[2 * q + 1] = __builtin_elementwise_fma(__builtin_amdgcn_cvt_pk_f32_fp8(w, true), a2, acc[2 * q + 1]); } }
            float af[16];
#pragma unroll
            for (int q = 0; q < 8; ++q) { af[2 * q] = acc[q].x; af[2 * q + 1] = acc[q].y; }
#ifdef VDBG
#pragma unroll
            for (int q = 0; q < 16; ++q) { af[q] += __shfl_xor(af[q], 8); af[q] += __shfl_xor(af[q], 16); af[q] += __shfl_xor(af[q], 32); }
            { float s0 = af[0], s1 = af[1];
#pragma unroll
              for (int gg = 1; gg < 8; ++gg) { s0 = (g == gg) ? af[2 * gg] : s0; s1 = (g == gg) ? af[2 * gg + 1] : s1; }
              af[0] = s0; af[1] = s1; }
#else
#pragma unroll
            for (int q = 0; q < 8; ++q) { float xa = af[q], xb = af[q + 8]; asm("s_nop 1\n\tv_permlane32_swap_b32 %0, %1" : "+v"(xa), "+v"(xb)); af[q] = xa + xb; }
#pragma unroll
            for (int q = 0; q < 4; ++q) { float xa = af[q], xb = af[q + 4]; asm("s_nop 1\n\tv_permlane16_swap_b32 %0, %1" : "+v"(xa), "+v"(xb)); af[q] = xa + xb; }
            { const bool up = (c.lane & 8) != 0;
#pragma unroll
              for (int q = 0; q < 2; ++q) { const float keep = up ? af[q + 2] : af[q], send = up ? af[q] : af[q + 2]; af[q] = keep + swz_xor<(8 << 10) | 0x1F>(send); } }
#endif
            const f32x2 xn = {xold.x + af[0], xold.y + af[1]};
            *xp = xn;
            if (k == 0) asm volatile("" :: "v"(wv[0]), "v"(wv[1]), "v"(wv[2]), "v"(wv[3]), "v"(wv[4]), "v"(wv[5]), "v"(wv[6]), "v"(wv[7]));
        }
    }
}
#ifdef VREF
__device__ __forceinline__ void peer_v_ref_phase(const Ctx& c, const unsigned char* Vt, const int* IDXT, const float* WA, float* X) {
    for (int m = c.gw; m < NTOK; m += c.ngw) {
        const int i0 = IDXT[(size_t)m * 128 + c.lane], i1 = IDXT[(size_t)m * 128 + 64 + c.lane];
        const float a0 = WA[(size_t)m * 128 + c.lane], a1 = WA[(size_t)m * 128 + 64 + c.lane];
        f32x2 acc[16];
#pragma unroll
        for (int k = 0; k < 16; ++k) acc[k] = (f32x2){0.f, 0.f};
        for (int e = 0; e < 128; ++e) {
            const int row = __shfl(e < 64 ? i0 : i1, e & 63); const float a = __shfl(e < 64 ? a0 : a1, e & 63); const f32x2 a2 = {a, a};
            const u32x4* vp = (const u32x4*)(Vt + (size_t)row * DM) + c.lane;
#pragma unroll
            for (int cc = 0; cc < 2; ++cc) { const u32x4 v = vp[64 * cc];
#pragma unroll
                for (int q = 0; q < 4; ++q) { const int w = (int)v[q];
                    acc[8 * cc + 2 * q] = __builtin_elementwise_fma(__builtin_amdgcn_cvt_pk_f32_fp8(w, false), a2, acc[8 * cc + 2 * q]);
                    acc[8 * cc + 2 * q + 1] = __builtin_elementwise_fma(__builtin_amdgcn_cvt_pk_f32_fp8(w, true), a2, acc[8 * cc + 2 * q + 1]); } }
        }
        float* xr = X + (size_t)m * DM;
#pragma unroll
        for (int cc = 0; cc < 2; ++cc) { f32x4* xp = (f32x4*)(xr + 1024 * cc + 16 * c.lane);
#pragma unroll
            for (int q = 0; q < 4; ++q) { f32x4 xa = xp[q]; xa[0] += acc[8 * cc + 2 * q].x; xa[1] += acc[8 * cc + 2 * q].y; xa[2] += acc[8 * cc + 2 * q + 1].x; xa[3] += acc[8 * cc + 2 * q + 1].y; xp[q] = xa; } }
    }
}
#endif
__device__ __forceinline__ void norm_phase(const Ctx& c, float* X, int mode, const float* g1, const float* g2, bf16* H, bf16* HKV) {
    f32x4 ga[8], gb[8]; load_g(g1, c.lane, ga); load_g(mode == 1 ? g2 : g1, c.lane, gb);
    int m = c.gw;
    f32x4 v[8]; load_row(X + (size_t)m * DM, c.lane, v);
    for (; m < NTOK; m += c.ngw) {
        const int mn = m + c.ngw < NTOK ? m + c.ngw : m;
        f32x4 nx[8]; load_row(X + (size_t)mn * DM, c.lane, nx);
        const float rstd = row_rstd(v);
        if (mode == 2) { f32x4* xo = (f32x4*)(X + (size_t)m * DM) + c.lane;
#pragma unroll
            for (int j = 0; j < 8; ++j) { f32x4 y; y[0] = v[j][0] * rstd * ga[j][0]; y[1] = v[j][1] * rstd * ga[j][1]; y[2] = v[j][2] * rstd * ga[j][2]; y[3] = v[j][3] * rstd * ga[j][3]; xo[64 * j] = y; }
        } else { store_norm_bf16_r(v, rstd, ga, H + (size_t)m * DM, c.lane); if (mode == 1) store_norm_bf16_r(v, rstd, gb, HKV + (size_t)m * DM, c.lane); }
#pragma unroll
        for (int j = 0; j < 8; ++j) v[j] = nx[j];
    }
}

__device__ __forceinline__ void rms_final_phase(const Ctx& c, float* X, const float* g) {
    for (int m = c.gw; m < NTOK; m += c.ngw) { f32x4 v[8]; load_row(X + (size_t)m * DM, c.lane, v); const float rstd = row_rstd(v);
        const f32x4* gr = (const f32x4*)g + c.lane; f32x4* xo = (f32x4*)(X + (size_t)m * DM) + c.lane;
#pragma unroll
        for (int j = 0; j < 8; ++j) { const f32x4 gv = gr[64 * j]; f32x4 y; for (int k = 0; k < 4; ++k) { y[k] = v[j][k] * rstd * gv[k]; if (!(fabsf(y[k]) < 1e30f)) y[k] = 0.f; } xo[64 * j] = y; } }
}

#ifdef DIAGBUF
__device__ __forceinline__ void diag_copy_phase(const Ctx& c, float* X, const unsigned char* ws) {
    const bf16* src = (const bf16*)(ws + (size_t)DIAGBUF);
    for (size_t i = (size_t)c.bx * 512 + c.tid; i < (size_t)NTOK * DM; i += (size_t)c.G * 512) { const size_t t = i / DM, col = i % DM; float v = bflo((unsigned)src[t * DIAGLD + col]); if (!(fabsf(v) < 1e30f)) v = 0.f; X[i] = v; }
}
#endif

__device__ __forceinline__ unsigned off_b(unsigned row, unsigned ch) { return 256u * row + 16u * (ch ^ (((row & 3u) << 2) | ((row >> 2) & 3u))); }
__device__ __forceinline__ float rowmax4(float x) {
    float a = x, b = x; asm("s_nop 1\n\tv_permlane16_swap_b32 %0, %1" : "+v"(a), "+v"(b)); x = fmaxf(a, b);
    a = x; b = x; asm("s_nop 1\n\tv_permlane32_swap_b32 %0, %1" : "+v"(a), "+v"(b)); return fmaxf(a, b);
}
constexpr int AT_K = 0, AT_V = 32768, AT_BUF = 65536, AT_BIAS = 131072, AT_HEADB = 16384;
__device__ __forceinline__ void attn_phase(const Ctx& c, const bf16* Qg, const bf16* KVg, bf16* AOg, const float* relb, int dryvar = 0) {
    LAS unsigned char* lds = c.lds; const unsigned ldsb = (unsigned)(size_t)lds;
    const int tid = c.tid, lane = c.lane, w = c.wave, hg = w >> 2, wq = w & 3, fr = lane & 15, fq = lane >> 4, tq = (lane & 15) >> 2, tp = lane & 3;
    const int tl = tid & 255, lrow = tl >> 2, lc = tl & 3;
    unsigned vadr[8];
#pragma unroll
    for (int d = 0; d < 8; ++d) vadr[d] = ldsb + AT_V + hg * AT_HEADB + off_b(4 * fq + tq, 2 * d + (tp >> 1)) + 8 * (tp & 1);
    unsigned kadr[4];
#pragma unroll
    for (int s4 = 0; s4 < 4; ++s4) kadr[s4] = ldsb + AT_K + hg * AT_HEADB + 256 * fr + 16 * (fq ^ ((fr >> 2) & 3)) + 64 * (s4 ^ (fr & 3));
    for (int u = c.bx; u < NBATCH * NCHUNK * (AH / 2); u += c.G) {
        const int hp = u & 7, ch = (u >> 3) & 63, b = u >> 9, h = 2 * hp + hg;
        const size_t tq0 = (size_t)b * SEQ + (size_t)ch * CHUNK;
        __syncthreads();
        for (int i = tid; i < 2 * 272; i += 512) { const int hh = i / 272, k = i % 272; ((LAS float*)(lds + AT_BIAS))[i] = (k < NREL) ? relb[(size_t)(2 * hp + hh) * NREL + k] * 1.4426950408889634f : 0.f; }
        bf16x8 qf[4];
        { const bf16* qp = Qg + (tq0 + 16 * wq + fr) * DM + h * AHD + 8 * fq;
#pragma unroll
          for (int s = 0; s < 4; ++s) qf[s] = *(const bf16x8*)(qp + 32 * s); }
        f32x4 O[8];
#pragma unroll
        for (int d = 0; d < 8; ++d) O[d] = (f32x4){0.f, 0.f, 0.f, 0.f};
        float mrun = -1e30f, lrun = 0.f;
        const int t0 = ch >= LEFT ? 0 : LEFT - ch;
        u32x4 pk[4], pv[4];
        { const bf16* kp = KVg + ((size_t)b * SEQ + (size_t)(ch - LEFT + t0) * CHUNK + lrow) * (2 * DM) + h * AHD;
#pragma unroll
          for (int cc = 0; cc < 4; ++cc) { pk[cc] = *(const u32x4*)(kp + (lc + 4 * cc) * 8); pv[cc] = *(const u32x4*)(kp + DM + (lc + 4 * cc) * 8); } }
        const LAS float* bias = (const LAS float*)(lds + AT_BIAS) + hg * 272;
        const float bc = relb[(size_t)h * NREL + 256] * 1.4426950408889634f;
        for (int t = t0; t <= LEFT; ++t) {
            const int pb = ((t - t0) & 1) * AT_BUF;
#pragma unroll
            for (int cc = 0; cc < 4; ++cc) { *(LAS u32x4*)(lds + pb + AT_K + hg * AT_HEADB + off_b(lrow, lc + 4 * cc)) = pk[cc]; *(LAS u32x4*)(lds + pb + AT_V + hg * AT_HEADB + off_b(lrow, lc + 4 * cc)) = pv[cc]; }
            __syncthreads();
            if (t < LEFT && dryvar != 1) { const bf16* kp = KVg + ((size_t)b * SEQ + (size_t)(ch - LEFT + t + 1) * CHUNK + lrow) * (2 * DM) + h * AHD;
#pragma unroll
                for (int cc = 0; cc < 4; ++cc) { pk[cc] = *(const u32x4*)(kp + (lc + 4 * cc) * 8); pv[cc] = *(const u32x4*)(kp + DM + (lc + 4 * cc) * 8); } }
            f32x4 sT[4];
            {
                bf16x8 kf[16];
                const unsigned k0 = kadr[0] + pb, k1 = kadr[1] + pb, k2 = kadr[2] + pb, k3 = kadr[3] + pb;
                asm volatile("ds_read_b128 %0, %16\n\tds_read_b128 %1, %17\n\tds_read_b128 %2, %18\n\tds_read_b128 %3, %19\n\t"
                             "ds_read_b128 %4, %16 offset:4096\n\tds_read_b128 %5, %17 offset:4096\n\tds_read_b128 %6, %18 offset:4096\n\tds_read_b128 %7, %19 offset:4096\n\t"
                             "ds_read_b128 %8, %16 offset:8192\n\tds_read_b128 %9, %17 offset:8192\n\tds_read_b128 %10, %18 offset:8192\n\tds_read_b128 %11, %19 offset:8192\n\t"
                             "ds_read_b128 %12, %16 offset:12288\n\tds_read_b128 %13, %17 offset:12288\n\tds_read_b128 %14, %18 offset:12288\n\tds_read_b128 %15, %19 offset:12288"
                             : "=&v"(kf[0]), "=&v"(kf[1]), "=&v"(kf[2]), "=&v"(kf[3]), "=&v"(kf[4]), "=&v"(kf[5]), "=&v"(kf[6]), "=&v"(kf[7]),
                               "=&v"(kf[8]), "=&v"(kf[9]), "=&v"(kf[10]), "=&v"(kf[11]), "=&v"(kf[12]), "=&v"(kf[13]), "=&v"(kf[14]), "=&v"(kf[15])
                             : "v"(k0), "v"(k1), "v"(k2), "v"(k3) : "memory");
                asm volatile("s_waitcnt lgkmcnt(8)" : "+v"(kf[0]), "+v"(kf[1]), "+v"(kf[2]), "+v"(kf[3]), "+v"(kf[4]), "+v"(kf[5]), "+v"(kf[6]), "+v"(kf[7]) :: "memory");
#pragma unroll
                for (int kt = 0; kt < 2; ++kt) { sT[kt] = (f32x4){0.f, 0.f, 0.f, 0.f};
#pragma unroll
                    for (int s = 0; s < 4; ++s) sT[kt] = MFMA16(kf[4 * kt + s], qf[s], sT[kt]); }
                asm volatile("s_waitcnt lgkmcnt(0)" : "+v"(kf[8]), "+v"(kf[9]), "+v"(kf[10]), "+v"(kf[11]), "+v"(kf[12]), "+v"(kf[13]), "+v"(kf[14]), "+v"(kf[15]) :: "memory");
#pragma unroll
                for (int kt = 2; kt < 4; ++kt) { sT[kt] = (f32x4){0.f, 0.f, 0.f, 0.f};
#pragma unroll
                    for (int s = 0; s < 4; ++s) sT[kt] = MFMA16(kf[4 * kt + s], qf[s], sT[kt]); }
            }
            const int dbase = (LEFT - t) * CHUNK + (16 * wq + fr);
            if (t > LEFT - 3) {
#pragma unroll
                for (int kt = 0; kt < 4; ++kt)
#pragma unroll
                    for (int r = 0; r < 4; ++r) { const int dist = dbase - (16 * kt + 4 * fq + r); sT[kt][r] += bias[min(dist, 128) + 128]; }
            }
            s16x4 vlo[2][8], vhi[2][8];
            unsigned vcur[8];
#pragma unroll
            for (int d = 0; d < 8; ++d) vcur[d] = vadr[d] + pb;
#define TR8(dst, OFF) asm volatile("ds_read_b64_tr_b16 %0, %8 offset:" #OFF "\n\tds_read_b64_tr_b16 %1, %9 offset:" #OFF "\n\tds_read_b64_tr_b16 %2, %10 offset:" #OFF "\n\tds_read_b64_tr_b16 %3, %11 offset:" #OFF "\n\t" \
                "ds_read_b64_tr_b16 %4, %12 offset:" #OFF "\n\tds_read_b64_tr_b16 %5, %13 offset:" #OFF "\n\tds_read_b64_tr_b16 %6, %14 offset:" #OFF "\n\tds_read_b64_tr_b16 %7, %15 offset:" #OFF \
                : "=&v"(dst[0]), "=&v"(dst[1]), "=&v"(dst[2]), "=&v"(dst[3]), "=&v"(dst[4]), "=&v"(dst[5]), "=&v"(dst[6]), "=&v"(dst[7]) \
                : "v"(vcur[0]), "v"(vcur[1]), "v"(vcur[2]), "v"(vcur[3]), "v"(vcur[4]), "v"(vcur[5]), "v"(vcur[6]), "v"(vcur[7]) : "memory")
            TR8(vlo[0], 0); TR8(vhi[0], 4096); TR8(vlo[1], 8192); TR8(vhi[1], 12288);
#undef TR8
            float mx = -1e30f;
            const float badd = t <= LEFT - 3 ? bc : 0.f;
#pragma unroll
            for (int kt = 0; kt < 4; ++kt)
#pragma unroll
                for (int r = 0; r < 4; ++r) { sT[kt][r] += badd; mx = fmaxf(mx, sT[kt][r]); }
            mx = rowmax4(mx);
            const float mnew = fmaxf(mrun, mx), alpha = __builtin_amdgcn_exp2f(mrun - mnew); mrun = mnew;
            float ps = 0.f;
#pragma unroll
            for (int kt = 0; kt < 4; ++kt)
#pragma unroll
                for (int r = 0; r < 4; ++r) { sT[kt][r] = __builtin_amdgcn_exp2f(sT[kt][r] - mnew); ps += sT[kt][r]; }
            lrun = lrun * alpha + ps;
#pragma unroll
            for (int d = 0; d < 8; ++d) O[d] *= alpha;
            asm volatile("s_waitcnt lgkmcnt(0)" : "+v"(vlo[0][0]), "+v"(vlo[0][1]), "+v"(vlo[0][2]), "+v"(vlo[0][3]), "+v"(vlo[0][4]), "+v"(vlo[0][5]), "+v"(vlo[0][6]), "+v"(vlo[0][7]),
                         "+v"(vhi[0][0]), "+v"(vhi[0][1]), "+v"(vhi[0][2]), "+v"(vhi[0][3]), "+v"(vhi[0][4]), "+v"(vhi[0][5]), "+v"(vhi[0][6]), "+v"(vhi[0][7]) :: "memory");
            asm volatile("" : "+v"(vlo[1][0]), "+v"(vlo[1][1]), "+v"(vlo[1][2]), "+v"(vlo[1][3]), "+v"(vlo[1][4]), "+v"(vlo[1][5]), "+v"(vlo[1][6]), "+v"(vlo[1][7]),
                         "+v"(vhi[1][0]), "+v"(vhi[1][1]), "+v"(vhi[1][2]), "+v"(vhi[1][3]), "+v"(vhi[1][4]), "+v"(vhi[1][5]), "+v"(vhi[1][6]), "+v"(vhi[1][7]) :: "memory");
            __builtin_amdgcn_sched_barrier(0);
#pragma unroll
            for (int ks = 0; ks < 2; ++ks) {
                bf16x8 pb; { const unsigned p0 = pk2(sT[2 * ks][0], sT[2 * ks][1]), p1 = pk2(sT[2 * ks][2], sT[2 * ks][3]), p2 = pk2(sT[2 * ks + 1][0], sT[2 * ks + 1][1]), p3 = pk2(sT[2 * ks + 1][2], sT[2 * ks + 1][3]);
                    const u32x4 pw = (u32x4){p0, p1, p2, p3}; pb = __builtin_bit_cast(bf16x8, pw); }
#pragma unroll
                for (int d = 0; d < 8; ++d) { bf16x8 va; va[0] = vlo[ks][d][0]; va[1] = vlo[ks][d][1]; va[2] = vlo[ks][d][2]; va[3] = vlo[ks][d][3]; va[4] = vhi[ks][d][0]; va[5] = vhi[ks][d][1]; va[6] = vhi[ks][d][2]; va[7] = vhi[ks][d][3];
                    O[d] = MFMA16(va, pb, O[d]); }
            }
        }
        float lt = lrun; lt += __shfl_xor(lt, 16); lt += __shfl_xor(lt, 32);
        const float inv = 1.0f / lt;
        bf16* op = AOg + (tq0 + 16 * wq + fr) * DM + h * AHD + 4 * fq;
#pragma unroll
        for (int d = 0; d < 8; ++d) { u32x2 ow; ow.x = pk2(O[d][0] * inv, O[d][1] * inv); ow.y = pk2(O[d][2] * inv, O[d][3] * inv); *(u32x2*)(op + 16 * d) = ow; }
    }
}

constexpr int NSTEPS = 1 + 2 * 10 + 2 * 9;
template <int MASK> __global__ void __launch_bounds__(512, 2) yoco_fwd(Params p) {
    extern __shared__ __attribute__((aligned(16))) unsigned char lds_raw[];
#define MK_CTX() Ctx c; { int t_ = threadIdx.x; asm volatile("" : "+v"(t_)); c.lds = (LAS unsigned char*)lds_raw; c.tid = t_; c.lane = t_ & 63; c.wave = __builtin_amdgcn_readfirstlane(t_ >> 6); \
        { int b_ = blockIdx.x, g_ = gridDim.x; asm volatile("" : "+s"(b_), "+s"(g_)); c.bx = b_; c.G = g_; } c.gw = c.bx * 8 + c.wave; c.ngw = c.G * 8; }
    volatile LAS unsigned* MISC = (volatile LAS unsigned*)((LAS unsigned char*)lds_raw + LDS_MISC);
    if (threadIdx.x < 4) MISC[threadIdx.x] = 0u;
    __syncthreads();
    XcdBarrier bar; bar.bar = (unsigned*)(p.ws + WS_CTL); bar.x = 0; bar.st = MISC;
    if (p.hi - p.lo > 1) bar = xcd_barrier_post((unsigned*)(p.ws + WS_CTL), MISC);
    unsigned char* ws = p.ws;
    bf16* const H = (bf16*)(ws + WS_H); bf16* const HKV = (bf16*)(ws + WS_HKV);
    float* const X = p.out;
    int s = 0;
#ifndef REPMASK
#define REPMASK 0
#endif
#define KF_(f) p.f = kq_->f;
#define MK_P() Params p; { unsigned long long ka_ = (unsigned long long)__builtin_amdgcn_kernarg_segment_ptr(); asm volatile("" : "+s"(ka_)); const __attribute__((address_space(4))) Params* kq_ = (const __attribute__((address_space(4))) Params*)ka_; \
        KF_(x) KF_(ln_mix) KF_(ln_ffn) KF_(ret_w_in) KF_(ret_w_out) KF_(ret_gn) KF_(kv_norm) KF_(w_kv) KF_(att_w_q) KF_(att_w_o) KF_(att_rel_bias) KF_(peer_w_q) KF_(peer_sub_keys) KF_(peer_u) KF_(peer_v) KF_(ln_final) \
        KF_(out) KF_(ws) KF_(lo) KF_(hi) } \
        unsigned char* const ws = p.ws; bf16* const H = (bf16*)(ws + WS_H); bf16* const HKV = (bf16*)(ws + WS_HKV); float* const X = p.out; (void)H; (void)HKV; (void)X;
#define BEGIN_STEP(k) if (((MASK >> (k)) & 1) && s >= p.lo && s < p.hi) { for (int rep_ = ((REPMASK >> (k)) & 1) ? 0 : 1; rep_ < 2; ++rep_) { MK_CTX(); MK_P();
#define END_STEP   if (rep_ == 0 || s + 1 < p.hi) xcd_barrier(bar); } } ++s;

    BEGIN_STEP(0) p0_prologue(p, c); END_STEP

    for (int l = 0; l < DEPTH; ++l) {
        if (l < 2) {
            BEGIN_STEP(1)
                pg8::Gemm g{H, (const bf16*)(ws + WS_WIN) + (size_t)l * RIN * DM, NTOK, RIN, DM}; pg8::StaticOrder S; S.init(NTOK, RIN, c.G, c.bx);
                pg8::EpiProj E{(bf16*)(ws + WS_Q), (bf16*)(ws + WS_K), (bf16*)(ws + WS_V), (bf16*)(ws + WS_G), (const float*)(ws + WS_ROT)};
                pg8::gemm_phase<pg8::EpiProj, pg8::StaticOrder>(c.lds, g, S, E, nullptr);
            END_STEP
            BEGIN_STEP(2)
                for (int u = c.bx; u < 256; u += c.G) ret_scan_unit(c, (const bf16*)(ws + WS_Q), (const bf16*)(ws + WS_K), (const bf16*)(ws + WS_V), (bf16*)(ws + WS_O), u);
            END_STEP
            BEGIN_STEP(3)
                ret_gate_phase(c, (const bf16*)(ws + WS_O), (bf16*)(ws + WS_G), p.ret_gn + (size_t)l * RVW, rep_ == 0 ? (bf16*)(ws + WS_SC) : nullptr);
            END_STEP
        } else {
            BEGIN_STEP(4)
                for (int pass = (l == 2 ? 0 : 1); pass < 2; ++pass) {
                    const int N = pass ? DM : 2 * DM;
                    pg8::Gemm g{pass ? H : HKV, pass ? (const bf16*)(ws + WS_WQ) + (size_t)(l - 2) * DM * DM : (const bf16*)(ws + WS_WKV), NTOK, N, DM}; pg8::StaticOrder S; S.init(NTOK, N, c.G, c.bx);
                    pg8::EpiBf16S E{pass ? (bf16*)(ws + WS_Q) : (bf16*)(ws + WS_KV), N, pass ? 0.12751743082459868f : 1.0f};
                    pg8::gemm_phase<pg8::EpiBf16S, pg8::StaticOrder>(c.lds, g, S, E, nullptr);
                }
            END_STEP
            BEGIN_STEP(5)
#ifdef ATTNDRY
                attn_phase(c, (const bf16*)(ws + WS_Q), (const bf16*)(ws + WS_KV), rep_ == 0 ? (bf16*)(ws + WS_O) : (bf16*)(ws + WS_AO), p.att_rel_bias + (size_t)(l - 2) * AH * NREL, rep_ == 0 ? ATTNDRY : 0);
#else
                attn_phase(c, (const bf16*)(ws + WS_Q), (const bf16*)(ws + WS_KV), (bf16*)(ws + WS_AO), p.att_rel_bias + (size_t)(l - 2) * AH * NREL);
#endif
            END_STEP
        }
        BEGIN_STEP(6)
            const int K = l < 2 ? RVW : DM;
            pg8::Gemm g{l < 2 ? (const bf16*)(ws + WS_G) : (const bf16*)(ws + WS_AO), l < 2 ? (const bf16*)(ws + WS_WOUT) + (size_t)l * DM * RVW : (const bf16*)(ws + WS_WO) + (size_t)(l - 2) * DM * DM, NTOK, DM, K};
            pg8::StaticOrder S; S.init(NTOK, DM, c.G, c.bx);
            pg8::EpiRes E{X, DM, H, p.ln_ffn + (size_t)l * DM, (float*)(ws + WS_SQP)};
            pg8::gemm_phase<pg8::EpiRes, pg8::StaticOrder>(c.lds, g, S, E, nullptr);
        END_STEP
        BEGIN_STEP(8)
            pg8::Gemm g{H, (const bf16*)(ws + WS_WC) + (size_t)l * DM * DM, NTOK, DM, DM}; pg8::StaticOrder S; S.init(NTOK, DM, c.G, c.bx);
            pg8::EpiF32 E{(float*)(ws + WS_SC), DM};
            pg8::gemm_phase<pg8::EpiF32, pg8::StaticOrder>(c.lds, g, S, E, nullptr);
        END_STEP
        BEGIN_STEP(9)
            peer_topk_phase(c, (const float*)(ws + WS_SC), (int*)(ws + WS_IDX), (float*)(ws + WS_WGT), (const float*)(ws + WS_SQP), (float*)(ws + WS_RSTD));
        END_STEP
        BEGIN_STEP(10)
#ifdef DRYIDXMASK
            peer_u_phase(c, H, ws + WS_PU + (size_t)l * PE * DM, (const int*)(ws + WS_IDX), (float*)(ws + WS_SC), rep_ == 0 ? DRYIDXMASK : 0xffffffffu);
#else
            peer_u_phase(c, H, ws + WS_PU + (size_t)l * PE * DM, (const int*)(ws + WS_IDX), (float*)(ws + WS_SC));
#endif
        END_STEP
        BEGIN_STEP(11)
            peer_a_phase(c, (const float*)(ws + WS_SC), (const int*)(ws + WS_IDX), (float*)(ws + WS_WGT), (const float*)(ws + WS_RS) + (size_t)l * PE, (const float*)(ws + WS_RS) + (size_t)(DEPTH + l) * PE, (const float*)(ws + WS_RSTD));
        END_STEP
        BEGIN_STEP(12)
#ifdef VREF
            peer_v_ref_phase(c, ws + WS_PV + (size_t)l * PE * DM, (const int*)(ws + WS_IDX), (const float*)(ws + WS_WGT), X);
#else
            peer_v_phase(c, ws + WS_PV + (size_t)l * PE * DM, (const int*)(ws + WS_IDX), (const float*)(ws + WS_WGT), X);
#endif
        END_STEP
        BEGIN_STEP(13)
            const int mode = (l == DEPTH - 1) ? 2 : (l == 1 ? 1 : 0);
            norm_phase(c, X, mode, mode == 2 ? p.ln_final : p.ln_mix + (size_t)(l + 1) * DM, p.kv_norm, H, HKV);
        END_STEP
    }
#ifdef DIAGBUF
    if ((MASK >> 14) & 1) { MK_CTX(); diag_copy_phase(c, X, ws); }
#else
    if ((MASK >> 14) & 1) { MK_CTX(); MK_P(); rms_final_phase(c, X, p.ln_final); }
#endif
#undef BEGIN_STEP
#undef END_STEP
}

#ifndef N_LAUNCH_CUT
#define N_LAUNCH_CUT 1
#endif
typedef void (*kern_t)(Params);
template <int SITE> static void launch_site(const Params& p, hipStream_t stream) {
    static bool attr = false;
    if (!attr) { (void)hipFuncSetAttribute((const void*)yoco_fwd<(1 << SITE)>, hipFuncAttributeMaxDynamicSharedMemorySize, LDS_BYTES); attr = true; }
    hipLaunchKernelGGL((yoco_fwd<(1 << SITE)>), dim3(256), dim3(512), LDS_BYTES, stream, p);
}
#ifndef MEGASITES
#define MEGASITES 0
#endif
static void launch_step_site(int site, const Params& p, hipStream_t stream) {
    if ((MEGASITES >> site) & 1) { hipLaunchKernelGGL((yoco_fwd<0x3FFF>), dim3(256), dim3(512), LDS_BYTES, stream, p); return; }
    switch (site) {
        case 0: launch_site<0>(p, stream); break; case 1: launch_site<1>(p, stream); break; case 2: launch_site<2>(p, stream); break; case 3: launch_site<3>(p, stream); break;
        case 4: launch_site<4>(p, stream); break; case 5: launch_site<5>(p, stream); break; case 6: launch_site<6>(p, stream); break; case 7: launch_site<7>(p, stream); break;
        case 8: launch_site<8>(p, stream); break; case 9: launch_site<9>(p, stream); break; case 10: launch_site<10>(p, stream); break; case 11: launch_site<11>(p, stream); break; case 12: launch_site<12>(p, stream); break; case 13: launch_site<13>(p, stream); break; default: launch_site<14>(p, stream); break;
    }
}
extern "C" void kernel_launch(void* const* d_in, const int* in_sizes, int n_in, void* d_out, int out_size, void* d_ws, size_t ws_size, hipStream_t stream) {
    static int ready = 0;
    if (ready == 0) {
        if (n_in != 16 || out_size != NTOK * DM || ws_size < WS_END) { fprintf(stderr, "kernel_launch: unexpected sizes (n_in %d out %d ws %zu, need %zu)\n", n_in, out_size, ws_size, (size_t)WS_END); ready = -1; return; }
#if N_LAUNCH_CUT || MEGASITES
        if (hipFuncSetAttribute((const void*)yoco_fwd<0x3FFF>, hipFuncAttributeMaxDynamicSharedMemorySize, LDS_BYTES) != hipSuccess) { fprintf(stderr, "kernel_launch: hipFuncSetAttribute failed\n"); ready = -1; return; }
#endif
        ready = 1;
    }
    if (ready < 0) return;
    (void)hipMemsetAsync(d_ws, 0, 16384, stream);
    Params p{};
    p.x = (const float*)d_in[0]; p.ln_mix = (const float*)d_in[1]; p.ln_ffn = (const float*)d_in[2]; p.ret_w_in = (const float*)d_in[3]; p.ret_w_out = (const float*)d_in[4]; p.ret_gn = (const float*)d_in[5];
    p.kv_norm = (const float*)d_in[6]; p.w_kv = (const float*)d_in[7]; p.att_w_q = (const float*)d_in[8]; p.att_w_o = (const float*)d_in[9]; p.att_rel_bias = (const float*)d_in[10];
    p.peer_w_q = (const float*)d_in[11]; p.peer_sub_keys = (const float*)d_in[12]; p.peer_u = (const float*)d_in[13]; p.peer_v = (const float*)d_in[14]; p.ln_final = (const float*)d_in[15];
    p.out = (float*)d_out; p.ws = (unsigned char*)d_ws;
#if N_LAUNCH_CUT == 2
    for (int s2 = 0; s2 < NSTEPS; ++s2) { p.lo = s2; p.hi = s2 + 1; hipLaunchKernelGGL((yoco_fwd<0x3FFF>), dim3(256), dim3(512), LDS_BYTES, stream, p); }
#elif N_LAUNCH_CUT
    p.lo = 0; p.hi = NSTEPS;
    hipLaunchKernelGGL((yoco_fwd<0x3FFF>), dim3(256), dim3(512), LDS_BYTES, stream, p);
#else
    static const int siteA[10] = {1, 2, 3, 6, 8, 9, 10, 11, 12, 13}, siteB[9] = {4, 5, 6, 8, 9, 10, 11, 12, 13};
    int s = 0;
#ifndef NSTOP
#define NSTOP 1000
#endif
    p.lo = s; p.hi = s + 1; launch_step_site(0, p, stream); ++s;
    for (int l = 0; l < DEPTH; ++l) { const int n = l < 2 ? 10 : 9; for (int k = 0; k < n; ++k) { p.lo = s; p.hi = s + 1; if (s < NSTOP) launch_step_site(l < 2 ? siteA[k] : siteB[k], p, stream); ++s; } }
    if (NSTOP < NSTEPS) { p.lo = -1; p.hi = -1; launch_step_site(14, p, stream); }
#endif
}
```

```cpp
#include <hip/hip_runtime.h>
#include <cstdio>
#include <cstdint>

#define LAS __attribute__((address_space(3)))
#define GAS __attribute__((address_space(1)))
typedef unsigned short bf16;
typedef unsigned u32x2 __attribute__((ext_vector_type(2)));
typedef float f32x2v __attribute__((ext_vector_type(2)));

constexpr int DM = 2048, NBATCH = 4, SEQ = 4096, NTOK = NBATCH * SEQ, DEPTH = 4;
constexpr int CHUNK = 64, NCHUNK = SEQ / CHUNK;
constexpr int RH = 8, RQK = 256, RV = 512, RQKW = RH * RQK, RVW = RH * RV, RIN = 2 * RQKW + 2 * RVW;
constexpr int AH = 16, AHD = 128, LEFT = 8, NREL = 257;
constexpr int PH = 8, PNK = 128, PE = PNK * PNK, PTOPK = 16;
constexpr float EPS = 1e-6f;

constexpr size_t MiB = 1ull << 20;
constexpr size_t WS_CTL = 0, CTL_BYTES = 1 * MiB;
constexpr size_t WS_ROT = 1 * MiB;
constexpr size_t WS_RS = 6 * MiB;
constexpr size_t WS_WIN = 8 * MiB;
constexpr size_t WS_WOUT = 104 * MiB;
constexpr size_t WS_WKV = 136 * MiB;
constexpr size_t WS_WQ = 152 * MiB;
constexpr size_t WS_WO = 168 * MiB;
constexpr size_t WS_WC = 184 * MiB;
constexpr size_t WS_PU = 216 * MiB;
constexpr size_t WS_PV = 472 * MiB;
constexpr size_t WS_H = 728 * MiB;
constexpr size_t WS_HKV = 792 * MiB;
constexpr size_t WS_Q = 856 * MiB;
constexpr size_t WS_K = 920 * MiB;
constexpr size_t WS_V = 984 * MiB;
constexpr size_t WS_G = 1112 * MiB;
constexpr size_t WS_O = 1240 * MiB;
constexpr size_t WS_KV = 1368 * MiB;
constexpr size_t WS_AO = 1496 * MiB;
constexpr size_t WS_SC = 1560 * MiB;
constexpr size_t WS_IDX = 1688 * MiB;
constexpr size_t WS_WGT = 1696 * MiB;
constexpr size_t WS_SQP = 1704 * MiB;
constexpr size_t WS_RSTD = 1706 * MiB;
constexpr size_t WS_END = 1708 * MiB;

constexpr int LDS_BYTES = 160 * 1024;
constexpr int LDS_MISC = LDS_BYTES - 256;

__device__ __forceinline__ unsigned f2bf(float f) { unsigned u = __builtin_bit_cast(unsigned, f); return (u + 0x7fffu + ((u >> 16) & 1u)) >> 16; }
typedef __bf16 bfx2_t __attribute__((ext_vector_type(2)));
__device__ __forceinline__ unsigned pk2(float lo, float hi) { const f32x2v v = {lo, hi}; return __builtin_bit_cast(unsigned, __builtin_convertvector(v, bfx2_t)); }
__device__ __forceinline__ float bflo(unsigned u) { return __builtin_bit_cast(float, u << 16); }
__device__ __forceinline__ float bfhi(unsigned u) { return __builtin_bit_cast(float, u & 0xffff0000u); }
__device__ __forceinline__ float wave_sum(float v) {
#pragma unroll
    for (int o = 1; o < 64; o <<= 1) v += __shfl_xor(v, o);
    return v;
}
#define VM_WAIT() asm volatile("s_waitcnt vmcnt(0)" ::: "memory")
#define LDS_WAIT() asm volatile("s_waitcnt lgkmcnt(0)" ::: "memory")

#define XB_TMO      128
#define XB_XCNT(j)  (256  + 64 * (j))
#define XB_XSUB(j)  (1280 + 64 * (j))
#define XB_XGEN(j)  (2304 + 64 * (j))
#define XB_TOP      3328
#define XB_TOPGEN   3392
#define XCD_BAR_WORDS 3456
#define XB_SPIN_CAP (1u << 18)

__device__ __forceinline__ unsigned xb_ld(unsigned* p)              { return __hip_atomic_load(p, __ATOMIC_RELAXED, __HIP_MEMORY_SCOPE_AGENT); }
__device__ __forceinline__ unsigned xb_add(unsigned* p, unsigned v) { return __hip_atomic_fetch_add(p, v, __ATOMIC_RELAXED, __HIP_MEMORY_SCOPE_AGENT); }
__device__ __forceinline__ unsigned xb_xcc_id() { return (unsigned)__builtin_amdgcn_s_getreg((3 << 11) | 20) & 0xFu; }
#define XB_SPIN(cond, bar) do { unsigned _sp = 0; while (cond) { __builtin_amdgcn_s_sleep(1); \
    if ((++_sp & 255u) == 0u) { if (xb_ld(&(bar)[XB_TMO])) break; if (_sp > XB_SPIN_CAP) { atomicAdd(&(bar)[XB_TMO], 1u); break; } } } } while (0)

struct XcdBarrier {
    unsigned* bar; unsigned x;
    volatile LAS unsigned* st;
};

__device__ __forceinline__ XcdBarrier xcd_barrier_post(unsigned* bar, volatile LAS unsigned* st) {
    XcdBarrier b; b.bar = bar; b.x = xb_xcc_id(); b.st = st;
    if (threadIdx.x == 0) (void)xb_add(&bar[XB_XCNT(b.x)], 1u);
    return b;
}
__device__ __forceinline__ void xcd_barrier_complete(unsigned* bar, unsigned x, unsigned& nloc, unsigned& nx) {
    const unsigned G = gridDim.x * gridDim.y * gridDim.z;
    unsigned sum, cnt, mine, sp = 0u;
    for (;;) {
        sum = 0u; cnt = 0u; mine = 0u;
#pragma unroll
        for (unsigned j = 0; j < 16; ++j) { const unsigned c = xb_ld(&bar[XB_XCNT(j)]); sum += c; cnt += (c > 0u) ? 1u : 0u; mine = (j == x) ? c : mine; }
        if (sum == G) break;
        __builtin_amdgcn_s_sleep(1);
        if ((++sp & 255u) == 0u) { if (xb_ld(&bar[XB_TMO])) break; if (sp > XB_SPIN_CAP) { atomicAdd(&bar[XB_TMO], 1u); break; } }
    }
    nloc = mine > 0u ? mine : 1u; nx = cnt > 0u ? cnt : 1u;
}

__device__ __forceinline__ void xcd_barrier(const XcdBarrier& b) {
    asm volatile("s_waitcnt vmcnt(0)" ::: "memory");
    __syncthreads();
    if (threadIdx.x == 0) {
        unsigned* bar = b.bar;
        __builtin_amdgcn_s_waitcnt(0);
        unsigned nloc = b.st[0], nx = b.st[1];
        if (nloc == 0u) { xcd_barrier_complete(bar, b.x, nloc, nx); b.st[0] = nloc; b.st[1] = nx; }
        const unsigned old = xb_add(&bar[XB_XSUB(b.x)], 1u);
        const unsigned gen = old / nloc;
        if (old + 1u == (gen + 1u) * nloc) {
            __builtin_amdgcn_fence(__ATOMIC_RELEASE, "agent");
            asm volatile("s_waitcnt vmcnt(0)" ::: "memory");
            const unsigned og = xb_add(&bar[XB_TOP], 1u);
            const unsigned tg = og / nx;
            if (og + 1u == (tg + 1u) * nx) xb_add(&bar[XB_TOPGEN], 1u);
            else XB_SPIN(xb_ld(&bar[XB_TOPGEN]) == tg, bar);
            __builtin_amdgcn_fence(__ATOMIC_ACQUIRE, "agent");
            xb_add(&bar[XB_XGEN(b.x)], 1u);
            asm volatile("s_waitcnt vmcnt(0)" ::: "memory");
        } else {
            XB_SPIN(xb_ld(&bar[XB_XGEN(b.x)]) == gen, bar);
            __builtin_amdgcn_fence(__ATOMIC_ACQUIRE, "agent");
            asm volatile("s_waitcnt vmcnt(0)" ::: "memory");
        }
    }
    __syncthreads();
}

namespace pg8 {
#define PG8_LAS __attribute__((address_space(3)))
typedef unsigned short bf16_t;
typedef short bf16x8 __attribute__((ext_vector_type(8)));
typedef float f32x4 __attribute__((ext_vector_type(4)));
typedef unsigned u32x4 __attribute__((ext_vector_type(4)));
constexpr int BM = 256, BK = 64, HALF = 128, HTB = HALF * BK * 2  , STAGE_BYTES = 8 * HTB, NXCD = 8, WGM = 8;

__host__ __device__ __forceinline__ int lds_byte(int r, int c) { const int st = (r >> 4) * 2 + (c >> 5), rr = r & 15, cc = c & 31, ob = rr * 64 + cc * 2; return st * 1024 + (ob ^ (((ob >> 9) & 1) << 5)); }
__host__ __device__ __forceinline__ void stage_rc(int b, int& R, int& C) { const int st = b / 1024, sb = b % 1024, swz = sb ^ (((sb >> 9) & 1) << 5); R = (st >> 1) * 16 + swz / 64; C = (st & 1) * 32 + (swz % 64) / 2; }
__host__ __device__ __forceinline__ int perm32(int rho) { const int n = rho >> 4, i = rho & 15; return 8 * (i >> 2) + 4 * n + (i & 3); }

struct Unit { int pm, pn; };
struct Gemm { const bf16_t* A; const bf16_t* Bt; int M, N, K; };

struct StaticOrder {
    int nM, nN, nwg, G, c;
    __host__ __device__ void init(int M, int N, int G_, int c_) { nM = M / BM; nN = N / BM; nwg = nM * nN; G = G_; c = c_; }
    __host__ __device__ bool next(int i, Unit& u) const {
        const long L = (long)i * G + c; if (L >= nwg) return false;
        int wgid = (int)L; { const int q = nwg / NXCD, r = nwg % NXCD, xcd = wgid % NXCD, off = wgid / NXCD; wgid = (xcd < r ? xcd * (q + 1) : r * (q + 1) + (xcd - r) * q) + off; }
        const int nig = WGM * nN, gid = wgid / nig, fm = gid * WGM, gsz = (nM - fm) < WGM ? (nM - fm) : WGM;
        u.pm = fm + ((wgid % nig) % gsz); u.pn = (wgid % nig) / gsz; return true;
    }
    __device__ __forceinline__ void a_ready(const Unit&) const {}
    __device__ __forceinline__ void done(const Unit&) const {}
};
struct CountedOrder : StaticOrder {
    const unsigned* ready; unsigned need; unsigned* tmo;
    __device__ __forceinline__ void a_ready(const Unit& u) const {
        if (threadIdx.x < 64) {
            const unsigned long long t0 = __builtin_amdgcn_s_memrealtime(); unsigned polls = 0;
            while ((unsigned)__builtin_amdgcn_readfirstlane(__hip_atomic_load(ready + 64 * u.pm, __ATOMIC_RELAXED, __HIP_MEMORY_SCOPE_AGENT)) < need) {
                if ((++polls & 255u) == 0u && __builtin_amdgcn_readfirstlane(__hip_atomic_load(tmo, __ATOMIC_RELAXED, __HIP_MEMORY_SCOPE_AGENT)) != 0u) break;
                if (__builtin_amdgcn_s_memrealtime() - t0 > 2000000ull) {
                    if (threadIdx.x == 0) { unsigned expect = 0u; __hip_atomic_compare_exchange_strong(tmo + 1, &expect, 0x600u | (unsigned)(u.pm & 0xff), __ATOMIC_RELAXED, __ATOMIC_RELAXED, __HIP_MEMORY_SCOPE_AGENT); __hip_atomic_store(tmo, 1u, __ATOMIC_RELAXED, __HIP_MEMORY_SCOPE_AGENT); }
                    break; }
                __builtin_amdgcn_s_sleep(2); }
            __builtin_amdgcn_fence(__ATOMIC_ACQUIRE, "agent");
            asm volatile("s_waitcnt vmcnt(0)" ::: "memory");
        }
#if !defined(BROKEN_HOOK_NO_BARRIER)
        asm volatile("" ::: "memory"); __builtin_amdgcn_s_barrier(); asm volatile("" ::: "memory");
#endif
    }
};

__device__ __forceinline__ unsigned cvt_pk_bf16(float lo, float hi) { return pk2(lo, hi); }
typedef float f32x2 __attribute__((ext_vector_type(2)));
__device__ __forceinline__ f32x2 gelu_pk(f32x2 v) {
    const f32x2 av = __builtin_elementwise_abs(v), d = av * 0.2316418882f + 1.0f;
    f32x2 t; t.x = __builtin_amdgcn_rcpf(d.x); t.y = __builtin_amdgcn_rcpf(d.y);
    f32x2 q = t * 0.5307027145f + (-0.7265760135f); q = q * t + 0.7107068705f; q = q * t + (-0.142248368f); q = q * t + 0.127414796f; q = q * t;
    const f32x2 s = (v * v) * (-0.72134752044f);
    f32x2 e; e.x = __builtin_amdgcn_exp2f(s.x); e.y = __builtin_amdgcn_exp2f(s.y);
    const f32x2 m = v * (q * e), r = v - m;
    f32x2 o; o.x = v.x < 0.f ? m.x : r.x; o.y = v.y < 0.f ? m.y : r.y; return o;
}


struct EpiF32 {
    static constexpr bool PERM = false, AFTER_DRAIN = false;
    float* C; int ldc;
    __device__ __forceinline__ void operator()(const f32x4 (&acc)[2][2][4][2], const Unit& u, int wr, int wc, int fr, int fq) const {
        const int row0 = u.pm * BM + wr * 64 + fr, col0 = u.pn * BM + wc * 32 + 4 * fq;
#pragma unroll
        for (int ai = 0; ai < 2; ++ai)
#pragma unroll
            for (int m = 0; m < 4; ++m) { float* rowp = C + (size_t)(row0 + ai * HALF + m * 16) * ldc + col0;
#pragma unroll
                for (int bj = 0; bj < 2; ++bj)
#pragma unroll
                    for (int n = 0; n < 2; ++n) *(f32x4*)(rowp + bj * HALF + n * 16) = acc[ai][bj][m][n]; }
    }
};
struct EpiRes {
    static constexpr bool PERM = false, AFTER_DRAIN = false;
    float* X; int ldc; bf16_t* Hn; const float* gn; float* sqp;
    __device__ __forceinline__ void operator()(const f32x4 (&acc)[2][2][4][2], const Unit& u, int wr, int wc, int fr, int fq) const {
        const int row0 = u.pm * BM + wr * 64 + fr, col0 = u.pn * BM + wc * 32 + 4 * fq;
        f32x4 gv[2][2];
#pragma unroll
        for (int bj = 0; bj < 2; ++bj)
#pragma unroll
            for (int n = 0; n < 2; ++n) gv[bj][n] = *(const f32x4*)(gn + col0 + bj * HALF + n * 16);
#pragma unroll
        for (int ai = 0; ai < 2; ++ai) {
            f32x4 old[4][2][2];
#pragma unroll
            for (int m = 0; m < 4; ++m) { const float* rp = X + (size_t)(row0 + ai * HALF + m * 16) * ldc + col0;
#pragma unroll
                for (int bj = 0; bj < 2; ++bj)
#pragma unroll
                    for (int n = 0; n < 2; ++n) old[m][bj][n] = *(const f32x4*)(rp + bj * HALF + n * 16); }
#pragma unroll
            for (int m = 0; m < 4; ++m) { const int r = row0 + ai * HALF + m * 16; float* rowp = X + (size_t)r * ldc + col0; bf16_t* hp = Hn + (size_t)r * ldc + col0;
                float ss = 0.f;
#pragma unroll
                for (int bj = 0; bj < 2; ++bj)
#pragma unroll
                    for (int n = 0; n < 2; ++n) { const f32x4 xn = old[m][bj][n] + acc[ai][bj][m][n]; *(f32x4*)(rowp + bj * HALF + n * 16) = xn;
                        ss += (xn[0] * xn[0] + xn[1] * xn[1]) + (xn[2] * xn[2] + xn[3] * xn[3]);
                        const f32x4 hg = xn * gv[bj][n]; u32x2 hw; hw.x = pk2(hg[0], hg[1]); hw.y = pk2(hg[2], hg[3]); *(u32x2*)(hp + bj * HALF + n * 16) = hw; }
                ss += __shfl_xor(ss, 16); ss += __shfl_xor(ss, 32);
                if (fq == 0) sqp[(size_t)r * 32 + u.pn * 4 + wc] = ss; }
        }
    }
};
struct EpiBf16S {
    static constexpr bool PERM = true, AFTER_DRAIN = false;
    bf16_t* O; int ldc; float scale;
    __device__ __forceinline__ void operator()(const f32x4 (&acc)[2][2][4][2], const Unit& u, int wr, int wc, int fr, int fq) const {
        const int row0 = u.pm * BM + wr * 64 + fr, col0 = u.pn * BM + wc * 32 + 8 * fq;
#pragma unroll
        for (int ai = 0; ai < 2; ++ai)
#pragma unroll
            for (int m = 0; m < 4; ++m) { bf16_t* rowp = O + (size_t)(row0 + ai * HALF + m * 16) * ldc + col0;
#pragma unroll
                for (int bj = 0; bj < 2; ++bj) { const f32x4 v0 = acc[ai][bj][m][0] * scale, v1 = acc[ai][bj][m][1] * scale;
                    u32x4 w; w.x = cvt_pk_bf16(v0[0], v0[1]); w.y = cvt_pk_bf16(v0[2], v0[3]); w.z = cvt_pk_bf16(v1[0], v1[1]); w.w = cvt_pk_bf16(v1[2], v1[3]);
                    *(u32x4*)(rowp + bj * HALF) = w; } }
    }
};
struct EpiProj {
    static constexpr bool PERM = true, AFTER_DRAIN = false;
    bf16_t *Q, *Kp, *V, *G; const float* rot;
    __device__ __forceinline__ void operator()(const f32x4 (&acc)[2][2][4][2], const Unit& u, int wr, int wc, int fr, int fq) const {
        const int row0 = u.pm * BM + wr * 64 + fr, pn = u.pn, dd0 = wc * 32 + 8 * fq;
        if (pn < 16) {
            bf16_t* base = (pn < 8 ? Q : Kp) + (pn & 7) * 256 + dd0; const float sc = pn < 8 ? 1.0f : 0.0625f;
#pragma unroll
            for (int ai = 0; ai < 2; ++ai)
#pragma unroll
                for (int m = 0; m < 4; ++m) { const int r = row0 + ai * HALF + m * 16; const float* rt = rot + (size_t)(r & (4096 - 1)) * 256 + dd0;
                    f32x4 o1[2], o2[2];
#pragma unroll
                    for (int n = 0; n < 2; ++n) { const f32x4 cs = *(const f32x4*)(rt + 4 * n), sn = *(const f32x4*)(rt + 128 + 4 * n); const f32x4 t1 = acc[ai][0][m][n], t2 = acc[ai][1][m][n];
                        o1[n] = (t1 * cs - t2 * sn) * sc; o2[n] = (t1 * sn + t2 * cs) * sc; }
                    u32x4 w1, w2;
                    w1.x = cvt_pk_bf16(o1[0][0], o1[0][1]); w1.y = cvt_pk_bf16(o1[0][2], o1[0][3]); w1.z = cvt_pk_bf16(o1[1][0], o1[1][1]); w1.w = cvt_pk_bf16(o1[1][2], o1[1][3]);
                    w2.x = cvt_pk_bf16(o2[0][0], o2[0][1]); w2.y = cvt_pk_bf16(o2[0][2], o2[0][3]); w2.z = cvt_pk_bf16(o2[1][0], o2[1][1]); w2.w = cvt_pk_bf16(o2[1][2], o2[1][3]);
                    bf16_t* rowp = base + (size_t)r * 2048; *(u32x4*)rowp = w1; *(u32x4*)(rowp + 128) = w2; }
        } else {
            bf16_t* base = (pn < 32 ? V : G) + ((pn - 16) & 15) * 256 + dd0;
#pragma unroll
            for (int ai = 0; ai < 2; ++ai)
#pragma unroll
                for (int m = 0; m < 4; ++m) { bf16_t* rowp = base + (size_t)(row0 + ai * HALF + m * 16) * 4096;
#pragma unroll
                    for (int bj = 0; bj < 2; ++bj) { const f32x4 v0 = acc[ai][bj][m][0], v1 = acc[ai][bj][m][1];
                        u32x4 w; w.x = cvt_pk_bf16(v0[0], v0[1]); w.y = cvt_pk_bf16(v0[2], v0[3]); w.z = cvt_pk_bf16(v1[0], v1[1]); w.w = cvt_pk_bf16(v1[2], v1[3]);
                        *(u32x4*)(rowp + bj * HALF) = w; } }
        }
    }
};
template <class Epi, class Sched, bool STAMP = false>
__device__ __forceinline__ void gemm_phase(PG8_LAS unsigned char* lds, const Gemm g, const Sched& S, const Epi& E, unsigned long long* stamps) {
    int tid_ = threadIdx.x; asm volatile("" : "+v"(tid_));
    const int tid = tid_, wid = __builtin_amdgcn_readfirstlane(tid >> 6), lane = tid & 63, wr = wid >> 2, wc = wid & 3, fr = lane & 15, fq = lane >> 4;
    const int K = g.K, nt = K / BK;
    int ts_lo = 0, ts_hi = 0, nts = 0; const unsigned long long rt_entry = STAMP ? (unsigned long long)wall_clock64() : 0ull;
#define PG8_STAMP() do { if (STAMP && wid == 0 && nts < 64) { const unsigned long long _c = (unsigned long long)clock64(); \
        ts_lo = (lane == nts) ? (int)(unsigned)_c : ts_lo; ts_hi = (lane == nts) ? (int)(unsigned)(_c >> 32) : ts_hi; ++nts; } } while (0)
    PG8_STAMP();
    unsigned voffA[2], voffB[2];
#pragma unroll
    for (int i = 0; i < 2; ++i) { int R, C; stage_rc(tid * 16 + i * 8192, R, C); const int Rb = Epi::PERM ? ((R & ~31) + perm32(R & 31)) : R;
        voffA[i] = (unsigned)(R * K + C) * 2u; voffB[i] = (unsigned)(Rb * K + C) * 2u; }
    const size_t kstep = (size_t)(BK * 2);
    const size_t hstep = (size_t)HALF * K * 2;
    const size_t tstep = 2 * hstep;
    const unsigned ldsw = (unsigned)wid * 1024u;
    const int aoff = lds_byte(wr * 64 + fr, fq * 8), boff = lds_byte(wc * 32 + fr, fq * 8);
#define PG8_SA(b, h) (((b) * 2 + (h)) * HTB)
#define PG8_SB(b, h) ((4 + (b) * 2 + (h)) * HTB)
#define PG8_STAGE(bufoff, gbase, voff) do { _Pragma("unroll") for (int _i = 0; _i < 2; ++_i) \
        __builtin_amdgcn_global_load_lds((const unsigned*)((const char*)(gbase) + (voff)[_i]), (PG8_LAS unsigned*)(lds + (bufoff) + ldsw + _i * 8192), 16, 0, 0); } while (0)
#define PG8_LDA(dst, b, h) do { _Pragma("unroll") for (int m = 0; m < 4; ++m) _Pragma("unroll") for (int k = 0; k < 2; ++k) dst[m][k] = *(const PG8_LAS bf16x8*)(lds + PG8_SA(b, h) + aoff + m * 2048 + k * 1024); } while (0)
#define PG8_LDB(dst, b, h) do { _Pragma("unroll") for (int n = 0; n < 2; ++n) _Pragma("unroll") for (int k = 0; k < 2; ++k) dst[n][k] = *(const PG8_LAS bf16x8*)(lds + PG8_SB(b, h) + boff + n * 2048 + k * 1024); } while (0)
#define PG8_MMA(ai, bj, At, Bt) do { __builtin_amdgcn_s_setprio(1); _Pragma("unroll") for (int m = 0; m < 4; ++m) _Pragma("unroll") for (int n = 0; n < 2; ++n) _Pragma("unroll") for (int k = 0; k < 2; ++k) \
        acc[ai][bj][m][n] = __builtin_amdgcn_mfma_f32_16x16x32_bf16(Bt[n][k], At[m][k], acc[ai][bj][m][n], 0, 0, 0); __builtin_amdgcn_s_setprio(0); } while (0)
#define PG8_WAIT_V(n) asm volatile("s_waitcnt vmcnt(" #n ")" ::: "memory")
#define PG8_WAIT_L(n) asm volatile("s_waitcnt lgkmcnt(" #n ")" ::: "memory")
#define PG8_BAR __builtin_amdgcn_s_barrier()
#define PG8_SCHED __builtin_amdgcn_sched_barrier(0)
    Unit cur, nxt; int ui = 0;
    if (!S.next(0, cur)) return;
    f32x4 acc[2][2][4][2];
#pragma unroll
    for (int a = 0; a < 2; ++a)
#pragma unroll
        for (int b = 0; b < 2; ++b)
#pragma unroll
            for (int m = 0; m < 4; ++m)
#pragma unroll
                for (int n = 0; n < 2; ++n) acc[a][b][m][n] = (f32x4){0.f, 0.f, 0.f, 0.f};
    bf16x8 At[4][2], B0[2][2], B1[2][2];
    const char* cA = (const char*)g.A + (size_t)cur.pm * tstep; const char* cB = (const char*)g.Bt + (size_t)cur.pn * tstep;
    S.a_ready(cur);
    PG8_STAGE(PG8_SB(0, 0), cB, voffB); PG8_STAGE(PG8_SA(0, 0), cA, voffA); PG8_STAGE(PG8_SB(0, 1), cB + hstep, voffB); PG8_STAGE(PG8_SA(0, 1), cA + hstep, voffA);
    if (wr == 1) PG8_BAR;
    PG8_WAIT_V(4); PG8_BAR;
    PG8_STAGE(PG8_SB(1, 0), cB + kstep, voffB); PG8_STAGE(PG8_SA(1, 0), cA + kstep, voffA); PG8_STAGE(PG8_SB(1, 1), cB + hstep + kstep, voffB);
    PG8_WAIT_V(6); PG8_BAR;
    PG8_STAMP();
    for (;;) {
        const bool has_next = S.next(ui + 1, nxt);
        const char* nA = has_next ? (const char*)g.A + (size_t)nxt.pm * tstep : cA; const char* nB = has_next ? (const char*)g.Bt + (size_t)nxt.pn * tstep : cB;
        for (int t = 0; t < nt; t += 2) {
            const bool last = (t == nt - 2);
            const char* a1 = cA + (size_t)(t + 1) * kstep;
            const char* a2 = last ? nA : cA + (size_t)(t + 2) * kstep; const char* b2 = last ? nB : cB + (size_t)(t + 2) * kstep;
            const char* a3 = a2 + kstep; const char* b3 = b2 + kstep;
            if (last && has_next) S.a_ready(nxt);
            PG8_LDB(B0, 0, 0); PG8_SCHED; PG8_LDA(At, 0, 0); PG8_STAGE(PG8_SA(1, 1), a1 + hstep, voffA);
            PG8_WAIT_L(8); PG8_BAR; PG8_WAIT_L(0); PG8_MMA(0, 0, At, B0); PG8_BAR; PG8_SCHED;
            PG8_LDB(B1, 0, 1); PG8_STAGE(PG8_SB(0, 0), b2, voffB);
            PG8_BAR; PG8_WAIT_L(0); PG8_MMA(0, 1, At, B1); PG8_BAR;
            PG8_LDA(At, 0, 1); PG8_STAGE(PG8_SA(0, 0), a2, voffA);
            PG8_BAR; PG8_WAIT_L(0); PG8_MMA(1, 0, At, B0); PG8_BAR; PG8_SCHED;
            PG8_STAGE(PG8_SB(0, 1), b2 + hstep, voffB);
            PG8_WAIT_V(6); PG8_BAR; PG8_MMA(1, 1, At, B1); PG8_BAR;
            PG8_LDB(B0, 1, 0); PG8_SCHED; PG8_LDA(At, 1, 0); PG8_STAGE(PG8_SA(0, 1), a2 + hstep, voffA);
            PG8_WAIT_L(8); PG8_BAR; PG8_WAIT_L(0); PG8_MMA(0, 0, At, B0); PG8_BAR; PG8_SCHED;
            PG8_LDB(B1, 1, 1); PG8_STAGE(PG8_SB(1, 0), b3, voffB);
            PG8_BAR; PG8_WAIT_L(0); PG8_MMA(0, 1, At, B1); PG8_BAR;
            PG8_LDA(At, 1, 1); PG8_STAGE(PG8_SA(1, 0), a3, voffA);
            PG8_BAR; PG8_WAIT_L(0); PG8_MMA(1, 0, At, B0); PG8_BAR; PG8_SCHED;
            PG8_STAGE(PG8_SB(1, 1), b3 + hstep, voffB);
            PG8_WAIT_V(6); PG8_BAR; PG8_MMA(1, 1, At, B1); PG8_BAR;
        }
        PG8_STAMP();
        if constexpr (!Epi::AFTER_DRAIN) { E(acc, cur, wr, wc, fr, fq); S.done(cur); }
        PG8_STAMP();
        if (!has_next) break;
#pragma unroll
        for (int a = 0; a < 2; ++a)
#pragma unroll
            for (int b = 0; b < 2; ++b)
#pragma unroll
                for (int m = 0; m < 4; ++m)
#pragma unroll
                    for (int n = 0; n < 2; ++n) acc[a][b][m][n] = (f32x4){0.f, 0.f, 0.f, 0.f};
        cur = nxt; cA = nA; cB = nB; ++ui;
    }
    PG8_WAIT_V(0);
    if (wr == 0) PG8_BAR;
    PG8_BAR;
    if constexpr (Epi::AFTER_DRAIN) { E.fused(acc, cur, wr, wc, fr, fq, lds, wid, lane); S.done(cur); }
    PG8_STAMP();
    if (STAMP && wid == 0) { stamps[lane] = lane < nts ? (((unsigned long long)(unsigned)ts_hi << 32) | (unsigned)ts_lo) : 0ull;
        if (lane == 62) stamps[62] = rt_entry; if (lane == 63) stamps[63] = (unsigned long long)wall_clock64(); }
#undef PG8_STAMP
#undef PG8_SA
#undef PG8_SB
#undef PG8_STAGE
#undef PG8_LDA
#undef PG8_LDB
#undef PG8_MMA
#undef PG8_WAIT_V
#undef PG8_WAIT_L
#undef PG8_BAR
#undef PG8_SCHED
}
}

using pg8::bf16x8; using pg8::f32x4; using pg8::u32x4;
typedef short s16x4 __attribute__((ext_vector_type(4)));
typedef __bf16 bfx2 __attribute__((ext_vector_type(2)));

struct Params {
    const float *x, *ln_mix, *ln_ffn, *ret_w_in, *ret_w_out, *ret_gn, *kv_norm, *w_kv, *att_w_q, *att_w_o, *att_rel_bias, *peer_w_q, *peer_sub_keys, *peer_u, *peer_v, *ln_final;
    float* out; unsigned char* ws; int lo, hi;
};
struct Ctx { LAS unsigned char* lds; int tid, lane, wave, bx, G, gw, ngw; };

__device__ __forceinline__ float dot2bf(unsigned a, unsigned b, float c) { return __builtin_amdgcn_fdot2_f32_bf16(__builtin_bit_cast(bfx2, a), __builtin_bit_cast(bfx2, b), c, false); }
__device__ __forceinline__ bf16x8 lds128(LAS const unsigned char* p) { return *(LAS const bf16x8*)p; }
__device__ __forceinline__ bf16x8 tr_frag(unsigned a0, unsigned a1) {
    s16x4 lo, hi;
    asm volatile("ds_read_b64_tr_b16 %0, %2\n\tds_read_b64_tr_b16 %1, %3\n\ts_waitcnt lgkmcnt(0)" : "=&v"(lo), "=&v"(hi) : "v"(a0), "v"(a1) : "memory");
    bf16x8 r; r[0] = lo[0]; r[1] = lo[1]; r[2] = lo[2]; r[3] = lo[3]; r[4] = hi[0]; r[5] = hi[1]; r[6] = hi[2]; r[7] = hi[3]; return r;
}
#define MFMA16(a, b, c) __builtin_amdgcn_mfma_f32_16x16x32_bf16((a), (b), (c), 0, 0, 0)

__device__ __forceinline__ void load_row(const float* xrow, int lane, f32x4 (&v)[8]) {
    const f32x4* xr = (const f32x4*)xrow + lane;
#pragma unroll
    for (int j = 0; j < 8; ++j) v[j] = xr[64 * j];
}
__device__ __forceinline__ float row_rstd(const f32x4 (&v)[8]) {
    float s = 0.f;
#pragma unroll
    for (int j = 0; j < 8; ++j) s += (v[j][0] * v[j][0] + v[j][1] * v[j][1]) + (v[j][2] * v[j][2] + v[j][3] * v[j][3]);
    return 1.0f / sqrtf(wave_sum(s) * (1.0f / DM) + EPS);
}
__device__ __forceinline__ void store_norm_bf16(const f32x4 (&v)[8], float rstd, const float* g, bf16* orow, int lane) {
    const f32x4* gr = (const f32x4*)g + lane; u32x2* o8 = (u32x2*)orow + lane;
#pragma unroll
    for (int j = 0; j < 8; ++j) { const f32x4 gv = gr[64 * j]; u32x2 w; w.x = pk2(v[j][0] * rstd * gv[0], v[j][1] * rstd * gv[1]); w.y = pk2(v[j][2] * rstd * gv[2], v[j][3] * rstd * gv[3]); o8[64 * j] = w; }
}
__device__ __forceinline__ void load_g(const float* g, int lane, f32x4 (&gv)[8]) {
    const f32x4* gr = (const f32x4*)g + lane;
#pragma unroll
    for (int j = 0; j < 8; ++j) gv[j] = gr[64 * j];
}
__device__ __forceinline__ void store_norm_bf16_r(const f32x4 (&v)[8], float rstd, const f32x4 (&gv)[8], bf16* orow, int lane) {
    u32x2* o8 = (u32x2*)orow + lane;
#pragma unroll
    for (int j = 0; j < 8; ++j) { u32x2 w; w.x = pk2(v[j][0] * rstd * gv[j][0], v[j][1] * rstd * gv[j][1]); w.y = pk2(v[j][2] * rstd * gv[j][2], v[j][3] * rstd * gv[j][3]); o8[64 * j] = w; }
}
__device__ __forceinline__ unsigned q8pack(float a, float b, float c, float d) {
    const unsigned ua = __builtin_bit_cast(unsigned, a + 12582912.0f), ub = __builtin_bit_cast(unsigned, b + 12582912.0f), uc = __builtin_bit_cast(unsigned, c + 12582912.0f), ud = __builtin_bit_cast(unsigned, d + 12582912.0f);
    return (ua & 255u) | ((ub & 255u) << 8) | ((uc & 255u) << 16) | (ud << 24);
}

__device__ __forceinline__ void p0_transpose_item(const float* W, int K, int N, bf16* WT, LAS float* scr, int item, int lane) {
    const int nblk = N / 32, kb = item / nblk, nb = item % nblk, k0 = 64 * kb, n0 = 32 * nb;
    float tv[32];
#pragma unroll
    for (int i = 0; i < 32; ++i) { const int kk = 2 * i + (lane >> 5); tv[i] = W[(size_t)(k0 + kk) * N + n0 + (lane & 31)]; }
#pragma unroll
    for (int i = 0; i < 32; ++i) { const int kk = 2 * i + (lane >> 5); scr[kk * 33 + (lane & 31)] = tv[i]; }
    LDS_WAIT(); asm volatile("" ::: "memory");
    const int c = lane & 7;
#pragma unroll
    for (int j = 0; j < 4; ++j) { const int n = (lane >> 3) + 8 * j; const LAS float* s = scr + (8 * c) * 33 + n;
        u32x4 o; o.x = pk2(s[0 * 33], s[1 * 33]); o.y = pk2(s[2 * 33], s[3 * 33]); o.z = pk2(s[4 * 33], s[5 * 33]); o.w = pk2(s[6 * 33], s[7 * 33]);
        *(u32x4*)(WT + (size_t)(n0 + n) * K + k0 + 8 * c) = o; }
    LDS_WAIT(); asm volatile("" ::: "memory");
}
__device__ __forceinline__ void p0_fold_tile(const Params& p, const Ctx& c, int tl) {
    const int l = tl >> 9, hp = (tl >> 5) & 15, j0 = (tl & 31) * 64;
    LAS float* As = (LAS float*)c.lds;
    LAS float* Bs = (LAS float*)c.lds + 64 * 132;
    const float* Wq = p.peer_w_q + (size_t)l * DM * DM; const float* sk = p.peer_sub_keys + ((size_t)l * 2 + (hp & 1)) * PNK * 128;
    __syncthreads();
    for (int i = c.tid; i < 64 * 32; i += 512) { const int jj = i >> 5, d4 = i & 31; *(LAS f32x4*)(As + jj * 132 + d4 * 4) = *(const f32x4*)(Wq + (size_t)(j0 + jj) * DM + hp * 128 + d4 * 4); }
    for (int i = c.tid; i < 128 * 32; i += 512) { const int k = i >> 5, d4 = i & 31; *(LAS f32x4*)(Bs + k * 132 + d4 * 4) = *(const f32x4*)(sk + (size_t)k * 128 + d4 * 4); }
    __syncthreads();
    const int tj = c.tid & 15, tk = c.tid >> 4;
    float acc[4][4];
#pragma unroll
    for (int b = 0; b < 4; ++b)
#pragma unroll
        for (int a = 0; a < 4; ++a) acc[b][a] = 0.f;
    for (int d4 = 0; d4 < 32; ++d4) {
        f32x4 av[4], bv[4];
#pragma unroll
        for (int a = 0; a < 4; ++a) av[a] = *(LAS const f32x4*)(As + (tj + 16 * a) * 132 + d4 * 4);
#pragma unroll
        for (int b = 0; b < 4; ++b) bv[b] = *(LAS const f32x4*)(Bs + (tk * 4 + b) * 132 + d4 * 4);
#pragma unroll
        for (int b = 0; b < 4; ++b)
#pragma unroll
            for (int a = 0; a < 4; ++a) acc[b][a] += (av[a][0] * bv[b][0] + av[a][1] * bv[b][1]) + (av[a][2] * bv[b][2] + av[a][3] * bv[b][3]);
    }
    bf16* WcT = (bf16*)(p.ws + WS_WC) + (size_t)l * DM * DM;
#pragma unroll
    for (int b = 0; b < 4; ++b)
#pragma unroll
        for (int a = 0; a < 4; ++a) WcT[(size_t)(hp * 128 + tk * 4 + b) * DM + j0 + tj + 16 * a] = (bf16)f2bf(acc[b][a]);
}
__device__ __forceinline__ void p0_prologue(const Params& p, const Ctx& c) {
#ifndef PROREP
#define PROREP 0
#endif
    const bool fold_last = (c.bx & 1) != 0;
    if (!fold_last) {
    for (int tl = c.bx; tl < DEPTH * 16 * 32; tl += c.G) p0_fold_tile(p, c, tl);
    __syncthreads();
    }
    for (int rp_ = ((PROREP >> 1) & 1) ? 0 : 1; rp_ < 2; ++rp_)
    {
        LAS float* scr = (LAS float*)(c.lds + c.wave * 16384);
        constexpr int I_IN = (DM / 64) * (RIN / 32), I_OUT = (RVW / 64) * (DM / 32), I_KV = (DM / 64) * (2 * DM / 32), I_SQ = (DM / 64) * (DM / 32);
        constexpr int NITEMS = 2 * I_IN + 2 * I_OUT + I_KV + 4 * I_SQ;
        for (int it = c.gw; it < NITEMS; it += c.ngw) {
            int r = it;
            if (r < 2 * I_IN) { const int l = r / I_IN; p0_transpose_item(p.ret_w_in + (size_t)l * DM * RIN, DM, RIN, (bf16*)(p.ws + WS_WIN) + (size_t)l * RIN * DM, scr, r % I_IN, c.lane); continue; } r -= 2 * I_IN;
            if (r < 2 * I_OUT) { const int l = r / I_OUT; p0_transpose_item(p.ret_w_out + (size_t)l * RVW * DM, RVW, DM, (bf16*)(p.ws + WS_WOUT) + (size_t)l * DM * RVW, scr, r % I_OUT, c.lane); continue; } r -= 2 * I_OUT;
            if (r < I_KV) { p0_transpose_item(p.w_kv, DM, 2 * DM, (bf16*)(p.ws + WS_WKV), scr, r, c.lane); continue; } r -= I_KV;
            if (r < 2 * I_SQ) { const int l = r / I_SQ; p0_transpose_item(p.att_w_q + (size_t)l * DM * DM, DM, DM, (bf16*)(p.ws + WS_WQ) + (size_t)l * DM * DM, scr, r % I_SQ, c.lane); continue; } r -= 2 * I_SQ;
            { const int l = r / I_SQ; p0_transpose_item(p.att_w_o + (size_t)l * DM * DM, DM, DM, (bf16*)(p.ws + WS_WO) + (size_t)l * DM * DM, scr, r % I_SQ, c.lane); }
        }
    }
    for (int rp_ = ((PROREP >> 2) & 1) ? 0 : 1; rp_ < 2; ++rp_)
    {
        float* rs = (float*)(p.ws + WS_RS);
        for (int row = c.gw; row < 2 * DEPTH * PE; row += c.ngw) {
            const int which = row >= DEPTH * PE, r = row - which * DEPTH * PE;
            f32x4 v[8]; load_row((which ? p.peer_v : p.peer_u) + (size_t)r * DM, c.lane, v);
            float am = 0.f;
#pragma unroll
            for (int j = 0; j < 8; ++j) am = fmaxf(fmaxf(am, fmaxf(fabsf(v[j][0]), fabsf(v[j][1]))), fmaxf(fabsf(v[j][2]), fabsf(v[j][3])));
#pragma unroll
            for (int o = 1; o < 64; o <<= 1) am = fmaxf(am, __shfl_xor(am, o));
            int e = (int)((__builtin_bit_cast(unsigned, am) >> 23) & 0xffu) - 127; if (am == 0.f) e = 7;
            int k = 7 - e; k = k < -100 ? -100 : (k > 100 ? 100 : k);
            const float sc = __builtin_bit_cast(float, (unsigned)(k + 127) << 23), rsc = __builtin_bit_cast(float, (unsigned)(127 - k) << 23);
            const int lyr = r / PE, re = r % PE;
            unsigned char* dstb = p.ws + (which ? WS_PV : WS_PU) + (size_t)lyr * PE * DM + (size_t)re * 128;
            if (which) {
#pragma unroll
                for (int j = 0; j < 8; ++j) { int w = 0; w = __builtin_amdgcn_cvt_pk_fp8_f32(v[j][0] * sc, v[j][1] * sc, w, false); w = __builtin_amdgcn_cvt_pk_fp8_f32(v[j][2] * sc, v[j][3] * sc, w, true); { const int col = 4 * c.lane + 256 * j; *(unsigned*)(dstb + (size_t)(col >> 7) * PE * 128 + (col & 127)) = (unsigned)w; } }
                if (c.lane == 0) rs[row] = rsc;
            } else {
                const float s8 = am > 0.f ? 127.0f / am : 0.f;
#pragma unroll
                for (int j = 0; j < 8; ++j) { const unsigned w = q8pack(v[j][0] * s8, v[j][1] * s8, v[j][2] * s8, v[j][3] * s8); const int col = 4 * c.lane + 256 * j; *(unsigned*)(dstb + (size_t)(col >> 7) * PE * 128 + (col & 127)) = w; }
                if (c.lane == 0) rs[row] = am * (1.0f / 127.0f);
            }
        }
    }
    for (int rp_ = ((PROREP >> 3) & 1) ? 0 : 1; rp_ < 2; ++rp_)
    {
        float* rot = (float*)(p.ws + WS_ROT);
        for (int i = c.bx * 512 + c.tid; i < SEQ * 128; i += c.G * 512) { const int pos = i >> 7, d = i & 127;
            const float inv = (float)(1.0 / pow(10000.0, (double)d / 128.0)); const float ang = (float)pos * inv;
            rot[(size_t)pos * 256 + d] = (float)cos((double)ang); rot[(size_t)pos * 256 + 128 + d] = (float)sin((double)ang); }
    }
    for (int rp_ = ((PROREP >> 4) & 1) ? 0 : 1; rp_ < 2; ++rp_)
    { f32x4 gv[8]; load_g(p.ln_mix, c.lane, gv);
      for (int m = c.gw; m < NTOK; m += c.ngw) {
        f32x4 v[8]; load_row(p.x + (size_t)m * DM, c.lane, v);
        f32x4* xo = (f32x4*)(p.out + (size_t)m * DM) + c.lane;
#pragma unroll
        for (int j = 0; j < 8; ++j) xo[64 * j] = v[j];
        store_norm_bf16_r(v, row_rstd(v), gv, (bf16*)(p.ws + WS_H) + (size_t)m * DM, c.lane);
      } }
    if (fold_last) {
    __syncthreads();
    for (int tl = c.bx; tl < DEPTH * 16 * 32; tl += c.G) p0_fold_tile(p, c, tl);
    __syncthreads();
    }
}

constexpr int RS_QS = 0, RS_KS = 33792, RS_VS = 67584, RS_VZ = 76800, RS_PS = 86016, RS_RS = 95232, RS_END = 129024, QK_STR = 528, V_STR = 144;
__device__ __forceinline__ void ret_scan_unit(const Ctx& c, const bf16* Qg, const bf16* Kg, const bf16* Vg, bf16* Og, int unit) {
    const int xg = unit & 7, slot = unit >> 3, pair = xg * 4 + (slot >> 3), es = slot & 7, b = pair >> 3, h = pair & 7;
    const int tid = c.tid, lane = c.lane, w = c.wave, fr = lane & 15, fq = lane >> 4, tq = (lane & 15) >> 2, tp = lane & 3;
    LAS unsigned char* lds = c.lds;
    const float lgam = log1pf(-exp2f(-5.0f - (float)h));
    const float cdec = expf(lgam * 64.0f);
    const int lrow = tid >> 3, lch = tid & 7;
    const size_t tok0 = (size_t)b * SEQ;
    const bf16* qrow = Qg + (tok0 + lrow) * RQKW + h * RQK + lch * 8;
    const bf16* krow = Kg + (tok0 + lrow) * RQKW + h * RQK + lch * 8;
    const bf16* vrow = Vg + (tok0 + lrow) * RVW + h * RV + es * 64 + lch * 8;
    const float zeta = expf(lgam * (float)(63 - lrow));
    u32x4 pq[4], pk[4], pv;
#pragma unroll
    for (int cc = 0; cc < 4; ++cc) { pq[cc] = *(const u32x4*)(qrow + cc * 64); pk[cc] = *(const u32x4*)(krow + cc * 64); }
    pv = *(const u32x4*)vrow;
    __syncthreads();
    for (int i = tid; i < (RS_END - RS_RS) / 16; i += 512) *(LAS u32x4*)(lds + RS_RS + i * 16) = (u32x4){0u, 0u, 0u, 0u};
    f32x4 Racc[2][4];
#pragma unroll
    for (int x = 0; x < 2; ++x)
#pragma unroll
        for (int y = 0; y < 4; ++y) Racc[x][y] = (f32x4){0.f, 0.f, 0.f, 0.f};
    const int jt = w & 3, it0 = 2 * (w >> 2);
    const int it = w & 3, et0 = 2 * (w >> 2);
    float xi[4];
#pragma unroll
    for (int r = 0; r < 4; ++r) xi[r] = expf(lgam * (float)(16 * it + 4 * fq + r + 1));
    const unsigned ldsb = (unsigned)(size_t)lds;
    float dmask[2][4];
#pragma unroll
    for (int x = 0; x < 2; ++x)
#pragma unroll
        for (int r = 0; r < 4; ++r) { const int i = 16 * (it0 + x) + fr, j = 16 * jt + 4 * fq + r; dmask[x][r] = (i >= j) ? expf(lgam * (float)(i - j)) : 0.f; }
    asm volatile("" : "+v"(dmask[0][0]), "+v"(dmask[0][1]), "+v"(dmask[0][2]), "+v"(dmask[0][3]), "+v"(dmask[1][0]), "+v"(dmask[1][1]), "+v"(dmask[1][2]), "+v"(dmask[1][3]));
    for (int n = 0; n < NCHUNK; ++n) {
        __syncthreads();
#pragma unroll
        for (int cc = 0; cc < 4; ++cc) { *(LAS u32x4*)(lds + RS_QS + lrow * QK_STR + (lch + 8 * cc) * 16) = pq[cc]; *(LAS u32x4*)(lds + RS_KS + lrow * QK_STR + (lch + 8 * cc) * 16) = pk[cc]; }
        *(LAS u32x4*)(lds + RS_VS + lrow * V_STR + lch * 16) = pv;
        { u32x4 z; z.x = pk2(bflo(pv.x) * zeta, bfhi(pv.x) * zeta); z.y = pk2(bflo(pv.y) * zeta, bfhi(pv.y) * zeta); z.z = pk2(bflo(pv.z) * zeta, bfhi(pv.z) * zeta); z.w = pk2(bflo(pv.w) * zeta, bfhi(pv.w) * zeta);
          *(LAS u32x4*)(lds + RS_VZ + lrow * V_STR + lch * 16) = z; }
        __syncthreads();
        if (n + 1 < NCHUNK) {
            const size_t adv = (size_t)(n + 1) * CHUNK;
#pragma unroll
            for (int cc = 0; cc < 4; ++cc) { pq[cc] = *(const u32x4*)(qrow + adv * RQKW + cc * 64); pk[cc] = *(const u32x4*)(krow + adv * RQKW + cc * 64); }
            pv = *(const u32x4*)(vrow + adv * RVW);
        }
        {
            f32x4 s0 = (f32x4){0.f, 0.f, 0.f, 0.f}, s1 = s0;
#pragma unroll
            for (int kh = 0; kh < 2; ++kh) {
                bf16x8 fa[4], fb0[4], fb1[4];
#pragma unroll
                for (int k4 = 0; k4 < 4; ++k4) { const int ks = 4 * kh + k4;
                    fa[k4] = lds128(lds + RS_KS + (16 * jt + fr) * QK_STR + (4 * ks + fq) * 16);
                    fb0[k4] = lds128(lds + RS_QS + (16 * it0 + fr) * QK_STR + (4 * ks + fq) * 16);
                    fb1[k4] = lds128(lds + RS_QS + (16 * (it0 + 1) + fr) * QK_STR + (4 * ks + fq) * 16); }
                __builtin_amdgcn_sched_barrier(0);
#pragma unroll
                for (int k4 = 0; k4 < 4; ++k4) { s0 = MFMA16(fa[k4], fb0[k4], s0); s1 = MFMA16(fa[k4], fb1[k4], s1); }
            }
#pragma unroll
            for (int x = 0; x < 2; ++x) { const f32x4 s = x ? s1 : s0; const int i = 16 * (it0 + x) + fr; float pr[4];
#pragma unroll
                for (int r = 0; r < 4; ++r) pr[r] = s[r] * dmask[x][r];
                u32x2 pw; pw.x = pk2(pr[0], pr[1]); pw.y = pk2(pr[2], pr[3]);
                *(LAS u32x2*)(lds + RS_PS + i * V_STR + (16 * jt + 4 * fq) * 2) = pw; }
        }
        f32x4 o0 = (f32x4){0.f, 0.f, 0.f, 0.f}, o1 = o0;
        {
#pragma unroll
            for (int kh = 0; kh < 2; ++kh) {
                bf16x8 fa[4], fb0[4], fb1[4];
#pragma unroll
                for (int k4 = 0; k4 < 4; ++k4) { const int ks = 4 * kh + k4;
                    fa[k4] = lds128(lds + RS_QS + (16 * it + fr) * QK_STR + (4 * ks + fq) * 16);
                    fb0[k4] = lds128(lds + RS_RS + (16 * et0 + fr) * QK_STR + (4 * ks + fq) * 16);
                    fb1[k4] = lds128(lds + RS_RS + (16 * (et0 + 1) + fr) * QK_STR + (4 * ks + fq) * 16); }
                __builtin_amdgcn_sched_barrier(0);
#pragma unroll
                for (int k4 = 0; k4 < 4; ++k4) { o0 = MFMA16(fa[k4], fb0[k4], o0); o1 = MFMA16(fa[k4], fb1[k4], o1); }
            }
        }
#pragma unroll
        for (int r = 0; r < 4; ++r) { o0[r] *= xi[r]; o1[r] *= xi[r]; }
        __syncthreads();
#pragma unroll
        for (int ks = 0; ks < 2; ++ks) {
            const bf16x8 a = lds128(lds + RS_PS + (16 * it + fr) * V_STR + (4 * ks + fq) * 16);
            const unsigned va = ldsb + RS_VS + (32 * ks + 8 * fq + tq) * V_STR + 8 * tp;
            const bf16x8 b0 = tr_frag(va + 32 * et0, va + 4 * V_STR + 32 * et0);
            const bf16x8 b1 = tr_frag(va + 32 * (et0 + 1), va + 4 * V_STR + 32 * (et0 + 1));
            __builtin_amdgcn_sched_barrier(0);
            o0 = MFMA16(a, b0, o0); o1 = MFMA16(a, b1, o1);
        }
        {
            bf16* op = Og + (tok0 + (size_t)n * CHUNK + 16 * it + 4 * fq) * RVW + h * RV + es * 64 + 16 * et0 + fr;
#pragma unroll
            for (int r = 0; r < 4; ++r) { op[(size_t)r * RVW] = (bf16)f2bf(o0[r]); op[(size_t)r * RVW + 16] = (bf16)f2bf(o1[r]); }
        }
#pragma unroll
        for (int x = 0; x < 2; ++x)
#pragma unroll
            for (int y = 0; y < 4; ++y) Racc[x][y] *= cdec;
#pragma unroll
        for (int ks = 0; ks < 2; ++ks) {
            const unsigned ka = ldsb + RS_KS + (32 * ks + 8 * fq + tq) * QK_STR + 8 * tp;
            const unsigned za = ldsb + RS_VZ + (32 * ks + 8 * fq + tq) * V_STR + 8 * tp;
            bf16x8 ak[2], bz[4];
#pragma unroll
            for (int x = 0; x < 2; ++x) ak[x] = tr_frag(ka + 32 * (2 * w + x), ka + 4 * QK_STR + 32 * (2 * w + x));
#pragma unroll
            for (int y = 0; y < 4; ++y) bz[y] = tr_frag(za + 32 * y, za + 4 * V_STR + 32 * y);
            __builtin_amdgcn_sched_barrier(0);
#pragma unroll
            for (int x = 0; x < 2; ++x)
#pragma unroll
                for (int y = 0; y < 4; ++y) Racc[x][y] = MFMA16(ak[x], bz[y], Racc[x][y]);
        }
#pragma unroll
        for (int x = 0; x < 2; ++x)
#pragma unroll
            for (int y = 0; y < 4; ++y) { u32x2 rw; rw.x = pk2(Racc[x][y][0], Racc[x][y][1]); rw.y = pk2(Racc[x][y][2], Racc[x][y][3]);
                *(LAS u32x2*)(lds + RS_RS + (16 * y + fr) * QK_STR + (16 * (2 * w + x) + 4 * fq) * 2) = rw; }
    }
}

template <int CTRL> __device__ __forceinline__ float dpp_f(float x) { return __builtin_bit_cast(float, __builtin_amdgcn_mov_dpp(__builtin_bit_cast(int, x), CTRL, 0xF, 0xF, true)); }
__device__ __forceinline__ float sum8(float x) { x += dpp_f<0xB1>(x); x += dpp_f<0x4E>(x); x += dpp_f<0x141>(x); return x; }
__device__ __forceinline__ void ret_gate_phase(const Ctx& c, const bf16* Og, bf16* Gg, const float* gn, bf16* Zout = nullptr) {
    const int col0 = 512 * (c.lane >> 3) + 8 * (c.lane & 7);
    f32x4 gw[16];
#pragma unroll
    for (int j = 0; j < 8; ++j) { gw[2 * j] = *(const f32x4*)(gn + col0 + 64 * j); gw[2 * j + 1] = *(const f32x4*)(gn + col0 + 64 * j + 4); }
    u32x4 ovn[8];
    if (c.gw < NTOK) { const bf16* orow = Og + (size_t)c.gw * RVW + col0;
#pragma unroll
        for (int j = 0; j < 8; ++j) ovn[j] = *(const u32x4*)(orow + 64 * j); }
    for (int m = c.gw; m < NTOK; m += c.ngw) {
        u32x4 gv[8], ov[8];
        { const bf16* grow = Gg + (size_t)m * RVW + col0;
#pragma unroll
          for (int j = 0; j < 8; ++j) { gv[j] = *(const u32x4*)(grow + 64 * j); ov[j] = ovn[j]; } }
        { const int mn = m + c.ngw < NTOK ? m + c.ngw : m; const bf16* orow = Og + (size_t)mn * RVW + col0;
#pragma unroll
          for (int j = 0; j < 8; ++j) ovn[j] = *(const u32x4*)(orow + 64 * j); }
        float s1 = 0.f;
#pragma unroll
        for (int j = 0; j < 8; ++j) { const u32x4 t = ov[j];
            s1 += ((bflo(t.x) + bfhi(t.x)) + (bflo(t.y) + bfhi(t.y))) + ((bflo(t.z) + bfhi(t.z)) + (bflo(t.w) + bfhi(t.w))); }
        const float mu = sum8(s1) * (1.0f / RV);
        asm volatile("" : "+v"(ov[0]), "+v"(ov[1]), "+v"(ov[2]), "+v"(ov[3]), "+v"(ov[4]), "+v"(ov[5]), "+v"(ov[6]), "+v"(ov[7]));
        float s2 = 0.f;
#pragma unroll
        for (int j = 0; j < 8; ++j) { const u32x4 t = ov[j];
            const float d[8] = {bflo(t.x) - mu, bfhi(t.x) - mu, bflo(t.y) - mu, bfhi(t.y) - mu, bflo(t.z) - mu, bfhi(t.z) - mu, bflo(t.w) - mu, bfhi(t.w) - mu};
            float q = 0.f;
#pragma unroll
            for (int k = 0; k < 8; ++k) q += d[k] * d[k];
            s2 += q; }
        const float rstd = 1.0f / sqrtf(sum8(s2) * (1.0f / RV) + EPS);
        asm volatile("" : "+v"(ov[0]), "+v"(ov[1]), "+v"(ov[2]), "+v"(ov[3]), "+v"(ov[4]), "+v"(ov[5]), "+v"(ov[6]), "+v"(ov[7]));
        bf16* zrow = (Zout ? Zout : Gg) + (size_t)m * RVW + col0;
#pragma unroll
        for (int j = 0; j < 8; ++j) {
            const float gg[8] = {gw[2 * j][0], gw[2 * j][1], gw[2 * j][2], gw[2 * j][3], gw[2 * j + 1][0], gw[2 * j + 1][1], gw[2 * j + 1][2], gw[2 * j + 1][3]};
            const u32x4 t = gv[j], u = ov[j];
            const float g[8] = {bflo(t.x), bfhi(t.x), bflo(t.y), bfhi(t.y), bflo(t.z), bfhi(t.z), bflo(t.w), bfhi(t.w)};
            const float o[8] = {bflo(u.x), bfhi(u.x), bflo(u.y), bfhi(u.y), bflo(u.z), bfhi(u.z), bflo(u.w), bfhi(u.w)};
            float z[8];
#pragma unroll
            for (int k = 0; k < 8; ++k) { const float y = (o[k] - mu) * rstd * gg[k]; z[k] = g[k] * __builtin_amdgcn_rcpf(1.0f + __builtin_amdgcn_exp2f(-1.4426950408889634f * g[k])) * y; }
            u32x4 zw; zw.x = pk2(z[0], z[1]); zw.y = pk2(z[2], z[3]); zw.z = pk2(z[4], z[5]); zw.w = pk2(z[6], z[7]);
            *(u32x4*)(zrow + 64 * j) = zw;
        }
    }
}

__device__ __forceinline__ void rms_phase(const Ctx& c, const float* X, const float* g, bf16* H) {
    for (int m = c.gw; m < NTOK; m += c.ngw) { f32x4 v[8]; load_row(X + (size_t)m * DM, c.lane, v); store_norm_bf16(v, row_rstd(v), g, H + (size_t)m * DM, c.lane); }
}

__device__ __forceinline__ int fkey(float f) { const int i = __builtin_bit_cast(int, f); return i ^ ((i >> 31) & 0x7fffffff); }
__device__ __forceinline__ float kval(int k) { return __builtin_bit_cast(float, k ^ ((k >> 31) & 0x7fffffff)); }
__device__ __forceinline__ int med3i(int a, int b, int c) { int r; asm("v_med3_i32 %0, %1, %2, %3" : "=v"(r) : "v"(a), "v"(b), "v"(c)); return r; }
#define INS16(L, key) do { const int _k = (key); _Pragma("unroll") for (int _q = 15; _q >= 1; --_q) L[_q] = med3i(L[_q - 1], L[_q], _k); L[0] = max(L[0], _k); } while (0)
constexpr int TK_LIST = 544, TK_HALF = 272, TK_KEYS = 256 * TK_LIST;
__device__ __forceinline__ void peer_topk_phase(const Ctx& c, const float* SC, int* IDX, float* WGT, const float* SQP, float* RSTD) {
    LAS unsigned char* lds = c.lds;
    u32x4 pre[16];
    if (c.bx < NTOK / 16) { const u32x4* src = (const u32x4*)(SC + (size_t)c.bx * 16 * DM);
#pragma unroll
        for (int i = 0; i < 16; ++i) pre[i] = src[c.tid + 512 * i]; }
    for (int tile = c.bx; tile < NTOK / 16; tile += c.G) {
        __syncthreads();
#pragma unroll
        for (int i = 0; i < 16; ++i) { const int g = c.tid + 512 * i; *(LAS u32x4*)(lds + (g >> 5) * TK_LIST + ((g >> 4) & 1) * TK_HALF + (g & 15) * 16) = pre[i]; }
        if (tile + c.G < NTOK / 16) { const u32x4* src = (const u32x4*)(SC + (size_t)(tile + c.G) * 16 * DM);
#pragma unroll
            for (int i = 0; i < 16; ++i) pre[i] = src[c.tid + 512 * i]; }
        __syncthreads();
        {
            const int lst = c.tid >> 1, hf = c.tid & 1;
            int L[16];
#pragma unroll
            for (int q = 0; q < 16; ++q) L[q] = (int)0x80000000;
            LAS unsigned char* lp = lds + lst * TK_LIST + hf * TK_HALF;
#pragma unroll 2
            for (int g = 0; g < 16; ++g) { const f32x4 v = *(LAS const f32x4*)(lp + g * 16);
#pragma unroll
                for (int e = 0; e < 4; ++e) INS16(L, (fkey(v[e]) & ~127) | (hf * 64 + g * 4 + e)); }
            if (hf) {
#pragma unroll
                for (int q = 0; q < 16; ++q) ((LAS int*)lp)[q] = L[q]; }
            __syncthreads();
            if (!hf) { LAS const int* op = (LAS const int*)(lp + TK_HALF);
#pragma unroll
                for (int q = 0; q < 16; ++q) INS16(L, op[q]);
                LAS int* kp = (LAS int*)(lds + TK_KEYS) + lst * 16;
#pragma unroll
                for (int q = 0; q < 16; ++q) kp[q] = L[q]; }
        }
        __syncthreads();
        if (c.tid < 128) {
            LAS const int* k1 = (LAS const int*)(lds + TK_KEYS) + (c.tid * 2) * 16; LAS const int* k2 = k1 + 16;
            float v1[16], v2[16];
#pragma unroll
            for (int q = 0; q < 16; ++q) { v1[q] = kval(k1[q] & ~127); v2[q] = kval(k2[q] & ~127); }
            int L[16];
#pragma unroll
            for (int q = 0; q < 16; ++q) L[q] = (fkey(v1[0] + v2[q]) & ~255) | q;
#pragma unroll
            for (int i = 1; i < 16; ++i)
#pragma unroll
                for (int j = 0; j < 16; ++j) if ((i + 1) * (j + 1) <= 16) INS16(L, (fkey(v1[i] + v2[j]) & ~255) | (i * 16 + j));
            const int tt = c.tid >> 3, hh = c.tid & 7; const size_t ob0 = ((size_t)tile * 16 + tt) * 128;
            float rstd; { const f32x4* sp = (const f32x4*)(SQP + ((size_t)tile * 16 + tt) * 32); f32x4 a4 = sp[0];
#pragma unroll
              for (int q = 1; q < 8; ++q) a4 += sp[q];
              rstd = 1.0f / sqrtf(((a4[0] + a4[1]) + (a4[2] + a4[3])) * (1.0f / DM) + EPS); }
            if (hh == 0) RSTD[(size_t)tile * 16 + tt] = rstd;
            const float m0 = kval(L[0] & ~255); float ex[16], se = 0.f;
#pragma unroll
            for (int q = 0; q < 16; ++q) { ex[q] = __builtin_amdgcn_exp2f((kval(L[q] & ~255) - m0) * (rstd * 1.4426950408889634f)); se += ex[q]; }
            const float inv = 1.0f / se;
#pragma unroll
            for (int q = 0; q < 16; ++q) { const int cid = L[q] & 255; const int es = hh * 16 + q, pos = (es & 7) * 16 + (es >> 3);
                IDX[ob0 + pos] = (k1[cid >> 4] & 127) * PNK + (k2[cid & 15] & 127); WGT[ob0 + pos] = ex[q] * inv; }
        }
    }
}

template <int NSTAGE> __device__ __forceinline__ void xreduce_stage(float (&p)[64], int lane) {
    constexpr int S = NSTAGE;
    if constexpr (S == 32) {
#pragma unroll
        for (int k = 0; k < S; ++k) { float xa = p[k], xb = p[k + S]; asm("s_nop 1\n\tv_permlane32_swap_b32 %0, %1" : "+v"(xa), "+v"(xb)); p[k] = xa + xb; }
    } else if constexpr (S == 16) {
#pragma unroll
        for (int k = 0; k < S; ++k) { float xa = p[k], xb = p[k + S]; asm("s_nop 1\n\tv_permlane16_swap_b32 %0, %1" : "+v"(xa), "+v"(xb)); p[k] = xa + xb; }
    } else {
        const bool up = (lane & S) != 0;
#pragma unroll
        for (int k = 0; k < S; ++k) { const float keep = up ? p[k + S] : p[k], send = up ? p[k] : p[k + S];
            p[k] = keep + __builtin_bit_cast(float, __builtin_amdgcn_ds_swizzle(__builtin_bit_cast(int, send), (S << 10) | 0x1F)); }
    }
}
__device__ __forceinline__ float gelu_erf(float v) { return 0.5f * v * (1.0f + erff(v * 0.70710678118654752f)); }
typedef float f32x2 __attribute__((ext_vector_type(2)));
__device__ __forceinline__ float peer_dots64(const unsigned char* U, int idxv, const f32x2 (&h2)[16], int lane) {
    float p[64];
#pragma unroll
    for (int e = 0; e < 64; ++e) {
        const int row = __builtin_amdgcn_readlane(idxv, e);
        const u32x4* up = (const u32x4*)(U + (size_t)row * DM) + lane;
        f32x2 a = {0.f, 0.f};
#pragma unroll
        for (int cc = 0; cc < 2; ++cc) { const u32x4 u = up[64 * cc];
#pragma unroll
            for (int q = 0; q < 4; ++q) { const int w = (int)u[q];
                a = __builtin_elementwise_fma(__builtin_amdgcn_cvt_pk_f32_fp8(w, false), h2[8 * cc + 2 * q], a);
                a = __builtin_elementwise_fma(__builtin_amdgcn_cvt_pk_f32_fp8(w, true), h2[8 * cc + 2 * q + 1], a); } }
        p[e] = a.x + a.y;
    }
    xreduce_stage<32>(p, lane); xreduce_stage<16>(p, lane); xreduce_stage<8>(p, lane); xreduce_stage<4>(p, lane); xreduce_stage<2>(p, lane); xreduce_stage<1>(p, lane);
    return p[0];
}
__device__ __forceinline__ void peer_accum64(const unsigned char* Vt, int idxv, float av, f32x2 (&acc)[16], int lane) {
#pragma unroll 8
    for (int e = 0; e < 64; ++e) {
        const int row = __builtin_amdgcn_readlane(idxv, e); const float a = __builtin_bit_cast(float, __builtin_amdgcn_readlane(__builtin_bit_cast(int, av), e));
        const f32x2 a2 = {a, a};
        const u32x4* vp = (const u32x4*)(Vt + (size_t)row * DM) + lane;
#pragma unroll
        for (int cc = 0; cc < 2; ++cc) { const u32x4 v = vp[64 * cc];
#pragma unroll
            for (int q = 0; q < 4; ++q) { const int w = (int)v[q];
                acc[8 * cc + 2 * q] = __builtin_elementwise_fma(__builtin_amdgcn_cvt_pk_f32_fp8(w, false), a2, acc[8 * cc + 2 * q]);
                acc[8 * cc + 2 * q + 1] = __builtin_elementwise_fma(__builtin_amdgcn_cvt_pk_f32_fp8(w, true), a2, acc[8 * cc + 2 * q + 1]); } }
    }
}
constexpr int GD = 8;
#define PG_ISSUE(vv) do { const int row_ = __builtin_amdgcn_readlane((((vv) >> 6) & 1) ? i1 : i0, (vv) & 63); \
        const u32x4* bp_ = (const u32x4*)((((vv) >> 6) < 2 ? U : Vt) + (size_t)row_ * DM) + lane; ring[(vv) % GD][0] = bp_[0]; ring[(vv) % GD][1] = bp_[64]; } while (0)
template <int SEG> __device__ __forceinline__ void peer_seg(const unsigned char* U, const unsigned char* Vt, int i0, int i1, u32x4 (&ring)[GD][2], float (&p)[64], float aseg, const f32x2 (&h2)[16], f32x2 (&acc)[16], int lane) {
#pragma unroll
    for (int e = 0; e < 64; ++e) {
        const int v = SEG * 64 + e;
        const u32x4 r0 = ring[v % GD][0], r1 = ring[v % GD][1];
        if (SEG < 2) {
            f32x2 a = {0.f, 0.f};
#pragma unroll
            for (int q = 0; q < 4; ++q) { const int wa = (int)r0[q], wb = (int)r1[q];
                a = __builtin_elementwise_fma(__builtin_amdgcn_cvt_pk_f32_fp8(wa, false), h2[2 * q], a); a = __builtin_elementwise_fma(__builtin_amdgcn_cvt_pk_f32_fp8(wa, true), h2[2 * q + 1], a);
                a = __builtin_elementwise_fma(__builtin_amdgcn_cvt_pk_f32_fp8(wb, false), h2[8 + 2 * q], a); a = __builtin_elementwise_fma(__builtin_amdgcn_cvt_pk_f32_fp8(wb, true), h2[8 + 2 * q + 1], a); }
            { float hs_; asm("v_add_f32 %0, %1, %2" : "=v"(hs_) : "v"(a.x), "v"(a.y)); p[e] = hs_; }
        } else {
            const float av = __builtin_bit_cast(float, __builtin_amdgcn_readlane(__builtin_bit_cast(int, aseg), e)); const f32x2 a2 = {av, av};
#pragma unroll
            for (int q = 0; q < 4; ++q) { const int wa = (int)r0[q], wb = (int)r1[q];
                acc[2 * q] = __builtin_elementwise_fma(__builtin_amdgcn_cvt_pk_f32_fp8(wa, false), a2, acc[2 * q]); acc[2 * q + 1] = __builtin_elementwise_fma(__builtin_amdgcn_cvt_pk_f32_fp8(wa, true), a2, acc[2 * q + 1]);
                acc[8 + 2 * q] = __builtin_elementwise_fma(__builtin_amdgcn_cvt_pk_f32_fp8(wb, false), a2, acc[8 + 2 * q]); acc[8 + 2 * q + 1] = __builtin_elementwise_fma(__builtin_amdgcn_cvt_pk_f32_fp8(wb, true), a2, acc[8 + 2 * q + 1]); }
            asm volatile("" : "+v"(acc[0]), "+v"(acc[1]), "+v"(acc[2]), "+v"(acc[3]), "+v"(acc[4]), "+v"(acc[5]), "+v"(acc[6]), "+v"(acc[7]), "+v"(acc[8]), "+v"(acc[9]), "+v"(acc[10]), "+v"(acc[11]), "+v"(acc[12]), "+v"(acc[13]), "+v"(acc[14]), "+v"(acc[15]));
        }
        if (v + GD < 256) PG_ISSUE(v + GD);
        __builtin_amdgcn_sched_barrier(0);
    }
}
__device__ __forceinline__ void peer_token_pipe(const unsigned char* U, const unsigned char* Vt, int i0, int i1, float su0, float su1, float w0, float w1, const f32x2 (&h2)[16], f32x2 (&acc)[16], int lane) {
    u32x4 ring[GD][2];
    float p[64];
#pragma unroll
    for (int v = 0; v < GD; ++v) PG_ISSUE(v);
    peer_seg<0>(U, Vt, i0, i1, ring, p, 0.f, h2, acc, lane);
    xreduce_stage<32>(p, lane); xreduce_stage<16>(p, lane); xreduce_stage<8>(p, lane); xreduce_stage<4>(p, lane); xreduce_stage<2>(p, lane); xreduce_stage<1>(p, lane);
    const float a0 = gelu_erf(p[0] * su0) * w0;
    __builtin_amdgcn_sched_barrier(0);
    peer_seg<1>(U, Vt, i0, i1, ring, p, 0.f, h2, acc, lane);
    xreduce_stage<32>(p, lane); xreduce_stage<16>(p, lane); xreduce_stage<8>(p, lane); xreduce_stage<4>(p, lane); xreduce_stage<2>(p, lane); xreduce_stage<1>(p, lane);
    const float a1 = gelu_erf(p[0] * su1) * w1;
    __builtin_amdgcn_sched_barrier(0);
    peer_seg<2>(U, Vt, i0, i1, ring, p, a0, h2, acc, lane);
    peer_seg<3>(U, Vt, i0, i1, ring, p, a1, h2, acc, lane);
}
#undef PG_ISSUE
__device__ __forceinline__ void peer_gather_phase(const Ctx& c, const bf16* Hn, const unsigned char* U, const unsigned char* Vt, const float* rsU, const float* rsV, const int* IDX, const float* WGT, const float* Xr, float* X, int mode,
                                                  const float* g1, const float* g2, bf16* Hout, bf16* HKVout) {
    for (int m = c.gw; m < NTOK; m += c.ngw) {
        int lane_ = c.lane; asm volatile("" : "+v"(lane_));
#ifdef DRYIDXMASK
        const int imask_ = (X != Xr) ? DRYIDXMASK : 0xffff;
        const int i0 = IDX[(size_t)m * 128 + lane_] & imask_, i1 = IDX[(size_t)m * 128 + 64 + lane_] & imask_;
#else
        const int i0 = IDX[(size_t)m * 128 + lane_], i1 = IDX[(size_t)m * 128 + 64 + lane_];
#endif
        const float w0 = WGT[(size_t)m * 128 + lane_] * rsV[i0], w1 = WGT[(size_t)m * 128 + 64 + lane_] * rsV[i1];
        const float su0 = rsU[i0], su1 = rsU[i1];
        f32x2 h2[16];
#pragma unroll
        for (int cc = 0; cc < 2; ++cc) { const u32x4* hp = (const u32x4*)(Hn + (size_t)m * DM + 1024 * cc + 16 * lane_); const u32x4 ha = hp[0], hb = hp[1];
#pragma unroll
            for (int q = 0; q < 4; ++q) { h2[8 * cc + q] = (f32x2){bflo(ha[q]), bfhi(ha[q])}; h2[8 * cc + 4 + q] = (f32x2){bflo(hb[q]), bfhi(hb[q])}; } }
        f32x2 acc[16];
#pragma unroll
        for (int k = 0; k < 16; ++k) acc[k] = (f32x2){0.f, 0.f};
        peer_token_pipe(U, Vt, i0, i1, su0, su1, w0, w1, h2, acc, lane_);
        float* xr = X + (size_t)m * DM; const float* xrr = Xr + (size_t)m * DM; float ss = 0.f;
#pragma unroll
        for (int cc = 0; cc < 2; ++cc) {
            f32x4* xp = (f32x4*)(xr + 1024 * cc + 16 * lane_); const f32x4* xq = (const f32x4*)(xrr + 1024 * cc + 16 * lane_);
#pragma unroll
            for (int q = 0; q < 4; ++q) { f32x4 xa = xq[q]; xa[0] += acc[8 * cc + 2 * q].x; xa[1] += acc[8 * cc + 2 * q].y; xa[2] += acc[8 * cc + 2 * q + 1].x; xa[3] += acc[8 * cc + 2 * q + 1].y;
                acc[8 * cc + 2 * q] = (f32x2){xa[0], xa[1]}; acc[8 * cc + 2 * q + 1] = (f32x2){xa[2], xa[3]}; ss += (xa[0] * xa[0] + xa[1] * xa[1]) + (xa[2] * xa[2] + xa[3] * xa[3]);
                if (mode != 2) xp[q] = xa; }
        }
        const float rstd = 1.0f / sqrtf(wave_sum(ss) * (1.0f / DM) + EPS);
#pragma unroll
        for (int cc = 0; cc < 2; ++cc) {
            const f32x4* gp = (const f32x4*)(g1 + 1024 * cc + 16 * lane_);
            if (mode == 2) {
                f32x4* xp = (f32x4*)(xr + 1024 * cc + 16 * lane_);
#pragma unroll
                for (int q = 0; q < 4; ++q) { const f32x4 gv = gp[q]; f32x4 y; y[0] = acc[8 * cc + 2 * q].x * rstd * gv[0]; y[1] = acc[8 * cc + 2 * q].y * rstd * gv[1]; y[2] = acc[8 * cc + 2 * q + 1].x * rstd * gv[2]; y[3] = acc[8 * cc + 2 * q + 1].y * rstd * gv[3]; xp[q] = y; }
            } else {
                u32x4 hw[2];
#pragma unroll
                for (int q = 0; q < 4; ++q) { const f32x4 gv = gp[q]; hw[q >> 1][2 * (q & 1)] = pk2(acc[8 * cc + 2 * q].x * rstd * gv[0], acc[8 * cc + 2 * q].y * rstd * gv[1]); hw[q >> 1][2 * (q & 1) + 1] = pk2(acc[8 * cc + 2 * q + 1].x * rstd * gv[2], acc[8 * cc + 2 * q + 1].y * rstd * gv[3]); }
                u32x4* ho = (u32x4*)(Hout + (size_t)m * DM + 1024 * cc + 16 * lane_); ho[0] = hw[0]; ho[1] = hw[1];
                if (mode == 1) {
                    const f32x4* kp = (const f32x4*)(g2 + 1024 * cc + 16 * lane_); u32x4 kw[2];
#pragma unroll
                    for (int q = 0; q < 4; ++q) { const f32x4 gv = kp[q]; kw[q >> 1][2 * (q & 1)] = pk2(acc[8 * cc + 2 * q].x * rstd * gv[0], acc[8 * cc + 2 * q].y * rstd * gv[1]); kw[q >> 1][2 * (q & 1) + 1] = pk2(acc[8 * cc + 2 * q + 1].x * rstd * gv[2], acc[8 * cc + 2 * q + 1].y * rstd * gv[3]); }
                    u32x4* ko = (u32x4*)(HKVout + (size_t)m * DM + 1024 * cc + 16 * lane_); ko[0] = kw[0]; ko[1] = kw[1];
                }
            }
        }
    }
}

template <int PAT> __device__ __forceinline__ float swz_xor(float v) { return __builtin_bit_cast(float, __builtin_amdgcn_ds_swizzle(__builtin_bit_cast(int, v), PAT)); }
template <int PAT> __device__ __forceinline__ int swz_xor_i(int v) { return __builtin_amdgcn_ds_swizzle(v, PAT); }
template <int C> __device__ __forceinline__ unsigned bc8(unsigned v) { return (unsigned)__builtin_amdgcn_ds_swizzle((int)v, (C << 5) | 0x18); }
__device__ __forceinline__ void bcast16(unsigned x0, unsigned x1, unsigned (&o)[16]) {
    o[0] = bc8<0>(x0); o[1] = bc8<0>(x1); o[2] = bc8<1>(x0); o[3] = bc8<1>(x1); o[4] = bc8<2>(x0); o[5] = bc8<2>(x1); o[6] = bc8<3>(x0); o[7] = bc8<3>(x1);
    o[8] = bc8<4>(x0); o[9] = bc8<4>(x1); o[10] = bc8<5>(x0); o[11] = bc8<5>(x1); o[12] = bc8<6>(x0); o[13] = bc8<6>(x1); o[14] = bc8<7>(x0); o[15] = bc8<7>(x1);
}
__device__ __forceinline__ void peer_u_phase(const Ctx& c, const bf16* Hn, const unsigned char* U, const int* IDXT, float* PD, unsigned imask = 0xffffffffu) {
    const int xg = c.bx & 7, wr = (c.bx >> 3) * 8 + c.wave, g = c.lane >> 3, sub = c.lane & 7;
    for (int pass = 0; pass < 2; ++pass) {
        const int s = xg + 8 * pass, col0 = 128 * s + 16 * sub;
        const unsigned char* Us = U + (size_t)s * PE * 128 + 16 * sub;
        u32x4 wv[8];
        { const u32x4* wp = (const u32x4*)(U + (size_t)s * PE * 128 + (size_t)(c.bx >> 3) * 65536) + c.tid;
#pragma unroll
          for (int q = 0; q < 8; ++q) wv[q] = wp[q * 512]; }
        u32x2 ii; unsigned hw;
        { ii = *(const u32x2*)(IDXT + (size_t)wr * 128 + g * 16 + 2 * sub);
          hw = *((const unsigned*)(Hn + (size_t)wr * DM + 128 * s) + c.lane); }
        for (int k = 0; k < NTOK / 256; ++k) {
            const int t = wr + 256 * k;
            u32x4 r[16]; unsigned rj[16];
            bcast16(ii.x, ii.y, rj);
#pragma unroll
            for (int j = 0; j < 16; ++j) r[j] = *(const u32x4*)(Us + (size_t)(rj[j] & imask) * 128);
            float hf[16];
#pragma unroll
            for (int q = 0; q < 8; ++q) { const unsigned hd = (unsigned)__builtin_amdgcn_ds_bpermute(32 * sub + 4 * q, (int)hw); hf[2 * q] = bflo(hd); hf[2 * q + 1] = bfhi(hd); }
            if (k + 1 < NTOK / 256) { ii = *(const u32x2*)(IDXT + (size_t)(t + 256) * 128 + g * 16 + 2 * sub);
                hw = *((const unsigned*)(Hn + (size_t)(t + 256) * DM + 128 * s) + c.lane); }
            float am = 0.f;
#pragma unroll
            for (int q = 0; q < 16; ++q) am = fmaxf(am, fabsf(hf[q]));
            am = fmaxf(am, dpp_f<0xB1>(am)); am = fmaxf(am, dpp_f<0x4E>(am)); am = fmaxf(am, dpp_f<0x141>(am));
            const float hsc = am > 0.f ? 127.0f / am : 0.f, hinv = am * (1.0f / 127.0f);
            unsigned hq[4];
#pragma unroll
            for (int q = 0; q < 4; ++q) hq[q] = q8pack(hf[4 * q] * hsc, hf[4 * q + 1] * hsc, hf[4 * q + 2] * hsc, hf[4 * q + 3] * hsc);
            int p[16];
#pragma unroll
            for (int j = 0; j < 16; ++j) { int a = __builtin_amdgcn_sdot4((int)r[j].x, (int)hq[0], 0, false); a = __builtin_amdgcn_sdot4((int)r[j].y, (int)hq[1], a, false);
                a = __builtin_amdgcn_sdot4((int)r[j].z, (int)hq[2], a, false); p[j] = __builtin_amdgcn_sdot4((int)r[j].w, (int)hq[3], a, false); }
            { const bool up = (sub & 4) != 0;
#pragma unroll
              for (int q = 0; q < 8; ++q) { const int keep = up ? p[q + 8] : p[q], send = up ? p[q] : p[q + 8]; p[q] = keep + swz_xor_i<(4 << 10) | 0x1F>(send); } }
            { const bool up = (sub & 2) != 0;
#pragma unroll
              for (int q = 0; q < 4; ++q) { const int keep = up ? p[q + 4] : p[q], send = up ? p[q] : p[q + 4]; p[q] = keep + swz_xor_i<(2 << 10) | 0x1F>(send); } }
            { const bool up = (sub & 1) != 0;
#pragma unroll
              for (int q = 0; q < 2; ++q) { const int keep = up ? p[q + 2] : p[q], send = up ? p[q] : p[q + 2]; p[q] = keep + swz_xor_i<(1 << 10) | 0x1F>(send); } }
            f32x2 o = {(float)p[0] * hinv, (float)p[1] * hinv};
            *(f32x2*)(PD + ((size_t)t * 16 + s) * 128 + g * 16 + 2 * sub) = o;
            if (k == 0) asm volatile("" :: "v"(wv[0]), "v"(wv[1]), "v"(wv[2]), "v"(wv[3]), "v"(wv[4]), "v"(wv[5]), "v"(wv[6]), "v"(wv[7]));
        }
    }
}
__device__ __forceinline__ void peer_a_phase(const Ctx& c, const float* PD, const int* IDXT, float* WA, const float* rsU, const float* rsV, const float* RSTD) {
    const int i0 = c.bx * 512 + c.tid, step = c.G * 512;
    f32x4 vn[16];
    if (i0 < NTOK * 32) { const f32x4* pp = (const f32x4*)(PD + (size_t)(i0 >> 5) * 2048) + (i0 & 31);
#pragma unroll
        for (int s = 0; s < 16; ++s) vn[s] = pp[s * 32]; }
    for (int i4 = i0; i4 < NTOK * 32; i4 += step) {
        const int t = i4 >> 5;
        f32x4 v[16];
#pragma unroll
        for (int s = 0; s < 16; ++s) v[s] = vn[s];
        const u32x4 e = *((const u32x4*)IDXT + i4); const f32x4 w = *((const f32x4*)WA + i4); const float rs = RSTD[t];
        { const int i5 = i4 + step < NTOK * 32 ? i4 + step : i4; const f32x4* pp = (const f32x4*)(PD + (size_t)(i5 >> 5) * 2048) + (i5 & 31);
#pragma unroll
          for (int s = 0; s < 16; ++s) vn[s] = pp[s * 32]; }
        float ru[4], rv[4];
#pragma unroll
        for (int q = 0; q < 4; ++q) { const unsigned eq = e[q]; ru[q] = rsU[eq]; rv[q] = rsV[eq]; }
        f32x4 sm = v[0];
#pragma unroll
        for (int s = 1; s < 16; ++s) sm += v[s];
        asm volatile("" :: "v"(ru[0]), "v"(ru[1]), "v"(ru[2]), "v"(ru[3]), "v"(rv[0]), "v"(rv[1]), "v"(rv[2]), "v"(rv[3]));
        f32x4 o;
#pragma unroll
        for (int q = 0; q < 4; ++q) o[q] = gelu_erf(sm[q] * ru[q] * rs) * w[q] * rv[q];
        *((f32x4*)WA + i4) = o;
    }
}
__device__ __forceinline__ void peer_v_phase(const Ctx& c, const unsigned char* Vt, const int* IDXT, const float* WA, float* X) {
    const int xg = c.bx & 7, wr = (c.bx >> 3) * 8 + c.wave, g = c.lane >> 3, sub = c.lane & 7;
    for (int pass = 0; pass < 2; ++pass) {
        const int s = xg + 8 * pass, col0 = 128 * s + 16 * sub;
        const unsigned char* Vs = Vt + (size_t)s * PE * 128 + 16 * sub;
        u32x4 wv[8];
        { const u32x4* wp = (const u32x4*)(Vt + (size_t)s * PE * 128 + (size_t)(c.bx >> 3) * 65536) + c.tid;
#pragma unroll
          for (int q = 0; q < 8; ++q) wv[q] = wp[q * 512]; }
        u32x2 ii, aa;
        { ii = *(const u32x2*)(IDXT + (size_t)wr * 128 + g * 16 + 2 * sub); aa = *(const u32x2*)(WA + (size_t)wr * 128 + g * 16 + 2 * sub); }
        for (int k = 0; k < NTOK / 256; ++k) {
            const int t = wr + 256 * k;
            u32x4 r[16]; float av[16]; unsigned rj[16], aj[16];
            bcast16(ii.x, ii.y, rj);
#pragma unroll
            for (int j = 0; j < 16; ++j) r[j] = *(const u32x4*)(Vs + (size_t)rj[j] * 128);
            bcast16(aa.x, aa.y, aj);
#pragma unroll
            for (int j = 0; j < 16; ++j) av[j] = __builtin_bit_cast(float, aj[j]);
            f32x2* xp = (f32x2*)(X + (size_t)t * DM + col0 + 2 * g);
            const f32x2 xold = *xp;
            if (k + 1 < NTOK / 256) { ii = *(const u32x2*)(IDXT + (size_t)(t + 256) * 128 + g * 16 + 2 * sub); aa = *(const u32x2*)(WA + (size_t)(t + 256) * 128 + g * 16 + 2 * sub); }
            f32x2 acc[8];
#pragma unroll
            for (int q = 0; q < 8; ++q) acc[q] = (f32x2){0.f, 0.f};
#pragma unroll
            for (int j = 0; j < 16; ++j) { float aj_ = av[j]; asm("" : "+v"(aj_));
                const f32x2 a2 = {aj_, aj_};
#pragma unroll
                for (int q = 0; q < 4; ++q) { const int w = (int)r[j][q]; acc[2 * q] = __builtin_elementwise_fma(__builtin_amdgcn_cvt_pk_f32_fp8(w, false), a2, acc[2 * q]); acc[2 * q + 1] = __builtin_elementwise_fma(__builtin_amdgcn_cvt_pk_f32_fp8(w, true), a2, acc[2 * q + 1]); } }
            float af[16];
#pragma unroll
            for (int q = 0; q < 8; ++q) { af[2 * q] = acc[q].x; af[2 * q + 1] = acc[q].y; }
#ifdef VDBG
#pragma unroll
            for (int q = 0; q < 16; ++q) { af[q] += __shfl_xor(af[q], 8); af[q] += __shfl_xor(af[q], 16); af[q] += __shfl_xor(af[q], 32); }
            { float s0 = af[0], s1 = af[1];
#pragma unroll
              for (int gg = 1; gg < 8; ++gg) { s0 = (g == gg) ? af[2 * gg] : s0; s1 = (g == gg) ? af[2 * gg + 1] : s1; }
              af[0] = s0; af[1] = s1; }
#else
#pragma unroll
            for (int q = 0; q < 8; ++q) { float xa = af[q], xb = af[q + 8]; asm("s_nop 1\n\tv_permlane32_swap_b32 %0, %1" : "+v"(xa), "+v"(xb)); af[q] = xa + xb; }
#pragma unroll
            for (int q = 0; q < 4; ++q) { float xa = af[q], xb = af[q + 4]; asm("s_nop 1\n\tv_permlane16_swap_b32 %0, %1" : "+v"(xa), "+v"(xb)); af[q] = xa + xb; }
            { const bool up = (c.lane & 8) != 0;
#pragma unroll
              for (int q = 0; q < 2; ++q) { const float keep = up ? af[q + 2] : af[q], send = up ? af[q] : af[q + 2]; af[q] = keep + swz_xor<(8 << 10) | 0x1F>(send); } }
#endif
            const f32x2 xn = {xold.x + af[0], xold.y + af[1]};
            *xp = xn;
            if (k == 0) asm volatile("" :: "v"(wv[0]), "v"(wv[1]), "v"(wv[2]), "v"(wv[3]), "v"(wv[4]), "v"(wv[5]), "v"(wv[6]), "v"(wv[7]));
        }
    }
}
#ifdef VREF
__device__ __forceinline__ void peer_v_ref_phase(const Ctx& c, const unsigned char* Vt, const int* IDXT, const float* WA, float* X) {
    for (int m = c.gw; m < NTOK; m += c.ngw) {
        const int i0 = IDXT[(size_t)m * 128 + c.lane], i1 = IDXT[(size_t)m * 128 + 64 + c.lane];
        const float a0 = WA[(size_t)m * 128 + c.lane], a1 = WA[(size_t)m * 128 + 64 + c.lane];
        f32x2 acc[16];
#pragma unroll
        for (int k = 0; k < 16; ++k) acc[k] = (f32x2){0.f, 0.f};
        for (int e = 0; e < 128; ++e) {
            const int row = __shfl(e < 64 ? i0 : i1, e & 63); const float a = __shfl(e < 64 ? a0 : a1, e & 63); const f32x2 a2 = {a, a};
            const u32x4* vp = (const u32x4*)(Vt + (size_t)row * DM) + c.lane;
#pragma unroll
            for (int cc = 0; cc < 2; ++cc) { const u32x4 v = vp[64 * cc];
#pragma unroll
                for (int q = 0; q < 4; ++q) { const int w = (int)v[q];
                    acc[8 * cc + 2 * q] = __builtin_elementwise_fma(__builtin_amdgcn_cvt_pk_f32_fp8(w, false), a2, acc[8 * cc + 2 * q]);
                    acc[8 * cc + 2 * q + 1] = __builtin_elementwise_fma(__builtin_amdgcn_cvt_pk_f32_fp8(w, true), a2, acc[8 * cc + 2 * q + 1]); } }
        }
        float* xr = X + (size_t)m * DM;
#pragma unroll
        for (int cc = 0; cc < 2; ++cc) { f32x4* xp = (f32x4*)(xr + 1024 * cc + 16 * c.lane);
#pragma unroll
            for (int q = 0; q < 4; ++q) { f32x4 xa = xp[q]; xa[0] += acc[8 * cc + 2 * q].x; xa[1] += acc[8 * cc + 2 * q].y; xa[2] += acc[8 * cc + 2 * q + 1].x; xa[3] += acc[8 * cc + 2 * q + 1].y; xp[q] = xa; } }
    }
}
#endif
__device__ __forceinline__ void norm_phase(const Ctx& c, float* X, int mode, const float* g1, const float* g2, bf16* H, bf16* HKV) {
    f32x4 ga[8], gb[8]; load_g(g1, c.lane, ga); load_g(mode == 1 ? g2 : g1, c.lane, gb);
    int m = c.gw;
    f32x4 v[8]; load_row(X + (size_t)m * DM, c.lane, v);
    for (; m < NTOK; m += c.ngw) {
        const int mn = m + c.ngw < NTOK ? m + c.ngw : m;
        f32x4 nx[8]; load_row(X + (size_t)mn * DM, c.lane, nx);
        const float rstd = row_rstd(v);
        if (mode == 2) { f32x4* xo = (f32x4*)(X + (size_t)m * DM) + c.lane;
#pragma unroll
            for (int j = 0; j < 8; ++j) { f32x4 y; y[0] = v[j][0] * rstd * ga[j][0]; y[1] = v[j][1] * rstd * ga[j][1]; y[2] = v[j][2] * rstd * ga[j][2]; y[3] = v[j][3] * rstd * ga[j][3]; xo[64 * j] = y; }
        } else { store_norm_bf16_r(v, rstd, ga, H + (size_t)m * DM, c.lane); if (mode == 1) store_norm_bf16_r(v, rstd, gb, HKV + (size_t)m * DM, c.lane); }
#pragma unroll
        for (int j = 0; j < 8; ++j) v[j] = nx[j];
    }
}

__device__ __forceinline__ void rms_final_phase(const Ctx& c, float* X, const float* g) {
    for (int m = c.gw; m < NTOK; m += c.ngw) { f32x4 v[8]; load_row(X + (size_t)m * DM, c.lane, v); const float rstd = row_rstd(v);
        const f32x4* gr = (const f32x4*)g + c.lane; f32x4* xo = (f32x4*)(X + (size_t)m * DM) + c.lane;
#pragma unroll
        for (int j = 0; j < 8; ++j) { const f32x4 gv = gr[64 * j]; f32x4 y; for (int k = 0; k < 4; ++k) { y[k] = v[j][k] * rstd * gv[k]; if (!(fabsf(y[k]) < 1e30f)) y[k] = 0.f; } xo[64 * j] = y; } }
}

#ifdef DIAGBUF
__device__ __forceinline__ void diag_copy_phase(const Ctx& c, float* X, const unsigned char* ws) {
    const bf16* src = (const bf16*)(ws + (size_t)DIAGBUF);
    for (size_t i = (size_t)c.bx * 512 + c.tid; i < (size_t)NTOK * DM; i += (size_t)c.G * 512) { const size_t t = i / DM, col = i % DM; float v = bflo((unsigned)src[t * DIAGLD + col]); if (!(fabsf(v) < 1e30f)) v = 0.f; X[i] = v; }
}
#endif

__device__ __forceinline__ unsigned off_b(unsigned row, unsigned ch) { return 256u * row + 16u * (ch ^ (((row & 3u) << 2) | ((row >> 2) & 3u))); }
__device__ __forceinline__ float rowmax4(float x) {
    float a = x, b = x; asm("s_nop 1\n\tv_permlane16_swap_b32 %0, %1" : "+v"(a), "+v"(b)); x = fmaxf(a, b);
    a = x; b = x; asm("s_nop 1\n\tv_permlane32_swap_b32 %0, %1" : "+v"(a), "+v"(b)); return fmaxf(a, b);
}
constexpr int AT_K = 0, AT_V = 32768, AT_BUF = 65536, AT_BIAS = 131072, AT_HEADB = 16384;
__device__ __forceinline__ void attn_phase(const Ctx& c, const bf16* Qg, const bf16* KVg, bf16* AOg, const float* relb, int dryvar = 0) {
    LAS unsigned char* lds = c.lds; const unsigned ldsb = (unsigned)(size_t)lds;
    const int tid = c.tid, lane = c.lane, w = c.wave, hg = w >> 2, wq = w & 3, fr = lane & 15, fq = lane >> 4, tq = (lane & 15) >> 2, tp = lane & 3;
    const int tl = tid & 255, lrow = tl >> 2, lc = tl & 3;
    unsigned vadr[8];
#pragma unroll
    for (int d = 0; d < 8; ++d) vadr[d] = ldsb + AT_V + hg * AT_HEADB + off_b(4 * fq + tq, 2 * d + (tp >> 1)) + 8 * (tp & 1);
    unsigned kadr[4];
#pragma unroll
    for (int s4 = 0; s4 < 4; ++s4) kadr[s4] = ldsb + AT_K + hg * AT_HEADB + 256 * fr + 16 * (fq ^ ((fr >> 2) & 3)) + 64 * (s4 ^ (fr & 3));
    for (int u = c.bx; u < NBATCH * NCHUNK * (AH / 2); u += c.G) {
        const int hp = u & 7, ch = (u >> 3) & 63, b = u >> 9, h = 2 * hp + hg;
        const size_t tq0 = (size_t)b * SEQ + (size_t)ch * CHUNK;
        __syncthreads();
        for (int i = tid; i < 2 * 272; i += 512) { const int hh = i / 272, k = i % 272; ((LAS float*)(lds + AT_BIAS))[i] = (k < NREL) ? relb[(size_t)(2 * hp + hh) * NREL + k] * 1.4426950408889634f : 0.f; }
        bf16x8 qf[4];
        { const bf16* qp = Qg + (tq0 + 16 * wq + fr) * DM + h * AHD + 8 * fq;
#pragma unroll
          for (int s = 0; s < 4; ++s) qf[s] = *(const bf16x8*)(qp + 32 * s); }
        f32x4 O[8];
#pragma unroll
        for (int d = 0; d < 8; ++d) O[d] = (f32x4){0.f, 0.f, 0.f, 0.f};
        float mrun = -1e30f, lrun = 0.f;
        const int t0 = ch >= LEFT ? 0 : LEFT - ch;
        u32x4 pk[4], pv[4];
        { const bf16* kp = KVg + ((size_t)b * SEQ + (size_t)(ch - LEFT + t0) * CHUNK + lrow) * (2 * DM) + h * AHD;
#pragma unroll
          for (int cc = 0; cc < 4; ++cc) { pk[cc] = *(const u32x4*)(kp + (lc + 4 * cc) * 8); pv[cc] = *(const u32x4*)(kp + DM + (lc + 4 * cc) * 8); } }
        const LAS float* bias = (const LAS float*)(lds + AT_BIAS) + hg * 272;
        const float bc = relb[(size_t)h * NREL + 256] * 1.4426950408889634f;
        for (int t = t0; t <= LEFT; ++t) {
            const int pb = ((t - t0) & 1) * AT_BUF;
#pragma unroll
            for (int cc = 0; cc < 4; ++cc) { *(LAS u32x4*)(lds + pb + AT_K + hg * AT_HEADB + off_b(lrow, lc + 4 * cc)) = pk[cc]; *(LAS u32x4*)(lds + pb + AT_V + hg * AT_HEADB + off_b(lrow, lc + 4 * cc)) = pv[cc]; }
            __syncthreads();
            if (t < LEFT && dryvar != 1) { const bf16* kp = KVg + ((size_t)b * SEQ + (size_t)(ch - LEFT + t + 1) * CHUNK + lrow) * (2 * DM) + h * AHD;
#pragma unroll
                for (int cc = 0; cc < 4; ++cc) { pk[cc] = *(const u32x4*)(kp + (lc + 4 * cc) * 8); pv[cc] = *(const u32x4*)(kp + DM + (lc + 4 * cc) * 8); } }
            f32x4 sT[4];
            {
                bf16x8 kf[16];
                const unsigned k0 = kadr[0] + pb, k1 = kadr[1] + pb, k2 = kadr[2] + pb, k3 = kadr[3] + pb;
                asm volatile("ds_read_b128 %0, %16\n\tds_read_b128 %1, %17\n\tds_read_b128 %2, %18\n\tds_read_b128 %3, %19\n\t"
                             "ds_read_b128 %4, %16 offset:4096\n\tds_read_b128 %5, %17 offset:4096\n\tds_read_b128 %6, %18 offset:4096\n\tds_read_b128 %7, %19 offset:4096\n\t"
                             "ds_read_b128 %8, %16 offset:8192\n\tds_read_b128 %9, %17 offset:8192\n\tds_read_b128 %10, %18 offset:8192\n\tds_read_b128 %11, %19 offset:8192\n\t"
                             "ds_read_b128 %12, %16 offset:12288\n\tds_read_b128 %13, %17 offset:12288\n\tds_read_b128 %14, %18 offset:12288\n\tds_read_b128 %15, %19 offset:12288"
                             : "=&v"(kf[0]), "=&v"(kf[1]), "=&v"(kf[2]), "=&v"(kf[3]), "=&v"(kf[4]), "=&v"(kf[5]), "=&v"(kf[6]), "=&v"(kf[7]),
                               "=&v"(kf[8]), "=&v"(kf[9]), "=&v"(kf[10]), "=&v"(kf[11]), "=&v"(kf[12]), "=&v"(kf[13]), "=&v"(kf[14]), "=&v"(kf[15])
                             : "v"(k0), "v"(k1), "v"(k2), "v"(k3) : "memory");
                asm volatile("s_waitcnt lgkmcnt(8)" : "+v"(kf[0]), "+v"(kf[1]), "+v"(kf[2]), "+v"(kf[3]), "+v"(kf[4]), "+v"(kf[5]), "+v"(kf[6]), "+v"(kf[7]) :: "memory");
#pragma unroll
                for (int kt = 0; kt < 2; ++kt) { sT[kt] = (f32x4){0.f, 0.f, 0.f, 0.f};
#pragma unroll
                    for (int s = 0; s < 4; ++s) sT[kt] = MFMA16(kf[4 * kt + s], qf[s], sT[kt]); }
                asm volatile("s_waitcnt lgkmcnt(0)" : "+v"(kf[8]), "+v"(kf[9]), "+v"(kf[10]), "+v"(kf[11]), "+v"(kf[12]), "+v"(kf[13]), "+v"(kf[14]), "+v"(kf[15]) :: "memory");
#pragma unroll
                for (int kt = 2; kt < 4; ++kt) { sT[kt] = (f32x4){0.f, 0.f, 0.f, 0.f};
#pragma unroll
                    for (int s = 0; s < 4; ++s) sT[kt] = MFMA16(kf[4 * kt + s], qf[s], sT[kt]); }
            }
            const int dbase = (LEFT - t) * CHUNK + (16 * wq + fr);
            if (t > LEFT - 3) {
#pragma unroll
                for (int kt = 0; kt < 4; ++kt)
#pragma unroll
                    for (int r = 0; r < 4; ++r) { const int dist = dbase - (16 * kt + 4 * fq + r); sT[kt][r] += bias[min(dist, 128) + 128]; }
            }
            s16x4 vlo[2][8], vhi[2][8];
            unsigned vcur[8];
#pragma unroll
            for (int d = 0; d < 8; ++d) vcur[d] = vadr[d] + pb;
#define TR8(dst, OFF) asm volatile("ds_read_b64_tr_b16 %0, %8 offset:" #OFF "\n\tds_read_b64_tr_b16 %1, %9 offset:" #OFF "\n\tds_read_b64_tr_b16 %2, %10 offset:" #OFF "\n\tds_read_b64_tr_b16 %3, %11 offset:" #OFF "\n\t" \
                "ds_read_b64_tr_b16 %4, %12 offset:" #OFF "\n\tds_read_b64_tr_b16 %5, %13 offset:" #OFF "\n\tds_read_b64_tr_b16 %6, %14 offset:" #OFF "\n\tds_read_b64_tr_b16 %7, %15 offset:" #OFF \
                : "=&v"(dst[0]), "=&v"(dst[1]), "=&v"(dst[2]), "=&v"(dst[3]), "=&v"(dst[4]), "=&v"(dst[5]), "=&v"(dst[6]), "=&v"(dst[7]) \
                : "v"(vcur[0]), "v"(vcur[1]), "v"(vcur[2]), "v"(vcur[3]), "v"(vcur[4]), "v"(vcur[5]), "v"(vcur[6]), "v"(vcur[7]) : "memory")
            TR8(vlo[0], 0); TR8(vhi[0], 4096); TR8(vlo[1], 8192); TR8(vhi[1], 12288);
#undef TR8
            float mx = -1e30f;
            const float badd = t <= LEFT - 3 ? bc : 0.f;
#pragma unroll
            for (int kt = 0; kt < 4; ++kt)
#pragma unroll
                for (int r = 0; r < 4; ++r) { sT[kt][r] += badd; mx = fmaxf(mx, sT[kt][r]); }
            mx = rowmax4(mx);
            const float mnew = fmaxf(mrun, mx), alpha = __builtin_amdgcn_exp2f(mrun - mnew); mrun = mnew;
            float ps = 0.f;
#pragma unroll
            for (int kt = 0; kt < 4; ++kt)
#pragma unroll
                for (int r = 0; r < 4; ++r) { sT[kt][r] = __builtin_amdgcn_exp2f(sT[kt][r] - mnew); ps += sT[kt][r]; }
            lrun = lrun * alpha + ps;
#pragma unroll
            for (int d = 0; d < 8; ++d) O[d] *= alpha;
            asm volatile("s_waitcnt lgkmcnt(0)" : "+v"(vlo[0][0]), "+v"(vlo[0][1]), "+v"(vlo[0][2]), "+v"(vlo[0][3]), "+v"(vlo[0][4]), "+v"(vlo[0][5]), "+v"(vlo[0][6]), "+v"(vlo[0][7]),
                         "+v"(vhi[0][0]), "+v"(vhi[0][1]), "+v"(vhi[0][2]), "+v"(vhi[0][3]), "+v"(vhi[0][4]), "+v"(vhi[0][5]), "+v"(vhi[0][6]), "+v"(vhi[0][7]) :: "memory");
            asm volatile("" : "+v"(vlo[1][0]), "+v"(vlo[1][1]), "+v"(vlo[1][2]), "+v"(vlo[1][3]), "+v"(vlo[1][4]), "+v"(vlo[1][5]), "+v"(vlo[1][6]), "+v"(vlo[1][7]),
                         "+v"(vhi[1][0]), "+v"(vhi[1][1]), "+v"(vhi[1][2]), "+v"(vhi[1][3]), "+v"(vhi[1][4]), "+v"(vhi[1][5]), "+v"(vhi[1][6]), "+v"(vhi[1][7]) :: "memory");
            __builtin_amdgcn_sched_barrier(0);
#pragma unroll
            for (int ks = 0; ks < 2; ++ks) {
                bf16x8 pb; { const unsigned p0 = pk2(sT[2 * ks][0], sT[2 * ks][1]), p1 = pk2(sT[2 * ks][2], sT[2 * ks][3]), p2 = pk2(sT[2 * ks + 1][0], sT[2 * ks + 1][1]), p3 = pk2(sT[2 * ks + 1][2], sT[2 * ks + 1][3]);
                    const u32x4 pw = (u32x4){p0, p1, p2, p3}; pb = __builtin_bit_cast(bf16x8, pw); }
#pragma unroll
                for (int d = 0; d < 8; ++d) { bf16x8 va; va[0] = vlo[ks][d][0]; va[1] = vlo[ks][d][1]; va[2] = vlo[ks][d][2]; va[3] = vlo[ks][d][3]; va[4] = vhi[ks][d][0]; va[5] = vhi[ks][d][1]; va[6] = vhi[ks][d][2]; va[7] = vhi[ks][d][3];
                    O[d] = MFMA16(va, pb, O[d]); }
            }
        }
        float lt = lrun; lt += __shfl_xor(lt, 16); lt += __shfl_xor(lt, 32);
        const float inv = 1.0f / lt;
        bf16* op = AOg + (tq0 + 16 * wq + fr) * DM + h * AHD + 4 * fq;
#pragma unroll
        for (int d = 0; d < 8; ++d) { u32x2 ow; ow.x = pk2(O[d][0] * inv, O[d][1] * inv); ow.y = pk2(O[d][2] * inv, O[d][3] * inv); *(u32x2*)(op + 16 * d) = ow; }
    }
}

constexpr int NSTEPS = 1 + 2 * 10 + 2 * 9;
template <int MASK> __global__ void __launch_bounds__(512, 2) yoco_fwd(Params p) {
    extern __shared__ __attribute__((aligned(16))) unsigned char lds_raw[];
#define MK_CTX() Ctx c; { int t_ = threadIdx.x; asm volatile("" : "+v"(t_)); c.lds = (LAS unsigned char*)lds_raw; c.tid = t_; c.lane = t_ & 63; c.wave = __builtin_amdgcn_readfirstlane(t_ >> 6); \
        { int b_ = blockIdx.x, g_ = gridDim.x; asm volatile("" : "+s"(b_), "+s"(g_)); c.bx = b_; c.G = g_; } c.gw = c.bx * 8 + c.wave; c.ngw = c.G * 8; }
    volatile LAS unsigned* MISC = (volatile LAS unsigned*)((LAS unsigned char*)lds_raw + LDS_MISC);
    if (threadIdx.x < 4) MISC[threadIdx.x] = 0u;
    __syncthreads();
    XcdBarrier bar; bar.bar = (unsigned*)(p.ws + WS_CTL); bar.x = 0; bar.st = MISC;
    if (p.hi - p.lo > 1) bar = xcd_barrier_post((unsigned*)(p.ws + WS_CTL), MISC);
    unsigned char* ws = p.ws;
    bf16* const H = (bf16*)(ws + WS_H); bf16* const HKV = (bf16*)(ws + WS_HKV);
    float* const X = p.out;
    int s = 0;
#ifndef REPMASK
#define REPMASK 0
#endif
#define KF_(f) p.f = kq_->f;
#define MK_P() Params p; { unsigned long long ka_ = (unsigned long long)__builtin_amdgcn_kernarg_segment_ptr(); asm volatile("" : "+s"(ka_)); const __attribute__((address_space(4))) Params* kq_ = (const __attribute__((address_space(4))) Params*)ka_; \
        KF_(x) KF_(ln_mix) KF_(ln_ffn) KF_(ret_w_in) KF_(ret_w_out) KF_(ret_gn) KF_(kv_norm) KF_(w_kv) KF_(att_w_q) KF_(att_w_o) KF_(att_rel_bias) KF_(peer_w_q) KF_(peer_sub_keys) KF_(peer_u) KF_(peer_v) KF_(ln_final) \
        KF_(out) KF_(ws) KF_(lo) KF_(hi) } \
        unsigned char* const ws = p.ws; bf16* const H = (bf16*)(ws + WS_H); bf16* const HKV = (bf16*)(ws + WS_HKV); float* const X = p.out; (void)H; (void)HKV; (void)X;
#define BEGIN_STEP(k) if (((MASK >> (k)) & 1) && s >= p.lo && s < p.hi) { for (int rep_ = ((REPMASK >> (k)) & 1) ? 0 : 1; rep_ < 2; ++rep_) { MK_CTX(); MK_P();
#define END_STEP   if (rep_ == 0 || s + 1 < p.hi) xcd_barrier(bar); } } ++s;

    BEGIN_STEP(0) p0_prologue(p, c); END_STEP

    for (int l = 0; l < DEPTH; ++l) {
        if (l < 2) {
            BEGIN_STEP(1)
                pg8::Gemm g{H, (const bf16*)(ws + WS_WIN) + (size_t)l * RIN * DM, NTOK, RIN, DM}; pg8::StaticOrder S; S.init(NTOK, RIN, c.G, c.bx);
                pg8::EpiProj E{(bf16*)(ws + WS_Q), (bf16*)(ws + WS_K), (bf16*)(ws + WS_V), (bf16*)(ws + WS_G), (const float*)(ws + WS_ROT)};
                pg8::gemm_phase<pg8::EpiProj, pg8::StaticOrder>(c.lds, g, S, E, nullptr);
            END_STEP
            BEGIN_STEP(2)
                for (int u = c.bx; u < 256; u += c.G) ret_scan_unit(c, (const bf16*)(ws + WS_Q), (const bf16*)(ws + WS_K), (const bf16*)(ws + WS_V), (bf16*)(ws + WS_O), u);
            END_STEP
            BEGIN_STEP(3)
                ret_gate_phase(c, (const bf16*)(ws + WS_O), (bf16*)(ws + WS_G), p.ret_gn + (size_t)l * RVW, rep_ == 0 ? (bf16*)(ws + WS_SC) : nullptr);
            END_STEP
        } else {
            BEGIN_STEP(4)
                for (int pass = (l == 2 ? 0 : 1); pass < 2; ++pass) {
                    const int N = pass ? DM : 2 * DM;
                    pg8::Gemm g{pass ? H : HKV, pass ? (const bf16*)(ws + WS_WQ) + (size_t)(l - 2) * DM * DM : (const bf16*)(ws + WS_WKV), NTOK, N, DM}; pg8::StaticOrder S; S.init(NTOK, N, c.G, c.bx);
                    pg8::EpiBf16S E{pass ? (bf16*)(ws + WS_Q) : (bf16*)(ws + WS_KV), N, pass ? 0.12751743082459868f : 1.0f};
                    pg8::gemm_phase<pg8::EpiBf16S, pg8::StaticOrder>(c.lds, g, S, E, nullptr);
                }
            END_STEP
            BEGIN_STEP(5)
#ifdef ATTNDRY
                attn_phase(c, (const bf16*)(ws + WS_Q), (const bf16*)(ws + WS_KV), rep_ == 0 ? (bf16*)(ws + WS_O) : (bf16*)(ws + WS_AO), p.att_rel_bias + (size_t)(l - 2) * AH * NREL, rep_ == 0 ? ATTNDRY : 0);
#else
                attn_phase(c, (const bf16*)(ws + WS_Q), (const bf16*)(ws + WS_KV), (bf16*)(ws + WS_AO), p.att_rel_bias + (size_t)(l - 2) * AH * NREL);
#endif
            END_STEP
        }
        BEGIN_STEP(6)
            const int K = l < 2 ? RVW : DM;
            pg8::Gemm g{l < 2 ? (const bf16*)(ws + WS_G) : (const bf16*)(ws + WS_AO), l < 2 ? (const bf16*)(ws + WS_WOUT) + (size_t)l * DM * RVW : (const bf16*)(ws + WS_WO) + (size_t)(l - 2) * DM * DM, NTOK, DM, K};
            pg8::StaticOrder S; S.init(NTOK, DM, c.G, c.bx);
            pg8::EpiRes E{X, DM, H, p.ln_ffn + (size_t)l * DM, (float*)(ws + WS_SQP)};
            pg8::gemm_phase<pg8::EpiRes, pg8::StaticOrder>(c.lds, g, S, E, nullptr);
        END_STEP
        BEGIN_STEP(8)
            pg8::Gemm g{H, (const bf16*)(ws + WS_WC) + (size_t)l * DM * DM, NTOK, DM, DM}; pg8::StaticOrder S; S.init(NTOK, DM, c.G, c.bx);
            pg8::EpiF32 E{(float*)(ws + WS_SC), DM};
            pg8::gemm_phase<pg8::EpiF32, pg8::StaticOrder>(c.lds, g, S, E, nullptr);
        END_STEP
        BEGIN_STEP(9)
            peer_topk_phase(c, (const float*)(ws + WS_SC), (int*)(ws + WS_IDX), (float*)(ws + WS_WGT), (const float*)(ws + WS_SQP), (float*)(ws + WS_RSTD));
        END_STEP
        BEGIN_STEP(10)
#ifdef DRYIDXMASK
            peer_u_phase(c, H, ws + WS_PU + (size_t)l * PE * DM, (const int*)(ws + WS_IDX), (float*)(ws + WS_SC), rep_ == 0 ? DRYIDXMASK : 0xffffffffu);
#else
            peer_u_phase(c, H, ws + WS_PU + (size_t)l * PE * DM, (const int*)(ws + WS_IDX), (float*)(ws + WS_SC));
#endif
        END_STEP
        BEGIN_STEP(11)
            peer_a_phase(c, (const float*)(ws + WS_SC), (const int*)(ws + WS_IDX), (float*)(ws + WS_WGT), (const float*)(ws + WS_RS) + (size_t)l * PE, (const float*)(ws + WS_RS) + (size_t)(DEPTH + l) * PE, (const float*)(ws + WS_RSTD));
        END_STEP
        BEGIN_STEP(12)
#ifdef VREF
            peer_v_ref_phase(c, ws + WS_PV + (size_t)l * PE * DM, (const int*)(ws + WS_IDX), (const float*)(ws + WS_WGT), X);
#else
            peer_v_phase(c, ws + WS_PV + (size_t)l * PE * DM, (const int*)(ws + WS_IDX), (const float*)(ws + WS_WGT), X);
#endif
        END_STEP
        BEGIN_STEP(13)
            const int mode = (l == DEPTH - 1) ? 2 : (l == 1 ? 1 : 0);
            norm_phase(c, X, mode, mode == 2 ? p.ln_final : p.ln_mix + (size_t)(l + 1) * DM, p.kv_norm, H, HKV);
        END_STEP
    }
#ifdef DIAGBUF
    if ((MASK >> 14) & 1) { MK_CTX(); diag_copy_phase(c, X, ws); }
#else
    if ((MASK >> 14) & 1) { MK_CTX(); MK_P(); rms_final_phase(c, X, p.ln_final); }
#endif
#undef BEGIN_STEP
#undef END_STEP
}

#ifndef N_LAUNCH_CUT
#define N_LAUNCH_CUT 1
#endif
typedef void (*kern_t)(Params);
template <int SITE> static void launch_site(const Params& p, hipStream_t stream) {
    static bool attr = false;
    if (!attr) { (void)hipFuncSetAttribute((const void*)yoco_fwd<(1 << SITE)>, hipFuncAttributeMaxDynamicSharedMemorySize, LDS_BYTES); attr = true; }
    hipLaunchKernelGGL((yoco_fwd<(1 << SITE)>), dim3(256), dim3(512), LDS_BYTES, stream, p);
}
#ifndef MEGASITES
#define MEGASITES 0
#endif
static void launch_step_site(int site, const Params& p, hipStream_t stream) {
    if ((MEGASITES >> site) & 1) { hipLaunchKernelGGL((yoco_fwd<0x3FFF>), dim3(256), dim3(512), LDS_BYTES, stream, p); return; }
    switch (site) {
        case 0: launch_site<0>(p, stream); break; case 1: launch_site<1>(p, stream); break; case 2: launch_site<2>(p, stream); break; case 3: launch_site<3>(p, stream); break;
        case 4: launch_site<4>(p, stream); break; case 5: launch_site<5>(p, stream); break; case 6: launch_site<6>(p, stream); break; case 7: launch_site<7>(p, stream); break;
        case 8: launch_site<8>(p, stream); break; case 9: launch_site<9>(p, stream); break; case 10: launch_site<10>(p, stream); break; case 11: launch_site<11>(p, stream); break; case 12: launch_site<12>(p, stream); break; case 13: launch_site<13>(p, stream); break; default: launch_site<14>(p, stream); break;
    }
}
extern "C" void kernel_launch(void* const* d_in, const int* in_sizes, int n_in, void* d_out, int out_size, void* d_ws, size_t ws_size, hipStream_t stream) {
    static int ready = 0;
    if (ready == 0) {
        if (n_in != 16 || out_size != NTOK * DM || ws_size < WS_END) { fprintf(stderr, "kernel_launch: unexpected sizes (n_in %d out %d ws %zu, need %zu)\n", n_in, out_size, ws_size, (size_t)WS_END); ready = -1; return; }
#if N_LAUNCH_CUT || MEGASITES
        if (hipFuncSetAttribute((const void*)yoco_fwd<0x3FFF>, hipFuncAttributeMaxDynamicSharedMemorySize, LDS_BYTES) != hipSuccess) { fprintf(stderr, "kernel_launch: hipFuncSetAttribute failed\n"); ready = -1; return; }
#endif
        ready = 1;
    }
    if (ready < 0) return;
    (void)hipMemsetAsync(d_ws, 0, 16384, stream);
    Params p{};
    p.x = (const float*)d_in[0]; p.ln_mix = (const float*)d_in[1]; p.ln_ffn = (const float*)d_in[2]; p.ret_w_in = (const float*)d_in[3]; p.ret_w_out = (const float*)d_in[4]; p.ret_gn = (const float*)d_in[5];
    p.kv_norm = (const float*)d_in[6]; p.w_kv = (const float*)d_in[7]; p.att_w_q = (const float*)d_in[8]; p.att_w_o = (const float*)d_in[9]; p.att_rel_bias = (const float*)d_in[10];
    p.peer_w_q = (const float*)d_in[11]; p.peer_sub_keys = (const float*)d_in[12]; p.peer_u = (const float*)d_in[13]; p.peer_v = (const float*)d_in[14]; p.ln_final = (const float*)d_in[15];
    p.out = (float*)d_out; p.ws = (unsigned char*)d_ws;
#if N_LAUNCH_CUT == 2
    for (int s2 = 0; s2 < NSTEPS; ++s2) { p.lo = s2; p.hi = s2 + 1; hipLaunchKernelGGL((yoco_fwd<0x3FFF>), dim3(256), dim3(512), LDS_BYTES, stream, p); }
#elif N_LAUNCH_CUT
    p.lo = 0; p.hi = NSTEPS;
    hipLaunchKernelGGL((yoco_fwd<0x3FFF>), dim3(256), dim3(512), LDS_BYTES, stream, p);
#else
    static const int siteA[10] = {1, 2, 3, 6, 8, 9, 10, 11, 12, 13}, siteB[9] = {4, 5, 6, 8, 9, 10, 11, 12, 13};
    int s = 0;
#ifndef NSTOP
#define NSTOP 1000
#endif
    p.lo = s; p.hi = s + 1; launch_step_site(0, p, stream); ++s;
    for (int l = 0; l < DEPTH; ++l) { const int n = l < 2 ? 10 : 9; for (int k = 0; k < n; ++k) { p.lo = s; p.hi = s + 1; if (s < NSTOP) launch_step_site(l < 2 ? siteA[k] : siteB[k], p, stream); ++s; } }
    if (NSTOP < NSTEPS) { p.lo = -1; p.hi = -1; launch_step_site(14, p, stream); }
#endif
}
```

```cpp
#include <hip/hip_runtime.h>
#include <cstdio>
#include <cstdint>

#define LAS __attribute__((address_space(3)))
#define GAS __attribute__((address_space(1)))
typedef unsigned short bf16;
typedef unsigned u32x2 __attribute__((ext_vector_type(2)));
typedef float f32x2v __attribute__((ext_vector_type(2)));

constexpr int DM = 2048, NBATCH = 4, SEQ = 4096, NTOK = NBATCH * SEQ, DEPTH = 4;
constexpr int CHUNK = 64, NCHUNK = SEQ / CHUNK;
constexpr int RH = 8, RQK = 256, RV = 512, RQKW = RH * RQK, RVW = RH * RV, RIN = 2 * RQKW + 2 * RVW;
constexpr int AH = 16, AHD = 128, LEFT = 8, NREL = 257;
constexpr int PH = 8, PNK = 128, PE = PNK * PNK, PTOPK = 16;
constexpr float EPS = 1e-6f;

constexpr size_t MiB = 1ull << 20;
constexpr size_t WS_CTL = 0, CTL_BYTES = 1 * MiB;
constexpr size_t WS_ROT = 1 * MiB;
constexpr size_t WS_RS = 6 * MiB;
constexpr size_t WS_WIN = 8 * MiB;
constexpr size_t WS_WOUT = 104 * MiB;
constexpr size_t WS_WKV = 136 * MiB;
constexpr size_t WS_WQ = 152 * MiB;
constexpr size_t WS_WO = 168 * MiB;
constexpr size_t WS_WC = 184 * MiB;
constexpr size_t WS_PU = 216 * MiB;
constexpr size_t WS_PV = 472 * MiB;
constexpr size_t WS_H = 728 * MiB;
constexpr size_t WS_HKV = 792 * MiB;
constexpr size_t WS_Q = 856 * MiB;
constexpr size_t WS_K = 920 * MiB;
constexpr size_t WS_V = 984 * MiB;
constexpr size_t WS_G = 1112 * MiB;
constexpr size_t WS_O = 1240 * MiB;
constexpr size_t WS_KV = 1368 * MiB;
constexpr size_t WS_AO = 1496 * MiB;
constexpr size_t WS_SC = 1560 * MiB;
constexpr size_t WS_IDX = 1688 * MiB;
constexpr size_t WS_WGT = 1696 * MiB;
constexpr size_t WS_SQP = 1704 * MiB;
constexpr size_t WS_RSTD = 1706 * MiB;
constexpr size_t WS_END = 1708 * MiB;

constexpr int LDS_BYTES = 160 * 1024;
constexpr int LDS_MISC = LDS_BYTES - 256;

__device__ __forceinline__ unsigned f2bf(float f) { unsigned u = __builtin_bit_cast(unsigned, f); return (u + 0x7fffu + ((u >> 16) & 1u)) >> 16; }
typedef __bf16 bfx2_t __attribute__((ext_vector_type(2)));
__device__ __forceinline__ unsigned pk2(float lo, float hi) { const f32x2v v = {lo, hi}; return __builtin_bit_cast(unsigned, __builtin_convertvector(v, bfx2_t)); }
__device__ __forceinline__ float bflo(unsigned u) { return __builtin_bit_cast(float, u << 16); }
__device__ __forceinline__ float bfhi(unsigned u) { return __builtin_bit_cast(float, u & 0xffff0000u); }
__device__ __forceinline__ float wave_sum(float v) {
#pragma unroll
    for (int o = 1; o < 64; o <<= 1) v += __shfl_xor(v, o);
    return v;
}
#define VM_WAIT() asm volatile("s_waitcnt vmcnt(0)" ::: "memory")
#define LDS_WAIT() asm volatile("s_waitcnt lgkmcnt(0)" ::: "memory")

#define XB_TMO      128
#define XB_XCNT(j)  (256  + 64 * (j))
#define XB_XSUB(j)  (1280 + 64 * (j))
#define XB_XGEN(j)  (2304 + 64 * (j))
#define XB_TOP      3328
#define XB_TOPGEN   3392
#define XCD_BAR_WORDS 3456
#define XB_SPIN_CAP (1u << 18)

__device__ __forceinline__ unsigned xb_ld(unsigned* p)              { return __hip_atomic_load(p, __ATOMIC_RELAXED, __HIP_MEMORY_SCOPE_AGENT); }
__device__ __forceinline__ unsigned xb_add(unsigned* p, unsigned v) { return __hip_atomic_fetch_add(p, v, __ATOMIC_RELAXED, __HIP_MEMORY_SCOPE_AGENT); }
__device__ __forceinline__ unsigned xb_xcc_id() { return (unsigned)__builtin_amdgcn_s_getreg((3 << 11) | 20) & 0xFu; }
#define XB_SPIN(cond, bar) do { unsigned _sp = 0; while (cond) { __builtin_amdgcn_s_sleep(1); \
    if ((++_sp & 255u) == 0u) { if (xb_ld(&(bar)[XB_TMO])) break; if (_sp > XB_SPIN_CAP) { atomicAdd(&(bar)[XB_TMO], 1u); break; } } } } while (0)

struct XcdBarrier {
    unsigned* bar; unsigned x;
    volatile LAS unsigned* st;
};

__device__ __forceinline__ XcdBarrier xcd_barrier_post(unsigned* bar, volatile LAS unsigned* st) {
    XcdBarrier b; b.bar = bar; b.x = xb_xcc_id(); b.st = st;
    if (threadIdx.x == 0) (void)xb_add(&bar[XB_XCNT(b.x)], 1u);
    return b;
}
__device__ __forceinline__ void xcd_barrier_complete(unsigned* bar, unsigned x, unsigned& nloc, unsigned& nx) {
    const unsigned G = gridDim.x * gridDim.y * gridDim.z;
    unsigned sum, cnt, mine, sp = 0u;
    for (;;) {
        sum = 0u; cnt = 0u; mine = 0u;
#pragma unroll
        for (unsigned j = 0; j < 16; ++j) { const unsigned c = xb_ld(&bar[XB_XCNT(j)]); sum += c; cnt += (c > 0u) ? 1u : 0u; mine = (j == x) ? c : mine; }
        if (sum == G) break;
        __builtin_amdgcn_s_sleep(1);
        if ((++sp & 255u) == 0u) { if (xb_ld(&bar[XB_TMO])) break; if (sp > XB_SPIN_CAP) { atomicAdd(&bar[XB_TMO], 1u); break; } }
    }
    nloc = mine > 0u ? mine : 1u; nx = cnt > 0u ? cnt : 1u;
}

__device__ __forceinline__ void xcd_barrier(const XcdBarrier& b) {
    asm volatile("s_waitcnt vmcnt(0)" ::: "memory");
    __syncthreads();
    if (threadIdx.x == 0) {
        unsigned* bar = b.bar;
        __builtin_amdgcn_s_waitcnt(0);
        unsigned nloc = b.st[0], nx = b.st[1];
        if (nloc == 0u) { xcd_barrier_complete(bar, b.x, nloc, nx); b.st[0] = nloc; b.st[1] = nx; }
        const unsigned old = xb_add(&bar[XB_XSUB(b.x)], 1u);
        const unsigned gen = old / nloc;
        if (old + 1u == (gen + 1u) * nloc) {
            __builtin_amdgcn_fence(__ATOMIC_RELEASE, "agent");
            asm volatile("s_waitcnt vmcnt(0)" ::: "memory");
            const unsigned og = xb_add(&bar[XB_TOP], 1u);
            const unsigned tg = og / nx;
            if (og + 1u == (tg + 1u) * nx) xb_add(&bar[XB_TOPGEN], 1u);
            else XB_SPIN(xb_ld(&bar[XB_TOPGEN]) == tg, bar);
            __builtin_amdgcn_fence(__ATOMIC_ACQUIRE, "agent");
            xb_add(&bar[XB_XGEN(b.x)], 1u);
            asm volatile("s_waitcnt vmcnt(0)" ::: "memory");
        } else {
            XB_SPIN(xb_ld(&bar[XB_XGEN(b.x)]) == gen, bar);
            __builtin_amdgcn_fence(__ATOMIC_ACQUIRE, "agent");
            asm volatile("s_waitcnt vmcnt(0)" ::: "memory");
        }
    }
    __syncthreads();
}

namespace pg8 {
#define PG8_LAS __attribute__((address_space(3)))
typedef unsigned short bf16_t;
typedef short bf16x8 __attribute__((ext_vector_type(8)));
typedef float f32x4 __attribute__((ext_vector_type(4)));
typedef unsigned u32x4 __attribute__((ext_vector_type(4)));
constexpr int BM = 256, BK = 64, HALF = 128, HTB = HALF * BK * 2  , STAGE_BYTES = 8 * HTB, NXCD = 8, WGM = 8;

__host__ __device__ __forceinline__ int lds_byte(int r, int c) { const int st = (r >> 4) * 2 + (c >> 5), rr = r & 15, cc = c & 31, ob = rr * 64 + cc * 2; return st * 1024 + (ob ^ (((ob >> 9) & 1) << 5)); }
__host__ __device__ __forceinline__ void stage_rc(int b, int& R, int& C) { const int st = b / 1024, sb = b % 1024, swz = sb ^ (((sb >> 9) & 1) << 5); R = (st >> 1) * 16 + swz / 64; C = (st & 1) * 32 + (swz % 64) / 2; }
__host__ __device__ __forceinline__ int perm32(int rho) { const int n = rho >> 4, i = rho & 15; return 8 * (i >> 2) + 4 * n + (i & 3); }

struct Unit { int pm, pn; };
struct Gemm { const bf16_t* A; const bf16_t* Bt; int M, N, K; };

struct StaticOrder {
    int nM, nN, nwg, G, c;
    __host__ __device__ void init(int M, int N, int G_, int c_) { nM = M / BM; nN = N / BM; nwg = nM * nN; G = G_; c = c_; }
    __host__ __device__ bool next(int i, Unit& u) const {
        const long L = (long)i * G + c; if (L >= nwg) return false;
        int wgid = (int)L; { const int q = nwg / NXCD, r = nwg % NXCD, xcd = wgid % NXCD, off = wgid / NXCD; wgid = (xcd < r ? xcd * (q + 1) : r * (q + 1) + (xcd - r) * q) + off; }
        const int nig = WGM * nN, gid = wgid / nig, fm = gid * WGM, gsz = (nM - fm) < WGM ? (nM - fm) : WGM;
        u.pm = fm + ((wgid % nig) % gsz); u.pn = (wgid % nig) / gsz; return true;
    }
    __device__ __forceinline__ void a_ready(const Unit&) const {}
    __device__ __forceinline__ void done(const Unit&) const {}
};
struct CountedOrder : StaticOrder {
    const unsigned* ready; unsigned need; unsigned* tmo;
    __device__ __forceinline__ void a_ready(const Unit& u) const {
        if (threadIdx.x < 64) {
            const unsigned long long t0 = __builtin_amdgcn_s_memrealtime(); unsigned polls = 0;
            while ((unsigned)__builtin_amdgcn_readfirstlane(__hip_atomic_load(ready + 64 * u.pm, __ATOMIC_RELAXED, __HIP_MEMORY_SCOPE_AGENT)) < need) {
                if ((++polls & 255u) == 0u && __builtin_amdgcn_readfirstlane(__hip_atomic_load(tmo, __ATOMIC_RELAXED, __HIP_MEMORY_SCOPE_AGENT)) != 0u) break;
                if (__builtin_amdgcn_s_memrealtime() - t0 > 2000000ull) {
                    if (threadIdx.x == 0) { unsigned expect = 0u; __hip_atomic_compare_exchange_strong(tmo + 1, &expect, 0x600u | (unsigned)(u.pm & 0xff), __ATOMIC_RELAXED, __ATOMIC_RELAXED, __HIP_MEMORY_SCOPE_AGENT); __hip_atomic_store(tmo, 1u, __ATOMIC_RELAXED, __HIP_MEMORY_SCOPE_AGENT); }
                    break; }
                __builtin_amdgcn_s_sleep(2); }
            __builtin_amdgcn_fence(__ATOMIC_ACQUIRE, "agent");
            asm volatile("s_waitcnt vmcnt(0)" ::: "memory");
        }
#if !defined(BROKEN_HOOK_NO_BARRIER)
        asm volatile("" ::: "memory"); __builtin_amdgcn_s_barrier(); asm volatile("" ::: "memory");
#endif
    }
};

__device__ __forceinline__ unsigned cvt_pk_bf16(float lo, float hi) { return pk2(lo, hi); }
typedef float f32x2 __attribute__((ext_vector_type(2)));
__device__ __forceinline__ f32x2 gelu_pk(f32x2 v) {
    const f32x2 av = __builtin_elementwise_abs(v), d = av * 0.2316418882f + 1.0f;
    f32x2 t; t.x = __builtin_amdgcn_rcpf(d.x); t.y = __builtin_amdgcn_rcpf(d.y);
    f32x2 q = t * 0.5307027145f + (-0.7265760135f); q = q * t + 0.7107068705f; q = q * t + (-0.142248368f); q = q * t + 0.127414796f; q = q * t;
    const f32x2 s = (v * v) * (-0.72134752044f);
    f32x2 e; e.x = __builtin_amdgcn_exp2f(s.x); e.y = __builtin_amdgcn_exp2f(s.y);
    const f32x2 m = v * (q * e), r = v - m;
    f32x2 o; o.x = v.x < 0.f ? m.x : r.x; o.y = v.y < 0.f ? m.y : r.y; return o;
}


struct EpiF32 {
    static constexpr bool PERM = false, AFTER_DRAIN = false;
    float* C; int ldc;
    __device__ __forceinline__ void operator()(const f32x4 (&acc)[2][2][4][2], const Unit& u, int wr, int wc, int fr, int fq) const {
        const int row0 = u.pm * BM + wr * 64 + fr, col0 = u.pn * BM + wc * 32 + 4 * fq;
#pragma unroll
        for (int ai = 0; ai < 2; ++ai)
#pragma unroll
            for (int m = 0; m < 4; ++m) { float* rowp = C + (size_t)(row0 + ai * HALF + m * 16) * ldc + col0;
#pragma unroll
                for (int bj = 0; bj < 2; ++bj)
#pragma unroll
                    for (int n = 0; n < 2; ++n) *(f32x4*)(rowp + bj * HALF + n * 16) = acc[ai][bj][m][n]; }
    }
};
struct EpiRes {
    static constexpr bool PERM = false, AFTER_DRAIN = false;
    float* X; int ldc; bf16_t* Hn; const float* gn; float* sqp;
    __device__ __forceinline__ void operator()(const f32x4 (&acc)[2][2][4][2], const Unit& u, int wr, int wc, int fr, int fq) const {
        const int row0 = u.pm * BM + wr * 64 + fr, col0 = u.pn * BM + wc * 32 + 4 * fq;
        f32x4 gv[2][2];
#pragma unroll
        for (int bj = 0; bj < 2; ++bj)
#pragma unroll
            for (int n = 0; n < 2; ++n) gv[bj][n] = *(const f32x4*)(gn + col0 + bj * HALF + n * 16);
#pragma unroll
        for (int ai = 0; ai < 2; ++ai) {
            f32x4 old[4][2][2];
#pragma unroll
            for (int m = 0; m < 4; ++m) { const float* rp = X + (size_t)(row0 + ai * HALF + m * 16) * ldc + col0;
#pragma unroll
                for (int bj = 0; bj < 2; ++bj)
#pragma unroll
                    for (int n = 0; n < 2; ++n) old[m][bj][n] = *(const f32x4*)(rp + bj * HALF + n * 16); }
#pragma unroll
            for (int m = 0; m < 4; ++m) { const int r = row0 + ai * HALF + m * 16; float* rowp = X + (size_t)r * ldc + col0; bf16_t* hp = Hn + (size_t)r * ldc + col0;
                float ss = 0.f;
#pragma unroll
                for (int bj = 0; bj < 2; ++bj)
#pragma unroll
                    for (int n = 0; n < 2; ++n) { const f32x4 xn = old[m][bj][n] + acc[ai][bj][m][n]; *(f32x4*)(rowp + bj * HALF + n * 16) = xn;
                        ss += (xn[0] * xn[0] + xn[1] * xn[1]) + (xn[2] * xn[2] + xn[3] * xn[3]);
                        const f32x4 hg = xn * gv[bj][n]; u32x2 hw; hw.x = pk2(hg[0], hg[1]); hw.y = pk2(hg[2], hg[3]); *(u32x2*)(hp + bj * HALF + n * 16) = hw; }
                ss += __shfl_xor(ss, 16); ss += __shfl_xor(ss, 32);
                if (fq == 0) sqp[(size_t)r * 32 + u.pn * 4 + wc] = ss; }
        }
    }
};
struct EpiBf16S {
    static constexpr bool PERM = true, AFTER_DRAIN = false;
    bf16_t* O; int ldc; float scale;
    __device__ __forceinline__ void operator()(const f32x4 (&acc)[2][2][4][2], const Unit& u, int wr, int wc, int fr, int fq) const {
        const int row0 = u.pm * BM + wr * 64 + fr, col0 = u.pn * BM + wc * 32 + 8 * fq;
#pragma unroll
        for (int ai = 0; ai < 2; ++ai)
#pragma unroll
            for (int m = 0; m < 4; ++m) { bf16_t* rowp = O + (size_t)(row0 + ai * HALF + m * 16) * ldc + col0;
#pragma unroll
                for (int bj = 0; bj < 2; ++bj) { const f32x4 v0 = acc[ai][bj][m][0] * scale, v1 = acc[ai][bj][m][1] * scale;
                    u32x4 w; w.x = cvt_pk_bf16(v0[0], v0[1]); w.y = cvt_pk_bf16(v0[2], v0[3]); w.z = cvt_pk_bf16(v1[0], v1[1]); w.w = cvt_pk_bf16(v1[2], v1[3]);
                    *(u32x4*)(rowp + bj * HALF) = w; } }
    }
};
struct EpiProj {
    static constexpr bool PERM = true, AFTER_DRAIN = false;
    bf16_t *Q, *Kp, *V, *G; const float* rot;
    __device__ __forceinline__ void operator()(const f32x4 (&acc)[2][2][4][2], const Unit& u, int wr, int wc, int fr, int fq) const {
        const int row0 = u.pm * BM + wr * 64 + fr, pn = u.pn, dd0 = wc * 32 + 8 * fq;
        if (pn < 16) {
            bf16_t* base = (pn < 8 ? Q : Kp) + (pn & 7) * 256 + dd0; const float sc = pn < 8 ? 1.0f : 0.0625f;
#pragma unroll
            for (int ai = 0; ai < 2; ++ai)
#pragma unroll
                for (int m = 0; m < 4; ++m) { const int r = row0 + ai * HALF + m * 16; const float* rt = rot + (size_t)(r & (4096 - 1)) * 256 + dd0;
                    f32x4 o1[2], o2[2];
#pragma unroll
                    for (int n = 0; n < 2; ++n) { const f32x4 cs = *(const f32x4*)(rt + 4 * n), sn = *(const f32x4*)(rt + 128 + 4 * n); const f32x4 t1 = acc[ai][0][m][n], t2 = acc[ai][1][m][n];
                        o1[n] = (t1 * cs - t2 * sn) * sc; o2[n] = (t1 * sn + t2 * cs) * sc; }
                    u32x4 w1, w2;
                    w1.x = cvt_pk_bf16(o1[0][0], o1[0][1]); w1.y = cvt_pk_bf16(o1[0][2], o1[0][3]); w1.z = cvt_pk_bf16(o1[1][0], o1[1][1]); w1.w = cvt_pk_bf16(o1[1][2], o1[1][3]);
                    w2.x = cvt_pk_bf16(o2[0][0], o2[0][1]); w2.y = cvt_pk_bf16(o2[0][2], o2[0][3]); w2.z = cvt_pk_bf16(o2[1][0], o2[1][1]); w2.w = cvt_pk_bf16(o2[1][2], o2[1][3]);
                    bf16_t* rowp = base + (size_t)r * 2048; *(u32x4*)rowp = w1; *(u32x4*)(rowp + 128) = w2; }
        } else {
            bf16_t* base = (pn < 32 ? V : G) + ((pn - 16) & 15) * 256 + dd0;
#pragma unroll
            for (int ai = 0; ai < 2; ++ai)
#pragma unroll
                for (int m = 0; m < 4; ++m) { bf16_t* rowp = base + (size_t)(row0 + ai * HALF + m * 16) * 4096;
#pragma unroll
                    for (int bj = 0; bj < 2; ++bj) { const f32x4 v0 = acc[ai][bj][m][0], v1 = acc[ai][bj][m][1];
                        u32x4 w; w.x = cvt_pk_bf16(v0[0], v0[1]); w.y = cvt_pk_bf16(v0[2], v0[3]); w.z = cvt_pk_bf16(v1[0], v1[1]); w.w = cvt_pk_bf16(v1[2], v1[3]);
                        *(u32x4*)(rowp + bj * HALF) = w; } }
        }
    }
};
template <class Epi, class Sched, bool STAMP = false>
__device__ __forceinline__ void gemm_phase(PG8_LAS unsigned char* lds, const Gemm g, const Sched& S, const Epi& E, unsigned long long* stamps) {
    int tid_ = threadIdx.x; asm volatile("" : "+v"(tid_));
    const int tid = tid_, wid = __builtin_amdgcn_readfirstlane(tid >> 6), lane = tid & 63, wr = wid >> 2, wc = wid & 3, fr = lane & 15, fq = lane >> 4;
    const int K = g.K, nt = K / BK;
    int ts_lo = 0, ts_hi = 0, nts = 0; const unsigned long long rt_entry = STAMP ? (unsigned long long)wall_clock64() : 0ull;
#define PG8_STAMP() do { if (STAMP && wid == 0 && nts < 64) { const unsigned long long _c = (unsigned long long)clock64(); \
        ts_lo = (lane == nts) ? (int)(unsigned)_c : ts_lo; ts_hi = (lane == nts) ? (int)(unsigned)(_c >> 32) : ts_hi; ++nts; } } while (0)
    PG8_STAMP();
    unsigned voffA[2], voffB[2];
#pragma unroll
    for (int i = 0; i < 2; ++i) { int R, C; stage_rc(tid * 16 + i * 8192, R, C); const int Rb = Epi::PERM ? ((R & ~31) + perm32(R & 31)) : R;
        voffA[i] = (unsigned)(R * K + C) * 2u; voffB[i] = (unsigned)(Rb * K + C) * 2u; }
    const size_t kstep = (size_t)(BK * 2);
    const size_t hstep = (size_t)HALF * K * 2;
    const size_t tstep = 2 * hstep;
    const unsigned ldsw = (unsigned)wid * 1024u;
    const int aoff = lds_byte(wr * 64 + fr, fq * 8), boff = lds_byte(wc * 32 + fr, fq * 8);
#define PG8_SA(b, h) (((b) * 2 + (h)) * HTB)
#define PG8_SB(b, h) ((4 + (b) * 2 + (h)) * HTB)
#define PG8_STAGE(bufoff, gbase, voff) do { _Pragma("unroll") for (int _i = 0; _i < 2; ++_i) \
        __builtin_amdgcn_global_load_lds((const unsigned*)((const char*)(gbase) + (voff)[_i]), (PG8_LAS unsigned*)(lds + (bufoff) + ldsw + _i * 8192), 16, 0, 0); } while (0)
#define PG8_LDA(dst, b, h) do { _Pragma("unroll") for (int m = 0; m < 4; ++m) _Pragma("unroll") for (int k = 0; k < 2; ++k) dst[m][k] = *(const PG8_LAS bf16x8*)(lds + PG8_SA(b, h) + aoff + m * 2048 + k * 1024); } while (0)
#define PG8_LDB(dst, b, h) do { _Pragma("unroll") for (int n = 0; n < 2; ++n) _Pragma("unroll") for (int k = 0; k < 2; ++k) dst[n][k] = *(const PG8_LAS bf16x8*)(lds + PG8_SB(b, h) + boff + n * 2048 + k * 1024); } while (0)
#define PG8_MMA(ai, bj, At, Bt) do { __builtin_amdgcn_s_setprio(1); _Pragma("unroll") for (int m = 0; m < 4; ++m) _Pragma("unroll") for (int n = 0; n < 2; ++n) _Pragma("unroll") for (int k = 0; k < 2; ++k) \
        acc[ai][bj][m][n] = __builtin_amdgcn_mfma_f32_16x16x32_bf16(Bt[n][k], At[m][k], acc[ai][bj][m][n], 0, 0, 0); __builtin_amdgcn_s_setprio(0); } while (0)
#define PG8_WAIT_V(n) asm volatile("s_waitcnt vmcnt(" #n ")" ::: "memory")
#define PG8_WAIT_L(n) asm volatile("s_waitcnt lgkmcnt(" #n ")" ::: "memory")
#define PG8_BAR __builtin_amdgcn_s_barrier()
#define PG8_SCHED __builtin_amdgcn_sched_barrier(0)
    Unit cur, nxt; int ui = 0;
    if (!S.next(0, cur)) return;
    f32x4 acc[2][2][4][2];
#pragma unroll
    for (int a = 0; a < 2; ++a)
#pragma unroll
        for (int b = 0; b < 2; ++b)
#pragma unroll
            for (int m = 0; m < 4; ++m)
#pragma unroll
                for (int n = 0; n < 2; ++n) acc[a][b][m][n] = (f32x4){0.f, 0.f, 0.f, 0.f};
    bf16x8 At[4][2], B0[2][2], B1[2][2];
    const char* cA = (const char*)g.A + (size_t)cur.pm * tstep; const char* cB = (const char*)g.Bt + (size_t)cur.pn * tstep;
    S.a_ready(cur);
    PG8_STAGE(PG8_SB(0, 0), cB, voffB); PG8_STAGE(PG8_SA(0, 0), cA, voffA); PG8_STAGE(PG8_SB(0, 1), cB + hstep, voffB); PG8_STAGE(PG8_SA(0, 1), cA + hstep, voffA);
    if (wr == 1) PG8_BAR;
    PG8_WAIT_V(4); PG8_BAR;
    PG8_STAGE(PG8_SB(1, 0), cB + kstep, voffB); PG8_STAGE(PG8_SA(1, 0), cA + kstep, voffA); PG8_STAGE(PG8_SB(1, 1), cB + hstep + kstep, voffB);
    PG8_WAIT_V(6); PG8_BAR;
    PG8_STAMP();
    for (;;) {
        const bool has_next = S.next(ui + 1, nxt);
        const char* nA = has_next ? (const char*)g.A + (size_t)nxt.pm * tstep : cA; const char* nB = has_next ? (const char*)g.Bt + (size_t)nxt.pn * tstep : cB;
        for (int t = 0; t < nt; t += 2) {
            const bool last = (t == nt - 2);
            const char* a1 = cA + (size_t)(t + 1) * kstep;
            const char* a2 = last ? nA : cA + (size_t)(t + 2) * kstep; const char* b2 = last ? nB : cB + (size_t)(t + 2) * kstep;
            const char* a3 = a2 + kstep; const char* b3 = b2 + kstep;
            if (last && has_next) S.a_ready(nxt);
            PG8_LDB(B0, 0, 0); PG8_SCHED; PG8_LDA(At, 0, 0); PG8_STAGE(PG8_SA(1, 1), a1 + hstep, voffA);
            PG8_WAIT_L(8); PG8_BAR; PG8_WAIT_L(0); PG8_MMA(0, 0, At, B0); PG8_BAR; PG8_SCHED;
            PG8_LDB(B1, 0, 1); PG8_STAGE(PG8_SB(0, 0), b2, voffB);
            PG8_BAR; PG8_WAIT_L(0); PG8_MMA(0, 1, At, B1); PG8_BAR;
            PG8_LDA(At, 0, 1); PG8_STAGE(PG8_SA(0, 0), a2, voffA);
            PG8_BAR; PG8_WAIT_L(0); PG8_MMA(1, 0, At, B0); PG8_BAR; PG8_SCHED;
            PG8_STAGE(PG8_SB(0, 1), b2 + hstep, voffB);
            PG8_WAIT_V(6); PG8_BAR; PG8_MMA(1, 1, At, B1); PG8_BAR;
            PG8_LDB(B0, 1, 0); PG8_SCHED; PG8_LDA(At, 1, 0); PG8_STAGE(PG8_SA(0, 1), a2 + hstep, voffA);
            PG8_WAIT_L(8); PG8_BAR; PG8_WAIT_L(0); PG8_MMA(0, 0, At, B0); PG8_BAR; PG8_SCHED;
            PG8_LDB(B1, 1, 1); PG8_STAGE(PG8_SB(1, 0), b3, voffB);
            PG8_BAR; PG8_WAIT_L(0); PG8_MMA(0, 1, At, B1); PG8_BAR;
            PG8_LDA(At, 1, 1); PG8_STAGE(PG8_SA(1, 0), a3, voffA);
            PG8_BAR; PG8_WAIT_L(0); PG8_MMA(1, 0, At, B0); PG8_BAR; PG8_SCHED;
            PG8_STAGE(PG8_SB(1, 1), b3 + hstep, voffB);
            PG8_WAIT_V(6); PG8_BAR; PG8_MMA(1, 1, At, B1); PG8_BAR;
        }
        PG8_STAMP();
        if constexpr (!Epi::AFTER_DRAIN) { E(acc, cur, wr, wc, fr, fq); S.done(cur); }
        PG8_STAMP();
        if (!has_next) break;
#pragma unroll
        for (int a = 0; a < 2; ++a)
#pragma unroll
            for (int b = 0; b < 2; ++b)
#pragma unroll
                for (int m = 0; m < 4; ++m)
#pragma unroll
                    for (int n = 0; n < 2; ++n) acc[a][b][m][n] = (f32x4){0.f, 0.f, 0.f, 0.f};
        cur = nxt; cA = nA; cB = nB; ++ui;
    }
    PG8_WAIT_V(0);
    if (wr == 0) PG8_BAR;
    PG8_BAR;
    if constexpr (Epi::AFTER_DRAIN) { E.fused(acc, cur, wr, wc, fr, fq, lds, wid, lane); S.done(cur); }
    PG8_STAMP();
    if (STAMP && wid == 0) { stamps[lane] = lane < nts ? (((unsigned long long)(unsigned)ts_hi << 32) | (unsigned)ts_lo) : 0ull;
        if (lane == 62) stamps[62] = rt_entry; if (lane == 63) stamps[63] = (unsigned long long)wall_clock64(); }
#undef PG8_STAMP
#undef PG8_SA
#undef PG8_SB
#undef PG8_STAGE
#undef PG8_LDA
#undef PG8_LDB
#undef PG8_MMA
#undef PG8_WAIT_V
#undef PG8_WAIT_L
#undef PG8_BAR
#undef PG8_SCHED
}
}

using pg8::bf16x8; using pg8::f32x4; using pg8::u32x4;
typedef short s16x4 __attribute__((ext_vector_type(4)));
typedef __bf16 bfx2 __attribute__((ext_vector_type(2)));

struct Params {
    const float *x, *ln_mix, *ln_ffn, *ret_w_in, *ret_w_out, *ret_gn, *kv_norm, *w_kv, *att_w_q, *att_w_o, *att_rel_bias, *peer_w_q, *peer_sub_keys, *peer_u, *peer_v, *ln_final;
    float* out; unsigned char* ws; int lo, hi;
};
struct Ctx { LAS unsigned char* lds; int tid, lane, wave, bx, G, gw, ngw; };

__device__ __forceinline__ float dot2bf(unsigned a, unsigned b, float c) { return __builtin_amdgcn_fdot2_f32_bf16(__builtin_bit_cast(bfx2, a), __builtin_bit_cast(bfx2, b), c, false); }
__device__ __forceinline__ bf16x8 lds128(LAS const unsigned char* p) { return *(LAS const bf16x8*)p; }
__device__ __forceinline__ bf16x8 tr_frag(unsigned a0, unsigned a1) {
    s16x4 lo, hi;
    asm volatile("ds_read_b64_tr_b16 %0, %2\n\tds_read_b64_tr_b16 %1, %3\n\ts_waitcnt lgkmcnt(0)" : "=&v"(lo), "=&v"(hi) : "v"(a0), "v"(a1) : "memory");
    bf16x8 r; r[0] = lo[0]; r[1] = lo[1]; r[2] = lo[2]; r[3] = lo[3]; r[4] = hi[0]; r[5] = hi[1]; r[6] = hi[2]; r[7] = hi[3]; return r;
}
#define MFMA16(a, b, c) __builtin_amdgcn_mfma_f32_16x16x32_bf16((a), (b), (c), 0, 0, 0)

__device__ __forceinline__ void load_row(const float* xrow, int lane, f32x4 (&v)[8]) {
    const f32x4* xr = (const f32x4*)xrow + lane;
#pragma unroll
    for (int j = 0; j < 8; ++j) v[j] = xr[64 * j];
}
__device__ __forceinline__ float row_rstd(const f32x4 (&v)[8]) {
    float s = 0.f;
#pragma unroll
    for (int j = 0; j < 8; ++j) s += (v[j][0] * v[j][0] + v[j][1] * v[j][1]) + (v[j][2] * v[j][2] + v[j][3] * v[j][3]);
    return 1.0f / sqrtf(wave_sum(s) * (1.0f / DM) + EPS);
}
__device__ __forceinline__ void store_norm_bf16(const f32x4 (&v)[8], float rstd, const float* g, bf16* orow, int lane) {
    const f32x4* gr = (const f32x4*)g + lane; u32x2* o8 = (u32x2*)orow + lane;
#pragma unroll
    for (int j = 0; j < 8; ++j) { const f32x4 gv = gr[64 * j]; u32x2 w; w.x = pk2(v[j][0] * rstd * gv[0], v[j][1] * rstd * gv[1]); w.y = pk2(v[j][2] * rstd * gv[2], v[j][3] * rstd * gv[3]); o8[64 * j] = w; }
}
__device__ __forceinline__ void load_g(const float* g, int lane, f32x4 (&gv)[8]) {
    const f32x4* gr = (const f32x4*)g + lane;
#pragma unroll
    for (int j = 0; j < 8; ++j) gv[j] = gr[64 * j];
}
__device__ __forceinline__ void store_norm_bf16_r(const f32x4 (&v)[8], float rstd, const f32x4 (&gv)[8], bf16* orow, int lane) {
    u32x2* o8 = (u32x2*)orow + lane;
#pragma unroll
    for (int j = 0; j < 8; ++j) { u32x2 w; w.x = pk2(v[j][0] * rstd * gv[j][0], v[j][1] * rstd * gv[j][1]); w.y = pk2(v[j][2] * rstd * gv[j][2], v[j][3] * rstd * gv[j][3]); o8[64 * j] = w; }
}
__device__ __forceinline__ unsigned q8pack(float a, float b, float c, float d) {
    const unsigned ua = __builtin_bit_cast(unsigned, a + 12582912.0f), ub = __builtin_bit_cast(unsigned, b + 12582912.0f), uc = __builtin_bit_cast(unsigned, c + 12582912.0f), ud = __builtin_bit_cast(unsigned, d + 12582912.0f);
    return (ua & 255u) | ((ub & 255u) << 8) | ((uc & 255u) << 16) | (ud << 24);
}

__device__ __forceinline__ void p0_transpose_item(const float* W, int K, int N, bf16* WT, LAS float* scr, int item, int lane) {
    const int nblk = N / 32, kb = item / nblk, nb = item % nblk, k0 = 64 * kb, n0 = 32 * nb;
    float tv[32];
#pragma unroll
    for (int i = 0; i < 32; ++i) { const int kk = 2 * i + (lane >> 5); tv[i] = W[(size_t)(k0 + kk) * N + n0 + (lane & 31)]; }
#pragma unroll
    for (int i = 0; i < 32; ++i) { const int kk = 2 * i + (lane >> 5); scr[kk * 33 + (lane & 31)] = tv[i]; }
    LDS_WAIT(); asm volatile("" ::: "memory");
    const int c = lane & 7;
#pragma unroll
    for (int j = 0; j < 4; ++j) { const int n = (lane >> 3) + 8 * j; const LAS float* s = scr + (8 * c) * 33 + n;
        u32x4 o; o.x = pk2(s[0 * 33], s[1 * 33]); o.y = pk2(s[2 * 33], s[3 * 33]); o.z = pk2(s[4 * 33], s[5 * 33]); o.w = pk2(s[6 * 33], s[7 * 33]);
        *(u32x4*)(WT + (size_t)(n0 + n) * K + k0 + 8 * c) = o; }
    LDS_WAIT(); asm volatile("" ::: "memory");
}
__device__ __forceinline__ void p0_fold_tile(const Params& p, const Ctx& c, int tl) {
    const int l = tl >> 9, hp = (tl >> 5) & 15, j0 = (tl & 31) * 64;
    LAS float* As = (LAS float*)c.lds;
    LAS float* Bs = (LAS float*)c.lds + 64 * 132;
    const float* Wq = p.peer_w_q + (size_t)l * DM * DM; const float* sk = p.peer_sub_keys + ((size_t)l * 2 + (hp & 1)) * PNK * 128;
    __syncthreads();
    for (int i = c.tid; i < 64 * 32; i += 512) { const int jj = i >> 5, d4 = i & 31; *(LAS f32x4*)(As + jj * 132 + d4 * 4) = *(const f32x4*)(Wq + (size_t)(j0 + jj) * DM + hp * 128 + d4 * 4); }
    for (int i = c.tid; i < 128 * 32; i += 512) { const int k = i >> 5, d4 = i & 31; *(LAS f32x4*)(Bs + k * 132 + d4 * 4) = *(const f32x4*)(sk + (size_t)k * 128 + d4 * 4); }
    __syncthreads();
    const int tj = c.tid & 15, tk = c.tid >> 4;
    float acc[4][4];
#pragma unroll
    for (int b = 0; b < 4; ++b)
#pragma unroll
        for (int a = 0; a < 4; ++a) acc[b][a] = 0.f;
    for (int d4 = 0; d4 < 32; ++d4) {
        f32x4 av[4], bv[4];
#pragma unroll
        for (int a = 0; a < 4; ++a) av[a] = *(LAS const f32x4*)(As + (tj + 16 * a) * 132 + d4 * 4);
#pragma unroll
        for (int b = 0; b < 4; ++b) bv[b] = *(LAS const f32x4*)(Bs + (tk * 4 + b) * 132 + d4 * 4);
#pragma unroll
        for (int b = 0; b < 4; ++b)
#pragma unroll
            for (int a = 0; a < 4; ++a) acc[b][a] += (av[a][0] * bv[b][0] + av[a][1] * bv[b][1]) + (av[a][2] * bv[b][2] + av[a][3] * bv[b][3]);
    }
    bf16* WcT = (bf16*)(p.ws + WS_WC) + (size_t)l * DM * DM;
#pragma unroll
    for (int b = 0; b < 4; ++b)
#pragma unroll
        for (int a = 0; a < 4; ++a) WcT[(size_t)(hp * 128 + tk * 4 + b) * DM + j0 + tj + 16 * a] = (bf16)f2bf(acc[b][a]);
}
__device__ __forceinline__ void p0_prologue(const Params& p, const Ctx& c) {
#ifndef PROREP
#define PROREP 0
#endif
    const bool fold_last = (c.bx & 1) != 0;
    if (!fold_last) {
    for (int tl = c.bx; tl < DEPTH * 16 * 32; tl += c.G) p0_fold_tile(p, c, tl);
    __syncthreads();
    }
    for (int rp_ = ((PROREP >> 1) & 1) ? 0 : 1; rp_ < 2; ++rp_)
    {
        LAS float* scr = (LAS float*)(c.lds + c.wave * 16384);
        constexpr int I_IN = (DM / 64) * (RIN / 32), I_OUT = (RVW / 64) * (DM / 32), I_KV = (DM / 64) * (2 * DM / 32), I_SQ = (DM / 64) * (DM / 32);
        constexpr int NITEMS = 2 * I_IN + 2 * I_OUT + I_KV + 4 * I_SQ;
        for (int it = c.gw; it < NITEMS; it += c.ngw) {
            int r = it;
            if (r < 2 * I_IN) { const int l = r / I_IN; p0_transpose_item(p.ret_w_in + (size_t)l * DM * RIN, DM, RIN, (bf16*)(p.ws + WS_WIN) + (size_t)l * RIN * DM, scr, r % I_IN, c.lane); continue; } r -= 2 * I_IN;
            if (r < 2 * I_OUT) { const int l = r / I_OUT; p0_transpose_item(p.ret_w_out + (size_t)l * RVW * DM, RVW, DM, (bf16*)(p.ws + WS_WOUT) + (size_t)l * DM * RVW, scr, r % I_OUT, c.lane); continue; } r -= 2 * I_OUT;
            if (r < I_KV) { p0_transpose_item(p.w_kv, DM, 2 * DM, (bf16*)(p.ws + WS_WKV), scr, r, c.lane); continue; } r -= I_KV;
            if (r < 2 * I_SQ) { const int l = r / I_SQ; p0_transpose_item(p.att_w_q + (size_t)l * DM * DM, DM, DM, (bf16*)(p.ws + WS_WQ) + (size_t)l * DM * DM, scr, r % I_SQ, c.lane); continue; } r -= 2 * I_SQ;
            { const int l = r / I_SQ; p0_transpose_item(p.att_w_o + (size_t)l * DM * DM, DM, DM, (bf16*)(p.ws + WS_WO) + (size_t)l * DM * DM, scr, r % I_SQ, c.lane); }
        }
    }
    for (int rp_ = ((PROREP >> 2) & 1) ? 0 : 1; rp_ < 2; ++rp_)
    {
        float* rs = (float*)(p.ws + WS_RS);
        for (int row = c.gw; row < 2 * DEPTH * PE; row += c.ngw) {
            const int which = row >= DEPTH * PE, r = row - which * DEPTH * PE;
            f32x4 v[8]; load_row((which ? p.peer_v : p.peer_u) + (size_t)r * DM, c.lane, v);
            float am = 0.f;
#pragma unroll
            for (int j = 0; j < 8; ++j) am = fmaxf(fmaxf(am, fmaxf(fabsf(v[j][0]), fabsf(v[j][1]))), fmaxf(fabsf(v[j][2]), fabsf(v[j][3])));
#pragma unroll
            for (int o = 1; o < 64; o <<= 1) am = fmaxf(am, __shfl_xor(am, o));
            int e = (int)((__builtin_bit_cast(unsigned, am) >> 23) & 0xffu) - 127; if (am == 0.f) e = 7;
            int k = 7 - e; k = k < -100 ? -100 : (k > 100 ? 100 : k);
            const float sc = __builtin_bit_cast(float, (unsigned)(k + 127) << 23), rsc = __builtin_bit_cast(float, (unsigned)(127 - k) << 23);
            const int lyr = r / PE, re = r % PE;
            unsigned char* dstb = p.ws + (which ? WS_PV : WS_PU) + (size_t)lyr * PE * DM + (size_t)re * 128;
            if (which) {
#pragma unroll
                for (int j = 0; j < 8; ++j) { int w = 0; w = __builtin_amdgcn_cvt_pk_fp8_f32(v[j][0] * sc, v[j][1] * sc, w, false); w = __builtin_amdgcn_cvt_pk_fp8_f32(v[j][2] * sc, v[j][3] * sc, w, true); { const int col = 4 * c.lane + 256 * j; *(unsigned*)(dstb + (size_t)(col >> 7) * PE * 128 + (col & 127)) = (unsigned)w; } }
                if (c.lane == 0) rs[row] = rsc;
            } else {
                const float s8 = am > 0.f ? 127.0f / am : 0.f;
#pragma unroll
                for (int j = 0; j < 8; ++j) { const unsigned w = q8pack(v[j][0] * s8, v[j][1] * s8, v[j][2] * s8, v[j][3] * s8); const int col = 4 * c.lane + 256 * j; *(unsigned*)(dstb + (size_t)(col >> 7) * PE * 128 + (col & 127)) = w; }
                if (c.lane == 0) rs[row] = am * (1.0f / 127.0f);
            }
        }
    }
    for (int rp_ = ((PROREP >> 3) & 1) ? 0 : 1; rp_ < 2; ++rp_)
    {
        float* rot = (float*)(p.ws + WS_ROT);
        for (int i = c.bx * 512 + c.tid; i < SEQ * 128; i += c.G * 512) { const int pos = i >> 7, d = i & 127;
            const float inv = (float)(1.0 / pow(10000.0, (double)d / 128.0)); const float ang = (float)pos * inv;
            rot[(size_t)pos * 256 + d] = (float)cos((double)ang); rot[(size_t)pos * 256 + 128 + d] = (float)sin((double)ang); }
    }
    for (int rp_ = ((PROREP >> 4) & 1) ? 0 : 1; rp_ < 2; ++rp_)
    { f32x4 gv[8]; load_g(p.ln_mix, c.lane, gv);
      for (int m = c.gw; m < NTOK; m += c.ngw) {
        f32x4 v[8]; load_row(p.x + (size_t)m * DM, c.lane, v);
        f32x4* xo = (f32x4*)(p.out + (size_t)m * DM) + c.lane;
#pragma unroll
        for (int j = 0; j < 8; ++j) xo[64 * j] = v[j];
        store_norm_bf16_r(v, row_rstd(v), gv, (bf16*)(p.ws + WS_H) + (size_t)m * DM, c.lane);
      } }
    if (fold_last) {
    __syncthreads();
    for (int tl = c.bx; tl < DEPTH * 16 * 32; tl += c.G) p0_fold_tile(p, c, tl);
    __syncthreads();
    }
}

constexpr int RS_QS = 0, RS_KS = 33792, RS_VS = 67584, RS_VZ = 76800, RS_PS = 86016, RS_RS = 95232, RS_END = 129024, QK_STR = 528, V_STR = 144;
__device__ __forceinline__ void ret_scan_unit(const Ctx& c, const bf16* Qg, const bf16* Kg, const bf16* Vg, bf16* Og, int unit) {
    const int xg = unit & 7, slot = unit >> 3, pair = xg * 4 + (slot >> 3), es = slot & 7, b = pair >> 3, h = pair & 7;
    const int tid = c.tid, lane = c.lane, w = c.wave, fr = lane & 15, fq = lane >> 4, tq = (lane & 15) >> 2, tp = lane & 3;
    LAS unsigned char* lds = c.lds;
    const float lgam = log1pf(-exp2f(-5.0f - (float)h));
    const float cdec = expf(lgam * 64.0f);
    const int lrow = tid >> 3, lch = tid & 7;
    const size_t tok0 = (size_t)b * SEQ;
    const bf16* qrow = Qg + (tok0 + lrow) * RQKW + h * RQK + lch * 8;
    const bf16* krow = Kg + (tok0 + lrow) * RQKW + h * RQK + lch * 8;
    const bf16* vrow = Vg + (tok0 + lrow) * RVW + h * RV + es * 64 + lch * 8;
    const float zeta = expf(lgam * (float)(63 - lrow));
    u32x4 pq[4], pk[4], pv;
#pragma unroll
    for (int cc = 0; cc < 4; ++cc) { pq[cc] = *(const u32x4*)(qrow + cc * 64); pk[cc] = *(const u32x4*)(krow + cc * 64); }
    pv = *(const u32x4*)vrow;
    __syncthreads();
    for (int i = tid; i < (RS_END - RS_RS) / 16; i += 512) *(LAS u32x4*)(lds + RS_RS + i * 16) = (u32x4){0u, 0u, 0u, 0u};
    f32x4 Racc[2][4];
#pragma unroll
    for (int x = 0; x < 2; ++x)
#pragma unroll
        for (int y = 0; y < 4; ++y) Racc[x][y] = (f32x4){0.f, 0.f, 0.f, 0.f};
    const int jt = w & 3, it0 = 2 * (w >> 2);
    const int it = w & 3, et0 = 2 * (w >> 2);
    float xi[4];
#pragma unroll
    for (int r = 0; r < 4; ++r) xi[r] = expf(lgam * (float)(16 * it + 4 * fq + r + 1));
    const unsigned ldsb = (unsigned)(size_t)lds;
    float dmask[2][4];
#pragma unroll
    for (int x = 0; x < 2; ++x)
#pragma unroll
        for (int r = 0; r < 4; ++r) { const int i = 16 * (it0 + x) + fr, j = 16 * jt + 4 * fq + r; dmask[x][r] = (i >= j) ? expf(lgam * (float)(i - j)) : 0.f; }
    asm volatile("" : "+v"(dmask[0][0]), "+v"(dmask[0][1]), "+v"(dmask[0][2]), "+v"(dmask[0][3]), "+v"(dmask[1][0]), "+v"(dmask[1][1]), "+v"(dmask[1][2]), "+v"(dmask[1][3]));
    for (int n = 0; n < NCHUNK; ++n) {
        __syncthreads();
#pragma unroll
        for (int cc = 0; cc < 4; ++cc) { *(LAS u32x4*)(lds + RS_QS + lrow * QK_STR + (lch + 8 * cc) * 16) = pq[cc]; *(LAS u32x4*)(lds + RS_KS + lrow * QK_STR + (lch + 8 * cc) * 16) = pk[cc]; }
        *(LAS u32x4*)(lds + RS_VS + lrow * V_STR + lch * 16) = pv;
        { u32x4 z; z.x = pk2(bflo(pv.x) * zeta, bfhi(pv.x) * zeta); z.y = pk2(bflo(pv.y) * zeta, bfhi(pv.y) * zeta); z.z = pk2(bflo(pv.z) * zeta, bfhi(pv.z) * zeta); z.w = pk2(bflo(pv.w) * zeta, bfhi(pv.w) * zeta);
          *(LAS u32x4*)(lds + RS_VZ + lrow * V_STR + lch * 16) = z; }
        __syncthreads();
        if (n + 1 < NCHUNK) {
            const size_t adv = (size_t)(n + 1) * CHUNK;
#pragma unroll
            for (int cc = 0; cc < 4; ++cc) { pq[cc] = *(const u32x4*)(qrow + adv * RQKW + cc * 64); pk[cc] = *(const u32x4*)(krow + adv * RQKW + cc * 64); }
            pv = *(const u32x4*)(vrow + adv * RVW);
        }
        {
            f32x4 s0 = (f32x4){0.f, 0.f, 0.f, 0.f}, s1 = s0;
#pragma unroll
            for (int kh = 0; kh < 2; ++kh) {
                bf16x8 fa[4], fb0[4], fb1[4];
#pragma unroll
                for (int k4 = 0; k4 < 4; ++k4) { const int ks = 4 * kh + k4;
                    fa[k4] = lds128(lds + RS_KS + (16 * jt + fr) * QK_STR + (4 * ks + fq) * 16);
                    fb0[k4] = lds128(lds + RS_QS + (16 * it0 + fr) * QK_STR + (4 * ks + fq) * 16);
                    fb1[k4] = lds128(lds + RS_QS + (16 * (it0 + 1) + fr) * QK_STR + (4 * ks + fq) * 16); }
                __builtin_amdgcn_sched_barrier(0);
#pragma unroll
                for (int k4 = 0; k4 < 4; ++k4) { s0 = MFMA16(fa[k4], fb0[k4], s0); s1 = MFMA16(fa[k4], fb1[k4], s1); }
            }
#pragma unroll
            for (int x = 0; x < 2; ++x) { const f32x4 s = x ? s1 : s0; const int i = 16 * (it0 + x) + fr; float pr[4];
#pragma unroll
                for (int r = 0; r < 4; ++r) pr[r] = s[r] * dmask[x][r];
                u32x2 pw; pw.x = pk2(pr[0], pr[1]); pw.y = pk2(pr[2], pr[3]);
                *(LAS u32x2*)(lds + RS_PS + i * V_STR + (16 * jt + 4 * fq) * 2) = pw; }
        }
        f32x4 o0 = (f32x4){0.f, 0.f, 0.f, 0.f}, o1 = o0;
        {
#pragma unroll
            for (int kh = 0; kh < 2; ++kh) {
                bf16x8 fa[4], fb0[4], fb1[4];
#pragma unroll
                for (int k4 = 0; k4 < 4; ++k4) { const int ks = 4 * kh + k4;
                    fa[k4] = lds128(lds + RS_QS + (16 * it + fr) * QK_STR + (4 * ks + fq) * 16);
                    fb0[k4] = lds128(lds + RS_RS + (16 * et0 + fr) * QK_STR + (4 * ks + fq) * 16);
                    fb1[k4] = lds128(lds + RS_RS + (16 * (et0 + 1) + fr) * QK_STR + (4 * ks + fq) * 16); }
                __builtin_amdgcn_sched_barrier(0);
#pragma unroll
                for (int k4 = 0; k4 < 4; ++k4) { o0 = MFMA16(fa[k4], fb0[k4], o0); o1 = MFMA16(fa[k4], fb1[k4], o1); }
            }
        }
#pragma unroll
        for (int r = 0; r < 4; ++r) { o0[r] *= xi[r]; o1[r] *= xi[r]; }
        __syncthreads();
#pragma unroll
        for (int ks = 0; ks < 2; ++ks) {
            const bf16x8 a = lds128(lds + RS_PS + (16 * it + fr) * V_STR + (4 * ks + fq) * 16);
            const unsigned va = ldsb + RS_VS + (32 * ks + 8 * fq + tq) * V_STR + 8 * tp;
            const bf16x8 b0 = tr_frag(va + 32 * et0, va + 4 * V_STR + 32 * et0);
            const bf16x8 b1 = tr_frag(va + 32 * (et0 + 1), va + 4 * V_STR + 32 * (et0 + 1));
            __builtin_amdgcn_sched_barrier(0);
            o0 = MFMA16(a, b0, o0); o1 = MFMA16(a, b1, o1);
        }
        {
            bf16* op = Og + (tok0 + (size_t)n * CHUNK + 16 * it + 4 * fq) * RVW + h * RV + es * 64 + 16 * et0 + fr;
#pragma unroll
            for (int r = 0; r < 4; ++r) { op[(size_t)r * RVW] = (bf16)f2bf(o0[r]); op[(size_t)r * RVW + 16] = (bf16)f2bf(o1[r]); }
        }
#pragma unroll
        for (int x = 0; x < 2; ++x)
#pragma unroll
            for (int y = 0; y < 4; ++y) Racc[x][y] *= cdec;
#pragma unroll
        for (int ks = 0; ks < 2; ++ks) {
            const unsigned ka = ldsb + RS_KS + (32 * ks + 8 * fq + tq) * QK_STR + 8 * tp;
            const unsigned za = ldsb + RS_VZ + (32 * ks + 8 * fq + tq) * V_STR + 8 * tp;
            bf16x8 ak[2], bz[4];
#pragma unroll
            for (int x = 0; x < 2; ++x) ak[x] = tr_frag(ka + 32 * (2 * w + x), ka + 4 * QK_STR + 32 * (2 * w + x));
#pragma unroll
            for (int y = 0; y < 4; ++y) bz[y] = tr_frag(za + 32 * y, za + 4 * V_STR + 32 * y);
            __builtin_amdgcn_sched_barrier(0);
#pragma unroll
            for (int x = 0; x < 2; ++x)
#pragma unroll
                for (int y = 0; y < 4; ++y) Racc[x][y] = MFMA16(ak[x], bz[y], Racc[x][y]);
        }
#pragma unroll
        for (int x = 0; x < 2; ++x)
#pragma unroll
            for (int y = 0; y < 4; ++y) { u32x2 rw; rw.x = pk2(Racc[x][y][0], Racc[x][y][1]); rw.y = pk2(Racc[x][y][2], Racc[x][y][3]);
                *(LAS u32x2*)(lds + RS_RS + (16 * y + fr) * QK_STR + (16 * (2 * w + x) + 4 * fq) * 2) = rw; }
    }
}

template <int CTRL> __device__ __forceinline__ float dpp_f(float x) { return __builtin_bit_cast(float, __builtin_amdgcn_mov_dpp(__builtin_bit_cast(int, x), CTRL, 0xF, 0xF, true)); }
__device__ __forceinline__ float sum8(float x) { x += dpp_f<0xB1>(x); x += dpp_f<0x4E>(x); x += dpp_f<0x141>(x); return x; }
__device__ __forceinline__ void ret_gate_phase(const Ctx& c, const bf16* Og, bf16* Gg, const float* gn, bf16* Zout = nullptr) {
    const int col0 = 512 * (c.lane >> 3) + 8 * (c.lane & 7);
    f32x4 gw[16];
#pragma unroll
    for (int j = 0; j < 8; ++j) { gw[2 * j] = *(const f32x4*)(gn + col0 + 64 * j); gw[2 * j + 1] = *(const f32x4*)(gn + col0 + 64 * j + 4); }
    u32x4 ovn[8];
    if (c.gw < NTOK) { const bf16* orow = Og + (size_t)c.gw * RVW + col0;
#pragma unroll
        for (int j = 0; j < 8; ++j) ovn[j] = *(const u32x4*)(orow + 64 * j); }
    for (int m = c.gw; m < NTOK; m += c.ngw) {
        u32x4 gv[8], ov[8];
        { const bf16* grow = Gg + (size_t)m * RVW + col0;
#pragma unroll
          for (int j = 0; j < 8; ++j) { gv[j] = *(const u32x4*)(grow + 64 * j); ov[j] = ovn[j]; } }
        { const int mn = m + c.ngw < NTOK ? m + c.ngw : m; const bf16* orow = Og + (size_t)mn * RVW + col0;
#pragma unroll
          for (int j = 0; j < 8; ++j) ovn[j] = *(const u32x4*)(orow + 64 * j); }
        float s1 = 0.f;
#pragma unroll
        for (int j = 0; j < 8; ++j) { const u32x4 t = ov[j];
            s1 += ((bflo(t.x) + bfhi(t.x)) + (bflo(t.y) + bfhi(t.y))) + ((bflo(t.z) + bfhi(t.z)) + (bflo(t.w) + bfhi(t.w))); }
        const float mu = sum8(s1) * (1.0f / RV);
        asm volatile("" : "+v"(ov[0]), "+v"(ov[1]), "+v"(ov[2]), "+v"(ov[3]), "+v"(ov[4]), "+v"(ov[5]), "+v"(ov[6]), "+v"(ov[7]));
        float s2 = 0.f;
#pragma unroll
        for (int j = 0; j < 8; ++j) { const u32x4 t = ov[j];
            const float d[8] = {bflo(t.x) - mu, bfhi(t.x) - mu, bflo(t.y) - mu, bfhi(t.y) - mu, bflo(t.z) - mu, bfhi(t.z) - mu, bflo(t.w) - mu, bfhi(t.w) - mu};
            float q = 0.f;
#pragma unroll
            for (int k = 0; k < 8; ++k) q += d[k] * d[k];
            s2 += q; }
        const float rstd = 1.0f / sqrtf(sum8(s2) * (1.0f / RV) + EPS);
        asm volatile("" : "+v"(ov[0]), "+v"(ov[1]), "+v"(ov[2]), "+v"(ov[3]), "+v"(ov[4]), "+v"(ov[5]), "+v"(ov[6]), "+v"(ov[7]));
        bf16* zrow = (Zout ? Zout : Gg) + (size_t)m * RVW + col0;
#pragma unroll
        for (int j = 0; j < 8; ++j) {
            const float gg[8] = {gw[2 * j][0], gw[2 * j][1], gw[2 * j][2], gw[2 * j][3], gw[2 * j + 1][0], gw[2 * j + 1][1], gw[2 * j + 1][2], gw[2 * j + 1][3]};
            const u32x4 t = gv[j], u = ov[j];
            const float g[8] = {bflo(t.x), bfhi(t.x), bflo(t.y), bfhi(t.y), bflo(t.z), bfhi(t.z), bflo(t.w), bfhi(t.w)};
            const float o[8] = {bflo(u.x), bfhi(u.x), bflo(u.y), bfhi(u.y), bflo(u.z), bfhi(u.z), bflo(u.w), bfhi(u.w)};
            float z[8];
#pragma unroll
            for (int k = 0; k < 8; ++k) { const float y = (o[k] - mu) * rstd * gg[k]; z[k] = g[k] * __builtin_amdgcn_rcpf(1.0f + __builtin_amdgcn_exp2f(-1.4426950408889634f * g[k])) * y; }
            u32x4 zw; zw.x = pk2(z[0], z[1]); zw.y = pk2(z[2], z[3]); zw.z = pk2(z[4], z[5]); zw.w = pk2(z[6], z[7]);
            *(u32x4*)(zrow + 64 * j) = zw;
        }
    }
}

__device__ __forceinline__ void rms_phase(const Ctx& c, const float* X, const float* g, bf16* H) {
    for (int m = c.gw; m < NTOK; m += c.ngw) { f32x4 v[8]; load_row(X + (size_t)m * DM, c.lane, v); store_norm_bf16(v, row_rstd(v), g, H + (size_t)m * DM, c.lane); }
}

__device__ __forceinline__ int fkey(float f) { const int i = __builtin_bit_cast(int, f); return i ^ ((i >> 31) & 0x7fffffff); }
__device__ __forceinline__ float kval(int k) { return __builtin_bit_cast(float, k ^ ((k >> 31) & 0x7fffffff)); }
__device__ __forceinline__ int med3i(int a, int b, int c) { int r; asm("v_med3_i32 %0, %1, %2, %3" : "=v"(r) : "v"(a), "v"(b), "v"(c)); return r; }
#define INS16(L, key) do { const int _k = (key); _Pragma("unroll") for (int _q = 15; _q >= 1; --_q) L[_q] = med3i(L[_q - 1], L[_q], _k); L[0] = max(L[0], _k); } while (0)
constexpr int TK_LIST = 544, TK_HALF = 272, TK_KEYS = 256 * TK_LIST;
__device__ __forceinline__ void peer_topk_phase(const Ctx& c, const float* SC, int* IDX, float* WGT, const float* SQP, float* RSTD) {
    LAS unsigned char* lds = c.lds;
    u32x4 pre[16];
    if (c.bx < NTOK / 16) { const u32x4* src = (const u32x4*)(SC + (size_t)c.bx * 16 * DM);
#pragma unroll
        for (int i = 0; i < 16; ++i) pre[i] = src[c.tid + 512 * i]; }
    for (int tile = c.bx; tile < NTOK / 16; tile += c.G) {
        __syncthreads();
#pragma unroll
        for (int i = 0; i < 16; ++i) { const int g = c.tid + 512 * i; *(LAS u32x4*)(lds + (g >> 5) * TK_LIST + ((g >> 4) & 1) * TK_HALF + (g & 15) * 16) = pre[i]; }
        if (tile + c.G < NTOK / 16) { const u32x4* src = (const u32x4*)(SC + (size_t)(tile + c.G) * 16 * DM);
#pragma unroll
            for (int i = 0; i < 16; ++i) pre[i] = src[c.tid + 512 * i]; }
        __syncthreads();
        {
            const int lst = c.tid >> 1, hf = c.tid & 1;
            int L[16];
#pragma unroll
            for (int q = 0; q < 16; ++q) L[q] = (int)0x80000000;
            LAS unsigned char* lp = lds + lst * TK_LIST + hf * TK_HALF;
#pragma unroll 2
            for (int g = 0; g < 16; ++g) { const f32x4 v = *(LAS const f32x4*)(lp + g * 16);
#pragma unroll
                for (int e = 0; e < 4; ++e) INS16(L, (fkey(v[e]) & ~127) | (hf * 64 + g * 4 + e)); }
            if (hf) {
#pragma unroll
                for (int q = 0; q < 16; ++q) ((LAS int*)lp)[q] = L[q]; }
            __syncthreads();
            if (!hf) { LAS const int* op = (LAS const int*)(lp + TK_HALF);
#pragma unroll
                for (int q = 0; q < 16; ++q) INS16(L, op[q]);
                LAS int* kp = (LAS int*)(lds + TK_KEYS) + lst * 16;
#pragma unroll
                for (int q = 0; q < 16; ++q) kp[q] = L[q]; }
        }
        __syncthreads();
        if (c.tid < 128) {
            LAS const int* k1 = (LAS const int*)(lds + TK_KEYS) + (c.tid * 2) * 16; LAS const int* k2 = k1 + 16;
            float v1[16], v2[16];
#pragma unroll
            for (int q = 0; q < 16; ++q) { v1[q] = kval(k1[q] & ~127); v2[q] = kval(k2[q] & ~127); }
            int L[16];
#pragma unroll
            for (int q = 0; q < 16; ++q) L[q] = (fkey(v1[0] + v2[q]) & ~255) | q;
#pragma unroll
            for (int i = 1; i < 16; ++i)
#pragma unroll
                for (int j = 0; j < 16; ++j) if ((i + 1) * (j + 1) <= 16) INS16(L, (fkey(v1[i] + v2[j]) & ~255) | (i * 16 + j));
            const int tt = c.tid >> 3, hh = c.tid & 7; const size_t ob0 = ((size_t)tile * 16 + tt) * 128;
            float rstd; { const f32x4* sp = (const f32x4*)(SQP + ((size_t)tile * 16 + tt) * 32); f32x4 a4 = sp[0];
#pragma unroll
              for (int q = 1; q < 8; ++q) a4 += sp[q];
              rstd = 1.0f / sqrtf(((a4[0] + a4[1]) + (a4[2] + a4[3])) * (1.0f / DM) + EPS); }
            if (hh == 0) RSTD[(size_t)tile * 16 + tt] = rstd;
            const float m0 = kval(L[0] & ~255); float ex[16], se = 0.f;
#pragma unroll
            for (int q = 0; q < 16; ++q) { ex[q] = __builtin_amdgcn_exp2f((kval(L[q] & ~255) - m0) * (rstd * 1.4426950408889634f)); se += ex[q]; }
            const float inv = 1.0f / se;
#pragma unroll
            for (int q = 0; q < 16; ++q) { const int cid = L[q] & 255; const int es = hh * 16 + q, pos = (es & 7) * 16 + (es >> 3);
                IDX[ob0 + pos] = (k1[cid >> 4] & 127) * PNK + (k2[cid & 15] & 127); WGT[ob0 + pos] = ex[q] * inv; }
        }
    }
}

template <int NSTAGE> __device__ __forceinline__ void xreduce_stage(float (&p)[64], int lane) {
    constexpr int S = NSTAGE;
    if constexpr (S == 32) {
#pragma unroll
        for (int k = 0; k < S; ++k) { float xa = p[k], xb = p[k + S]; asm("s_nop 1\n\tv_permlane32_swap_b32 %0, %1" : "+v"(xa), "+v"(xb)); p[k] = xa + xb; }
    } else if constexpr (S == 16) {
#pragma unroll
        for (int k = 0; k < S; ++k) { float xa = p[k], xb = p[k + S]; asm("s_nop 1\n\tv_permlane16_swap_b32 %0, %1" : "+v"(xa), "+v"(xb)); p[k] = xa + xb; }
    } else {
        const bool up = (lane & S) != 0;
#pragma unroll
        for (int k = 0; k < S; ++k) { const float keep = up ? p[k + S] : p[k], send = up ? p[k] : p[k + S];
            p[k] = keep + __builtin_bit_cast(float, __builtin_amdgcn_ds_swizzle(__builtin_bit_cast(int, send), (S << 10) | 0x1F)); }
    }
}
__device__ __forceinline__ float gelu_erf(float v) { return 0.5f * v * (1.0f + erff(v * 0.70710678118654752f)); }
typedef float f32x2 __attribute__((ext_vector_type(2)));
__device__ __forceinline__ float peer_dots64(const unsigned char* U, int idxv, const f32x2 (&h2)[16], int lane) {
    float p[64];
#pragma unroll
    for (int e = 0; e < 64; ++e) {
        const int row = __builtin_amdgcn_readlane(idxv, e);
        const u32x4* up = (const u32x4*)(U + (size_t)row * DM) + lane;
        f32x2 a = {0.f, 0.f};
#pragma unroll
        for (int cc = 0; cc < 2; ++cc) { const u32x4 u = up[64 * cc];
#pragma unroll
            for (int q = 0; q < 4; ++q) { const int w = (int)u[q];
                a = __builtin_elementwise_fma(__builtin_amdgcn_cvt_pk_f32_fp8(w, false), h2[8 * cc + 2 * q], a);
                a = __builtin_elementwise_fma(__builtin_amdgcn_cvt_pk_f32_fp8(w, true), h2[8 * cc + 2 * q + 1], a); } }
        p[e] = a.x + a.y;
    }
    xreduce_stage<32>(p, lane); xreduce_stage<16>(p, lane); xreduce_stage<8>(p, lane); xreduce_stage<4>(p, lane); xreduce_stage<2>(p, lane); xreduce_stage<1>(p, lane);
    return p[0];
}
__device__ __forceinline__ void peer_accum64(const unsigned char* Vt, int idxv, float av, f32x2 (&acc)[16], int lane) {
#pragma unroll 8
    for (int e = 0; e < 64; ++e) {
        const int row = __builtin_amdgcn_readlane(idxv, e); const float a = __builtin_bit_cast(float, __builtin_amdgcn_readlane(__builtin_bit_cast(int, av), e));
        const f32x2 a2 = {a, a};
        const u32x4* vp = (const u32x4*)(Vt + (size_t)row * DM) + lane;
#pragma unroll
        for (int cc = 0; cc < 2; ++cc) { const u32x4 v = vp[64 * cc];
#pragma unroll
            for (int q = 0; q < 4; ++q) { const int w = (int)v[q];
                acc[8 * cc + 2 * q] = __builtin_elementwise_fma(__builtin_amdgcn_cvt_pk_f32_fp8(w, false), a2, acc[8 * cc + 2 * q]);
                acc[8 * cc + 2 * q + 1] = __builtin_elementwise_fma(__builtin_amdgcn_cvt_pk_f32_fp8(w, true), a2, acc[8 * cc + 2 * q + 1]); } }
    }
}
constexpr int GD = 8;
#define PG_ISSUE(vv) do { const int row_ = __builtin_amdgcn_readlane((((vv) >> 6) & 1) ? i1 : i0, (vv) & 63); \
        const u32x4* bp_ = (const u32x4*)((((vv) >> 6) < 2 ? U : Vt) + (size_t)row_ * DM) + lane; ring[(vv) % GD][0] = bp_[0]; ring[(vv) % GD][1] = bp_[64]; } while (0)
template <int SEG> __device__ __forceinline__ void peer_seg(const unsigned char* U, const unsigned char* Vt, int i0, int i1, u32x4 (&ring)[GD][2], float (&p)[64], float aseg, const f32x2 (&h2)[16], f32x2 (&acc)[16], int lane) {
#pragma unroll
    for (int e = 0; e < 64; ++e) {
        const int v = SEG * 64 + e;
        const u32x4 r0 = ring[v % GD][0], r1 = ring[v % GD][1];
        if (SEG < 2) {
            f32x2 a = {0.f, 0.f};
#pragma unroll
            for (int q = 0; q < 4; ++q) { const int wa = (int)r0[q], wb = (int)r1[q];
                a = __builtin_elementwise_fma(__builtin_amdgcn_cvt_pk_f32_fp8(wa, false), h2[2 * q], a); a = __builtin_elementwise_fma(__builtin_amdgcn_cvt_pk_f32_fp8(wa, true), h2[2 * q + 1], a);
                a = __builtin_elementwise_fma(__builtin_amdgcn_cvt_pk_f32_fp8(wb, false), h2[8 + 2 * q], a); a = __builtin_elementwise_fma(__builtin_amdgcn_cvt_pk_f32_fp8(wb, true), h2[8 + 2 * q + 1], a); }
            { float hs_; asm("v_add_f32 %0, %1, %2" : "=v"(hs_) : "v"(a.x), "v"(a.y)); p[e] = hs_; }
        } else {
            const float av = __builtin_bit_cast(float, __builtin_amdgcn_readlane(__builtin_bit_cast(int, aseg), e)); const f32x2 a2 = {av, av};
#pragma unroll
            for (int q = 0; q < 4; ++q) { const int wa = (int)r0[q], wb = (int)r1[q];
                acc[2 * q] = __builtin_elementwise_fma(__builtin_amdgcn_cvt_pk_f32_fp8(wa, false), a2, acc[2 * q]); acc[2 * q + 1] = __builtin_elementwise_fma(__builtin_amdgcn_cvt_pk_f32_fp8(wa, true), a2, acc[2 * q + 1]);
                acc[8 + 2 * q] = __builtin_elementwise_fma(__builtin_amdgcn_cvt_pk_f32_fp8(wb, false), a2, acc[8 + 2 * q]); acc[8 + 2 * q + 1] = __builtin_elementwise_fma(__builtin_amdgcn_cvt_pk_f32_fp8(wb, true), a2, acc[8 + 2 * q + 1]); }
            asm volatile("" : "+v"(acc[0]), "+v"(acc[1]), "+v"(acc[2]), "+v"(acc[3]), "+v"(acc[4]), "+v"(acc[5]), "+v"(acc[6]), "+v"(acc[7]), "+v"(acc[8]), "+v"(acc[9]), "+v"(acc[10]), "+v"(acc[11]), "+v"(acc[12]), "+v"(acc[13]), "+v"(acc[14]), "+v"(acc[15]));
        }
        if (v + GD < 256) PG_ISSUE(v + GD);
        __builtin_amdgcn_sched_barrier(0);
    }
}
__device__ __forceinline__ void peer_token_pipe(const unsigned char* U, const unsigned char* Vt, int i0, int i1, float su0, float su1, float w0, float w1, const f32x2 (&h2)[16], f32x2 (&acc)[16], int lane) {
    u32x4 ring[GD][2];
    float p[64];
#pragma unroll
    for (int v = 0; v < GD; ++v) PG_ISSUE(v);
    peer_seg<0>(U, Vt, i0, i1, ring, p, 0.f, h2, acc, lane);
    xreduce_stage<32>(p, lane); xreduce_stage<16>(p, lane); xreduce_stage<8>(p, lane); xreduce_stage<4>(p, lane); xreduce_stage<2>(p, lane); xreduce_stage<1>(p, lane);
    const float a0 = gelu_erf(p[0] * su0) * w0;
    __builtin_amdgcn_sched_barrier(0);
    peer_seg<1>(U, Vt, i0, i1, ring, p, 0.f, h2, acc, lane);
    xreduce_stage<32>(p, lane); xreduce_stage<16>(p, lane); xreduce_stage<8>(p, lane); xreduce_stage<4>(p, lane); xreduce_stage<2>(p, lane); xreduce_stage<1>(p, lane);
    const float a1 = gelu_erf(p[0] * su1) * w1;
    __builtin_amdgcn_sched_barrier(0);
    peer_seg<2>(U, Vt, i0, i1, ring, p, a0, h2, acc, lane);
    peer_seg<3>(U, Vt, i0, i1, ring, p, a1, h2, acc, lane);
}
#undef PG_ISSUE
__device__ __forceinline__ void peer_gather_phase(const Ctx& c, const bf16* Hn, const unsigned char* U, const unsigned char* Vt, const float* rsU, const float* rsV, const int* IDX, const float* WGT, const float* Xr, float* X, int mode,
                                                  const float* g1, const float* g2, bf16* Hout, bf16* HKVout) {
    for (int m = c.gw; m < NTOK; m += c.ngw) {
        int lane_ = c.lane; asm volatile("" : "+v"(lane_));
#ifdef DRYIDXMASK
        const int imask_ = (X != Xr) ? DRYIDXMASK : 0xffff;
        const int i0 = IDX[(size_t)m * 128 + lane_] & imask_, i1 = IDX[(size_t)m * 128 + 64 + lane_] & imask_;
#else
        const int i0 = IDX[(size_t)m * 128 + lane_], i1 = IDX[(size_t)m * 128 + 64 + lane_];
#endif
        const float w0 = WGT[(size_t)m * 128 + lane_] * rsV[i0], w1 = WGT[(size_t)m * 128 + 64 + lane_] * rsV[i1];
        const float su0 = rsU[i0], su1 = rsU[i1];
        f32x2 h2[16];
#pragma unroll
        for (int cc = 0; cc < 2; ++cc) { const u32x4* hp = (const u32x4*)(Hn + (size_t)m * DM + 1024 * cc + 16 * lane_); const u32x4 ha = hp[0], hb = hp[1];
#pragma unroll
            for (int q = 0; q < 4; ++q) { h2[8 * cc + q] = (f32x2){bflo(ha[q]), bfhi(ha[q])}; h2[8 * cc + 4 + q] = (f32x2){bflo(hb[q]), bfhi(hb[q])}; } }
        f32x2 acc[16];
#pragma unroll
        for (int k = 0; k < 16; ++k) acc[k] = (f32x2){0.f, 0.f};
        peer_token_pipe(U, Vt, i0, i1, su0, su1, w0, w1, h2, acc, lane_);
        float* xr = X + (size_t)m * DM; const float* xrr = Xr + (size_t)m * DM; float ss = 0.f;
#pragma unroll
        for (int cc = 0; cc < 2; ++cc) {
            f32x4* xp = (f32x4*)(xr + 1024 * cc + 16 * lane_); const f32x4* xq = (const f32x4*)(xrr + 1024 * cc + 16 * lane_);
#pragma unroll
            for (int q = 0; q < 4; ++q) { f32x4 xa = xq[q]; xa[0] += acc[8 * cc + 2 * q].x; xa[1] += acc[8 * cc + 2 * q].y; xa[2] += acc[8 * cc + 2 * q + 1].x; xa[3] += acc[8 * cc + 2 * q + 1].y;
                acc[8 * cc + 2 * q] = (f32x2){xa[0], xa[1]}; acc[8 * cc + 2 * q + 1] = (f32x2){xa[2], xa[3]}; ss += (xa[0] * xa[0] + xa[1] * xa[1]) + (xa[2] * xa[2] + xa[3] * xa[3]);
                if (mode != 2) xp[q] = xa; }
        }
        const float rstd = 1.0f / sqrtf(wave_sum(ss) * (1.0f / DM) + EPS);
#pragma unroll
        for (int cc = 0; cc < 2; ++cc) {
            const f32x4* gp = (const f32x4*)(g1 + 1024 * cc + 16 * lane_);
            if (mode == 2) {
                f32x4* xp = (f32x4*)(xr + 1024 * cc + 16 * lane_);
#pragma unroll
                for (int q = 0; q < 4; ++q) { const f32x4 gv = gp[q]; f32x4 y; y[0] = acc[8 * cc + 2 * q].x * rstd * gv[0]; y[1] = acc[8 * cc + 2 * q].y * rstd * gv[1]; y[2] = acc[8 * cc + 2 * q + 1].x * rstd * gv[2]; y[3] = acc[8 * cc + 2 * q + 1].y * rstd * gv[3]; xp[q] = y; }
            } else {
                u32x4 hw[2];
#pragma unroll
                for (int q = 0; q < 4; ++q) { const f32x4 gv = gp[q]; hw[q >> 1][2 * (q & 1)] = pk2(acc[8 * cc + 2 * q].x * rstd * gv[0], acc[8 * cc + 2 * q].y * rstd * gv[1]); hw[q >> 1][2 * (q & 1) + 1] = pk2(acc[8 * cc + 2 * q + 1].x * rstd * gv[2], acc[8 * cc + 2 * q + 1].y * rstd * gv[3]); }
                u32x4* ho = (u32x4*)(Hout + (size_t)m * DM + 1024 * cc + 16 * lane_); ho[0] = hw[0]; ho[1] = hw[1];
                if (mode == 1) {
                    const f32x4* kp = (const f32x4*)(g2 + 1024 * cc + 16 * lane_); u32x4 kw[2];
#pragma unroll
                    for (int q = 0; q < 4; ++q) { const f32x4 gv = kp[q]; kw[q >> 1][2 * (q & 1)] = pk2(acc[8 * cc + 2 * q].x * rstd * gv[0], acc[8 * cc + 2 * q].y * rstd * gv[1]); kw[q >> 1][2 * (q & 1) + 1] = pk2(acc[8 * cc + 2 * q + 1].x * rstd * gv[2], acc[8 * cc + 2 * q + 1].y * rstd * gv[3]); }
                    u32x4* ko = (u32x4*)(HKVout + (size_t)m * DM + 1024 * cc + 16 * lane_); ko[0] = kw[0]; ko[1] = kw[1];
                }
            }
        }
    }
}

template <int PAT> __device__ __forceinline__ float swz_xor(float v) { return __builtin_bit_cast(float, __builtin_amdgcn_ds_swizzle(__builtin_bit_cast(int, v), PAT)); }
template <int PAT> __device__ __forceinline__ int swz_xor_i(int v) { return __builtin_amdgcn_ds_swizzle(v, PAT); }
template <int C> __device__ __forceinline__ unsigned bc8(unsigned v) { return (unsigned)__builtin_amdgcn_ds_swizzle((int)v, (C << 5) | 0x18); }
__device__ __forceinline__ void bcast16(unsigned x0, unsigned x1, unsigned (&o)[16]) {
    o[0] = bc8<0>(x0); o[1] = bc8<0>(x1); o[2] = bc8<1>(x0); o[3] = bc8<1>(x1); o[4] = bc8<2>(x0); o[5] = bc8<2>(x1); o[6] = bc8<3>(x0); o[7] = bc8<3>(x1);
    o[8] = bc8<4>(x0); o[9] = bc8<4>(x1); o[10] = bc8<5>(x0); o[11] = bc8<5>(x1); o[12] = bc8<6>(x0); o[13] = bc8<6>(x1); o[14] = bc8<7>(x0); o[15] = bc8<7>(x1);
}
__device__ __forceinline__ void peer_u_phase(const Ctx& c, const bf16* Hn, const unsigned char* U, const int* IDXT, float* PD, unsigned imask = 0xffffffffu) {
    const int xg = c.bx & 7, wr = (c.bx >> 3) * 8 + c.wave, g = c.lane >> 3, sub = c.lane & 7;
    for (int pass = 0; pass < 2; ++pass) {
        const int s = xg + 8 * pass, col0 = 128 * s + 16 * sub;
        const unsigned char* Us = U + (size_t)s * PE * 128 + 16 * sub;
        u32x4 wv[8];
        { const u32x4* wp = (const u32x4*)(U + (size_t)s * PE * 128 + (size_t)(c.bx >> 3) * 65536) + c.tid;
#pragma unroll
          for (int q = 0; q < 8; ++q) wv[q] = wp[q * 512]; }
        u32x2 ii; unsigned hw;
        { ii = *(const u32x2*)(IDXT + (size_t)wr * 128 + g * 16 + 2 * sub);
          hw = *((const unsigned*)(Hn + (size_t)wr * DM + 128 * s) + c.lane); }
        for (int k = 0; k < NTOK / 256; ++k) {
            const int t = wr + 256 * k;
            u32x4 r[16]; unsigned rj[16];
            bcast16(ii.x, ii.y, rj);
#pragma unroll
            for (int j = 0; j < 16; ++j) r[j] = *(const u32x4*)(Us + (size_t)(rj[j] & imask) * 128);
            float hf[16];
#pragma unroll
            for (int q = 0; q < 8; ++q) { const unsigned hd = (unsigned)__builtin_amdgcn_ds_bpermute(32 * sub + 4 * q, (int)hw); hf[2 * q] = bflo(hd); hf[2 * q + 1] = bfhi(hd); }
            if (k + 1 < NTOK / 256) { ii = *(const u32x2*)(IDXT + (size_t)(t + 256) * 128 + g * 16 + 2 * sub);
                hw = *((const unsigned*)(Hn + (size_t)(t + 256) * DM + 128 * s) + c.lane); }
            float am = 0.f;
#pragma unroll
            for (int q = 0; q < 16; ++q) am = fmaxf(am, fabsf(hf[q]));
            am = fmaxf(am, dpp_f<0xB1>(am)); am = fmaxf(am, dpp_f<0x4E>(am)); am = fmaxf(am, dpp_f<0x141>(am));
            const float hsc = am > 0.f ? 127.0f / am : 0.f, hinv = am * (1.0f / 127.0f);
            unsigned hq[4];
#pragma unroll
            for (int q = 0; q < 4; ++q) hq[q] = q8pack(hf[4 * q] * hsc, hf[4 * q + 1] * hsc, hf[4 * q + 2] * hsc, hf[4 * q + 3] * hsc);
            int p[16];
#pragma unroll
            for (int j = 0; j < 16; ++j) { int a = __builtin_amdgcn_sdot4((int)r[j].x, (int)hq[0], 0, false); a = __builtin_amdgcn_sdot4((int)r[j].y, (int)hq[1], a, false);
                a = __builtin_amdgcn_sdot4((int)r[j].z, (int)hq[2], a, false); p[j] = __builtin_amdgcn_sdot4((int)r[j].w, (int)hq[3], a, false); }
            { const bool up = (sub & 4) != 0;
#pragma unroll
              for (int q = 0; q < 8; ++q) { const int keep = up ? p[q + 8] : p[q], send = up ? p[q] : p[q + 8]; p[q] = keep + swz_xor_i<(4 << 10) | 0x1F>(send); } }
            { const bool up = (sub & 2) != 0;
#pragma unroll
              for (int q = 0; q < 4; ++q) { const int keep = up ? p[q + 4] : p[q], send = up ? p[q] : p[q + 4]; p[q] = keep + swz_xor_i<(2 << 10) | 0x1F>(send); } }
            { const bool up = (sub & 1) != 0;
#pragma unroll
              for (int q = 0; q < 2; ++q) { const int keep = up ? p[q + 2] : p[q], send = up ? p[q] : p[q + 2]; p[q] = keep + swz_xor_i<(1 << 10) | 0x1F>(send); } }
            f32x2 o = {(float)p[0] * hinv, (float)p[1] * hinv};
            *(f32x2*)(PD + ((size_t)t * 16 + s) * 128 + g * 16 + 2 * sub) = o;
            if (k == 0) asm volatile("" :: "v"(wv[0]), "v"(wv[1]), "v"(wv[2]), "v"(wv[3]), "v"(wv[4]), "v"(wv[5]), "v"(wv[6]), "v"(wv[7]));
        }
    }
}
__device__ __forceinline__ void peer_a_phase(const Ctx& c, const float* PD, const int* IDXT, float* WA, const float* rsU, const float* rsV, const float* RSTD) {
    const int i0 = c.bx * 512 + c.tid, step = c.G * 512;
    f32x4 vn[16];
    if (i0 < NTOK * 32) { const f32x4* pp = (const f32x4*)(PD + (size_t)(i0 >> 5) * 2048) + (i0 & 31);
#pragma unroll
        for (int s = 0; s < 16; ++s) vn[s] = pp[s * 32]; }
    for (int i4 = i0; i4 < NTOK * 32; i4 += step) {
        const int t = i4 >> 5;
        f32x4 v[16];
#pragma unroll
        for (int s = 0; s < 16; ++s) v[s] = vn[s];
        const u32x4 e = *((const u32x4*)IDXT + i4); const f32x4 w = *((const f32x4*)WA + i4); const float rs = RSTD[t];
        { const int i5 = i4 + step < NTOK * 32 ? i4 + step : i4; const f32x4* pp = (const f32x4*)(PD + (size_t)(i5 >> 5) * 2048) + (i5 & 31);
#pragma unroll
          for (int s = 0; s < 16; ++s) vn[s] = pp[s * 32]; }
        float ru[4], rv[4];
#pragma unroll
        for (int q = 0; q < 4; ++q) { const unsigned eq = e[q]; ru[q] = rsU[eq]; rv[q] = rsV[eq]; }
        f32x4 sm = v[0];
#pragma unroll
        for (int s = 1; s < 16; ++s) sm += v[s];
        asm volatile("" :: "v"(ru[0]), "v"(ru[1]), "v"(ru[2]), "v"(ru[3]), "v"(rv[0]), "v"(rv[1]), "v"(rv[2]), "v"(rv[3]));
        f32x4 o;
#pragma unroll
        for (int q = 0; q < 4; ++q) o[q] = gelu_erf(sm[q] * ru[q] * rs) * w[q] * rv[q];
        *((f32x4*)WA + i4) = o;
    }
}
__device__ __forceinline__ void peer_v_phase(const Ctx& c, const unsigned char* Vt, const int* IDXT, const float* WA, float* X) {
    const int xg = c.bx & 7, wr = (c.bx >> 3) * 8 + c.wave, g = c.lane >> 3, sub = c.lane & 7;
    for (int pass = 0; pass < 2; ++pass) {
        const int s = xg + 8 * pass, col0 = 128 * s + 16 * sub;
        const unsigned char* Vs = Vt + (size_t)s * PE * 128 + 16 * sub;
        u32x4 wv[8];
        { const u32x4* wp = (const u32x4*)(Vt + (size_t)s * PE * 128 + (size_t)(c.bx >> 3) * 65536) + c.tid;
#pragma unroll
          for (int q = 0; q < 8; ++q) wv[q] = wp[q * 512]; }
        u32x2 ii, aa;
        { ii = *(const u32x2*)(IDXT + (size_t)wr * 128 + g * 16 + 2 * sub); aa = *(const u32x2*)(WA + (size_t)wr * 128 + g * 16 + 2 * sub); }
        for (int k = 0; k < NTOK / 256; ++k) {
            const int t = wr + 256 * k;
            u32x4 r[16]; float av[16]; unsigned rj[16], aj[16];
            bcast16(ii.x, ii.y, rj);
#pragma unroll
            for (int j = 0; j < 16; ++j) r[j] = *(const u32x4*)(Vs + (size_t)rj[j] * 128);
            bcast16(aa.x, aa.y, aj);
#pragma unroll
            for (int j = 0; j < 16; ++j) av[j] = __builtin_bit_cast(float, aj[j]);
            f32x2* xp = (f32x2*)(X + (size_t)t * DM + col0 + 2 * g);
            const f32x2 xold = *xp;
            if (k + 1 < NTOK / 256) { ii = *(const u32x2*)(IDXT + (size_t)(t + 256) * 128 + g * 16 + 2 * sub); aa = *(const u32x2*)(WA + (size_t)(t + 256) * 128 + g * 16 + 2 * sub); }
            f32x2 acc[8];
#pragma unroll
            for (int q = 0; q < 8; ++q) acc[q] = (f32x2){0.f, 0.f};
#pragma unroll
            for (int j = 0; j < 16; ++j) { float aj_ = av[j]; asm("" : "+v"(aj_));
                const f32x2 a2 = {aj_, aj_};
#pragma unroll
                for (int q = 0; q < 4; ++q) { const int w = (int)r[j][q]; acc[2 * q] = __builtin_elementwise_fma(__builtin_amdgcn_cvt_pk_f32_fp8(w, false), a2, acc[2 * q]); acc[2 * q + 1] = __builtin_elementwise_fma(__builtin_amdgcn_cvt_pk_f32_fp8(w, true), a2, acc[2 * q + 1]); } }
            float af[16];
#pragma unroll
            for (int q = 0; q < 8; ++q) { af[2 * q] = acc[q].x; af[2 * q + 1] = acc[q].y; }
#ifdef VDBG
#pragma unroll
            for (int q = 0; q < 16; ++q) { af[q] += __shfl_xor(af[q], 8); af[q] += __shfl_xor(af[q], 16); af[q] += __shfl_xor(af[q], 32); }
            { float s0 = af[0], s1 = af[1];
#pragma unroll
              for (int gg = 1; gg < 8; ++gg) { s0 = (g == gg) ? af[2 * gg] : s0; s1 = (g == gg) ? af[2 * gg + 1] : s1; }
              af[0] = s0; af[1] = s1; }
#else
#pragma unroll
            for (int q = 0; q < 8; ++q) { float xa = af[q], xb = af[q + 8]; asm("s_nop 1\n\tv_permlane32_swap_b32 %0, %1" : "+v"(xa), "+v"(xb)); af[q] = xa + xb; }
#pragma unroll
            for (int q = 0; q < 4; ++q) { float xa = af[q], xb = af[q + 4]; asm("s_nop 1\n\tv_permlane16_swap_b32 %0, %1" : "+v"(xa), "+v"(xb)); af[q] = xa + xb; }
            { const bool up = (c.lane & 8) != 0;
#pragma unroll
              for (int q = 0; q < 2; ++q) { const float keep = up ? af[q + 2] : af[q], send = up ? af[q] : af[q + 2]; af[q] = keep + swz_xor<(8 << 10) | 0x1F>(send); } }
#endif
            const f32x2 xn = {xold.x + af[0], xold.y + af[1]};
            *xp = xn;
            if (k == 0) asm volatile("" :: "v"(wv[0]), "v"(wv[1]), "v"(wv[2]), "v"(wv[3]), "v"(wv[4]), "v"(wv[5]), "v"(wv[6]), "v"(wv[7]));
        }
    }
}
#ifdef VREF
__device__ __forceinline__ void peer_v_ref_phase(const Ctx& c, const unsigned char* Vt, const int* IDXT, const float* WA, float* X) {
    for (int m = c.gw; m < NTOK; m += c.ngw) {
        const int i0 = IDXT[(size_t)m * 128 + c.lane], i1 = IDXT[(size_t)m * 128 + 64 + c.lane];
        const float a0 = WA[(size_t)m * 128 + c.lane], a1 = WA[(size_t)m * 128 + 64 + c.lane];
        f32x2 acc[16];
#pragma unroll
        for (int k = 0; k < 16; ++k) acc[k] = (f32x2){0.f, 0.f};
        for (int e = 0; e < 128; ++e) {
            const int row = __shfl(e < 64 ? i0 : i1, e & 63); const float a = __shfl(e < 64 ? a0 : a1, e & 63); const f32x2 a2 = {a, a};
            const u32x4* vp = (const u32x4*)(Vt + (size_t)row * DM) + c.lane;
#pragma unroll
            for (int cc = 0; cc < 2; ++cc) { const u32x4 v = vp[64 * cc];
#pragma unroll
                for (int q = 0; q < 4; ++q) { const int w = (int)v[q];
                    acc[8 * cc + 2 * q] = __builtin_elementwise_fma(__builtin_amdgcn_cvt_pk_f32_fp8(w, false), a2, acc[8 * cc + 2 * q]);
                    acc[8 * cc + 2 * q + 1] = __builtin_elementwise_fma(__builtin_amdgcn_cvt_pk_f32_fp8(w, true), a2, acc[8 * cc + 2 * q + 1]); } }
        }
        float* xr = X + (size_t)m * DM;
#pragma unroll
        for (int cc = 0; cc < 2; ++cc) { f32x4* xp = (f32x4*)(xr + 1024 * cc + 16 * c.lane);
#pragma unroll
            for (int q = 0; q < 4; ++q) { f32x4 xa = xp[q]; xa[0] += acc[8 * cc + 2 * q].x; xa[1] += acc[8 * cc + 2 * q].y; xa[2] += acc[8 * cc + 2 * q + 1].x; xa[3] += acc[8 * cc + 2 * q + 1].y; xp[q] = xa; } }
    }
}
#endif
__device__ __forceinline__ void norm_phase(const Ctx& c, float* X, int mode, const float* g1, const float* g2, bf16* H, bf16* HKV) {
    f32x4 ga[8], gb[8]; load_g(g1, c.lane, ga); load_g(mode == 1 ? g2 : g1, c.lane, gb);
    int m = c.gw;
    f32x4 v[8]; load_row(X + (size_t)m * DM, c.lane, v);
    for (; m < NTOK; m += c.ngw) {
        const int mn = m + c.ngw < NTOK ? m + c.ngw : m;
        f32x4 nx[8]; load_row(X + (size_t)mn * DM, c.lane, nx);
        const float rstd = row_rstd(v);
        if (mode == 2) { f32x4* xo = (f32x4*)(X + (size_t)m * DM) + c.lane;
#pragma unroll
            for (int j = 0; j < 8; ++j) { f32x4 y; y[0] = v[j][0] * rstd * ga[j][0]; y[1] = v[j][1] * rstd * ga[j][1]; y[2] = v[j][2] * rstd * ga[j][2]; y[3] = v[j][3] * rstd * ga[j][3]; xo[64 * j] = y; }
        } else { store_norm_bf16_r(v, rstd, ga, H + (size_t)m * DM, c.lane); if (mode == 1) store_norm_bf16_r(v, rstd, gb, HKV + (size_t)m * DM, c.lane); }
#pragma unroll
        for (int j = 0; j < 8; ++j) v[j] = nx[j];
    }
}

__device__ __forceinline__ void rms_final_phase(const Ctx& c, float* X, const float* g) {
    for (int m = c.gw; m < NTOK; m += c.ngw) { f32x4 v[8]; load_row(X + (size_t)m * DM, c.lane, v); const float rstd = row_rstd(v);
        const f32x4* gr = (const f32x4*)g + c.lane; f32x4* xo = (f32x4*)(X + (size_t)m * DM) + c.lane;
#pragma unroll
        for (int j = 0; j < 8; ++j) { const f32x4 gv = gr[64 * j]; f32x4 y; for (int k = 0; k < 4; ++k) { y[k] = v[j][k] * rstd * gv[k]; if (!(fabsf(y[k]) < 1e30f)) y[k] = 0.f; } xo[64 * j] = y; } }
}

#ifdef DIAGBUF
__device__ __forceinline__ void diag_copy_phase(const Ctx& c, float* X, const unsigned char* ws) {
    const bf16* src = (const bf16*)(ws + (size_t)DIAGBUF);
    for (size_t i = (size_t)c.bx * 512 + c.tid; i < (size_t)NTOK * DM; i += (size_t)c.G * 512) { const size_t t = i / DM, col = i % DM; float v = bflo((unsigned)src[t * DIAGLD + col]); if (!(fabsf(v) < 1e30f)) v = 0.f; X[i] = v; }
}
#endif

__device__ __forceinline__ unsigned off_b(unsigned row, unsigned ch) { return 256u * row + 16u * (ch ^ (((row & 3u) << 2) | ((row >> 2) & 3u))); }
__device__ __forceinline__ float rowmax4(float x) {
    float a = x, b = x; asm("s_nop 1\n\tv_permlane16_swap_b32 %0, %1" : "+v"(a), "+v"(b)); x = fmaxf(a, b);
    a = x; b = x; asm("s_nop 1\n\tv_permlane32_swap_b32 %0, %1" : "+v"(a), "+v"(b)); return fmaxf(a, b);
}
constexpr int AT_K = 0, AT_V = 32768, AT_BUF = 65536, AT_BIAS = 131072, AT_HEADB = 16384;
__device__ __forceinline__ void attn_phase(const Ctx& c, const bf16* Qg, const bf16* KVg, bf16* AOg, const float* relb, int dryvar = 0) {
    LAS unsigned char* lds = c.lds; const unsigned ldsb = (unsigned)(size_t)lds;
    const int tid = c.tid, lane = c.lane, w = c.wave, hg = w >> 2, wq = w & 3, fr = lane & 15, fq = lane >> 4, tq = (lane & 15) >> 2, tp = lane & 3;
    const int tl = tid & 255, lrow = tl >> 2, lc = tl & 3;
    unsigned vadr[8];
#pragma unroll
    for (int d = 0; d < 8; ++d) vadr[d] = ldsb + AT_V + hg * AT_HEADB + off_b(4 * fq + tq, 2 * d + (tp >> 1)) + 8 * (tp & 1);
    unsigned kadr[4];
#pragma unroll
    for (int s4 = 0; s4 < 4; ++s4) kadr[s4] = ldsb + AT_K + hg * AT_HEADB + 256 * fr + 16 * (fq ^ ((fr >> 2) & 3)) + 64 * (s4 ^ (fr & 3));
    for (int u = c.bx; u < NBATCH * NCHUNK * (AH / 2); u += c.G) {
        const int hp = u & 7, ch = (u >> 3) & 63, b = u >> 9, h = 2 * hp + hg;
        const size_t tq0 = (size_t)b * SEQ + (size_t)ch * CHUNK;
        __syncthreads();
        for (int i = tid; i < 2 * 272; i += 512) { const int hh = i / 272, k = i % 272; ((LAS float*)(lds + AT_BIAS))[i] = (k < NREL) ? relb[(size_t)(2 * hp + hh) * NREL + k] * 1.4426950408889634f : 0.f; }
        bf16x8 qf[4];
        { const bf16* qp = Qg + (tq0 + 16 * wq + fr) * DM + h * AHD + 8 * fq;
#pragma unroll
          for (int s = 0; s < 4; ++s) qf[s] = *(const bf16x8*)(qp + 32 * s); }
        f32x4 O[8];
#pragma unroll
        for (int d = 0; d < 8; ++d) O[d] = (f32x4){0.f, 0.f, 0.f, 0.f};
        float mrun = -1e30f, lrun = 0.f;
        const int t0 = ch >= LEFT ? 0 : LEFT - ch;
        u32x4 pk[4], pv[4];
        { const bf16* kp = KVg + ((size_t)b * SEQ + (size_t)(ch - LEFT + t0) * CHUNK + lrow) * (2 * DM) + h * AHD;
#pragma unroll
          for (int cc = 0; cc < 4; ++cc) { pk[cc] = *(const u32x4*)(kp + (lc + 4 * cc) * 8); pv[cc] = *(const u32x4*)(kp + DM + (lc + 4 * cc) * 8); } }
        const LAS float* bias = (const LAS float*)(lds + AT_BIAS) + hg * 272;
        const float bc = relb[(size_t)h * NREL + 256] * 1.4426950408889634f;
        for (int t = t0; t <= LEFT; ++t) {
            const int pb = ((t - t0) & 1) * AT_BUF;
#pragma unroll
            for (int cc = 0; cc < 4; ++cc) { *(LAS u32x4*)(lds + pb + AT_K + hg * AT_HEADB + off_b(lrow, lc + 4 * cc)) = pk[cc]; *(LAS u32x4*)(lds + pb + AT_V + hg * AT_HEADB + off_b(lrow, lc + 4 * cc)) = pv[cc]; }
            __syncthreads();
            if (t < LEFT && dryvar != 1) { const bf16* kp = KVg + ((size_t)b * SEQ + (size_t)(ch - LEFT + t + 1) * CHUNK + lrow) * (2 * DM) + h * AHD;
#pragma unroll
                for (int cc = 0; cc < 4; ++cc) { pk[cc] = *(const u32x4*)(kp + (lc + 4 * cc) * 8); pv[cc] = *(const u32x4*)(kp + DM + (lc + 4 * cc) * 8); } }
            f32x4 sT[4];
            {
                bf16x8 kf[16];
                const unsigned k0 = kadr[0] + pb, k1 = kadr[1] + pb, k2 = kadr[2] + pb, k3 = kadr[3] + pb;
                asm volatile("ds_read_b128 %0, %16\n\tds_read_b128 %1, %17\n\tds_read_b128 %2, %18\n\tds_read_b128 %3, %19\n\t"
                             "ds_read_b128 %4, %16 offset:4096\n\tds_read_b128 %5, %17 offset:4096\n\tds_read_b128 %6, %18 offset:4096\n\tds_read_b128 %7, %19 offset:4096\n\t"
                             "ds_read_b128 %8, %16 offset:8192\n\tds_read_b128 %9, %17 offset:8192\n\tds_read_b128 %10, %18 offset:8192\n\tds_read_b128 %11, %19 offset:8192\n\t"
                             "ds_read_b128 %12, %16 offset:12288\n\tds_read_b128 %13, %17 offset:12288\n\tds_read_b128 %14, %18 offset:12288\n\tds_read_b128 %15, %19 offset:12288"
                             : "=&v"(kf[0]), "=&v"(kf[1]), "=&v"(kf[2]), "=&v"(kf[3]), "=&v"(kf[4]), "=&v"(kf[5]), "=&v"(kf[6]), "=&v"(kf[7]),
                               "=&v"(kf[8]), "=&v"(kf[9]), "=&v"(kf[10]), "=&v"(kf[11]), "=&v"(kf[12]), "=&v"(kf[13]), "=&v"(kf[14]), "=&v"(kf[15])
                             : "v"(k0), "v"(k1), "v"(k2), "v"(k3) : "memory");
                asm volatile("s_waitcnt lgkmcnt(8)" : "+v"(kf[0]), "+v"(kf[1]), "+v"(kf[2]), "+v"(kf[3]), "+v"(kf[4]), "+v"(kf[5]), "+v"(kf[6]), "+v"(kf[7]) :: "memory");
#pragma unroll
                for (int kt = 0; kt < 2; ++kt) { sT[kt] = (f32x4){0.f, 0.f, 0.f, 0.f};
#pragma unroll
                    for (int s = 0; s < 4; ++s) sT[kt] = MFMA16(kf[4 * kt + s], qf[s], sT[kt]); }
                asm volatile("s_waitcnt lgkmcnt(0)" : "+v"(kf[8]), "+v"(kf[9]), "+v"(kf[10]), "+v"(kf[11]), "+v"(kf[12]), "+v"(kf[13]), "+v"(kf[14]), "+v"(kf[15]) :: "memory");
#pragma unroll
                for (int kt = 2; kt < 4; ++kt) { sT[kt] = (f32x4){0.f, 0.f, 0.f, 0.f};
#pragma unroll
                    for (int s = 0; s < 4; ++s) sT[kt] = MFMA16(kf[4 * kt + s], qf[s], sT[kt]); }
            }
            const int dbase = (LEFT - t) * CHUNK + (16 * wq + fr);
            if (t > LEFT - 3) {
#pragma unroll
                for (int kt = 0; kt < 4; ++kt)
#pragma unroll
                    for (int r = 0; r < 4; ++r) { const int dist = dbase - (16 * kt + 4 * fq + r); sT[kt][r] += bias[min(dist, 128) + 128]; }
            }
            s16x4 vlo[2][8], vhi[2][8];
            unsigned vcur[8];
#pragma unroll
            for (int d = 0; d < 8; ++d) vcur[d] = vadr[d] + pb;
#define TR8(dst, OFF) asm volatile("ds_read_b64_tr_b16 %0, %8 offset:" #OFF "\n\tds_read_b64_tr_b16 %1, %9 offset:" #OFF "\n\tds_read_b64_tr_b16 %2, %10 offset:" #OFF "\n\tds_read_b64_tr_b16 %3, %11 offset:" #OFF "\n\t" \
                "ds_read_b64_tr_b16 %4, %12 offset:" #OFF "\n\tds_read_b64_tr_b16 %5, %13 offset:" #OFF "\n\tds_read_b64_tr_b16 %6, %14 offset:" #OFF "\n\tds_read_b64_tr_b16 %7, %15 offset:" #OFF \
                : "=&v"(dst[0]), "=&v"(dst[1]), "=&v"(dst[2]), "=&v"(dst[3]), "=&v"(dst[4]), "=&v"(dst[5]), "=&v"(dst[6]), "=&v"(dst[7]) \
                : "v"(vcur[0]), "v"(vcur[1]), "v"(vcur[2]), "v"(vcur[3]), "v"(vcur[4]), "v"(vcur[5]), "v"(vcur[6]), "v"(vcur[7]) : "memory")
            TR8(vlo[0], 0); TR8(vhi[0], 4096); TR8(vlo[1], 8192); TR8(vhi[1], 12288);
#undef TR8
            float mx = -1e30f;
            const float badd = t <= LEFT - 3 ? bc : 0.f;
#pragma unroll
            for (int kt = 0; kt < 4; ++kt)
#pragma unroll
                for (int r = 0; r < 4; ++r) { sT[kt][r] += badd; mx = fmaxf(mx, sT[kt][r]); }
            mx = rowmax4(mx);
            const float mnew = fmaxf(mrun, mx), alpha = __builtin_amdgcn_exp2f(mrun - mnew); mrun = mnew;
            float ps = 0.f;
#pragma unroll
            for (int kt = 0; kt < 4; ++kt)
#pragma unroll
                for (int r = 0; r < 4; ++r) { sT[kt][r] = __builtin_amdgcn_exp2f(sT[kt][r] - mnew); ps += sT[kt][r]; }
            lrun = lrun * alpha + ps;
#pragma unroll
            for (int d = 0; d < 8; ++d) O[d] *= alpha;
            asm volatile("s_waitcnt lgkmcnt(0)" : "+v"(vlo[0][0]), "+v"(vlo[0][1]), "+v"(vlo[0][2]), "+v"(vlo[0][3]), "+v"(vlo[0][4]), "+v"(vlo[0][5]), "+v"(vlo[0][6]), "+v"(vlo[0][7]),
                         "+v"(vhi[0][0]), "+v"(vhi[0][1]), "+v"(vhi[0][2]), "+v"(vhi[0][3]), "+v"(vhi[0][4]), "+v"(vhi[0][5]), "+v"(vhi[0][6]), "+v"(vhi[0][7]) :: "memory");
            asm volatile("" : "+v"(vlo[1][0]), "+v"(vlo[1][1]), "+v"(vlo[1][2]), "+v"(vlo[1][3]), "+v"(vlo[1][4]), "+v"(vlo[1][5]), "+v"(vlo[1][6]), "+v"(vlo[1][7]),
                         "+v"(vhi[1][0]), "+v"(vhi[1][1]), "+v"(vhi[1][2]), "+v"(vhi[1][3]), "+v"(vhi[1][4]), "+v"(vhi[1][5]), "+v"(vhi[1][6]), "+v"(vhi[1][7]) :: "memory");
            __builtin_amdgcn_sched_barrier(0);
#pragma unroll
            for (int ks = 0; ks < 2; ++ks) {
                bf16x8 pb; { const unsigned p0 = pk2(sT[2 * ks][0], sT[2 * ks][1]), p1 = pk2(sT[2 * ks][2], sT[2 * ks][3]), p2 = pk2(sT[2 * ks + 1][0], sT[2 * ks + 1][1]), p3 = pk2(sT[2 * ks + 1][2], sT[2 * ks + 1][3]);
                    const u32x4 pw = (u32x4){p0, p1, p2, p3}; pb = __builtin_bit_cast(bf16x8, pw); }
#pragma unroll
                for (int d = 0; d < 8; ++d) { bf16x8 va; va[0] = vlo[ks][d][0]; va[1] = vlo[ks][d][1]; va[2] = vlo[ks][d][2]; va[3] = vlo[ks][d][3]; va[4] = vhi[ks][d][0]; va[5] = vhi[ks][d][1]; va[6] = vhi[ks][d][2]; va[7] = vhi[ks][d][3];
                    O[d] = MFMA16(va, pb, O[d]); }
            }
        }
        float lt = lrun; lt += __shfl_xor(lt, 16); lt += __shfl_xor(lt, 32);
        const float inv = 1.0f / lt;
        bf16* op = AOg + (tq0 + 16 * wq + fr) * DM + h * AHD + 4 * fq;
#pragma unroll
        for (int d = 0; d < 8; ++d) { u32x2 ow; ow.x = pk2(O[d][0] * inv, O[d][1] * inv); ow.y = pk2(O[d][2] * inv, O[d][3] * inv); *(u32x2*)(op + 16 * d) = ow; }
    }
}

namespace at2 {
typedef float f32x16 __attribute__((ext_vector_type(16)));
constexpr int SHM_V = 64 * 128 * 2, SHM_K = 64 * 128 * 2, OFF_K = 2 * SHM_V, OFF_WS = 2 * SHM_V + 2 * SHM_K, OFF_BIAS = OFF_WS + 8 * 64 * 4, OFF_Q = OFF_BIAS + 2048;
constexpr float THRL = 8.0f * 1.4426950408889634f;
#define A2_KSWZ(row, colB) ((row) * 256 + ((colB) ^ (((row) & 7) << 4)))
#define A2_SBAR() __builtin_amdgcn_sched_barrier(0)
__device__ __forceinline__ int crow(int r, int hi) { return (r & 3) + 8 * (r >> 2) + 4 * hi; }
__device__ __forceinline__ float pl32max(float x) { auto rr = __builtin_amdgcn_permlane32_swap(__builtin_bit_cast(unsigned, x), __builtin_bit_cast(unsigned, x), false, false);
    const unsigned a = rr[0], b = rr[1]; return fmaxf(__builtin_bit_cast(float, a), __builtin_bit_cast(float, b)); }
__device__ __forceinline__ float pl32sum(float x) { auto rr = __builtin_amdgcn_permlane32_swap(__builtin_bit_cast(unsigned, x), __builtin_bit_cast(unsigned, x), false, false);
    const unsigned a = rr[0], b = rr[1]; return __builtin_bit_cast(float, a) + __builtin_bit_cast(float, b); }
__device__ __forceinline__ void partialSM(f32x16& p0, f32x16& p1, float& m_reg, float& mn, float& alpha) {
    float pmax = p0[0];
#pragma unroll
    for (int r = 1; r < 16; ++r) pmax = fmaxf(pmax, p0[r]);
#pragma unroll
    for (int r = 0; r < 16; ++r) pmax = fmaxf(pmax, p1[r]);
    pmax = pl32max(pmax);
    if (__builtin_expect(__all(pmax - m_reg <= THRL), 1)) { mn = m_reg; alpha = 1.f; }
    else { mn = fmaxf(m_reg, pmax); alpha = __builtin_amdgcn_exp2f(m_reg - mn); m_reg = mn; }
#pragma unroll
    for (int r = 0; r < 16; ++r) { p0[r] -= mn; p1[r] -= mn; }
#pragma unroll
    for (int r = 0; r < 16; ++r) p0[r] = __builtin_amdgcn_exp2f(p0[r]);
}
__device__ __forceinline__ void finishSM(f32x16& p0, f32x16& p1, float alpha, float& l_reg, bf16x8& pa0, bf16x8& pa1, bf16x8& pa2, bf16x8& pa3) {
#pragma unroll
    for (int r = 0; r < 16; ++r) p1[r] = __builtin_amdgcn_exp2f(p1[r]);
    float ps = 0.f;
#pragma unroll
    for (int r = 0; r < 16; ++r) ps += p0[r];
#pragma unroll
    for (int r = 0; r < 16; ++r) ps += p1[r];
    ps = pl32sum(ps);
    l_reg = l_reg * alpha + ps;
#define A2_PK4(P, BASE, OUT) do { const unsigned a0 = pk2(P[BASE + 0], P[BASE + 1]), a1 = pk2(P[BASE + 2], P[BASE + 3]), b0 = pk2(P[BASE + 4], P[BASE + 5]), b1 = pk2(P[BASE + 6], P[BASE + 7]); \
        auto r0 = __builtin_amdgcn_permlane32_swap(a0, b0, false, false); auto r1 = __builtin_amdgcn_permlane32_swap(a1, b1, false, false); \
        const unsigned w0 = r0[0], w1 = r1[0], w2 = r0[1], w3 = r1[1]; const u32x4 w = {w0, w1, w2, w3}; OUT = __builtin_bit_cast(bf16x8, w); } while (0)
    A2_PK4(p0, 0, pa0); A2_PK4(p0, 8, pa1); A2_PK4(p1, 0, pa2); A2_PK4(p1, 8, pa3);
#undef A2_PK4
}
__device__ __forceinline__ void qkt(f32x16& p0, f32x16& p1, LAS const unsigned char* Ks, LAS const unsigned char* qr_l, int r32, int hi) {
    asm volatile("" : "+v"(r32));
#pragma unroll
    for (int r = 0; r < 16; ++r) { p0[r] = 0.f; p1[r] = 0.f; }
#pragma unroll
    for (int d0 = 0; d0 < 8; ++d0) { const int cb = (d0 * 16 + hi * 8) * 2;
        const bf16x8 b0 = *(LAS const bf16x8*)(Ks + A2_KSWZ(r32, cb));
        const bf16x8 b1 = *(LAS const bf16x8*)(Ks + A2_KSWZ(32 + r32, cb));
        const bf16x8 q8 = *(LAS const bf16x8*)(qr_l + d0 * 1024);
        p0 = __builtin_amdgcn_mfma_f32_32x32x16_bf16(b0, q8, p0, 0, 0, 0);
        p1 = __builtin_amdgcn_mfma_f32_32x32x16_bf16(b1, q8, p1, 0, 0, 0); }
}
__device__ __forceinline__ int v_st(int k, int c) { const int kk = (k & ~0xC) | ((k & 4) << 1) | ((k & 8) >> 1); return ((kk >> 3) * 4 + (c >> 5)) * 512 + ((kk & 7) * 32 + (c & 31)) * 2; }
__device__ __forceinline__ int v_rd_base(int lane) { return ((lane & 3) << 3) | (((lane >> 2) & 3) << 6) | (((lane >> 4) & 1) << 5) | (((lane >> 5) & 1) << 8); }
constexpr int v_rd_off(int d0, int ks, int half) { return d0 * 512 + ks * 4096 + half * 2048; }
template <int OFF> __device__ __forceinline__ s16x4 tr_read(int vb) { s16x4 r; asm volatile("ds_read_b64_tr_b16 %0, %1 offset:%2" : "=&v"(r) : "v"(vb), "i"(OFF) : "memory"); return r; }
template <int D0> __device__ __forceinline__ void pv_one(f32x16& od, int vb, bf16x8 pa0, bf16x8 pa1, bf16x8 pa2, bf16x8 pa3) {
    const s16x4 l0 = tr_read<v_rd_off(D0, 0, 0)>(vb), h0 = tr_read<v_rd_off(D0, 0, 1)>(vb), l1 = tr_read<v_rd_off(D0, 1, 0)>(vb), h1 = tr_read<v_rd_off(D0, 1, 1)>(vb);
    const s16x4 l2 = tr_read<v_rd_off(D0, 2, 0)>(vb), h2 = tr_read<v_rd_off(D0, 2, 1)>(vb), l3 = tr_read<v_rd_off(D0, 3, 0)>(vb), h3 = tr_read<v_rd_off(D0, 3, 1)>(vb);
    asm volatile("s_waitcnt lgkmcnt(0)" ::: "memory"); A2_SBAR();
#define A2_PK(L, H) (bf16x8){L[0], L[1], L[2], L[3], H[0], H[1], H[2], H[3]}
    od = __builtin_amdgcn_mfma_f32_32x32x16_bf16(pa0, A2_PK(l0, h0), od, 0, 0, 0);
    od = __builtin_amdgcn_mfma_f32_32x32x16_bf16(pa1, A2_PK(l1, h1), od, 0, 0, 0);
    od = __builtin_amdgcn_mfma_f32_32x32x16_bf16(pa2, A2_PK(l2, h2), od, 0, 0, 0);
    od = __builtin_amdgcn_mfma_f32_32x32x16_bf16(pa3, A2_PK(l3, h3), od, 0, 0, 0);
#undef A2_PK
}
__device__ __forceinline__ void pv_d0(f32x16 (&o)[4], int vb, bf16x8 pa0, bf16x8 pa1, bf16x8 pa2, bf16x8 pa3) {
    pv_one<0>(o[0], vb, pa0, pa1, pa2, pa3); pv_one<1>(o[1], vb, pa0, pa1, pa2, pa3); pv_one<2>(o[2], vb, pa0, pa1, pa2, pa3); pv_one<3>(o[3], vb, pa0, pa1, pa2, pa3);
}
__device__ __forceinline__ void bias_mask(f32x16& p0, f32x16& p1, int dc, LAS const float* bias, float bc, int qrow, int hi) {
    if (dc < 0 || dc > 8) {
#pragma unroll
        for (int r = 0; r < 16; ++r) { p0[r] = -__builtin_inff(); p1[r] = -__builtin_inff(); }
    } else if (dc >= 3) {
#pragma unroll
        for (int r = 0; r < 16; ++r) { p0[r] += bc; p1[r] += bc; }
    } else {
        int db = 64 * dc + qrow + 128 - 4 * hi; asm volatile("" : "+v"(db));
#pragma unroll
        for (int r = 0; r < 16; ++r) { const int k0 = (r & 3) + 8 * (r >> 2); p0[r] += bias[min(db - k0, 256)]; p1[r] += bias[min(db - 32 - k0, 256)]; }
    }
}
__device__ __forceinline__ void block(const bf16* Qb, const bf16* Kh, const bf16* Vh, bf16* Ob, int NT, int dc0, LAS const float* bias, float bc, LAS unsigned char* lds, int tid) {
    constexpr int LDQ = DM, LDK = 2 * DM, LDO = DM;
    const int wid = tid >> 6, lane = tid & 63, r32 = lane & 31, hi = lane >> 5;
    LAS unsigned char* V_lds = lds; LAS unsigned char* K_lds = lds + OFF_K;
    LAS float* ws = (LAS float*)(lds + OFF_WS) + wid * 64; LAS float* li_l = ws; LAS float* al_l = ws + 32;
    float m_reg = -1e30f, l_reg = 0.f; f32x16 o[4];
    LAS unsigned char* qr = lds + OFF_Q + wid * 8192 + lane * 16;
#pragma unroll
    for (int d = 0; d < 4; ++d)
#pragma unroll
        for (int r = 0; r < 16; ++r) o[d][r] = 0.f;
    const bf16* Qw = Qb + (size_t)(wid * 32 + r32) * LDQ + hi * 8;
#pragma unroll
    for (int d0 = 0; d0 < 8; ++d0) *(LAS bf16x8*)(qr + d0 * 1024) = *(const bf16x8*)(Qw + d0 * 16);
    const int sr = tid >> 4, sc = (tid & 15) * 8, vst0 = v_st(sr, sc), vst1 = v_st(32 + sr, sc);
    const int vb0 = (int)(unsigned)(size_t)V_lds + v_rd_base(lane);
    const int qrow = (wid & 1) * 32 + r32, dcw = dc0 + (wid >> 1);
    bf16x8 sv0[1], sv1[1], sk0[1], sk1[1];
#define A2_SLOAD(i, k0) do { sv0[i] = *(const bf16x8*)(Vh + (size_t)((k0) + sr) * LDK + sc); sv1[i] = *(const bf16x8*)(Vh + (size_t)((k0) + 32 + sr) * LDK + sc); \
        sk0[i] = *(const bf16x8*)(Kh + (size_t)((k0) + sr) * LDK + sc); sk1[i] = *(const bf16x8*)(Kh + (size_t)((k0) + 32 + sr) * LDK + sc); } while (0)
#define A2_SWRITE(b, i) do { *(LAS bf16x8*)(V_lds + (b) * SHM_V + vst0) = sv0[i]; *(LAS bf16x8*)(V_lds + (b) * SHM_V + vst1) = sv1[i]; const int kc = sc * 2; \
        *(LAS bf16x8*)(K_lds + (b) * SHM_K + A2_KSWZ(sr, kc)) = sk0[i]; *(LAS bf16x8*)(K_lds + (b) * SHM_K + A2_KSWZ(32 + sr, kc)) = sk1[i]; } while (0)
#define A2_SWAIT() asm volatile("s_waitcnt vmcnt(0)" ::: "memory")
#define A2_RESC(a) do { if (__any((a) < 1.f)) { if (hi == 0) al_l[r32] = (a); asm volatile("s_waitcnt lgkmcnt(0)" ::: "memory"); \
        _Pragma("unroll") for (int d = 0; d < 4; ++d) _Pragma("unroll") for (int r = 0; r < 16; ++r) o[d][r] *= al_l[crow(r, hi)]; } } while (0)
    f32x16 pA0, pA1, pB0, pB1; float mnA, mnB, alA, alB; bf16x8 pa0, pa1, pa2, pa3;
    A2_SLOAD(0, 0); asm volatile("s_waitcnt vmcnt(0)" ::: "memory"); A2_SWRITE(0, 0); __syncthreads();
    qkt(pA0, pA1, K_lds, qr, r32, hi); bias_mask(pA0, pA1, dcw - 0, bias, bc, qrow, hi); partialSM(pA0, pA1, m_reg, mnA, alA);
    A2_SLOAD(0, 64);
    A2_SWAIT(); A2_SWRITE(1, 0); __syncthreads();
    for (int j = 1; j + 1 < NT; j += 2) {
        A2_SBAR(); qkt(pB0, pB1, K_lds + SHM_K, qr, r32, hi); bias_mask(pB0, pB1, dcw - j, bias, bc, qrow, hi);
        finishSM(pA0, pA1, alA, l_reg, pa0, pa1, pa2, pa3); A2_SBAR();
        A2_SLOAD(0, (j + 1) * 64); A2_SBAR();
        pv_d0(o, vb0, pa0, pa1, pa2, pa3); partialSM(pB0, pB1, m_reg, mnB, alB);
        __syncthreads(); A2_SWAIT(); A2_SWRITE(0, 0);
        A2_RESC(alB); __syncthreads();
        A2_SBAR(); qkt(pA0, pA1, K_lds, qr, r32, hi); bias_mask(pA0, pA1, dcw - (j + 1), bias, bc, qrow, hi);
        finishSM(pB0, pB1, alB, l_reg, pa0, pa1, pa2, pa3); A2_SBAR();
        A2_SLOAD(0, (j + 2) * 64);
        A2_SBAR();
        pv_d0(o, vb0 + SHM_V, pa0, pa1, pa2, pa3); partialSM(pA0, pA1, m_reg, mnA, alA);
        __syncthreads(); A2_SWAIT(); A2_SWRITE(1, 0);
        A2_RESC(alA); __syncthreads();
    }
    A2_SBAR(); qkt(pB0, pB1, K_lds + SHM_K, qr, r32, hi); bias_mask(pB0, pB1, dcw - (NT - 1), bias, bc, qrow, hi);
    finishSM(pA0, pA1, alA, l_reg, pa0, pa1, pa2, pa3); A2_SBAR();
    pv_d0(o, vb0, pa0, pa1, pa2, pa3); partialSM(pB0, pB1, m_reg, mnB, alB);
    __syncthreads(); A2_RESC(alB);
    finishSM(pB0, pB1, alB, l_reg, pa0, pa1, pa2, pa3); A2_SBAR();
    pv_d0(o, vb0 + SHM_V, pa0, pa1, pa2, pa3);
    if (hi == 0) li_l[r32] = l_reg; asm volatile("s_waitcnt lgkmcnt(0)" ::: "memory");
    float rli[16];
#pragma unroll
    for (int r = 0; r < 16; ++r) rli[r] = __builtin_amdgcn_rcpf(li_l[crow(r, hi)]);
    bf16* Ow = Ob + (size_t)(wid * 32) * LDO;
#pragma unroll
    for (int r = 0; r < 16; ++r) { const int orow = crow(r, hi);
#pragma unroll
        for (int d0 = 0; d0 < 4; ++d0) Ow[(size_t)orow * LDO + d0 * 32 + r32] = (bf16)f2bf(o[d0][r] * rli[r]); }
#undef A2_SLOAD
#undef A2_SWRITE
#undef A2_SWAIT
#undef A2_RESC
}
}
__device__ __forceinline__ void attn_phase2(const Ctx& c, const bf16* Qg, const bf16* KVg, bf16* AOg, const float* relb) {
    LAS unsigned char* lds = c.lds;
    for (int u = c.bx; u < NBATCH * AH * 16; u += c.G) {
        const int h = u & 15, b = (u >> 4) & 3, qb = u >> 6;
        const int c0 = 4 * qb, kb = c0 >= LEFT ? c0 - LEFT : 0, NT = c0 + 4 - kb;
        __syncthreads();
        for (int i = c.tid; i < 272; i += 512) ((LAS float*)(lds + at2::OFF_BIAS))[i] = (i < NREL) ? relb[(size_t)h * NREL + i] * 1.4426950408889634f : 0.f;
        const float bc = relb[(size_t)h * NREL + 256] * 1.4426950408889634f;
        __syncthreads();
        const size_t tq0 = (size_t)b * SEQ + (size_t)c0 * CHUNK, tk0 = (size_t)b * SEQ + (size_t)kb * CHUNK;
        at2::block(Qg + tq0 * DM + h * AHD, KVg + tk0 * (2 * DM) + h * AHD, KVg + tk0 * (2 * DM) + DM + h * AHD, AOg + tq0 * DM + h * AHD, NT, c0 - kb, (const LAS float*)(lds + at2::OFF_BIAS), bc, lds, c.tid);
    }
}

constexpr int NSTEPS = 1 + 2 * 10 + 2 * 9;
template <int MASK> __global__ void __launch_bounds__(512, 2) yoco_fwd(Params p) {
    extern __shared__ __attribute__((aligned(16))) unsigned char lds_raw[];
#define MK_CTX() Ctx c; { int t_ = threadIdx.x; asm volatile("" : "+v"(t_)); c.lds = (LAS unsigned char*)lds_raw; c.tid = t_; c.lane = t_ & 63; c.wave = __builtin_amdgcn_readfirstlane(t_ >> 6); \
        { int b_ = blockIdx.x, g_ = gridDim.x; asm volatile("" : "+s"(b_), "+s"(g_)); c.bx = b_; c.G = g_; } c.gw = c.bx * 8 + c.wave; c.ngw = c.G * 8; }
    volatile LAS unsigned* MISC = (volatile LAS unsigned*)((LAS unsigned char*)lds_raw + LDS_MISC);
    if (threadIdx.x < 4) MISC[threadIdx.x] = 0u;
    __syncthreads();
    XcdBarrier bar; bar.bar = (unsigned*)(p.ws + WS_CTL); bar.x = 0; bar.st = MISC;
    if (p.hi - p.lo > 1) bar = xcd_barrier_post((unsigned*)(p.ws + WS_CTL), MISC);
    unsigned char* ws = p.ws;
    bf16* const H = (bf16*)(ws + WS_H); bf16* const HKV = (bf16*)(ws + WS_HKV);
    float* const X = p.out;
    int s = 0;
#ifndef REPMASK
#define REPMASK 0
#endif
#define KF_(f) p.f = kq_->f;
#define MK_P() Params p; { unsigned long long ka_ = (unsigned long long)__builtin_amdgcn_kernarg_segment_ptr(); asm volatile("" : "+s"(ka_)); const __attribute__((address_space(4))) Params* kq_ = (const __attribute__((address_space(4))) Params*)ka_; \
        KF_(x) KF_(ln_mix) KF_(ln_ffn) KF_(ret_w_in) KF_(ret_w_out) KF_(ret_gn) KF_(kv_norm) KF_(w_kv) KF_(att_w_q) KF_(att_w_o) KF_(att_rel_bias) KF_(peer_w_q) KF_(peer_sub_keys) KF_(peer_u) KF_(peer_v) KF_(ln_final) \
        KF_(out) KF_(ws) KF_(lo) KF_(hi) } \
        unsigned char* const ws = p.ws; bf16* const H = (bf16*)(ws + WS_H); bf16* const HKV = (bf16*)(ws + WS_HKV); float* const X = p.out; (void)H; (void)HKV; (void)X;
#define BEGIN_STEP(k) if (((MASK >> (k)) & 1) && s >= p.lo && s < p.hi) { for (int rep_ = ((REPMASK >> (k)) & 1) ? 0 : 1; rep_ < 2; ++rep_) { MK_CTX(); MK_P();
#define END_STEP   if (rep_ == 0 || s + 1 < p.hi) xcd_barrier(bar); } } ++s;

    BEGIN_STEP(0) p0_prologue(p, c); END_STEP

    for (int l = 0; l < DEPTH; ++l) {
        if (l < 2) {
            BEGIN_STEP(1)
                pg8::Gemm g{H, (const bf16*)(ws + WS_WIN) + (size_t)l * RIN * DM, NTOK, RIN, DM}; pg8::StaticOrder S; S.init(NTOK, RIN, c.G, c.bx);
                pg8::EpiProj E{(bf16*)(ws + WS_Q), (bf16*)(ws + WS_K), (bf16*)(ws + WS_V), (bf16*)(ws + WS_G), (const float*)(ws + WS_ROT)};
                pg8::gemm_phase<pg8::EpiProj, pg8::StaticOrder>(c.lds, g, S, E, nullptr);
            END_STEP
            BEGIN_STEP(2)
                for (int u = c.bx; u < 256; u += c.G) ret_scan_unit(c, (const bf16*)(ws + WS_Q), (const bf16*)(ws + WS_K), (const bf16*)(ws + WS_V), (bf16*)(ws + WS_O), u);
            END_STEP
            BEGIN_STEP(3)
                ret_gate_phase(c, (const bf16*)(ws + WS_O), (bf16*)(ws + WS_G), p.ret_gn + (size_t)l * RVW, rep_ == 0 ? (bf16*)(ws + WS_SC) : nullptr);
            END_STEP
        } else {
            BEGIN_STEP(4)
                for (int pass = (l == 2 ? 0 : 1); pass < 2; ++pass) {
                    const int N = pass ? DM : 2 * DM;
                    pg8::Gemm g{pass ? H : HKV, pass ? (const bf16*)(ws + WS_WQ) + (size_t)(l - 2) * DM * DM : (const bf16*)(ws + WS_WKV), NTOK, N, DM}; pg8::StaticOrder S; S.init(NTOK, N, c.G, c.bx);
                    pg8::EpiBf16S E{pass ? (bf16*)(ws + WS_Q) : (bf16*)(ws + WS_KV), N, pass ? 0.12751743082459868f : 1.0f};
                    pg8::gemm_phase<pg8::EpiBf16S, pg8::StaticOrder>(c.lds, g, S, E, nullptr);
                }
            END_STEP
            BEGIN_STEP(5)
#ifdef ATTNDRY
                attn_phase(c, (const bf16*)(ws + WS_Q), (const bf16*)(ws + WS_KV), rep_ == 0 ? (bf16*)(ws + WS_O) : (bf16*)(ws + WS_AO), p.att_rel_bias + (size_t)(l - 2) * AH * NREL, rep_ == 0 ? ATTNDRY : 0);
#else
                attn_phase2(c, (const bf16*)(ws + WS_Q), (const bf16*)(ws + WS_KV), (bf16*)(ws + WS_AO), p.att_rel_bias + (size_t)(l - 2) * AH * NREL);
#endif
            END_STEP
        }
        BEGIN_STEP(6)
            const int K = l < 2 ? RVW : DM;
            pg8::Gemm g{l < 2 ? (const bf16*)(ws + WS_G) : (const bf16*)(ws + WS_AO), l < 2 ? (const bf16*)(ws + WS_WOUT) + (size_t)l * DM * RVW : (const bf16*)(ws + WS_WO) + (size_t)(l - 2) * DM * DM, NTOK, DM, K};
            pg8::StaticOrder S; S.init(NTOK, DM, c.G, c.bx);
            pg8::EpiRes E{X, DM, H, p.ln_ffn + (size_t)l * DM, (float*)(ws + WS_SQP)};
            pg8::gemm_phase<pg8::EpiRes, pg8::StaticOrder>(c.lds, g, S, E, nullptr);
        END_STEP
        BEGIN_STEP(8)
            pg8::Gemm g{H, (const bf16*)(ws + WS_WC) + (size_t)l * DM * DM, NTOK, DM, DM}; pg8::StaticOrder S; S.init(NTOK, DM, c.G, c.bx);
            pg8::EpiF32 E{(float*)(ws + WS_SC), DM};
            pg8::gemm_phase<pg8::EpiF32, pg8::StaticOrder>(c.lds, g, S, E, nullptr);
        END_STEP
        BEGIN_STEP(9)
            peer_topk_phase(c, (const float*)(ws + WS_SC), (int*)(ws + WS_IDX), (float*)(ws + WS_WGT), (const float*)(ws + WS_SQP), (float*)(ws + WS_RSTD));
        END_STEP
        BEGIN_STEP(10)
#ifdef DRYIDXMASK
            peer_u_phase(c, H, ws + WS_PU + (size_t)l * PE * DM, (const int*)(ws + WS_IDX), (float*)(ws + WS_SC), rep_ == 0 ? DRYIDXMASK : 0xffffffffu);
#else
            peer_u_phase(c, H, ws + WS_PU + (size_t)l * PE * DM, (const int*)(ws + WS_IDX), (float*)(ws + WS_SC));
#endif
        END_STEP
        BEGIN_STEP(11)
            peer_a_phase(c, (const float*)(ws + WS_SC), (const int*)(ws + WS_IDX), (float*)(ws + WS_WGT), (const float*)(ws + WS_RS) + (size_t)l * PE, (const float*)(ws + WS_RS) + (size_t)(DEPTH + l) * PE, (const float*)(ws + WS_RSTD));
        END_STEP
        BEGIN_STEP(12)
#ifdef VREF
            peer_v_ref_phase(c, ws + WS_PV + (size_t)l * PE * DM, (const int*)(ws + WS_IDX), (const float*)(ws + WS_WGT), X);
#else
            peer_v_phase(c, ws + WS_PV + (size_t)l * PE * DM, (const int*)(ws + WS_IDX), (const float*)(ws + WS_WGT), X);
#endif
        END_STEP
        BEGIN_STEP(13)
            const int mode = (l == DEPTH - 1) ? 2 : (l == 1 ? 1 : 0);
            norm_phase(c, X, mode, mode == 2 ? p.ln_final : p.ln_mix + (size_t)(l + 1) * DM, p.kv_norm, H, HKV);
        END_STEP
    }
#ifdef DIAGBUF
    if ((MASK >> 14) & 1) { MK_CTX(); diag_copy_phase(c, X, ws); }
#else
    if ((MASK >> 14) & 1) { MK_CTX(); MK_P(); rms_final_phase(c, X, p.ln_final); }
#endif
#undef BEGIN_STEP
#undef END_STEP
}

#ifndef N_LAUNCH_CUT
#define N_LAUNCH_CUT 1
#endif
typedef void (*kern_t)(Params);
template <int SITE> static void launch_site(const Params& p, hipStream_t stream) {
    static bool attr = false;
    if (!attr) { (void)hipFuncSetAttribute((const void*)yoco_fwd<(1 << SITE)>, hipFuncAttributeMaxDynamicSharedMemorySize, LDS_BYTES); attr = true; }
    hipLaunchKernelGGL((yoco_fwd<(1 << SITE)>), dim3(256), dim3(512), LDS_BYTES, stream, p);
}
#ifndef MEGASITES
#define MEGASITES 0
#endif
static void launch_step_site(int site, const Params& p, hipStream_t stream) {
    if ((MEGASITES >> site) & 1) { hipLaunchKernelGGL((yoco_fwd<0x3FFF>), dim3(256), dim3(512), LDS_BYTES, stream, p); return; }
    switch (site) {
        case 0: launch_site<0>(p, stream); break; case 1: launch_site<1>(p, stream); break; case 2: launch_site<2>(p, stream); break; case 3: launch_site<3>(p, stream); break;
        case 4: launch_site<4>(p, stream); break; case 5: launch_site<5>(p, stream); break; case 6: launch_site<6>(p, stream); break; case 7: launch_site<7>(p, stream); break;
        case 8: launch_site<8>(p, stream); break; case 9: launch_site<9>(p, stream); break; case 10: launch_site<10>(p, stream); break; case 11: launch_site<11>(p, stream); break; case 12: launch_site<12>(p, stream); break; case 13: launch_site<13>(p, stream); break; default: launch_site<14>(p, stream); break;
    }
}
extern "C" void kernel_launch(void* const* d_in, const int* in_sizes, int n_in, void* d_out, int out_size, void* d_ws, size_t ws_size, hipStream_t stream) {
    static int ready = 0;
    if (ready == 0) {
        if (n_in != 16 || out_size != NTOK * DM || ws_size < WS_END) { fprintf(stderr, "kernel_launch: unexpected sizes (n_in %d out %d ws %zu, need %zu)\n", n_in, out_size, ws_size, (size_t)WS_END); ready = -1; return; }
#if N_LAUNCH_CUT || MEGASITES
        if (hipFuncSetAttribute((const void*)yoco_fwd<0x3FFF>, hipFuncAttributeMaxDynamicSharedMemorySize, LDS_BYTES) != hipSuccess) { fprintf(stderr, "kernel_launch: hipFuncSetAttribute failed\n"); ready = -1; return; }
#endif
        ready = 1;
    }
    if (ready < 0) return;
    (void)hipMemsetAsync(d_ws, 0, 16384, stream);
    Params p{};
    p.x = (const float*)d_in[0]; p.ln_mix = (const float*)d_in[1]; p.ln_ffn = (const float*)d_in[2]; p.ret_w_in = (const float*)d_in[3]; p.ret_w_out = (const float*)d_in[4]; p.ret_gn = (const float*)d_in[5];
    p.kv_norm = (const float*)d_in[6]; p.w_kv = (const float*)d_in[7]; p.att_w_q = (const float*)d_in[8]; p.att_w_o = (const float*)d_in[9]; p.att_rel_bias = (const float*)d_in[10];
    p.peer_w_q = (const float*)d_in[11]; p.peer_sub_keys = (const float*)d_in[12]; p.peer_u = (const float*)d_in[13]; p.peer_v = (const float*)d_in[14]; p.ln_final = (const float*)d_in[15];
    p.out = (float*)d_out; p.ws = (unsigned char*)d_ws;
#if N_LAUNCH_CUT == 2
    for (int s2 = 0; s2 < NSTEPS; ++s2) { p.lo = s2; p.hi = s2 + 1; hipLaunchKernelGGL((yoco_fwd<0x3FFF>), dim3(256), dim3(512), LDS_BYTES, stream, p); }
#elif N_LAUNCH_CUT
    p.lo = 0; p.hi = NSTEPS;
    hipLaunchKernelGGL((yoco_fwd<0x3FFF>), dim3(256), dim3(512), LDS_BYTES, stream, p);
#else
    static const int siteA[10] = {1, 2, 3, 6, 8, 9, 10, 11, 12, 13}, siteB[9] = {4, 5, 6, 8, 9, 10, 11, 12, 13};
    int s = 0;
#ifndef NSTOP
#define NSTOP 1000
#endif
    p.lo = s; p.hi = s + 1; launch_step_site(0, p, stream); ++s;
    for (int l = 0; l < DEPTH; ++l) { const int n = l < 2 ? 10 : 9; for (int k = 0; k < n; ++k) { p.lo = s; p.hi = s + 1; if (s < NSTOP) launch_step_site(l < 2 ? siteA[k] : siteB[k], p, stream); ++s; } }
    if (NSTOP < NSTEPS) { p.lo = -1; p.hi = -1; launch_step_site(14, p, stream); }
#endif
}
```

```cpp
#include <hip/hip_runtime.h>
#include <cstdio>
#include <cstdint>

#define LAS __attribute__((address_space(3)))
#define GAS __attribute__((address_space(1)))
typedef unsigned short bf16;
typedef unsigned u32x2 __attribute__((ext_vector_type(2)));
typedef float f32x2v __attribute__((ext_vector_type(2)));

constexpr int DM = 2048, NBATCH = 4, SEQ = 4096, NTOK = NBATCH * SEQ, DEPTH = 4;
constexpr int CHUNK = 64, NCHUNK = SEQ / CHUNK;
constexpr int RH = 8, RQK = 256, RV = 512, RQKW = RH * RQK, RVW = RH * RV, RIN = 2 * RQKW + 2 * RVW;
constexpr int AH = 16, AHD = 128, LEFT = 8, NREL = 257;
constexpr int PH = 8, PNK = 128, PE = PNK * PNK, PTOPK = 16;
constexpr float EPS = 1e-6f;

constexpr size_t MiB = 1ull << 20;
constexpr size_t WS_CTL = 0, CTL_BYTES = 1 * MiB;
constexpr size_t WS_ROT = 1 * MiB;
constexpr size_t WS_RS = 6 * MiB;
constexpr size_t WS_WIN = 8 * MiB;
constexpr size_t WS_WOUT = 104 * MiB;
constexpr size_t WS_WKV = 136 * MiB;
constexpr size_t WS_WQ = 152 * MiB;
constexpr size_t WS_WO = 168 * MiB;
constexpr size_t WS_WC = 184 * MiB;
constexpr size_t WS_PU = 216 * MiB;
constexpr size_t WS_PV = 472 * MiB;
constexpr size_t WS_H = 728 * MiB;
constexpr size_t WS_HKV = 792 * MiB;
constexpr size_t WS_Q = 856 * MiB;
constexpr size_t WS_K = 920 * MiB;
constexpr size_t WS_V = 984 * MiB;
constexpr size_t WS_G = 1112 * MiB;
constexpr size_t WS_O = 1240 * MiB;
constexpr size_t WS_KV = 1368 * MiB;
constexpr size_t WS_AO = 1496 * MiB;
constexpr size_t WS_SC = 1560 * MiB;
constexpr size_t WS_IDX = 1688 * MiB;
constexpr size_t WS_WGT = 1696 * MiB;
constexpr size_t WS_SQP = 1704 * MiB;
constexpr size_t WS_RSTD = 1706 * MiB;
constexpr size_t WS_END = 1708 * MiB;

constexpr int LDS_BYTES = 160 * 1024;
constexpr int LDS_MISC = LDS_BYTES - 256;

__device__ __forceinline__ unsigned f2bf(float f) { unsigned u = __builtin_bit_cast(unsigned, f); return (u + 0x7fffu + ((u >> 16) & 1u)) >> 16; }
typedef __bf16 bfx2_t __attribute__((ext_vector_type(2)));
__device__ __forceinline__ unsigned pk2(float lo, float hi) { const f32x2v v = {lo, hi}; return __builtin_bit_cast(unsigned, __builtin_convertvector(v, bfx2_t)); }
__device__ __forceinline__ float bflo(unsigned u) { return __builtin_bit_cast(float, u << 16); }
__device__ __forceinline__ float bfhi(unsigned u) { return __builtin_bit_cast(float, u & 0xffff0000u); }
__device__ __forceinline__ float wave_sum(float v) {
#pragma unroll
    for (int o = 1; o < 64; o <<= 1) v += __shfl_xor(v, o);
    return v;
}
#define VM_WAIT() asm volatile("s_waitcnt vmcnt(0)" ::: "memory")
#define LDS_WAIT() asm volatile("s_waitcnt lgkmcnt(0)" ::: "memory")

#define XB_TMO      128
#define XB_XCNT(j)  (256  + 64 * (j))
#define XB_XSUB(j)  (1280 + 64 * (j))
#define XB_XGEN(j)  (2304 + 64 * (j))
#define XB_TOP      3328
#define XB_TOPGEN   3392
#define XCD_BAR_WORDS 3456
#define XB_SPIN_CAP (1u << 18)

__device__ __forceinline__ unsigned xb_ld(unsigned* p)              { return __hip_atomic_load(p, __ATOMIC_RELAXED, __HIP_MEMORY_SCOPE_AGENT); }
__device__ __forceinline__ unsigned xb_add(unsigned* p, unsigned v) { return __hip_atomic_fetch_add(p, v, __ATOMIC_RELAXED, __HIP_MEMORY_SCOPE_AGENT); }
__device__ __forceinline__ unsigned xb_xcc_id() { return (unsigned)__builtin_amdgcn_s_getreg((3 << 11) | 20) & 0xFu; }
#define XB_SPIN(cond, bar) do { unsigned _sp = 0; while (cond) { __builtin_amdgcn_s_sleep(1); \
    if ((++_sp & 255u) == 0u) { if (xb_ld(&(bar)[XB_TMO])) break; if (_sp > XB_SPIN_CAP) { atomicAdd(&(bar)[XB_TMO], 1u); break; } } } } while (0)

struct XcdBarrier {
    unsigned* bar; unsigned x;
    volatile LAS unsigned* st;
};

__device__ __forceinline__ XcdBarrier xcd_barrier_post(unsigned* bar, volatile LAS unsigned* st) {
    XcdBarrier b; b.bar = bar; b.x = xb_xcc_id(); b.st = st;
    if (threadIdx.x == 0) (void)xb_add(&bar[XB_XCNT(b.x)], 1u);
    return b;
}
__device__ __forceinline__ void xcd_barrier_complete(unsigned* bar, unsigned x, unsigned& nloc, unsigned& nx) {
    const unsigned G = gridDim.x * gridDim.y * gridDim.z;
    unsigned sum, cnt, mine, sp = 0u;
    for (;;) {
        sum = 0u; cnt = 0u; mine = 0u;
#pragma unroll
        for (unsigned j = 0; j < 16; ++j) { const unsigned c = xb_ld(&bar[XB_XCNT(j)]); sum += c; cnt += (c > 0u) ? 1u : 0u; mine = (j == x) ? c : mine; }
        if (sum == G) break;
        __builtin_amdgcn_s_sleep(1);
        if ((++sp & 255u) == 0u) { if (xb_ld(&bar[XB_TMO])) break; if (sp > XB_SPIN_CAP) { atomicAdd(&bar[XB_TMO], 1u); break; } }
    }
    nloc = mine > 0u ? mine : 1u; nx = cnt > 0u ? cnt : 1u;
}

__device__ __forceinline__ void xcd_barrier(const XcdBarrier& b) {
    asm volatile("s_waitcnt vmcnt(0)" ::: "memory");
    __syncthreads();
    if (threadIdx.x == 0) {
        unsigned* bar = b.bar;
        __builtin_amdgcn_s_waitcnt(0);
        unsigned nloc = b.st[0], nx = b.st[1];
        if (nloc == 0u) { xcd_barrier_complete(bar, b.x, nloc, nx); b.st[0] = nloc; b.st[1] = nx; }
        const unsigned old = xb_add(&bar[XB_XSUB(b.x)], 1u);
        const unsigned gen = old / nloc;
        if (old + 1u == (gen + 1u) * nloc) {
            __builtin_amdgcn_fence(__ATOMIC_RELEASE, "agent");
            asm volatile("s_waitcnt vmcnt(0)" ::: "memory");
            const unsigned og = xb_add(&bar[XB_TOP], 1u);
            const unsigned tg = og / nx;
            if (og + 1u == (tg + 1u) * nx) xb_add(&bar[XB_TOPGEN], 1u);
            else XB_SPIN(xb_ld(&bar[XB_TOPGEN]) == tg, bar);
            __builtin_amdgcn_fence(__ATOMIC_ACQUIRE, "agent");
            xb_add(&bar[XB_XGEN(b.x)], 1u);
            asm volatile("s_waitcnt vmcnt(0)" ::: "memory");
        } else {
            XB_SPIN(xb_ld(&bar[XB_XGEN(b.x)]) == gen, bar);
            __builtin_amdgcn_fence(__ATOMIC_ACQUIRE, "agent");
            asm volatile("s_waitcnt vmcnt(0)" ::: "memory");
        }
    }
    __syncthreads();
}

namespace pg8 {
#define PG8_LAS __attribute__((address_space(3)))
typedef unsigned short bf16_t;
typedef short bf16x8 __attribute__((ext_vector_type(8)));
typedef float f32x4 __attribute__((ext_vector_type(4)));
typedef unsigned u32x4 __attribute__((ext_vector_type(4)));
constexpr int BM = 256, BK = 64, HALF = 128, HTB = HALF * BK * 2  , STAGE_BYTES = 8 * HTB, NXCD = 8, WGM = 8;

__host__ __device__ __forceinline__ int lds_byte(int r, int c) { const int st = (r >> 4) * 2 + (c >> 5), rr = r & 15, cc = c & 31, ob = rr * 64 + cc * 2; return st * 1024 + (ob ^ (((ob >> 9) & 1) << 5)); }
__host__ __device__ __forceinline__ void stage_rc(int b, int& R, int& C) { const int st = b / 1024, sb = b % 1024, swz = sb ^ (((sb >> 9) & 1) << 5); R = (st >> 1) * 16 + swz / 64; C = (st & 1) * 32 + (swz % 64) / 2; }
__host__ __device__ __forceinline__ int perm32(int rho) { const int n = rho >> 4, i = rho & 15; return 8 * (i >> 2) + 4 * n + (i & 3); }

struct Unit { int pm, pn; };
struct Gemm { const bf16_t* A; const bf16_t* Bt; int M, N, K; };

struct StaticOrder {
    int nM, nN, nwg, G, c;
    __host__ __device__ void init(int M, int N, int G_, int c_) { nM = M / BM; nN = N / BM; nwg = nM * nN; G = G_; c = c_; }
    __host__ __device__ bool next(int i, Unit& u) const {
        const long L = (long)i * G + c; if (L >= nwg) return false;
        int wgid = (int)L; { const int q = nwg / NXCD, r = nwg % NXCD, xcd = wgid % NXCD, off = wgid / NXCD; wgid = (xcd < r ? xcd * (q + 1) : r * (q + 1) + (xcd - r) * q) + off; }
        const int nig = WGM * nN, gid = wgid / nig, fm = gid * WGM, gsz = (nM - fm) < WGM ? (nM - fm) : WGM;
        u.pm = fm + ((wgid % nig) % gsz); u.pn = (wgid % nig) / gsz; return true;
    }
    __device__ __forceinline__ void a_ready(const Unit&) const {}
    __device__ __forceinline__ void done(const Unit&) const {}
};
struct CountedOrder : StaticOrder {
    const unsigned* ready; unsigned need; unsigned* tmo;
    __device__ __forceinline__ void a_ready(const Unit& u) const {
        if (threadIdx.x < 64) {
            const unsigned long long t0 = __builtin_amdgcn_s_memrealtime(); unsigned polls = 0;
            while ((unsigned)__builtin_amdgcn_readfirstlane(__hip_atomic_load(ready + 64 * u.pm, __ATOMIC_RELAXED, __HIP_MEMORY_SCOPE_AGENT)) < need) {
                if ((++polls & 255u) == 0u && __builtin_amdgcn_readfirstlane(__hip_atomic_load(tmo, __ATOMIC_RELAXED, __HIP_MEMORY_SCOPE_AGENT)) != 0u) break;
                if (__builtin_amdgcn_s_memrealtime() - t0 > 2000000ull) {
                    if (threadIdx.x == 0) { unsigned expect = 0u; __hip_atomic_compare_exchange_strong(tmo + 1, &expect, 0x600u | (unsigned)(u.pm & 0xff), __ATOMIC_RELAXED, __ATOMIC_RELAXED, __HIP_MEMORY_SCOPE_AGENT); __hip_atomic_store(tmo, 1u, __ATOMIC_RELAXED, __HIP_MEMORY_SCOPE_AGENT); }
                    break; }
                __builtin_amdgcn_s_sleep(2); }
            __builtin_amdgcn_fence(__ATOMIC_ACQUIRE, "agent");
            asm volatile("s_waitcnt vmcnt(0)" ::: "memory");
        }
#if !defined(BROKEN_HOOK_NO_BARRIER)
        asm volatile("" ::: "memory"); __builtin_amdgcn_s_barrier(); asm volatile("" ::: "memory");
#endif
    }
};

__device__ __forceinline__ unsigned cvt_pk_bf16(float lo, float hi) { return pk2(lo, hi); }
typedef float f32x2 __attribute__((ext_vector_type(2)));
__device__ __forceinline__ f32x2 gelu_pk(f32x2 v) {
    const f32x2 av = __builtin_elementwise_abs(v), d = av * 0.2316418882f + 1.0f;
    f32x2 t; t.x = __builtin_amdgcn_rcpf(d.x); t.y = __builtin_amdgcn_rcpf(d.y);
    f32x2 q = t * 0.5307027145f + (-0.7265760135f); q = q * t + 0.7107068705f; q = q * t + (-0.142248368f); q = q * t + 0.127414796f; q = q * t;
    const f32x2 s = (v * v) * (-0.72134752044f);
    f32x2 e; e.x = __builtin_amdgcn_exp2f(s.x); e.y = __builtin_amdgcn_exp2f(s.y);
    const f32x2 m = v * (q * e), r = v - m;
    f32x2 o; o.x = v.x < 0.f ? m.x : r.x; o.y = v.y < 0.f ? m.y : r.y; return o;
}


struct EpiF32 {
    static constexpr bool PERM = false, AFTER_DRAIN = false;
    float* C; int ldc;
    __device__ __forceinline__ void operator()(const f32x4 (&acc)[2][2][4][2], const Unit& u, int wr, int wc, int fr, int fq) const {
        const int row0 = u.pm * BM + wr * 64 + fr, col0 = u.pn * BM + wc * 32 + 4 * fq;
#pragma unroll
        for (int ai = 0; ai < 2; ++ai)
#pragma unroll
            for (int m = 0; m < 4; ++m) { float* rowp = C + (size_t)(row0 + ai * HALF + m * 16) * ldc + col0;
#pragma unroll
                for (int bj = 0; bj < 2; ++bj)
#pragma unroll
                    for (int n = 0; n < 2; ++n) *(f32x4*)(rowp + bj * HALF + n * 16) = acc[ai][bj][m][n]; }
    }
};
struct EpiRes {
    static constexpr bool PERM = false, AFTER_DRAIN = false;
    float* X; int ldc; bf16_t* Hn; const float* gn; float* sqp;
    __device__ __forceinline__ void operator()(const f32x4 (&acc)[2][2][4][2], const Unit& u, int wr, int wc, int fr, int fq) const {
        const int row0 = u.pm * BM + wr * 64 + fr, col0 = u.pn * BM + wc * 32 + 4 * fq;
        f32x4 gv[2][2];
#pragma unroll
        for (int bj = 0; bj < 2; ++bj)
#pragma unroll
            for (int n = 0; n < 2; ++n) gv[bj][n] = *(const f32x4*)(gn + col0 + bj * HALF + n * 16);
#pragma unroll
        for (int ai = 0; ai < 2; ++ai) {
            f32x4 old[4][2][2];
#pragma unroll
            for (int m = 0; m < 4; ++m) { const float* rp = X + (size_t)(row0 + ai * HALF + m * 16) * ldc + col0;
#pragma unroll
                for (int bj = 0; bj < 2; ++bj)
#pragma unroll
                    for (int n = 0; n < 2; ++n) old[m][bj][n] = *(const f32x4*)(rp + bj * HALF + n * 16); }
#pragma unroll
            for (int m = 0; m < 4; ++m) { const int r = row0 + ai * HALF + m * 16; float* rowp = X + (size_t)r * ldc + col0; bf16_t* hp = Hn + (size_t)r * ldc + col0;
                float ss = 0.f;
#pragma unroll
                for (int bj = 0; bj < 2; ++bj)
#pragma unroll
                    for (int n = 0; n < 2; ++n) { const f32x4 xn = old[m][bj][n] + acc[ai][bj][m][n]; *(f32x4*)(rowp + bj * HALF + n * 16) = xn;
                        ss += (xn[0] * xn[0] + xn[1] * xn[1]) + (xn[2] * xn[2] + xn[3] * xn[3]);
                        const f32x4 hg = xn * gv[bj][n]; u32x2 hw; hw.x = pk2(hg[0], hg[1]); hw.y = pk2(hg[2], hg[3]); *(u32x2*)(hp + bj * HALF + n * 16) = hw; }
                ss += __shfl_xor(ss, 16); ss += __shfl_xor(ss, 32);
                if (fq == 0) sqp[(size_t)r * 32 + u.pn * 4 + wc] = ss; }
        }
    }
};
struct EpiBf16S {
    static constexpr bool PERM = true, AFTER_DRAIN = false;
    bf16_t* O; int ldc; float scale;
    __device__ __forceinline__ void operator()(const f32x4 (&acc)[2][2][4][2], const Unit& u, int wr, int wc, int fr, int fq) const {
        const int row0 = u.pm * BM + wr * 64 + fr, col0 = u.pn * BM + wc * 32 + 8 * fq;
#pragma unroll
        for (int ai = 0; ai < 2; ++ai)
#pragma unroll
            for (int m = 0; m < 4; ++m) { bf16_t* rowp = O + (size_t)(row0 + ai * HALF + m * 16) * ldc + col0;
#pragma unroll
                for (int bj = 0; bj < 2; ++bj) { const f32x4 v0 = acc[ai][bj][m][0] * scale, v1 = acc[ai][bj][m][1] * scale;
                    u32x4 w; w.x = cvt_pk_bf16(v0[0], v0[1]); w.y = cvt_pk_bf16(v0[2], v0[3]); w.z = cvt_pk_bf16(v1[0], v1[1]); w.w = cvt_pk_bf16(v1[2], v1[3]);
                    *(u32x4*)(rowp + bj * HALF) = w; } }
    }
};
struct EpiProj {
    static constexpr bool PERM = true, AFTER_DRAIN = false;
    bf16_t *Q, *Kp, *V, *G; const float* rot;
    __device__ __forceinline__ void operator()(const f32x4 (&acc)[2][2][4][2], const Unit& u, int wr, int wc, int fr, int fq) const {
        const int row0 = u.pm * BM + wr * 64 + fr, pn = u.pn, dd0 = wc * 32 + 8 * fq;
        if (pn < 16) {
            bf16_t* base = (pn < 8 ? Q : Kp) + (pn & 7) * 256 + dd0; const float sc = pn < 8 ? 1.0f : 0.0625f;
#pragma unroll
            for (int ai = 0; ai < 2; ++ai)
#pragma unroll
                for (int m = 0; m < 4; ++m) { const int r = row0 + ai * HALF + m * 16; const float* rt = rot + (size_t)(r & (4096 - 1)) * 256 + dd0;
                    f32x4 o1[2], o2[2];
#pragma unroll
                    for (int n = 0; n < 2; ++n) { const f32x4 cs = *(const f32x4*)(rt + 4 * n), sn = *(const f32x4*)(rt + 128 + 4 * n); const f32x4 t1 = acc[ai][0][m][n], t2 = acc[ai][1][m][n];
                        o1[n] = (t1 * cs - t2 * sn) * sc; o2[n] = (t1 * sn + t2 * cs) * sc; }
                    u32x4 w1, w2;
                    w1.x = cvt_pk_bf16(o1[0][0], o1[0][1]); w1.y = cvt_pk_bf16(o1[0][2], o1[0][3]); w1.z = cvt_pk_bf16(o1[1][0], o1[1][1]); w1.w = cvt_pk_bf16(o1[1][2], o1[1][3]);
                    w2.x = cvt_pk_bf16(o2[0][0], o2[0][1]); w2.y = cvt_pk_bf16(o2[0][2], o2[0][3]); w2.z = cvt_pk_bf16(o2[1][0], o2[1][1]); w2.w = cvt_pk_bf16(o2[1][2], o2[1][3]);
                    bf16_t* rowp = base + (size_t)r * 2048; *(u32x4*)rowp = w1; *(u32x4*)(rowp + 128) = w2; }
        } else {
            bf16_t* base = (pn < 32 ? V : G) + ((pn - 16) & 15) * 256 + dd0;
#pragma unroll
            for (int ai = 0; ai < 2; ++ai)
#pragma unroll
                for (int m = 0; m < 4; ++m) { bf16_t* rowp = base + (size_t)(row0 + ai * HALF + m * 16) * 4096;
#pragma unroll
                    for (int bj = 0; bj < 2; ++bj) { const f32x4 v0 = acc[ai][bj][m][0], v1 = acc[ai][bj][m][1];
                        u32x4 w; w.x = cvt_pk_bf16(v0[0], v0[1]); w.y = cvt_pk_bf16(v0[2], v0[3]); w.z = cvt_pk_bf16(v1[0], v1[1]); w.w = cvt_pk_bf16(v1[2], v1[3]);
                        *(u32x4*)(rowp + bj * HALF) = w; } }
        }
    }
};
template <class Epi, class Sched, bool STAMP = false>
__device__ __forceinline__ void gemm_phase(PG8_LAS unsigned char* lds, const Gemm g, const Sched& S, const Epi& E, unsigned long long* stamps) {
    int tid_ = threadIdx.x; asm volatile("" : "+v"(tid_));
    const int tid = tid_, wid = __builtin_amdgcn_readfirstlane(tid >> 6), lane = tid & 63, wr = wid >> 2, wc = wid & 3, fr = lane & 15, fq = lane >> 4;
    const int K = g.K, nt = K / BK;
    int ts_lo = 0, ts_hi = 0, nts = 0; const unsigned long long rt_entry = STAMP ? (unsigned long long)wall_clock64() : 0ull;
#define PG8_STAMP() do { if (STAMP && wid == 0 && nts < 64) { const unsigned long long _c = (unsigned long long)clock64(); \
        ts_lo = (lane == nts) ? (int)(unsigned)_c : ts_lo; ts_hi = (lane == nts) ? (int)(unsigned)(_c >> 32) : ts_hi; ++nts; } } while (0)
    PG8_STAMP();
    unsigned voffA[2], voffB[2];
#pragma unroll
    for (int i = 0; i < 2; ++i) { int R, C; stage_rc(tid * 16 + i * 8192, R, C); const int Rb = Epi::PERM ? ((R & ~31) + perm32(R & 31)) : R;
        voffA[i] = (unsigned)(R * K + C) * 2u; voffB[i] = (unsigned)(Rb * K + C) * 2u; }
    const size_t kstep = (size_t)(BK * 2);
    const size_t hstep = (size_t)HALF * K * 2;
    const size_t tstep = 2 * hstep;
    const unsigned ldsw = (unsigned)wid * 1024u;
    const int aoff = lds_byte(wr * 64 + fr, fq * 8), boff = lds_byte(wc * 32 + fr, fq * 8);
#define PG8_SA(b, h) (((b) * 2 + (h)) * HTB)
#define PG8_SB(b, h) ((4 + (b) * 2 + (h)) * HTB)
#define PG8_STAGE(bufoff, gbase, voff) do { _Pragma("unroll") for (int _i = 0; _i < 2; ++_i) \
        __builtin_amdgcn_global_load_lds((const unsigned*)((const char*)(gbase) + (voff)[_i]), (PG8_LAS unsigned*)(lds + (bufoff) + ldsw + _i * 8192), 16, 0, 0); } while (0)
#define PG8_LDA(dst, b, h) do { _Pragma("unroll") for (int m = 0; m < 4; ++m) _Pragma("unroll") for (int k = 0; k < 2; ++k) dst[m][k] = *(const PG8_LAS bf16x8*)(lds + PG8_SA(b, h) + aoff + m * 2048 + k * 1024); } while (0)
#define PG8_LDB(dst, b, h) do { _Pragma("unroll") for (int n = 0; n < 2; ++n) _Pragma("unroll") for (int k = 0; k < 2; ++k) dst[n][k] = *(const PG8_LAS bf16x8*)(lds + PG8_SB(b, h) + boff + n * 2048 + k * 1024); } while (0)
#define PG8_MMA(ai, bj, At, Bt) do { __builtin_amdgcn_s_setprio(1); _Pragma("unroll") for (int m = 0; m < 4; ++m) _Pragma("unroll") for (int n = 0; n < 2; ++n) _Pragma("unroll") for (int k = 0; k < 2; ++k) \
        acc[ai][bj][m][n] = __builtin_amdgcn_mfma_f32_16x16x32_bf16(Bt[n][k], At[m][k], acc[ai][bj][m][n], 0, 0, 0); __builtin_amdgcn_s_setprio(0); } while (0)
#define PG8_WAIT_V(n) asm volatile("s_waitcnt vmcnt(" #n ")" ::: "memory")
#define PG8_WAIT_L(n) asm volatile("s_waitcnt lgkmcnt(" #n ")" ::: "memory")
#define PG8_BAR __builtin_amdgcn_s_barrier()
#define PG8_SCHED __builtin_amdgcn_sched_barrier(0)
    Unit cur, nxt; int ui = 0;
    if (!S.next(0, cur)) return;
    f32x4 acc[2][2][4][2];
#pragma unroll
    for (int a = 0; a < 2; ++a)
#pragma unroll
        for (int b = 0; b < 2; ++b)
#pragma unroll
            for (int m = 0; m < 4; ++m)
#pragma unroll
                for (int n = 0; n < 2; ++n) acc[a][b][m][n] = (f32x4){0.f, 0.f, 0.f, 0.f};
    bf16x8 At[4][2], B0[2][2], B1[2][2];
    const char* cA = (const char*)g.A + (size_t)cur.pm * tstep; const char* cB = (const char*)g.Bt + (size_t)cur.pn * tstep;
    S.a_ready(cur);
    PG8_STAGE(PG8_SB(0, 0), cB, voffB); PG8_STAGE(PG8_SA(0, 0), cA, voffA); PG8_STAGE(PG8_SB(0, 1), cB + hstep, voffB); PG8_STAGE(PG8_SA(0, 1), cA + hstep, voffA);
    if (wr == 1) PG8_BAR;
    PG8_WAIT_V(4); PG8_BAR;
    PG8_STAGE(PG8_SB(1, 0), cB + kstep, voffB); PG8_STAGE(PG8_SA(1, 0), cA + kstep, voffA); PG8_STAGE(PG8_SB(1, 1), cB + hstep + kstep, voffB);
    PG8_WAIT_V(6); PG8_BAR;
    PG8_STAMP();
    for (;;) {
        const bool has_next = S.next(ui + 1, nxt);
        const char* nA = has_next ? (const char*)g.A + (size_t)nxt.pm * tstep : cA; const char* nB = has_next ? (const char*)g.Bt + (size_t)nxt.pn * tstep : cB;
        for (int t = 0; t < nt; t += 2) {
            const bool last = (t == nt - 2);
            const char* a1 = cA + (size_t)(t + 1) * kstep;
            const char* a2 = last ? nA : cA + (size_t)(t + 2) * kstep; const char* b2 = last ? nB : cB + (size_t)(t + 2) * kstep;
            const char* a3 = a2 + kstep; const char* b3 = b2 + kstep;
            if (last && has_next) S.a_ready(nxt);
            PG8_LDB(B0, 0, 0); PG8_SCHED; PG8_LDA(At, 0, 0); PG8_STAGE(PG8_SA(1, 1), a1 + hstep, voffA);
            PG8_WAIT_L(8); PG8_BAR; PG8_WAIT_L(0); PG8_MMA(0, 0, At, B0); PG8_BAR; PG8_SCHED;
            PG8_LDB(B1, 0, 1); PG8_STAGE(PG8_SB(0, 0), b2, voffB);
            PG8_BAR; PG8_WAIT_L(0); PG8_MMA(0, 1, At, B1); PG8_BAR;
            PG8_LDA(At, 0, 1); PG8_STAGE(PG8_SA(0, 0), a2, voffA);
            PG8_BAR; PG8_WAIT_L(0); PG8_MMA(1, 0, At, B0); PG8_BAR; PG8_SCHED;
            PG8_STAGE(PG8_SB(0, 1), b2 + hstep, voffB);
            PG8_WAIT_V(6); PG8_BAR; PG8_MMA(1, 1, At, B1); PG8_BAR;
            PG8_LDB(B0, 1, 0); PG8_SCHED; PG8_LDA(At, 1, 0); PG8_STAGE(PG8_SA(0, 1), a2 + hstep, voffA);
            PG8_WAIT_L(8); PG8_BAR; PG8_WAIT_L(0); PG8_MMA(0, 0, At, B0); PG8_BAR; PG8_SCHED;
            PG8_LDB(B1, 1, 1); PG8_STAGE(PG8_SB(1, 0), b3, voffB);
            PG8_BAR; PG8_WAIT_L(0); PG8_MMA(0, 1, At, B1); PG8_BAR;
            PG8_LDA(At, 1, 1); PG8_STAGE(PG8_SA(1, 0), a3, voffA);
            PG8_BAR; PG8_WAIT_L(0); PG8_MMA(1, 0, At, B0); PG8_BAR; PG8_SCHED;
            PG8_STAGE(PG8_SB(1, 1), b3 + hstep, voffB);
            PG8_WAIT_V(6); PG8_BAR; PG8_MMA(1, 1, At, B1); PG8_BAR;
        }
        PG8_STAMP();
        if constexpr (!Epi::AFTER_DRAIN) { E(acc, cur, wr, wc, fr, fq); S.done(cur); }
        PG8_STAMP();
        if (!has_next) break;
#pragma unroll
        for (int a = 0; a < 2; ++a)
#pragma unroll
            for (int b = 0; b < 2; ++b)
#pragma unroll
                for (int m = 0; m < 4; ++m)
#pragma unroll
                    for (int n = 0; n < 2; ++n) acc[a][b][m][n] = (f32x4){0.f, 0.f, 0.f, 0.f};
        cur = nxt; cA = nA; cB = nB; ++ui;
    }
    PG8_WAIT_V(0);
    if (wr == 0) PG8_BAR;
    PG8_BAR;
    if constexpr (Epi::AFTER_DRAIN) { E.fused(acc, cur, wr, wc, fr, fq, lds, wid, lane); S.done(cur); }
    PG8_STAMP();
    if (STAMP && wid == 0) { stamps[lane] = lane < nts ? (((unsigned long long)(unsigned)ts_hi << 32) | (unsigned)ts_lo) : 0ull;
        if (lane == 62) stamps[62] = rt_entry; if (lane == 63) stamps[63] = (unsigned long long)wall_clock64(); }
#undef PG8_STAMP
#undef PG8_SA
#undef PG8_SB
#undef PG8_STAGE
#undef PG8_LDA
#undef PG8_LDB
#undef PG8_MMA
#undef PG8_WAIT_V
#undef PG8_WAIT_L
#undef PG8_BAR
#undef PG8_SCHED
}
}

using pg8::bf16x8; using pg8::f32x4; using pg8::u32x4;
typedef short s16x4 __attribute__((ext_vector_type(4)));
typedef __bf16 bfx2 __attribute__((ext_vector_type(2)));

struct Params {
    const float *x, *ln_mix, *ln_ffn, *ret_w_in, *ret_w_out, *ret_gn, *kv_norm, *w_kv, *att_w_q, *att_w_o, *att_rel_bias, *peer_w_q, *peer_sub_keys, *peer_u, *peer_v, *ln_final;
    float* out; unsigned char* ws; int lo, hi;
};
struct Ctx { LAS unsigned char* lds; int tid, lane, wave, bx, G, gw, ngw; };

__device__ __forceinline__ float dot2bf(unsigned a, unsigned b, float c) { return __builtin_amdgcn_fdot2_f32_bf16(__builtin_bit_cast(bfx2, a), __builtin_bit_cast(bfx2, b), c, false); }
__device__ __forceinline__ bf16x8 lds128(LAS const unsigned char* p) { return *(LAS const bf16x8*)p; }
__device__ __forceinline__ bf16x8 tr_frag(unsigned a0, unsigned a1) {
    s16x4 lo, hi;
    asm volatile("ds_read_b64_tr_b16 %0, %2\n\tds_read_b64_tr_b16 %1, %3\n\ts_waitcnt lgkmcnt(0)" : "=&v"(lo), "=&v"(hi) : "v"(a0), "v"(a1) : "memory");
    bf16x8 r; r[0] = lo[0]; r[1] = lo[1]; r[2] = lo[2]; r[3] = lo[3]; r[4] = hi[0]; r[5] = hi[1]; r[6] = hi[2]; r[7] = hi[3]; return r;
}
#define MFMA16(a, b, c) __builtin_amdgcn_mfma_f32_16x16x32_bf16((a), (b), (c), 0, 0, 0)

__device__ __forceinline__ void load_row(const float* xrow, int lane, f32x4 (&v)[8]) {
    const f32x4* xr = (const f32x4*)xrow + lane;
#pragma unroll
    for (int j = 0; j < 8; ++j) v[j] = xr[64 * j];
}
__device__ __forceinline__ float row_rstd(const f32x4 (&v)[8]) {
    float s = 0.f;
#pragma unroll
    for (int j = 0; j < 8; ++j) s += (v[j][0] * v[j][0] + v[j][1] * v[j][1]) + (v[j][2] * v[j][2] + v[j][3] * v[j][3]);
    return 1.0f / sqrtf(wave_sum(s) * (1.0f / DM) + EPS);
}
__device__ __forceinline__ void store_norm_bf16(const f32x4 (&v)[8], float rstd, const float* g, bf16* orow, int lane) {
    const f32x4* gr = (const f32x4*)g + lane; u32x2* o8 = (u32x2*)orow + lane;
#pragma unroll
    for (int j = 0; j < 8; ++j) { const f32x4 gv = gr[64 * j]; u32x2 w; w.x = pk2(v[j][0] * rstd * gv[0], v[j][1] * rstd * gv[1]); w.y = pk2(v[j][2] * rstd * gv[2], v[j][3] * rstd * gv[3]); o8[64 * j] = w; }
}
__device__ __forceinline__ void load_g(const float* g, int lane, f32x4 (&gv)[8]) {
    const f32x4* gr = (const f32x4*)g + lane;
#pragma unroll
    for (int j = 0; j < 8; ++j) gv[j] = gr[64 * j];
}
__device__ __forceinline__ void store_norm_bf16_r(const f32x4 (&v)[8], float rstd, const f32x4 (&gv)[8], bf16* orow, int lane) {
    u32x2* o8 = (u32x2*)orow + lane;
#pragma unroll
    for (int j = 0; j < 8; ++j) { u32x2 w; w.x = pk2(v[j][0] * rstd * gv[j][0], v[j][1] * rstd * gv[j][1]); w.y = pk2(v[j][2] * rstd * gv[j][2], v[j][3] * rstd * gv[j][3]); o8[64 * j] = w; }
}
__device__ __forceinline__ unsigned q8pack(float a, float b, float c, float d) {
    const unsigned ua = __builtin_bit_cast(unsigned, a + 12582912.0f), ub = __builtin_bit_cast(unsigned, b + 12582912.0f), uc = __builtin_bit_cast(unsigned, c + 12582912.0f), ud = __builtin_bit_cast(unsigned, d + 12582912.0f);
    return (ua & 255u) | ((ub & 255u) << 8) | ((uc & 255u) << 16) | (ud << 24);
}

__device__ __forceinline__ void p0_transpose_item(const float* W, int K, int N, bf16* WT, LAS float* scr, int item, int lane) {
    const int nblk = N / 32, kb = item / nblk, nb = item % nblk, k0 = 64 * kb, n0 = 32 * nb;
    float tv[32];
#pragma unroll
    for (int i = 0; i < 32; ++i) { const int kk = 2 * i + (lane >> 5); tv[i] = W[(size_t)(k0 + kk) * N + n0 + (lane & 31)]; }
#pragma unroll
    for (int i = 0; i < 32; ++i) { const int kk = 2 * i + (lane >> 5); scr[kk * 33 + (lane & 31)] = tv[i]; }
    LDS_WAIT(); asm volatile("" ::: "memory");
    const int c = lane & 7;
#pragma unroll
    for (int j = 0; j < 4; ++j) { const int n = (lane >> 3) + 8 * j; const LAS float* s = scr + (8 * c) * 33 + n;
        u32x4 o; o.x = pk2(s[0 * 33], s[1 * 33]); o.y = pk2(s[2 * 33], s[3 * 33]); o.z = pk2(s[4 * 33], s[5 * 33]); o.w = pk2(s[6 * 33], s[7 * 33]);
        *(u32x4*)(WT + (size_t)(n0 + n) * K + k0 + 8 * c) = o; }
    LDS_WAIT(); asm volatile("" ::: "memory");
}
__device__ __forceinline__ void p0_fold_tile(const Params& p, const Ctx& c, int tl) {
    const int l = tl >> 9, hp = (tl >> 5) & 15, j0 = (tl & 31) * 64;
    LAS float* As = (LAS float*)c.lds;
    LAS float* Bs = (LAS float*)c.lds + 64 * 132;
    const float* Wq = p.peer_w_q + (size_t)l * DM * DM; const float* sk = p.peer_sub_keys + ((size_t)l * 2 + (hp & 1)) * PNK * 128;
    __syncthreads();
    for (int i = c.tid; i < 64 * 32; i += 512) { const int jj = i >> 5, d4 = i & 31; *(LAS f32x4*)(As + jj * 132 + d4 * 4) = *(const f32x4*)(Wq + (size_t)(j0 + jj) * DM + hp * 128 + d4 * 4); }
    for (int i = c.tid; i < 128 * 32; i += 512) { const int k = i >> 5, d4 = i & 31; *(LAS f32x4*)(Bs + k * 132 + d4 * 4) = *(const f32x4*)(sk + (size_t)k * 128 + d4 * 4); }
    __syncthreads();
    const int tj = c.tid & 15, tk = c.tid >> 4;
    float acc[4][4];
#pragma unroll
    for (int b = 0; b < 4; ++b)
#pragma unroll
        for (int a = 0; a < 4; ++a) acc[b][a] = 0.f;
    for (int d4 = 0; d4 < 32; ++d4) {
        f32x4 av[4], bv[4];
#pragma unroll
        for (int a = 0; a < 4; ++a) av[a] = *(LAS const f32x4*)(As + (tj + 16 * a) * 132 + d4 * 4);
#pragma unroll
        for (int b = 0; b < 4; ++b) bv[b] = *(LAS const f32x4*)(Bs + (tk * 4 + b) * 132 + d4 * 4);
#pragma unroll
        for (int b = 0; b < 4; ++b)
#pragma unroll
            for (int a = 0; a < 4; ++a) acc[b][a] += (av[a][0] * bv[b][0] + av[a][1] * bv[b][1]) + (av[a][2] * bv[b][2] + av[a][3] * bv[b][3]);
    }
    bf16* WcT = (bf16*)(p.ws + WS_WC) + (size_t)l * DM * DM;
#pragma unroll
    for (int b = 0; b < 4; ++b)
#pragma unroll
        for (int a = 0; a < 4; ++a) WcT[(size_t)(hp * 128 + tk * 4 + b) * DM + j0 + tj + 16 * a] = (bf16)f2bf(acc[b][a]);
}
__device__ __forceinline__ void p0_prologue(const Params& p, const Ctx& c) {
#ifndef PROREP
#define PROREP 0
#endif
    const bool fold_last = (c.bx & 1) != 0;
    if (!fold_last) {
    for (int tl = c.bx; tl < DEPTH * 16 * 32; tl += c.G) p0_fold_tile(p, c, tl);
    __syncthreads();
    }
    for (int rp_ = ((PROREP >> 1) & 1) ? 0 : 1; rp_ < 2; ++rp_)
    {
        LAS float* scr = (LAS float*)(c.lds + c.wave * 16384);
        constexpr int I_IN = (DM / 64) * (RIN / 32), I_OUT = (RVW / 64) * (DM / 32), I_KV = (DM / 64) * (2 * DM / 32), I_SQ = (DM / 64) * (DM / 32);
        constexpr int NITEMS = 2 * I_IN + 2 * I_OUT + I_KV + 4 * I_SQ;
        for (int it = c.gw; it < NITEMS; it += c.ngw) {
            int r = it;
            if (r < 2 * I_IN) { const int l = r / I_IN; p0_transpose_item(p.ret_w_in + (size_t)l * DM * RIN, DM, RIN, (bf16*)(p.ws + WS_WIN) + (size_t)l * RIN * DM, scr, r % I_IN, c.lane); continue; } r -= 2 * I_IN;
            if (r < 2 * I_OUT) { const int l = r / I_OUT; p0_transpose_item(p.ret_w_out + (size_t)l * RVW * DM, RVW, DM, (bf16*)(p.ws + WS_WOUT) + (size_t)l * DM * RVW, scr, r % I_OUT, c.lane); continue; } r -= 2 * I_OUT;
            if (r < I_KV) { p0_transpose_item(p.w_kv, DM, 2 * DM, (bf16*)(p.ws + WS_WKV), scr, r, c.lane); continue; } r -= I_KV;
            if (r < 2 * I_SQ) { const int l = r / I_SQ; p0_transpose_item(p.att_w_q + (size_t)l * DM * DM, DM, DM, (bf16*)(p.ws + WS_WQ) + (size_t)l * DM * DM, scr, r % I_SQ, c.lane); continue; } r -= 2 * I_SQ;
            { const int l = r / I_SQ; p0_transpose_item(p.att_w_o + (size_t)l * DM * DM, DM, DM, (bf16*)(p.ws + WS_WO) + (size_t)l * DM * DM, scr, r % I_SQ, c.lane); }
        }
    }
    for (int rp_ = ((PROREP >> 2) & 1) ? 0 : 1; rp_ < 2; ++rp_)
    {
        float* rs = (float*)(p.ws + WS_RS);
        for (int row = c.gw; row < 2 * DEPTH * PE; row += c.ngw) {
            const int which = row >= DEPTH * PE, r = row - which * DEPTH * PE;
            f32x4 v[8]; load_row((which ? p.peer_v : p.peer_u) + (size_t)r * DM, c.lane, v);
            float am = 0.f;
#pragma unroll
            for (int j = 0; j < 8; ++j) am = fmaxf(fmaxf(am, fmaxf(fabsf(v[j][0]), fabsf(v[j][1]))), fmaxf(fabsf(v[j][2]), fabsf(v[j][3])));
#pragma unroll
            for (int o = 1; o < 64; o <<= 1) am = fmaxf(am, __shfl_xor(am, o));
            int e = (int)((__builtin_bit_cast(unsigned, am) >> 23) & 0xffu) - 127; if (am == 0.f) e = 7;
            int k = 7 - e; k = k < -100 ? -100 : (k > 100 ? 100 : k);
            const float sc = __builtin_bit_cast(float, (unsigned)(k + 127) << 23), rsc = __builtin_bit_cast(float, (unsigned)(127 - k) << 23);
            const int lyr = r / PE, re = r % PE;
            unsigned char* dstb = p.ws + (which ? WS_PV : WS_PU) + (size_t)lyr * PE * DM + (size_t)re * 128;
            if (which) {
#pragma unroll
                for (int j = 0; j < 8; ++j) { int w = 0; w = __builtin_amdgcn_cvt_pk_fp8_f32(v[j][0] * sc, v[j][1] * sc, w, false); w = __builtin_amdgcn_cvt_pk_fp8_f32(v[j][2] * sc, v[j][3] * sc, w, true); { const int col = 4 * c.lane + 256 * j; *(unsigned*)(dstb + (size_t)(col >> 7) * PE * 128 + (col & 127)) = (unsigned)w; } }
                if (c.lane == 0) rs[row] = rsc;
            } else {
                const float s8 = am > 0.f ? 127.0f / am : 0.f;
#pragma unroll
                for (int j = 0; j < 8; ++j) { const unsigned w = q8pack(v[j][0] * s8, v[j][1] * s8, v[j][2] * s8, v[j][3] * s8); const int col = 4 * c.lane + 256 * j; *(unsigned*)(dstb + (size_t)(col >> 7) * PE * 128 + (col & 127)) = w; }
                if (c.lane == 0) rs[row] = am * (1.0f / 127.0f);
            }
        }
    }
    for (int rp_ = ((PROREP >> 3) & 1) ? 0 : 1; rp_ < 2; ++rp_)
    {
        float* rot = (float*)(p.ws + WS_ROT);
        for (int i = c.bx * 512 + c.tid; i < SEQ * 128; i += c.G * 512) { const int pos = i >> 7, d = i & 127;
            const float inv = (float)(1.0 / pow(10000.0, (double)d / 128.0)); const float ang = (float)pos * inv;
            rot[(size_t)pos * 256 + d] = (float)cos((double)ang); rot[(size_t)pos * 256 + 128 + d] = (float)sin((double)ang); }
    }
    for (int rp_ = ((PROREP >> 4) & 1) ? 0 : 1; rp_ < 2; ++rp_)
    { f32x4 gv[8]; load_g(p.ln_mix, c.lane, gv);
      for (int m = c.gw; m < NTOK; m += c.ngw) {
        f32x4 v[8]; load_row(p.x + (size_t)m * DM, c.lane, v);
        f32x4* xo = (f32x4*)(p.out + (size_t)m * DM) + c.lane;
#pragma unroll
        for (int j = 0; j < 8; ++j) xo[64 * j] = v[j];
        store_norm_bf16_r(v, row_rstd(v), gv, (bf16*)(p.ws + WS_H) + (size_t)m * DM, c.lane);
      } }
    if (fold_last) {
    __syncthreads();
    for (int tl = c.bx; tl < DEPTH * 16 * 32; tl += c.G) p0_fold_tile(p, c, tl);
    __syncthreads();
    }
}

constexpr int RS_QS = 0, RS_KS = 33792, RS_VS = 67584, RS_VZ = 76800, RS_PS = 86016, RS_RS = 95232, RS_END = 129024, QK_STR = 528, V_STR = 144;
__device__ __forceinline__ void ret_scan_unit(const Ctx& c, const bf16* Qg, const bf16* Kg, const bf16* Vg, bf16* Og, int unit) {
    const int xg = unit & 7, slot = unit >> 3, pair = xg * 4 + (slot >> 3), es = slot & 7, b = pair >> 3, h = pair & 7;
    const int tid = c.tid, lane = c.lane, w = c.wave, fr = lane & 15, fq = lane >> 4, tq = (lane & 15) >> 2, tp = lane & 3;
    LAS unsigned char* lds = c.lds;
    const float lgam = log1pf(-exp2f(-5.0f - (float)h));
    const float cdec = expf(lgam * 64.0f);
    const int lrow = tid >> 3, lch = tid & 7;
    const size_t tok0 = (size_t)b * SEQ;
    const bf16* qrow = Qg + (tok0 + lrow) * RQKW + h * RQK + lch * 8;
    const bf16* krow = Kg + (tok0 + lrow) * RQKW + h * RQK + lch * 8;
    const bf16* vrow = Vg + (tok0 + lrow) * RVW + h * RV + es * 64 + lch * 8;
    const float zeta = expf(lgam * (float)(63 - lrow));
    u32x4 pq[4], pk[4], pv;
#pragma unroll
    for (int cc = 0; cc < 4; ++cc) { pq[cc] = *(const u32x4*)(qrow + cc * 64); pk[cc] = *(const u32x4*)(krow + cc * 64); }
    pv = *(const u32x4*)vrow;
    __syncthreads();
    for (int i = tid; i < (RS_END - RS_RS) / 16; i += 512) *(LAS u32x4*)(lds + RS_RS + i * 16) = (u32x4){0u, 0u, 0u, 0u};
    f32x4 Racc[2][4];
#pragma unroll
    for (int x = 0; x < 2; ++x)
#pragma unroll
        for (int y = 0; y < 4; ++y) Racc[x][y] = (f32x4){0.f, 0.f, 0.f, 0.f};
    const int jt = w & 3, it0 = 2 * (w >> 2);
    const int it = w & 3, et0 = 2 * (w >> 2);
    float xi[4];
#pragma unroll
    for (int r = 0; r < 4; ++r) xi[r] = expf(lgam * (float)(16 * it + 4 * fq + r + 1));
    const unsigned ldsb = (unsigned)(size_t)lds;
    float dmask[2][4];
#pragma unroll
    for (int x = 0; x < 2; ++x)
#pragma unroll
        for (int r = 0; r < 4; ++r) { const int i = 16 * (it0 + x) + fr, j = 16 * jt + 4 * fq + r; dmask[x][r] = (i >= j) ? expf(lgam * (float)(i - j)) : 0.f; }
    asm volatile("" : "+v"(dmask[0][0]), "+v"(dmask[0][1]), "+v"(dmask[0][2]), "+v"(dmask[0][3]), "+v"(dmask[1][0]), "+v"(dmask[1][1]), "+v"(dmask[1][2]), "+v"(dmask[1][3]));
    for (int n = 0; n < NCHUNK; ++n) {
        __syncthreads();
#pragma unroll
        for (int cc = 0; cc < 4; ++cc) { *(LAS u32x4*)(lds + RS_QS + lrow * QK_STR + (lch + 8 * cc) * 16) = pq[cc]; *(LAS u32x4*)(lds + RS_KS + lrow * QK_STR + (lch + 8 * cc) * 16) = pk[cc]; }
        *(LAS u32x4*)(lds + RS_VS + lrow * V_STR + lch * 16) = pv;
        { u32x4 z; z.x = pk2(bflo(pv.x) * zeta, bfhi(pv.x) * zeta); z.y = pk2(bflo(pv.y) * zeta, bfhi(pv.y) * zeta); z.z = pk2(bflo(pv.z) * zeta, bfhi(pv.z) * zeta); z.w = pk2(bflo(pv.w) * zeta, bfhi(pv.w) * zeta);
          *(LAS u32x4*)(lds + RS_VZ + lrow * V_STR + lch * 16) = z; }
        __syncthreads();
        if (n + 1 < NCHUNK) {
            const size_t adv = (size_t)(n + 1) * CHUNK;
#pragma unroll
            for (int cc = 0; cc < 4; ++cc) { pq[cc] = *(const u32x4*)(qrow + adv * RQKW + cc * 64); pk[cc] = *(const u32x4*)(krow + adv * RQKW + cc * 64); }
            pv = *(const u32x4*)(vrow + adv * RVW);
        }
        {
            f32x4 s0 = (f32x4){0.f, 0.f, 0.f, 0.f}, s1 = s0;
#pragma unroll
            for (int kh = 0; kh < 2; ++kh) {
                bf16x8 fa[4], fb0[4], fb1[4];
#pragma unroll
                for (int k4 = 0; k4 < 4; ++k4) { const int ks = 4 * kh + k4;
                    fa[k4] = lds128(lds + RS_KS + (16 * jt + fr) * QK_STR + (4 * ks + fq) * 16);
                    fb0[k4] = lds128(lds + RS_QS + (16 * it0 + fr) * QK_STR + (4 * ks + fq) * 16);
                    fb1[k4] = lds128(lds + RS_QS + (16 * (it0 + 1) + fr) * QK_STR + (4 * ks + fq) * 16); }
                __builtin_amdgcn_sched_barrier(0);
#pragma unroll
                for (int k4 = 0; k4 < 4; ++k4) { s0 = MFMA16(fa[k4], fb0[k4], s0); s1 = MFMA16(fa[k4], fb1[k4], s1); }
            }
#pragma unroll
            for (int x = 0; x < 2; ++x) { const f32x4 s = x ? s1 : s0; const int i = 16 * (it0 + x) + fr; float pr[4];
#pragma unroll
                for (int r = 0; r < 4; ++r) pr[r] = s[r] * dmask[x][r];
                u32x2 pw; pw.x = pk2(pr[0], pr[1]); pw.y = pk2(pr[2], pr[3]);
                *(LAS u32x2*)(lds + RS_PS + i * V_STR + (16 * jt + 4 * fq) * 2) = pw; }
        }
        f32x4 o0 = (f32x4){0.f, 0.f, 0.f, 0.f}, o1 = o0;
        {
#pragma unroll
            for (int kh = 0; kh < 2; ++kh) {
                bf16x8 fa[4], fb0[4], fb1[4];
#pragma unroll
                for (int k4 = 0; k4 < 4; ++k4) { const int ks = 4 * kh + k4;
                    fa[k4] = lds128(lds + RS_QS + (16 * it + fr) * QK_STR + (4 * ks + fq) * 16);
                    fb0[k4] = lds128(lds + RS_RS + (16 * et0 + fr) * QK_STR + (4 * ks + fq) * 16);
                    fb1[k4] = lds128(lds + RS_RS + (16 * (et0 + 1) + fr) * QK_STR + (4 * ks + fq) * 16); }
                __builtin_amdgcn_sched_barrier(0);
#pragma unroll
                for (int k4 = 0; k4 < 4; ++k4) { o0 = MFMA16(fa[k4], fb0[k4], o0); o1 = MFMA16(fa[k4], fb1[k4], o1); }
            }
        }
#pragma unroll
        for (int r = 0; r < 4; ++r) { o0[r] *= xi[r]; o1[r] *= xi[r]; }
        __syncthreads();
#pragma unroll
        for (int ks = 0; ks < 2; ++ks) {
            const bf16x8 a = lds128(lds + RS_PS + (16 * it + fr) * V_STR + (4 * ks + fq) * 16);
            const unsigned va = ldsb + RS_VS + (32 * ks + 8 * fq + tq) * V_STR + 8 * tp;
            const bf16x8 b0 = tr_frag(va + 32 * et0, va + 4 * V_STR + 32 * et0);
            const bf16x8 b1 = tr_frag(va + 32 * (et0 + 1), va + 4 * V_STR + 32 * (et0 + 1));
            __builtin_amdgcn_sched_barrier(0);
            o0 = MFMA16(a, b0, o0); o1 = MFMA16(a, b1, o1);
        }
        {
            bf16* op = Og + (tok0 + (size_t)n * CHUNK + 16 * it + 4 * fq) * RVW + h * RV + es * 64 + 16 * et0 + fr;
#pragma unroll
            for (int r = 0; r < 4; ++r) { op[(size_t)r * RVW] = (bf16)f2bf(o0[r]); op[(size_t)r * RVW + 16] = (bf16)f2bf(o1[r]); }
        }
#pragma unroll
        for (int x = 0; x < 2; ++x)
#pragma unroll
            for (int y = 0; y < 4; ++y) Racc[x][y] *= cdec;
#pragma unroll
        for (int ks = 0; ks < 2; ++ks) {
            const unsigned ka = ldsb + RS_KS + (32 * ks + 8 * fq + tq) * QK_STR + 8 * tp;
            const unsigned za = ldsb + RS_VZ + (32 * ks + 8 * fq + tq) * V_STR + 8 * tp;
            bf16x8 ak[2], bz[4];
#pragma unroll
            for (int x = 0; x < 2; ++x) ak[x] = tr_frag(ka + 32 * (2 * w + x), ka + 4 * QK_STR + 32 * (2 * w + x));
#pragma unroll
            for (int y = 0; y < 4; ++y) bz[y] = tr_frag(za + 32 * y, za + 4 * V_STR + 32 * y);
            __builtin_amdgcn_sched_barrier(0);
#pragma unroll
            for (int x = 0; x < 2; ++x)
#pragma unroll
                for (int y = 0; y < 4; ++y) Racc[x][y] = MFMA16(ak[x], bz[y], Racc[x][y]);
        }
#pragma unroll
        for (int x = 0; x < 2; ++x)
#pragma unroll
            for (int y = 0; y < 4; ++y) { u32x2 rw; rw.x = pk2(Racc[x][y][0], Racc[x][y][1]); rw.y = pk2(Racc[x][y][2], Racc[x][y][3]);
                *(LAS u32x2*)(lds + RS_RS + (16 * y + fr) * QK_STR + (16 * (2 * w + x) + 4 * fq) * 2) = rw; }
    }
}

template <int CTRL> __device__ __forceinline__ float dpp_f(float x) { return __builtin_bit_cast(float, __builtin_amdgcn_mov_dpp(__builtin_bit_cast(int, x), CTRL, 0xF, 0xF, true)); }
__device__ __forceinline__ float sum8(float x) { x += dpp_f<0xB1>(x); x += dpp_f<0x4E>(x); x += dpp_f<0x141>(x); return x; }
__device__ __forceinline__ void ret_gate_phase(const Ctx& c, const bf16* Og, bf16* Gg, const float* gn, bf16* Zout = nullptr) {
    const int col0 = 512 * (c.lane >> 3) + 8 * (c.lane & 7);
    f32x4 gw[16];
#pragma unroll
    for (int j = 0; j < 8; ++j) { gw[2 * j] = *(const f32x4*)(gn + col0 + 64 * j); gw[2 * j + 1] = *(const f32x4*)(gn + col0 + 64 * j + 4); }
    u32x4 ovn[8];
    if (c.gw < NTOK) { const bf16* orow = Og + (size_t)c.gw * RVW + col0;
#pragma unroll
        for (int j = 0; j < 8; ++j) ovn[j] = *(const u32x4*)(orow + 64 * j); }
    for (int m = c.gw; m < NTOK; m += c.ngw) {
        u32x4 gv[8], ov[8];
        { const bf16* grow = Gg + (size_t)m * RVW + col0;
#pragma unroll
          for (int j = 0; j < 8; ++j) { gv[j] = *(const u32x4*)(grow + 64 * j); ov[j] = ovn[j]; } }
        { const int mn = m + c.ngw < NTOK ? m + c.ngw : m; const bf16* orow = Og + (size_t)mn * RVW + col0;
#pragma unroll
          for (int j = 0; j < 8; ++j) ovn[j] = *(const u32x4*)(orow + 64 * j); }
        float s1 = 0.f;
#pragma unroll
        for (int j = 0; j < 8; ++j) { const u32x4 t = ov[j];
            s1 += ((bflo(t.x) + bfhi(t.x)) + (bflo(t.y) + bfhi(t.y))) + ((bflo(t.z) + bfhi(t.z)) + (bflo(t.w) + bfhi(t.w))); }
        const float mu = sum8(s1) * (1.0f / RV);
        asm volatile("" : "+v"(ov[0]), "+v"(ov[1]), "+v"(ov[2]), "+v"(ov[3]), "+v"(ov[4]), "+v"(ov[5]), "+v"(ov[6]), "+v"(ov[7]));
        float s2 = 0.f;
#pragma unroll
        for (int j = 0; j < 8; ++j) { const u32x4 t = ov[j];
            const float d[8] = {bflo(t.x) - mu, bfhi(t.x) - mu, bflo(t.y) - mu, bfhi(t.y) - mu, bflo(t.z) - mu, bfhi(t.z) - mu, bflo(t.w) - mu, bfhi(t.w) - mu};
            float q = 0.f;
#pragma unroll
            for (int k = 0; k < 8; ++k) q += d[k] * d[k];
            s2 += q; }
        const float rstd = 1.0f / sqrtf(sum8(s2) * (1.0f / RV) + EPS);
        asm volatile("" : "+v"(ov[0]), "+v"(ov[1]), "+v"(ov[2]), "+v"(ov[3]), "+v"(ov[4]), "+v"(ov[5]), "+v"(ov[6]), "+v"(ov[7]));
        bf16* zrow = (Zout ? Zout : Gg) + (size_t)m * RVW + col0;
#pragma unroll
        for (int j = 0; j < 8; ++j) {
            const float gg[8] = {gw[2 * j][0], gw[2 * j][1], gw[2 * j][2], gw[2 * j][3], gw[2 * j + 1][0], gw[2 * j + 1][1], gw[2 * j + 1][2], gw[2 * j + 1][3]};
            const u32x4 t = gv[j], u = ov[j];
            const float g[8] = {bflo(t.x), bfhi(t.x), bflo(t.y), bfhi(t.y), bflo(t.z), bfhi(t.z), bflo(t.w), bfhi(t.w)};
            const float o[8] = {bflo(u.x), bfhi(u.x), bflo(u.y), bfhi(u.y), bflo(u.z), bfhi(u.z), bflo(u.w), bfhi(u.w)};
            float z[8];
#pragma unroll
            for (int k = 0; k < 8; ++k) { const float y = (o[k] - mu) * rstd * gg[k]; z[k] = g[k] * __builtin_amdgcn_rcpf(1.0f + __builtin_amdgcn_exp2f(-1.4426950408889634f * g[k])) * y; }
            u32x4 zw; zw.x = pk2(z[0], z[1]); zw.y = pk2(z[2], z[3]); zw.z = pk2(z[4], z[5]); zw.w = pk2(z[6], z[7]);
            *(u32x4*)(zrow + 64 * j) = zw;
        }
    }
}

__device__ __forceinline__ void rms_phase(const Ctx& c, const float* X, const float* g, bf16* H) {
    for (int m = c.gw; m < NTOK; m += c.ngw) { f32x4 v[8]; load_row(X + (size_t)m * DM, c.lane, v); store_norm_bf16(v, row_rstd(v), g, H + (size_t)m * DM, c.lane); }
}

__device__ __forceinline__ int fkey(float f) { const int i = __builtin_bit_cast(int, f); return i ^ ((i >> 31) & 0x7fffffff); }
__device__ __forceinline__ float kval(int k) { return __builtin_bit_cast(float, k ^ ((k >> 31) & 0x7fffffff)); }
__device__ __forceinline__ int med3i(int a, int b, int c) { int r; asm("v_med3_i32 %0, %1, %2, %3" : "=v"(r) : "v"(a), "v"(b), "v"(c)); return r; }
#define INS16(L, key) do { const int _k = (key); _Pragma("unroll") for (int _q = 15; _q >= 1; --_q) L[_q] = med3i(L[_q - 1], L[_q], _k); L[0] = max(L[0], _k); } while (0)
constexpr int TK_LIST = 544, TK_HALF = 272, TK_KEYS = 256 * TK_LIST;
__device__ __forceinline__ void peer_topk_phase(const Ctx& c, const float* SC, int* IDX, float* WGT, const float* SQP, float* RSTD) {
    LAS unsigned char* lds = c.lds;
    u32x4 pre[16];
    if (c.bx < NTOK / 16) { const u32x4* src = (const u32x4*)(SC + (size_t)c.bx * 16 * DM);
#pragma unroll
        for (int i = 0; i < 16; ++i) pre[i] = src[c.tid + 512 * i]; }
    for (int tile = c.bx; tile < NTOK / 16; tile += c.G) {
        __syncthreads();
#pragma unroll
        for (int i = 0; i < 16; ++i) { const int g = c.tid + 512 * i; *(LAS u32x4*)(lds + (g >> 5) * TK_LIST + ((g >> 4) & 1) * TK_HALF + (g & 15) * 16) = pre[i]; }
        if (tile + c.G < NTOK / 16) { const u32x4* src = (const u32x4*)(SC + (size_t)(tile + c.G) * 16 * DM);
#pragma unroll
            for (int i = 0; i < 16; ++i) pre[i] = src[c.tid + 512 * i]; }
        __syncthreads();
        {
            const int lst = c.tid >> 1, hf = c.tid & 1;
            int L[16];
#pragma unroll
            for (int q = 0; q < 16; ++q) L[q] = (int)0x80000000;
            LAS unsigned char* lp = lds + lst * TK_LIST + hf * TK_HALF;
#pragma unroll 2
            for (int g = 0; g < 16; ++g) { const f32x4 v = *(LAS const f32x4*)(lp + g * 16);
#pragma unroll
                for (int e = 0; e < 4; ++e) INS16(L, (fkey(v[e]) & ~127) | (hf * 64 + g * 4 + e)); }
            if (hf) {
#pragma unroll
                for (int q = 0; q < 16; ++q) ((LAS int*)lp)[q] = L[q]; }
            __syncthreads();
            if (!hf) { LAS const int* op = (LAS const int*)(lp + TK_HALF);
#pragma unroll
                for (int q = 0; q < 16; ++q) INS16(L, op[q]);
                LAS int* kp = (LAS int*)(lds + TK_KEYS) + lst * 16;
#pragma unroll
                for (int q = 0; q < 16; ++q) kp[q] = L[q]; }
        }
        __syncthreads();
        if (c.tid < 128) {
            LAS const int* k1 = (LAS const int*)(lds + TK_KEYS) + (c.tid * 2) * 16; LAS const int* k2 = k1 + 16;
            float v1[16], v2[16];
#pragma unroll
            for (int q = 0; q < 16; ++q) { v1[q] = kval(k1[q] & ~127); v2[q] = kval(k2[q] & ~127); }
            int L[16];
#pragma unroll
            for (int q = 0; q < 16; ++q) L[q] = (fkey(v1[0] + v2[q]) & ~255) | q;
#pragma unroll
            for (int i = 1; i < 16; ++i)
#pragma unroll
                for (int j = 0; j < 16; ++j) if ((i + 1) * (j + 1) <= 16) INS16(L, (fkey(v1[i] + v2[j]) & ~255) | (i * 16 + j));
            const int tt = c.tid >> 3, hh = c.tid & 7; const size_t ob0 = ((size_t)tile * 16 + tt) * 128;
            float rstd; { const f32x4* sp = (const f32x4*)(SQP + ((size_t)tile * 16 + tt) * 32); f32x4 a4 = sp[0];
#pragma unroll
              for (int q = 1; q < 8; ++q) a4 += sp[q];
              rstd = 1.0f / sqrtf(((a4[0] + a4[1]) + (a4[2] + a4[3])) * (1.0f / DM) + EPS); }
            if (hh == 0) RSTD[(size_t)tile * 16 + tt] = rstd;
            const float m0 = kval(L[0] & ~255); float ex[16], se = 0.f;
#pragma unroll
            for (int q = 0; q < 16; ++q) { ex[q] = __builtin_amdgcn_exp2f((kval(L[q] & ~255) - m0) * (rstd * 1.4426950408889634f)); se += ex[q]; }
            const float inv = 1.0f / se;
#pragma unroll
            for (int q = 0; q < 16; ++q) { const int cid = L[q] & 255; const int es = hh * 16 + q, pos = (es & 7) * 16 + (es >> 3);
                IDX[ob0 + pos] = (k1[cid >> 4] & 127) * PNK + (k2[cid & 15] & 127); WGT[ob0 + pos] = ex[q] * inv; }
        }
    }
}

template <int NSTAGE> __device__ __forceinline__ void xreduce_stage(float (&p)[64], int lane) {
    constexpr int S = NSTAGE;
    if constexpr (S == 32) {
#pragma unroll
        for (int k = 0; k < S; ++k) { float xa = p[k], xb = p[k + S]; asm("s_nop 1\n\tv_permlane32_swap_b32 %0, %1" : "+v"(xa), "+v"(xb)); p[k] = xa + xb; }
    } else if constexpr (S == 16) {
#pragma unroll
        for (int k = 0; k < S; ++k) { float xa = p[k], xb = p[k + S]; asm("s_nop 1\n\tv_permlane16_swap_b32 %0, %1" : "+v"(xa), "+v"(xb)); p[k] = xa + xb; }
    } else {
        const bool up = (lane & S) != 0;
#pragma unroll
        for (int k = 0; k < S; ++k) { const float keep = up ? p[k + S] : p[k], send = up ? p[k] : p[k + S];
            p[k] = keep + __builtin_bit_cast(float, __builtin_amdgcn_ds_swizzle(__builtin_bit_cast(int, send), (S << 10) | 0x1F)); }
    }
}
__device__ __forceinline__ float gelu_erf(float v) { return 0.5f * v * (1.0f + erff(v * 0.70710678118654752f)); }
typedef float f32x2 __attribute__((ext_vector_type(2)));
__device__ __forceinline__ float peer_dots64(const unsigned char* U, int idxv, const f32x2 (&h2)[16], int lane) {
    float p[64];
#pragma unroll
    for (int e = 0; e < 64; ++e) {
        const int row = __builtin_amdgcn_readlane(idxv, e);
        const u32x4* up = (const u32x4*)(U + (size_t)row * DM) + lane;
        f32x2 a = {0.f, 0.f};
#pragma unroll
        for (int cc = 0; cc < 2; ++cc) { const u32x4 u = up[64 * cc];
#pragma unroll
            for (int q = 0; q < 4; ++q) { const int w = (int)u[q];
                a = __builtin_elementwise_fma(__builtin_amdgcn_cvt_pk_f32_fp8(w, false), h2[8 * cc + 2 * q], a);
                a = __builtin_elementwise_fma(__builtin_amdgcn_cvt_pk_f32_fp8(w, true), h2[8 * cc + 2 * q + 1], a); } }
        p[e] = a.x + a.y;
    }
    xreduce_stage<32>(p, lane); xreduce_stage<16>(p, lane); xreduce_stage<8>(p, lane); xreduce_stage<4>(p, lane); xreduce_stage<2>(p, lane); xreduce_stage<1>(p, lane);
    return p[0];
}
__device__ __forceinline__ void peer_accum64(const unsigned char* Vt, int idxv, float av, f32x2 (&acc)[16], int lane) {
#pragma unroll 8
    for (int e = 0; e < 64; ++e) {
        const int row = __builtin_amdgcn_readlane(idxv, e); const float a = __builtin_bit_cast(float, __builtin_amdgcn_readlane(__builtin_bit_cast(int, av), e));
        const f32x2 a2 = {a, a};
        const u32x4* vp = (const u32x4*)(Vt + (size_t)row * DM) + lane;
#pragma unroll
        for (int cc = 0; cc < 2; ++cc) { const u32x4 v = vp[64 * cc];
#pragma unroll
            for (int q = 0; q < 4; ++q) { const int w = (int)v[q];
                acc[8 * cc + 2 * q] = __builtin_elementwise_fma(__builtin_amdgcn_cvt_pk_f32_fp8(w, false), a2, acc[8 * cc + 2 * q]);
                acc[8 * cc + 2 * q + 1] = __builtin_elementwise_fma(__builtin_amdgcn_cvt_pk_f32_fp8(w, true), a2, acc[8 * cc + 2 * q + 1]); } }
    }
}
constexpr int GD = 8;
#define PG_ISSUE(vv) do { const int row_ = __builtin_amdgcn_readlane((((vv) >> 6) & 1) ? i1 : i0, (vv) & 63); \
        const u32x4* bp_ = (const u32x4*)((((vv) >> 6) < 2 ? U : Vt) + (size_t)row_ * DM) + lane; ring[(vv) % GD][0] = bp_[0]; ring[(vv) % GD][1] = bp_[64]; } while (0)
template <int SEG> __device__ __forceinline__ void peer_seg(const unsigned char* U, const unsigned char* Vt, int i0, int i1, u32x4 (&ring)[GD][2], float (&p)[64], float aseg, const f32x2 (&h2)[16], f32x2 (&acc)[16], int lane) {
#pragma unroll
    for (int e = 0; e < 64; ++e) {
        const int v = SEG * 64 + e;
        const u32x4 r0 = ring[v % GD][0], r1 = ring[v % GD][1];
        if (SEG < 2) {
            f32x2 a = {0.f, 0.f};
#pragma unroll
            for (int q = 0; q < 4; ++q) { const int wa = (int)r0[q], wb = (int)r1[q];
                a = __builtin_elementwise_fma(__builtin_amdgcn_cvt_pk_f32_fp8(wa, false), h2[2 * q], a); a = __builtin_elementwise_fma(__builtin_amdgcn_cvt_pk_f32_fp8(wa, true), h2[2 * q + 1], a);
                a = __builtin_elementwise_fma(__builtin_amdgcn_cvt_pk_f32_fp8(wb, false), h2[8 + 2 * q], a); a = __builtin_elementwise_fma(__builtin_amdgcn_cvt_pk_f32_fp8(wb, true), h2[8 + 2 * q + 1], a); }
            { float hs_; asm("v_add_f32 %0, %1, %2" : "=v"(hs_) : "v"(a.x), "v"(a.y)); p[e] = hs_; }
        } else {
            const float av = __builtin_bit_cast(float, __builtin_amdgcn_readlane(__builtin_bit_cast(int, aseg), e)); const f32x2 a2 = {av, av};
#pragma unroll
            for (int q = 0; q < 4; ++q) { const int wa = (int)r0[q], wb = (int)r1[q];
                acc[2 * q] = __builtin_elementwise_fma(__builtin_amdgcn_cvt_pk_f32_fp8(wa, false), a2, acc[2 * q]); acc[2 * q + 1] = __builtin_elementwise_fma(__builtin_amdgcn_cvt_pk_f32_fp8(wa, true), a2, acc[2 * q + 1]);
                acc[8 + 2 * q] = __builtin_elementwise_fma(__builtin_amdgcn_cvt_pk_f32_fp8(wb, false), a2, acc[8 + 2 * q]); acc[8 + 2 * q + 1] = __builtin_elementwise_fma(__builtin_amdgcn_cvt_pk_f32_fp8(wb, true), a2, acc[8 + 2 * q + 1]); }
            asm volatile("" : "+v"(acc[0]), "+v"(acc[1]), "+v"(acc[2]), "+v"(acc[3]), "+v"(acc[4]), "+v"(acc[5]), "+v"(acc[6]), "+v"(acc[7]), "+v"(acc[8]), "+v"(acc[9]), "+v"(acc[10]), "+v"(acc[11]), "+v"(acc[12]), "+v"(acc[13]), "+v"(acc[14]), "+v"(acc[15]));
        }
        if (v + GD < 256) PG_ISSUE(v + GD);
        __builtin_amdgcn_sched_barrier(0);
    }
}
__device__ __forceinline__ void peer_token_pipe(const unsigned char* U, const unsigned char* Vt, int i0, int i1, float su0, float su1, float w0, float w1, const f32x2 (&h2)[16], f32x2 (&acc)[16], int lane) {
    u32x4 ring[GD][2];
    float p[64];
#pragma unroll
    for (int v = 0; v < GD; ++v) PG_ISSUE(v);
    peer_seg<0>(U, Vt, i0, i1, ring, p, 0.f, h2, acc, lane);
    xreduce_stage<32>(p, lane); xreduce_stage<16>(p, lane); xreduce_stage<8>(p, lane); xreduce_stage<4>(p, lane); xreduce_stage<2>(p, lane); xreduce_stage<1>(p, lane);
    const float a0 = gelu_erf(p[0] * su0) * w0;
    __builtin_amdgcn_sched_barrier(0);
    peer_seg<1>(U, Vt, i0, i1, ring, p, 0.f, h2, acc, lane);
    xreduce_stage<32>(p, lane); xreduce_stage<16>(p, lane); xreduce_stage<8>(p, lane); xreduce_stage<4>(p, lane); xreduce_stage<2>(p, lane); xreduce_stage<1>(p, lane);
    const float a1 = gelu_erf(p[0] * su1) * w1;
    __builtin_amdgcn_sched_barrier(0);
    peer_seg<2>(U, Vt, i0, i1, ring, p, a0, h2, acc, lane);
    peer_seg<3>(U, Vt, i0, i1, ring, p, a1, h2, acc, lane);
}
#undef PG_ISSUE
__device__ __forceinline__ void peer_gather_phase(const Ctx& c, const bf16* Hn, const unsigned char* U, const unsigned char* Vt, const float* rsU, const float* rsV, const int* IDX, const float* WGT, const float* Xr, float* X, int mode,
                                                  const float* g1, const float* g2, bf16* Hout, bf16* HKVout) {
    for (int m = c.gw; m < NTOK; m += c.ngw) {
        int lane_ = c.lane; asm volatile("" : "+v"(lane_));
#ifdef DRYIDXMASK
        const int imask_ = (X != Xr) ? DRYIDXMASK : 0xffff;
        const int i0 = IDX[(size_t)m * 128 + lane_] & imask_, i1 = IDX[(size_t)m * 128 + 64 + lane_] & imask_;
#else
        const int i0 = IDX[(size_t)m * 128 + lane_], i1 = IDX[(size_t)m * 128 + 64 + lane_];
#endif
        const float w0 = WGT[(size_t)m * 128 + lane_] * rsV[i0], w1 = WGT[(size_t)m * 128 + 64 + lane_] * rsV[i1];
        const float su0 = rsU[i0], su1 = rsU[i1];
        f32x2 h2[16];
#pragma unroll
        for (int cc = 0; cc < 2; ++cc) { const u32x4* hp = (const u32x4*)(Hn + (size_t)m * DM + 1024 * cc + 16 * lane_); const u32x4 ha = hp[0], hb = hp[1];
#pragma unroll
            for (int q = 0; q < 4; ++q) { h2[8 * cc + q] = (f32x2){bflo(ha[q]), bfhi(ha[q])}; h2[8 * cc + 4 + q] = (f32x2){bflo(hb[q]), bfhi(hb[q])}; } }
        f32x2 acc[16];
#pragma unroll
        for (int k = 0; k < 16; ++k) acc[k] = (f32x2){0.f, 0.f};
        peer_token_pipe(U, Vt, i0, i1, su0, su1, w0, w1, h2, acc, lane_);
        float* xr = X + (size_t)m * DM; const float* xrr = Xr + (size_t)m * DM; float ss = 0.f;
#pragma unroll
        for (int cc = 0; cc < 2; ++cc) {
            f32x4* xp = (f32x4*)(xr + 1024 * cc + 16 * lane_); const f32x4* xq = (const f32x4*)(xrr + 1024 * cc + 16 * lane_);
#pragma unroll
            for (int q = 0; q < 4; ++q) { f32x4 xa = xq[q]; xa[0] += acc[8 * cc + 2 * q].x; xa[1] += acc[8 * cc + 2 * q].y; xa[2] += acc[8 * cc + 2 * q + 1].x; xa[3] += acc[8 * cc + 2 * q + 1].y;
                acc[8 * cc + 2 * q] = (f32x2){xa[0], xa[1]}; acc[8 * cc + 2 * q + 1] = (f32x2){xa[2], xa[3]}; ss += (xa[0] * xa[0] + xa[1] * xa[1]) + (xa[2] * xa[2] + xa[3] * xa[3]);
                if (mode != 2) xp[q] = xa; }
        }
        const float rstd = 1.0f / sqrtf(wave_sum(ss) * (1.0f / DM) + EPS);
#pragma unroll
        for (int cc = 0; cc < 2; ++cc) {
            const f32x4* gp = (const f32x4*)(g1 + 1024 * cc + 16 * lane_);
            if (mode == 2) {
                f32x4* xp = (f32x4*)(xr + 1024 * cc + 16 * lane_);
#pragma unroll
                for (int q = 0; q < 4; ++q) { const f32x4 gv = gp[q]; f32x4 y; y[0] = acc[8 * cc + 2 * q].x * rstd * gv[0]; y[1] = acc[8 * cc + 2 * q].y * rstd * gv[1]; y[2] = acc[8 * cc + 2 * q + 1].x * rstd * gv[2]; y[3] = acc[8 * cc + 2 * q + 1].y * rstd * gv[3]; xp[q] = y; }
            } else {
                u32x4 hw[2];
#pragma unroll
                for (int q = 0; q < 4; ++q) { const f32x4 gv = gp[q]; hw[q >> 1][2 * (q & 1)] = pk2(acc[8 * cc + 2 * q].x * rstd * gv[0], acc[8 * cc + 2 * q].y * rstd * gv[1]); hw[q >> 1][2 * (q & 1) + 1] = pk2(acc[8 * cc + 2 * q + 1].x * rstd * gv[2], acc[8 * cc + 2 * q + 1].y * rstd * gv[3]); }
                u32x4* ho = (u32x4*)(Hout + (size_t)m * DM + 1024 * cc + 16 * lane_); ho[0] = hw[0]; ho[1] = hw[1];
                if (mode == 1) {
                    const f32x4* kp = (const f32x4*)(g2 + 1024 * cc + 16 * lane_); u32x4 kw[2];
#pragma unroll
                    for (int q = 0; q < 4; ++q) { const f32x4 gv = kp[q]; kw[q >> 1][2 * (q & 1)] = pk2(acc[8 * cc + 2 * q].x * rstd * gv[0], acc[8 * cc + 2 * q].y * rstd * gv[1]); kw[q >> 1][2 * (q & 1) + 1] = pk2(acc[8 * cc + 2 * q + 1].x * rstd * gv[2], acc[8 * cc + 2 * q + 1].y * rstd * gv[3]); }
                    u32x4* ko = (u32x4*)(HKVout + (size_t)m * DM + 1024 * cc + 16 * lane_); ko[0] = kw[0]; ko[1] = kw[1];
                }
            }
        }
    }
}

template <int PAT> __device__ __forceinline__ float swz_xor(float v) { return __builtin_bit_cast(float, __builtin_amdgcn_ds_swizzle(__builtin_bit_cast(int, v), PAT)); }
template <int PAT> __device__ __forceinline__ int swz_xor_i(int v) { return __builtin_amdgcn_ds_swizzle(v, PAT); }
template <int C> __device__ __forceinline__ unsigned bc8(unsigned v) { return (unsigned)__builtin_amdgcn_ds_swizzle((int)v, (C << 5) | 0x18); }
__device__ __forceinline__ void bcast16(unsigned x0, unsigned x1, unsigned (&o)[16]) {
    o[0] = bc8<0>(x0); o[1] = bc8<0>(x1); o[2] = bc8<1>(x0); o[3] = bc8<1>(x1); o[4] = bc8<2>(x0); o[5] = bc8<2>(x1); o[6] = bc8<3>(x0); o[7] = bc8<3>(x1);
    o[8] = bc8<4>(x0); o[9] = bc8<4>(x1); o[10] = bc8<5>(x0); o[11] = bc8<5>(x1); o[12] = bc8<6>(x0); o[13] = bc8<6>(x1); o[14] = bc8<7>(x0); o[15] = bc8<7>(x1);
}
__device__ __forceinline__ void peer_u_phase(const Ctx& c, const bf16* Hn, const unsigned char* U, const int* IDXT, float* PD, unsigned imask = 0xffffffffu) {
    const int xg = c.bx & 7, wr = (c.bx >> 3) * 8 + c.wave, g = c.lane >> 3, sub = c.lane & 7;
    for (int pass = 0; pass < 2; ++pass) {
        const int s = xg + 8 * pass, col0 = 128 * s + 16 * sub;
        const unsigned char* Us = U + (size_t)s * PE * 128 + 16 * sub;
        u32x4 wv[8];
        { const u32x4* wp = (const u32x4*)(U + (size_t)s * PE * 128 + (size_t)(c.bx >> 3) * 65536) + c.tid;
#pragma unroll
          for (int q = 0; q < 8; ++q) wv[q] = wp[q * 512]; }
        u32x2 ii; unsigned hw;
        { ii = *(const u32x2*)(IDXT + (size_t)wr * 128 + g * 16 + 2 * sub);
          hw = *((const unsigned*)(Hn + (size_t)wr * DM + 128 * s) + c.lane); }
        for (int k = 0; k < NTOK / 256; ++k) {
            const int t = wr + 256 * k;
            u32x4 r[16]; unsigned rj[16];
            bcast16(ii.x, ii.y, rj);
#pragma unroll
            for (int j = 0; j < 16; ++j) r[j] = *(const u32x4*)(Us + (size_t)(rj[j] & imask) * 128);
            float hf[16];
#pragma unroll
            for (int q = 0; q < 8; ++q) { const unsigned hd = (unsigned)__builtin_amdgcn_ds_bpermute(32 * sub + 4 * q, (int)hw); hf[2 * q] = bflo(hd); hf[2 * q + 1] = bfhi(hd); }
            if (k + 1 < NTOK / 256) { ii = *(const u32x2*)(IDXT + (size_t)(t + 256) * 128 + g * 16 + 2 * sub);
                hw = *((const unsigned*)(Hn + (size_t)(t + 256) * DM + 128 * s) + c.lane); }
            float am = 0.f;
#pragma unroll
            for (int q = 0; q < 16; ++q) am = fmaxf(am, fabsf(hf[q]));
            am = fmaxf(am, dpp_f<0xB1>(am)); am = fmaxf(am, dpp_f<0x4E>(am)); am = fmaxf(am, dpp_f<0x141>(am));
            const float hsc = am > 0.f ? 127.0f / am : 0.f, hinv = am * (1.0f / 127.0f);
            unsigned hq[4];
#pragma unroll
            for (int q = 0; q < 4; ++q) hq[q] = q8pack(hf[4 * q] * hsc, hf[4 * q + 1] * hsc, hf[4 * q + 2] * hsc, hf[4 * q + 3] * hsc);
            int p[16];
#pragma unroll
            for (int j = 0; j < 16; ++j) { int a = __builtin_amdgcn_sdot4((int)r[j].x, (int)hq[0], 0, false); a = __builtin_amdgcn_sdot4((int)r[j].y, (int)hq[1], a, false);
                a = __builtin_amdgcn_sdot4((int)r[j].z, (int)hq[2], a, false); p[j] = __builtin_amdgcn_sdot4((int)r[j].w, (int)hq[3], a, false); }
            { const bool up = (sub & 4) != 0;
#pragma unroll
              for (int q = 0; q < 8; ++q) { const int keep = up ? p[q + 8] : p[q], send = up ? p[q] : p[q + 8]; p[q] = keep + swz_xor_i<(4 << 10) | 0x1F>(send); } }
            { const bool up = (sub & 2) != 0;
#pragma unroll
              for (int q = 0; q < 4; ++q) { const int keep = up ? p[q + 4] : p[q], send = up ? p[q] : p[q + 4]; p[q] = keep + swz_xor_i<(2 << 10) | 0x1F>(send); } }
            { const bool up = (sub & 1) != 0;
#pragma unroll
              for (int q = 0; q < 2; ++q) { const int keep = up ? p[q + 2] : p[q], send = up ? p[q] : p[q + 2]; p[q] = keep + swz_xor_i<(1 << 10) | 0x1F>(send); } }
            f32x2 o = {(float)p[0] * hinv, (float)p[1] * hinv};
            *(f32x2*)(PD + ((size_t)t * 16 + s) * 128 + g * 16 + 2 * sub) = o;
            if (k == 0) asm volatile("" :: "v"(wv[0]), "v"(wv[1]), "v"(wv[2]), "v"(wv[3]), "v"(wv[4]), "v"(wv[5]), "v"(wv[6]), "v"(wv[7]));
        }
    }
}
__device__ __forceinline__ void peer_a_phase(const Ctx& c, const float* PD, const int* IDXT, float* WA, const float* rsU, const float* rsV, const float* RSTD) {
    const int i0 = c.bx * 512 + c.tid, step = c.G * 512;
    f32x4 vn[16];
    if (i0 < NTOK * 32) { const f32x4* pp = (const f32x4*)(PD + (size_t)(i0 >> 5) * 2048) + (i0 & 31);
#pragma unroll
        for (int s = 0; s < 16; ++s) vn[s] = pp[s * 32]; }
    for (int i4 = i0; i4 < NTOK * 32; i4 += step) {
        const int t = i4 >> 5;
        f32x4 v[16];
#pragma unroll
        for (int s = 0; s < 16; ++s) v[s] = vn[s];
        const u32x4 e = *((const u32x4*)IDXT + i4); const f32x4 w = *((const f32x4*)WA + i4); const float rs = RSTD[t];
        { const int i5 = i4 + step < NTOK * 32 ? i4 + step : i4; const f32x4* pp = (const f32x4*)(PD + (size_t)(i5 >> 5) * 2048) + (i5 & 31);
#pragma unroll
          for (int s = 0; s < 16; ++s) vn[s] = pp[s * 32]; }
        float ru[4], rv[4];
#pragma unroll
        for (int q = 0; q < 4; ++q) { const unsigned eq = e[q]; ru[q] = rsU[eq]; rv[q] = rsV[eq]; }
        f32x4 sm = v[0];
#pragma unroll
        for (int s = 1; s < 16; ++s) sm += v[s];
        asm volatile("" :: "v"(ru[0]), "v"(ru[1]), "v"(ru[2]), "v"(ru[3]), "v"(rv[0]), "v"(rv[1]), "v"(rv[2]), "v"(rv[3]));
        f32x4 o;
#pragma unroll
        for (int q = 0; q < 4; ++q) o[q] = gelu_erf(sm[q] * ru[q] * rs) * w[q] * rv[q];
        *((f32x4*)WA + i4) = o;
    }
}
__device__ __forceinline__ void peer_v_phase(const Ctx& c, const unsigned char* Vt, const int* IDXT, const float* WA, float* X) {
    const int xg = c.bx & 7, wr = (c.bx >> 3) * 8 + c.wave, g = c.lane >> 3, sub = c.lane & 7;
    for (int pass = 0; pass < 2; ++pass) {
        const int s = xg + 8 * pass, col0 = 128 * s + 16 * sub;
        const unsigned char* Vs = Vt + (size_t)s * PE * 128 + 16 * sub;
        u32x4 wv[8];
        { const u32x4* wp = (const u32x4*)(Vt + (size_t)s * PE * 128 + (size_t)(c.bx >> 3) * 65536) + c.tid;
#pragma unroll
          for (int q = 0; q < 8; ++q) wv[q] = wp[q * 512]; }
        u32x2 ii, aa;
        { ii = *(const u32x2*)(IDXT + (size_t)wr * 128 + g * 16 + 2 * sub); aa = *(const u32x2*)(WA + (size_t)wr * 128 + g * 16 + 2 * sub); }
        for (int k = 0; k < NTOK / 256; ++k) {
            const int t = wr + 256 * k;
            u32x4 r[16]; float av[16]; unsigned rj[16], aj[16];
            bcast16(ii.x, ii.y, rj);
#pragma unroll
            for (int j = 0; j < 16; ++j) r[j] = *(const u32x4*)(Vs + (size_t)rj[j] * 128);
            bcast16(aa.x, aa.y, aj);
#pragma unroll
            for (int j = 0; j < 16; ++j) av[j] = __builtin_bit_cast(float, aj[j]);
            f32x2* xp = (f32x2*)(X + (size_t)t * DM + col0 + 2 * g);
            const f32x2 xold = *xp;
            if (k + 1 < NTOK / 256) { ii = *(const u32x2*)(IDXT + (size_t)(t + 256) * 128 + g * 16 + 2 * sub); aa = *(const u32x2*)(WA + (size_t)(t + 256) * 128 + g * 16 + 2 * sub); }
            f32x2 acc[8];
#pragma unroll
            for (int q = 0; q < 8; ++q) acc[q] = (f32x2){0.f, 0.f};
#pragma unroll
            for (int j = 0; j < 16; ++j) { float aj_ = av[j]; asm("" : "+v"(aj_));
                const f32x2 a2 = {aj_, aj_};
#pragma unroll
                for (int q = 0; q < 4; ++q) { const int w = (int)r[j][q]; acc[2 * q] = __builtin_elementwise_fma(__builtin_amdgcn_cvt_pk_f32_fp8(w, false), a2, acc[2 * q]); acc[2 * q + 1] = __builtin_elementwise_fma(__builtin_amdgcn_cvt_pk_f32_fp8(w, true), a2, acc[2 * q + 1]); } }
            float af[16];
#pragma unroll
            for (int q = 0; q < 8; ++q) { af[2 * q] = acc[q].x; af[2 * q + 1] = acc[q].y; }
#ifdef VDBG
#pragma unroll
            for (int q = 0; q < 16; ++q) { af[q] += __shfl_xor(af[q], 8); af[q] += __shfl_xor(af[q], 16); af[q] += __shfl_xor(af[q], 32); }
            { float s0 = af[0], s1 = af[1];
#pragma unroll
              for (int gg = 1; gg < 8; ++gg) { s0 = (g == gg) ? af[2 * gg] : s0; s1 = (g == gg) ? af[2 * gg + 1] : s1; }
              af[0] = s0; af[1] = s1; }
#else
#pragma unroll
            for (int q = 0; q < 8; ++q) { float xa = af[q], xb = af[q + 8]; asm("s_nop 1\n\tv_permlane32_swap_b32 %0, %1" : "+v"(xa), "+v"(xb)); af[q] = xa + xb; }
#pragma unroll
            for (int q = 0; q < 4; ++q) { float xa = af[q], xb = af[q + 4]; asm("s_nop 1\n\tv_permlane16_swap_b32 %0, %1" : "+v"(xa), "+v"(xb)); af[q] = xa + xb; }
            { const bool up = (c.lane & 8) != 0;
#pragma unroll
              for (int q = 0; q < 2; ++q) { const float keep = up ? af[q + 2] : af[q], send = up ? af[q] : af[q + 2]; af[q] = keep + swz_xor<(8 << 10) | 0x1F>(send); } }
#endif
            const f32x2 xn = {xold.x + af[0], xold.y + af[1]};
            *xp = xn;
            if (k == 0) asm volatile("" :: "v"(wv[0]), "v"(wv[1]), "v"(wv[2]), "v"(wv[3]), "v"(wv[4]), "v"(wv[5]), "v"(wv[6]), "v"(wv[7]));
        }
    }
}
#ifdef VREF
__device__ __forceinline__ void peer_v_ref_phase(const Ctx& c, const unsigned char* Vt, const int* IDXT, const float* WA, float* X) {
    for (int m = c.gw; m < NTOK; m += c.ngw) {
        const int i0 = IDXT[(size_t)m * 128 + c.lane], i1 = IDXT[(size_t)m * 128 + 64 + c.lane];
        const float a0 = WA[(size_t)m * 128 + c.lane], a1 = WA[(size_t)m * 128 + 64 + c.lane];
        f32x2 acc[16];
#pragma unroll
        for (int k = 0; k < 16; ++k) acc[k] = (f32x2){0.f, 0.f};
        for (int e = 0; e < 128; ++e) {
            const int row = __shfl(e < 64 ? i0 : i1, e & 63); const float a = __shfl(e < 64 ? a0 : a1, e & 63); const f32x2 a2 = {a, a};
            const u32x4* vp = (const u32x4*)(Vt + (size_t)row * DM) + c.lane;
#pragma unroll
            for (int cc = 0; cc < 2; ++cc) { const u32x4 v = vp[64 * cc];
#pragma unroll
                for (int q = 0; q < 4; ++q) { const int w = (int)v[q];
                    acc[8 * cc + 2 * q] = __builtin_elementwise_fma(__builtin_amdgcn_cvt_pk_f32_fp8(w, false), a2, acc[8 * cc + 2 * q]);
                    acc[8 * cc + 2 * q + 1] = __builtin_elementwise_fma(__builtin_amdgcn_cvt_pk_f32_fp8(w, true), a2, acc[8 * cc + 2 * q + 1]); } }
        }
        float* xr = X + (size_t)m * DM;
#pragma unroll
        for (int cc = 0; cc < 2; ++cc) { f32x4* xp = (f32x4*)(xr + 1024 * cc + 16 * c.lane);
#pragma unroll
            for (int q = 0; q < 4; ++q) { f32x4 xa = xp[q]; xa[0] += acc[8 * cc + 2 * q].x; xa[1] += acc[8 * cc + 2 * q].y; xa[2] += acc[8 * cc + 2 * q + 1].x; xa[3] += acc[8 * cc + 2 * q + 1].y; xp[q] = xa; } }
    }
}
#endif
__device__ __forceinline__ void norm_phase(const Ctx& c, float* X, int mode, const float* g1, const float* g2, bf16* H, bf16* HKV) {
    f32x4 ga[8], gb[8]; load_g(g1, c.lane, ga); load_g(mode == 1 ? g2 : g1, c.lane, gb);
    int m = c.gw;
    f32x4 v[8]; load_row(X + (size_t)m * DM, c.lane, v);
    for (; m < NTOK; m += c.ngw) {
        const int mn = m + c.ngw < NTOK ? m + c.ngw : m;
        f32x4 nx[8]; load_row(X + (size_t)mn * DM, c.lane, nx);
        const float rstd = row_rstd(v);
        if (mode == 2) { f32x4* xo = (f32x4*)(X + (size_t)m * DM) + c.lane;
#pragma unroll
            for (int j = 0; j < 8; ++j) { f32x4 y; y[0] = v[j][0] * rstd * ga[j][0]; y[1] = v[j][1] * rstd * ga[j][1]; y[2] = v[j][2] * rstd * ga[j][2]; y[3] = v[j][3] * rstd * ga[j][3]; xo[64 * j] = y; }
        } else { store_norm_bf16_r(v, rstd, ga, H + (size_t)m * DM, c.lane); if (mode == 1) store_norm_bf16_r(v, rstd, gb, HKV + (size_t)m * DM, c.lane); }
#pragma unroll
        for (int j = 0; j < 8; ++j) v[j] = nx[j];
    }
}

__device__ __forceinline__ void rms_final_phase(const Ctx& c, float* X, const float* g) {
    for (int m = c.gw; m < NTOK; m += c.ngw) { f32x4 v[8]; load_row(X + (size_t)m * DM, c.lane, v); const float rstd = row_rstd(v);
        const f32x4* gr = (const f32x4*)g + c.lane; f32x4* xo = (f32x4*)(X + (size_t)m * DM) + c.lane;
#pragma unroll
        for (int j = 0; j < 8; ++j) { const f32x4 gv = gr[64 * j]; f32x4 y; for (int k = 0; k < 4; ++k) { y[k] = v[j][k] * rstd * gv[k]; if (!(fabsf(y[k]) < 1e30f)) y[k] = 0.f; } xo[64 * j] = y; } }
}

#ifdef DIAGBUF
__device__ __forceinline__ void diag_copy_phase(const Ctx& c, float* X, const unsigned char* ws) {
    const bf16* src = (const bf16*)(ws + (size_t)DIAGBUF);
    for (size_t i = (size_t)c.bx * 512 + c.tid; i < (size_t)NTOK * DM; i += (size_t)c.G * 512) { const size_t t = i / DM, col = i % DM; float v = bflo((unsigned)src[t * DIAGLD + col]); if (!(fabsf(v) < 1e30f)) v = 0.f; X[i] = v; }
}
#endif

__device__ __forceinline__ unsigned off_b(unsigned row, unsigned ch) { return 256u * row + 16u * (ch ^ (((row & 3u) << 2) | ((row >> 2) & 3u))); }
__device__ __forceinline__ float rowmax4(float x) {
    float a = x, b = x; asm("s_nop 1\n\tv_permlane16_swap_b32 %0, %1" : "+v"(a), "+v"(b)); x = fmaxf(a, b);
    a = x; b = x; asm("s_nop 1\n\tv_permlane32_swap_b32 %0, %1" : "+v"(a), "+v"(b)); return fmaxf(a, b);
}
constexpr int AT_K = 0, AT_V = 32768, AT_BUF = 65536, AT_BIAS = 131072, AT_HEADB = 16384;
__device__ __forceinline__ void attn_phase(const Ctx& c, const bf16* Qg, const bf16* KVg, bf16* AOg, const float* relb, int dryvar = 0) {
    LAS unsigned char* lds = c.lds; const unsigned ldsb = (unsigned)(size_t)lds;
    const int tid = c.tid, lane = c.lane, w = c.wave, hg = w >> 2, wq = w & 3, fr = lane & 15, fq = lane >> 4, tq = (lane & 15) >> 2, tp = lane & 3;
    const int tl = tid & 255, lrow = tl >> 2, lc = tl & 3;
    unsigned vadr[8];
#pragma unroll
    for (int d = 0; d < 8; ++d) vadr[d] = ldsb + AT_V + hg * AT_HEADB + off_b(4 * fq + tq, 2 * d + (tp >> 1)) + 8 * (tp & 1);
    unsigned kadr[4];
#pragma unroll
    for (int s4 = 0; s4 < 4; ++s4) kadr[s4] = ldsb + AT_K + hg * AT_HEADB + 256 * fr + 16 * (fq ^ ((fr >> 2) & 3)) + 64 * (s4 ^ (fr & 3));
    for (int u = c.bx; u < NBATCH * NCHUNK * (AH / 2); u += c.G) {
        const int hp = u & 7, ch = (u >> 3) & 63, b = u >> 9, h = 2 * hp + hg;
        const size_t tq0 = (size_t)b * SEQ + (size_t)ch * CHUNK;
        __syncthreads();
        for (int i = tid; i < 2 * 272; i += 512) { const int hh = i / 272, k = i % 272; ((LAS float*)(lds + AT_BIAS))[i] = (k < NREL) ? relb[(size_t)(2 * hp + hh) * NREL + k] * 1.4426950408889634f : 0.f; }
        bf16x8 qf[4];
        { const bf16* qp = Qg + (tq0 + 16 * wq + fr) * DM + h * AHD + 8 * fq;
#pragma unroll
          for (int s = 0; s < 4; ++s) qf[s] = *(const bf16x8*)(qp + 32 * s); }
        f32x4 O[8];
#pragma unroll
        for (int d = 0; d < 8; ++d) O[d] = (f32x4){0.f, 0.f, 0.f, 0.f};
        float mrun = -1e30f, lrun = 0.f;
        const int t0 = ch >= LEFT ? 0 : LEFT - ch;
        u32x4 pk[4], pv[4];
        { const bf16* kp = KVg + ((size_t)b * SEQ + (size_t)(ch - LEFT + t0) * CHUNK + lrow) * (2 * DM) + h * AHD;
#pragma unroll
          for (int cc = 0; cc < 4; ++cc) { pk[cc] = *(const u32x4*)(kp + (lc + 4 * cc) * 8); pv[cc] = *(const u32x4*)(kp + DM + (lc + 4 * cc) * 8); } }
        const LAS float* bias = (const LAS float*)(lds + AT_BIAS) + hg * 272;
        const float bc = relb[(size_t)h * NREL + 256] * 1.4426950408889634f;
        for (int t = t0; t <= LEFT; ++t) {
            const int pb = ((t - t0) & 1) * AT_BUF;
#pragma unroll
            for (int cc = 0; cc < 4; ++cc) { *(LAS u32x4*)(lds + pb + AT_K + hg * AT_HEADB + off_b(lrow, lc + 4 * cc)) = pk[cc]; *(LAS u32x4*)(lds + pb + AT_V + hg * AT_HEADB + off_b(lrow, lc + 4 * cc)) = pv[cc]; }
            __syncthreads();
            if (t < LEFT && dryvar != 1) { const bf16* kp = KVg + ((size_t)b * SEQ + (size_t)(ch - LEFT + t + 1) * CHUNK + lrow) * (2 * DM) + h * AHD;
#pragma unroll
                for (int cc = 0; cc < 4; ++cc) { pk[cc] = *(const u32x4*)(kp + (lc + 4 * cc) * 8); pv[cc] = *(const u32x4*)(kp + DM + (lc + 4 * cc) * 8); } }
            f32x4 sT[4];
            {
                bf16x8 kf[16];
                const unsigned k0 = kadr[0] + pb, k1 = kadr[1] + pb, k2 = kadr[2] + pb, k3 = kadr[3] + pb;
                asm volatile("ds_read_b128 %0, %16\n\tds_read_b128 %1, %17\n\tds_read_b128 %2, %18\n\tds_read_b128 %3, %19\n\t"
                             "ds_read_b128 %4, %16 offset:4096\n\tds_read_b128 %5, %17 offset:4096\n\tds_read_b128 %6, %18 offset:4096\n\tds_read_b128 %7, %19 offset:4096\n\t"
                             "ds_read_b128 %8, %16 offset:8192\n\tds_read_b128 %9, %17 offset:8192\n\tds_read_b128 %10, %18 offset:8192\n\tds_read_b128 %11, %19 offset:8192\n\t"
                             "ds_read_b128 %12, %16 offset:12288\n\tds_read_b128 %13, %17 offset:12288\n\tds_read_b128 %14, %18 offset:12288\n\tds_read_b128 %15, %19 offset:12288"
                             : "=&v"(kf[0]), "=&v"(kf[1]), "=&v"(kf[2]), "=&v"(kf[3]), "=&v"(kf[4]), "=&v"(kf[5]), "=&v"(kf[6]), "=&v"(kf[7]),
                               "=&v"(kf[8]), "=&v"(kf[9]), "=&v"(kf[10]), "=&v"(kf[11]), "=&v"(kf[12]), "=&v"(kf[13]), "=&v"(kf[14]), "=&v"(kf[15])
                             : "v"(k0), "v"(k1), "v"(k2), "v"(k3) : "memory");
                asm volatile("s_waitcnt lgkmcnt(8)" : "+v"(kf[0]), "+v"(kf[1]), "+v"(kf[2]), "+v"(kf[3]), "+v"(kf[4]), "+v"(kf[5]), "+v"(kf[6]), "+v"(kf[7]) :: "memory");
#pragma unroll
                for (int kt = 0; kt < 2; ++kt) { sT[kt] = (f32x4){0.f, 0.f, 0.f, 0.f};
#pragma unroll
                    for (int s = 0; s < 4; ++s) sT[kt] = MFMA16(kf[4 * kt + s], qf[s], sT[kt]); }
                asm volatile("s_waitcnt lgkmcnt(0)" : "+v"(kf[8]), "+v"(kf[9]), "+v"(kf[10]), "+v"(kf[11]), "+v"(kf[12]), "+v"(kf[13]), "+v"(kf[14]), "+v"(kf[15]) :: "memory");
#pragma unroll
                for (int kt = 2; kt < 4; ++kt) { sT[kt] = (f32x4){0.f, 0.f, 0.f, 0.f};
#pragma unroll
                    for (int s = 0; s < 4; ++s) sT[kt] = MFMA16(kf[4 * kt + s], qf[s], sT[kt]); }
            }
            const int dbase = (LEFT - t) * CHUNK + (16 * wq + fr);
            if (t > LEFT - 3) {
#pragma unroll
                for (int kt = 0; kt < 4; ++kt)
#pragma unroll
                    for (int r = 0; r < 4; ++r) { const int dist = dbase - (16 * kt + 4 * fq + r); sT[kt][r] += bias[min(dist, 128) + 128]; }
            }
            s16x4 vlo[2][8], vhi[2][8];
            unsigned vcur[8];
#pragma unroll
            for (int d = 0; d < 8; ++d) vcur[d] = vadr[d] + pb;
#define TR8(dst, OFF) asm volatile("ds_read_b64_tr_b16 %0, %8 offset:" #OFF "\n\tds_read_b64_tr_b16 %1, %9 offset:" #OFF "\n\tds_read_b64_tr_b16 %2, %10 offset:" #OFF "\n\tds_read_b64_tr_b16 %3, %11 offset:" #OFF "\n\t" \
                "ds_read_b64_tr_b16 %4, %12 offset:" #OFF "\n\tds_read_b64_tr_b16 %5, %13 offset:" #OFF "\n\tds_read_b64_tr_b16 %6, %14 offset:" #OFF "\n\tds_read_b64_tr_b16 %7, %15 offset:" #OFF \
                : "=&v"(dst[0]), "=&v"(dst[1]), "=&v"(dst[2]), "=&v"(dst[3]), "=&v"(dst[4]), "=&v"(dst[5]), "=&v"(dst[6]), "=&v"(dst[7]) \
                : "v"(vcur[0]), "v"(vcur[1]), "v"(vcur[2]), "v"(vcur[3]), "v"(vcur[4]), "v"(vcur[5]), "v"(vcur[6]), "v"(vcur[7]) : "memory")
            TR8(vlo[0], 0); TR8(vhi[0], 4096); TR8(vlo[1], 8192); TR8(vhi[1], 12288);
#undef TR8
            float mx = -1e30f;
            const float badd = t <= LEFT - 3 ? bc : 0.f;
#pragma unroll
            for (int kt = 0; kt < 4; ++kt)
#pragma unroll
                for (int r = 0; r < 4; ++r) { sT[kt][r] += badd; mx = fmaxf(mx, sT[kt][r]); }
            mx = rowmax4(mx);
            const float mnew = fmaxf(mrun, mx), alpha = __builtin_amdgcn_exp2f(mrun - mnew); mrun = mnew;
            float ps = 0.f;
#pragma unroll
            for (int kt = 0; kt < 4; ++kt)
#pragma unroll
                for (int r = 0; r < 4; ++r) { sT[kt][r] = __builtin_amdgcn_exp2f(sT[kt][r] - mnew); ps += sT[kt][r]; }
            lrun = lrun * alpha + ps;
#pragma unroll
            for (int d = 0; d < 8; ++d) O[d] *= alpha;
            asm volatile("s_waitcnt lgkmcnt(0)" : "+v"(vlo[0][0]), "+v"(vlo[0][1]), "+v"(vlo[0][2]), "+v"(vlo[0][3]), "+v"(vlo[0][4]), "+v"(vlo[0][5]), "+v"(vlo[0][6]), "+v"(vlo[0][7]),
                         "+v"(vhi[0][0]), "+v"(vhi[0][1]), "+v"(vhi[0][2]), "+v"(vhi[0][3]), "+v"(vhi[0][4]), "+v"(vhi[0][5]), "+v"(vhi[0][6]), "+v"(vhi[0][7]) :: "memory");
            asm volatile("" : "+v"(vlo[1][0]), "+v"(vlo[1][1]), "+v"(vlo[1][2]), "+v"(vlo[1][3]), "+v"(vlo[1][4]), "+v"(vlo[1][5]), "+v"(vlo[1][6]), "+v"(vlo[1][7]),
                         "+v"(vhi[1][0]), "+v"(vhi[1][1]), "+v"(vhi[1][2]), "+v"(vhi[1][3]), "+v"(vhi[1][4]), "+v"(vhi[1][5]), "+v"(vhi[1][6]), "+v"(vhi[1][7]) :: "memory");
            __builtin_amdgcn_sched_barrier(0);
#pragma unroll
            for (int ks = 0; ks < 2; ++ks) {
                bf16x8 pb; { const unsigned p0 = pk2(sT[2 * ks][0], sT[2 * ks][1]), p1 = pk2(sT[2 * ks][2], sT[2 * ks][3]), p2 = pk2(sT[2 * ks + 1][0], sT[2 * ks + 1][1]), p3 = pk2(sT[2 * ks + 1][2], sT[2 * ks + 1][3]);
                    const u32x4 pw = (u32x4){p0, p1, p2, p3}; pb = __builtin_bit_cast(bf16x8, pw); }
#pragma unroll
                for (int d = 0; d < 8; ++d) { bf16x8 va; va[0] = vlo[ks][d][0]; va[1] = vlo[ks][d][1]; va[2] = vlo[ks][d][2]; va[3] = vlo[ks][d][3]; va[4] = vhi[ks][d][0]; va[5] = vhi[ks][d][1]; va[6] = vhi[ks][d][2]; va[7] = vhi[ks][d][3];
                    O[d] = MFMA16(va, pb, O[d]); }
            }
        }
        float lt = lrun; lt += __shfl_xor(lt, 16); lt += __shfl_xor(lt, 32);
        const float inv = 1.0f / lt;
        bf16* op = AOg + (tq0 + 16 * wq + fr) * DM + h * AHD + 4 * fq;
#pragma unroll
        for (int d = 0; d < 8; ++d) { u32x2 ow; ow.x = pk2(O[d][0] * inv, O[d][1] * inv); ow.y = pk2(O[d][2] * inv, O[d][3] * inv); *(u32x2*)(op + 16 * d) = ow; }
    }
}

namespace at2 {
typedef float f32x16 __attribute__((ext_vector_type(16)));
constexpr int SHM_V = 64 * 128 * 2, SHM_K = 64 * 128 * 2, OFF_K = 2 * SHM_V, OFF_WS = 2 * SHM_V + 2 * SHM_K, OFF_BIAS = OFF_WS + 8 * 64 * 4, OFF_Q = OFF_BIAS + 2048;
constexpr float THRL = 8.0f * 1.4426950408889634f;
#define A2_KSWZ(row, colB) ((row) * 256 + ((colB) ^ (((row) & 7) << 4)))
#define A2_SBAR() __builtin_amdgcn_sched_barrier(0)
__device__ __forceinline__ int crow(int r, int hi) { return (r & 3) + 8 * (r >> 2) + 4 * hi; }
__device__ __forceinline__ float pl32max(float x) { auto rr = __builtin_amdgcn_permlane32_swap(__builtin_bit_cast(unsigned, x), __builtin_bit_cast(unsigned, x), false, false);
    const unsigned a = rr[0], b = rr[1]; return fmaxf(__builtin_bit_cast(float, a), __builtin_bit_cast(float, b)); }
__device__ __forceinline__ float pl32sum(float x) { auto rr = __builtin_amdgcn_permlane32_swap(__builtin_bit_cast(unsigned, x), __builtin_bit_cast(unsigned, x), false, false);
    const unsigned a = rr[0], b = rr[1]; return __builtin_bit_cast(float, a) + __builtin_bit_cast(float, b); }
__device__ __forceinline__ void partialSM(f32x16& p0, f32x16& p1, float& m_reg, float& mn, float& alpha) {
    float pmax = p0[0];
#pragma unroll
    for (int r = 1; r < 16; ++r) pmax = fmaxf(pmax, p0[r]);
#pragma unroll
    for (int r = 0; r < 16; ++r) pmax = fmaxf(pmax, p1[r]);
    pmax = pl32max(pmax);
    if (__builtin_expect(__all(pmax - m_reg <= THRL), 1)) { mn = m_reg; alpha = 1.f; }
    else { mn = fmaxf(m_reg, pmax); alpha = __builtin_amdgcn_exp2f(m_reg - mn); m_reg = mn; }
#pragma unroll
    for (int r = 0; r < 16; ++r) { p0[r] -= mn; p1[r] -= mn; }
#pragma unroll
    for (int r = 0; r < 16; ++r) p0[r] = __builtin_amdgcn_exp2f(p0[r]);
}
__device__ __forceinline__ void finishSM(f32x16& p0, f32x16& p1, float alpha, float& l_reg, bf16x8& pa0, bf16x8& pa1, bf16x8& pa2, bf16x8& pa3) {
#pragma unroll
    for (int r = 0; r < 16; ++r) p1[r] = __builtin_amdgcn_exp2f(p1[r]);
    float ps = 0.f;
#pragma unroll
    for (int r = 0; r < 16; ++r) ps += p0[r];
#pragma unroll
    for (int r = 0; r < 16; ++r) ps += p1[r];
    ps = pl32sum(ps);
    l_reg = l_reg * alpha + ps;
#define A2_PK4(P, BASE, OUT) do { const unsigned a0 = pk2(P[BASE + 0], P[BASE + 1]), a1 = pk2(P[BASE + 2], P[BASE + 3]), b0 = pk2(P[BASE + 4], P[BASE + 5]), b1 = pk2(P[BASE + 6], P[BASE + 7]); \
        auto r0 = __builtin_amdgcn_permlane32_swap(a0, b0, false, false); auto r1 = __builtin_amdgcn_permlane32_swap(a1, b1, false, false); \
        const unsigned w0 = r0[0], w1 = r1[0], w2 = r0[1], w3 = r1[1]; const u32x4 w = {w0, w1, w2, w3}; OUT = __builtin_bit_cast(bf16x8, w); } while (0)
    A2_PK4(p0, 0, pa0); A2_PK4(p0, 8, pa1); A2_PK4(p1, 0, pa2); A2_PK4(p1, 8, pa3);
#undef A2_PK4
}
__device__ __forceinline__ void qkt(f32x16& p0, f32x16& p1, LAS const unsigned char* Ks, LAS const unsigned char* qr_l, int r32, int hi) {
    asm volatile("" : "+v"(r32));
#pragma unroll
    for (int r = 0; r < 16; ++r) { p0[r] = 0.f; p1[r] = 0.f; }
#pragma unroll
    for (int d0 = 0; d0 < 8; ++d0) { const int cb = (d0 * 16 + hi * 8) * 2;
        const bf16x8 b0 = *(LAS const bf16x8*)(Ks + A2_KSWZ(r32, cb));
        const bf16x8 b1 = *(LAS const bf16x8*)(Ks + A2_KSWZ(32 + r32, cb));
        const bf16x8 q8 = *(LAS const bf16x8*)(qr_l + d0 * 1024);
        p0 = __builtin_amdgcn_mfma_f32_32x32x16_bf16(b0, q8, p0, 0, 0, 0);
        p1 = __builtin_amdgcn_mfma_f32_32x32x16_bf16(b1, q8, p1, 0, 0, 0); }
}
__device__ __forceinline__ int v_st(int k, int c) { const int kk = (k & ~0xC) | ((k & 4) << 1) | ((k & 8) >> 1); return ((kk >> 3) * 4 + (c >> 5)) * 512 + ((kk & 7) * 32 + (c & 31)) * 2; }
__device__ __forceinline__ int v_rd_base(int lane) { return ((lane & 3) << 3) | (((lane >> 2) & 3) << 6) | (((lane >> 4) & 1) << 5) | (((lane >> 5) & 1) << 8); }
constexpr int v_rd_off(int d0, int ks, int half) { return d0 * 512 + ks * 4096 + half * 2048; }
template <int OFF> __device__ __forceinline__ s16x4 tr_read(int vb) { s16x4 r; asm volatile("ds_read_b64_tr_b16 %0, %1 offset:%2" : "=&v"(r) : "v"(vb), "i"(OFF) : "memory"); return r; }
template <int D0> __device__ __forceinline__ void pv_one(f32x16& od, int vb, bf16x8 pa0, bf16x8 pa1, bf16x8 pa2, bf16x8 pa3) {
    const s16x4 l0 = tr_read<v_rd_off(D0, 0, 0)>(vb), h0 = tr_read<v_rd_off(D0, 0, 1)>(vb), l1 = tr_read<v_rd_off(D0, 1, 0)>(vb), h1 = tr_read<v_rd_off(D0, 1, 1)>(vb);
    const s16x4 l2 = tr_read<v_rd_off(D0, 2, 0)>(vb), h2 = tr_read<v_rd_off(D0, 2, 1)>(vb), l3 = tr_read<v_rd_off(D0, 3, 0)>(vb), h3 = tr_read<v_rd_off(D0, 3, 1)>(vb);
    asm volatile("s_waitcnt lgkmcnt(0)" ::: "memory"); A2_SBAR();
#define A2_PK(L, H) (bf16x8){L[0], L[1], L[2], L[3], H[0], H[1], H[2], H[3]}
    od = __builtin_amdgcn_mfma_f32_32x32x16_bf16(pa0, A2_PK(l0, h0), od, 0, 0, 0);
    od = __builtin_amdgcn_mfma_f32_32x32x16_bf16(pa1, A2_PK(l1, h1), od, 0, 0, 0);
    od = __builtin_amdgcn_mfma_f32_32x32x16_bf16(pa2, A2_PK(l2, h2), od, 0, 0, 0);
    od = __builtin_amdgcn_mfma_f32_32x32x16_bf16(pa3, A2_PK(l3, h3), od, 0, 0, 0);
#undef A2_PK
}
__device__ __forceinline__ void pv_d0(f32x16 (&o)[4], int vb, bf16x8 pa0, bf16x8 pa1, bf16x8 pa2, bf16x8 pa3) {
    pv_one<0>(o[0], vb, pa0, pa1, pa2, pa3); pv_one<1>(o[1], vb, pa0, pa1, pa2, pa3); pv_one<2>(o[2], vb, pa0, pa1, pa2, pa3); pv_one<3>(o[3], vb, pa0, pa1, pa2, pa3);
}
__device__ __forceinline__ void bias_mask(f32x16& p0, f32x16& p1, int dc, LAS const float* bias, float bc, int qrow, int hi) {
    if (dc < 0 || dc > 8) {
#pragma unroll
        for (int r = 0; r < 16; ++r) { p0[r] = -__builtin_inff(); p1[r] = -__builtin_inff(); }
    } else if (dc >= 3) {
#pragma unroll
        for (int r = 0; r < 16; ++r) { p0[r] += bc; p1[r] += bc; }
    } else {
        int db = 64 * dc + qrow + 128 - 4 * hi; asm volatile("" : "+v"(db));
#pragma unroll
        for (int r = 0; r < 16; ++r) { const int k0 = (r & 3) + 8 * (r >> 2); p0[r] += bias[min(db - k0, 256)]; p1[r] += bias[min(db - 32 - k0, 256)]; }
    }
}
__device__ __forceinline__ void block(const bf16* Qb, const bf16* Kh, const bf16* Vh, bf16* Ob, int NT, int dc0, LAS const float* bias, float bc, LAS unsigned char* lds, int tid) {
    constexpr int LDQ = DM, LDK = 2 * DM, LDO = DM;
    const int wid = tid >> 6, lane = tid & 63, r32 = lane & 31, hi = lane >> 5;
    LAS unsigned char* V_lds = lds; LAS unsigned char* K_lds = lds + OFF_K;
    LAS float* ws = (LAS float*)(lds + OFF_WS) + wid * 64; LAS float* li_l = ws; LAS float* al_l = ws + 32;
    float m_reg = -1e30f, l_reg = 0.f; f32x16 o[4];
    LAS unsigned char* qr = lds + OFF_Q + wid * 8192 + lane * 16;
#pragma unroll
    for (int d = 0; d < 4; ++d)
#pragma unroll
        for (int r = 0; r < 16; ++r) o[d][r] = 0.f;
    const bf16* Qw = Qb + (size_t)(wid * 32 + r32) * LDQ + hi * 8;
#pragma unroll
    for (int d0 = 0; d0 < 8; ++d0) *(LAS bf16x8*)(qr + d0 * 1024) = *(const bf16x8*)(Qw + d0 * 16);
    const int sr = tid >> 4, sc = (tid & 15) * 8, vst0 = v_st(sr, sc), vst1 = v_st(32 + sr, sc);
    const int vb0 = (int)(unsigned)(size_t)V_lds + v_rd_base(lane);
    const int qrow = (wid & 1) * 32 + r32, dcw = dc0 + (wid >> 1);
    bf16x8 sv0[1], sv1[1], sk0[1], sk1[1];
#define A2_SLOAD(i, k0) do { sv0[i] = *(const bf16x8*)(Vh + (size_t)((k0) + sr) * LDK + sc); sv1[i] = *(const bf16x8*)(Vh + (size_t)((k0) + 32 + sr) * LDK + sc); \
        sk0[i] = *(const bf16x8*)(Kh + (size_t)((k0) + sr) * LDK + sc); sk1[i] = *(const bf16x8*)(Kh + (size_t)((k0) + 32 + sr) * LDK + sc); } while (0)
#define A2_SWRITE(b, i) do { *(LAS bf16x8*)(V_lds + (b) * SHM_V + vst0) = sv0[i]; *(LAS bf16x8*)(V_lds + (b) * SHM_V + vst1) = sv1[i]; const int kc = sc * 2; \
        *(LAS bf16x8*)(K_lds + (b) * SHM_K + A2_KSWZ(sr, kc)) = sk0[i]; *(LAS bf16x8*)(K_lds + (b) * SHM_K + A2_KSWZ(32 + sr, kc)) = sk1[i]; } while (0)
#define A2_SWAIT() asm volatile("s_waitcnt vmcnt(0)" ::: "memory")
#define A2_RESC(a) do { if (__any((a) < 1.f)) { if (hi == 0) al_l[r32] = (a); asm volatile("s_waitcnt lgkmcnt(0)" ::: "memory"); \
        _Pragma("unroll") for (int d = 0; d < 4; ++d) _Pragma("unroll") for (int r = 0; r < 16; ++r) o[d][r] *= al_l[crow(r, hi)]; } } while (0)
    f32x16 pA0, pA1, pB0, pB1; float mnA, mnB, alA = 1.f, alB = 1.f; bf16x8 pa0, pa1, pa2, pa3;
#define A2_VIS(jj) ((unsigned)(dcw - (jj)) <= 8u)
    A2_SLOAD(0, 0); asm volatile("s_waitcnt vmcnt(0)" ::: "memory"); A2_SWRITE(0, 0); __syncthreads();
    bool vA = A2_VIS(0), vB = false;
    if (vA) { qkt(pA0, pA1, K_lds, qr, r32, hi); bias_mask(pA0, pA1, dcw - 0, bias, bc, qrow, hi); partialSM(pA0, pA1, m_reg, mnA, alA); }
    A2_SLOAD(0, 64);
    A2_SWAIT(); A2_SWRITE(1, 0); __syncthreads();
    for (int j = 1; j + 1 < NT; j += 2) {
        vB = A2_VIS(j);
        A2_SBAR(); if (vB) { qkt(pB0, pB1, K_lds + SHM_K, qr, r32, hi); bias_mask(pB0, pB1, dcw - j, bias, bc, qrow, hi); }
        if (vA) finishSM(pA0, pA1, alA, l_reg, pa0, pa1, pa2, pa3);
        A2_SBAR();
        A2_SLOAD(0, (j + 1) * 64); A2_SBAR();
        if (vA) pv_d0(o, vb0, pa0, pa1, pa2, pa3);
        alB = 1.f; if (vB) partialSM(pB0, pB1, m_reg, mnB, alB);
        __syncthreads(); A2_SWAIT(); A2_SWRITE(0, 0);
        A2_RESC(alB); __syncthreads();
        vA = A2_VIS(j + 1);
        A2_SBAR(); if (vA) { qkt(pA0, pA1, K_lds, qr, r32, hi); bias_mask(pA0, pA1, dcw - (j + 1), bias, bc, qrow, hi); }
        if (vB) finishSM(pB0, pB1, alB, l_reg, pa0, pa1, pa2, pa3);
        A2_SBAR();
        A2_SLOAD(0, (j + 2) * 64);
        A2_SBAR();
        if (vB) pv_d0(o, vb0 + SHM_V, pa0, pa1, pa2, pa3);
        alA = 1.f; if (vA) partialSM(pA0, pA1, m_reg, mnA, alA);
        __syncthreads(); A2_SWAIT(); A2_SWRITE(1, 0);
        A2_RESC(alA); __syncthreads();
    }
    vB = A2_VIS(NT - 1);
    A2_SBAR(); if (vB) { qkt(pB0, pB1, K_lds + SHM_K, qr, r32, hi); bias_mask(pB0, pB1, dcw - (NT - 1), bias, bc, qrow, hi); }
    if (vA) finishSM(pA0, pA1, alA, l_reg, pa0, pa1, pa2, pa3);
    A2_SBAR();
    if (vA) pv_d0(o, vb0, pa0, pa1, pa2, pa3);
    alB = 1.f; if (vB) partialSM(pB0, pB1, m_reg, mnB, alB);
    __syncthreads(); A2_RESC(alB);
    if (vB) { finishSM(pB0, pB1, alB, l_reg, pa0, pa1, pa2, pa3); A2_SBAR();
        pv_d0(o, vb0 + SHM_V, pa0, pa1, pa2, pa3); }
#undef A2_VIS
    if (hi == 0) li_l[r32] = l_reg; asm volatile("s_waitcnt lgkmcnt(0)" ::: "memory");
    float rli[16];
#pragma unroll
    for (int r = 0; r < 16; ++r) rli[r] = __builtin_amdgcn_rcpf(li_l[crow(r, hi)]);
    bf16* Ow = Ob + (size_t)(wid * 32) * LDO;
#pragma unroll
    for (int r = 0; r < 16; ++r) { const int orow = crow(r, hi);
#pragma unroll
        for (int d0 = 0; d0 < 4; ++d0) Ow[(size_t)orow * LDO + d0 * 32 + r32] = (bf16)f2bf(o[d0][r] * rli[r]); }
#undef A2_SLOAD
#undef A2_SWRITE
#undef A2_SWAIT
#undef A2_RESC
}
}
__device__ __forceinline__ void attn_phase2(const Ctx& c, const bf16* Qg, const bf16* KVg, bf16* AOg, const float* relb) {
    LAS unsigned char* lds = c.lds;
    for (int u = c.bx; u < NBATCH * AH * 16; u += c.G) {
        const int h = u & 15, b = (u >> 4) & 3, qb = u >> 6;
        const int c0 = 4 * qb, kb = c0 >= LEFT ? c0 - LEFT : 0, NT = c0 + 4 - kb;
        __syncthreads();
        { int i = c.tid; asm volatile("" : "+v"(i));
          if (i < 272) ((LAS float*)(lds + at2::OFF_BIAS))[i] = (i < NREL) ? relb[(size_t)h * NREL + i] * 1.4426950408889634f : 0.f; }
        const float bc = relb[(size_t)h * NREL + 256] * 1.4426950408889634f;
        __syncthreads();
        const size_t tq0 = (size_t)b * SEQ + (size_t)c0 * CHUNK, tk0 = (size_t)b * SEQ + (size_t)kb * CHUNK;
        at2::block(Qg + tq0 * DM + h * AHD, KVg + tk0 * (2 * DM) + h * AHD, KVg + tk0 * (2 * DM) + DM + h * AHD, AOg + tq0 * DM + h * AHD, NT, c0 - kb, (const LAS float*)(lds + at2::OFF_BIAS), bc, lds, c.tid);
    }
}

constexpr int NSTEPS = 1 + 2 * 10 + 2 * 9;
template <int MASK> __global__ void __launch_bounds__(512, 2) yoco_fwd(Params p) {
    extern __shared__ __attribute__((aligned(16))) unsigned char lds_raw[];
#define MK_CTX() Ctx c; { int t_ = threadIdx.x; asm volatile("" : "+v"(t_)); c.lds = (LAS unsigned char*)lds_raw; c.tid = t_; c.lane = t_ & 63; c.wave = __builtin_amdgcn_readfirstlane(t_ >> 6); \
        { int b_ = blockIdx.x, g_ = gridDim.x; asm volatile("" : "+s"(b_), "+s"(g_)); c.bx = b_; c.G = g_; } c.gw = c.bx * 8 + c.wave; c.ngw = c.G * 8; }
    volatile LAS unsigned* MISC = (volatile LAS unsigned*)((LAS unsigned char*)lds_raw + LDS_MISC);
    if (threadIdx.x < 4) MISC[threadIdx.x] = 0u;
    __syncthreads();
    XcdBarrier bar; bar.bar = (unsigned*)(p.ws + WS_CTL); bar.x = 0; bar.st = MISC;
    if (p.hi - p.lo > 1) bar = xcd_barrier_post((unsigned*)(p.ws + WS_CTL), MISC);
    unsigned char* ws = p.ws;
    bf16* const H = (bf16*)(ws + WS_H); bf16* const HKV = (bf16*)(ws + WS_HKV);
    float* const X = p.out;
    int s = 0;
#ifndef REPMASK
#define REPMASK 0
#endif
#define KF_(f) p.f = kq_->f;
#define MK_P() Params p; { unsigned long long ka_ = (unsigned long long)__builtin_amdgcn_kernarg_segment_ptr(); asm volatile("" : "+s"(ka_)); const __attribute__((address_space(4))) Params* kq_ = (const __attribute__((address_space(4))) Params*)ka_; \
        KF_(x) KF_(ln_mix) KF_(ln_ffn) KF_(ret_w_in) KF_(ret_w_out) KF_(ret_gn) KF_(kv_norm) KF_(w_kv) KF_(att_w_q) KF_(att_w_o) KF_(att_rel_bias) KF_(peer_w_q) KF_(peer_sub_keys) KF_(peer_u) KF_(peer_v) KF_(ln_final) \
        KF_(out) KF_(ws) KF_(lo) KF_(hi) } \
        unsigned char* const ws = p.ws; bf16* const H = (bf16*)(ws + WS_H); bf16* const HKV = (bf16*)(ws + WS_HKV); float* const X = p.out; (void)H; (void)HKV; (void)X;
#define BEGIN_STEP(k) if (((MASK >> (k)) & 1) && s >= p.lo && s < p.hi) { for (int rep_ = ((REPMASK >> (k)) & 1) ? 0 : 1; rep_ < 2; ++rep_) { MK_CTX(); MK_P();
#define END_STEP   if (rep_ == 0 || s + 1 < p.hi) xcd_barrier(bar); } } ++s;

    BEGIN_STEP(0) p0_prologue(p, c); END_STEP

    for (int l = 0; l < DEPTH; ++l) {
        if (l < 2) {
            BEGIN_STEP(1)
                pg8::Gemm g{H, (const bf16*)(ws + WS_WIN) + (size_t)l * RIN * DM, NTOK, RIN, DM}; pg8::StaticOrder S; S.init(NTOK, RIN, c.G, c.bx);
                pg8::EpiProj E{(bf16*)(ws + WS_Q), (bf16*)(ws + WS_K), (bf16*)(ws + WS_V), (bf16*)(ws + WS_G), (const float*)(ws + WS_ROT)};
                pg8::gemm_phase<pg8::EpiProj, pg8::StaticOrder>(c.lds, g, S, E, nullptr);
            END_STEP
            BEGIN_STEP(2)
                for (int u = c.bx; u < 256; u += c.G) ret_scan_unit(c, (const bf16*)(ws + WS_Q), (const bf16*)(ws + WS_K), (const bf16*)(ws + WS_V), (bf16*)(ws + WS_O), u);
            END_STEP
            BEGIN_STEP(3)
                ret_gate_phase(c, (const bf16*)(ws + WS_O), (bf16*)(ws + WS_G), p.ret_gn + (size_t)l * RVW, rep_ == 0 ? (bf16*)(ws + WS_SC) : nullptr);
            END_STEP
        } else {
            BEGIN_STEP(4)
                for (int pass = (l == 2 ? 0 : 1); pass < 2; ++pass) {
                    const int N = pass ? DM : 2 * DM;
                    pg8::Gemm g{pass ? H : HKV, pass ? (const bf16*)(ws + WS_WQ) + (size_t)(l - 2) * DM * DM : (const bf16*)(ws + WS_WKV), NTOK, N, DM}; pg8::StaticOrder S; S.init(NTOK, N, c.G, c.bx);
                    pg8::EpiBf16S E{pass ? (bf16*)(ws + WS_Q) : (bf16*)(ws + WS_KV), N, pass ? 0.12751743082459868f : 1.0f};
                    pg8::gemm_phase<pg8::EpiBf16S, pg8::StaticOrder>(c.lds, g, S, E, nullptr);
                }
            END_STEP
            BEGIN_STEP(5)
#ifdef ATTNDRY
                attn_phase(c, (const bf16*)(ws + WS_Q), (const bf16*)(ws + WS_KV), rep_ == 0 ? (bf16*)(ws + WS_O) : (bf16*)(ws + WS_AO), p.att_rel_bias + (size_t)(l - 2) * AH * NREL, rep_ == 0 ? ATTNDRY : 0);
#else
                attn_phase2(c, (const bf16*)(ws + WS_Q), (const bf16*)(ws + WS_KV), (bf16*)(ws + WS_AO), p.att_rel_bias + (size_t)(l - 2) * AH * NREL);
#endif
            END_STEP
        }
        BEGIN_STEP(6)
            const int K = l < 2 ? RVW : DM;
            pg8::Gemm g{l < 2 ? (const bf16*)(ws + WS_G) : (const bf16*)(ws + WS_AO), l < 2 ? (const bf16*)(ws + WS_WOUT) + (size_t)l * DM * RVW : (const bf16*)(ws + WS_WO) + (size_t)(l - 2) * DM * DM, NTOK, DM, K};
            pg8::StaticOrder S; S.init(NTOK, DM, c.G, c.bx);
            pg8::EpiRes E{X, DM, H, p.ln_ffn + (size_t)l * DM, (float*)(ws + WS_SQP)};
            pg8::gemm_phase<pg8::EpiRes, pg8::StaticOrder>(c.lds, g, S, E, nullptr);
        END_STEP
        BEGIN_STEP(8)
            pg8::Gemm g{H, (const bf16*)(ws + WS_WC) + (size_t)l * DM * DM, NTOK, DM, DM}; pg8::StaticOrder S; S.init(NTOK, DM, c.G, c.bx);
            pg8::EpiF32 E{(float*)(ws + WS_SC), DM};
            pg8::gemm_phase<pg8::EpiF32, pg8::StaticOrder>(c.lds, g, S, E, nullptr);
        END_STEP
        BEGIN_STEP(9)
            peer_topk_phase(c, (const float*)(ws + WS_SC), (int*)(ws + WS_IDX), (float*)(ws + WS_WGT), (const float*)(ws + WS_SQP), (float*)(ws + WS_RSTD));
        END_STEP
        BEGIN_STEP(10)
#ifdef DRYIDXMASK
            peer_u_phase(c, H, ws + WS_PU + (size_t)l * PE * DM, (const int*)(ws + WS_IDX), (float*)(ws + WS_SC), rep_ == 0 ? DRYIDXMASK : 0xffffffffu);
#else
            peer_u_phase(c, H, ws + WS_PU + (size_t)l * PE * DM, (const int*)(ws + WS_IDX), (float*)(ws + WS_SC));
#endif
        END_STEP
        BEGIN_STEP(11)
            peer_a_phase(c, (const float*)(ws + WS_SC), (const int*)(ws + WS_IDX), (float*)(ws + WS_WGT), (const float*)(ws + WS_RS) + (size_t)l * PE, (const float*)(ws + WS_RS) + (size_t)(DEPTH + l) * PE, (const float*)(ws + WS_RSTD));
        END_STEP
        BEGIN_STEP(12)
#ifdef VREF
            peer_v_ref_phase(c, ws + WS_PV + (size_t)l * PE * DM, (const int*)(ws + WS_IDX), (const float*)(ws + WS_WGT), X);
#else
            peer_v_phase(c, ws + WS_PV + (size_t)l * PE * DM, (const int*)(ws + WS_IDX), (const float*)(ws + WS_WGT), X);
#endif
        END_STEP
        BEGIN_STEP(13)
            const int mode = (l == DEPTH - 1) ? 2 : (l == 1 ? 1 : 0);
            norm_phase(c, X, mode, mode == 2 ? p.ln_final : p.ln_mix + (size_t)(l + 1) * DM, p.kv_norm, H, HKV);
        END_STEP
    }
#ifdef DIAGBUF
    if ((MASK >> 14) & 1) { MK_CTX(); diag_copy_phase(c, X, ws); }
#else
    if ((MASK >> 14) & 1) { MK_CTX(); MK_P(); rms_final_phase(c, X, p.ln_final); }
#endif
#undef BEGIN_STEP
#undef END_STEP
}

#ifndef N_LAUNCH_CUT
#define N_LAUNCH_CUT 1
#endif
typedef void (*kern_t)(Params);
template <int SITE> static void launch_site(const Params& p, hipStream_t stream) {
    static bool attr = false;
    if (!attr) { (void)hipFuncSetAttribute((const void*)yoco_fwd<(1 << SITE)>, hipFuncAttributeMaxDynamicSharedMemorySize, LDS_BYTES); attr = true; }
    hipLaunchKernelGGL((yoco_fwd<(1 << SITE)>), dim3(256), dim3(512), LDS_BYTES, stream, p);
}
#ifndef MEGASITES
#define MEGASITES 0
#endif
static void launch_step_site(int site, const Params& p, hipStream_t stream) {
    if ((MEGASITES >> site) & 1) { hipLaunchKernelGGL((yoco_fwd<0x3FFF>), dim3(256), dim3(512), LDS_BYTES, stream, p); return; }
    switch (site) {
        case 0: launch_site<0>(p, stream); break; case 1: launch_site<1>(p, stream); break; case 2: launch_site<2>(p, stream); break; case 3: launch_site<3>(p, stream); break;
        case 4: launch_site<4>(p, stream); break; case 5: launch_site<5>(p, stream); break; case 6: launch_site<6>(p, stream); break; case 7: launch_site<7>(p, stream); break;
        case 8: launch_site<8>(p, stream); break; case 9: launch_site<9>(p, stream); break; case 10: launch_site<10>(p, stream); break; case 11: launch_site<11>(p, stream); break; case 12: launch_site<12>(p, stream); break; case 13: launch_site<13>(p, stream); break; default: launch_site<14>(p, stream); break;
    }
}
extern "C" void kernel_launch(void* const* d_in, const int* in_sizes, int n_in, void* d_out, int out_size, void* d_ws, size_t ws_size, hipStream_t stream) {
    static int ready = 0;
    if (ready == 0) {
        if (n_in != 16 || out_size != NTOK * DM || ws_size < WS_END) { fprintf(stderr, "kernel_launch: unexpected sizes (n_in %d out %d ws %zu, need %zu)\n", n_in, out_size, ws_size, (size_t)WS_END); ready = -1; return; }
#if N_LAUNCH_CUT || MEGASITES
        if (hipFuncSetAttribute((const void*)yoco_fwd<0x3FFF>, hipFuncAttributeMaxDynamicSharedMemorySize, LDS_BYTES) != hipSuccess) { fprintf(stderr, "kernel_launch: hipFuncSetAttribute failed\n"); ready = -1; return; }
#endif
        ready = 1;
    }
    if (ready < 0) return;
    (void)hipMemsetAsync(d_ws, 0, 16384, stream);
    Params p{};
    p.x = (const float*)d_in[0]; p.ln_mix = (const float*)d_in[1]; p.ln_ffn = (const float*)d_in[2]; p.ret_w_in = (const float*)d_in[3]; p.ret_w_out = (const float*)d_in[4]; p.ret_gn = (const float*)d_in[5];
    p.kv_norm = (const float*)d_in[6]; p.w_kv = (const float*)d_in[7]; p.att_w_q = (const float*)d_in[8]; p.att_w_o = (const float*)d_in[9]; p.att_rel_bias = (const float*)d_in[10];
    p.peer_w_q = (const float*)d_in[11]; p.peer_sub_keys = (const float*)d_in[12]; p.peer_u = (const float*)d_in[13]; p.peer_v = (const float*)d_in[14]; p.ln_final = (const float*)d_in[15];
    p.out = (float*)d_out; p.ws = (unsigned char*)d_ws;
#if N_LAUNCH_CUT == 2
    for (int s2 = 0; s2 < NSTEPS; ++s2) { p.lo = s2; p.hi = s2 + 1; hipLaunchKernelGGL((yoco_fwd<0x3FFF>), dim3(256), dim3(512), LDS_BYTES, stream, p); }
#elif N_LAUNCH_CUT
    p.lo = 0; p.hi = NSTEPS;
    hipLaunchKernelGGL((yoco_fwd<0x3FFF>), dim3(256), dim3(512), LDS_BYTES, stream, p);
#else
    static const int siteA[10] = {1, 2, 3, 6, 8, 9, 10, 11, 12, 13}, siteB[9] = {4, 5, 6, 8, 9, 10, 11, 12, 13};
    int s = 0;
#ifndef NSTOP
#define NSTOP 1000
#endif
    p.lo = s; p.hi = s + 1; launch_step_site(0, p, stream); ++s;
    for (int l = 0; l < DEPTH; ++l) { const int n = l < 2 ? 10 : 9; for (int k = 0; k < n; ++k) { p.lo = s; p.hi = s + 1; if (s < NSTOP) launch_step_site(l < 2 ? siteA[k] : siteB[k], p, stream); ++s; } }
    if (NSTOP < NSTEPS) { p.lo = -1; p.hi = -1; launch_step_site(14, p, stream); }
#endif
}
```

```cpp
#include <hip/hip_runtime.h>
#include <cstdio>
#include <cstdint>

#define LAS __attribute__((address_space(3)))
#define GAS __attribute__((address_space(1)))
typedef unsigned short bf16;
typedef unsigned u32x2 __attribute__((ext_vector_type(2)));
typedef float f32x2v __attribute__((ext_vector_type(2)));

constexpr int DM = 2048, NBATCH = 4, SEQ = 4096, NTOK = NBATCH * SEQ, DEPTH = 4;
constexpr int CHUNK = 64, NCHUNK = SEQ / CHUNK;
constexpr int RH = 8, RQK = 256, RV = 512, RQKW = RH * RQK, RVW = RH * RV, RIN = 2 * RQKW + 2 * RVW;
constexpr int AH = 16, AHD = 128, LEFT = 8, NREL = 257;
constexpr int PH = 8, PNK = 128, PE = PNK * PNK, PTOPK = 16;
constexpr float EPS = 1e-6f;

constexpr size_t MiB = 1ull << 20;
constexpr size_t WS_CTL = 0, CTL_BYTES = 1 * MiB;
constexpr size_t WS_ROT = 1 * MiB;
constexpr size_t WS_RS = 6 * MiB;
constexpr size_t WS_WIN = 8 * MiB;
constexpr size_t WS_WOUT = 104 * MiB;
constexpr size_t WS_WKV = 136 * MiB;
constexpr size_t WS_WQ = 152 * MiB;
constexpr size_t WS_WO = 168 * MiB;
constexpr size_t WS_WC = 184 * MiB;
constexpr size_t WS_PU = 216 * MiB;
constexpr size_t WS_PV = 472 * MiB;
constexpr size_t WS_H = 728 * MiB;
constexpr size_t WS_HKV = 792 * MiB;
constexpr size_t WS_Q = 856 * MiB;
constexpr size_t WS_K = 920 * MiB;
constexpr size_t WS_V = 984 * MiB;
constexpr size_t WS_G = 1112 * MiB;
constexpr size_t WS_O = 1240 * MiB;
constexpr size_t WS_KV = 1368 * MiB;
constexpr size_t WS_AO = 1496 * MiB;
constexpr size_t WS_SC = 1560 * MiB;
constexpr size_t WS_IDX = 1688 * MiB;
constexpr size_t WS_WGT = 1696 * MiB;
constexpr size_t WS_SQP = 1704 * MiB;
constexpr size_t WS_RSTD = 1706 * MiB;
constexpr size_t WS_END = 1708 * MiB;

constexpr int LDS_BYTES = 160 * 1024;
constexpr int LDS_MISC = LDS_BYTES - 256;

__device__ __forceinline__ unsigned f2bf(float f) { unsigned u = __builtin_bit_cast(unsigned, f); return (u + 0x7fffu + ((u >> 16) & 1u)) >> 16; }
typedef __bf16 bfx2_t __attribute__((ext_vector_type(2)));
__device__ __forceinline__ unsigned pk2(float lo, float hi) { const f32x2v v = {lo, hi}; return __builtin_bit_cast(unsigned, __builtin_convertvector(v, bfx2_t)); }
__device__ __forceinline__ float bflo(unsigned u) { return __builtin_bit_cast(float, u << 16); }
__device__ __forceinline__ float bfhi(unsigned u) { return __builtin_bit_cast(float, u & 0xffff0000u); }
__device__ __forceinline__ float wave_sum(float v) {
#pragma unroll
    for (int o = 1; o < 64; o <<= 1) v += __shfl_xor(v, o);
    return v;
}
#define VM_WAIT() asm volatile("s_waitcnt vmcnt(0)" ::: "memory")
#define LDS_WAIT() asm volatile("s_waitcnt lgkmcnt(0)" ::: "memory")

#define XB_TMO      128
#define XB_XCNT(j)  (256  + 64 * (j))
#define XB_XSUB(j)  (1280 + 64 * (j))
#define XB_XGEN(j)  (2304 + 64 * (j))
#define XB_TOP      3328
#define XB_TOPGEN   3392
#define XCD_BAR_WORDS 3456
#define XB_SPIN_CAP (1u << 18)

__device__ __forceinline__ unsigned xb_ld(unsigned* p)              { return __hip_atomic_load(p, __ATOMIC_RELAXED, __HIP_MEMORY_SCOPE_AGENT); }
__device__ __forceinline__ unsigned xb_add(unsigned* p, unsigned v) { return __hip_atomic_fetch_add(p, v, __ATOMIC_RELAXED, __HIP_MEMORY_SCOPE_AGENT); }
__device__ __forceinline__ unsigned xb_xcc_id() { return (unsigned)__builtin_amdgcn_s_getreg((3 << 11) | 20) & 0xFu; }
#define XB_SPIN(cond, bar) do { unsigned _sp = 0; while (cond) { __builtin_amdgcn_s_sleep(1); \
    if ((++_sp & 255u) == 0u) { if (xb_ld(&(bar)[XB_TMO])) break; if (_sp > XB_SPIN_CAP) { atomicAdd(&(bar)[XB_TMO], 1u); break; } } } } while (0)

struct XcdBarrier {
    unsigned* bar; unsigned x;
    volatile LAS unsigned* st;
};

__device__ __forceinline__ XcdBarrier xcd_barrier_post(unsigned* bar, volatile LAS unsigned* st) {
    XcdBarrier b; b.bar = bar; b.x = xb_xcc_id(); b.st = st;
    if (threadIdx.x == 0) (void)xb_add(&bar[XB_XCNT(b.x)], 1u);
    return b;
}
__device__ __forceinline__ void xcd_barrier_complete(unsigned* bar, unsigned x, unsigned& nloc, unsigned& nx) {
    const unsigned G = gridDim.x * gridDim.y * gridDim.z;
    unsigned sum, cnt, mine, sp = 0u;
    for (;;) {
        sum = 0u; cnt = 0u; mine = 0u;
#pragma unroll
        for (unsigned j = 0; j < 16; ++j) { const unsigned c = xb_ld(&bar[XB_XCNT(j)]); sum += c; cnt += (c > 0u) ? 1u : 0u; mine = (j == x) ? c : mine; }
        if (sum == G) break;
        __builtin_amdgcn_s_sleep(1);
        if ((++sp & 255u) == 0u) { if (xb_ld(&bar[XB_TMO])) break; if (sp > XB_SPIN_CAP) { atomicAdd(&bar[XB_TMO], 1u); break; } }
    }
    nloc = mine > 0u ? mine : 1u; nx = cnt > 0u ? cnt : 1u;
}

__device__ __forceinline__ void xcd_barrier(const XcdBarrier& b) {
    asm volatile("s_waitcnt vmcnt(0)" ::: "memory");
    __syncthreads();
    if (threadIdx.x == 0) {
        unsigned* bar = b.bar;
        __builtin_amdgcn_s_waitcnt(0);
        unsigned nloc = b.st[0], nx = b.st[1];
        if (nloc == 0u) { xcd_barrier_complete(bar, b.x, nloc, nx); b.st[0] = nloc; b.st[1] = nx; }
        const unsigned old = xb_add(&bar[XB_XSUB(b.x)], 1u);
        const unsigned gen = old / nloc;
        if (old + 1u == (gen + 1u) * nloc) {
            __builtin_amdgcn_fence(__ATOMIC_RELEASE, "agent");
            asm volatile("s_waitcnt vmcnt(0)" ::: "memory");
            const unsigned og = xb_add(&bar[XB_TOP], 1u);
            const unsigned tg = og / nx;
            if (og + 1u == (tg + 1u) * nx) xb_add(&bar[XB_TOPGEN], 1u);
            else XB_SPIN(xb_ld(&bar[XB_TOPGEN]) == tg, bar);
            __builtin_amdgcn_fence(__ATOMIC_ACQUIRE, "agent");
            xb_add(&bar[XB_XGEN(b.x)], 1u);
            asm volatile("s_waitcnt vmcnt(0)" ::: "memory");
        } else {
            XB_SPIN(xb_ld(&bar[XB_XGEN(b.x)]) == gen, bar);
            __builtin_amdgcn_fence(__ATOMIC_ACQUIRE, "agent");
            asm volatile("s_waitcnt vmcnt(0)" ::: "memory");
        }
    }
    __syncthreads();
}

namespace pg8 {
#define PG8_LAS __attribute__((address_space(3)))
typedef unsigned short bf16_t;
typedef short bf16x8 __attribute__((ext_vector_type(8)));
typedef float f32x4 __attribute__((ext_vector_type(4)));
typedef unsigned u32x4 __attribute__((ext_vector_type(4)));
constexpr int BM = 256, BK = 64, HALF = 128, HTB = HALF * BK * 2  , STAGE_BYTES = 8 * HTB, NXCD = 8, WGM = 8;

__host__ __device__ __forceinline__ int lds_byte(int r, int c) { const int st = (r >> 4) * 2 + (c >> 5), rr = r & 15, cc = c & 31, ob = rr * 64 + cc * 2; return st * 1024 + (ob ^ (((ob >> 9) & 1) << 5)); }
__host__ __device__ __forceinline__ void stage_rc(int b, int& R, int& C) { const int st = b / 1024, sb = b % 1024, swz = sb ^ (((sb >> 9) & 1) << 5); R = (st >> 1) * 16 + swz / 64; C = (st & 1) * 32 + (swz % 64) / 2; }
__host__ __device__ __forceinline__ int perm32(int rho) { const int n = rho >> 4, i = rho & 15; return 8 * (i >> 2) + 4 * n + (i & 3); }

struct Unit { int pm, pn; };
struct Gemm { const bf16_t* A; const bf16_t* Bt; int M, N, K; };

struct StaticOrder {
    int nM, nN, nwg, G, c;
    __host__ __device__ void init(int M, int N, int G_, int c_) { nM = M / BM; nN = N / BM; nwg = nM * nN; G = G_; c = c_; }
    __host__ __device__ bool next(int i, Unit& u) const {
        const long L = (long)i * G + c; if (L >= nwg) return false;
        int wgid = (int)L; { const int q = nwg / NXCD, r = nwg % NXCD, xcd = wgid % NXCD, off = wgid / NXCD; wgid = (xcd < r ? xcd * (q + 1) : r * (q + 1) + (xcd - r) * q) + off; }
        const int nig = WGM * nN, gid = wgid / nig, fm = gid * WGM, gsz = (nM - fm) < WGM ? (nM - fm) : WGM;
        u.pm = fm + ((wgid % nig) % gsz); u.pn = (wgid % nig) / gsz; return true;
    }
    __device__ __forceinline__ void a_ready(const Unit&) const {}
    __device__ __forceinline__ void done(const Unit&) const {}
};
struct CountedOrder : StaticOrder {
    const unsigned* ready; unsigned need; unsigned* tmo;
    __device__ __forceinline__ void a_ready(const Unit& u) const {
        if (threadIdx.x < 64) {
            const unsigned long long t0 = __builtin_amdgcn_s_memrealtime(); unsigned polls = 0;
            while ((unsigned)__builtin_amdgcn_readfirstlane(__hip_atomic_load(ready + 64 * u.pm, __ATOMIC_RELAXED, __HIP_MEMORY_SCOPE_AGENT)) < need) {
                if ((++polls & 255u) == 0u && __builtin_amdgcn_readfirstlane(__hip_atomic_load(tmo, __ATOMIC_RELAXED, __HIP_MEMORY_SCOPE_AGENT)) != 0u) break;
                if (__builtin_amdgcn_s_memrealtime() - t0 > 2000000ull) {
                    if (threadIdx.x == 0) { unsigned expect = 0u; __hip_atomic_compare_exchange_strong(tmo + 1, &expect, 0x600u | (unsigned)(u.pm & 0xff), __ATOMIC_RELAXED, __ATOMIC_RELAXED, __HIP_MEMORY_SCOPE_AGENT); __hip_atomic_store(tmo, 1u, __ATOMIC_RELAXED, __HIP_MEMORY_SCOPE_AGENT); }
                    break; }
                __builtin_amdgcn_s_sleep(2); }
            __builtin_amdgcn_fence(__ATOMIC_ACQUIRE, "agent");
            asm volatile("s_waitcnt vmcnt(0)" ::: "memory");
        }
#if !defined(BROKEN_HOOK_NO_BARRIER)
        asm volatile("" ::: "memory"); __builtin_amdgcn_s_barrier(); asm volatile("" ::: "memory");
#endif
    }
};

__device__ __forceinline__ unsigned cvt_pk_bf16(float lo, float hi) { return pk2(lo, hi); }
typedef float f32x2 __attribute__((ext_vector_type(2)));
__device__ __forceinline__ f32x2 gelu_pk(f32x2 v) {
    const f32x2 av = __builtin_elementwise_abs(v), d = av * 0.2316418882f + 1.0f;
    f32x2 t; t.x = __builtin_amdgcn_rcpf(d.x); t.y = __builtin_amdgcn_rcpf(d.y);
    f32x2 q = t * 0.5307027145f + (-0.7265760135f); q = q * t + 0.7107068705f; q = q * t + (-0.142248368f); q = q * t + 0.127414796f; q = q * t;
    const f32x2 s = (v * v) * (-0.72134752044f);
    f32x2 e; e.x = __builtin_amdgcn_exp2f(s.x); e.y = __builtin_amdgcn_exp2f(s.y);
    const f32x2 m = v * (q * e), r = v - m;
    f32x2 o; o.x = v.x < 0.f ? m.x : r.x; o.y = v.y < 0.f ? m.y : r.y; return o;
}


struct EpiF32 {
    static constexpr bool PERM = false, AFTER_DRAIN = false;
    float* C; int ldc;
    __device__ __forceinline__ void operator()(const f32x4 (&acc)[2][2][4][2], const Unit& u, int wr, int wc, int fr, int fq) const {
        const int row0 = u.pm * BM + wr * 64 + fr, col0 = u.pn * BM + wc * 32 + 4 * fq;
#pragma unroll
        for (int ai = 0; ai < 2; ++ai)
#pragma unroll
            for (int m = 0; m < 4; ++m) { float* rowp = C + (size_t)(row0 + ai * HALF + m * 16) * ldc + col0;
#pragma unroll
                for (int bj = 0; bj < 2; ++bj)
#pragma unroll
                    for (int n = 0; n < 2; ++n) *(f32x4*)(rowp + bj * HALF + n * 16) = acc[ai][bj][m][n]; }
    }
};
struct EpiRes {
    static constexpr bool PERM = false, AFTER_DRAIN = false;
    float* X; int ldc; bf16_t* Hn; const float* gn; float* sqp;
    __device__ __forceinline__ void operator()(const f32x4 (&acc)[2][2][4][2], const Unit& u, int wr, int wc, int fr, int fq) const {
        const int row0 = u.pm * BM + wr * 64 + fr, col0 = u.pn * BM + wc * 32 + 4 * fq;
        f32x4 gv[2][2];
#pragma unroll
        for (int bj = 0; bj < 2; ++bj)
#pragma unroll
            for (int n = 0; n < 2; ++n) gv[bj][n] = *(const f32x4*)(gn + col0 + bj * HALF + n * 16);
#pragma unroll
        for (int ai = 0; ai < 2; ++ai) {
            f32x4 old[4][2][2];
#pragma unroll
            for (int m = 0; m < 4; ++m) { const float* rp = X + (size_t)(row0 + ai * HALF + m * 16) * ldc + col0;
#pragma unroll
                for (int bj = 0; bj < 2; ++bj)
#pragma unroll
                    for (int n = 0; n < 2; ++n) old[m][bj][n] = *(const f32x4*)(rp + bj * HALF + n * 16); }
#pragma unroll
            for (int m = 0; m < 4; ++m) { const int r = row0 + ai * HALF + m * 16; float* rowp = X + (size_t)r * ldc + col0; bf16_t* hp = Hn + (size_t)r * ldc + col0;
                float ss = 0.f;
#pragma unroll
                for (int bj = 0; bj < 2; ++bj)
#pragma unroll
                    for (int n = 0; n < 2; ++n) { const f32x4 xn = old[m][bj][n] + acc[ai][bj][m][n]; *(f32x4*)(rowp + bj * HALF + n * 16) = xn;
                        ss += (xn[0] * xn[0] + xn[1] * xn[1]) + (xn[2] * xn[2] + xn[3] * xn[3]);
                        const f32x4 hg = xn * gv[bj][n]; u32x2 hw; hw.x = pk2(hg[0], hg[1]); hw.y = pk2(hg[2], hg[3]); *(u32x2*)(hp + bj * HALF + n * 16) = hw; }
                ss += __shfl_xor(ss, 16); ss += __shfl_xor(ss, 32);
                if (fq == 0) sqp[(size_t)r * 32 + u.pn * 4 + wc] = ss; }
        }
    }
};
struct EpiBf16S {
    static constexpr bool PERM = true, AFTER_DRAIN = false;
    bf16_t* O; int ldc; float scale;
    __device__ __forceinline__ void operator()(const f32x4 (&acc)[2][2][4][2], const Unit& u, int wr, int wc, int fr, int fq) const {
        const int row0 = u.pm * BM + wr * 64 + fr, col0 = u.pn * BM + wc * 32 + 8 * fq;
#pragma unroll
        for (int ai = 0; ai < 2; ++ai)
#pragma unroll
            for (int m = 0; m < 4; ++m) { bf16_t* rowp = O + (size_t)(row0 + ai * HALF + m * 16) * ldc + col0;
#pragma unroll
                for (int bj = 0; bj < 2; ++bj) { const f32x4 v0 = acc[ai][bj][m][0] * scale, v1 = acc[ai][bj][m][1] * scale;
                    u32x4 w; w.x = cvt_pk_bf16(v0[0], v0[1]); w.y = cvt_pk_bf16(v0[2], v0[3]); w.z = cvt_pk_bf16(v1[0], v1[1]); w.w = cvt_pk_bf16(v1[2], v1[3]);
                    *(u32x4*)(rowp + bj * HALF) = w; } }
    }
};
struct EpiProj {
    static constexpr bool PERM = true, AFTER_DRAIN = false;
    bf16_t *Q, *Kp, *V, *G; const float* rot;
    __device__ __forceinline__ void operator()(const f32x4 (&acc)[2][2][4][2], const Unit& u, int wr, int wc, int fr, int fq) const {
        const int row0 = u.pm * BM + wr * 64 + fr, pn = u.pn, dd0 = wc * 32 + 8 * fq;
        if (pn < 16) {
            bf16_t* base = (pn < 8 ? Q : Kp) + (pn & 7) * 256 + dd0; const float sc = pn < 8 ? 1.0f : 0.0625f;
#pragma unroll
            for (int ai = 0; ai < 2; ++ai)
#pragma unroll
                for (int m = 0; m < 4; ++m) { const int r = row0 + ai * HALF + m * 16; const float* rt = rot + (size_t)(r & (4096 - 1)) * 256 + dd0;
                    f32x4 o1[2], o2[2];
#pragma unroll
                    for (int n = 0; n < 2; ++n) { const f32x4 cs = *(const f32x4*)(rt + 4 * n), sn = *(const f32x4*)(rt + 128 + 4 * n); const f32x4 t1 = acc[ai][0][m][n], t2 = acc[ai][1][m][n];
                        o1[n] = (t1 * cs - t2 * sn) * sc; o2[n] = (t1 * sn + t2 * cs) * sc; }
                    u32x4 w1, w2;
                    w1.x = cvt_pk_bf16(o1[0][0], o1[0][1]); w1.y = cvt_pk_bf16(o1[0][2], o1[0][3]); w1.z = cvt_pk_bf16(o1[1][0], o1[1][1]); w1.w = cvt_pk_bf16(o1[1][2], o1[1][3]);
                    w2.x = cvt_pk_bf16(o2[0][0], o2[0][1]); w2.y = cvt_pk_bf16(o2[0][2], o2[0][3]); w2.z = cvt_pk_bf16(o2[1][0], o2[1][1]); w2.w = cvt_pk_bf16(o2[1][2], o2[1][3]);
                    bf16_t* rowp = base + (size_t)r * 2048; *(u32x4*)rowp = w1; *(u32x4*)(rowp + 128) = w2; }
        } else {
            bf16_t* base = (pn < 32 ? V : G) + ((pn - 16) & 15) * 256 + dd0;
#pragma unroll
            for (int ai = 0; ai < 2; ++ai)
#pragma unroll
                for (int m = 0; m < 4; ++m) { bf16_t* rowp = base + (size_t)(row0 + ai * HALF + m * 16) * 4096;
#pragma unroll
                    for (int bj = 0; bj < 2; ++bj) { const f32x4 v0 = acc[ai][bj][m][0], v1 = acc[ai][bj][m][1];
                        u32x4 w; w.x = cvt_pk_bf16(v0[0], v0[1]); w.y = cvt_pk_bf16(v0[2], v0[3]); w.z = cvt_pk_bf16(v1[0], v1[1]); w.w = cvt_pk_bf16(v1[2], v1[3]);
                        *(u32x4*)(rowp + bj * HALF) = w; } }
        }
    }
};
template <class Epi, class Sched, bool STAMP = false>
__device__ __forceinline__ void gemm_phase(PG8_LAS unsigned char* lds, const Gemm g, const Sched& S, const Epi& E, unsigned long long* stamps) {
    int tid_ = threadIdx.x; asm volatile("" : "+v"(tid_));
    const int tid = tid_, wid = __builtin_amdgcn_readfirstlane(tid >> 6), lane = tid & 63, wr = wid >> 2, wc = wid & 3, fr = lane & 15, fq = lane >> 4;
    const int K = g.K, nt = K / BK;
    int ts_lo = 0, ts_hi = 0, nts = 0; const unsigned long long rt_entry = STAMP ? (unsigned long long)wall_clock64() : 0ull;
#define PG8_STAMP() do { if (STAMP && wid == 0 && nts < 64) { const unsigned long long _c = (unsigned long long)clock64(); \
        ts_lo = (lane == nts) ? (int)(unsigned)_c : ts_lo; ts_hi = (lane == nts) ? (int)(unsigned)(_c >> 32) : ts_hi; ++nts; } } while (0)
    PG8_STAMP();
    unsigned voffA[2], voffB[2];
#pragma unroll
    for (int i = 0; i < 2; ++i) { int R, C; stage_rc(tid * 16 + i * 8192, R, C); const int Rb = Epi::PERM ? ((R & ~31) + perm32(R & 31)) : R;
        voffA[i] = (unsigned)(R * K + C) * 2u; voffB[i] = (unsigned)(Rb * K + C) * 2u; }
    const size_t kstep = (size_t)(BK * 2);
    const size_t hstep = (size_t)HALF * K * 2;
    const size_t tstep = 2 * hstep;
    const unsigned ldsw = (unsigned)wid * 1024u;
    const int aoff = lds_byte(wr * 64 + fr, fq * 8), boff = lds_byte(wc * 32 + fr, fq * 8);
#define PG8_SA(b, h) (((b) * 2 + (h)) * HTB)
#define PG8_SB(b, h) ((4 + (b) * 2 + (h)) * HTB)
#define PG8_STAGE(bufoff, gbase, voff) do { _Pragma("unroll") for (int _i = 0; _i < 2; ++_i) \
        __builtin_amdgcn_global_load_lds((const unsigned*)((const char*)(gbase) + (voff)[_i]), (PG8_LAS unsigned*)(lds + (bufoff) + ldsw + _i * 8192), 16, 0, 0); } while (0)
#define PG8_LDA(dst, b, h) do { _Pragma("unroll") for (int m = 0; m < 4; ++m) _Pragma("unroll") for (int k = 0; k < 2; ++k) dst[m][k] = *(const PG8_LAS bf16x8*)(lds + PG8_SA(b, h) + aoff + m * 2048 + k * 1024); } while (0)
#define PG8_LDB(dst, b, h) do { _Pragma("unroll") for (int n = 0; n < 2; ++n) _Pragma("unroll") for (int k = 0; k < 2; ++k) dst[n][k] = *(const PG8_LAS bf16x8*)(lds + PG8_SB(b, h) + boff + n * 2048 + k * 1024); } while (0)
#define PG8_MMA(ai, bj, At, Bt) do { __builtin_amdgcn_s_setprio(1); _Pragma("unroll") for (int m = 0; m < 4; ++m) _Pragma("unroll") for (int n = 0; n < 2; ++n) _Pragma("unroll") for (int k = 0; k < 2; ++k) \
        acc[ai][bj][m][n] = __builtin_amdgcn_mfma_f32_16x16x32_bf16(Bt[n][k], At[m][k], acc[ai][bj][m][n], 0, 0, 0); __builtin_amdgcn_s_setprio(0); } while (0)
#define PG8_WAIT_V(n) asm volatile("s_waitcnt vmcnt(" #n ")" ::: "memory")
#define PG8_WAIT_L(n) asm volatile("s_waitcnt lgkmcnt(" #n ")" ::: "memory")
#define PG8_BAR __builtin_amdgcn_s_barrier()
#define PG8_SCHED __builtin_amdgcn_sched_barrier(0)
    Unit cur, nxt; int ui = 0;
    if (!S.next(0, cur)) return;
    f32x4 acc[2][2][4][2];
#pragma unroll
    for (int a = 0; a < 2; ++a)
#pragma unroll
        for (int b = 0; b < 2; ++b)
#pragma unroll
            for (int m = 0; m < 4; ++m)
#pragma unroll
                for (int n = 0; n < 2; ++n) acc[a][b][m][n] = (f32x4){0.f, 0.f, 0.f, 0.f};
    bf16x8 At[4][2], B0[2][2], B1[2][2];
    const char* cA = (const char*)g.A + (size_t)cur.pm * tstep; const char* cB = (const char*)g.Bt + (size_t)cur.pn * tstep;
    S.a_ready(cur);
    PG8_STAGE(PG8_SB(0, 0), cB, voffB); PG8_STAGE(PG8_SA(0, 0), cA, voffA); PG8_STAGE(PG8_SB(0, 1), cB + hstep, voffB); PG8_STAGE(PG8_SA(0, 1), cA + hstep, voffA);
    if (wr == 1) PG8_BAR;
    PG8_WAIT_V(4); PG8_BAR;
    PG8_STAGE(PG8_SB(1, 0), cB + kstep, voffB); PG8_STAGE(PG8_SA(1, 0), cA + kstep, voffA); PG8_STAGE(PG8_SB(1, 1), cB + hstep + kstep, voffB);
    PG8_WAIT_V(6); PG8_BAR;
    PG8_STAMP();
    for (;;) {
        const bool has_next = S.next(ui + 1, nxt);
        const char* nA = has_next ? (const char*)g.A + (size_t)nxt.pm * tstep : cA; const char* nB = has_next ? (const char*)g.Bt + (size_t)nxt.pn * tstep : cB;
        for (int t = 0; t < nt; t += 2) {
            const bool last = (t == nt - 2);
            const char* a1 = cA + (size_t)(t + 1) * kstep;
            const char* a2 = last ? nA : cA + (size_t)(t + 2) * kstep; const char* b2 = last ? nB : cB + (size_t)(t + 2) * kstep;
            const char* a3 = a2 + kstep; const char* b3 = b2 + kstep;
            if (last && has_next) S.a_ready(nxt);
            PG8_LDB(B0, 0, 0); PG8_SCHED; PG8_LDA(At, 0, 0); PG8_STAGE(PG8_SA(1, 1), a1 + hstep, voffA);
            PG8_WAIT_L(8); PG8_BAR; PG8_WAIT_L(0); PG8_MMA(0, 0, At, B0); PG8_BAR; PG8_SCHED;
            PG8_LDB(B1, 0, 1); PG8_STAGE(PG8_SB(0, 0), b2, voffB);
            PG8_BAR; PG8_WAIT_L(0); PG8_MMA(0, 1, At, B1); PG8_BAR;
            PG8_LDA(At, 0, 1); PG8_STAGE(PG8_SA(0, 0), a2, voffA);
            PG8_BAR; PG8_WAIT_L(0); PG8_MMA(1, 0, At, B0); PG8_BAR; PG8_SCHED;
            PG8_STAGE(PG8_SB(0, 1), b2 + hstep, voffB);
            PG8_WAIT_V(6); PG8_BAR; PG8_MMA(1, 1, At, B1); PG8_BAR;
            PG8_LDB(B0, 1, 0); PG8_SCHED; PG8_LDA(At, 1, 0); PG8_STAGE(PG8_SA(0, 1), a2 + hstep, voffA);
            PG8_WAIT_L(8); PG8_BAR; PG8_WAIT_L(0); PG8_MMA(0, 0, At, B0); PG8_BAR; PG8_SCHED;
            PG8_LDB(B1, 1, 1); PG8_STAGE(PG8_SB(1, 0), b3, voffB);
            PG8_BAR; PG8_WAIT_L(0); PG8_MMA(0, 1, At, B1); PG8_BAR;
            PG8_LDA(At, 1, 1); PG8_STAGE(PG8_SA(1, 0), a3, voffA);
            PG8_BAR; PG8_WAIT_L(0); PG8_MMA(1, 0, At, B0); PG8_BAR; PG8_SCHED;
            PG8_STAGE(PG8_SB(1, 1), b3 + hstep, voffB);
            PG8_WAIT_V(6); PG8_BAR; PG8_MMA(1, 1, At, B1); PG8_BAR;
        }
        PG8_STAMP();
        if constexpr (!Epi::AFTER_DRAIN) { E(acc, cur, wr, wc, fr, fq); S.done(cur); }
        PG8_STAMP();
        if (!has_next) break;
#pragma unroll
        for (int a = 0; a < 2; ++a)
#pragma unroll
            for (int b = 0; b < 2; ++b)
#pragma unroll
                for (int m = 0; m < 4; ++m)
#pragma unroll
                    for (int n = 0; n < 2; ++n) acc[a][b][m][n] = (f32x4){0.f, 0.f, 0.f, 0.f};
        cur = nxt; cA = nA; cB = nB; ++ui;
    }
    PG8_WAIT_V(0);
    if (wr == 0) PG8_BAR;
    PG8_BAR;
    if constexpr (Epi::AFTER_DRAIN) { E.fused(acc, cur, wr, wc, fr, fq, lds, wid, lane); S.done(cur); }
    PG8_STAMP();
    if (STAMP && wid == 0) { stamps[lane] = lane < nts ? (((unsigned long long)(unsigned)ts_hi << 32) | (unsigned)ts_lo) : 0ull;
        if (lane == 62) stamps[62] = rt_entry; if (lane == 63) stamps[63] = (unsigned long long)wall_clock64(); }
#undef PG8_STAMP
#undef PG8_SA
#undef PG8_SB
#undef PG8_STAGE
#undef PG8_LDA
#undef PG8_LDB
#undef PG8_MMA
#undef PG8_WAIT_V
#undef PG8_WAIT_L
#undef PG8_BAR
#undef PG8_SCHED
}
}

using pg8::bf16x8; using pg8::f32x4; using pg8::u32x4;
typedef short s16x4 __attribute__((ext_vector_type(4)));
typedef __bf16 bfx2 __attribute__((ext_vector_type(2)));

struct Params {
    const float *x, *ln_mix, *ln_ffn, *ret_w_in, *ret_w_out, *ret_gn, *kv_norm, *w_kv, *att_w_q, *att_w_o, *att_rel_bias, *peer_w_q, *peer_sub_keys, *peer_u, *peer_v, *ln_final;
    float* out; unsigned char* ws; int lo, hi;
};
struct Ctx { LAS unsigned char* lds; int tid, lane, wave, bx, G, gw, ngw; };

__device__ __forceinline__ float dot2bf(unsigned a, unsigned b, float c) { return __builtin_amdgcn_fdot2_f32_bf16(__builtin_bit_cast(bfx2, a), __builtin_bit_cast(bfx2, b), c, false); }
__device__ __forceinline__ bf16x8 lds128(LAS const unsigned char* p) { return *(LAS const bf16x8*)p; }
__device__ __forceinline__ bf16x8 tr_frag(unsigned a0, unsigned a1) {
    s16x4 lo, hi;
    asm volatile("ds_read_b64_tr_b16 %0, %2\n\tds_read_b64_tr_b16 %1, %3\n\ts_waitcnt lgkmcnt(0)" : "=&v"(lo), "=&v"(hi) : "v"(a0), "v"(a1) : "memory");
    bf16x8 r; r[0] = lo[0]; r[1] = lo[1]; r[2] = lo[2]; r[3] = lo[3]; r[4] = hi[0]; r[5] = hi[1]; r[6] = hi[2]; r[7] = hi[3]; return r;
}
#define MFMA16(a, b, c) __builtin_amdgcn_mfma_f32_16x16x32_bf16((a), (b), (c), 0, 0, 0)

__device__ __forceinline__ void load_row(const float* xrow, int lane, f32x4 (&v)[8]) {
    const f32x4* xr = (const f32x4*)xrow + lane;
#pragma unroll
    for (int j = 0; j < 8; ++j) v[j] = xr[64 * j];
}
__device__ __forceinline__ float row_rstd(const f32x4 (&v)[8]) {
    float s = 0.f;
#pragma unroll
    for (int j = 0; j < 8; ++j) s += (v[j][0] * v[j][0] + v[j][1] * v[j][1]) + (v[j][2] * v[j][2] + v[j][3] * v[j][3]);
    return 1.0f / sqrtf(wave_sum(s) * (1.0f / DM) + EPS);
}
__device__ __forceinline__ void store_norm_bf16(const f32x4 (&v)[8], float rstd, const float* g, bf16* orow, int lane) {
    const f32x4* gr = (const f32x4*)g + lane; u32x2* o8 = (u32x2*)orow + lane;
#pragma unroll
    for (int j = 0; j < 8; ++j) { const f32x4 gv = gr[64 * j]; u32x2 w; w.x = pk2(v[j][0] * rstd * gv[0], v[j][1] * rstd * gv[1]); w.y = pk2(v[j][2] * rstd * gv[2], v[j][3] * rstd * gv[3]); o8[64 * j] = w; }
}
__device__ __forceinline__ void load_g(const float* g, int lane, f32x4 (&gv)[8]) {
    const f32x4* gr = (const f32x4*)g + lane;
#pragma unroll
    for (int j = 0; j < 8; ++j) gv[j] = gr[64 * j];
}
__device__ __forceinline__ void store_norm_bf16_r(const f32x4 (&v)[8], float rstd, const f32x4 (&gv)[8], bf16* orow, int lane) {
    u32x2* o8 = (u32x2*)orow + lane;
#pragma unroll
    for (int j = 0; j < 8; ++j) { u32x2 w; w.x = pk2(v[j][0] * rstd * gv[j][0], v[j][1] * rstd * gv[j][1]); w.y = pk2(v[j][2] * rstd * gv[j][2], v[j][3] * rstd * gv[j][3]); o8[64 * j] = w; }
}
__device__ __forceinline__ unsigned q8pack(float a, float b, float c, float d) {
    const unsigned ua = __builtin_bit_cast(unsigned, a + 12582912.0f), ub = __builtin_bit_cast(unsigned, b + 12582912.0f), uc = __builtin_bit_cast(unsigned, c + 12582912.0f), ud = __builtin_bit_cast(unsigned, d + 12582912.0f);
    return (ua & 255u) | ((ub & 255u) << 8) | ((uc & 255u) << 16) | (ud << 24);
}

__device__ __forceinline__ void p0_transpose_item(const float* W, int K, int N, bf16* WT, LAS float* scr, int item, int lane) {
    const int nblk = N / 32, kb = item / nblk, nb = item % nblk, k0 = 64 * kb, n0 = 32 * nb;
    float tv[32];
#pragma unroll
    for (int i = 0; i < 32; ++i) { const int kk = 2 * i + (lane >> 5); tv[i] = W[(size_t)(k0 + kk) * N + n0 + (lane & 31)]; }
#pragma unroll
    for (int i = 0; i < 32; ++i) { const int kk = 2 * i + (lane >> 5); scr[kk * 33 + (lane & 31)] = tv[i]; }
    LDS_WAIT(); asm volatile("" ::: "memory");
    const int c = lane & 7;
#pragma unroll
    for (int j = 0; j < 4; ++j) { const int n = (lane >> 3) + 8 * j; const LAS float* s = scr + (8 * c) * 33 + n;
        u32x4 o; o.x = pk2(s[0 * 33], s[1 * 33]); o.y = pk2(s[2 * 33], s[3 * 33]); o.z = pk2(s[4 * 33], s[5 * 33]); o.w = pk2(s[6 * 33], s[7 * 33]);
        *(u32x4*)(WT + (size_t)(n0 + n) * K + k0 + 8 * c) = o; }
    LDS_WAIT(); asm volatile("" ::: "memory");
}
__device__ __forceinline__ void p0_fold_tile(const Params& p, const Ctx& c, int tl) {
    const int l = tl >> 9, hp = (tl >> 5) & 15, j0 = (tl & 31) * 64;
    LAS float* As = (LAS float*)c.lds;
    LAS float* Bs = (LAS float*)c.lds + 64 * 132;
    const float* Wq = p.peer_w_q + (size_t)l * DM * DM; const float* sk = p.peer_sub_keys + ((size_t)l * 2 + (hp & 1)) * PNK * 128;
    __syncthreads();
    for (int i = c.tid; i < 64 * 32; i += 512) { const int jj = i >> 5, d4 = i & 31; *(LAS f32x4*)(As + jj * 132 + d4 * 4) = *(const f32x4*)(Wq + (size_t)(j0 + jj) * DM + hp * 128 + d4 * 4); }
    for (int i = c.tid; i < 128 * 32; i += 512) { const int k = i >> 5, d4 = i & 31; *(LAS f32x4*)(Bs + k * 132 + d4 * 4) = *(const f32x4*)(sk + (size_t)k * 128 + d4 * 4); }
    __syncthreads();
    const int tj = c.tid & 15, tk = c.tid >> 4;
    float acc[4][4];
#pragma unroll
    for (int b = 0; b < 4; ++b)
#pragma unroll
        for (int a = 0; a < 4; ++a) acc[b][a] = 0.f;
    for (int d4 = 0; d4 < 32; ++d4) {
        f32x4 av[4], bv[4];
#pragma unroll
        for (int a = 0; a < 4; ++a) av[a] = *(LAS const f32x4*)(As + (tj + 16 * a) * 132 + d4 * 4);
#pragma unroll
        for (int b = 0; b < 4; ++b) bv[b] = *(LAS const f32x4*)(Bs + (tk * 4 + b) * 132 + d4 * 4);
#pragma unroll
        for (int b = 0; b < 4; ++b)
#pragma unroll
            for (int a = 0; a < 4; ++a) acc[b][a] += (av[a][0] * bv[b][0] + av[a][1] * bv[b][1]) + (av[a][2] * bv[b][2] + av[a][3] * bv[b][3]);
    }
    bf16* WcT = (bf16*)(p.ws + WS_WC) + (size_t)l * DM * DM;
#pragma unroll
    for (int b = 0; b < 4; ++b)
#pragma unroll
        for (int a = 0; a < 4; ++a) WcT[(size_t)(hp * 128 + tk * 4 + b) * DM + j0 + tj + 16 * a] = (bf16)f2bf(acc[b][a]);
}
__device__ __forceinline__ void p0_prologue(const Params& p, const Ctx& c) {
#ifndef PROREP
#define PROREP 0
#endif
    const bool fold_last = (c.bx & 1) != 0;
    if (!fold_last) {
    for (int tl = c.bx; tl < DEPTH * 16 * 32; tl += c.G) p0_fold_tile(p, c, tl);
    __syncthreads();
    }
    for (int rp_ = ((PROREP >> 1) & 1) ? 0 : 1; rp_ < 2; ++rp_)
    {
        LAS float* scr = (LAS float*)(c.lds + c.wave * 16384);
        constexpr int I_IN = (DM / 64) * (RIN / 32), I_OUT = (RVW / 64) * (DM / 32), I_KV = (DM / 64) * (2 * DM / 32), I_SQ = (DM / 64) * (DM / 32);
        constexpr int NITEMS = 2 * I_IN + 2 * I_OUT + I_KV + 4 * I_SQ;
        for (int it = c.gw; it < NITEMS; it += c.ngw) {
            int r = it;
            if (r < 2 * I_IN) { const int l = r / I_IN; p0_transpose_item(p.ret_w_in + (size_t)l * DM * RIN, DM, RIN, (bf16*)(p.ws + WS_WIN) + (size_t)l * RIN * DM, scr, r % I_IN, c.lane); continue; } r -= 2 * I_IN;
            if (r < 2 * I_OUT) { const int l = r / I_OUT; p0_transpose_item(p.ret_w_out + (size_t)l * RVW * DM, RVW, DM, (bf16*)(p.ws + WS_WOUT) + (size_t)l * DM * RVW, scr, r % I_OUT, c.lane); continue; } r -= 2 * I_OUT;
            if (r < I_KV) { p0_transpose_item(p.w_kv, DM, 2 * DM, (bf16*)(p.ws + WS_WKV), scr, r, c.lane); continue; } r -= I_KV;
            if (r < 2 * I_SQ) { const int l = r / I_SQ; p0_transpose_item(p.att_w_q + (size_t)l * DM * DM, DM, DM, (bf16*)(p.ws + WS_WQ) + (size_t)l * DM * DM, scr, r % I_SQ, c.lane); continue; } r -= 2 * I_SQ;
            { const int l = r / I_SQ; p0_transpose_item(p.att_w_o + (size_t)l * DM * DM, DM, DM, (bf16*)(p.ws + WS_WO) + (size_t)l * DM * DM, scr, r % I_SQ, c.lane); }
        }
    }
    for (int rp_ = ((PROREP >> 2) & 1) ? 0 : 1; rp_ < 2; ++rp_)
    {
        float* rs = (float*)(p.ws + WS_RS);
        for (int row = c.gw; row < 2 * DEPTH * PE; row += c.ngw) {
            const int which = row >= DEPTH * PE, r = row - which * DEPTH * PE;
            f32x4 v[8]; load_row((which ? p.peer_v : p.peer_u) + (size_t)r * DM, c.lane, v);
            float am = 0.f;
#pragma unroll
            for (int j = 0; j < 8; ++j) am = fmaxf(fmaxf(am, fmaxf(fabsf(v[j][0]), fabsf(v[j][1]))), fmaxf(fabsf(v[j][2]), fabsf(v[j][3])));
#pragma unroll
            for (int o = 1; o < 64; o <<= 1) am = fmaxf(am, __shfl_xor(am, o));
            int e = (int)((__builtin_bit_cast(unsigned, am) >> 23) & 0xffu) - 127; if (am == 0.f) e = 7;
            int k = 7 - e; k = k < -100 ? -100 : (k > 100 ? 100 : k);
            const float sc = __builtin_bit_cast(float, (unsigned)(k + 127) << 23), rsc = __builtin_bit_cast(float, (unsigned)(127 - k) << 23);
            const int lyr = r / PE, re = r % PE;
            unsigned char* dstb = p.ws + (which ? WS_PV : WS_PU) + (size_t)lyr * PE * DM + (size_t)re * 128;
            if (which) {
#pragma unroll
                for (int j = 0; j < 8; ++j) { int w = 0; w = __builtin_amdgcn_cvt_pk_fp8_f32(v[j][0] * sc, v[j][1] * sc, w, false); w = __builtin_amdgcn_cvt_pk_fp8_f32(v[j][2] * sc, v[j][3] * sc, w, true); { const int col = 4 * c.lane + 256 * j; *(unsigned*)(dstb + (size_t)(col >> 7) * PE * 128 + (col & 127)) = (unsigned)w; } }
                if (c.lane == 0) rs[row] = rsc;
            } else {
                const float s8 = am > 0.f ? 127.0f / am : 0.f;
#pragma unroll
                for (int j = 0; j < 8; ++j) { const unsigned w = q8pack(v[j][0] * s8, v[j][1] * s8, v[j][2] * s8, v[j][3] * s8); const int col = 4 * c.lane + 256 * j; *(unsigned*)(dstb + (size_t)(col >> 7) * PE * 128 + (col & 127)) = w; }
                if (c.lane == 0) rs[row] = am * (1.0f / 127.0f);
            }
        }
    }
    for (int rp_ = ((PROREP >> 3) & 1) ? 0 : 1; rp_ < 2; ++rp_)
    {
        float* rot = (float*)(p.ws + WS_ROT);
        for (int i = c.bx * 512 + c.tid; i < SEQ * 128; i += c.G * 512) { const int pos = i >> 7, d = i & 127;
            const float inv = (float)(1.0 / pow(10000.0, (double)d / 128.0)); const float ang = (float)pos * inv;
            rot[(size_t)pos * 256 + d] = (float)cos((double)ang); rot[(size_t)pos * 256 + 128 + d] = (float)sin((double)ang); }
    }
    for (int rp_ = ((PROREP >> 4) & 1) ? 0 : 1; rp_ < 2; ++rp_)
    { f32x4 gv[8]; load_g(p.ln_mix, c.lane, gv);
      for (int m = c.gw; m < NTOK; m += c.ngw) {
        f32x4 v[8]; load_row(p.x + (size_t)m * DM, c.lane, v);
        f32x4* xo = (f32x4*)(p.out + (size_t)m * DM) + c.lane;
#pragma unroll
        for (int j = 0; j < 8; ++j) xo[64 * j] = v[j];
        store_norm_bf16_r(v, row_rstd(v), gv, (bf16*)(p.ws + WS_H) + (size_t)m * DM, c.lane);
      } }
    if (fold_last) {
    __syncthreads();
    for (int tl = c.bx; tl < DEPTH * 16 * 32; tl += c.G) p0_fold_tile(p, c, tl);
    __syncthreads();
    }
}

constexpr int RS_QS = 0, RS_KS = 33792, RS_VS = 67584, RS_VZ = 76800, RS_PS = 86016, RS_RS = 95232, RS_END = 129024, QK_STR = 528, V_STR = 144;
__device__ __forceinline__ void ret_scan_unit(const Ctx& c, const bf16* Qg, const bf16* Kg, const bf16* Vg, bf16* Og, int unit) {
    const int xg = unit & 7, slot = unit >> 3, pair = xg * 4 + (slot >> 3), es = slot & 7, b = pair >> 3, h = pair & 7;
    const int tid = c.tid, lane = c.lane, w = c.wave, fr = lane & 15, fq = lane >> 4, tq = (lane & 15) >> 2, tp = lane & 3;
    LAS unsigned char* lds = c.lds;
    const float lgam = log1pf(-exp2f(-5.0f - (float)h));
    const float cdec = expf(lgam * 64.0f);
    const int lrow = tid >> 3, lch = tid & 7;
    const size_t tok0 = (size_t)b * SEQ;
    const bf16* qrow = Qg + (tok0 + lrow) * RQKW + h * RQK + lch * 8;
    const bf16* krow = Kg + (tok0 + lrow) * RQKW + h * RQK + lch * 8;
    const bf16* vrow = Vg + (tok0 + lrow) * RVW + h * RV + es * 64 + lch * 8;
    const float zeta = expf(lgam * (float)(63 - lrow));
    u32x4 pq[4], pk[4], pv;
#pragma unroll
    for (int cc = 0; cc < 4; ++cc) { pq[cc] = *(const u32x4*)(qrow + cc * 64); pk[cc] = *(const u32x4*)(krow + cc * 64); }
    pv = *(const u32x4*)vrow;
    __syncthreads();
    for (int i = tid; i < (RS_END - RS_RS) / 16; i += 512) *(LAS u32x4*)(lds + RS_RS + i * 16) = (u32x4){0u, 0u, 0u, 0u};
    f32x4 Racc[2][4];
#pragma unroll
    for (int x = 0; x < 2; ++x)
#pragma unroll
        for (int y = 0; y < 4; ++y) Racc[x][y] = (f32x4){0.f, 0.f, 0.f, 0.f};
    const int jt = w & 3, it0 = 2 * (w >> 2);
    const int it = w & 3, et0 = 2 * (w >> 2);
    float xi[4];
#pragma unroll
    for (int r = 0; r < 4; ++r) xi[r] = expf(lgam * (float)(16 * it + 4 * fq + r + 1));
    const unsigned ldsb = (unsigned)(size_t)lds;
    float dmask[2][4];
#pragma unroll
    for (int x = 0; x < 2; ++x)
#pragma unroll
        for (int r = 0; r < 4; ++r) { const int i = 16 * (it0 + x) + fr, j = 16 * jt + 4 * fq + r; dmask[x][r] = (i >= j) ? expf(lgam * (float)(i - j)) : 0.f; }
    asm volatile("" : "+v"(dmask[0][0]), "+v"(dmask[0][1]), "+v"(dmask[0][2]), "+v"(dmask[0][3]), "+v"(dmask[1][0]), "+v"(dmask[1][1]), "+v"(dmask[1][2]), "+v"(dmask[1][3]));
    for (int n = 0; n < NCHUNK; ++n) {
        __syncthreads();
#pragma unroll
        for (int cc = 0; cc < 4; ++cc) { *(LAS u32x4*)(lds + RS_QS + lrow * QK_STR + (lch + 8 * cc) * 16) = pq[cc]; *(LAS u32x4*)(lds + RS_KS + lrow * QK_STR + (lch + 8 * cc) * 16) = pk[cc]; }
        *(LAS u32x4*)(lds + RS_VS + lrow * V_STR + lch * 16) = pv;
        { u32x4 z; z.x = pk2(bflo(pv.x) * zeta, bfhi(pv.x) * zeta); z.y = pk2(bflo(pv.y) * zeta, bfhi(pv.y) * zeta); z.z = pk2(bflo(pv.z) * zeta, bfhi(pv.z) * zeta); z.w = pk2(bflo(pv.w) * zeta, bfhi(pv.w) * zeta);
          *(LAS u32x4*)(lds + RS_VZ + lrow * V_STR + lch * 16) = z; }
        __syncthreads();
        if (n + 1 < NCHUNK) {
            const size_t adv = (size_t)(n + 1) * CHUNK;
#pragma unroll
            for (int cc = 0; cc < 4; ++cc) { pq[cc] = *(const u32x4*)(qrow + adv * RQKW + cc * 64); pk[cc] = *(const u32x4*)(krow + adv * RQKW + cc * 64); }
            pv = *(const u32x4*)(vrow + adv * RVW);
        }
        {
            f32x4 s0 = (f32x4){0.f, 0.f, 0.f, 0.f}, s1 = s0;
#pragma unroll
            for (int kh = 0; kh < 2; ++kh) {
                bf16x8 fa[4], fb0[4], fb1[4];
#pragma unroll
                for (int k4 = 0; k4 < 4; ++k4) { const int ks = 4 * kh + k4;
                    fa[k4] = lds128(lds + RS_KS + (16 * jt + fr) * QK_STR + (4 * ks + fq) * 16);
                    fb0[k4] = lds128(lds + RS_QS + (16 * it0 + fr) * QK_STR + (4 * ks + fq) * 16);
                    fb1[k4] = lds128(lds + RS_QS + (16 * (it0 + 1) + fr) * QK_STR + (4 * ks + fq) * 16); }
                __builtin_amdgcn_sched_barrier(0);
#pragma unroll
                for (int k4 = 0; k4 < 4; ++k4) { s0 = MFMA16(fa[k4], fb0[k4], s0); s1 = MFMA16(fa[k4], fb1[k4], s1); }
            }
#pragma unroll
            for (int x = 0; x < 2; ++x) { const f32x4 s = x ? s1 : s0; const int i = 16 * (it0 + x) + fr; float pr[4];
#pragma unroll
                for (int r = 0; r < 4; ++r) pr[r] = s[r] * dmask[x][r];
                u32x2 pw; pw.x = pk2(pr[0], pr[1]); pw.y = pk2(pr[2], pr[3]);
                *(LAS u32x2*)(lds + RS_PS + i * V_STR + (16 * jt + 4 * fq) * 2) = pw; }
        }
        f32x4 o0 = (f32x4){0.f, 0.f, 0.f, 0.f}, o1 = o0;
        {
#pragma unroll
            for (int kh = 0; kh < 2; ++kh) {
                bf16x8 fa[4], fb0[4], fb1[4];
#pragma unroll
                for (int k4 = 0; k4 < 4; ++k4) { const int ks = 4 * kh + k4;
                    fa[k4] = lds128(lds + RS_QS + (16 * it + fr) * QK_STR + (4 * ks + fq) * 16);
                    fb0[k4] = lds128(lds + RS_RS + (16 * et0 + fr) * QK_STR + (4 * ks + fq) * 16);
                    fb1[k4] = lds128(lds + RS_RS + (16 * (et0 + 1) + fr) * QK_STR + (4 * ks + fq) * 16); }
                __builtin_amdgcn_sched_barrier(0);
#pragma unroll
                for (int k4 = 0; k4 < 4; ++k4) { o0 = MFMA16(fa[k4], fb0[k4], o0); o1 = MFMA16(fa[k4], fb1[k4], o1); }
            }
        }
#pragma unroll
        for (int r = 0; r < 4; ++r) { o0[r] *= xi[r]; o1[r] *= xi[r]; }
        __syncthreads();
#pragma unroll
        for (int ks = 0; ks < 2; ++ks) {
            const bf16x8 a = lds128(lds + RS_PS + (16 * it + fr) * V_STR + (4 * ks + fq) * 16);
            const unsigned va = ldsb + RS_VS + (32 * ks + 8 * fq + tq) * V_STR + 8 * tp;
            const bf16x8 b0 = tr_frag(va + 32 * et0, va + 4 * V_STR + 32 * et0);
            const bf16x8 b1 = tr_frag(va + 32 * (et0 + 1), va + 4 * V_STR + 32 * (et0 + 1));
            __builtin_amdgcn_sched_barrier(0);
            o0 = MFMA16(a, b0, o0); o1 = MFMA16(a, b1, o1);
        }
        {
            bf16* op = Og + (tok0 + (size_t)n * CHUNK + 16 * it + 4 * fq) * RVW + h * RV + es * 64 + 16 * et0 + fr;
#pragma unroll
            for (int r = 0; r < 4; ++r) { op[(size_t)r * RVW] = (bf16)f2bf(o0[r]); op[(size_t)r * RVW + 16] = (bf16)f2bf(o1[r]); }
        }
#pragma unroll
        for (int x = 0; x < 2; ++x)
#pragma unroll
            for (int y = 0; y < 4; ++y) Racc[x][y] *= cdec;
#pragma unroll
        for (int ks = 0; ks < 2; ++ks) {
            const unsigned ka = ldsb + RS_KS + (32 * ks + 8 * fq + tq) * QK_STR + 8 * tp;
            const unsigned za = ldsb + RS_VZ + (32 * ks + 8 * fq + tq) * V_STR + 8 * tp;
            bf16x8 ak[2], bz[4];
#pragma unroll
            for (int x = 0; x < 2; ++x) ak[x] = tr_frag(ka + 32 * (2 * w + x), ka + 4 * QK_STR + 32 * (2 * w + x));
#pragma unroll
            for (int y = 0; y < 4; ++y) bz[y] = tr_frag(za + 32 * y, za + 4 * V_STR + 32 * y);
            __builtin_amdgcn_sched_barrier(0);
#pragma unroll
            for (int x = 0; x < 2; ++x)
#pragma unroll
                for (int y = 0; y < 4; ++y) Racc[x][y] = MFMA16(ak[x], bz[y], Racc[x][y]);
        }
#pragma unroll
        for (int x = 0; x < 2; ++x)
#pragma unroll
            for (int y = 0; y < 4; ++y) { u32x2 rw; rw.x = pk2(Racc[x][y][0], Racc[x][y][1]); rw.y = pk2(Racc[x][y][2], Racc[x][y][3]);
                *(LAS u32x2*)(lds + RS_RS + (16 * y + fr) * QK_STR + (16 * (2 * w + x) + 4 * fq) * 2) = rw; }
    }
}

template <int CTRL> __device__ __forceinline__ float dpp_f(float x) { return __builtin_bit_cast(float, __builtin_amdgcn_mov_dpp(__builtin_bit_cast(int, x), CTRL, 0xF, 0xF, true)); }
__device__ __forceinline__ float sum8(float x) { x += dpp_f<0xB1>(x); x += dpp_f<0x4E>(x); x += dpp_f<0x141>(x); return x; }
__device__ __forceinline__ void ret_gate_phase(const Ctx& c, const bf16* Og, bf16* Gg, const float* gn, bf16* Zout = nullptr) {
    const int col0 = 512 * (c.lane >> 3) + 8 * (c.lane & 7);
    f32x4 gw[16];
#pragma unroll
    for (int j = 0; j < 8; ++j) { gw[2 * j] = *(const f32x4*)(gn + col0 + 64 * j); gw[2 * j + 1] = *(const f32x4*)(gn + col0 + 64 * j + 4); }
    u32x4 ovn[8];
    if (c.gw < NTOK) { const bf16* orow = Og + (size_t)c.gw * RVW + col0;
#pragma unroll
        for (int j = 0; j < 8; ++j) ovn[j] = *(const u32x4*)(orow + 64 * j); }
    for (int m = c.gw; m < NTOK; m += c.ngw) {
        u32x4 gv[8], ov[8];
        { const bf16* grow = Gg + (size_t)m * RVW + col0;
#pragma unroll
          for (int j = 0; j < 8; ++j) { gv[j] = *(const u32x4*)(grow + 64 * j); ov[j] = ovn[j]; } }
        { const int mn = m + c.ngw < NTOK ? m + c.ngw : m; const bf16* orow = Og + (size_t)mn * RVW + col0;
#pragma unroll
          for (int j = 0; j < 8; ++j) ovn[j] = *(const u32x4*)(orow + 64 * j); }
        float s1 = 0.f;
#pragma unroll
        for (int j = 0; j < 8; ++j) { const u32x4 t = ov[j];
            s1 += ((bflo(t.x) + bfhi(t.x)) + (bflo(t.y) + bfhi(t.y))) + ((bflo(t.z) + bfhi(t.z)) + (bflo(t.w) + bfhi(t.w))); }
        const float mu = sum8(s1) * (1.0f / RV);
        asm volatile("" : "+v"(ov[0]), "+v"(ov[1]), "+v"(ov[2]), "+v"(ov[3]), "+v"(ov[4]), "+v"(ov[5]), "+v"(ov[6]), "+v"(ov[7]));
        float s2 = 0.f;
#pragma unroll
        for (int j = 0; j < 8; ++j) { const u32x4 t = ov[j];
            const float d[8] = {bflo(t.x) - mu, bfhi(t.x) - mu, bflo(t.y) - mu, bfhi(t.y) - mu, bflo(t.z) - mu, bfhi(t.z) - mu, bflo(t.w) - mu, bfhi(t.w) - mu};
            float q = 0.f;
#pragma unroll
            for (int k = 0; k < 8; ++k) q += d[k] * d[k];
            s2 += q; }
        const float rstd = 1.0f / sqrtf(sum8(s2) * (1.0f / RV) + EPS);
        asm volatile("" : "+v"(ov[0]), "+v"(ov[1]), "+v"(ov[2]), "+v"(ov[3]), "+v"(ov[4]), "+v"(ov[5]), "+v"(ov[6]), "+v"(ov[7]));
        bf16* zrow = (Zout ? Zout : Gg) + (size_t)m * RVW + col0;
#pragma unroll
        for (int j = 0; j < 8; ++j) {
            const float gg[8] = {gw[2 * j][0], gw[2 * j][1], gw[2 * j][2], gw[2 * j][3], gw[2 * j + 1][0], gw[2 * j + 1][1], gw[2 * j + 1][2], gw[2 * j + 1][3]};
            const u32x4 t = gv[j], u = ov[j];
            const float g[8] = {bflo(t.x), bfhi(t.x), bflo(t.y), bfhi(t.y), bflo(t.z), bfhi(t.z), bflo(t.w), bfhi(t.w)};
            const float o[8] = {bflo(u.x), bfhi(u.x), bflo(u.y), bfhi(u.y), bflo(u.z), bfhi(u.z), bflo(u.w), bfhi(u.w)};
            float z[8];
#pragma unroll
            for (int k = 0; k < 8; ++k) { const float y = (o[k] - mu) * rstd * gg[k]; z[k] = g[k] * __builtin_amdgcn_rcpf(1.0f + __builtin_amdgcn_exp2f(-1.4426950408889634f * g[k])) * y; }
            u32x4 zw; zw.x = pk2(z[0], z[1]); zw.y = pk2(z[2], z[3]); zw.z = pk2(z[4], z[5]); zw.w = pk2(z[6], z[7]);
            *(u32x4*)(zrow + 64 * j) = zw;
        }
    }
}

__device__ __forceinline__ void rms_phase(const Ctx& c, const float* X, const float* g, bf16* H) {
    for (int m = c.gw; m < NTOK; m += c.ngw) { f32x4 v[8]; load_row(X + (size_t)m * DM, c.lane, v); store_norm_bf16(v, row_rstd(v), g, H + (size_t)m * DM, c.lane); }
}

__device__ __forceinline__ int fkey(float f) { const int i = __builtin_bit_cast(int, f); return i ^ ((i >> 31) & 0x7fffffff); }
__device__ __forceinline__ float kval(int k) { return __builtin_bit_cast(float, k ^ ((k >> 31) & 0x7fffffff)); }
__device__ __forceinline__ int med3i(int a, int b, int c) { int r; asm("v_med3_i32 %0, %1, %2, %3" : "=v"(r) : "v"(a), "v"(b), "v"(c)); return r; }
#define INS16(L, key) do { const int _k = (key); _Pragma("unroll") for (int _q = 15; _q >= 1; --_q) L[_q] = med3i(L[_q - 1], L[_q], _k); L[0] = max(L[0], _k); } while (0)
constexpr int TK_LIST = 544, TK_HALF = 272, TK_KEYS = 256 * TK_LIST;
__device__ __forceinline__ void peer_topk_phase(const Ctx& c, const float* SC, int* IDX, float* WGT, const float* SQP, float* RSTD) {
    LAS unsigned char* lds = c.lds;
    u32x4 pre[16];
    if (c.bx < NTOK / 16) { const u32x4* src = (const u32x4*)(SC + (size_t)c.bx * 16 * DM);
#pragma unroll
        for (int i = 0; i < 16; ++i) pre[i] = src[c.tid + 512 * i]; }
    for (int tile = c.bx; tile < NTOK / 16; tile += c.G) {
        __syncthreads();
#pragma unroll
        for (int i = 0; i < 16; ++i) { const int g = c.tid + 512 * i; *(LAS u32x4*)(lds + (g >> 5) * TK_LIST + ((g >> 4) & 1) * TK_HALF + (g & 15) * 16) = pre[i]; }
        if (tile + c.G < NTOK / 16) { const u32x4* src = (const u32x4*)(SC + (size_t)(tile + c.G) * 16 * DM);
#pragma unroll
            for (int i = 0; i < 16; ++i) pre[i] = src[c.tid + 512 * i]; }
        __syncthreads();
        {
            const int lst = c.tid >> 1, hf = c.tid & 1;
            int L[16];
#pragma unroll
            for (int q = 0; q < 16; ++q) L[q] = (int)0x80000000;
            LAS unsigned char* lp = lds + lst * TK_LIST + hf * TK_HALF;
#pragma unroll 2
            for (int g = 0; g < 16; ++g) { const f32x4 v = *(LAS const f32x4*)(lp + g * 16);
#pragma unroll
                for (int e = 0; e < 4; ++e) INS16(L, (fkey(v[e]) & ~127) | (hf * 64 + g * 4 + e)); }
            if (hf) {
#pragma unroll
                for (int q = 0; q < 16; ++q) ((LAS int*)lp)[q] = L[q]; }
            __syncthreads();
            if (!hf) { LAS const int* op = (LAS const int*)(lp + TK_HALF);
#pragma unroll
                for (int q = 0; q < 16; ++q) INS16(L, op[q]);
                LAS int* kp = (LAS int*)(lds + TK_KEYS) + lst * 16;
#pragma unroll
                for (int q = 0; q < 16; ++q) kp[q] = L[q]; }
        }
        __syncthreads();
        if (c.tid < 128) {
            LAS const int* k1 = (LAS const int*)(lds + TK_KEYS) + (c.tid * 2) * 16; LAS const int* k2 = k1 + 16;
            float v1[16], v2[16];
#pragma unroll
            for (int q = 0; q < 16; ++q) { v1[q] = kval(k1[q] & ~127); v2[q] = kval(k2[q] & ~127); }
            int L[16];
#pragma unroll
            for (int q = 0; q < 16; ++q) L[q] = (fkey(v1[0] + v2[q]) & ~255) | q;
#pragma unroll
            for (int i = 1; i < 16; ++i)
#pragma unroll
                for (int j = 0; j < 16; ++j) if ((i + 1) * (j + 1) <= 16) INS16(L, (fkey(v1[i] + v2[j]) & ~255) | (i * 16 + j));
            const int tt = c.tid >> 3, hh = c.tid & 7; const size_t ob0 = ((size_t)tile * 16 + tt) * 128;
            float rstd; { const f32x4* sp = (const f32x4*)(SQP + ((size_t)tile * 16 + tt) * 32); f32x4 a4 = sp[0];
#pragma unroll
              for (int q = 1; q < 8; ++q) a4 += sp[q];
              rstd = 1.0f / sqrtf(((a4[0] + a4[1]) + (a4[2] + a4[3])) * (1.0f / DM) + EPS); }
            if (hh == 0) RSTD[(size_t)tile * 16 + tt] = rstd;
            const float m0 = kval(L[0] & ~255); float ex[16], se = 0.f;
#pragma unroll
            for (int q = 0; q < 16; ++q) { ex[q] = __builtin_amdgcn_exp2f((kval(L[q] & ~255) - m0) * (rstd * 1.4426950408889634f)); se += ex[q]; }
            const float inv = 1.0f / se;
#pragma unroll
            for (int q = 0; q < 16; ++q) { const int cid = L[q] & 255; const int es = hh * 16 + q, pos = (es & 7) * 16 + (es >> 3);
                IDX[ob0 + pos] = (k1[cid >> 4] & 127) * PNK + (k2[cid & 15] & 127); WGT[ob0 + pos] = ex[q] * inv; }
        }
    }
}

template <int NSTAGE> __device__ __forceinline__ void xreduce_stage(float (&p)[64], int lane) {
    constexpr int S = NSTAGE;
    if constexpr (S == 32) {
#pragma unroll
        for (int k = 0; k < S; ++k) { float xa = p[k], xb = p[k + S]; asm("s_nop 1\n\tv_permlane32_swap_b32 %0, %1" : "+v"(xa), "+v"(xb)); p[k] = xa + xb; }
    } else if constexpr (S == 16) {
#pragma unroll
        for (int k = 0; k < S; ++k) { float xa = p[k], xb = p[k + S]; asm("s_nop 1\n\tv_permlane16_swap_b32 %0, %1" : "+v"(xa), "+v"(xb)); p[k] = xa + xb; }
    } else {
        const bool up = (lane & S) != 0;
#pragma unroll
        for (int k = 0; k < S; ++k) { const float keep = up ? p[k + S] : p[k], send = up ? p[k] : p[k + S];
            p[k] = keep + __builtin_bit_cast(float, __builtin_amdgcn_ds_swizzle(__builtin_bit_cast(int, send), (S << 10) | 0x1F)); }
    }
}
__device__ __forceinline__ float gelu_erf(float v) { return 0.5f * v * (1.0f + erff(v * 0.70710678118654752f)); }
typedef float f32x2 __attribute__((ext_vector_type(2)));
__device__ __forceinline__ float peer_dots64(const unsigned char* U, int idxv, const f32x2 (&h2)[16], int lane) {
    float p[64];
#pragma unroll
    for (int e = 0; e < 64; ++e) {
        const int row = __builtin_amdgcn_readlane(idxv, e);
        const u32x4* up = (const u32x4*)(U + (size_t)row * DM) + lane;
        f32x2 a = {0.f, 0.f};
#pragma unroll
        for (int cc = 0; cc < 2; ++cc) { const u32x4 u = up[64 * cc];
#pragma unroll
            for (int q = 0; q < 4; ++q) { const int w = (int)u[q];
                a = __builtin_elementwise_fma(__builtin_amdgcn_cvt_pk_f32_fp8(w, false), h2[8 * cc + 2 * q], a);
                a = __builtin_elementwise_fma(__builtin_amdgcn_cvt_pk_f32_fp8(w, true), h2[8 * cc + 2 * q + 1], a); } }
        p[e] = a.x + a.y;
    }
    xreduce_stage<32>(p, lane); xreduce_stage<16>(p, lane); xreduce_stage<8>(p, lane); xreduce_stage<4>(p, lane); xreduce_stage<2>(p, lane); xreduce_stage<1>(p, lane);
    return p[0];
}
__device__ __forceinline__ void peer_accum64(const unsigned char* Vt, int idxv, float av, f32x2 (&acc)[16], int lane) {
#pragma unroll 8
    for (int e = 0; e < 64; ++e) {
        const int row = __builtin_amdgcn_readlane(idxv, e); const float a = __builtin_bit_cast(float, __builtin_amdgcn_readlane(__builtin_bit_cast(int, av), e));
        const f32x2 a2 = {a, a};
        const u32x4* vp = (const u32x4*)(Vt + (size_t)row * DM) + lane;
#pragma unroll
        for (int cc = 0; cc < 2; ++cc) { const u32x4 v = vp[64 * cc];
#pragma unroll
            for (int q = 0; q < 4; ++q) { const int w = (int)v[q];
                acc[8 * cc + 2 * q] = __builtin_elementwise_fma(__builtin_amdgcn_cvt_pk_f32_fp8(w, false), a2, acc[8 * cc + 2 * q]);
                acc[8 * cc + 2 * q + 1] = __builtin_elementwise_fma(__builtin_amdgcn_cvt_pk_f32_fp8(w, true), a2, acc[8 * cc + 2 * q + 1]); } }
    }
}
constexpr int GD = 8;
#define PG_ISSUE(vv) do { const int row_ = __builtin_amdgcn_readlane((((vv) >> 6) & 1) ? i1 : i0, (vv) & 63); \
        const u32x4* bp_ = (const u32x4*)((((vv) >> 6) < 2 ? U : Vt) + (size_t)row_ * DM) + lane; ring[(vv) % GD][0] = bp_[0]; ring[(vv) % GD][1] = bp_[64]; } while (0)
template <int SEG> __device__ __forceinline__ void peer_seg(const unsigned char* U, const unsigned char* Vt, int i0, int i1, u32x4 (&ring)[GD][2], float (&p)[64], float aseg, const f32x2 (&h2)[16], f32x2 (&acc)[16], int lane) {
#pragma unroll
    for (int e = 0; e < 64; ++e) {
        const int v = SEG * 64 + e;
        const u32x4 r0 = ring[v % GD][0], r1 = ring[v % GD][1];
        if (SEG < 2) {
            f32x2 a = {0.f, 0.f};
#pragma unroll
            for (int q = 0; q < 4; ++q) { const int wa = (int)r0[q], wb = (int)r1[q];
                a = __builtin_elementwise_fma(__builtin_amdgcn_cvt_pk_f32_fp8(wa, false), h2[2 * q], a); a = __builtin_elementwise_fma(__builtin_amdgcn_cvt_pk_f32_fp8(wa, true), h2[2 * q + 1], a);
                a = __builtin_elementwise_fma(__builtin_amdgcn_cvt_pk_f32_fp8(wb, false), h2[8 + 2 * q], a); a = __builtin_elementwise_fma(__builtin_amdgcn_cvt_pk_f32_fp8(wb, true), h2[8 + 2 * q + 1], a); }
            { float hs_; asm("v_add_f32 %0, %1, %2" : "=v"(hs_) : "v"(a.x), "v"(a.y)); p[e] = hs_; }
        } else {
            const float av = __builtin_bit_cast(float, __builtin_amdgcn_readlane(__builtin_bit_cast(int, aseg), e)); const f32x2 a2 = {av, av};
#pragma unroll
            for (int q = 0; q < 4; ++q) { const int wa = (int)r0[q], wb = (int)r1[q];
                acc[2 * q] = __builtin_elementwise_fma(__builtin_amdgcn_cvt_pk_f32_fp8(wa, false), a2, acc[2 * q]); acc[2 * q + 1] = __builtin_elementwise_fma(__builtin_amdgcn_cvt_pk_f32_fp8(wa, true), a2, acc[2 * q + 1]);
                acc[8 + 2 * q] = __builtin_elementwise_fma(__builtin_amdgcn_cvt_pk_f32_fp8(wb, false), a2, acc[8 + 2 * q]); acc[8 + 2 * q + 1] = __builtin_elementwise_fma(__builtin_amdgcn_cvt_pk_f32_fp8(wb, true), a2, acc[8 + 2 * q + 1]); }
            asm volatile("" : "+v"(acc[0]), "+v"(acc[1]), "+v"(acc[2]), "+v"(acc[3]), "+v"(acc[4]), "+v"(acc[5]), "+v"(acc[6]), "+v"(acc[7]), "+v"(acc[8]), "+v"(acc[9]), "+v"(acc[10]), "+v"(acc[11]), "+v"(acc[12]), "+v"(acc[13]), "+v"(acc[14]), "+v"(acc[15]));
        }
        if (v + GD < 256) PG_ISSUE(v + GD);
        __builtin_amdgcn_sched_barrier(0);
    }
}
__device__ __forceinline__ void peer_token_pipe(const unsigned char* U, const unsigned char* Vt, int i0, int i1, float su0, float su1, float w0, float w1, const f32x2 (&h2)[16], f32x2 (&acc)[16], int lane) {
    u32x4 ring[GD][2];
    float p[64];
#pragma unroll
    for (int v = 0; v < GD; ++v) PG_ISSUE(v);
    peer_seg<0>(U, Vt, i0, i1, ring, p, 0.f, h2, acc, lane);
    xreduce_stage<32>(p, lane); xreduce_stage<16>(p, lane); xreduce_stage<8>(p, lane); xreduce_stage<4>(p, lane); xreduce_stage<2>(p, lane); xreduce_stage<1>(p, lane);
    const float a0 = gelu_erf(p[0] * su0) * w0;
    __builtin_amdgcn_sched_barrier(0);
    peer_seg<1>(U, Vt, i0, i1, ring, p, 0.f, h2, acc, lane);
    xreduce_stage<32>(p, lane); xreduce_stage<16>(p, lane); xreduce_stage<8>(p, lane); xreduce_stage<4>(p, lane); xreduce_stage<2>(p, lane); xreduce_stage<1>(p, lane);
    const float a1 = gelu_erf(p[0] * su1) * w1;
    __builtin_amdgcn_sched_barrier(0);
    peer_seg<2>(U, Vt, i0, i1, ring, p, a0, h2, acc, lane);
    peer_seg<3>(U, Vt, i0, i1, ring, p, a1, h2, acc, lane);
}
#undef PG_ISSUE
__device__ __forceinline__ void peer_gather_phase(const Ctx& c, const bf16* Hn, const unsigned char* U, const unsigned char* Vt, const float* rsU, const float* rsV, const int* IDX, const float* WGT, const float* Xr, float* X, int mode,
                                                  const float* g1, const float* g2, bf16* Hout, bf16* HKVout) {
    for (int m = c.gw; m < NTOK; m += c.ngw) {
        int lane_ = c.lane; asm volatile("" : "+v"(lane_));
#ifdef DRYIDXMASK
        const int imask_ = (X != Xr) ? DRYIDXMASK : 0xffff;
        const int i0 = IDX[(size_t)m * 128 + lane_] & imask_, i1 = IDX[(size_t)m * 128 + 64 + lane_] & imask_;
#else
        const int i0 = IDX[(size_t)m * 128 + lane_], i1 = IDX[(size_t)m * 128 + 64 + lane_];
#endif
        const float w0 = WGT[(size_t)m * 128 + lane_] * rsV[i0], w1 = WGT[(size_t)m * 128 + 64 + lane_] * rsV[i1];
        const float su0 = rsU[i0], su1 = rsU[i1];
        f32x2 h2[16];
#pragma unroll
        for (int cc = 0; cc < 2; ++cc) { const u32x4* hp = (const u32x4*)(Hn + (size_t)m * DM + 1024 * cc + 16 * lane_); const u32x4 ha = hp[0], hb = hp[1];
#pragma unroll
            for (int q = 0; q < 4; ++q) { h2[8 * cc + q] = (f32x2){bflo(ha[q]), bfhi(ha[q])}; h2[8 * cc + 4 + q] = (f32x2){bflo(hb[q]), bfhi(hb[q])}; } }
        f32x2 acc[16];
#pragma unroll
        for (int k = 0; k < 16; ++k) acc[k] = (f32x2){0.f, 0.f};
        peer_token_pipe(U, Vt, i0, i1, su0, su1, w0, w1, h2, acc, lane_);
        float* xr = X + (size_t)m * DM; const float* xrr = Xr + (size_t)m * DM; float ss = 0.f;
#pragma unroll
        for (int cc = 0; cc < 2; ++cc) {
            f32x4* xp = (f32x4*)(xr + 1024 * cc + 16 * lane_); const f32x4* xq = (const f32x4*)(xrr + 1024 * cc + 16 * lane_);
#pragma unroll
            for (int q = 0; q < 4; ++q) { f32x4 xa = xq[q]; xa[0] += acc[8 * cc + 2 * q].x; xa[1] += acc[8 * cc + 2 * q].y; xa[2] += acc[8 * cc + 2 * q + 1].x; xa[3] += acc[8 * cc + 2 * q + 1].y;
                acc[8 * cc + 2 * q] = (f32x2){xa[0], xa[1]}; acc[8 * cc + 2 * q + 1] = (f32x2){xa[2], xa[3]}; ss += (xa[0] * xa[0] + xa[1] * xa[1]) + (xa[2] * xa[2] + xa[3] * xa[3]);
                if (mode != 2) xp[q] = xa; }
        }
        const float rstd = 1.0f / sqrtf(wave_sum(ss) * (1.0f / DM) + EPS);
#pragma unroll
        for (int cc = 0; cc < 2; ++cc) {
            const f32x4* gp = (const f32x4*)(g1 + 1024 * cc + 16 * lane_);
            if (mode == 2) {
                f32x4* xp = (f32x4*)(xr + 1024 * cc + 16 * lane_);
#pragma unroll
                for (int q = 0; q < 4; ++q) { const f32x4 gv = gp[q]; f32x4 y; y[0] = acc[8 * cc + 2 * q].x * rstd * gv[0]; y[1] = acc[8 * cc + 2 * q].y * rstd * gv[1]; y[2] = acc[8 * cc + 2 * q + 1].x * rstd * gv[2]; y[3] = acc[8 * cc + 2 * q + 1].y * rstd * gv[3]; xp[q] = y; }
            } else {
                u32x4 hw[2];
#pragma unroll
                for (int q = 0; q < 4; ++q) { const f32x4 gv = gp[q]; hw[q >> 1][2 * (q & 1)] = pk2(acc[8 * cc + 2 * q].x * rstd * gv[0], acc[8 * cc + 2 * q].y * rstd * gv[1]); hw[q >> 1][2 * (q & 1) + 1] = pk2(acc[8 * cc + 2 * q + 1].x * rstd * gv[2], acc[8 * cc + 2 * q + 1].y * rstd * gv[3]); }
                u32x4* ho = (u32x4*)(Hout + (size_t)m * DM + 1024 * cc + 16 * lane_); ho[0] = hw[0]; ho[1] = hw[1];
                if (mode == 1) {
                    const f32x4* kp = (const f32x4*)(g2 + 1024 * cc + 16 * lane_); u32x4 kw[2];
#pragma unroll
                    for (int q = 0; q < 4; ++q) { const f32x4 gv = kp[q]; kw[q >> 1][2 * (q & 1)] = pk2(acc[8 * cc + 2 * q].x * rstd * gv[0], acc[8 * cc + 2 * q].y * rstd * gv[1]); kw[q >> 1][2 * (q & 1) + 1] = pk2(acc[8 * cc + 2 * q + 1].x * rstd * gv[2], acc[8 * cc + 2 * q + 1].y * rstd * gv[3]); }
                    u32x4* ko = (u32x4*)(HKVout + (size_t)m * DM + 1024 * cc + 16 * lane_); ko[0] = kw[0]; ko[1] = kw[1];
                }
            }
        }
    }
}

template <int PAT> __device__ __forceinline__ float swz_xor(float v) { return __builtin_bit_cast(float, __builtin_amdgcn_ds_swizzle(__builtin_bit_cast(int, v), PAT)); }
template <int PAT> __device__ __forceinline__ int swz_xor_i(int v) { return __builtin_amdgcn_ds_swizzle(v, PAT); }
template <int C> __device__ __forceinline__ unsigned bc8(unsigned v) { return (unsigned)__builtin_amdgcn_ds_swizzle((int)v, (C << 5) | 0x18); }
__device__ __forceinline__ void bcast16(unsigned x0, unsigned x1, unsigned (&o)[16]) {
    o[0] = bc8<0>(x0); o[1] = bc8<0>(x1); o[2] = bc8<1>(x0); o[3] = bc8<1>(x1); o[4] = bc8<2>(x0); o[5] = bc8<2>(x1); o[6] = bc8<3>(x0); o[7] = bc8<3>(x1);
    o[8] = bc8<4>(x0); o[9] = bc8<4>(x1); o[10] = bc8<5>(x0); o[11] = bc8<5>(x1); o[12] = bc8<6>(x0); o[13] = bc8<6>(x1); o[14] = bc8<7>(x0); o[15] = bc8<7>(x1);
}
__device__ __forceinline__ void peer_u_phase(const Ctx& c, const bf16* Hn, const unsigned char* U, const int* IDXT, float* PD, unsigned imask = 0xffffffffu) {
    const int xg = c.bx & 7, wr = (c.bx >> 3) * 8 + c.wave, g = c.lane >> 3, sub = c.lane & 7;
    for (int pass = 0; pass < 2; ++pass) {
        const int s = xg + 8 * pass, col0 = 128 * s + 16 * sub;
        const unsigned char* Us = U + (size_t)s * PE * 128 + 16 * sub;
        u32x4 wv[8];
        { const u32x4* wp = (const u32x4*)(U + (size_t)s * PE * 128 + (size_t)(c.bx >> 3) * 65536) + c.tid;
#pragma unroll
          for (int q = 0; q < 8; ++q) wv[q] = wp[q * 512]; }
        u32x2 ii; unsigned hw;
        { ii = *(const u32x2*)(IDXT + (size_t)wr * 128 + g * 16 + 2 * sub);
          hw = *((const unsigned*)(Hn + (size_t)wr * DM + 128 * s) + c.lane); }
        for (int k = 0; k < NTOK / 256; ++k) {
            const int t = wr + 256 * k;
            u32x4 r[16]; unsigned rj[16];
            bcast16(ii.x, ii.y, rj);
#pragma unroll
            for (int j = 0; j < 16; ++j) r[j] = *(const u32x4*)(Us + (size_t)(rj[j] & imask) * 128);
            float hf[16];
#pragma unroll
            for (int q = 0; q < 8; ++q) { const unsigned hd = (unsigned)__builtin_amdgcn_ds_bpermute(32 * sub + 4 * q, (int)hw); hf[2 * q] = bflo(hd); hf[2 * q + 1] = bfhi(hd); }
            if (k + 1 < NTOK / 256) { ii = *(const u32x2*)(IDXT + (size_t)(t + 256) * 128 + g * 16 + 2 * sub);
                hw = *((const unsigned*)(Hn + (size_t)(t + 256) * DM + 128 * s) + c.lane); }
            float am = 0.f;
#pragma unroll
            for (int q = 0; q < 16; ++q) am = fmaxf(am, fabsf(hf[q]));
            am = fmaxf(am, dpp_f<0xB1>(am)); am = fmaxf(am, dpp_f<0x4E>(am)); am = fmaxf(am, dpp_f<0x141>(am));
            const float hsc = am > 0.f ? 127.0f / am : 0.f, hinv = am * (1.0f / 127.0f);
            unsigned hq[4];
#pragma unroll
            for (int q = 0; q < 4; ++q) hq[q] = q8pack(hf[4 * q] * hsc, hf[4 * q + 1] * hsc, hf[4 * q + 2] * hsc, hf[4 * q + 3] * hsc);
            int p[16];
#pragma unroll
            for (int j = 0; j < 16; ++j) { int a = __builtin_amdgcn_sdot4((int)r[j].x, (int)hq[0], 0, false); a = __builtin_amdgcn_sdot4((int)r[j].y, (int)hq[1], a, false);
                a = __builtin_amdgcn_sdot4((int)r[j].z, (int)hq[2], a, false); p[j] = __builtin_amdgcn_sdot4((int)r[j].w, (int)hq[3], a, false); }
            { const bool up = (sub & 4) != 0;
#pragma unroll
              for (int q = 0; q < 8; ++q) { const int keep = up ? p[q + 8] : p[q], send = up ? p[q] : p[q + 8]; p[q] = keep + swz_xor_i<(4 << 10) | 0x1F>(send); } }
            { const bool up = (sub & 2) != 0;
#pragma unroll
              for (int q = 0; q < 4; ++q) { const int keep = up ? p[q + 4] : p[q], send = up ? p[q] : p[q + 4]; p[q] = keep + swz_xor_i<(2 << 10) | 0x1F>(send); } }
            { const bool up = (sub & 1) != 0;
#pragma unroll
              for (int q = 0; q < 2; ++q) { const int keep = up ? p[q + 2] : p[q], send = up ? p[q] : p[q + 2]; p[q] = keep + swz_xor_i<(1 << 10) | 0x1F>(send); } }
            *((unsigned*)PD + (((size_t)t * 16 + s) * 128 + g * 16 + 2 * sub) / 2) = pk2((float)p[0] * hinv, (float)p[1] * hinv);
            if (k == 0) asm volatile("" :: "v"(wv[0]), "v"(wv[1]), "v"(wv[2]), "v"(wv[3]), "v"(wv[4]), "v"(wv[5]), "v"(wv[6]), "v"(wv[7]));
        }
    }
}
__device__ __forceinline__ void peer_a_phase(const Ctx& c, const float* PD, const int* IDXT, float* WA, const float* rsU, const float* rsV, const float* RSTD) {
    const int i0 = c.bx * 512 + c.tid, step = c.G * 512;
    u32x2 vn[16];
    if (i0 < NTOK * 32) { const u32x2* pp = (const u32x2*)PD + (size_t)(i0 >> 5) * 512 + (i0 & 31);
#pragma unroll
        for (int s = 0; s < 16; ++s) vn[s] = pp[s * 32]; }
    for (int i4 = i0; i4 < NTOK * 32; i4 += step) {
        const int t = i4 >> 5;
        f32x4 v[16];
#pragma unroll
        for (int s = 0; s < 16; ++s) { const u32x2 w2 = vn[s]; v[s] = (f32x4){bflo(w2.x), bfhi(w2.x), bflo(w2.y), bfhi(w2.y)}; }
        const u32x4 e = *((const u32x4*)IDXT + i4); const f32x4 w = *((const f32x4*)WA + i4); const float rs = RSTD[t];
        { const int i5 = i4 + step < NTOK * 32 ? i4 + step : i4; const u32x2* pp = (const u32x2*)PD + (size_t)(i5 >> 5) * 512 + (i5 & 31);
#pragma unroll
          for (int s = 0; s < 16; ++s) vn[s] = pp[s * 32]; }
        float ru[4], rv[4];
#pragma unroll
        for (int q = 0; q < 4; ++q) { const unsigned eq = e[q]; ru[q] = rsU[eq]; rv[q] = rsV[eq]; }
        f32x4 sm = v[0];
#pragma unroll
        for (int s = 1; s < 16; ++s) sm += v[s];
        asm volatile("" :: "v"(ru[0]), "v"(ru[1]), "v"(ru[2]), "v"(ru[3]), "v"(rv[0]), "v"(rv[1]), "v"(rv[2]), "v"(rv[3]));
        f32x4 o;
#pragma unroll
        for (int q = 0; q < 4; ++q) o[q] = gelu_erf(sm[q] * ru[q] * rs) * w[q] * rv[q];
        *((f32x4*)WA + i4) = o;
    }
}
__device__ __forceinline__ void peer_v_phase(const Ctx& c, const unsigned char* Vt, const int* IDXT, const float* WA, float* X) {
    const int xg = c.bx & 7, wr = (c.bx >> 3) * 8 + c.wave, g = c.lane >> 3, sub = c.lane & 7;
    for (int pass = 0; pass < 2; ++pass) {
        const int s = xg + 8 * pass, col0 = 128 * s + 16 * sub;
        const unsigned char* Vs = Vt + (size_t)s * PE * 128 + 16 * sub;
        u32x4 wv[8];
        { const u32x4* wp = (const u32x4*)(Vt + (size_t)s * PE * 128 + (size_t)(c.bx >> 3) * 65536) + c.tid;
#pragma unroll
          for (int q = 0; q < 8; ++q) wv[q] = wp[q * 512]; }
        u32x2 ii, aa;
        { ii = *(const u32x2*)(IDXT + (size_t)wr * 128 + g * 16 + 2 * sub); aa = *(const u32x2*)(WA + (size_t)wr * 128 + g * 16 + 2 * sub); }
        for (int k = 0; k < NTOK / 256; ++k) {
            const int t = wr + 256 * k;
            u32x4 r[16]; float av[16]; unsigned rj[16], aj[16];
            bcast16(ii.x, ii.y, rj);
#pragma unroll
            for (int j = 0; j < 16; ++j) r[j] = *(const u32x4*)(Vs + (size_t)rj[j] * 128);
            bcast16(aa.x, aa.y, aj);
#pragma unroll
            for (int j = 0; j < 16; ++j) av[j] = __builtin_bit_cast(float, aj[j]);
            f32x2* xp = (f32x2*)(X + (size_t)t * DM + col0 + 2 * g);
            const f32x2 xold = *xp;
            if (k + 1 < NTOK / 256) { ii = *(const u32x2*)(IDXT + (size_t)(t + 256) * 128 + g * 16 + 2 * sub); aa = *(const u32x2*)(WA + (size_t)(t + 256) * 128 + g * 16 + 2 * sub); }
            f32x2 acc[8];
#pragma unroll
            for (int q = 0; q < 8; ++q) acc[q] = (f32x2){0.f, 0.f};
#pragma unroll
            for (int j = 0; j < 16; ++j) { float aj_ = av[j]; asm("" : "+v"(aj_));
                const f32x2 a2 = {aj_, aj_};
#pragma unroll
                for (int q = 0; q < 4; ++q) { const int w = (int)r[j][q]; acc[2 * q] = __builtin_elementwise_fma(__builtin_amdgcn_cvt_pk_f32_fp8(w, false), a2, acc[2 * q]); acc[2 * q + 1] = __builtin_elementwise_fma(__builtin_amdgcn_cvt_pk_f32_fp8(w, true), a2, acc[2 * q + 1]); } }
            float af[16];
#pragma unroll
            for (int q = 0; q < 8; ++q) { af[2 * q] = acc[q].x; af[2 * q + 1] = acc[q].y; }
#ifdef VDBG
#pragma unroll
            for (int q = 0; q < 16; ++q) { af[q] += __shfl_xor(af[q], 8); af[q] += __shfl_xor(af[q], 16); af[q] += __shfl_xor(af[q], 32); }
            { float s0 = af[0], s1 = af[1];
#pragma unroll
              for (int gg = 1; gg < 8; ++gg) { s0 = (g == gg) ? af[2 * gg] : s0; s1 = (g == gg) ? af[2 * gg + 1] : s1; }
              af[0] = s0; af[1] = s1; }
#else
#pragma unroll
            for (int q = 0; q < 8; ++q) { float xa = af[q], xb = af[q + 8]; asm("s_nop 1\n\tv_permlane32_swap_b32 %0, %1" : "+v"(xa), "+v"(xb)); af[q] = xa + xb; }
#pragma unroll
            for (int q = 0; q < 4; ++q) { float xa = af[q], xb = af[q + 4]; asm("s_nop 1\n\tv_permlane16_swap_b32 %0, %1" : "+v"(xa), "+v"(xb)); af[q] = xa + xb; }
            { const bool up = (c.lane & 8) != 0;
#pragma unroll
              for (int q = 0; q < 2; ++q) { const float keep = up ? af[q + 2] : af[q], send = up ? af[q] : af[q + 2]; af[q] = keep + swz_xor<(8 << 10) | 0x1F>(send); } }
#endif
            const f32x2 xn = {xold.x + af[0], xold.y + af[1]};
            *xp = xn;
            if (k == 0) asm volatile("" :: "v"(wv[0]), "v"(wv[1]), "v"(wv[2]), "v"(wv[3]), "v"(wv[4]), "v"(wv[5]), "v"(wv[6]), "v"(wv[7]));
        }
    }
}
#ifdef VREF
__device__ __forceinline__ void peer_v_ref_phase(const Ctx& c, const unsigned char* Vt, const int* IDXT, const float* WA, float* X) {
    for (int m = c.gw; m < NTOK; m += c.ngw) {
        const int i0 = IDXT[(size_t)m * 128 + c.lane], i1 = IDXT[(size_t)m * 128 + 64 + c.lane];
        const float a0 = WA[(size_t)m * 128 + c.lane], a1 = WA[(size_t)m * 128 + 64 + c.lane];
        f32x2 acc[16];
#pragma unroll
        for (int k = 0; k < 16; ++k) acc[k] = (f32x2){0.f, 0.f};
        for (int e = 0; e < 128; ++e) {
            const int row = __shfl(e < 64 ? i0 : i1, e & 63); const float a = __shfl(e < 64 ? a0 : a1, e & 63); const f32x2 a2 = {a, a};
            const u32x4* vp = (const u32x4*)(Vt + (size_t)row * DM) + c.lane;
#pragma unroll
            for (int cc = 0; cc < 2; ++cc) { const u32x4 v = vp[64 * cc];
#pragma unroll
                for (int q = 0; q < 4; ++q) { const int w = (int)v[q];
                    acc[8 * cc + 2 * q] = __builtin_elementwise_fma(__builtin_amdgcn_cvt_pk_f32_fp8(w, false), a2, acc[8 * cc + 2 * q]);
                    acc[8 * cc + 2 * q + 1] = __builtin_elementwise_fma(__builtin_amdgcn_cvt_pk_f32_fp8(w, true), a2, acc[8 * cc + 2 * q + 1]); } }
        }
        float* xr = X + (size_t)m * DM;
#pragma unroll
        for (int cc = 0; cc < 2; ++cc) { f32x4* xp = (f32x4*)(xr + 1024 * cc + 16 * c.lane);
#pragma unroll
            for (int q = 0; q < 4; ++q) { f32x4 xa = xp[q]; xa[0] += acc[8 * cc + 2 * q].x; xa[1] += acc[8 * cc + 2 * q].y; xa[2] += acc[8 * cc + 2 * q + 1].x; xa[3] += acc[8 * cc + 2 * q + 1].y; xp[q] = xa; } }
    }
}
#endif
__device__ __forceinline__ void norm_phase(const Ctx& c, float* X, int mode, const float* g1, const float* g2, bf16* H, bf16* HKV) {
    f32x4 ga[8], gb[8]; load_g(g1, c.lane, ga); load_g(mode == 1 ? g2 : g1, c.lane, gb);
    int m = c.gw;
    f32x4 v[8]; load_row(X + (size_t)m * DM, c.lane, v);
    for (; m < NTOK; m += c.ngw) {
        const int mn = m + c.ngw < NTOK ? m + c.ngw : m;
        f32x4 nx[8]; load_row(X + (size_t)mn * DM, c.lane, nx);
        const float rstd = row_rstd(v);
        if (mode == 2) { f32x4* xo = (f32x4*)(X + (size_t)m * DM) + c.lane;
#pragma unroll
            for (int j = 0; j < 8; ++j) { f32x4 y; y[0] = v[j][0] * rstd * ga[j][0]; y[1] = v[j][1] * rstd * ga[j][1]; y[2] = v[j][2] * rstd * ga[j][2]; y[3] = v[j][3] * rstd * ga[j][3]; xo[64 * j] = y; }
        } else { store_norm_bf16_r(v, rstd, ga, H + (size_t)m * DM, c.lane); if (mode == 1) store_norm_bf16_r(v, rstd, gb, HKV + (size_t)m * DM, c.lane); }
#pragma unroll
        for (int j = 0; j < 8; ++j) v[j] = nx[j];
    }
}

__device__ __forceinline__ void rms_final_phase(const Ctx& c, float* X, const float* g) {
    for (int m = c.gw; m < NTOK; m += c.ngw) { f32x4 v[8]; load_row(X + (size_t)m * DM, c.lane, v); const float rstd = row_rstd(v);
        const f32x4* gr = (const f32x4*)g + c.lane; f32x4* xo = (f32x4*)(X + (size_t)m * DM) + c.lane;
#pragma unroll
        for (int j = 0; j < 8; ++j) { const f32x4 gv = gr[64 * j]; f32x4 y; for (int k = 0; k < 4; ++k) { y[k] = v[j][k] * rstd * gv[k]; if (!(fabsf(y[k]) < 1e30f)) y[k] = 0.f; } xo[64 * j] = y; } }
}

#ifdef DIAGBUF
__device__ __forceinline__ void diag_copy_phase(const Ctx& c, float* X, const unsigned char* ws) {
    const bf16* src = (const bf16*)(ws + (size_t)DIAGBUF);
    for (size_t i = (size_t)c.bx * 512 + c.tid; i < (size_t)NTOK * DM; i += (size_t)c.G * 512) { const size_t t = i / DM, col = i % DM; float v = bflo((unsigned)src[t * DIAGLD + col]); if (!(fabsf(v) < 1e30f)) v = 0.f; X[i] = v; }
}
#endif

__device__ __forceinline__ unsigned off_b(unsigned row, unsigned ch) { return 256u * row + 16u * (ch ^ (((row & 3u) << 2) | ((row >> 2) & 3u))); }
__device__ __forceinline__ float rowmax4(float x) {
    float a = x, b = x; asm("s_nop 1\n\tv_permlane16_swap_b32 %0, %1" : "+v"(a), "+v"(b)); x = fmaxf(a, b);
    a = x; b = x; asm("s_nop 1\n\tv_permlane32_swap_b32 %0, %1" : "+v"(a), "+v"(b)); return fmaxf(a, b);
}
constexpr int AT_K = 0, AT_V = 32768, AT_BUF = 65536, AT_BIAS = 131072, AT_HEADB = 16384;
__device__ __forceinline__ void attn_phase(const Ctx& c, const bf16* Qg, const bf16* KVg, bf16* AOg, const float* relb, int dryvar = 0) {
    LAS unsigned char* lds = c.lds; const unsigned ldsb = (unsigned)(size_t)lds;
    const int tid = c.tid, lane = c.lane, w = c.wave, hg = w >> 2, wq = w & 3, fr = lane & 15, fq = lane >> 4, tq = (lane & 15) >> 2, tp = lane & 3;
    const int tl = tid & 255, lrow = tl >> 2, lc = tl & 3;
    unsigned vadr[8];
#pragma unroll
    for (int d = 0; d < 8; ++d) vadr[d] = ldsb + AT_V + hg * AT_HEADB + off_b(4 * fq + tq, 2 * d + (tp >> 1)) + 8 * (tp & 1);
    unsigned kadr[4];
#pragma unroll
    for (int s4 = 0; s4 < 4; ++s4) kadr[s4] = ldsb + AT_K + hg * AT_HEADB + 256 * fr + 16 * (fq ^ ((fr >> 2) & 3)) + 64 * (s4 ^ (fr & 3));
    for (int u = c.bx; u < NBATCH * NCHUNK * (AH / 2); u += c.G) {
        const int hp = u & 7, ch = (u >> 3) & 63, b = u >> 9, h = 2 * hp + hg;
        const size_t tq0 = (size_t)b * SEQ + (size_t)ch * CHUNK;
        __syncthreads();
        for (int i = tid; i < 2 * 272; i += 512) { const int hh = i / 272, k = i % 272; ((LAS float*)(lds + AT_BIAS))[i] = (k < NREL) ? relb[(size_t)(2 * hp + hh) * NREL + k] * 1.4426950408889634f : 0.f; }
        bf16x8 qf[4];
        { const bf16* qp = Qg + (tq0 + 16 * wq + fr) * DM + h * AHD + 8 * fq;
#pragma unroll
          for (int s = 0; s < 4; ++s) qf[s] = *(const bf16x8*)(qp + 32 * s); }
        f32x4 O[8];
#pragma unroll
        for (int d = 0; d < 8; ++d) O[d] = (f32x4){0.f, 0.f, 0.f, 0.f};
        float mrun = -1e30f, lrun = 0.f;
        const int t0 = ch >= LEFT ? 0 : LEFT - ch;
        u32x4 pk[4], pv[4];
        { const bf16* kp = KVg + ((size_t)b * SEQ + (size_t)(ch - LEFT + t0) * CHUNK + lrow) * (2 * DM) + h * AHD;
#pragma unroll
          for (int cc = 0; cc < 4; ++cc) { pk[cc] = *(const u32x4*)(kp + (lc + 4 * cc) * 8); pv[cc] = *(const u32x4*)(kp + DM + (lc + 4 * cc) * 8); } }
        const LAS float* bias = (const LAS float*)(lds + AT_BIAS) + hg * 272;
        const float bc = relb[(size_t)h * NREL + 256] * 1.4426950408889634f;
        for (int t = t0; t <= LEFT; ++t) {
            const int pb = ((t - t0) & 1) * AT_BUF;
#pragma unroll
            for (int cc = 0; cc < 4; ++cc) { *(LAS u32x4*)(lds + pb + AT_K + hg * AT_HEADB + off_b(lrow, lc + 4 * cc)) = pk[cc]; *(LAS u32x4*)(lds + pb + AT_V + hg * AT_HEADB + off_b(lrow, lc + 4 * cc)) = pv[cc]; }
            __syncthreads();
            if (t < LEFT && dryvar != 1) { const bf16* kp = KVg + ((size_t)b * SEQ + (size_t)(ch - LEFT + t + 1) * CHUNK + lrow) * (2 * DM) + h * AHD;
#pragma unroll
                for (int cc = 0; cc < 4; ++cc) { pk[cc] = *(const u32x4*)(kp + (lc + 4 * cc) * 8); pv[cc] = *(const u32x4*)(kp + DM + (lc + 4 * cc) * 8); } }
            f32x4 sT[4];
            {
                bf16x8 kf[16];
                const unsigned k0 = kadr[0] + pb, k1 = kadr[1] + pb, k2 = kadr[2] + pb, k3 = kadr[3] + pb;
                asm volatile("ds_read_b128 %0, %16\n\tds_read_b128 %1, %17\n\tds_read_b128 %2, %18\n\tds_read_b128 %3, %19\n\t"
                             "ds_read_b128 %4, %16 offset:4096\n\tds_read_b128 %5, %17 offset:4096\n\tds_read_b128 %6, %18 offset:4096\n\tds_read_b128 %7, %19 offset:4096\n\t"
                             "ds_read_b128 %8, %16 offset:8192\n\tds_read_b128 %9, %17 offset:8192\n\tds_read_b128 %10, %18 offset:8192\n\tds_read_b128 %11, %19 offset:8192\n\t"
                             "ds_read_b128 %12, %16 offset:12288\n\tds_read_b128 %13, %17 offset:12288\n\tds_read_b128 %14, %18 offset:12288\n\tds_read_b128 %15, %19 offset:12288"
                             : "=&v"(kf[0]), "=&v"(kf[1]), "=&v"(kf[2]), "=&v"(kf[3]), "=&v"(kf[4]), "=&v"(kf[5]), "=&v"(kf[6]), "=&v"(kf[7]),
                               "=&v"(kf[8]), "=&v"(kf[9]), "=&v"(kf[10]), "=&v"(kf[11]), "=&v"(kf[12]), "=&v"(kf[13]), "=&v"(kf[14]), "=&v"(kf[15])
                             : "v"(k0), "v"(k1), "v"(k2), "v"(k3) : "memory");
                asm volatile("s_waitcnt lgkmcnt(8)" : "+v"(kf[0]), "+v"(kf[1]), "+v"(kf[2]), "+v"(kf[3]), "+v"(kf[4]), "+v"(kf[5]), "+v"(kf[6]), "+v"(kf[7]) :: "memory");
#pragma unroll
                for (int kt = 0; kt < 2; ++kt) { sT[kt] = (f32x4){0.f, 0.f, 0.f, 0.f};
#pragma unroll
                    for (int s = 0; s < 4; ++s) sT[kt] = MFMA16(kf[4 * kt + s], qf[s], sT[kt]); }
                asm volatile("s_waitcnt lgkmcnt(0)" : "+v"(kf[8]), "+v"(kf[9]), "+v"(kf[10]), "+v"(kf[11]), "+v"(kf[12]), "+v"(kf[13]), "+v"(kf[14]), "+v"(kf[15]) :: "memory");
#pragma unroll
                for (int kt = 2; kt < 4; ++kt) { sT[kt] = (f32x4){0.f, 0.f, 0.f, 0.f};
#pragma unroll
                    for (int s = 0; s < 4; ++s) sT[kt] = MFMA16(kf[4 * kt + s], qf[s], sT[kt]); }
            }
            const int dbase = (LEFT - t) * CHUNK + (16 * wq + fr);
            if (t > LEFT - 3) {
#pragma unroll
                for (int kt = 0; kt < 4; ++kt)
#pragma unroll
                    for (int r = 0; r < 4; ++r) { const int dist = dbase - (16 * kt + 4 * fq + r); sT[kt][r] += bias[min(dist, 128) + 128]; }
            }
            s16x4 vlo[2][8], vhi[2][8];
            unsigned vcur[8];
#pragma unroll
            for (int d = 0; d < 8; ++d) vcur[d] = vadr[d] + pb;
#define TR8(dst, OFF) asm volatile("ds_read_b64_tr_b16 %0, %8 offset:" #OFF "\n\tds_read_b64_tr_b16 %1, %9 offset:" #OFF "\n\tds_read_b64_tr_b16 %2, %10 offset:" #OFF "\n\tds_read_b64_tr_b16 %3, %11 offset:" #OFF "\n\t" \
                "ds_read_b64_tr_b16 %4, %12 offset:" #OFF "\n\tds_read_b64_tr_b16 %5, %13 offset:" #OFF "\n\tds_read_b64_tr_b16 %6, %14 offset:" #OFF "\n\tds_read_b64_tr_b16 %7, %15 offset:" #OFF \
                : "=&v"(dst[0]), "=&v"(dst[1]), "=&v"(dst[2]), "=&v"(dst[3]), "=&v"(dst[4]), "=&v"(dst[5]), "=&v"(dst[6]), "=&v"(dst[7]) \
                : "v"(vcur[0]), "v"(vcur[1]), "v"(vcur[2]), "v"(vcur[3]), "v"(vcur[4]), "v"(vcur[5]), "v"(vcur[6]), "v"(vcur[7]) : "memory")
            TR8(vlo[0], 0); TR8(vhi[0], 4096); TR8(vlo[1], 8192); TR8(vhi[1], 12288);
#undef TR8
            float mx = -1e30f;
            const float badd = t <= LEFT - 3 ? bc : 0.f;
#pragma unroll
            for (int kt = 0; kt < 4; ++kt)
#pragma unroll
                for (int r = 0; r < 4; ++r) { sT[kt][r] += badd; mx = fmaxf(mx, sT[kt][r]); }
            mx = rowmax4(mx);
            const float mnew = fmaxf(mrun, mx), alpha = __builtin_amdgcn_exp2f(mrun - mnew); mrun = mnew;
            float ps = 0.f;
#pragma unroll
            for (int kt = 0; kt < 4; ++kt)
#pragma unroll
                for (int r = 0; r < 4; ++r) { sT[kt][r] = __builtin_amdgcn_exp2f(sT[kt][r] - mnew); ps += sT[kt][r]; }
            lrun = lrun * alpha + ps;
#pragma unroll
            for (int d = 0; d < 8; ++d) O[d] *= alpha;
            asm volatile("s_waitcnt lgkmcnt(0)" : "+v"(vlo[0][0]), "+v"(vlo[0][1]), "+v"(vlo[0][2]), "+v"(vlo[0][3]), "+v"(vlo[0][4]), "+v"(vlo[0][5]), "+v"(vlo[0][6]), "+v"(vlo[0][7]),
                         "+v"(vhi[0][0]), "+v"(vhi[0][1]), "+v"(vhi[0][2]), "+v"(vhi[0][3]), "+v"(vhi[0][4]), "+v"(vhi[0][5]), "+v"(vhi[0][6]), "+v"(vhi[0][7]) :: "memory");
            asm volatile("" : "+v"(vlo[1][0]), "+v"(vlo[1][1]), "+v"(vlo[1][2]), "+v"(vlo[1][3]), "+v"(vlo[1][4]), "+v"(vlo[1][5]), "+v"(vlo[1][6]), "+v"(vlo[1][7]),
                         "+v"(vhi[1][0]), "+v"(vhi[1][1]), "+v"(vhi[1][2]), "+v"(vhi[1][3]), "+v"(vhi[1][4]), "+v"(vhi[1][5]), "+v"(vhi[1][6]), "+v"(vhi[1][7]) :: "memory");
            __builtin_amdgcn_sched_barrier(0);
#pragma unroll
            for (int ks = 0; ks < 2; ++ks) {
                bf16x8 pb; { const unsigned p0 = pk2(sT[2 * ks][0], sT[2 * ks][1]), p1 = pk2(sT[2 * ks][2], sT[2 * ks][3]), p2 = pk2(sT[2 * ks + 1][0], sT[2 * ks + 1][1]), p3 = pk2(sT[2 * ks + 1][2], sT[2 * ks + 1][3]);
                    const u32x4 pw = (u32x4){p0, p1, p2, p3}; pb = __builtin_bit_cast(bf16x8, pw); }
#pragma unroll
                for (int d = 0; d < 8; ++d) { bf16x8 va; va[0] = vlo[ks][d][0]; va[1] = vlo[ks][d][1]; va[2] = vlo[ks][d][2]; va[3] = vlo[ks][d][3]; va[4] = vhi[ks][d][0]; va[5] = vhi[ks][d][1]; va[6] = vhi[ks][d][2]; va[7] = vhi[ks][d][3];
                    O[d] = MFMA16(va, pb, O[d]); }
            }
        }
        float lt = lrun; lt += __shfl_xor(lt, 16); lt += __shfl_xor(lt, 32);
        const float inv = 1.0f / lt;
        bf16* op = AOg + (tq0 + 16 * wq + fr) * DM + h * AHD + 4 * fq;
#pragma unroll
        for (int d = 0; d < 8; ++d) { u32x2 ow; ow.x = pk2(O[d][0] * inv, O[d][1] * inv); ow.y = pk2(O[d][2] * inv, O[d][3] * inv); *(u32x2*)(op + 16 * d) = ow; }
    }
}

namespace at2 {
typedef float f32x16 __attribute__((ext_vector_type(16)));
constexpr int SHM_V = 64 * 128 * 2, SHM_K = 64 * 128 * 2, OFF_K = 2 * SHM_V, OFF_WS = 2 * SHM_V + 2 * SHM_K, OFF_BIAS = OFF_WS + 8 * 64 * 4, OFF_Q = OFF_BIAS + 2048;
constexpr float THRL = 8.0f * 1.4426950408889634f;
#define A2_KSWZ(row, colB) ((row) * 256 + ((colB) ^ (((row) & 7) << 4)))
#define A2_SBAR() __builtin_amdgcn_sched_barrier(0)
__device__ __forceinline__ int crow(int r, int hi) { return (r & 3) + 8 * (r >> 2) + 4 * hi; }
__device__ __forceinline__ float pl32max(float x) { auto rr = __builtin_amdgcn_permlane32_swap(__builtin_bit_cast(unsigned, x), __builtin_bit_cast(unsigned, x), false, false);
    const unsigned a = rr[0], b = rr[1]; return fmaxf(__builtin_bit_cast(float, a), __builtin_bit_cast(float, b)); }
__device__ __forceinline__ float pl32sum(float x) { auto rr = __builtin_amdgcn_permlane32_swap(__builtin_bit_cast(unsigned, x), __builtin_bit_cast(unsigned, x), false, false);
    const unsigned a = rr[0], b = rr[1]; return __builtin_bit_cast(float, a) + __builtin_bit_cast(float, b); }
__device__ __forceinline__ void partialSM(f32x16& p0, f32x16& p1, float& m_reg, float& mn, float& alpha) {
    float pmax = p0[0];
#pragma unroll
    for (int r = 1; r < 16; ++r) pmax = fmaxf(pmax, p0[r]);
#pragma unroll
    for (int r = 0; r < 16; ++r) pmax = fmaxf(pmax, p1[r]);
    pmax = pl32max(pmax);
    if (__builtin_expect(__all(pmax - m_reg <= THRL), 1)) { mn = m_reg; alpha = 1.f; }
    else { mn = fmaxf(m_reg, pmax); alpha = __builtin_amdgcn_exp2f(m_reg - mn); m_reg = mn; }
#pragma unroll
    for (int r = 0; r < 16; ++r) { p0[r] -= mn; p1[r] -= mn; }
#pragma unroll
    for (int r = 0; r < 16; ++r) p0[r] = __builtin_amdgcn_exp2f(p0[r]);
}
__device__ __forceinline__ void finishSM(f32x16& p0, f32x16& p1, float alpha, float& l_reg, bf16x8& pa0, bf16x8& pa1, bf16x8& pa2, bf16x8& pa3) {
#pragma unroll
    for (int r = 0; r < 16; ++r) p1[r] = __builtin_amdgcn_exp2f(p1[r]);
    float ps = 0.f;
#pragma unroll
    for (int r = 0; r < 16; ++r) ps += p0[r];
#pragma unroll
    for (int r = 0; r < 16; ++r) ps += p1[r];
    ps = pl32sum(ps);
    l_reg = l_reg * alpha + ps;
#define A2_PK4(P, BASE, OUT) do { const unsigned a0 = pk2(P[BASE + 0], P[BASE + 1]), a1 = pk2(P[BASE + 2], P[BASE + 3]), b0 = pk2(P[BASE + 4], P[BASE + 5]), b1 = pk2(P[BASE + 6], P[BASE + 7]); \
        auto r0 = __builtin_amdgcn_permlane32_swap(a0, b0, false, false); auto r1 = __builtin_amdgcn_permlane32_swap(a1, b1, false, false); \
        const unsigned w0 = r0[0], w1 = r1[0], w2 = r0[1], w3 = r1[1]; const u32x4 w = {w0, w1, w2, w3}; OUT = __builtin_bit_cast(bf16x8, w); } while (0)
    A2_PK4(p0, 0, pa0); A2_PK4(p0, 8, pa1); A2_PK4(p1, 0, pa2); A2_PK4(p1, 8, pa3);
#undef A2_PK4
}
__device__ __forceinline__ void qkt(f32x16& p0, f32x16& p1, LAS const unsigned char* Ks, LAS const unsigned char* qr_l, int r32, int hi) {
    asm volatile("" : "+v"(r32));
#pragma unroll
    for (int r = 0; r < 16; ++r) { p0[r] = 0.f; p1[r] = 0.f; }
#pragma unroll
    for (int d0 = 0; d0 < 8; ++d0) { const int cb = (d0 * 16 + hi * 8) * 2;
        const bf16x8 b0 = *(LAS const bf16x8*)(Ks + A2_KSWZ(r32, cb));
        const bf16x8 b1 = *(LAS const bf16x8*)(Ks + A2_KSWZ(32 + r32, cb));
        const bf16x8 q8 = *(LAS const bf16x8*)(qr_l + d0 * 1024);
        p0 = __builtin_amdgcn_mfma_f32_32x32x16_bf16(b0, q8, p0, 0, 0, 0);
        p1 = __builtin_amdgcn_mfma_f32_32x32x16_bf16(b1, q8, p1, 0, 0, 0); }
}
__device__ __forceinline__ int v_st(int k, int c) { const int kk = (k & ~0xC) | ((k & 4) << 1) | ((k & 8) >> 1); return ((kk >> 3) * 4 + (c >> 5)) * 512 + ((kk & 7) * 32 + (c & 31)) * 2; }
__device__ __forceinline__ int v_rd_base(int lane) { return ((lane & 3) << 3) | (((lane >> 2) & 3) << 6) | (((lane >> 4) & 1) << 5) | (((lane >> 5) & 1) << 8); }
constexpr int v_rd_off(int d0, int ks, int half) { return d0 * 512 + ks * 4096 + half * 2048; }
template <int OFF> __device__ __forceinline__ s16x4 tr_read(int vb) { s16x4 r; asm volatile("ds_read_b64_tr_b16 %0, %1 offset:%2" : "=&v"(r) : "v"(vb), "i"(OFF) : "memory"); return r; }
template <int D0> __device__ __forceinline__ void pv_one(f32x16& od, int vb, bf16x8 pa0, bf16x8 pa1, bf16x8 pa2, bf16x8 pa3) {
    const s16x4 l0 = tr_read<v_rd_off(D0, 0, 0)>(vb), h0 = tr_read<v_rd_off(D0, 0, 1)>(vb), l1 = tr_read<v_rd_off(D0, 1, 0)>(vb), h1 = tr_read<v_rd_off(D0, 1, 1)>(vb);
    const s16x4 l2 = tr_read<v_rd_off(D0, 2, 0)>(vb), h2 = tr_read<v_rd_off(D0, 2, 1)>(vb), l3 = tr_read<v_rd_off(D0, 3, 0)>(vb), h3 = tr_read<v_rd_off(D0, 3, 1)>(vb);
    asm volatile("s_waitcnt lgkmcnt(0)" ::: "memory"); A2_SBAR();
#define A2_PK(L, H) (bf16x8){L[0], L[1], L[2], L[3], H[0], H[1], H[2], H[3]}
    od = __builtin_amdgcn_mfma_f32_32x32x16_bf16(pa0, A2_PK(l0, h0), od, 0, 0, 0);
    od = __builtin_amdgcn_mfma_f32_32x32x16_bf16(pa1, A2_PK(l1, h1), od, 0, 0, 0);
    od = __builtin_amdgcn_mfma_f32_32x32x16_bf16(pa2, A2_PK(l2, h2), od, 0, 0, 0);
    od = __builtin_amdgcn_mfma_f32_32x32x16_bf16(pa3, A2_PK(l3, h3), od, 0, 0, 0);
#undef A2_PK
}
__device__ __forceinline__ void pv_d0(f32x16 (&o)[4], int vb, bf16x8 pa0, bf16x8 pa1, bf16x8 pa2, bf16x8 pa3) {
    pv_one<0>(o[0], vb, pa0, pa1, pa2, pa3); pv_one<1>(o[1], vb, pa0, pa1, pa2, pa3); pv_one<2>(o[2], vb, pa0, pa1, pa2, pa3); pv_one<3>(o[3], vb, pa0, pa1, pa2, pa3);
}
__device__ __forceinline__ void bias_mask(f32x16& p0, f32x16& p1, int dc, LAS const float* bias, float bc, int qrow, int hi) {
    if (dc < 0 || dc > 8) {
#pragma unroll
        for (int r = 0; r < 16; ++r) { p0[r] = -__builtin_inff(); p1[r] = -__builtin_inff(); }
    } else if (dc >= 3) {
#pragma unroll
        for (int r = 0; r < 16; ++r) { p0[r] += bc; p1[r] += bc; }
    } else {
        int db = 64 * dc + qrow + 128 - 4 * hi; asm volatile("" : "+v"(db));
#pragma unroll
        for (int r = 0; r < 16; ++r) { const int k0 = (r & 3) + 8 * (r >> 2); p0[r] += bias[min(db - k0, 256)]; p1[r] += bias[min(db - 32 - k0, 256)]; }
    }
}
__device__ __forceinline__ void block(const bf16* Qb, const bf16* Kh, const bf16* Vh, bf16* Ob, int NT, int dc0, LAS const float* bias, float bc, LAS unsigned char* lds, int tid) {
    constexpr int LDQ = DM, LDK = 2 * DM, LDO = DM;
    const int wid = tid >> 6, lane = tid & 63, r32 = lane & 31, hi = lane >> 5;
    LAS unsigned char* V_lds = lds; LAS unsigned char* K_lds = lds + OFF_K;
    LAS float* ws = (LAS float*)(lds + OFF_WS) + wid * 64; LAS float* li_l = ws; LAS float* al_l = ws + 32;
    float m_reg = -1e30f, l_reg = 0.f; f32x16 o[4];
    LAS unsigned char* qr = lds + OFF_Q + wid * 8192 + lane * 16;
#pragma unroll
    for (int d = 0; d < 4; ++d)
#pragma unroll
        for (int r = 0; r < 16; ++r) o[d][r] = 0.f;
    const bf16* Qw = Qb + (size_t)(wid * 32 + r32) * LDQ + hi * 8;
#pragma unroll
    for (int d0 = 0; d0 < 8; ++d0) *(LAS bf16x8*)(qr + d0 * 1024) = *(const bf16x8*)(Qw + d0 * 16);
    const int sr = tid >> 4, sc = (tid & 15) * 8, vst0 = v_st(sr, sc), vst1 = v_st(32 + sr, sc);
    const int vb0 = (int)(unsigned)(size_t)V_lds + v_rd_base(lane);
    const int qrow = (wid & 1) * 32 + r32, dcw = dc0 + (wid >> 1);
    bf16x8 sv0[1], sv1[1], sk0[1], sk1[1];
#define A2_SLOAD(i, k0) do { sv0[i] = *(const bf16x8*)(Vh + (size_t)((k0) + sr) * LDK + sc); sv1[i] = *(const bf16x8*)(Vh + (size_t)((k0) + 32 + sr) * LDK + sc); \
        sk0[i] = *(const bf16x8*)(Kh + (size_t)((k0) + sr) * LDK + sc); sk1[i] = *(const bf16x8*)(Kh + (size_t)((k0) + 32 + sr) * LDK + sc); } while (0)
#define A2_SWRITE(b, i) do { *(LAS bf16x8*)(V_lds + (b) * SHM_V + vst0) = sv0[i]; *(LAS bf16x8*)(V_lds + (b) * SHM_V + vst1) = sv1[i]; const int kc = sc * 2; \
        *(LAS bf16x8*)(K_lds + (b) * SHM_K + A2_KSWZ(sr, kc)) = sk0[i]; *(LAS bf16x8*)(K_lds + (b) * SHM_K + A2_KSWZ(32 + sr, kc)) = sk1[i]; } while (0)
#define A2_SWAIT() asm volatile("s_waitcnt vmcnt(0)" ::: "memory")
#define A2_RESC(a) do { if (__any((a) < 1.f)) { if (hi == 0) al_l[r32] = (a); asm volatile("s_waitcnt lgkmcnt(0)" ::: "memory"); \
        _Pragma("unroll") for (int d = 0; d < 4; ++d) _Pragma("unroll") for (int r = 0; r < 16; ++r) o[d][r] *= al_l[crow(r, hi)]; } } while (0)
    f32x16 pA0, pA1, pB0, pB1; float mnA, mnB, alA = 1.f, alB = 1.f; bf16x8 pa0, pa1, pa2, pa3;
#define A2_VIS(jj) ((unsigned)(dcw - (jj)) <= 8u)
    A2_SLOAD(0, 0); asm volatile("s_waitcnt vmcnt(0)" ::: "memory"); A2_SWRITE(0, 0); __syncthreads();
    bool vA = A2_VIS(0), vB = false;
    if (vA) { qkt(pA0, pA1, K_lds, qr, r32, hi); bias_mask(pA0, pA1, dcw - 0, bias, bc, qrow, hi); partialSM(pA0, pA1, m_reg, mnA, alA); }
    A2_SLOAD(0, 64);
    A2_SWAIT(); A2_SWRITE(1, 0); __syncthreads();
    for (int j = 1; j + 1 < NT; j += 2) {
        vB = A2_VIS(j);
        A2_SBAR(); if (vB) { qkt(pB0, pB1, K_lds + SHM_K, qr, r32, hi); bias_mask(pB0, pB1, dcw - j, bias, bc, qrow, hi); }
        if (vA) finishSM(pA0, pA1, alA, l_reg, pa0, pa1, pa2, pa3);
        A2_SBAR();
        A2_SLOAD(0, (j + 1) * 64); A2_SBAR();
        if (vA) pv_d0(o, vb0, pa0, pa1, pa2, pa3);
        alB = 1.f; if (vB) partialSM(pB0, pB1, m_reg, mnB, alB);
        __syncthreads(); A2_SWAIT(); A2_SWRITE(0, 0);
        A2_RESC(alB); __syncthreads();
        vA = A2_VIS(j + 1);
        A2_SBAR(); if (vA) { qkt(pA0, pA1, K_lds, qr, r32, hi); bias_mask(pA0, pA1, dcw - (j + 1), bias, bc, qrow, hi); }
        if (vB) finishSM(pB0, pB1, alB, l_reg, pa0, pa1, pa2, pa3);
        A2_SBAR();
        A2_SLOAD(0, (j + 2) * 64);
        A2_SBAR();
        if (vB) pv_d0(o, vb0 + SHM_V, pa0, pa1, pa2, pa3);
        alA = 1.f; if (vA) partialSM(pA0, pA1, m_reg, mnA, alA);
        __syncthreads(); A2_SWAIT(); A2_SWRITE(1, 0);
        A2_RESC(alA); __syncthreads();
    }
    vB = A2_VIS(NT - 1);
    A2_SBAR(); if (vB) { qkt(pB0, pB1, K_lds + SHM_K, qr, r32, hi); bias_mask(pB0, pB1, dcw - (NT - 1), bias, bc, qrow, hi); }
    if (vA) finishSM(pA0, pA1, alA, l_reg, pa0, pa1, pa2, pa3);
    A2_SBAR();
    if (vA) pv_d0(o, vb0, pa0, pa1, pa2, pa3);
    alB = 1.f; if (vB) partialSM(pB0, pB1, m_reg, mnB, alB);
    __syncthreads(); A2_RESC(alB);
    if (vB) { finishSM(pB0, pB1, alB, l_reg, pa0, pa1, pa2, pa3); A2_SBAR();
        pv_d0(o, vb0 + SHM_V, pa0, pa1, pa2, pa3); }
#undef A2_VIS
    if (hi == 0) li_l[r32] = l_reg; asm volatile("s_waitcnt lgkmcnt(0)" ::: "memory");
    float rli[16];
#pragma unroll
    for (int r = 0; r < 16; ++r) rli[r] = __builtin_amdgcn_rcpf(li_l[crow(r, hi)]);
    bf16* Ow = Ob + (size_t)(wid * 32) * LDO;
#pragma unroll
    for (int r = 0; r < 16; ++r) { const int orow = crow(r, hi);
#pragma unroll
        for (int d0 = 0; d0 < 4; ++d0) Ow[(size_t)orow * LDO + d0 * 32 + r32] = (bf16)f2bf(o[d0][r] * rli[r]); }
#undef A2_SLOAD
#undef A2_SWRITE
#undef A2_SWAIT
#undef A2_RESC
}
}
__device__ __forceinline__ void attn_phase2(const Ctx& c, const bf16* Qg, const bf16* KVg, bf16* AOg, const float* relb) {
    LAS unsigned char* lds = c.lds;
    for (int u = c.bx; u < NBATCH * AH * 16; u += c.G) {
        const int h = u & 15, b = (u >> 4) & 3, qb = u >> 6;
        const int c0 = 4 * qb, kb = c0 >= LEFT ? c0 - LEFT : 0, NT = c0 + 4 - kb;
        __syncthreads();
        { int i = c.tid; asm volatile("" : "+v"(i));
          if (i < 272) ((LAS float*)(lds + at2::OFF_BIAS))[i] = (i < NREL) ? relb[(size_t)h * NREL + i] * 1.4426950408889634f : 0.f; }
        const float bc = relb[(size_t)h * NREL + 256] * 1.4426950408889634f;
        __syncthreads();
        const size_t tq0 = (size_t)b * SEQ + (size_t)c0 * CHUNK, tk0 = (size_t)b * SEQ + (size_t)kb * CHUNK;
        at2::block(Qg + tq0 * DM + h * AHD, KVg + tk0 * (2 * DM) + h * AHD, KVg + tk0 * (2 * DM) + DM + h * AHD, AOg + tq0 * DM + h * AHD, NT, c0 - kb, (const LAS float*)(lds + at2::OFF_BIAS), bc, lds, c.tid);
    }
}

constexpr int NSTEPS = 1 + 2 * 10 + 2 * 9;
template <int MASK> __global__ void __launch_bounds__(512, 2) yoco_fwd(Params p) {
    extern __shared__ __attribute__((aligned(16))) unsigned char lds_raw[];
#define MK_CTX() Ctx c; { int t_ = threadIdx.x; asm volatile("" : "+v"(t_)); c.lds = (LAS unsigned char*)lds_raw; c.tid = t_; c.lane = t_ & 63; c.wave = __builtin_amdgcn_readfirstlane(t_ >> 6); \
        { int b_ = blockIdx.x, g_ = gridDim.x; asm volatile("" : "+s"(b_), "+s"(g_)); c.bx = b_; c.G = g_; } c.gw = c.bx * 8 + c.wave; c.ngw = c.G * 8; }
    volatile LAS unsigned* MISC = (volatile LAS unsigned*)((LAS unsigned char*)lds_raw + LDS_MISC);
    if (threadIdx.x < 4) MISC[threadIdx.x] = 0u;
    __syncthreads();
    XcdBarrier bar; bar.bar = (unsigned*)(p.ws + WS_CTL); bar.x = 0; bar.st = MISC;
    if (p.hi - p.lo > 1) bar = xcd_barrier_post((unsigned*)(p.ws + WS_CTL), MISC);
    unsigned char* ws = p.ws;
    bf16* const H = (bf16*)(ws + WS_H); bf16* const HKV = (bf16*)(ws + WS_HKV);
    float* const X = p.out;
    int s = 0;
#ifndef REPMASK
#define REPMASK 0
#endif
#define KF_(f) p.f = kq_->f;
#define MK_P() Params p; { unsigned long long ka_ = (unsigned long long)__builtin_amdgcn_kernarg_segment_ptr(); asm volatile("" : "+s"(ka_)); const __attribute__((address_space(4))) Params* kq_ = (const __attribute__((address_space(4))) Params*)ka_; \
        KF_(x) KF_(ln_mix) KF_(ln_ffn) KF_(ret_w_in) KF_(ret_w_out) KF_(ret_gn) KF_(kv_norm) KF_(w_kv) KF_(att_w_q) KF_(att_w_o) KF_(att_rel_bias) KF_(peer_w_q) KF_(peer_sub_keys) KF_(peer_u) KF_(peer_v) KF_(ln_final) \
        KF_(out) KF_(ws) KF_(lo) KF_(hi) } \
        unsigned char* const ws = p.ws; bf16* const H = (bf16*)(ws + WS_H); bf16* const HKV = (bf16*)(ws + WS_HKV); float* const X = p.out; (void)H; (void)HKV; (void)X;
#define BEGIN_STEP(k) if (((MASK >> (k)) & 1) && s >= p.lo && s < p.hi) { for (int rep_ = ((REPMASK >> (k)) & 1) ? 0 : 1; rep_ < 2; ++rep_) { MK_CTX(); MK_P();
#define END_STEP   if (rep_ == 0 || s + 1 < p.hi) xcd_barrier(bar); } } ++s;

    BEGIN_STEP(0) p0_prologue(p, c); END_STEP

    for (int l = 0; l < DEPTH; ++l) {
        if (l < 2) {
            BEGIN_STEP(1)
                pg8::Gemm g{H, (const bf16*)(ws + WS_WIN) + (size_t)l * RIN * DM, NTOK, RIN, DM}; pg8::StaticOrder S; S.init(NTOK, RIN, c.G, c.bx);
                pg8::EpiProj E{(bf16*)(ws + WS_Q), (bf16*)(ws + WS_K), (bf16*)(ws + WS_V), (bf16*)(ws + WS_G), (const float*)(ws + WS_ROT)};
                pg8::gemm_phase<pg8::EpiProj, pg8::StaticOrder>(c.lds, g, S, E, nullptr);
            END_STEP
            BEGIN_STEP(2)
                for (int u = c.bx; u < 256; u += c.G) ret_scan_unit(c, (const bf16*)(ws + WS_Q), (const bf16*)(ws + WS_K), (const bf16*)(ws + WS_V), (bf16*)(ws + WS_O), u);
            END_STEP
            BEGIN_STEP(3)
                ret_gate_phase(c, (const bf16*)(ws + WS_O), (bf16*)(ws + WS_G), p.ret_gn + (size_t)l * RVW, rep_ == 0 ? (bf16*)(ws + WS_SC) : nullptr);
            END_STEP
        } else {
            BEGIN_STEP(4)
                for (int pass = (l == 2 ? 0 : 1); pass < 2; ++pass) {
                    const int N = pass ? DM : 2 * DM;
                    pg8::Gemm g{pass ? H : HKV, pass ? (const bf16*)(ws + WS_WQ) + (size_t)(l - 2) * DM * DM : (const bf16*)(ws + WS_WKV), NTOK, N, DM}; pg8::StaticOrder S; S.init(NTOK, N, c.G, c.bx);
                    pg8::EpiBf16S E{pass ? (bf16*)(ws + WS_Q) : (bf16*)(ws + WS_KV), N, pass ? 0.12751743082459868f : 1.0f};
                    pg8::gemm_phase<pg8::EpiBf16S, pg8::StaticOrder>(c.lds, g, S, E, nullptr);
                }
            END_STEP
            BEGIN_STEP(5)
#ifdef ATTNDRY
                attn_phase(c, (const bf16*)(ws + WS_Q), (const bf16*)(ws + WS_KV), rep_ == 0 ? (bf16*)(ws + WS_O) : (bf16*)(ws + WS_AO), p.att_rel_bias + (size_t)(l - 2) * AH * NREL, rep_ == 0 ? ATTNDRY : 0);
#else
                attn_phase2(c, (const bf16*)(ws + WS_Q), (const bf16*)(ws + WS_KV), (bf16*)(ws + WS_AO), p.att_rel_bias + (size_t)(l - 2) * AH * NREL);
#endif
            END_STEP
        }
        BEGIN_STEP(6)
            const int K = l < 2 ? RVW : DM;
            pg8::Gemm g{l < 2 ? (const bf16*)(ws + WS_G) : (const bf16*)(ws + WS_AO), l < 2 ? (const bf16*)(ws + WS_WOUT) + (size_t)l * DM * RVW : (const bf16*)(ws + WS_WO) + (size_t)(l - 2) * DM * DM, NTOK, DM, K};
            pg8::StaticOrder S; S.init(NTOK, DM, c.G, c.bx);
            pg8::EpiRes E{X, DM, H, p.ln_ffn + (size_t)l * DM, (float*)(ws + WS_SQP)};
            pg8::gemm_phase<pg8::EpiRes, pg8::StaticOrder>(c.lds, g, S, E, nullptr);
        END_STEP
        BEGIN_STEP(8)
            pg8::Gemm g{H, (const bf16*)(ws + WS_WC) + (size_t)l * DM * DM, NTOK, DM, DM}; pg8::StaticOrder S; S.init(NTOK, DM, c.G, c.bx);
            pg8::EpiF32 E{(float*)(ws + WS_SC), DM};
            pg8::gemm_phase<pg8::EpiF32, pg8::StaticOrder>(c.lds, g, S, E, nullptr);
        END_STEP
        BEGIN_STEP(9)
            peer_topk_phase(c, (const float*)(ws + WS_SC), (int*)(ws + WS_IDX), (float*)(ws + WS_WGT), (const float*)(ws + WS_SQP), (float*)(ws + WS_RSTD));
        END_STEP
        BEGIN_STEP(10)
#ifdef DRYIDXMASK
            peer_u_phase(c, H, ws + WS_PU + (size_t)l * PE * DM, (const int*)(ws + WS_IDX), (float*)(ws + WS_SC), rep_ == 0 ? DRYIDXMASK : 0xffffffffu);
#else
            peer_u_phase(c, H, ws + WS_PU + (size_t)l * PE * DM, (const int*)(ws + WS_IDX), (float*)(ws + WS_SC));
#endif
        END_STEP
        BEGIN_STEP(11)
            peer_a_phase(c, (const float*)(ws + WS_SC), (const int*)(ws + WS_IDX), (float*)(ws + WS_WGT), (const float*)(ws + WS_RS) + (size_t)l * PE, (const float*)(ws + WS_RS) + (size_t)(DEPTH + l) * PE, (const float*)(ws + WS_RSTD));
        END_STEP
        BEGIN_STEP(12)
#ifdef VREF
            peer_v_ref_phase(c, ws + WS_PV + (size_t)l * PE * DM, (const int*)(ws + WS_IDX), (const float*)(ws + WS_WGT), X);
#else
            peer_v_phase(c, ws + WS_PV + (size_t)l * PE * DM, (const int*)(ws + WS_IDX), (const float*)(ws + WS_WGT), X);
#endif
        END_STEP
        BEGIN_STEP(13)
            const int mode = (l == DEPTH - 1) ? 2 : (l == 1 ? 1 : 0);
            norm_phase(c, X, mode, mode == 2 ? p.ln_final : p.ln_mix + (size_t)(l + 1) * DM, p.kv_norm, H, HKV);
        END_STEP
    }
#ifdef DIAGBUF
    if ((MASK >> 14) & 1) { MK_CTX(); diag_copy_phase(c, X, ws); }
#else
    if ((MASK >> 14) & 1) { MK_CTX(); MK_P(); rms_final_phase(c, X, p.ln_final); }
#endif
#undef BEGIN_STEP
#undef END_STEP
}

#ifndef N_LAUNCH_CUT
#define N_LAUNCH_CUT 1
#endif
typedef void (*kern_t)(Params);
template <int SITE> static void launch_site(const Params& p, hipStream_t stream) {
    static bool attr = false;
    if (!attr) { (void)hipFuncSetAttribute((const void*)yoco_fwd<(1 << SITE)>, hipFuncAttributeMaxDynamicSharedMemorySize, LDS_BYTES); attr = true; }
    hipLaunchKernelGGL((yoco_fwd<(1 << SITE)>), dim3(256), dim3(512), LDS_BYTES, stream, p);
}
#ifndef MEGASITES
#define MEGASITES 0
#endif
static void launch_step_site(int site, const Params& p, hipStream_t stream) {
    if ((MEGASITES >> site) & 1) { hipLaunchKernelGGL((yoco_fwd<0x3FFF>), dim3(256), dim3(512), LDS_BYTES, stream, p); return; }
    switch (site) {
        case 0: launch_site<0>(p, stream); break; case 1: launch_site<1>(p, stream); break; case 2: launch_site<2>(p, stream); break; case 3: launch_site<3>(p, stream); break;
        case 4: launch_site<4>(p, stream); break; case 5: launch_site<5>(p, stream); break; case 6: launch_site<6>(p, stream); break; case 7: launch_site<7>(p, stream); break;
        case 8: launch_site<8>(p, stream); break; case 9: launch_site<9>(p, stream); break; case 10: launch_site<10>(p, stream); break; case 11: launch_site<11>(p, stream); break; case 12: launch_site<12>(p, stream); break; case 13: launch_site<13>(p, stream); break; default: launch_site<14>(p, stream); break;
    }
}
extern "C" void kernel_launch(void* const* d_in, const int* in_sizes, int n_in, void* d_out, int out_size, void* d_ws, size_t ws_size, hipStream_t stream) {
    static int ready = 0;
    if (ready == 0) {
        if (n_in != 16 || out_size != NTOK * DM || ws_size < WS_END) { fprintf(stderr, "kernel_launch: unexpected sizes (n_in %d out %d ws %zu, need %zu)\n", n_in, out_size, ws_size, (size_t)WS_END); ready = -1; return; }
#if N_LAUNCH_CUT || MEGASITES
        if (hipFuncSetAttribute((const void*)yoco_fwd<0x3FFF>, hipFuncAttributeMaxDynamicSharedMemorySize, LDS_BYTES) != hipSuccess) { fprintf(stderr, "kernel_launch: hipFuncSetAttribute failed\n"); ready = -1; return; }
#endif
        ready = 1;
    }
    if (ready < 0) return;
    (void)hipMemsetAsync(d_ws, 0, 16384, stream);
    Params p{};
    p.x = (const float*)d_in[0]; p.ln_mix = (const float*)d_in[1]; p.ln_ffn = (const float*)d_in[2]; p.ret_w_in = (const float*)d_in[3]; p.ret_w_out = (const float*)d_in[4]; p.ret_gn = (const float*)d_in[5];
    p.kv_norm = (const float*)d_in[6]; p.w_kv = (const float*)d_in[7]; p.att_w_q = (const float*)d_in[8]; p.att_w_o = (const float*)d_in[9]; p.att_rel_bias = (const float*)d_in[10];
    p.peer_w_q = (const float*)d_in[11]; p.peer_sub_keys = (const float*)d_in[12]; p.peer_u = (const float*)d_in[13]; p.peer_v = (const float*)d_in[14]; p.ln_final = (const float*)d_in[15];
    p.out = (float*)d_out; p.ws = (unsigned char*)d_ws;
#if N_LAUNCH_CUT == 2
    for (int s2 = 0; s2 < NSTEPS; ++s2) { p.lo = s2; p.hi = s2 + 1; hipLaunchKernelGGL((yoco_fwd<0x3FFF>), dim3(256), dim3(512), LDS_BYTES, stream, p); }
#elif N_LAUNCH_CUT
    p.lo = 0; p.hi = NSTEPS;
    hipLaunchKernelGGL((yoco_fwd<0x3FFF>), dim3(256), dim3(512), LDS_BYTES, stream, p);
#else
    static const int siteA[10] = {1, 2, 3, 6, 8, 9, 10, 11, 12, 13}, siteB[9] = {4, 5, 6, 8, 9, 10, 11, 12, 13};
    int s = 0;
#ifndef NSTOP
#define NSTOP 1000
#endif
    p.lo = s; p.hi = s + 1; launch_step_site(0, p, stream); ++s;
    for (int l = 0; l < DEPTH; ++l) { const int n = l < 2 ? 10 : 9; for (int k = 0; k < n; ++k) { p.lo = s; p.hi = s + 1; if (s < NSTOP) launch_step_site(l < 2 ? siteA[k] : siteB[k], p, stream); ++s; } }
    if (NSTOP < NSTEPS) { p.lo = -1; p.hi = -1; launch_step_site(14, p, stream); }
#endif
}
```

```cpp
#include <hip/hip_runtime.h>
#include <cstdio>
#include <cstdint>

#define LAS __attribute__((address_space(3)))
#define GAS __attribute__((address_space(1)))
typedef unsigned short bf16;
typedef unsigned u32x2 __attribute__((ext_vector_type(2)));
typedef float f32x2v __attribute__((ext_vector_type(2)));

constexpr int DM = 2048, NBATCH = 4, SEQ = 4096, NTOK = NBATCH * SEQ, DEPTH = 4;
constexpr int CHUNK = 64, NCHUNK = SEQ / CHUNK;
constexpr int RH = 8, RQK = 256, RV = 512, RQKW = RH * RQK, RVW = RH * RV, RIN = 2 * RQKW + 2 * RVW;
constexpr int AH = 16, AHD = 128, LEFT = 8, NREL = 257;
constexpr int PH = 8, PNK = 128, PE = PNK * PNK, PTOPK = 16;
constexpr float EPS = 1e-6f;

constexpr size_t MiB = 1ull << 20;
constexpr size_t WS_CTL = 0, CTL_BYTES = 1 * MiB;
constexpr size_t WS_ROT = 1 * MiB;
constexpr size_t WS_RS = 6 * MiB;
constexpr size_t WS_WIN = 8 * MiB;
constexpr size_t WS_WOUT = 104 * MiB;
constexpr size_t WS_WKV = 136 * MiB;
constexpr size_t WS_WQ = 152 * MiB;
constexpr size_t WS_WO = 168 * MiB;
constexpr size_t WS_WC = 184 * MiB;
constexpr size_t WS_PU = 216 * MiB;
constexpr size_t WS_PV = 472 * MiB;
constexpr size_t WS_H = 728 * MiB;
constexpr size_t WS_HKV = 792 * MiB;
constexpr size_t WS_Q = 856 * MiB;
constexpr size_t WS_K = 920 * MiB;
constexpr size_t WS_V = 984 * MiB;
constexpr size_t WS_G = 1112 * MiB;
constexpr size_t WS_O = 1240 * MiB;
constexpr size_t WS_KV = 1368 * MiB;
constexpr size_t WS_AO = 1496 * MiB;
constexpr size_t WS_SC = 1560 * MiB;
constexpr size_t WS_IDX = 1688 * MiB;
constexpr size_t WS_WGT = 1696 * MiB;
constexpr size_t WS_SQP = 1704 * MiB;
constexpr size_t WS_RSTD = 1706 * MiB;
constexpr size_t WS_END = 1708 * MiB;

constexpr int LDS_BYTES = 160 * 1024;
constexpr int LDS_MISC = LDS_BYTES - 256;

__device__ __forceinline__ unsigned f2bf(float f) { unsigned u = __builtin_bit_cast(unsigned, f); return (u + 0x7fffu + ((u >> 16) & 1u)) >> 16; }
typedef __bf16 bfx2_t __attribute__((ext_vector_type(2)));
__device__ __forceinline__ unsigned pk2(float lo, float hi) { const f32x2v v = {lo, hi}; return __builtin_bit_cast(unsigned, __builtin_convertvector(v, bfx2_t)); }
__device__ __forceinline__ float bflo(unsigned u) { return __builtin_bit_cast(float, u << 16); }
__device__ __forceinline__ float bfhi(unsigned u) { return __builtin_bit_cast(float, u & 0xffff0000u); }
__device__ __forceinline__ float wave_sum(float v) {
#pragma unroll
    for (int o = 1; o < 64; o <<= 1) v += __shfl_xor(v, o);
    return v;
}
#define VM_WAIT() asm volatile("s_waitcnt vmcnt(0)" ::: "memory")
#define LDS_WAIT() asm volatile("s_waitcnt lgkmcnt(0)" ::: "memory")

#define XB_TMO      128
#define XB_XCNT(j)  (256  + 64 * (j))
#define XB_XSUB(j)  (1280 + 64 * (j))
#define XB_XGEN(j)  (2304 + 64 * (j))
#define XB_TOP      3328
#define XB_TOPGEN   3392
#define XCD_BAR_WORDS 3456
#define XB_SPIN_CAP (1u << 18)

__device__ __forceinline__ unsigned xb_ld(unsigned* p)              { return __hip_atomic_load(p, __ATOMIC_RELAXED, __HIP_MEMORY_SCOPE_AGENT); }
__device__ __forceinline__ unsigned xb_add(unsigned* p, unsigned v) { return __hip_atomic_fetch_add(p, v, __ATOMIC_RELAXED, __HIP_MEMORY_SCOPE_AGENT); }
__device__ __forceinline__ unsigned xb_xcc_id() { return (unsigned)__builtin_amdgcn_s_getreg((3 << 11) | 20) & 0xFu; }
#define XB_SPIN(cond, bar) do { unsigned _sp = 0; while (cond) { __builtin_amdgcn_s_sleep(1); \
    if ((++_sp & 255u) == 0u) { if (xb_ld(&(bar)[XB_TMO])) break; if (_sp > XB_SPIN_CAP) { atomicAdd(&(bar)[XB_TMO], 1u); break; } } } } while (0)

struct XcdBarrier {
    unsigned* bar; unsigned x;
    volatile LAS unsigned* st;
};

__device__ __forceinline__ XcdBarrier xcd_barrier_post(unsigned* bar, volatile LAS unsigned* st) {
    XcdBarrier b; b.bar = bar; b.x = xb_xcc_id(); b.st = st;
    if (threadIdx.x == 0) (void)xb_add(&bar[XB_XCNT(b.x)], 1u);
    return b;
}
__device__ __forceinline__ void xcd_barrier_complete(unsigned* bar, unsigned x, unsigned& nloc, unsigned& nx) {
    const unsigned G = gridDim.x * gridDim.y * gridDim.z;
    unsigned sum, cnt, mine, sp = 0u;
    for (;;) {
        sum = 0u; cnt = 0u; mine = 0u;
#pragma unroll
        for (unsigned j = 0; j < 16; ++j) { const unsigned c = xb_ld(&bar[XB_XCNT(j)]); sum += c; cnt += (c > 0u) ? 1u : 0u; mine = (j == x) ? c : mine; }
        if (sum == G) break;
        __builtin_amdgcn_s_sleep(1);
        if ((++sp & 255u) == 0u) { if (xb_ld(&bar[XB_TMO])) break; if (sp > XB_SPIN_CAP) { atomicAdd(&bar[XB_TMO], 1u); break; } }
    }
    nloc = mine > 0u ? mine : 1u; nx = cnt > 0u ? cnt : 1u;
}

__device__ __forceinline__ void xcd_barrier(const XcdBarrier& b) {
    asm volatile("s_waitcnt vmcnt(0)" ::: "memory");
    __syncthreads();
    if (threadIdx.x == 0) {
        unsigned* bar = b.bar;
        __builtin_amdgcn_s_waitcnt(0);
        unsigned nloc = b.st[0], nx = b.st[1];
        if (nloc == 0u) { xcd_barrier_complete(bar, b.x, nloc, nx); b.st[0] = nloc; b.st[1] = nx; }
        const unsigned old = xb_add(&bar[XB_XSUB(b.x)], 1u);
        const unsigned gen = old / nloc;
        if (old + 1u == (gen + 1u) * nloc) {
            __builtin_amdgcn_fence(__ATOMIC_RELEASE, "agent");
            asm volatile("s_waitcnt vmcnt(0)" ::: "memory");
            const unsigned og = xb_add(&bar[XB_TOP], 1u);
            const unsigned tg = og / nx;
            if (og + 1u == (tg + 1u) * nx) xb_add(&bar[XB_TOPGEN], 1u);
            else XB_SPIN(xb_ld(&bar[XB_TOPGEN]) == tg, bar);
            __builtin_amdgcn_fence(__ATOMIC_ACQUIRE, "agent");
            xb_add(&bar[XB_XGEN(b.x)], 1u);
            asm volatile("s_waitcnt vmcnt(0)" ::: "memory");
        } else {
            XB_SPIN(xb_ld(&bar[XB_XGEN(b.x)]) == gen, bar);
            __builtin_amdgcn_fence(__ATOMIC_ACQUIRE, "agent");
            asm volatile("s_waitcnt vmcnt(0)" ::: "memory");
        }
    }
    __syncthreads();
}

namespace pg8 {
#define PG8_LAS __attribute__((address_space(3)))
typedef unsigned short bf16_t;
typedef short bf16x8 __attribute__((ext_vector_type(8)));
typedef float f32x4 __attribute__((ext_vector_type(4)));
typedef unsigned u32x4 __attribute__((ext_vector_type(4)));
constexpr int BM = 256, BK = 64, HALF = 128, HTB = HALF * BK * 2  , STAGE_BYTES = 8 * HTB, NXCD = 8, WGM = 8;

__host__ __device__ __forceinline__ int lds_byte(int r, int c) { const int st = (r >> 4) * 2 + (c >> 5), rr = r & 15, cc = c & 31, ob = rr * 64 + cc * 2; return st * 1024 + (ob ^ (((ob >> 9) & 1) << 5)); }
__host__ __device__ __forceinline__ void stage_rc(int b, int& R, int& C) { const int st = b / 1024, sb = b % 1024, swz = sb ^ (((sb >> 9) & 1) << 5); R = (st >> 1) * 16 + swz / 64; C = (st & 1) * 32 + (swz % 64) / 2; }
__host__ __device__ __forceinline__ int perm32(int rho) { const int n = rho >> 4, i = rho & 15; return 8 * (i >> 2) + 4 * n + (i & 3); }

struct Unit { int pm, pn; };
struct Gemm { const bf16_t* A; const bf16_t* Bt; int M, N, K; };

struct StaticOrder {
    int nM, nN, nwg, G, c;
    __host__ __device__ void init(int M, int N, int G_, int c_) { nM = M / BM; nN = N / BM; nwg = nM * nN; G = G_; c = c_; }
    __host__ __device__ bool next(int i, Unit& u) const {
        const long L = (long)i * G + c; if (L >= nwg) return false;
        int wgid = (int)L; { const int q = nwg / NXCD, r = nwg % NXCD, xcd = wgid % NXCD, off = wgid / NXCD; wgid = (xcd < r ? xcd * (q + 1) : r * (q + 1) + (xcd - r) * q) + off; }
        const int nig = WGM * nN, gid = wgid / nig, fm = gid * WGM, gsz = (nM - fm) < WGM ? (nM - fm) : WGM;
        u.pm = fm + ((wgid % nig) % gsz); u.pn = (wgid % nig) / gsz; return true;
    }
    __device__ __forceinline__ void a_ready(const Unit&) const {}
    __device__ __forceinline__ void done(const Unit&) const {}
};
struct CountedOrder : StaticOrder {
    const unsigned* ready; unsigned need; unsigned* tmo;
    __device__ __forceinline__ void a_ready(const Unit& u) const {
        if (threadIdx.x < 64) {
            const unsigned long long t0 = __builtin_amdgcn_s_memrealtime(); unsigned polls = 0;
            while ((unsigned)__builtin_amdgcn_readfirstlane(__hip_atomic_load(ready + 64 * u.pm, __ATOMIC_RELAXED, __HIP_MEMORY_SCOPE_AGENT)) < need) {
                if ((++polls & 255u) == 0u && __builtin_amdgcn_readfirstlane(__hip_atomic_load(tmo, __ATOMIC_RELAXED, __HIP_MEMORY_SCOPE_AGENT)) != 0u) break;
                if (__builtin_amdgcn_s_memrealtime() - t0 > 2000000ull) {
                    if (threadIdx.x == 0) { unsigned expect = 0u; __hip_atomic_compare_exchange_strong(tmo + 1, &expect, 0x600u | (unsigned)(u.pm & 0xff), __ATOMIC_RELAXED, __ATOMIC_RELAXED, __HIP_MEMORY_SCOPE_AGENT); __hip_atomic_store(tmo, 1u, __ATOMIC_RELAXED, __HIP_MEMORY_SCOPE_AGENT); }
                    break; }
                __builtin_amdgcn_s_sleep(2); }
            __builtin_amdgcn_fence(__ATOMIC_ACQUIRE, "agent");
            asm volatile("s_waitcnt vmcnt(0)" ::: "memory");
        }
#if !defined(BROKEN_HOOK_NO_BARRIER)
        asm volatile("" ::: "memory"); __builtin_amdgcn_s_barrier(); asm volatile("" ::: "memory");
#endif
    }
};

__device__ __forceinline__ unsigned cvt_pk_bf16(float lo, float hi) { return pk2(lo, hi); }
typedef float f32x2 __attribute__((ext_vector_type(2)));
__device__ __forceinline__ f32x2 gelu_pk(f32x2 v) {
    const f32x2 av = __builtin_elementwise_abs(v), d = av * 0.2316418882f + 1.0f;
    f32x2 t; t.x = __builtin_amdgcn_rcpf(d.x); t.y = __builtin_amdgcn_rcpf(d.y);
    f32x2 q = t * 0.5307027145f + (-0.7265760135f); q = q * t + 0.7107068705f; q = q * t + (-0.142248368f); q = q * t + 0.127414796f; q = q * t;
    const f32x2 s = (v * v) * (-0.72134752044f);
    f32x2 e; e.x = __builtin_amdgcn_exp2f(s.x); e.y = __builtin_amdgcn_exp2f(s.y);
    const f32x2 m = v * (q * e), r = v - m;
    f32x2 o; o.x = v.x < 0.f ? m.x : r.x; o.y = v.y < 0.f ? m.y : r.y; return o;
}


struct EpiF32 {
    static constexpr bool PERM = false, AFTER_DRAIN = false;
    float* C; int ldc;
    __device__ __forceinline__ void operator()(const f32x4 (&acc)[2][2][4][2], const Unit& u, int wr, int wc, int fr, int fq) const {
        const int row0 = u.pm * BM + wr * 64 + fr, col0 = u.pn * BM + wc * 32 + 4 * fq;
#pragma unroll
        for (int ai = 0; ai < 2; ++ai)
#pragma unroll
            for (int m = 0; m < 4; ++m) { float* rowp = C + (size_t)(row0 + ai * HALF + m * 16) * ldc + col0;
#pragma unroll
                for (int bj = 0; bj < 2; ++bj)
#pragma unroll
                    for (int n = 0; n < 2; ++n) *(f32x4*)(rowp + bj * HALF + n * 16) = acc[ai][bj][m][n]; }
    }
};
struct EpiRes {
    static constexpr bool PERM = false, AFTER_DRAIN = false;
    float* X; int ldc; bf16_t* Hn; const float* gn; float* sqp;
    __device__ __forceinline__ void operator()(const f32x4 (&acc)[2][2][4][2], const Unit& u, int wr, int wc, int fr, int fq) const {
        const int row0 = u.pm * BM + wr * 64 + fr, col0 = u.pn * BM + wc * 32 + 4 * fq;
        f32x4 gv[2][2];
#pragma unroll
        for (int bj = 0; bj < 2; ++bj)
#pragma unroll
            for (int n = 0; n < 2; ++n) gv[bj][n] = *(const f32x4*)(gn + col0 + bj * HALF + n * 16);
#pragma unroll
        for (int ai = 0; ai < 2; ++ai) {
            f32x4 old[4][2][2];
#pragma unroll
            for (int m = 0; m < 4; ++m) { const float* rp = X + (size_t)(row0 + ai * HALF + m * 16) * ldc + col0;
#pragma unroll
                for (int bj = 0; bj < 2; ++bj)
#pragma unroll
                    for (int n = 0; n < 2; ++n) old[m][bj][n] = *(const f32x4*)(rp + bj * HALF + n * 16); }
#pragma unroll
            for (int m = 0; m < 4; ++m) { const int r = row0 + ai * HALF + m * 16; float* rowp = X + (size_t)r * ldc + col0; bf16_t* hp = Hn + (size_t)r * ldc + col0;
                float ss = 0.f;
#pragma unroll
                for (int bj = 0; bj < 2; ++bj)
#pragma unroll
                    for (int n = 0; n < 2; ++n) { const f32x4 xn = old[m][bj][n] + acc[ai][bj][m][n]; *(f32x4*)(rowp + bj * HALF + n * 16) = xn;
                        ss += (xn[0] * xn[0] + xn[1] * xn[1]) + (xn[2] * xn[2] + xn[3] * xn[3]);
                        const f32x4 hg = xn * gv[bj][n]; u32x2 hw; hw.x = pk2(hg[0], hg[1]); hw.y = pk2(hg[2], hg[3]); *(u32x2*)(hp + bj * HALF + n * 16) = hw; }
                ss += __shfl_xor(ss, 16); ss += __shfl_xor(ss, 32);
                if (fq == 0) sqp[(size_t)r * 32 + u.pn * 4 + wc] = ss; }
        }
    }
};
struct EpiBf16S {
    static constexpr bool PERM = true, AFTER_DRAIN = false;
    bf16_t* O; int ldc; float scale;
    __device__ __forceinline__ void operator()(const f32x4 (&acc)[2][2][4][2], const Unit& u, int wr, int wc, int fr, int fq) const {
        const int row0 = u.pm * BM + wr * 64 + fr, col0 = u.pn * BM + wc * 32 + 8 * fq;
#pragma unroll
        for (int ai = 0; ai < 2; ++ai)
#pragma unroll
            for (int m = 0; m < 4; ++m) { bf16_t* rowp = O + (size_t)(row0 + ai * HALF + m * 16) * ldc + col0;
#pragma unroll
                for (int bj = 0; bj < 2; ++bj) { const f32x4 v0 = acc[ai][bj][m][0] * scale, v1 = acc[ai][bj][m][1] * scale;
                    u32x4 w; w.x = cvt_pk_bf16(v0[0], v0[1]); w.y = cvt_pk_bf16(v0[2], v0[3]); w.z = cvt_pk_bf16(v1[0], v1[1]); w.w = cvt_pk_bf16(v1[2], v1[3]);
                    *(u32x4*)(rowp + bj * HALF) = w; } }
    }
};
struct EpiProj {
    static constexpr bool PERM = true, AFTER_DRAIN = false;
    bf16_t *Q, *Kp, *V, *G; const float* rot;
    __device__ __forceinline__ void operator()(const f32x4 (&acc)[2][2][4][2], const Unit& u, int wr, int wc, int fr, int fq) const {
        const int row0 = u.pm * BM + wr * 64 + fr, pn = u.pn, dd0 = wc * 32 + 8 * fq;
        if (pn < 16) {
            bf16_t* base = (pn < 8 ? Q : Kp) + (pn & 7) * 256 + dd0; const float sc = pn < 8 ? 1.0f : 0.0625f;
#pragma unroll
            for (int ai = 0; ai < 2; ++ai)
#pragma unroll
                for (int m = 0; m < 4; ++m) { const int r = row0 + ai * HALF + m * 16; const float* rt = rot + (size_t)(r & (4096 - 1)) * 256 + dd0;
                    f32x4 o1[2], o2[2];
#pragma unroll
                    for (int n = 0; n < 2; ++n) { const f32x4 cs = *(const f32x4*)(rt + 4 * n), sn = *(const f32x4*)(rt + 128 + 4 * n); const f32x4 t1 = acc[ai][0][m][n], t2 = acc[ai][1][m][n];
                        o1[n] = (t1 * cs - t2 * sn) * sc; o2[n] = (t1 * sn + t2 * cs) * sc; }
                    u32x4 w1, w2;
                    w1.x = cvt_pk_bf16(o1[0][0], o1[0][1]); w1.y = cvt_pk_bf16(o1[0][2], o1[0][3]); w1.z = cvt_pk_bf16(o1[1][0], o1[1][1]); w1.w = cvt_pk_bf16(o1[1][2], o1[1][3]);
                    w2.x = cvt_pk_bf16(o2[0][0], o2[0][1]); w2.y = cvt_pk_bf16(o2[0][2], o2[0][3]); w2.z = cvt_pk_bf16(o2[1][0], o2[1][1]); w2.w = cvt_pk_bf16(o2[1][2], o2[1][3]);
                    bf16_t* rowp = base + (size_t)r * 2048; *(u32x4*)rowp = w1; *(u32x4*)(rowp + 128) = w2; }
        } else {
            bf16_t* base = (pn < 32 ? V : G) + ((pn - 16) & 15) * 256 + dd0;
#pragma unroll
            for (int ai = 0; ai < 2; ++ai)
#pragma unroll
                for (int m = 0; m < 4; ++m) { bf16_t* rowp = base + (size_t)(row0 + ai * HALF + m * 16) * 4096;
#pragma unroll
                    for (int bj = 0; bj < 2; ++bj) { const f32x4 v0 = acc[ai][bj][m][0], v1 = acc[ai][bj][m][1];
                        u32x4 w; w.x = cvt_pk_bf16(v0[0], v0[1]); w.y = cvt_pk_bf16(v0[2], v0[3]); w.z = cvt_pk_bf16(v1[0], v1[1]); w.w = cvt_pk_bf16(v1[2], v1[3]);
                        *(u32x4*)(rowp + bj * HALF) = w; } }
        }
    }
};
template <class Epi, class Sched, bool STAMP = false>
__device__ __forceinline__ void gemm_phase(PG8_LAS unsigned char* lds, const Gemm g, const Sched& S, const Epi& E, unsigned long long* stamps) {
    int tid_ = threadIdx.x; asm volatile("" : "+v"(tid_));
    const int tid = tid_, wid = __builtin_amdgcn_readfirstlane(tid >> 6), lane = tid & 63, wr = wid >> 2, wc = wid & 3, fr = lane & 15, fq = lane >> 4;
    const int K = g.K, nt = K / BK;
    int ts_lo = 0, ts_hi = 0, nts = 0; const unsigned long long rt_entry = STAMP ? (unsigned long long)wall_clock64() : 0ull;
#define PG8_STAMP() do { if (STAMP && wid == 0 && nts < 64) { const unsigned long long _c = (unsigned long long)clock64(); \
        ts_lo = (lane == nts) ? (int)(unsigned)_c : ts_lo; ts_hi = (lane == nts) ? (int)(unsigned)(_c >> 32) : ts_hi; ++nts; } } while (0)
    PG8_STAMP();
    unsigned voffA[2], voffB[2];
#pragma unroll
    for (int i = 0; i < 2; ++i) { int R, C; stage_rc(tid * 16 + i * 8192, R, C); const int Rb = Epi::PERM ? ((R & ~31) + perm32(R & 31)) : R;
        voffA[i] = (unsigned)(R * K + C) * 2u; voffB[i] = (unsigned)(Rb * K + C) * 2u; }
    const size_t kstep = (size_t)(BK * 2);
    const size_t hstep = (size_t)HALF * K * 2;
    const size_t tstep = 2 * hstep;
    const unsigned ldsw = (unsigned)wid * 1024u;
    const int aoff = lds_byte(wr * 64 + fr, fq * 8), boff = lds_byte(wc * 32 + fr, fq * 8);
#define PG8_SA(b, h) (((b) * 2 + (h)) * HTB)
#define PG8_SB(b, h) ((4 + (b) * 2 + (h)) * HTB)
#define PG8_STAGE(bufoff, gbase, voff) do { _Pragma("unroll") for (int _i = 0; _i < 2; ++_i) \
        __builtin_amdgcn_global_load_lds((const unsigned*)((const char*)(gbase) + (voff)[_i]), (PG8_LAS unsigned*)(lds + (bufoff) + ldsw + _i * 8192), 16, 0, 0); } while (0)
#define PG8_LDA(dst, b, h) do { _Pragma("unroll") for (int m = 0; m < 4; ++m) _Pragma("unroll") for (int k = 0; k < 2; ++k) dst[m][k] = *(const PG8_LAS bf16x8*)(lds + PG8_SA(b, h) + aoff + m * 2048 + k * 1024); } while (0)
#define PG8_LDB(dst, b, h) do { _Pragma("unroll") for (int n = 0; n < 2; ++n) _Pragma("unroll") for (int k = 0; k < 2; ++k) dst[n][k] = *(const PG8_LAS bf16x8*)(lds + PG8_SB(b, h) + boff + n * 2048 + k * 1024); } while (0)
#define PG8_MMA(ai, bj, At, Bt) do { __builtin_amdgcn_s_setprio(1); _Pragma("unroll") for (int m = 0; m < 4; ++m) _Pragma("unroll") for (int n = 0; n < 2; ++n) _Pragma("unroll") for (int k = 0; k < 2; ++k) \
        acc[ai][bj][m][n] = __builtin_amdgcn_mfma_f32_16x16x32_bf16(Bt[n][k], At[m][k], acc[ai][bj][m][n], 0, 0, 0); __builtin_amdgcn_s_setprio(0); } while (0)
#define PG8_WAIT_V(n) asm volatile("s_waitcnt vmcnt(" #n ")" ::: "memory")
#define PG8_WAIT_L(n) asm volatile("s_waitcnt lgkmcnt(" #n ")" ::: "memory")
#define PG8_BAR __builtin_amdgcn_s_barrier()
#define PG8_SCHED __builtin_amdgcn_sched_barrier(0)
    Unit cur, nxt; int ui = 0;
    if (!S.next(0, cur)) return;
    f32x4 acc[2][2][4][2];
#pragma unroll
    for (int a = 0; a < 2; ++a)
#pragma unroll
        for (int b = 0; b < 2; ++b)
#pragma unroll
            for (int m = 0; m < 4; ++m)
#pragma unroll
                for (int n = 0; n < 2; ++n) acc[a][b][m][n] = (f32x4){0.f, 0.f, 0.f, 0.f};
    bf16x8 At[4][2], B0[2][2], B1[2][2];
    const char* cA = (const char*)g.A + (size_t)cur.pm * tstep; const char* cB = (const char*)g.Bt + (size_t)cur.pn * tstep;
    S.a_ready(cur);
    PG8_STAGE(PG8_SB(0, 0), cB, voffB); PG8_STAGE(PG8_SA(0, 0), cA, voffA); PG8_STAGE(PG8_SB(0, 1), cB + hstep, voffB); PG8_STAGE(PG8_SA(0, 1), cA + hstep, voffA);
    if (wr == 1) PG8_BAR;
    PG8_WAIT_V(4); PG8_BAR;
    PG8_STAGE(PG8_SB(1, 0), cB + kstep, voffB); PG8_STAGE(PG8_SA(1, 0), cA + kstep, voffA); PG8_STAGE(PG8_SB(1, 1), cB + hstep + kstep, voffB);
    PG8_WAIT_V(6); PG8_BAR;
    PG8_STAMP();
    for (;;) {
        const bool has_next = S.next(ui + 1, nxt);
        const char* nA = has_next ? (const char*)g.A + (size_t)nxt.pm * tstep : cA; const char* nB = has_next ? (const char*)g.Bt + (size_t)nxt.pn * tstep : cB;
        for (int t = 0; t < nt; t += 2) {
            const bool last = (t == nt - 2);
            const char* a1 = cA + (size_t)(t + 1) * kstep;
            const char* a2 = last ? nA : cA + (size_t)(t + 2) * kstep; const char* b2 = last ? nB : cB + (size_t)(t + 2) * kstep;
            const char* a3 = a2 + kstep; const char* b3 = b2 + kstep;
            if (last && has_next) S.a_ready(nxt);
            PG8_LDB(B0, 0, 0); PG8_SCHED; PG8_LDA(At, 0, 0); PG8_STAGE(PG8_SA(1, 1), a1 + hstep, voffA);
            PG8_WAIT_L(8); PG8_BAR; PG8_WAIT_L(0); PG8_MMA(0, 0, At, B0); PG8_BAR; PG8_SCHED;
            PG8_LDB(B1, 0, 1); PG8_STAGE(PG8_SB(0, 0), b2, voffB);
            PG8_BAR; PG8_WAIT_L(0); PG8_MMA(0, 1, At, B1); PG8_BAR;
            PG8_LDA(At, 0, 1); PG8_STAGE(PG8_SA(0, 0), a2, voffA);
            PG8_BAR; PG8_WAIT_L(0); PG8_MMA(1, 0, At, B0); PG8_BAR; PG8_SCHED;
            PG8_STAGE(PG8_SB(0, 1), b2 + hstep, voffB);
            PG8_WAIT_V(6); PG8_BAR; PG8_MMA(1, 1, At, B1); PG8_BAR;
            PG8_LDB(B0, 1, 0); PG8_SCHED; PG8_LDA(At, 1, 0); PG8_STAGE(PG8_SA(0, 1), a2 + hstep, voffA);
            PG8_WAIT_L(8); PG8_BAR; PG8_WAIT_L(0); PG8_MMA(0, 0, At, B0); PG8_BAR; PG8_SCHED;
            PG8_LDB(B1, 1, 1); PG8_STAGE(PG8_SB(1, 0), b3, voffB);
            PG8_BAR; PG8_WAIT_L(0); PG8_MMA(0, 1, At, B1); PG8_BAR;
            PG8_LDA(At, 1, 1); PG8_STAGE(PG8_SA(1, 0), a3, voffA);
            PG8_BAR; PG8_WAIT_L(0); PG8_MMA(1, 0, At, B0); PG8_BAR; PG8_SCHED;
            PG8_STAGE(PG8_SB(1, 1), b3 + hstep, voffB);
            PG8_WAIT_V(6); PG8_BAR; PG8_MMA(1, 1, At, B1); PG8_BAR;
        }
        PG8_STAMP();
        if constexpr (!Epi::AFTER_DRAIN) { E(acc, cur, wr, wc, fr, fq); S.done(cur); }
        PG8_STAMP();
        if (!has_next) break;
#pragma unroll
        for (int a = 0; a < 2; ++a)
#pragma unroll
            for (int b = 0; b < 2; ++b)
#pragma unroll
                for (int m = 0; m < 4; ++m)
#pragma unroll
                    for (int n = 0; n < 2; ++n) acc[a][b][m][n] = (f32x4){0.f, 0.f, 0.f, 0.f};
        cur = nxt; cA = nA; cB = nB; ++ui;
    }
    PG8_WAIT_V(0);
    if (wr == 0) PG8_BAR;
    PG8_BAR;
    if constexpr (Epi::AFTER_DRAIN) { E.fused(acc, cur, wr, wc, fr, fq, lds, wid, lane); S.done(cur); }
    PG8_STAMP();
    if (STAMP && wid == 0) { stamps[lane] = lane < nts ? (((unsigned long long)(unsigned)ts_hi << 32) | (unsigned)ts_lo) : 0ull;
        if (lane == 62) stamps[62] = rt_entry; if (lane == 63) stamps[63] = (unsigned long long)wall_clock64(); }
#undef PG8_STAMP
#undef PG8_SA
#undef PG8_SB
#undef PG8_STAGE
#undef PG8_LDA
#undef PG8_LDB
#undef PG8_MMA
#undef PG8_WAIT_V
#undef PG8_WAIT_L
#undef PG8_BAR
#undef PG8_SCHED
}
}

using pg8::bf16x8; using pg8::f32x4; using pg8::u32x4;
typedef short s16x4 __attribute__((ext_vector_type(4)));
typedef __bf16 bfx2 __attribute__((ext_vector_type(2)));

struct Params {
    const float *x, *ln_mix, *ln_ffn, *ret_w_in, *ret_w_out, *ret_gn, *kv_norm, *w_kv, *att_w_q, *att_w_o, *att_rel_bias, *peer_w_q, *peer_sub_keys, *peer_u, *peer_v, *ln_final;
    float* out; unsigned char* ws; int lo, hi;
};
struct Ctx { LAS unsigned char* lds; int tid, lane, wave, bx, G, gw, ngw; };

__device__ __forceinline__ float dot2bf(unsigned a, unsigned b, float c) { return __builtin_amdgcn_fdot2_f32_bf16(__builtin_bit_cast(bfx2, a), __builtin_bit_cast(bfx2, b), c, false); }
__device__ __forceinline__ bf16x8 lds128(LAS const unsigned char* p) { return *(LAS const bf16x8*)p; }
__device__ __forceinline__ bf16x8 tr_frag(unsigned a0, unsigned a1) {
    s16x4 lo, hi;
    asm volatile("ds_read_b64_tr_b16 %0, %2\n\tds_read_b64_tr_b16 %1, %3\n\ts_waitcnt lgkmcnt(0)" : "=&v"(lo), "=&v"(hi) : "v"(a0), "v"(a1) : "memory");
    bf16x8 r; r[0] = lo[0]; r[1] = lo[1]; r[2] = lo[2]; r[3] = lo[3]; r[4] = hi[0]; r[5] = hi[1]; r[6] = hi[2]; r[7] = hi[3]; return r;
}
#define MFMA16(a, b, c) __builtin_amdgcn_mfma_f32_16x16x32_bf16((a), (b), (c), 0, 0, 0)

__device__ __forceinline__ void load_row(const float* xrow, int lane, f32x4 (&v)[8]) {
    const f32x4* xr = (const f32x4*)xrow + lane;
#pragma unroll
    for (int j = 0; j < 8; ++j) v[j] = xr[64 * j];
}
__device__ __forceinline__ float row_rstd(const f32x4 (&v)[8]) {
    float s = 0.f;
#pragma unroll
    for (int j = 0; j < 8; ++j) s += (v[j][0] * v[j][0] + v[j][1] * v[j][1]) + (v[j][2] * v[j][2] + v[j][3] * v[j][3]);
    return 1.0f / sqrtf(wave_sum(s) * (1.0f / DM) + EPS);
}
__device__ __forceinline__ void store_norm_bf16(const f32x4 (&v)[8], float rstd, const float* g, bf16* orow, int lane) {
    const f32x4* gr = (const f32x4*)g + lane; u32x2* o8 = (u32x2*)orow + lane;
#pragma unroll
    for (int j = 0; j < 8; ++j) { const f32x4 gv = gr[64 * j]; u32x2 w; w.x = pk2(v[j][0] * rstd * gv[0], v[j][1] * rstd * gv[1]); w.y = pk2(v[j][2] * rstd * gv[2], v[j][3] * rstd * gv[3]); o8[64 * j] = w; }
}
__device__ __forceinline__ void load_g(const float* g, int lane, f32x4 (&gv)[8]) {
    const f32x4* gr = (const f32x4*)g + lane;
#pragma unroll
    for (int j = 0; j < 8; ++j) gv[j] = gr[64 * j];
}
__device__ __forceinline__ void store_norm_bf16_r(const f32x4 (&v)[8], float rstd, const f32x4 (&gv)[8], bf16* orow, int lane) {
    u32x2* o8 = (u32x2*)orow + lane;
#pragma unroll
    for (int j = 0; j < 8; ++j) { u32x2 w; w.x = pk2(v[j][0] * rstd * gv[j][0], v[j][1] * rstd * gv[j][1]); w.y = pk2(v[j][2] * rstd * gv[j][2], v[j][3] * rstd * gv[j][3]); o8[64 * j] = w; }
}
__device__ __forceinline__ unsigned q8pack(float a, float b, float c, float d) {
    const unsigned ua = __builtin_bit_cast(unsigned, a + 12582912.0f), ub = __builtin_bit_cast(unsigned, b + 12582912.0f), uc = __builtin_bit_cast(unsigned, c + 12582912.0f), ud = __builtin_bit_cast(unsigned, d + 12582912.0f);
    return (ua & 255u) | ((ub & 255u) << 8) | ((uc & 255u) << 16) | (ud << 24);
}

__device__ __forceinline__ void p0_transpose_item(const float* W, int K, int N, bf16* WT, LAS float* scr, int item, int lane) {
    const int nblk = N / 32, kb = item / nblk, nb = item % nblk, k0 = 64 * kb, n0 = 32 * nb;
    float tv[32];
#pragma unroll
    for (int i = 0; i < 32; ++i) { const int kk = 2 * i + (lane >> 5); tv[i] = W[(size_t)(k0 + kk) * N + n0 + (lane & 31)]; }
#pragma unroll
    for (int i = 0; i < 32; ++i) { const int kk = 2 * i + (lane >> 5); scr[kk * 33 + (lane & 31)] = tv[i]; }
    LDS_WAIT(); asm volatile("" ::: "memory");
    const int c = lane & 7;
#pragma unroll
    for (int j = 0; j < 4; ++j) { const int n = (lane >> 3) + 8 * j; const LAS float* s = scr + (8 * c) * 33 + n;
        u32x4 o; o.x = pk2(s[0 * 33], s[1 * 33]); o.y = pk2(s[2 * 33], s[3 * 33]); o.z = pk2(s[4 * 33], s[5 * 33]); o.w = pk2(s[6 * 33], s[7 * 33]);
        *(u32x4*)(WT + (size_t)(n0 + n) * K + k0 + 8 * c) = o; }
    LDS_WAIT(); asm volatile("" ::: "memory");
}
__device__ __forceinline__ void p0_fold_tile(const Params& p, const Ctx& c, int tl) {
    const int l = tl >> 9, hp = (tl >> 5) & 15, j0 = (tl & 31) * 64;
    LAS float* As = (LAS float*)c.lds;
    LAS float* Bs = (LAS float*)c.lds + 64 * 132;
    const float* Wq = p.peer_w_q + (size_t)l * DM * DM; const float* sk = p.peer_sub_keys + ((size_t)l * 2 + (hp & 1)) * PNK * 128;
    __syncthreads();
    for (int i = c.tid; i < 64 * 32; i += 512) { const int jj = i >> 5, d4 = i & 31; *(LAS f32x4*)(As + jj * 132 + d4 * 4) = *(const f32x4*)(Wq + (size_t)(j0 + jj) * DM + hp * 128 + d4 * 4); }
    for (int i = c.tid; i < 128 * 32; i += 512) { const int k = i >> 5, d4 = i & 31; *(LAS f32x4*)(Bs + k * 132 + d4 * 4) = *(const f32x4*)(sk + (size_t)k * 128 + d4 * 4); }
    __syncthreads();
    const int tj = c.tid & 15, tk = c.tid >> 4;
    float acc[4][4];
#pragma unroll
    for (int b = 0; b < 4; ++b)
#pragma unroll
        for (int a = 0; a < 4; ++a) acc[b][a] = 0.f;
    for (int d4 = 0; d4 < 32; ++d4) {
        f32x4 av[4], bv[4];
#pragma unroll
        for (int a = 0; a < 4; ++a) av[a] = *(LAS const f32x4*)(As + (tj + 16 * a) * 132 + d4 * 4);
#pragma unroll
        for (int b = 0; b < 4; ++b) bv[b] = *(LAS const f32x4*)(Bs + (tk * 4 + b) * 132 + d4 * 4);
#pragma unroll
        for (int b = 0; b < 4; ++b)
#pragma unroll
            for (int a = 0; a < 4; ++a) acc[b][a] += (av[a][0] * bv[b][0] + av[a][1] * bv[b][1]) + (av[a][2] * bv[b][2] + av[a][3] * bv[b][3]);
    }
    bf16* WcT = (bf16*)(p.ws + WS_WC) + (size_t)l * DM * DM;
#pragma unroll
    for (int b = 0; b < 4; ++b)
#pragma unroll
        for (int a = 0; a < 4; ++a) WcT[(size_t)(hp * 128 + tk * 4 + b) * DM + j0 + tj + 16 * a] = (bf16)f2bf(acc[b][a]);
}
__device__ __forceinline__ void p0_prologue(const Params& p, const Ctx& c) {
#ifndef PROREP
#define PROREP 0
#endif
    const bool fold_last = (c.bx & 1) != 0;
    if (!fold_last) {
    for (int tl = c.bx; tl < DEPTH * 16 * 32; tl += c.G) p0_fold_tile(p, c, tl);
    __syncthreads();
    }
    for (int rp_ = ((PROREP >> 1) & 1) ? 0 : 1; rp_ < 2; ++rp_)
    {
        LAS float* scr = (LAS float*)(c.lds + c.wave * 16384);
        constexpr int I_IN = (DM / 64) * (RIN / 32), I_OUT = (RVW / 64) * (DM / 32), I_KV = (DM / 64) * (2 * DM / 32), I_SQ = (DM / 64) * (DM / 32);
        constexpr int NITEMS = 2 * I_IN + 2 * I_OUT + I_KV + 4 * I_SQ;
        for (int it = c.gw; it < NITEMS; it += c.ngw) {
            int r = it;
            if (r < 2 * I_IN) { const int l = r / I_IN; p0_transpose_item(p.ret_w_in + (size_t)l * DM * RIN, DM, RIN, (bf16*)(p.ws + WS_WIN) + (size_t)l * RIN * DM, scr, r % I_IN, c.lane); continue; } r -= 2 * I_IN;
            if (r < 2 * I_OUT) { const int l = r / I_OUT; p0_transpose_item(p.ret_w_out + (size_t)l * RVW * DM, RVW, DM, (bf16*)(p.ws + WS_WOUT) + (size_t)l * DM * RVW, scr, r % I_OUT, c.lane); continue; } r -= 2 * I_OUT;
            if (r < I_KV) { p0_transpose_item(p.w_kv, DM, 2 * DM, (bf16*)(p.ws + WS_WKV), scr, r, c.lane); continue; } r -= I_KV;
            if (r < 2 * I_SQ) { const int l = r / I_SQ; p0_transpose_item(p.att_w_q + (size_t)l * DM * DM, DM, DM, (bf16*)(p.ws + WS_WQ) + (size_t)l * DM * DM, scr, r % I_SQ, c.lane); continue; } r -= 2 * I_SQ;
            { const int l = r / I_SQ; p0_transpose_item(p.att_w_o + (size_t)l * DM * DM, DM, DM, (bf16*)(p.ws + WS_WO) + (size_t)l * DM * DM, scr, r % I_SQ, c.lane); }
        }
    }
    for (int rp_ = ((PROREP >> 2) & 1) ? 0 : 1; rp_ < 2; ++rp_)
    {
        float* rs = (float*)(p.ws + WS_RS);
        for (int row = c.gw; row < 2 * DEPTH * PE; row += c.ngw) {
            const int which = row >= DEPTH * PE, r = row - which * DEPTH * PE;
            f32x4 v[8]; load_row((which ? p.peer_v : p.peer_u) + (size_t)r * DM, c.lane, v);
            float am = 0.f;
#pragma unroll
            for (int j = 0; j < 8; ++j) am = fmaxf(fmaxf(am, fmaxf(fabsf(v[j][0]), fabsf(v[j][1]))), fmaxf(fabsf(v[j][2]), fabsf(v[j][3])));
#pragma unroll
            for (int o = 1; o < 64; o <<= 1) am = fmaxf(am, __shfl_xor(am, o));
            int e = (int)((__builtin_bit_cast(unsigned, am) >> 23) & 0xffu) - 127; if (am == 0.f) e = 7;
            int k = 7 - e; k = k < -100 ? -100 : (k > 100 ? 100 : k);
            const float sc = __builtin_bit_cast(float, (unsigned)(k + 127) << 23), rsc = __builtin_bit_cast(float, (unsigned)(127 - k) << 23);
            const int lyr = r / PE, re = r % PE;
            unsigned char* dstb = p.ws + (which ? WS_PV : WS_PU) + (size_t)lyr * PE * DM + (size_t)re * 128;
            if (which) {
#pragma unroll
                for (int j = 0; j < 8; ++j) { int w = 0; w = __builtin_amdgcn_cvt_pk_fp8_f32(v[j][0] * sc, v[j][1] * sc, w, false); w = __builtin_amdgcn_cvt_pk_fp8_f32(v[j][2] * sc, v[j][3] * sc, w, true); { const int col = 4 * c.lane + 256 * j; *(unsigned*)(dstb + (size_t)(col >> 7) * PE * 128 + (col & 127)) = (unsigned)w; } }
                if (c.lane == 0) rs[row] = rsc;
            } else {
                const float s8 = am > 0.f ? 127.0f / am : 0.f;
#pragma unroll
                for (int j = 0; j < 8; ++j) { const unsigned w = q8pack(v[j][0] * s8, v[j][1] * s8, v[j][2] * s8, v[j][3] * s8); const int col = 4 * c.lane + 256 * j; *(unsigned*)(dstb + (size_t)(col >> 7) * PE * 128 + (col & 127)) = w; }
                if (c.lane == 0) rs[row] = am * (1.0f / 127.0f);
            }
        }
    }
    for (int rp_ = ((PROREP >> 3) & 1) ? 0 : 1; rp_ < 2; ++rp_)
    {
        float* rot = (float*)(p.ws + WS_ROT);
        for (int i = c.bx * 512 + c.tid; i < SEQ * 128; i += c.G * 512) { const int pos = i >> 7, d = i & 127;
            const float inv = (float)(1.0 / pow(10000.0, (double)d / 128.0)); const float ang = (float)pos * inv;
            rot[(size_t)pos * 256 + d] = (float)cos((double)ang); rot[(size_t)pos * 256 + 128 + d] = (float)sin((double)ang); }
    }
    for (int rp_ = ((PROREP >> 4) & 1) ? 0 : 1; rp_ < 2; ++rp_)
    { f32x4 gv[8]; load_g(p.ln_mix, c.lane, gv);
      for (int m = c.gw; m < NTOK; m += c.ngw) {
        f32x4 v[8]; load_row(p.x + (size_t)m * DM, c.lane, v);
        f32x4* xo = (f32x4*)(p.out + (size_t)m * DM) + c.lane;
#pragma unroll
        for (int j = 0; j < 8; ++j) xo[64 * j] = v[j];
        store_norm_bf16_r(v, row_rstd(v), gv, (bf16*)(p.ws + WS_H) + (size_t)m * DM, c.lane);
      } }
    if (fold_last) {
    __syncthreads();
    for (int tl = c.bx; tl < DEPTH * 16 * 32; tl += c.G) p0_fold_tile(p, c, tl);
    __syncthreads();
    }
}

constexpr int RS_QS = 0, RS_KS = 33792, RS_VS = 67584, RS_VZ = 76800, RS_PS = 86016, RS_RS = 95232, RS_END = 129024, QK_STR = 528, V_STR = 144;
__device__ __forceinline__ void ret_scan_unit(const Ctx& c, const bf16* Qg, const bf16* Kg, const bf16* Vg, bf16* Og, int unit) {
    const int xg = unit & 7, slot = unit >> 3, pair = xg * 4 + (slot >> 3), es = slot & 7, b = pair >> 3, h = pair & 7;
    const int tid = c.tid, lane = c.lane, w = c.wave, fr = lane & 15, fq = lane >> 4, tq = (lane & 15) >> 2, tp = lane & 3;
    LAS unsigned char* lds = c.lds;
    const float lgam = log1pf(-exp2f(-5.0f - (float)h));
    const float cdec = expf(lgam * 64.0f);
    const int lrow = tid >> 3, lch = tid & 7;
    const size_t tok0 = (size_t)b * SEQ;
    const bf16* qrow = Qg + (tok0 + lrow) * RQKW + h * RQK + lch * 8;
    const bf16* krow = Kg + (tok0 + lrow) * RQKW + h * RQK + lch * 8;
    const bf16* vrow = Vg + (tok0 + lrow) * RVW + h * RV + es * 64 + lch * 8;
    const float zeta = expf(lgam * (float)(63 - lrow));
    u32x4 pq[4], pk[4], pv;
#pragma unroll
    for (int cc = 0; cc < 4; ++cc) { pq[cc] = *(const u32x4*)(qrow + cc * 64); pk[cc] = *(const u32x4*)(krow + cc * 64); }
    pv = *(const u32x4*)vrow;
    __syncthreads();
    for (int i = tid; i < (RS_END - RS_RS) / 16; i += 512) *(LAS u32x4*)(lds + RS_RS + i * 16) = (u32x4){0u, 0u, 0u, 0u};
    f32x4 Racc[2][4];
#pragma unroll
    for (int x = 0; x < 2; ++x)
#pragma unroll
        for (int y = 0; y < 4; ++y) Racc[x][y] = (f32x4){0.f, 0.f, 0.f, 0.f};
    const int jt = w & 3, it0 = 2 * (w >> 2);
    const int it = w & 3, et0 = 2 * (w >> 2);
    float xi[4];
#pragma unroll
    for (int r = 0; r < 4; ++r) xi[r] = expf(lgam * (float)(16 * it + 4 * fq + r + 1));
    const unsigned ldsb = (unsigned)(size_t)lds;
    float dmask[2][4];
#pragma unroll
    for (int x = 0; x < 2; ++x)
#pragma unroll
        for (int r = 0; r < 4; ++r) { const int i = 16 * (it0 + x) + fr, j = 16 * jt + 4 * fq + r; dmask[x][r] = (i >= j) ? expf(lgam * (float)(i - j)) : 0.f; }
    asm volatile("" : "+v"(dmask[0][0]), "+v"(dmask[0][1]), "+v"(dmask[0][2]), "+v"(dmask[0][3]), "+v"(dmask[1][0]), "+v"(dmask[1][1]), "+v"(dmask[1][2]), "+v"(dmask[1][3]));
    for (int n = 0; n < NCHUNK; ++n) {
        __syncthreads();
#pragma unroll
        for (int cc = 0; cc < 4; ++cc) { *(LAS u32x4*)(lds + RS_QS + lrow * QK_STR + (lch + 8 * cc) * 16) = pq[cc]; *(LAS u32x4*)(lds + RS_KS + lrow * QK_STR + (lch + 8 * cc) * 16) = pk[cc]; }
        *(LAS u32x4*)(lds + RS_VS + lrow * V_STR + lch * 16) = pv;
        { u32x4 z; z.x = pk2(bflo(pv.x) * zeta, bfhi(pv.x) * zeta); z.y = pk2(bflo(pv.y) * zeta, bfhi(pv.y) * zeta); z.z = pk2(bflo(pv.z) * zeta, bfhi(pv.z) * zeta); z.w = pk2(bflo(pv.w) * zeta, bfhi(pv.w) * zeta);
          *(LAS u32x4*)(lds + RS_VZ + lrow * V_STR + lch * 16) = z; }
        __syncthreads();
        if (n + 1 < NCHUNK) {
            const size_t adv = (size_t)(n + 1) * CHUNK;
#pragma unroll
            for (int cc = 0; cc < 4; ++cc) { pq[cc] = *(const u32x4*)(qrow + adv * RQKW + cc * 64); pk[cc] = *(const u32x4*)(krow + adv * RQKW + cc * 64); }
            pv = *(const u32x4*)(vrow + adv * RVW);
        }
        {
            f32x4 s0 = (f32x4){0.f, 0.f, 0.f, 0.f}, s1 = s0;
#pragma unroll
            for (int kh = 0; kh < 2; ++kh) {
                bf16x8 fa[4], fb0[4], fb1[4];
#pragma unroll
                for (int k4 = 0; k4 < 4; ++k4) { const int ks = 4 * kh + k4;
                    fa[k4] = lds128(lds + RS_KS + (16 * jt + fr) * QK_STR + (4 * ks + fq) * 16);
                    fb0[k4] = lds128(lds + RS_QS + (16 * it0 + fr) * QK_STR + (4 * ks + fq) * 16);
                    fb1[k4] = lds128(lds + RS_QS + (16 * (it0 + 1) + fr) * QK_STR + (4 * ks + fq) * 16); }
                __builtin_amdgcn_sched_barrier(0);
#pragma unroll
                for (int k4 = 0; k4 < 4; ++k4) { s0 = MFMA16(fa[k4], fb0[k4], s0); s1 = MFMA16(fa[k4], fb1[k4], s1); }
            }
#pragma unroll
            for (int x = 0; x < 2; ++x) { const f32x4 s = x ? s1 : s0; const int i = 16 * (it0 + x) + fr; float pr[4];
#pragma unroll
                for (int r = 0; r < 4; ++r) pr[r] = s[r] * dmask[x][r];
                u32x2 pw; pw.x = pk2(pr[0], pr[1]); pw.y = pk2(pr[2], pr[3]);
                *(LAS u32x2*)(lds + RS_PS + i * V_STR + (16 * jt + 4 * fq) * 2) = pw; }
        }
        f32x4 o0 = (f32x4){0.f, 0.f, 0.f, 0.f}, o1 = o0;
        {
#pragma unroll
            for (int kh = 0; kh < 2; ++kh) {
                bf16x8 fa[4], fb0[4], fb1[4];
#pragma unroll
                for (int k4 = 0; k4 < 4; ++k4) { const int ks = 4 * kh + k4;
                    fa[k4] = lds128(lds + RS_QS + (16 * it + fr) * QK_STR + (4 * ks + fq) * 16);
                    fb0[k4] = lds128(lds + RS_RS + (16 * et0 + fr) * QK_STR + (4 * ks + fq) * 16);
                    fb1[k4] = lds128(lds + RS_RS + (16 * (et0 + 1) + fr) * QK_STR + (4 * ks + fq) * 16); }
                __builtin_amdgcn_sched_barrier(0);
#pragma unroll
                for (int k4 = 0; k4 < 4; ++k4) { o0 = MFMA16(fa[k4], fb0[k4], o0); o1 = MFMA16(fa[k4], fb1[k4], o1); }
            }
        }
#pragma unroll
        for (int r = 0; r < 4; ++r) { o0[r] *= xi[r]; o1[r] *= xi[r]; }
        __syncthreads();
#pragma unroll
        for (int ks = 0; ks < 2; ++ks) {
            const bf16x8 a = lds128(lds + RS_PS + (16 * it + fr) * V_STR + (4 * ks + fq) * 16);
            const unsigned va = ldsb + RS_VS + (32 * ks + 8 * fq + tq) * V_STR + 8 * tp;
            const bf16x8 b0 = tr_frag(va + 32 * et0, va + 4 * V_STR + 32 * et0);
            const bf16x8 b1 = tr_frag(va + 32 * (et0 + 1), va + 4 * V_STR + 32 * (et0 + 1));
            __builtin_amdgcn_sched_barrier(0);
            o0 = MFMA16(a, b0, o0); o1 = MFMA16(a, b1, o1);
        }
        {
            bf16* op = Og + (tok0 + (size_t)n * CHUNK + 16 * it + 4 * fq) * RVW + h * RV + es * 64 + 16 * et0 + fr;
#pragma unroll
            for (int r = 0; r < 4; ++r) { op[(size_t)r * RVW] = (bf16)f2bf(o0[r]); op[(size_t)r * RVW + 16] = (bf16)f2bf(o1[r]); }
        }
#pragma unroll
        for (int x = 0; x < 2; ++x)
#pragma unroll
            for (int y = 0; y < 4; ++y) Racc[x][y] *= cdec;
#pragma unroll
        for (int ks = 0; ks < 2; ++ks) {
            const unsigned ka = ldsb + RS_KS + (32 * ks + 8 * fq + tq) * QK_STR + 8 * tp;
            const unsigned za = ldsb + RS_VZ + (32 * ks + 8 * fq + tq) * V_STR + 8 * tp;
            bf16x8 ak[2], bz[4];
#pragma unroll
            for (int x = 0; x < 2; ++x) ak[x] = tr_frag(ka + 32 * (2 * w + x), ka + 4 * QK_STR + 32 * (2 * w + x));
#pragma unroll
            for (int y = 0; y < 4; ++y) bz[y] = tr_frag(za + 32 * y, za + 4 * V_STR + 32 * y);
            __builtin_amdgcn_sched_barrier(0);
#pragma unroll
            for (int x = 0; x < 2; ++x)
#pragma unroll
                for (int y = 0; y < 4; ++y) Racc[x][y] = MFMA16(ak[x], bz[y], Racc[x][y]);
        }
#pragma unroll
        for (int x = 0; x < 2; ++x)
#pragma unroll
            for (int y = 0; y < 4; ++y) { u32x2 rw; rw.x = pk2(Racc[x][y][0], Racc[x][y][1]); rw.y = pk2(Racc[x][y][2], Racc[x][y][3]);
                *(LAS u32x2*)(lds + RS_RS + (16 * y + fr) * QK_STR + (16 * (2 * w + x) + 4 * fq) * 2) = rw; }
    }
}

template <int CTRL> __device__ __forceinline__ float dpp_f(float x) { return __builtin_bit_cast(float, __builtin_amdgcn_mov_dpp(__builtin_bit_cast(int, x), CTRL, 0xF, 0xF, true)); }
__device__ __forceinline__ float sum8(float x) { x += dpp_f<0xB1>(x); x += dpp_f<0x4E>(x); x += dpp_f<0x141>(x); return x; }
__device__ __forceinline__ void ret_gate_phase(const Ctx& c, const bf16* Og, bf16* Gg, const float* gn, bf16* Zout = nullptr) {
    const int col0 = 512 * (c.lane >> 3) + 8 * (c.lane & 7);
    f32x4 gw[16];
#pragma unroll
    for (int j = 0; j < 8; ++j) { gw[2 * j] = *(const f32x4*)(gn + col0 + 64 * j); gw[2 * j + 1] = *(const f32x4*)(gn + col0 + 64 * j + 4); }
    u32x4 ovn[8];
    if (c.gw < NTOK) { const bf16* orow = Og + (size_t)c.gw * RVW + col0;
#pragma unroll
        for (int j = 0; j < 8; ++j) ovn[j] = *(const u32x4*)(orow + 64 * j); }
    for (int m = c.gw; m < NTOK; m += c.ngw) {
        u32x4 gv[8], ov[8];
        { const bf16* grow = Gg + (size_t)m * RVW + col0;
#pragma unroll
          for (int j = 0; j < 8; ++j) { gv[j] = *(const u32x4*)(grow + 64 * j); ov[j] = ovn[j]; } }
        { const int mn = m + c.ngw < NTOK ? m + c.ngw : m; const bf16* orow = Og + (size_t)mn * RVW + col0;
#pragma unroll
          for (int j = 0; j < 8; ++j) ovn[j] = *(const u32x4*)(orow + 64 * j); }
        float s1 = 0.f;
#pragma unroll
        for (int j = 0; j < 8; ++j) { const u32x4 t = ov[j];
            s1 += ((bflo(t.x) + bfhi(t.x)) + (bflo(t.y) + bfhi(t.y))) + ((bflo(t.z) + bfhi(t.z)) + (bflo(t.w) + bfhi(t.w))); }
        const float mu = sum8(s1) * (1.0f / RV);
        asm volatile("" : "+v"(ov[0]), "+v"(ov[1]), "+v"(ov[2]), "+v"(ov[3]), "+v"(ov[4]), "+v"(ov[5]), "+v"(ov[6]), "+v"(ov[7]));
        float s2 = 0.f;
#pragma unroll
        for (int j = 0; j < 8; ++j) { const u32x4 t = ov[j];
            const float d[8] = {bflo(t.x) - mu, bfhi(t.x) - mu, bflo(t.y) - mu, bfhi(t.y) - mu, bflo(t.z) - mu, bfhi(t.z) - mu, bflo(t.w) - mu, bfhi(t.w) - mu};
            float q = 0.f;
#pragma unroll
            for (int k = 0; k < 8; ++k) q += d[k] * d[k];
            s2 += q; }
        const float rstd = 1.0f / sqrtf(sum8(s2) * (1.0f / RV) + EPS);
        asm volatile("" : "+v"(ov[0]), "+v"(ov[1]), "+v"(ov[2]), "+v"(ov[3]), "+v"(ov[4]), "+v"(ov[5]), "+v"(ov[6]), "+v"(ov[7]));
        bf16* zrow = (Zout ? Zout : Gg) + (size_t)m * RVW + col0;
#pragma unroll
        for (int j = 0; j < 8; ++j) {
            const float gg[8] = {gw[2 * j][0], gw[2 * j][1], gw[2 * j][2], gw[2 * j][3], gw[2 * j + 1][0], gw[2 * j + 1][1], gw[2 * j + 1][2], gw[2 * j + 1][3]};
            const u32x4 t = gv[j], u = ov[j];
            const float g[8] = {bflo(t.x), bfhi(t.x), bflo(t.y), bfhi(t.y), bflo(t.z), bfhi(t.z), bflo(t.w), bfhi(t.w)};
            const float o[8] = {bflo(u.x), bfhi(u.x), bflo(u.y), bfhi(u.y), bflo(u.z), bfhi(u.z), bflo(u.w), bfhi(u.w)};
            float z[8];
#pragma unroll
            for (int k = 0; k < 8; ++k) { const float y = (o[k] - mu) * rstd * gg[k]; z[k] = g[k] * __builtin_amdgcn_rcpf(1.0f + __builtin_amdgcn_exp2f(-1.4426950408889634f * g[k])) * y; }
            u32x4 zw; zw.x = pk2(z[0], z[1]); zw.y = pk2(z[2], z[3]); zw.z = pk2(z[4], z[5]); zw.w = pk2(z[6], z[7]);
            *(u32x4*)(zrow + 64 * j) = zw;
        }
    }
}

__device__ __forceinline__ void rms_phase(const Ctx& c, const float* X, const float* g, bf16* H) {
    for (int m = c.gw; m < NTOK; m += c.ngw) { f32x4 v[8]; load_row(X + (size_t)m * DM, c.lane, v); store_norm_bf16(v, row_rstd(v), g, H + (size_t)m * DM, c.lane); }
}

__device__ __forceinline__ int fkey(float f) { const int i = __builtin_bit_cast(int, f); return i ^ ((i >> 31) & 0x7fffffff); }
__device__ __forceinline__ float kval(int k) { return __builtin_bit_cast(float, k ^ ((k >> 31) & 0x7fffffff)); }
__device__ __forceinline__ int med3i(int a, int b, int c) { int r; asm("v_med3_i32 %0, %1, %2, %3" : "=v"(r) : "v"(a), "v"(b), "v"(c)); return r; }
#define INS16(L, key) do { const int _k = (key); _Pragma("unroll") for (int _q = 15; _q >= 1; --_q) L[_q] = med3i(L[_q - 1], L[_q], _k); L[0] = max(L[0], _k); } while (0)
constexpr int TK_LIST = 544, TK_HALF = 272, TK_KEYS = 256 * TK_LIST;
__device__ __forceinline__ void peer_topk_phase(const Ctx& c, const float* SC, int* IDX, float* WGT, const float* SQP, float* RSTD) {
    LAS unsigned char* lds = c.lds;
    u32x4 pre[16];
    if (c.bx < NTOK / 16) { const u32x4* src = (const u32x4*)(SC + (size_t)c.bx * 16 * DM);
#pragma unroll
        for (int i = 0; i < 16; ++i) pre[i] = src[c.tid + 512 * i]; }
    for (int tile = c.bx; tile < NTOK / 16; tile += c.G) {
        __syncthreads();
#pragma unroll
        for (int i = 0; i < 16; ++i) { const int g = c.tid + 512 * i; *(LAS u32x4*)(lds + (g >> 5) * TK_LIST + ((g >> 4) & 1) * TK_HALF + (g & 15) * 16) = pre[i]; }
        if (tile + c.G < NTOK / 16) { const u32x4* src = (const u32x4*)(SC + (size_t)(tile + c.G) * 16 * DM);
#pragma unroll
            for (int i = 0; i < 16; ++i) pre[i] = src[c.tid + 512 * i]; }
        __syncthreads();
        {
            const int lst = c.tid >> 1, hf = c.tid & 1;
            int L[16];
#pragma unroll
            for (int q = 0; q < 16; ++q) L[q] = (int)0x80000000;
            LAS unsigned char* lp = lds + lst * TK_LIST + hf * TK_HALF;
#pragma unroll 2
            for (int g = 0; g < 16; ++g) { const f32x4 v = *(LAS const f32x4*)(lp + g * 16);
#pragma unroll
                for (int e = 0; e < 4; ++e) INS16(L, (fkey(v[e]) & ~127) | (hf * 64 + g * 4 + e)); }
            if (hf) {
#pragma unroll
                for (int q = 0; q < 16; ++q) ((LAS int*)lp)[q] = L[q]; }
            __syncthreads();
            if (!hf) { LAS const int* op = (LAS const int*)(lp + TK_HALF);
#pragma unroll
                for (int q = 0; q < 16; ++q) INS16(L, op[q]);
                LAS int* kp = (LAS int*)(lds + TK_KEYS) + lst * 16;
#pragma unroll
                for (int q = 0; q < 16; ++q) kp[q] = L[q]; }
        }
        __syncthreads();
        if (c.tid < 128) {
            LAS const int* k1 = (LAS const int*)(lds + TK_KEYS) + (c.tid * 2) * 16; LAS const int* k2 = k1 + 16;
            float v1[16], v2[16];
#pragma unroll
            for (int q = 0; q < 16; ++q) { v1[q] = kval(k1[q] & ~127); v2[q] = kval(k2[q] & ~127); }
            int L[16];
#pragma unroll
            for (int q = 0; q < 16; ++q) L[q] = (fkey(v1[0] + v2[q]) & ~255) | q;
#pragma unroll
            for (int i = 1; i < 16; ++i)
#pragma unroll
                for (int j = 0; j < 16; ++j) if ((i + 1) * (j + 1) <= 16) INS16(L, (fkey(v1[i] + v2[j]) & ~255) | (i * 16 + j));
            const int tt = c.tid >> 3, hh = c.tid & 7; const size_t ob0 = ((size_t)tile * 16 + tt) * 128;
            float rstd; { const f32x4* sp = (const f32x4*)(SQP + ((size_t)tile * 16 + tt) * 32); f32x4 a4 = sp[0];
#pragma unroll
              for (int q = 1; q < 8; ++q) a4 += sp[q];
              rstd = 1.0f / sqrtf(((a4[0] + a4[1]) + (a4[2] + a4[3])) * (1.0f / DM) + EPS); }
            if (hh == 0) RSTD[(size_t)tile * 16 + tt] = rstd;
            const float m0 = kval(L[0] & ~255); float ex[16], se = 0.f;
#pragma unroll
            for (int q = 0; q < 16; ++q) { ex[q] = __builtin_amdgcn_exp2f((kval(L[q] & ~255) - m0) * (rstd * 1.4426950408889634f)); se += ex[q]; }
            const float inv = 1.0f / se;
#pragma unroll
            for (int q = 0; q < 16; ++q) { const int cid = L[q] & 255; const int es = hh * 16 + q, pos = (es & 7) * 16 + (es >> 3);
                IDX[ob0 + pos] = (k1[cid >> 4] & 127) * PNK + (k2[cid & 15] & 127); WGT[ob0 + pos] = ex[q] * inv; }
        }
    }
}

template <int NSTAGE> __device__ __forceinline__ void xreduce_stage(float (&p)[64], int lane) {
    constexpr int S = NSTAGE;
    if constexpr (S == 32) {
#pragma unroll
        for (int k = 0; k < S; ++k) { float xa = p[k], xb = p[k + S]; asm("s_nop 1\n\tv_permlane32_swap_b32 %0, %1" : "+v"(xa), "+v"(xb)); p[k] = xa + xb; }
    } else if constexpr (S == 16) {
#pragma unroll
        for (int k = 0; k < S; ++k) { float xa = p[k], xb = p[k + S]; asm("s_nop 1\n\tv_permlane16_swap_b32 %0, %1" : "+v"(xa), "+v"(xb)); p[k] = xa + xb; }
    } else {
        const bool up = (lane & S) != 0;
#pragma unroll
        for (int k = 0; k < S; ++k) { const float keep = up ? p[k + S] : p[k], send = up ? p[k] : p[k + S];
            p[k] = keep + __builtin_bit_cast(float, __builtin_amdgcn_ds_swizzle(__builtin_bit_cast(int, send), (S << 10) | 0x1F)); }
    }
}
__device__ __forceinline__ float gelu_erf(float v) { return 0.5f * v * (1.0f + erff(v * 0.70710678118654752f)); }
typedef float f32x2 __attribute__((ext_vector_type(2)));
__device__ __forceinline__ float peer_dots64(const unsigned char* U, int idxv, const f32x2 (&h2)[16], int lane) {
    float p[64];
#pragma unroll
    for (int e = 0; e < 64; ++e) {
        const int row = __builtin_amdgcn_readlane(idxv, e);
        const u32x4* up = (const u32x4*)(U + (size_t)row * DM) + lane;
        f32x2 a = {0.f, 0.f};
#pragma unroll
        for (int cc = 0; cc < 2; ++cc) { const u32x4 u = up[64 * cc];
#pragma unroll
            for (int q = 0; q < 4; ++q) { const int w = (int)u[q];
                a = __builtin_elementwise_fma(__builtin_amdgcn_cvt_pk_f32_fp8(w, false), h2[8 * cc + 2 * q], a);
                a = __builtin_elementwise_fma(__builtin_amdgcn_cvt_pk_f32_fp8(w, true), h2[8 * cc + 2 * q + 1], a); } }
        p[e] = a.x + a.y;
    }
    xreduce_stage<32>(p, lane); xreduce_stage<16>(p, lane); xreduce_stage<8>(p, lane); xreduce_stage<4>(p, lane); xreduce_stage<2>(p, lane); xreduce_stage<1>(p, lane);
    return p[0];
}
__device__ __forceinline__ void peer_accum64(const unsigned char* Vt, int idxv, float av, f32x2 (&acc)[16], int lane) {
#pragma unroll 8
    for (int e = 0; e < 64; ++e) {
        const int row = __builtin_amdgcn_readlane(idxv, e); const float a = __builtin_bit_cast(float, __builtin_amdgcn_readlane(__builtin_bit_cast(int, av), e));
        const f32x2 a2 = {a, a};
        const u32x4* vp = (const u32x4*)(Vt + (size_t)row * DM) + lane;
#pragma unroll
        for (int cc = 0; cc < 2; ++cc) { const u32x4 v = vp[64 * cc];
#pragma unroll
            for (int q = 0; q < 4; ++q) { const int w = (int)v[q];
                acc[8 * cc + 2 * q] = __builtin_elementwise_fma(__builtin_amdgcn_cvt_pk_f32_fp8(w, false), a2, acc[8 * cc + 2 * q]);
                acc[8 * cc + 2 * q + 1] = __builtin_elementwise_fma(__builtin_amdgcn_cvt_pk_f32_fp8(w, true), a2, acc[8 * cc + 2 * q + 1]); } }
    }
}
constexpr int GD = 8;
#define PG_ISSUE(vv) do { const int row_ = __builtin_amdgcn_readlane((((vv) >> 6) & 1) ? i1 : i0, (vv) & 63); \
        const u32x4* bp_ = (const u32x4*)((((vv) >> 6) < 2 ? U : Vt) + (size_t)row_ * DM) + lane; ring[(vv) % GD][0] = bp_[0]; ring[(vv) % GD][1] = bp_[64]; } while (0)
template <int SEG> __device__ __forceinline__ void peer_seg(const unsigned char* U, const unsigned char* Vt, int i0, int i1, u32x4 (&ring)[GD][2], float (&p)[64], float aseg, const f32x2 (&h2)[16], f32x2 (&acc)[16], int lane) {
#pragma unroll
    for (int e = 0; e < 64; ++e) {
        const int v = SEG * 64 + e;
        const u32x4 r0 = ring[v % GD][0], r1 = ring[v % GD][1];
        if (SEG < 2) {
            f32x2 a = {0.f, 0.f};
#pragma unroll
            for (int q = 0; q < 4; ++q) { const int wa = (int)r0[q], wb = (int)r1[q];
                a = __builtin_elementwise_fma(__builtin_amdgcn_cvt_pk_f32_fp8(wa, false), h2[2 * q], a); a = __builtin_elementwise_fma(__builtin_amdgcn_cvt_pk_f32_fp8(wa, true), h2[2 * q + 1], a);
                a = __builtin_elementwise_fma(__builtin_amdgcn_cvt_pk_f32_fp8(wb, false), h2[8 + 2 * q], a); a = __builtin_elementwise_fma(__builtin_amdgcn_cvt_pk_f32_fp8(wb, true), h2[8 + 2 * q + 1], a); }
            { float hs_; asm("v_add_f32 %0, %1, %2" : "=v"(hs_) : "v"(a.x), "v"(a.y)); p[e] = hs_; }
        } else {
            const float av = __builtin_bit_cast(float, __builtin_amdgcn_readlane(__builtin_bit_cast(int, aseg), e)); const f32x2 a2 = {av, av};
#pragma unroll
            for (int q = 0; q < 4; ++q) { const int wa = (int)r0[q], wb = (int)r1[q];
                acc[2 * q] = __builtin_elementwise_fma(__builtin_amdgcn_cvt_pk_f32_fp8(wa, false), a2, acc[2 * q]); acc[2 * q + 1] = __builtin_elementwise_fma(__builtin_amdgcn_cvt_pk_f32_fp8(wa, true), a2, acc[2 * q + 1]);
                acc[8 + 2 * q] = __builtin_elementwise_fma(__builtin_amdgcn_cvt_pk_f32_fp8(wb, false), a2, acc[8 + 2 * q]); acc[8 + 2 * q + 1] = __builtin_elementwise_fma(__builtin_amdgcn_cvt_pk_f32_fp8(wb, true), a2, acc[8 + 2 * q + 1]); }
            asm volatile("" : "+v"(acc[0]), "+v"(acc[1]), "+v"(acc[2]), "+v"(acc[3]), "+v"(acc[4]), "+v"(acc[5]), "+v"(acc[6]), "+v"(acc[7]), "+v"(acc[8]), "+v"(acc[9]), "+v"(acc[10]), "+v"(acc[11]), "+v"(acc[12]), "+v"(acc[13]), "+v"(acc[14]), "+v"(acc[15]));
        }
        if (v + GD < 256) PG_ISSUE(v + GD);
        __builtin_amdgcn_sched_barrier(0);
    }
}
__device__ __forceinline__ void peer_token_pipe(const unsigned char* U, const unsigned char* Vt, int i0, int i1, float su0, float su1, float w0, float w1, const f32x2 (&h2)[16], f32x2 (&acc)[16], int lane) {
    u32x4 ring[GD][2];
    float p[64];
#pragma unroll
    for (int v = 0; v < GD; ++v) PG_ISSUE(v);
    peer_seg<0>(U, Vt, i0, i1, ring, p, 0.f, h2, acc, lane);
    xreduce_stage<32>(p, lane); xreduce_stage<16>(p, lane); xreduce_stage<8>(p, lane); xreduce_stage<4>(p, lane); xreduce_stage<2>(p, lane); xreduce_stage<1>(p, lane);
    const float a0 = gelu_erf(p[0] * su0) * w0;
    __builtin_amdgcn_sched_barrier(0);
    peer_seg<1>(U, Vt, i0, i1, ring, p, 0.f, h2, acc, lane);
    xreduce_stage<32>(p, lane); xreduce_stage<16>(p, lane); xreduce_stage<8>(p, lane); xreduce_stage<4>(p, lane); xreduce_stage<2>(p, lane); xreduce_stage<1>(p, lane);
    const float a1 = gelu_erf(p[0] * su1) * w1;
    __builtin_amdgcn_sched_barrier(0);
    peer_seg<2>(U, Vt, i0, i1, ring, p, a0, h2, acc, lane);
    peer_seg<3>(U, Vt, i0, i1, ring, p, a1, h2, acc, lane);
}
#undef PG_ISSUE
__device__ __forceinline__ void peer_gather_phase(const Ctx& c, const bf16* Hn, const unsigned char* U, const unsigned char* Vt, const float* rsU, const float* rsV, const int* IDX, const float* WGT, const float* Xr, float* X, int mode,
                                                  const float* g1, const float* g2, bf16* Hout, bf16* HKVout) {
    for (int m = c.gw; m < NTOK; m += c.ngw) {
        int lane_ = c.lane; asm volatile("" : "+v"(lane_));
#ifdef DRYIDXMASK
        const int imask_ = (X != Xr) ? DRYIDXMASK : 0xffff;
        const int i0 = IDX[(size_t)m * 128 + lane_] & imask_, i1 = IDX[(size_t)m * 128 + 64 + lane_] & imask_;
#else
        const int i0 = IDX[(size_t)m * 128 + lane_], i1 = IDX[(size_t)m * 128 + 64 + lane_];
#endif
        const float w0 = WGT[(size_t)m * 128 + lane_] * rsV[i0], w1 = WGT[(size_t)m * 128 + 64 + lane_] * rsV[i1];
        const float su0 = rsU[i0], su1 = rsU[i1];
        f32x2 h2[16];
#pragma unroll
        for (int cc = 0; cc < 2; ++cc) { const u32x4* hp = (const u32x4*)(Hn + (size_t)m * DM + 1024 * cc + 16 * lane_); const u32x4 ha = hp[0], hb = hp[1];
#pragma unroll
            for (int q = 0; q < 4; ++q) { h2[8 * cc + q] = (f32x2){bflo(ha[q]), bfhi(ha[q])}; h2[8 * cc + 4 + q] = (f32x2){bflo(hb[q]), bfhi(hb[q])}; } }
        f32x2 acc[16];
#pragma unroll
        for (int k = 0; k < 16; ++k) acc[k] = (f32x2){0.f, 0.f};
        peer_token_pipe(U, Vt, i0, i1, su0, su1, w0, w1, h2, acc, lane_);
        float* xr = X + (size_t)m * DM; const float* xrr = Xr + (size_t)m * DM; float ss = 0.f;
#pragma unroll
        for (int cc = 0; cc < 2; ++cc) {
            f32x4* xp = (f32x4*)(xr + 1024 * cc + 16 * lane_); const f32x4* xq = (const f32x4*)(xrr + 1024 * cc + 16 * lane_);
#pragma unroll
            for (int q = 0; q < 4; ++q) { f32x4 xa = xq[q]; xa[0] += acc[8 * cc + 2 * q].x; xa[1] += acc[8 * cc + 2 * q].y; xa[2] += acc[8 * cc + 2 * q + 1].x; xa[3] += acc[8 * cc + 2 * q + 1].y;
                acc[8 * cc + 2 * q] = (f32x2){xa[0], xa[1]}; acc[8 * cc + 2 * q + 1] = (f32x2){xa[2], xa[3]}; ss += (xa[0] * xa[0] + xa[1] * xa[1]) + (xa[2] * xa[2] + xa[3] * xa[3]);
                if (mode != 2) xp[q] = xa; }
        }
        const float rstd = 1.0f / sqrtf(wave_sum(ss) * (1.0f / DM) + EPS);
#pragma unroll
        for (int cc = 0; cc < 2; ++cc) {
            const f32x4* gp = (const f32x4*)(g1 + 1024 * cc + 16 * lane_);
            if (mode == 2) {
                f32x4* xp = (f32x4*)(xr + 1024 * cc + 16 * lane_);
#pragma unroll
                for (int q = 0; q < 4; ++q) { const f32x4 gv = gp[q]; f32x4 y; y[0] = acc[8 * cc + 2 * q].x * rstd * gv[0]; y[1] = acc[8 * cc + 2 * q].y * rstd * gv[1]; y[2] = acc[8 * cc + 2 * q + 1].x * rstd * gv[2]; y[3] = acc[8 * cc + 2 * q + 1].y * rstd * gv[3]; xp[q] = y; }
            } else {
                u32x4 hw[2];
#pragma unroll
                for (int q = 0; q < 4; ++q) { const f32x4 gv = gp[q]; hw[q >> 1][2 * (q & 1)] = pk2(acc[8 * cc + 2 * q].x * rstd * gv[0], acc[8 * cc + 2 * q].y * rstd * gv[1]); hw[q >> 1][2 * (q & 1) + 1] = pk2(acc[8 * cc + 2 * q + 1].x * rstd * gv[2], acc[8 * cc + 2 * q + 1].y * rstd * gv[3]); }
                u32x4* ho = (u32x4*)(Hout + (size_t)m * DM + 1024 * cc + 16 * lane_); ho[0] = hw[0]; ho[1] = hw[1];
                if (mode == 1) {
                    const f32x4* kp = (const f32x4*)(g2 + 1024 * cc + 16 * lane_); u32x4 kw[2];
#pragma unroll
                    for (int q = 0; q < 4; ++q) { const f32x4 gv = kp[q]; kw[q >> 1][2 * (q & 1)] = pk2(acc[8 * cc + 2 * q].x * rstd * gv[0], acc[8 * cc + 2 * q].y * rstd * gv[1]); kw[q >> 1][2 * (q & 1) + 1] = pk2(acc[8 * cc + 2 * q + 1].x * rstd * gv[2], acc[8 * cc + 2 * q + 1].y * rstd * gv[3]); }
                    u32x4* ko = (u32x4*)(HKVout + (size_t)m * DM + 1024 * cc + 16 * lane_); ko[0] = kw[0]; ko[1] = kw[1];
                }
            }
        }
    }
}

template <int PAT> __device__ __forceinline__ float swz_xor(float v) { return __builtin_bit_cast(float, __builtin_amdgcn_ds_swizzle(__builtin_bit_cast(int, v), PAT)); }
template <int PAT> __device__ __forceinline__ int swz_xor_i(int v) { return __builtin_amdgcn_ds_swizzle(v, PAT); }
template <int C> __device__ __forceinline__ unsigned bc8(unsigned v) { return (unsigned)__builtin_amdgcn_ds_swizzle((int)v, (C << 5) | 0x18); }
__device__ __forceinline__ void bcast16(unsigned x0, unsigned x1, unsigned (&o)[16]) {
    o[0] = bc8<0>(x0); o[1] = bc8<0>(x1); o[2] = bc8<1>(x0); o[3] = bc8<1>(x1); o[4] = bc8<2>(x0); o[5] = bc8<2>(x1); o[6] = bc8<3>(x0); o[7] = bc8<3>(x1);
    o[8] = bc8<4>(x0); o[9] = bc8<4>(x1); o[10] = bc8<5>(x0); o[11] = bc8<5>(x1); o[12] = bc8<6>(x0); o[13] = bc8<6>(x1); o[14] = bc8<7>(x0); o[15] = bc8<7>(x1);
}
__device__ __forceinline__ unsigned lq_issue(LAS unsigned* cnt, int lane) { unsigned v = 0u; if (lane == 0) v = __hip_atomic_fetch_add(cnt, 1u, __ATOMIC_RELAXED, __HIP_MEMORY_SCOPE_WORKGROUP); return v; }
__device__ __forceinline__ unsigned lq_take(unsigned v) { return (unsigned)__builtin_amdgcn_readfirstlane((int)v); }
__device__ __forceinline__ void peer_u_phase(const Ctx& c, const bf16* Hn, const unsigned char* U, const int* IDXT, float* PD, unsigned imask = 0xffffffffu) {
    const int xg = c.bx & 7, tb = (c.bx >> 3) * 8, g = c.lane >> 3, sub = c.lane & 7;
    LAS unsigned* LQ = (LAS unsigned*)(c.lds + LDS_MISC) + 8;
#define LQ_TOK(i) (tb + (int)((i) & 7u) + 256 * (int)((i) >> 3))
    for (int pass = 0; pass < 2; ++pass) {
        __syncthreads(); if (c.tid == 0) LQ[pass] = 0u; __syncthreads();
        unsigned cur = lq_take(lq_issue(LQ + pass, c.lane)), nxt = lq_take(lq_issue(LQ + pass, c.lane));
        const int s = xg + 8 * pass, col0 = 128 * s + 16 * sub;
        const unsigned char* Us = U + (size_t)s * PE * 128 + 16 * sub;
        u32x4 wv[8];
        { const u32x4* wp = (const u32x4*)(U + (size_t)s * PE * 128 + (size_t)(c.bx >> 3) * 65536) + c.tid;
#pragma unroll
          for (int q = 0; q < 8; ++q) wv[q] = wp[q * 512]; }
        u32x2 ii; unsigned hw;
        { const int t0 = cur < 512u ? LQ_TOK(cur) : tb;
          ii = *(const u32x2*)(IDXT + (size_t)t0 * 128 + g * 16 + 2 * sub);
          hw = *((const unsigned*)(Hn + (size_t)t0 * DM + 128 * s) + c.lane); }
        bool first = true;
        while (cur < 512u) {
            const unsigned vnn = lq_issue(LQ + pass, c.lane);
            const int t = LQ_TOK(cur), tn = nxt < 512u ? LQ_TOK(nxt) : t;
            u32x4 r[16]; unsigned rj[16];
            bcast16(ii.x, ii.y, rj);
#pragma unroll
            for (int j = 0; j < 16; ++j) r[j] = *(const u32x4*)(Us + (size_t)(rj[j] & imask) * 128);
            float hf[16];
#pragma unroll
            for (int q = 0; q < 8; ++q) { const unsigned hd = (unsigned)__builtin_amdgcn_ds_bpermute(32 * sub + 4 * q, (int)hw); hf[2 * q] = bflo(hd); hf[2 * q + 1] = bfhi(hd); }
            { ii = *(const u32x2*)(IDXT + (size_t)tn * 128 + g * 16 + 2 * sub);
                hw = *((const unsigned*)(Hn + (size_t)tn * DM + 128 * s) + c.lane); }
            float am = 0.f;
#pragma unroll
            for (int q = 0; q < 16; ++q) am = fmaxf(am, fabsf(hf[q]));
            am = fmaxf(am, dpp_f<0xB1>(am)); am = fmaxf(am, dpp_f<0x4E>(am)); am = fmaxf(am, dpp_f<0x141>(am));
            const float hsc = am > 0.f ? 127.0f / am : 0.f, hinv = am * (1.0f / 127.0f);
            unsigned hq[4];
#pragma unroll
            for (int q = 0; q < 4; ++q) hq[q] = q8pack(hf[4 * q] * hsc, hf[4 * q + 1] * hsc, hf[4 * q + 2] * hsc, hf[4 * q + 3] * hsc);
            int p[16];
#pragma unroll
            for (int j = 0; j < 16; ++j) { int a = __builtin_amdgcn_sdot4((int)r[j].x, (int)hq[0], 0, false); a = __builtin_amdgcn_sdot4((int)r[j].y, (int)hq[1], a, false);
                a = __builtin_amdgcn_sdot4((int)r[j].z, (int)hq[2], a, false); p[j] = __builtin_amdgcn_sdot4((int)r[j].w, (int)hq[3], a, false); }
            { const bool up = (sub & 4) != 0;
#pragma unroll
              for (int q = 0; q < 8; ++q) { const int keep = up ? p[q + 8] : p[q], send = up ? p[q] : p[q + 8]; p[q] = keep + swz_xor_i<(4 << 10) | 0x1F>(send); } }
            { const bool up = (sub & 2) != 0;
#pragma unroll
              for (int q = 0; q < 4; ++q) { const int keep = up ? p[q + 4] : p[q], send = up ? p[q] : p[q + 4]; p[q] = keep + swz_xor_i<(2 << 10) | 0x1F>(send); } }
            { const bool up = (sub & 1) != 0;
#pragma unroll
              for (int q = 0; q < 2; ++q) { const int keep = up ? p[q + 2] : p[q], send = up ? p[q] : p[q + 2]; p[q] = keep + swz_xor_i<(1 << 10) | 0x1F>(send); } }
            f32x2 o = {(float)p[0] * hinv, (float)p[1] * hinv};
            *(f32x2*)(PD + ((size_t)t * 16 + s) * 128 + g * 16 + 2 * sub) = o;
            if (first) { asm volatile("" :: "v"(wv[0]), "v"(wv[1]), "v"(wv[2]), "v"(wv[3]), "v"(wv[4]), "v"(wv[5]), "v"(wv[6]), "v"(wv[7])); first = false; }
            cur = nxt; nxt = lq_take(vnn);
        }
    }
#undef LQ_TOK
}
__device__ __forceinline__ void peer_a_phase(const Ctx& c, const float* PD, const int* IDXT, float* WA, const float* rsU, const float* rsV, const float* RSTD) {
    const int i0 = c.bx * 512 + c.tid, step = c.G * 512;
    f32x4 vn[16];
    if (i0 < NTOK * 32) { const f32x4* pp = (const f32x4*)(PD + (size_t)(i0 >> 5) * 2048) + (i0 & 31);
#pragma unroll
        for (int s = 0; s < 16; ++s) vn[s] = pp[s * 32]; }
    for (int i4 = i0; i4 < NTOK * 32; i4 += step) {
        const int t = i4 >> 5;
        f32x4 v[16];
#pragma unroll
        for (int s = 0; s < 16; ++s) v[s] = vn[s];
        const u32x4 e = *((const u32x4*)IDXT + i4); const f32x4 w = *((const f32x4*)WA + i4); const float rs = RSTD[t];
        { const int i5 = i4 + step < NTOK * 32 ? i4 + step : i4; const f32x4* pp = (const f32x4*)(PD + (size_t)(i5 >> 5) * 2048) + (i5 & 31);
#pragma unroll
          for (int s = 0; s < 16; ++s) vn[s] = pp[s * 32]; }
        float ru[4], rv[4];
#pragma unroll
        for (int q = 0; q < 4; ++q) { const unsigned eq = e[q]; ru[q] = rsU[eq]; rv[q] = rsV[eq]; }
        f32x4 sm = v[0];
#pragma unroll
        for (int s = 1; s < 16; ++s) sm += v[s];
        asm volatile("" :: "v"(ru[0]), "v"(ru[1]), "v"(ru[2]), "v"(ru[3]), "v"(rv[0]), "v"(rv[1]), "v"(rv[2]), "v"(rv[3]));
        f32x4 o;
#pragma unroll
        for (int q = 0; q < 4; ++q) o[q] = gelu_erf(sm[q] * ru[q] * rs) * w[q] * rv[q];
        *((f32x4*)WA + i4) = o;
    }
}
__device__ __forceinline__ void peer_v_phase(const Ctx& c, const unsigned char* Vt, const int* IDXT, const float* WA, float* X) {
    const int xg = c.bx & 7, tb = (c.bx >> 3) * 8, g = c.lane >> 3, sub = c.lane & 7;
    LAS unsigned* LQ = (LAS unsigned*)(c.lds + LDS_MISC) + 8;
#define LQ_TOK(i) (tb + (int)((i) & 7u) + 256 * (int)((i) >> 3))
    for (int pass = 0; pass < 2; ++pass) {
        __syncthreads(); if (c.tid == 0) LQ[pass] = 0u; __syncthreads();
        unsigned cur = lq_take(lq_issue(LQ + pass, c.lane)), nxt = lq_take(lq_issue(LQ + pass, c.lane));
        const int s = xg + 8 * pass, col0 = 128 * s + 16 * sub;
        const unsigned char* Vs = Vt + (size_t)s * PE * 128 + 16 * sub;
        u32x4 wv[8];
        { const u32x4* wp = (const u32x4*)(Vt + (size_t)s * PE * 128 + (size_t)(c.bx >> 3) * 65536) + c.tid;
#pragma unroll
          for (int q = 0; q < 8; ++q) wv[q] = wp[q * 512]; }
        u32x2 ii, aa;
        { const int t0 = cur < 512u ? LQ_TOK(cur) : tb; ii = *(const u32x2*)(IDXT + (size_t)t0 * 128 + g * 16 + 2 * sub); aa = *(const u32x2*)(WA + (size_t)t0 * 128 + g * 16 + 2 * sub); }
        bool first = true;
        while (cur < 512u) {
            const unsigned vnn = lq_issue(LQ + pass, c.lane);
            const int t = LQ_TOK(cur), tn = nxt < 512u ? LQ_TOK(nxt) : t;
            u32x4 r[16]; float av[16]; unsigned rj[16], aj[16];
            bcast16(ii.x, ii.y, rj);
#pragma unroll
            for (int j = 0; j < 16; ++j) r[j] = *(const u32x4*)(Vs + (size_t)rj[j] * 128);
            bcast16(aa.x, aa.y, aj);
#pragma unroll
            for (int j = 0; j < 16; ++j) av[j] = __builtin_bit_cast(float, aj[j]);
            f32x2* xp = (f32x2*)(X + (size_t)t * DM + col0 + 2 * g);
            const f32x2 xold = *xp;
            { ii = *(const u32x2*)(IDXT + (size_t)tn * 128 + g * 16 + 2 * sub); aa = *(const u32x2*)(WA + (size_t)tn * 128 + g * 16 + 2 * sub); }
            f32x2 acc[8];
#pragma unroll
            for (int q = 0; q < 8; ++q) acc[q] = (f32x2){0.f, 0.f};
#pragma unroll
            for (int j = 0; j < 16; ++j) { float aj_ = av[j]; asm("" : "+v"(aj_));
                const f32x2 a2 = {aj_, aj_};
#pragma unroll
                for (int q = 0; q < 4; ++q) { const int w = (int)r[j][q]; acc[2 * q] = __builtin_elementwise_fma(__builtin_amdgcn_cvt_pk_f32_fp8(w, false), a2, acc[2 * q]); acc[2 * q + 1] = __builtin_elementwise_fma(__builtin_amdgcn_cvt_pk_f32_fp8(w, true), a2, acc[2 * q + 1]); } }
            float af[16];
#pragma unroll
            for (int q = 0; q < 8; ++q) { af[2 * q] = acc[q].x; af[2 * q + 1] = acc[q].y; }
#ifdef VDBG
#pragma unroll
            for (int q = 0; q < 16; ++q) { af[q] += __shfl_xor(af[q], 8); af[q] += __shfl_xor(af[q], 16); af[q] += __shfl_xor(af[q], 32); }
            { float s0 = af[0], s1 = af[1];
#pragma unroll
              for (int gg = 1; gg < 8; ++gg) { s0 = (g == gg) ? af[2 * gg] : s0; s1 = (g == gg) ? af[2 * gg + 1] : s1; }
              af[0] = s0; af[1] = s1; }
#else
#pragma unroll
            for (int q = 0; q < 8; ++q) { float xa = af[q], xb = af[q + 8]; asm("s_nop 1\n\tv_permlane32_swap_b32 %0, %1" : "+v"(xa), "+v"(xb)); af[q] = xa + xb; }
#pragma unroll
            for (int q = 0; q < 4; ++q) { float xa = af[q], xb = af[q + 4]; asm("s_nop 1\n\tv_permlane16_swap_b32 %0, %1" : "+v"(xa), "+v"(xb)); af[q] = xa + xb; }
            { const bool up = (c.lane & 8) != 0;
#pragma unroll
              for (int q = 0; q < 2; ++q) { const float keep = up ? af[q + 2] : af[q], send = up ? af[q] : af[q + 2]; af[q] = keep + swz_xor<(8 << 10) | 0x1F>(send); } }
#endif
            const f32x2 xn = {xold.x + af[0], xold.y + af[1]};
            *xp = xn;
            if (first) { asm volatile("" :: "v"(wv[0]), "v"(wv[1]), "v"(wv[2]), "v"(wv[3]), "v"(wv[4]), "v"(wv[5]), "v"(wv[6]), "v"(wv[7])); first = false; }
            cur = nxt; nxt = lq_take(vnn);
        }
    }
#undef LQ_TOK
}
#ifdef VREF
__device__ __forceinline__ void peer_v_ref_phase(const Ctx& c, const unsigned char* Vt, const int* IDXT, const float* WA, float* X) {
    for (int m = c.gw; m < NTOK; m += c.ngw) {
        const int i0 = IDXT[(size_t)m * 128 + c.lane], i1 = IDXT[(size_t)m * 128 + 64 + c.lane];
        const float a0 = WA[(size_t)m * 128 + c.lane], a1 = WA[(size_t)m * 128 + 64 + c.lane];
        f32x2 acc[16];
#pragma unroll
        for (int k = 0; k < 16; ++k) acc[k] = (f32x2){0.f, 0.f};
        for (int e = 0; e < 128; ++e) {
            const int row = __shfl(e < 64 ? i0 : i1, e & 63); const float a = __shfl(e < 64 ? a0 : a1, e & 63); const f32x2 a2 = {a, a};
            const u32x4* vp = (const u32x4*)(Vt + (size_t)row * DM) + c.lane;
#pragma unroll
            for (int cc = 0; cc < 2; ++cc) { const u32x4 v = vp[64 * cc];
#pragma unroll
                for (int q = 0; q < 4; ++q) { const int w = (int)v[q];
                    acc[8 * cc + 2 * q] = __builtin_elementwise_fma(__builtin_amdgcn_cvt_pk_f32_fp8(w, false), a2, acc[8 * cc + 2 * q]);
                    acc[8 * cc + 2 * q + 1] = __builtin_elementwise_fma(__builtin_amdgcn_cvt_pk_f32_fp8(w, true), a2, acc[8 * cc + 2 * q + 1]); } }
        }
        float* xr = X + (size_t)m * DM;
#pragma unroll
        for (int cc = 0; cc < 2; ++cc) { f32x4* xp = (f32x4*)(xr + 1024 * cc + 16 * c.lane);
#pragma unroll
            for (int q = 0; q < 4; ++q) { f32x4 xa = xp[q]; xa[0] += acc[8 * cc + 2 * q].x; xa[1] += acc[8 * cc + 2 * q].y; xa[2] += acc[8 * cc + 2 * q + 1].x; xa[3] += acc[8 * cc + 2 * q + 1].y; xp[q] = xa; } }
    }
}
#endif
__device__ __forceinline__ void norm_phase(const Ctx& c, float* X, int mode, const float* g1, const float* g2, bf16* H, bf16* HKV) {
    f32x4 ga[8], gb[8]; load_g(g1, c.lane, ga); load_g(mode == 1 ? g2 : g1, c.lane, gb);
    int m = c.gw;
    f32x4 v[8]; load_row(X + (size_t)m * DM, c.lane, v);
    for (; m < NTOK; m += c.ngw) {
        const int mn = m + c.ngw < NTOK ? m + c.ngw : m;
        f32x4 nx[8]; load_row(X + (size_t)mn * DM, c.lane, nx);
        const float rstd = row_rstd(v);
        if (mode == 2) { f32x4* xo = (f32x4*)(X + (size_t)m * DM) + c.lane;
#pragma unroll
            for (int j = 0; j < 8; ++j) { f32x4 y; y[0] = v[j][0] * rstd * ga[j][0]; y[1] = v[j][1] * rstd * ga[j][1]; y[2] = v[j][2] * rstd * ga[j][2]; y[3] = v[j][3] * rstd * ga[j][3]; xo[64 * j] = y; }
        } else { store_norm_bf16_r(v, rstd, ga, H + (size_t)m * DM, c.lane); if (mode == 1) store_norm_bf16_r(v, rstd, gb, HKV + (size_t)m * DM, c.lane); }
#pragma unroll
        for (int j = 0; j < 8; ++j) v[j] = nx[j];
    }
}

__device__ __forceinline__ void rms_final_phase(const Ctx& c, float* X, const float* g) {
    for (int m = c.gw; m < NTOK; m += c.ngw) { f32x4 v[8]; load_row(X + (size_t)m * DM, c.lane, v); const float rstd = row_rstd(v);
        const f32x4* gr = (const f32x4*)g + c.lane; f32x4* xo = (f32x4*)(X + (size_t)m * DM) + c.lane;
#pragma unroll
        for (int j = 0; j < 8; ++j) { const f32x4 gv = gr[64 * j]; f32x4 y; for (int k = 0; k < 4; ++k) { y[k] = v[j][k] * rstd * gv[k]; if (!(fabsf(y[k]) < 1e30f)) y[k] = 0.f; } xo[64 * j] = y; } }
}

#ifdef DIAGBUF
__device__ __forceinline__ void diag_copy_phase(const Ctx& c, float* X, const unsigned char* ws) {
    const bf16* src = (const bf16*)(ws + (size_t)DIAGBUF);
    for (size_t i = (size_t)c.bx * 512 + c.tid; i < (size_t)NTOK * DM; i += (size_t)c.G * 512) { const size_t t = i / DM, col = i % DM; float v = bflo((unsigned)src[t * DIAGLD + col]); if (!(fabsf(v) < 1e30f)) v = 0.f; X[i] = v; }
}
#endif

__device__ __forceinline__ unsigned off_b(unsigned row, unsigned ch) { return 256u * row + 16u * (ch ^ (((row & 3u) << 2) | ((row >> 2) & 3u))); }
__device__ __forceinline__ float rowmax4(float x) {
    float a = x, b = x; asm("s_nop 1\n\tv_permlane16_swap_b32 %0, %1" : "+v"(a), "+v"(b)); x = fmaxf(a, b);
    a = x; b = x; asm("s_nop 1\n\tv_permlane32_swap_b32 %0, %1" : "+v"(a), "+v"(b)); return fmaxf(a, b);
}
constexpr int AT_K = 0, AT_V = 32768, AT_BUF = 65536, AT_BIAS = 131072, AT_HEADB = 16384;
__device__ __forceinline__ void attn_phase(const Ctx& c, const bf16* Qg, const bf16* KVg, bf16* AOg, const float* relb, int dryvar = 0) {
    LAS unsigned char* lds = c.lds; const unsigned ldsb = (unsigned)(size_t)lds;
    const int tid = c.tid, lane = c.lane, w = c.wave, hg = w >> 2, wq = w & 3, fr = lane & 15, fq = lane >> 4, tq = (lane & 15) >> 2, tp = lane & 3;
    const int tl = tid & 255, lrow = tl >> 2, lc = tl & 3;
    unsigned vadr[8];
#pragma unroll
    for (int d = 0; d < 8; ++d) vadr[d] = ldsb + AT_V + hg * AT_HEADB + off_b(4 * fq + tq, 2 * d + (tp >> 1)) + 8 * (tp & 1);
    unsigned kadr[4];
#pragma unroll
    for (int s4 = 0; s4 < 4; ++s4) kadr[s4] = ldsb + AT_K + hg * AT_HEADB + 256 * fr + 16 * (fq ^ ((fr >> 2) & 3)) + 64 * (s4 ^ (fr & 3));
    for (int u = c.bx; u < NBATCH * NCHUNK * (AH / 2); u += c.G) {
        const int hp = u & 7, ch = (u >> 3) & 63, b = u >> 9, h = 2 * hp + hg;
        const size_t tq0 = (size_t)b * SEQ + (size_t)ch * CHUNK;
        __syncthreads();
        for (int i = tid; i < 2 * 272; i += 512) { const int hh = i / 272, k = i % 272; ((LAS float*)(lds + AT_BIAS))[i] = (k < NREL) ? relb[(size_t)(2 * hp + hh) * NREL + k] * 1.4426950408889634f : 0.f; }
        bf16x8 qf[4];
        { const bf16* qp = Qg + (tq0 + 16 * wq + fr) * DM + h * AHD + 8 * fq;
#pragma unroll
          for (int s = 0; s < 4; ++s) qf[s] = *(const bf16x8*)(qp + 32 * s); }
        f32x4 O[8];
#pragma unroll
        for (int d = 0; d < 8; ++d) O[d] = (f32x4){0.f, 0.f, 0.f, 0.f};
        float mrun = -1e30f, lrun = 0.f;
        const int t0 = ch >= LEFT ? 0 : LEFT - ch;
        u32x4 pk[4], pv[4];
        { const bf16* kp = KVg + ((size_t)b * SEQ + (size_t)(ch - LEFT + t0) * CHUNK + lrow) * (2 * DM) + h * AHD;
#pragma unroll
          for (int cc = 0; cc < 4; ++cc) { pk[cc] = *(const u32x4*)(kp + (lc + 4 * cc) * 8); pv[cc] = *(const u32x4*)(kp + DM + (lc + 4 * cc) * 8); } }
        const LAS float* bias = (const LAS float*)(lds + AT_BIAS) + hg * 272;
        const float bc = relb[(size_t)h * NREL + 256] * 1.4426950408889634f;
        for (int t = t0; t <= LEFT; ++t) {
            const int pb = ((t - t0) & 1) * AT_BUF;
#pragma unroll
            for (int cc = 0; cc < 4; ++cc) { *(LAS u32x4*)(lds + pb + AT_K + hg * AT_HEADB + off_b(lrow, lc + 4 * cc)) = pk[cc]; *(LAS u32x4*)(lds + pb + AT_V + hg * AT_HEADB + off_b(lrow, lc + 4 * cc)) = pv[cc]; }
            __syncthreads();
            if (t < LEFT && dryvar != 1) { const bf16* kp = KVg + ((size_t)b * SEQ + (size_t)(ch - LEFT + t + 1) * CHUNK + lrow) * (2 * DM) + h * AHD;
#pragma unroll
                for (int cc = 0; cc < 4; ++cc) { pk[cc] = *(const u32x4*)(kp + (lc + 4 * cc) * 8); pv[cc] = *(const u32x4*)(kp + DM + (lc + 4 * cc) * 8); } }
            f32x4 sT[4];
            {
                bf16x8 kf[16];
                const unsigned k0 = kadr[0] + pb, k1 = kadr[1] + pb, k2 = kadr[2] + pb, k3 = kadr[3] + pb;
                asm volatile("ds_read_b128 %0, %16\n\tds_read_b128 %1, %17\n\tds_read_b128 %2, %18\n\tds_read_b128 %3, %19\n\t"
                             "ds_read_b128 %4, %16 offset:4096\n\tds_read_b128 %5, %17 offset:4096\n\tds_read_b128 %6, %18 offset:4096\n\tds_read_b128 %7, %19 offset:4096\n\t"
                             "ds_read_b128 %8, %16 offset:8192\n\tds_read_b128 %9, %17 offset:8192\n\tds_read_b128 %10, %18 offset:8192\n\tds_read_b128 %11, %19 offset:8192\n\t"
                             "ds_read_b128 %12, %16 offset:12288\n\tds_read_b128 %13, %17 offset:12288\n\tds_read_b128 %14, %18 offset:12288\n\tds_read_b128 %15, %19 offset:12288"
                             : "=&v"(kf[0]), "=&v"(kf[1]), "=&v"(kf[2]), "=&v"(kf[3]), "=&v"(kf[4]), "=&v"(kf[5]), "=&v"(kf[6]), "=&v"(kf[7]),
                               "=&v"(kf[8]), "=&v"(kf[9]), "=&v"(kf[10]), "=&v"(kf[11]), "=&v"(kf[12]), "=&v"(kf[13]), "=&v"(kf[14]), "=&v"(kf[15])
                             : "v"(k0), "v"(k1), "v"(k2), "v"(k3) : "memory");
                asm volatile("s_waitcnt lgkmcnt(8)" : "+v"(kf[0]), "+v"(kf[1]), "+v"(kf[2]), "+v"(kf[3]), "+v"(kf[4]), "+v"(kf[5]), "+v"(kf[6]), "+v"(kf[7]) :: "memory");
#pragma unroll
                for (int kt = 0; kt < 2; ++kt) { sT[kt] = (f32x4){0.f, 0.f, 0.f, 0.f};
#pragma unroll
                    for (int s = 0; s < 4; ++s) sT[kt] = MFMA16(kf[4 * kt + s], qf[s], sT[kt]); }
                asm volatile("s_waitcnt lgkmcnt(0)" : "+v"(kf[8]), "+v"(kf[9]), "+v"(kf[10]), "+v"(kf[11]), "+v"(kf[12]), "+v"(kf[13]), "+v"(kf[14]), "+v"(kf[15]) :: "memory");
#pragma unroll
                for (int kt = 2; kt < 4; ++kt) { sT[kt] = (f32x4){0.f, 0.f, 0.f, 0.f};
#pragma unroll
                    for (int s = 0; s < 4; ++s) sT[kt] = MFMA16(kf[4 * kt + s], qf[s], sT[kt]); }
            }
            const int dbase = (LEFT - t) * CHUNK + (16 * wq + fr);
            if (t > LEFT - 3) {
#pragma unroll
                for (int kt = 0; kt < 4; ++kt)
#pragma unroll
                    for (int r = 0; r < 4; ++r) { const int dist = dbase - (16 * kt + 4 * fq + r); sT[kt][r] += bias[min(dist, 128) + 128]; }
            }
            s16x4 vlo[2][8], vhi[2][8];
            unsigned vcur[8];
#pragma unroll
            for (int d = 0; d < 8; ++d) vcur[d] = vadr[d] + pb;
#define TR8(dst, OFF) asm volatile("ds_read_b64_tr_b16 %0, %8 offset:" #OFF "\n\tds_read_b64_tr_b16 %1, %9 offset:" #OFF "\n\tds_read_b64_tr_b16 %2, %10 offset:" #OFF "\n\tds_read_b64_tr_b16 %3, %11 offset:" #OFF "\n\t" \
                "ds_read_b64_tr_b16 %4, %12 offset:" #OFF "\n\tds_read_b64_tr_b16 %5, %13 offset:" #OFF "\n\tds_read_b64_tr_b16 %6, %14 offset:" #OFF "\n\tds_read_b64_tr_b16 %7, %15 offset:" #OFF \
                : "=&v"(dst[0]), "=&v"(dst[1]), "=&v"(dst[2]), "=&v"(dst[3]), "=&v"(dst[4]), "=&v"(dst[5]), "=&v"(dst[6]), "=&v"(dst[7]) \
                : "v"(vcur[0]), "v"(vcur[1]), "v"(vcur[2]), "v"(vcur[3]), "v"(vcur[4]), "v"(vcur[5]), "v"(vcur[6]), "v"(vcur[7]) : "memory")
            TR8(vlo[0], 0); TR8(vhi[0], 4096); TR8(vlo[1], 8192); TR8(vhi[1], 12288);
#undef TR8
            float mx = -1e30f;
            const float badd = t <= LEFT - 3 ? bc : 0.f;
#pragma unroll
            for (int kt = 0; kt < 4; ++kt)
#pragma unroll
                for (int r = 0; r < 4; ++r) { sT[kt][r] += badd; mx = fmaxf(mx, sT[kt][r]); }
            mx = rowmax4(mx);
            const float mnew = fmaxf(mrun, mx), alpha = __builtin_amdgcn_exp2f(mrun - mnew); mrun = mnew;
            float ps = 0.f;
#pragma unroll
            for (int kt = 0; kt < 4; ++kt)
#pragma unroll
                for (int r = 0; r < 4; ++r) { sT[kt][r] = __builtin_amdgcn_exp2f(sT[kt][r] - mnew); ps += sT[kt][r]; }
            lrun = lrun * alpha + ps;
#pragma unroll
            for (int d = 0; d < 8; ++d) O[d] *= alpha;
            asm volatile("s_waitcnt lgkmcnt(0)" : "+v"(vlo[0][0]), "+v"(vlo[0][1]), "+v"(vlo[0][2]), "+v"(vlo[0][3]), "+v"(vlo[0][4]), "+v"(vlo[0][5]), "+v"(vlo[0][6]), "+v"(vlo[0][7]),
                         "+v"(vhi[0][0]), "+v"(vhi[0][1]), "+v"(vhi[0][2]), "+v"(vhi[0][3]), "+v"(vhi[0][4]), "+v"(vhi[0][5]), "+v"(vhi[0][6]), "+v"(vhi[0][7]) :: "memory");
            asm volatile("" : "+v"(vlo[1][0]), "+v"(vlo[1][1]), "+v"(vlo[1][2]), "+v"(vlo[1][3]), "+v"(vlo[1][4]), "+v"(vlo[1][5]), "+v"(vlo[1][6]), "+v"(vlo[1][7]),
                         "+v"(vhi[1][0]), "+v"(vhi[1][1]), "+v"(vhi[1][2]), "+v"(vhi[1][3]), "+v"(vhi[1][4]), "+v"(vhi[1][5]), "+v"(vhi[1][6]), "+v"(vhi[1][7]) :: "memory");
            __builtin_amdgcn_sched_barrier(0);
#pragma unroll
            for (int ks = 0; ks < 2; ++ks) {
                bf16x8 pb; { const unsigned p0 = pk2(sT[2 * ks][0], sT[2 * ks][1]), p1 = pk2(sT[2 * ks][2], sT[2 * ks][3]), p2 = pk2(sT[2 * ks + 1][0], sT[2 * ks + 1][1]), p3 = pk2(sT[2 * ks + 1][2], sT[2 * ks + 1][3]);
                    const u32x4 pw = (u32x4){p0, p1, p2, p3}; pb = __builtin_bit_cast(bf16x8, pw); }
#pragma unroll
                for (int d = 0; d < 8; ++d) { bf16x8 va; va[0] = vlo[ks][d][0]; va[1] = vlo[ks][d][1]; va[2] = vlo[ks][d][2]; va[3] = vlo[ks][d][3]; va[4] = vhi[ks][d][0]; va[5] = vhi[ks][d][1]; va[6] = vhi[ks][d][2]; va[7] = vhi[ks][d][3];
                    O[d] = MFMA16(va, pb, O[d]); }
            }
        }
        float lt = lrun; lt += __shfl_xor(lt, 16); lt += __shfl_xor(lt, 32);
        const float inv = 1.0f / lt;
        bf16* op = AOg + (tq0 + 16 * wq + fr) * DM + h * AHD + 4 * fq;
#pragma unroll
        for (int d = 0; d < 8; ++d) { u32x2 ow; ow.x = pk2(O[d][0] * inv, O[d][1] * inv); ow.y = pk2(O[d][2] * inv, O[d][3] * inv); *(u32x2*)(op + 16 * d) = ow; }
    }
}

namespace at2 {
typedef float f32x16 __attribute__((ext_vector_type(16)));
constexpr int SHM_V = 64 * 128 * 2, SHM_K = 64 * 128 * 2, OFF_K = 2 * SHM_V, OFF_WS = 2 * SHM_V + 2 * SHM_K, OFF_BIAS = OFF_WS + 8 * 64 * 4, OFF_Q = OFF_BIAS + 2048;
constexpr float THRL = 8.0f * 1.4426950408889634f;
#define A2_KSWZ(row, colB) ((row) * 256 + ((colB) ^ (((row) & 7) << 4)))
#define A2_SBAR() __builtin_amdgcn_sched_barrier(0)
__device__ __forceinline__ int crow(int r, int hi) { return (r & 3) + 8 * (r >> 2) + 4 * hi; }
__device__ __forceinline__ float pl32max(float x) { auto rr = __builtin_amdgcn_permlane32_swap(__builtin_bit_cast(unsigned, x), __builtin_bit_cast(unsigned, x), false, false);
    const unsigned a = rr[0], b = rr[1]; return fmaxf(__builtin_bit_cast(float, a), __builtin_bit_cast(float, b)); }
__device__ __forceinline__ float pl32sum(float x) { auto rr = __builtin_amdgcn_permlane32_swap(__builtin_bit_cast(unsigned, x), __builtin_bit_cast(unsigned, x), false, false);
    const unsigned a = rr[0], b = rr[1]; return __builtin_bit_cast(float, a) + __builtin_bit_cast(float, b); }
__device__ __forceinline__ void partialSM(f32x16& p0, f32x16& p1, float& m_reg, float& mn, float& alpha) {
    float pmax = p0[0];
#pragma unroll
    for (int r = 1; r < 16; ++r) pmax = fmaxf(pmax, p0[r]);
#pragma unroll
    for (int r = 0; r < 16; ++r) pmax = fmaxf(pmax, p1[r]);
    pmax = pl32max(pmax);
    if (__builtin_expect(__all(pmax - m_reg <= THRL), 1)) { mn = m_reg; alpha = 1.f; }
    else { mn = fmaxf(m_reg, pmax); alpha = __builtin_amdgcn_exp2f(m_reg - mn); m_reg = mn; }
#pragma unroll
    for (int r = 0; r < 16; ++r) { p0[r] -= mn; p1[r] -= mn; }
#pragma unroll
    for (int r = 0; r < 16; ++r) p0[r] = __builtin_amdgcn_exp2f(p0[r]);
}
__device__ __forceinline__ void finishSM(f32x16& p0, f32x16& p1, float alpha, float& l_reg, bf16x8& pa0, bf16x8& pa1, bf16x8& pa2, bf16x8& pa3) {
#pragma unroll
    for (int r = 0; r < 16; ++r) p1[r] = __builtin_amdgcn_exp2f(p1[r]);
    float ps = 0.f;
#pragma unroll
    for (int r = 0; r < 16; ++r) ps += p0[r];
#pragma unroll
    for (int r = 0; r < 16; ++r) ps += p1[r];
    ps = pl32sum(ps);
    l_reg = l_reg * alpha + ps;
#define A2_PK4(P, BASE, OUT) do { const unsigned a0 = pk2(P[BASE + 0], P[BASE + 1]), a1 = pk2(P[BASE + 2], P[BASE + 3]), b0 = pk2(P[BASE + 4], P[BASE + 5]), b1 = pk2(P[BASE + 6], P[BASE + 7]); \
        auto r0 = __builtin_amdgcn_permlane32_swap(a0, b0, false, false); auto r1 = __builtin_amdgcn_permlane32_swap(a1, b1, false, false); \
        const unsigned w0 = r0[0], w1 = r1[0], w2 = r0[1], w3 = r1[1]; const u32x4 w = {w0, w1, w2, w3}; OUT = __builtin_bit_cast(bf16x8, w); } while (0)
    A2_PK4(p0, 0, pa0); A2_PK4(p0, 8, pa1); A2_PK4(p1, 0, pa2); A2_PK4(p1, 8, pa3);
#undef A2_PK4
}
__device__ __forceinline__ void qkt(f32x16& p0, f32x16& p1, LAS const unsigned char* Ks, LAS const unsigned char* qr_l, int r32, int hi) {
    asm volatile("" : "+v"(r32));
#pragma unroll
    for (int r = 0; r < 16; ++r) { p0[r] = 0.f; p1[r] = 0.f; }
#pragma unroll
    for (int d0 = 0; d0 < 8; ++d0) { const int cb = (d0 * 16 + hi * 8) * 2;
        const bf16x8 b0 = *(LAS const bf16x8*)(Ks + A2_KSWZ(r32, cb));
        const bf16x8 b1 = *(LAS const bf16x8*)(Ks + A2_KSWZ(32 + r32, cb));
        const bf16x8 q8 = *(LAS const bf16x8*)(qr_l + d0 * 1024);
        p0 = __builtin_amdgcn_mfma_f32_32x32x16_bf16(b0, q8, p0, 0, 0, 0);
        p1 = __builtin_amdgcn_mfma_f32_32x32x16_bf16(b1, q8, p1, 0, 0, 0); }
}
__device__ __forceinline__ int v_st(int k, int c) { const int kk = (k & ~0xC) | ((k & 4) << 1) | ((k & 8) >> 1); return ((kk >> 3) * 4 + (c >> 5)) * 512 + ((kk & 7) * 32 + (c & 31)) * 2; }
__device__ __forceinline__ int v_rd_base(int lane) { return ((lane & 3) << 3) | (((lane >> 2) & 3) << 6) | (((lane >> 4) & 1) << 5) | (((lane >> 5) & 1) << 8); }
constexpr int v_rd_off(int d0, int ks, int half) { return d0 * 512 + ks * 4096 + half * 2048; }
template <int OFF> __device__ __forceinline__ s16x4 tr_read(int vb) { s16x4 r; asm volatile("ds_read_b64_tr_b16 %0, %1 offset:%2" : "=&v"(r) : "v"(vb), "i"(OFF) : "memory"); return r; }
template <int D0> __device__ __forceinline__ void pv_one(f32x16& od, int vb, bf16x8 pa0, bf16x8 pa1, bf16x8 pa2, bf16x8 pa3) {
    const s16x4 l0 = tr_read<v_rd_off(D0, 0, 0)>(vb), h0 = tr_read<v_rd_off(D0, 0, 1)>(vb), l1 = tr_read<v_rd_off(D0, 1, 0)>(vb), h1 = tr_read<v_rd_off(D0, 1, 1)>(vb);
    const s16x4 l2 = tr_read<v_rd_off(D0, 2, 0)>(vb), h2 = tr_read<v_rd_off(D0, 2, 1)>(vb), l3 = tr_read<v_rd_off(D0, 3, 0)>(vb), h3 = tr_read<v_rd_off(D0, 3, 1)>(vb);
    asm volatile("s_waitcnt lgkmcnt(0)" ::: "memory"); A2_SBAR();
#define A2_PK(L, H) (bf16x8){L[0], L[1], L[2], L[3], H[0], H[1], H[2], H[3]}
    od = __builtin_amdgcn_mfma_f32_32x32x16_bf16(pa0, A2_PK(l0, h0), od, 0, 0, 0);
    od = __builtin_amdgcn_mfma_f32_32x32x16_bf16(pa1, A2_PK(l1, h1), od, 0, 0, 0);
    od = __builtin_amdgcn_mfma_f32_32x32x16_bf16(pa2, A2_PK(l2, h2), od, 0, 0, 0);
    od = __builtin_amdgcn_mfma_f32_32x32x16_bf16(pa3, A2_PK(l3, h3), od, 0, 0, 0);
#undef A2_PK
}
__device__ __forceinline__ void pv_d0(f32x16 (&o)[4], int vb, bf16x8 pa0, bf16x8 pa1, bf16x8 pa2, bf16x8 pa3) {
    pv_one<0>(o[0], vb, pa0, pa1, pa2, pa3); pv_one<1>(o[1], vb, pa0, pa1, pa2, pa3); pv_one<2>(o[2], vb, pa0, pa1, pa2, pa3); pv_one<3>(o[3], vb, pa0, pa1, pa2, pa3);
}
__device__ __forceinline__ void bias_mask(f32x16& p0, f32x16& p1, int dc, LAS const float* bias, float bc, int qrow, int hi) {
    if (dc < 0 || dc > 8) {
#pragma unroll
        for (int r = 0; r < 16; ++r) { p0[r] = -__builtin_inff(); p1[r] = -__builtin_inff(); }
    } else if (dc >= 3) {
#pragma unroll
        for (int r = 0; r < 16; ++r) { p0[r] += bc; p1[r] += bc; }
    } else {
        int db = 64 * dc + qrow + 128 - 4 * hi; asm volatile("" : "+v"(db));
#pragma unroll
        for (int r = 0; r < 16; ++r) { const int k0 = (r & 3) + 8 * (r >> 2); p0[r] += bias[min(db - k0, 256)]; p1[r] += bias[min(db - 32 - k0, 256)]; }
    }
}
__device__ __forceinline__ void block(const bf16* Qb, const bf16* Kh, const bf16* Vh, bf16* Ob, int NT, int dc0, LAS const float* bias, float bc, LAS unsigned char* lds, int tid) {
    constexpr int LDQ = DM, LDK = 2 * DM, LDO = DM;
    const int wid = tid >> 6, lane = tid & 63, r32 = lane & 31, hi = lane >> 5;
    LAS unsigned char* V_lds = lds; LAS unsigned char* K_lds = lds + OFF_K;
    LAS float* ws = (LAS float*)(lds + OFF_WS) + wid * 64; LAS float* li_l = ws; LAS float* al_l = ws + 32;
    float m_reg = -1e30f, l_reg = 0.f; f32x16 o[4];
    LAS unsigned char* qr = lds + OFF_Q + wid * 8192 + lane * 16;
#pragma unroll
    for (int d = 0; d < 4; ++d)
#pragma unroll
        for (int r = 0; r < 16; ++r) o[d][r] = 0.f;
    const bf16* Qw = Qb + (size_t)(wid * 32 + r32) * LDQ + hi * 8;
#pragma unroll
    for (int d0 = 0; d0 < 8; ++d0) *(LAS bf16x8*)(qr + d0 * 1024) = *(const bf16x8*)(Qw + d0 * 16);
    const int sr = tid >> 4, sc = (tid & 15) * 8, vst0 = v_st(sr, sc), vst1 = v_st(32 + sr, sc);
    const int vb0 = (int)(unsigned)(size_t)V_lds + v_rd_base(lane);
    const int qrow = (wid & 1) * 32 + r32, dcw = dc0 + (wid >> 1);
    bf16x8 sv0[1], sv1[1], sk0[1], sk1[1];
#define A2_SLOAD(i, k0) do { sv0[i] = *(const bf16x8*)(Vh + (size_t)((k0) + sr) * LDK + sc); sv1[i] = *(const bf16x8*)(Vh + (size_t)((k0) + 32 + sr) * LDK + sc); \
        sk0[i] = *(const bf16x8*)(Kh + (size_t)((k0) + sr) * LDK + sc); sk1[i] = *(const bf16x8*)(Kh + (size_t)((k0) + 32 + sr) * LDK + sc); } while (0)
#define A2_SWRITE(b, i) do { *(LAS bf16x8*)(V_lds + (b) * SHM_V + vst0) = sv0[i]; *(LAS bf16x8*)(V_lds + (b) * SHM_V + vst1) = sv1[i]; const int kc = sc * 2; \
        *(LAS bf16x8*)(K_lds + (b) * SHM_K + A2_KSWZ(sr, kc)) = sk0[i]; *(LAS bf16x8*)(K_lds + (b) * SHM_K + A2_KSWZ(32 + sr, kc)) = sk1[i]; } while (0)
#define A2_SWAIT() asm volatile("s_waitcnt vmcnt(0)" ::: "memory")
#define A2_RESC(a) do { if (__any((a) < 1.f)) { if (hi == 0) al_l[r32] = (a); asm volatile("s_waitcnt lgkmcnt(0)" ::: "memory"); \
        _Pragma("unroll") for (int d = 0; d < 4; ++d) _Pragma("unroll") for (int r = 0; r < 16; ++r) o[d][r] *= al_l[crow(r, hi)]; } } while (0)
    f32x16 pA0, pA1, pB0, pB1; float mnA, mnB, alA = 1.f, alB = 1.f; bf16x8 pa0, pa1, pa2, pa3;
#define A2_VIS(jj) ((unsigned)(dcw - (jj)) <= 8u)
    A2_SLOAD(0, 0); asm volatile("s_waitcnt vmcnt(0)" ::: "memory"); A2_SWRITE(0, 0); __syncthreads();
    bool vA = A2_VIS(0), vB = false;
    if (vA) { qkt(pA0, pA1, K_lds, qr, r32, hi); bias_mask(pA0, pA1, dcw - 0, bias, bc, qrow, hi); partialSM(pA0, pA1, m_reg, mnA, alA); }
    A2_SLOAD(0, 64);
    A2_SWAIT(); A2_SWRITE(1, 0); __syncthreads();
    for (int j = 1; j + 1 < NT; j += 2) {
        vB = A2_VIS(j);
        A2_SBAR(); if (vB) { qkt(pB0, pB1, K_lds + SHM_K, qr, r32, hi); bias_mask(pB0, pB1, dcw - j, bias, bc, qrow, hi); }
        if (vA) finishSM(pA0, pA1, alA, l_reg, pa0, pa1, pa2, pa3);
        A2_SBAR();
        A2_SLOAD(0, (j + 1) * 64); A2_SBAR();
        if (vA) pv_d0(o, vb0, pa0, pa1, pa2, pa3);
        alB = 1.f; if (vB) partialSM(pB0, pB1, m_reg, mnB, alB);
        __syncthreads(); A2_SWAIT(); A2_SWRITE(0, 0);
        A2_RESC(alB); __syncthreads();
        vA = A2_VIS(j + 1);
        A2_SBAR(); if (vA) { qkt(pA0, pA1, K_lds, qr, r32, hi); bias_mask(pA0, pA1, dcw - (j + 1), bias, bc, qrow, hi); }
        if (vB) finishSM(pB0, pB1, alB, l_reg, pa0, pa1, pa2, pa3);
        A2_SBAR();
        A2_SLOAD(0, (j + 2) * 64);
        A2_SBAR();
        if (vB) pv_d0(o, vb0 + SHM_V, pa0, pa1, pa2, pa3);
        alA = 1.f; if (vA) partialSM(pA0, pA1, m_reg, mnA, alA);
        __syncthreads(); A2_SWAIT(); A2_SWRITE(1, 0);
        A2_RESC(alA); __syncthreads();
    }
    vB = A2_VIS(NT - 1);
    A2_SBAR(); if (vB) { qkt(pB0, pB1, K_lds + SHM_K, qr, r32, hi); bias_mask(pB0, pB1, dcw - (NT - 1), bias, bc, qrow, hi); }
    if (vA) finishSM(pA0, pA1, alA, l_reg, pa0, pa1, pa2, pa3);
    A2_SBAR();
    if (vA) pv_d0(o, vb0, pa0, pa1, pa2, pa3);
    alB = 1.f; if (vB) partialSM(pB0, pB1, m_reg, mnB, alB);
    __syncthreads(); A2_RESC(alB);
    if (vB) { finishSM(pB0, pB1, alB, l_reg, pa0, pa1, pa2, pa3); A2_SBAR();
        pv_d0(o, vb0 + SHM_V, pa0, pa1, pa2, pa3); }
#undef A2_VIS
    if (hi == 0) li_l[r32] = l_reg; asm volatile("s_waitcnt lgkmcnt(0)" ::: "memory");
    float rli[16];
#pragma unroll
    for (int r = 0; r < 16; ++r) rli[r] = __builtin_amdgcn_rcpf(li_l[crow(r, hi)]);
    bf16* Ow = Ob + (size_t)(wid * 32) * LDO;
#pragma unroll
    for (int r = 0; r < 16; ++r) { const int orow = crow(r, hi);
#pragma unroll
        for (int d0 = 0; d0 < 4; ++d0) Ow[(size_t)orow * LDO + d0 * 32 + r32] = (bf16)f2bf(o[d0][r] * rli[r]); }
#undef A2_SLOAD
#undef A2_SWRITE
#undef A2_SWAIT
#undef A2_RESC
}
}
__device__ __forceinline__ void attn_phase2(const Ctx& c, const bf16* Qg, const bf16* KVg, bf16* AOg, const float* relb) {
    LAS unsigned char* lds = c.lds;
    for (int u = c.bx; u < NBATCH * AH * 16; u += c.G) {
        const int h = u & 15, b = (u >> 4) & 3, qb = u >> 6;
        const int c0 = 4 * qb, kb = c0 >= LEFT ? c0 - LEFT : 0, NT = c0 + 4 - kb;
        __syncthreads();
        { int i = c.tid; asm volatile("" : "+v"(i));
          if (i < 272) ((LAS float*)(lds + at2::OFF_BIAS))[i] = (i < NREL) ? relb[(size_t)h * NREL + i] * 1.4426950408889634f : 0.f; }
        const float bc = relb[(size_t)h * NREL + 256] * 1.4426950408889634f;
        __syncthreads();
        const size_t tq0 = (size_t)b * SEQ + (size_t)c0 * CHUNK, tk0 = (size_t)b * SEQ + (size_t)kb * CHUNK;
        at2::block(Qg + tq0 * DM + h * AHD, KVg + tk0 * (2 * DM) + h * AHD, KVg + tk0 * (2 * DM) + DM + h * AHD, AOg + tq0 * DM + h * AHD, NT, c0 - kb, (const LAS float*)(lds + at2::OFF_BIAS), bc, lds, c.tid);
    }
}

constexpr int NSTEPS = 1 + 2 * 10 + 2 * 9;
template <int MASK> __global__ void __launch_bounds__(512, 2) yoco_fwd(Params p) {
    extern __shared__ __attribute__((aligned(16))) unsigned char lds_raw[];
#define MK_CTX() Ctx c; { int t_ = threadIdx.x; asm volatile("" : "+v"(t_)); c.lds = (LAS unsigned char*)lds_raw; c.tid = t_; c.lane = t_ & 63; c.wave = __builtin_amdgcn_readfirstlane(t_ >> 6); \
        { int b_ = blockIdx.x, g_ = gridDim.x; asm volatile("" : "+s"(b_), "+s"(g_)); c.bx = b_; c.G = g_; } c.gw = c.bx * 8 + c.wave; c.ngw = c.G * 8; }
    volatile LAS unsigned* MISC = (volatile LAS unsigned*)((LAS unsigned char*)lds_raw + LDS_MISC);
    if (threadIdx.x < 4) MISC[threadIdx.x] = 0u;
    __syncthreads();
    XcdBarrier bar; bar.bar = (unsigned*)(p.ws + WS_CTL); bar.x = 0; bar.st = MISC;
    if (p.hi - p.lo > 1) bar = xcd_barrier_post((unsigned*)(p.ws + WS_CTL), MISC);
    unsigned char* ws = p.ws;
    bf16* const H = (bf16*)(ws + WS_H); bf16* const HKV = (bf16*)(ws + WS_HKV);
    float* const X = p.out;
    int s = 0;
#ifndef REPMASK
#define REPMASK 0
#endif
#define KF_(f) p.f = kq_->f;
#define MK_P() Params p; { unsigned long long ka_ = (unsigned long long)__builtin_amdgcn_kernarg_segment_ptr(); asm volatile("" : "+s"(ka_)); const __attribute__((address_space(4))) Params* kq_ = (const __attribute__((address_space(4))) Params*)ka_; \
        KF_(x) KF_(ln_mix) KF_(ln_ffn) KF_(ret_w_in) KF_(ret_w_out) KF_(ret_gn) KF_(kv_norm) KF_(w_kv) KF_(att_w_q) KF_(att_w_o) KF_(att_rel_bias) KF_(peer_w_q) KF_(peer_sub_keys) KF_(peer_u) KF_(peer_v) KF_(ln_final) \
        KF_(out) KF_(ws) KF_(lo) KF_(hi) } \
        unsigned char* const ws = p.ws; bf16* const H = (bf16*)(ws + WS_H); bf16* const HKV = (bf16*)(ws + WS_HKV); float* const X = p.out; (void)H; (void)HKV; (void)X;
#define BEGIN_STEP(k) if (((MASK >> (k)) & 1) && s >= p.lo && s < p.hi) { for (int rep_ = ((REPMASK >> (k)) & 1) ? 0 : 1; rep_ < 2; ++rep_) { MK_CTX(); MK_P();
#define END_STEP   if (rep_ == 0 || s + 1 < p.hi) xcd_barrier(bar); } } ++s;

    BEGIN_STEP(0) p0_prologue(p, c); END_STEP

    for (int l = 0; l < DEPTH; ++l) {
        if (l < 2) {
            BEGIN_STEP(1)
                pg8::Gemm g{H, (const bf16*)(ws + WS_WIN) + (size_t)l * RIN * DM, NTOK, RIN, DM}; pg8::StaticOrder S; S.init(NTOK, RIN, c.G, c.bx);
                pg8::EpiProj E{(bf16*)(ws + WS_Q), (bf16*)(ws + WS_K), (bf16*)(ws + WS_V), (bf16*)(ws + WS_G), (const float*)(ws + WS_ROT)};
                pg8::gemm_phase<pg8::EpiProj, pg8::StaticOrder>(c.lds, g, S, E, nullptr);
            END_STEP
            BEGIN_STEP(2)
                for (int u = c.bx; u < 256; u += c.G) ret_scan_unit(c, (const bf16*)(ws + WS_Q), (const bf16*)(ws + WS_K), (const bf16*)(ws + WS_V), (bf16*)(ws + WS_O), u);
            END_STEP
            BEGIN_STEP(3)
                ret_gate_phase(c, (const bf16*)(ws + WS_O), (bf16*)(ws + WS_G), p.ret_gn + (size_t)l * RVW, rep_ == 0 ? (bf16*)(ws + WS_SC) : nullptr);
            END_STEP
        } else {
            BEGIN_STEP(4)
                for (int pass = (l == 2 ? 0 : 1); pass < 2; ++pass) {
                    const int N = pass ? DM : 2 * DM;
                    pg8::Gemm g{pass ? H : HKV, pass ? (const bf16*)(ws + WS_WQ) + (size_t)(l - 2) * DM * DM : (const bf16*)(ws + WS_WKV), NTOK, N, DM}; pg8::StaticOrder S; S.init(NTOK, N, c.G, c.bx);
                    pg8::EpiBf16S E{pass ? (bf16*)(ws + WS_Q) : (bf16*)(ws + WS_KV), N, pass ? 0.12751743082459868f : 1.0f};
                    pg8::gemm_phase<pg8::EpiBf16S, pg8::StaticOrder>(c.lds, g, S, E, nullptr);
                }
            END_STEP
            BEGIN_STEP(5)
#ifdef ATTNDRY
                attn_phase(c, (const bf16*)(ws + WS_Q), (const bf16*)(ws + WS_KV), rep_ == 0 ? (bf16*)(ws + WS_O) : (bf16*)(ws + WS_AO), p.att_rel_bias + (size_t)(l - 2) * AH * NREL, rep_ == 0 ? ATTNDRY : 0);
#else
                attn_phase2(c, (const bf16*)(ws + WS_Q), (const bf16*)(ws + WS_KV), (bf16*)(ws + WS_AO), p.att_rel_bias + (size_t)(l - 2) * AH * NREL);
#endif
            END_STEP
        }
        BEGIN_STEP(6)
            const int K = l < 2 ? RVW : DM;
            pg8::Gemm g{l < 2 ? (const bf16*)(ws + WS_G) : (const bf16*)(ws + WS_AO), l < 2 ? (const bf16*)(ws + WS_WOUT) + (size_t)l * DM * RVW : (const bf16*)(ws + WS_WO) + (size_t)(l - 2) * DM * DM, NTOK, DM, K};
            pg8::StaticOrder S; S.init(NTOK, DM, c.G, c.bx);
            pg8::EpiRes E{X, DM, H, p.ln_ffn + (size_t)l * DM, (float*)(ws + WS_SQP)};
            pg8::gemm_phase<pg8::EpiRes, pg8::StaticOrder>(c.lds, g, S, E, nullptr);
        END_STEP
        BEGIN_STEP(8)
            pg8::Gemm g{H, (const bf16*)(ws + WS_WC) + (size_t)l * DM * DM, NTOK, DM, DM}; pg8::StaticOrder S; S.init(NTOK, DM, c.G, c.bx);
            pg8::EpiF32 E{(float*)(ws + WS_SC), DM};
            pg8::gemm_phase<pg8::EpiF32, pg8::StaticOrder>(c.lds, g, S, E, nullptr);
        END_STEP
        BEGIN_STEP(9)
            peer_topk_phase(c, (const float*)(ws + WS_SC), (int*)(ws + WS_IDX), (float*)(ws + WS_WGT), (const float*)(ws + WS_SQP), (float*)(ws + WS_RSTD));
        END_STEP
        BEGIN_STEP(10)
#ifdef DRYIDXMASK
            peer_u_phase(c, H, ws + WS_PU + (size_t)l * PE * DM, (const int*)(ws + WS_IDX), (float*)(ws + WS_SC), rep_ == 0 ? DRYIDXMASK : 0xffffffffu);
#else
            peer_u_phase(c, H, ws + WS_PU + (size_t)l * PE * DM, (const int*)(ws + WS_IDX), (float*)(ws + WS_SC));
#endif
        END_STEP
        BEGIN_STEP(11)
            peer_a_phase(c, (const float*)(ws + WS_SC), (const int*)(ws + WS_IDX), (float*)(ws + WS_WGT), (const float*)(ws + WS_RS) + (size_t)l * PE, (const float*)(ws + WS_RS) + (size_t)(DEPTH + l) * PE, (const float*)(ws + WS_RSTD));
        END_STEP
        BEGIN_STEP(12)
#ifdef VREF
            peer_v_ref_phase(c, ws + WS_PV + (size_t)l * PE * DM, (const int*)(ws + WS_IDX), (const float*)(ws + WS_WGT), X);
#else
            peer_v_phase(c, ws + WS_PV + (size_t)l * PE * DM, (const int*)(ws + WS_IDX), (const float*)(ws + WS_WGT), X);
#endif
        END_STEP
        BEGIN_STEP(13)
            const int mode = (l == DEPTH - 1) ? 2 : (l == 1 ? 1 : 0);
            norm_phase(c, X, mode, mode == 2 ? p.ln_final : p.ln_mix + (size_t)(l + 1) * DM, p.kv_norm, H, HKV);
        END_STEP
    }
#ifdef DIAGBUF
    if ((MASK >> 14) & 1) { MK_CTX(); diag_copy_phase(c, X, ws); }
#else
    if ((MASK >> 14) & 1) { MK_CTX(); MK_P(); rms_final_phase(c, X, p.ln_final); }
#endif
#undef BEGIN_STEP
#undef END_STEP
}

#ifndef N_LAUNCH_CUT
#define N_LAUNCH_CUT 1
#endif
typedef void (*kern_t)(Params);
template <int SITE> static void launch_site(const Params& p, hipStream_t stream) {
    static bool attr = false;
    if (!attr) { (void)hipFuncSetAttribute((const void*)yoco_fwd<(1 << SITE)>, hipFuncAttributeMaxDynamicSharedMemorySize, LDS_BYTES); attr = true; }
    hipLaunchKernelGGL((yoco_fwd<(1 << SITE)>), dim3(256), dim3(512), LDS_BYTES, stream, p);
}
#ifndef MEGASITES
#define MEGASITES 0
#endif
static void launch_step_site(int site, const Params& p, hipStream_t stream) {
    if ((MEGASITES >> site) & 1) { hipLaunchKernelGGL((yoco_fwd<0x3FFF>), dim3(256), dim3(512), LDS_BYTES, stream, p); return; }
    switch (site) {
        case 0: launch_site<0>(p, stream); break; case 1: launch_site<1>(p, stream); break; case 2: launch_site<2>(p, stream); break; case 3: launch_site<3>(p, stream); break;
        case 4: launch_site<4>(p, stream); break; case 5: launch_site<5>(p, stream); break; case 6: launch_site<6>(p, stream); break; case 7: launch_site<7>(p, stream); break;
        case 8: launch_site<8>(p, stream); break; case 9: launch_site<9>(p, stream); break; case 10: launch_site<10>(p, stream); break; case 11: launch_site<11>(p, stream); break; case 12: launch_site<12>(p, stream); break; case 13: launch_site<13>(p, stream); break; default: launch_site<14>(p, stream); break;
    }
}
extern "C" void kernel_launch(void* const* d_in, const int* in_sizes, int n_in, void* d_out, int out_size, void* d_ws, size_t ws_size, hipStream_t stream) {
    static int ready = 0;
    if (ready == 0) {
        if (n_in != 16 || out_size != NTOK * DM || ws_size < WS_END) { fprintf(stderr, "kernel_launch: unexpected sizes (n_in %d out %d ws %zu, need %zu)\n", n_in, out_size, ws_size, (size_t)WS_END); ready = -1; return; }
#if N_LAUNCH_CUT || MEGASITES
        if (hipFuncSetAttribute((const void*)yoco_fwd<0x3FFF>, hipFuncAttributeMaxDynamicSharedMemorySize, LDS_BYTES) != hipSuccess) { fprintf(stderr, "kernel_launch: hipFuncSetAttribute failed\n"); ready = -1; return; }
#endif
        ready = 1;
    }
    if (ready < 0) return;
    (void)hipMemsetAsync(d_ws, 0, 16384, stream);
    Params p{};
    p.x = (const float*)d_in[0]; p.ln_mix = (const float*)d_in[1]; p.ln_ffn = (const float*)d_in[2]; p.ret_w_in = (const float*)d_in[3]; p.ret_w_out = (const float*)d_in[4]; p.ret_gn = (const float*)d_in[5];
    p.kv_norm = (const float*)d_in[6]; p.w_kv = (const float*)d_in[7]; p.att_w_q = (const float*)d_in[8]; p.att_w_o = (const float*)d_in[9]; p.att_rel_bias = (const float*)d_in[10];
    p.peer_w_q = (const float*)d_in[11]; p.peer_sub_keys = (const float*)d_in[12]; p.peer_u = (const float*)d_in[13]; p.peer_v = (const float*)d_in[14]; p.ln_final = (const float*)d_in[15];
    p.out = (float*)d_out; p.ws = (unsigned char*)d_ws;
#if N_LAUNCH_CUT == 2
    for (int s2 = 0; s2 < NSTEPS; ++s2) { p.lo = s2; p.hi = s2 + 1; hipLaunchKernelGGL((yoco_fwd<0x3FFF>), dim3(256), dim3(512), LDS_BYTES, stream, p); }
#elif N_LAUNCH_CUT
    p.lo = 0; p.hi = NSTEPS;
    hipLaunchKernelGGL((yoco_fwd<0x3FFF>), dim3(256), dim3(512), LDS_BYTES, stream, p);
#else
    static const int siteA[10] = {1, 2, 3, 6, 8, 9, 10, 11, 12, 13}, siteB[9] = {4, 5, 6, 8, 9, 10, 11, 12, 13};
    int s = 0;
#ifndef NSTOP
#define NSTOP 1000
#endif
    p.lo = s; p.hi = s + 1; launch_step_site(0, p, stream); ++s;
    for (int l = 0; l < DEPTH; ++l) { const int n = l < 2 ? 10 : 9; for (int k = 0; k < n; ++k) { p.lo = s; p.hi = s + 1; if (s < NSTOP) launch_step_site(l < 2 ? siteA[k] : siteB[k], p, stream); ++s; } }
    if (NSTOP < NSTEPS) { p.lo = -1; p.hi = -1; launch_step_site(14, p, stream); }
#endif
}
```

```cpp
#include <hip/hip_runtime.h>
#include <cstdio>
#include <cstdint>

#define LAS __attribute__((address_space(3)))
#define GAS __attribute__((address_space(1)))
typedef unsigned short bf16;
typedef unsigned u32x2 __attribute__((ext_vector_type(2)));
typedef float f32x2v __attribute__((ext_vector_type(2)));

constexpr int DM = 2048, NBATCH = 4, SEQ = 4096, NTOK = NBATCH * SEQ, DEPTH = 4;
constexpr int CHUNK = 64, NCHUNK = SEQ / CHUNK;
constexpr int RH = 8, RQK = 256, RV = 512, RQKW = RH * RQK, RVW = RH * RV, RIN = 2 * RQKW + 2 * RVW;
constexpr int AH = 16, AHD = 128, LEFT = 8, NREL = 257;
constexpr int PH = 8, PNK = 128, PE = PNK * PNK, PTOPK = 16;
constexpr float EPS = 1e-6f;

constexpr size_t MiB = 1ull << 20;
constexpr size_t WS_CTL = 0, CTL_BYTES = 1 * MiB;
constexpr size_t WS_ROT = 1 * MiB;
constexpr size_t WS_RS = 6 * MiB;
constexpr size_t WS_WIN = 8 * MiB;
constexpr size_t WS_WOUT = 104 * MiB;
constexpr size_t WS_WKV = 136 * MiB;
constexpr size_t WS_WQ = 152 * MiB;
constexpr size_t WS_WO = 168 * MiB;
constexpr size_t WS_WC = 184 * MiB;
constexpr size_t WS_PU = 216 * MiB;
constexpr size_t WS_PV = 472 * MiB;
constexpr size_t WS_H = 728 * MiB;
constexpr size_t WS_HKV = 792 * MiB;
constexpr size_t WS_Q = 856 * MiB;
constexpr size_t WS_K = 920 * MiB;
constexpr size_t WS_V = 984 * MiB;
constexpr size_t WS_G = 1112 * MiB;
constexpr size_t WS_O = 1240 * MiB;
constexpr size_t WS_KV = 1368 * MiB;
constexpr size_t WS_AO = 1496 * MiB;
constexpr size_t WS_SC = 1560 * MiB;
constexpr size_t WS_IDX = 1688 * MiB;
constexpr size_t WS_WGT = 1696 * MiB;
constexpr size_t WS_SQP = 1704 * MiB;
constexpr size_t WS_RSTD = 1706 * MiB;
constexpr size_t WS_END = 1708 * MiB;

constexpr int LDS_BYTES = 160 * 1024;
constexpr int LDS_MISC = LDS_BYTES - 256;

__device__ __forceinline__ unsigned f2bf(float f) { unsigned u = __builtin_bit_cast(unsigned, f); return (u + 0x7fffu + ((u >> 16) & 1u)) >> 16; }
typedef __bf16 bfx2_t __attribute__((ext_vector_type(2)));
__device__ __forceinline__ unsigned pk2(float lo, float hi) { const f32x2v v = {lo, hi}; return __builtin_bit_cast(unsigned, __builtin_convertvector(v, bfx2_t)); }
__device__ __forceinline__ float bflo(unsigned u) { return __builtin_bit_cast(float, u << 16); }
__device__ __forceinline__ float bfhi(unsigned u) { return __builtin_bit_cast(float, u & 0xffff0000u); }
__device__ __forceinline__ float wave_sum(float v) {
#pragma unroll
    for (int o = 1; o < 64; o <<= 1) v += __shfl_xor(v, o);
    return v;
}
#define VM_WAIT() asm volatile("s_waitcnt vmcnt(0)" ::: "memory")
#define LDS_WAIT() asm volatile("s_waitcnt lgkmcnt(0)" ::: "memory")

#define XB_TMO      128
#define XB_XCNT(j)  (256  + 64 * (j))
#define XB_XSUB(j)  (1280 + 64 * (j))
#define XB_XGEN(j)  (2304 + 64 * (j))
#define XB_TOP      3328
#define XB_TOPGEN   3392
#define XCD_BAR_WORDS 3456
#define XB_SPIN_CAP (1u << 18)

__device__ __forceinline__ unsigned xb_ld(unsigned* p)              { return __hip_atomic_load(p, __ATOMIC_RELAXED, __HIP_MEMORY_SCOPE_AGENT); }
__device__ __forceinline__ unsigned xb_add(unsigned* p, unsigned v) { return __hip_atomic_fetch_add(p, v, __ATOMIC_RELAXED, __HIP_MEMORY_SCOPE_AGENT); }
__device__ __forceinline__ unsigned xb_xcc_id() { return (unsigned)__builtin_amdgcn_s_getreg((3 << 11) | 20) & 0xFu; }
#define XB_SPIN(cond, bar) do { unsigned _sp = 0; while (cond) { __builtin_amdgcn_s_sleep(1); \
    if ((++_sp & 255u) == 0u) { if (xb_ld(&(bar)[XB_TMO])) break; if (_sp > XB_SPIN_CAP) { atomicAdd(&(bar)[XB_TMO], 1u); break; } } } } while (0)

struct XcdBarrier {
    unsigned* bar; unsigned x;
    volatile LAS unsigned* st;
};

__device__ __forceinline__ XcdBarrier xcd_barrier_post(unsigned* bar, volatile LAS unsigned* st) {
    XcdBarrier b; b.bar = bar; b.x = xb_xcc_id(); b.st = st;
    if (threadIdx.x == 0) (void)xb_add(&bar[XB_XCNT(b.x)], 1u);
    return b;
}
__device__ __forceinline__ void xcd_barrier_complete(unsigned* bar, unsigned x, unsigned& nloc, unsigned& nx) {
    const unsigned G = gridDim.x * gridDim.y * gridDim.z;
    unsigned sum, cnt, mine, sp = 0u;
    for (;;) {
        sum = 0u; cnt = 0u; mine = 0u;
#pragma unroll
        for (unsigned j = 0; j < 16; ++j) { const unsigned c = xb_ld(&bar[XB_XCNT(j)]); sum += c; cnt += (c > 0u) ? 1u : 0u; mine = (j == x) ? c : mine; }
        if (sum == G) break;
        __builtin_amdgcn_s_sleep(1);
        if ((++sp & 255u) == 0u) { if (xb_ld(&bar[XB_TMO])) break; if (sp > XB_SPIN_CAP) { atomicAdd(&bar[XB_TMO], 1u); break; } }
    }
    nloc = mine > 0u ? mine : 1u; nx = cnt > 0u ? cnt : 1u;
}

__device__ __forceinline__ void xcd_barrier(const XcdBarrier& b) {
    asm volatile("s_waitcnt vmcnt(0)" ::: "memory");
    __syncthreads();
    if (threadIdx.x == 0) {
        unsigned* bar = b.bar;
        __builtin_amdgcn_s_waitcnt(0);
        unsigned nloc = b.st[0], nx = b.st[1];
        if (nloc == 0u) { xcd_barrier_complete(bar, b.x, nloc, nx); b.st[0] = nloc; b.st[1] = nx; }
        const unsigned old = xb_add(&bar[XB_XSUB(b.x)], 1u);
        const unsigned gen = old / nloc;
        if (old + 1u == (gen + 1u) * nloc) {
            __builtin_amdgcn_fence(__ATOMIC_RELEASE, "agent");
            asm volatile("s_waitcnt vmcnt(0)" ::: "memory");
            const unsigned og = xb_add(&bar[XB_TOP], 1u);
            const unsigned tg = og / nx;
            if (og + 1u == (tg + 1u) * nx) xb_add(&bar[XB_TOPGEN], 1u);
            else XB_SPIN(xb_ld(&bar[XB_TOPGEN]) == tg, bar);
            __builtin_amdgcn_fence(__ATOMIC_ACQUIRE, "agent");
            xb_add(&bar[XB_XGEN(b.x)], 1u);
            asm volatile("s_waitcnt vmcnt(0)" ::: "memory");
        } else {
            XB_SPIN(xb_ld(&bar[XB_XGEN(b.x)]) == gen, bar);
            __builtin_amdgcn_fence(__ATOMIC_ACQUIRE, "agent");
            asm volatile("s_waitcnt vmcnt(0)" ::: "memory");
        }
    }
    __syncthreads();
}

namespace pg8 {
#define PG8_LAS __attribute__((address_space(3)))
typedef unsigned short bf16_t;
typedef short bf16x8 __attribute__((ext_vector_type(8)));
typedef float f32x4 __attribute__((ext_vector_type(4)));
typedef unsigned u32x4 __attribute__((ext_vector_type(4)));
constexpr int BM = 256, BK = 64, HALF = 128, HTB = HALF * BK * 2  , STAGE_BYTES = 8 * HTB, NXCD = 8, WGM = 8;

__host__ __device__ __forceinline__ int lds_byte(int r, int c) { const int st = (r >> 4) * 2 + (c >> 5), rr = r & 15, cc = c & 31, ob = rr * 64 + cc * 2; return st * 1024 + (ob ^ (((ob >> 9) & 1) << 5)); }
__host__ __device__ __forceinline__ void stage_rc(int b, int& R, int& C) { const int st = b / 1024, sb = b % 1024, swz = sb ^ (((sb >> 9) & 1) << 5); R = (st >> 1) * 16 + swz / 64; C = (st & 1) * 32 + (swz % 64) / 2; }
__host__ __device__ __forceinline__ int perm32(int rho) { const int n = rho >> 4, i = rho & 15; return 8 * (i >> 2) + 4 * n + (i & 3); }

struct Unit { int pm, pn; };
struct Gemm { const bf16_t* A; const bf16_t* Bt; int M, N, K; };

struct StaticOrder {
    int nM, nN, nwg, G, c;
    __host__ __device__ void init(int M, int N, int G_, int c_) { nM = M / BM; nN = N / BM; nwg = nM * nN; G = G_; c = c_; }
    __host__ __device__ bool next(int i, Unit& u) const {
        const long L = (long)i * G + c; if (L >= nwg) return false;
        int wgid = (int)L; { const int q = nwg / NXCD, r = nwg % NXCD, xcd = wgid % NXCD, off = wgid / NXCD; wgid = (xcd < r ? xcd * (q + 1) : r * (q + 1) + (xcd - r) * q) + off; }
        const int nig = WGM * nN, gid = wgid / nig, fm = gid * WGM, gsz = (nM - fm) < WGM ? (nM - fm) : WGM;
        u.pm = fm + ((wgid % nig) % gsz); u.pn = (wgid % nig) / gsz; return true;
    }
    __device__ __forceinline__ void a_ready(const Unit&) const {}
    __device__ __forceinline__ void done(const Unit&) const {}
};
struct CountedOrder : StaticOrder {
    const unsigned* ready; unsigned need; unsigned* tmo;
    __device__ __forceinline__ void a_ready(const Unit& u) const {
        if (threadIdx.x < 64) {
            const unsigned long long t0 = __builtin_amdgcn_s_memrealtime(); unsigned polls = 0;
            while ((unsigned)__builtin_amdgcn_readfirstlane(__hip_atomic_load(ready + 64 * u.pm, __ATOMIC_RELAXED, __HIP_MEMORY_SCOPE_AGENT)) < need) {
                if ((++polls & 255u) == 0u && __builtin_amdgcn_readfirstlane(__hip_atomic_load(tmo, __ATOMIC_RELAXED, __HIP_MEMORY_SCOPE_AGENT)) != 0u) break;
                if (__builtin_amdgcn_s_memrealtime() - t0 > 2000000ull) {
                    if (threadIdx.x == 0) { unsigned expect = 0u; __hip_atomic_compare_exchange_strong(tmo + 1, &expect, 0x600u | (unsigned)(u.pm & 0xff), __ATOMIC_RELAXED, __ATOMIC_RELAXED, __HIP_MEMORY_SCOPE_AGENT); __hip_atomic_store(tmo, 1u, __ATOMIC_RELAXED, __HIP_MEMORY_SCOPE_AGENT); }
                    break; }
                __builtin_amdgcn_s_sleep(2); }
            __builtin_amdgcn_fence(__ATOMIC_ACQUIRE, "agent");
            asm volatile("s_waitcnt vmcnt(0)" ::: "memory");
        }
#if !defined(BROKEN_HOOK_NO_BARRIER)
        asm volatile("" ::: "memory"); __builtin_amdgcn_s_barrier(); asm volatile("" ::: "memory");
#endif
    }
};

__device__ __forceinline__ unsigned cvt_pk_bf16(float lo, float hi) { return pk2(lo, hi); }
typedef float f32x2 __attribute__((ext_vector_type(2)));
__device__ __forceinline__ f32x2 gelu_pk(f32x2 v) {
    const f32x2 av = __builtin_elementwise_abs(v), d = av * 0.2316418882f + 1.0f;
    f32x2 t; t.x = __builtin_amdgcn_rcpf(d.x); t.y = __builtin_amdgcn_rcpf(d.y);
    f32x2 q = t * 0.5307027145f + (-0.7265760135f); q = q * t + 0.7107068705f; q = q * t + (-0.142248368f); q = q * t + 0.127414796f; q = q * t;
    const f32x2 s = (v * v) * (-0.72134752044f);
    f32x2 e; e.x = __builtin_amdgcn_exp2f(s.x); e.y = __builtin_amdgcn_exp2f(s.y);
    const f32x2 m = v * (q * e), r = v - m;
    f32x2 o; o.x = v.x < 0.f ? m.x : r.x; o.y = v.y < 0.f ? m.y : r.y; return o;
}


struct EpiF32 {
    static constexpr bool PERM = false, AFTER_DRAIN = false;
    float* C; int ldc;
    __device__ __forceinline__ void operator()(const f32x4 (&acc)[2][2][4][2], const Unit& u, int wr, int wc, int fr, int fq) const {
        const int row0 = u.pm * BM + wr * 64 + fr, col0 = u.pn * BM + wc * 32 + 4 * fq;
#pragma unroll
        for (int ai = 0; ai < 2; ++ai)
#pragma unroll
            for (int m = 0; m < 4; ++m) { float* rowp = C + (size_t)(row0 + ai * HALF + m * 16) * ldc + col0;
#pragma unroll
                for (int bj = 0; bj < 2; ++bj)
#pragma unroll
                    for (int n = 0; n < 2; ++n) *(f32x4*)(rowp + bj * HALF + n * 16) = acc[ai][bj][m][n]; }
    }
};
struct EpiRes {
    static constexpr bool PERM = false, AFTER_DRAIN = false;
    float* X; int ldc; bf16_t* Hn; const float* gn; float* sqp;
    __device__ __forceinline__ void operator()(const f32x4 (&acc)[2][2][4][2], const Unit& u, int wr, int wc, int fr, int fq) const {
        const int row0 = u.pm * BM + wr * 64 + fr, col0 = u.pn * BM + wc * 32 + 4 * fq;
        f32x4 gv[2][2];
#pragma unroll
        for (int bj = 0; bj < 2; ++bj)
#pragma unroll
            for (int n = 0; n < 2; ++n) gv[bj][n] = *(const f32x4*)(gn + col0 + bj * HALF + n * 16);
#pragma unroll
        for (int ai = 0; ai < 2; ++ai) {
            f32x4 old[4][2][2];
#pragma unroll
            for (int m = 0; m < 4; ++m) { const float* rp = X + (size_t)(row0 + ai * HALF + m * 16) * ldc + col0;
#pragma unroll
                for (int bj = 0; bj < 2; ++bj)
#pragma unroll
                    for (int n = 0; n < 2; ++n) old[m][bj][n] = *(const f32x4*)(rp + bj * HALF + n * 16); }
#pragma unroll
            for (int m = 0; m < 4; ++m) { const int r = row0 + ai * HALF + m * 16; float* rowp = X + (size_t)r * ldc + col0; bf16_t* hp = Hn + (size_t)r * ldc + col0;
                float ss = 0.f;
#pragma unroll
                for (int bj = 0; bj < 2; ++bj)
#pragma unroll
                    for (int n = 0; n < 2; ++n) { const f32x4 xn = old[m][bj][n] + acc[ai][bj][m][n]; *(f32x4*)(rowp + bj * HALF + n * 16) = xn;
                        ss += (xn[0] * xn[0] + xn[1] * xn[1]) + (xn[2] * xn[2] + xn[3] * xn[3]);
                        const f32x4 hg = xn * gv[bj][n]; u32x2 hw; hw.x = pk2(hg[0], hg[1]); hw.y = pk2(hg[2], hg[3]); *(u32x2*)(hp + bj * HALF + n * 16) = hw; }
                ss += __shfl_xor(ss, 16); ss += __shfl_xor(ss, 32);
                if (fq == 0) sqp[(size_t)r * 32 + u.pn * 4 + wc] = ss; }
        }
    }
};
struct EpiBf16S {
    static constexpr bool PERM = true, AFTER_DRAIN = false;
    bf16_t* O; int ldc; float scale;
    __device__ __forceinline__ void operator()(const f32x4 (&acc)[2][2][4][2], const Unit& u, int wr, int wc, int fr, int fq) const {
        const int row0 = u.pm * BM + wr * 64 + fr, col0 = u.pn * BM + wc * 32 + 8 * fq;
#pragma unroll
        for (int ai = 0; ai < 2; ++ai)
#pragma unroll
            for (int m = 0; m < 4; ++m) { bf16_t* rowp = O + (size_t)(row0 + ai * HALF + m * 16) * ldc + col0;
#pragma unroll
                for (int bj = 0; bj < 2; ++bj) { const f32x4 v0 = acc[ai][bj][m][0] * scale, v1 = acc[ai][bj][m][1] * scale;
                    u32x4 w; w.x = cvt_pk_bf16(v0[0], v0[1]); w.y = cvt_pk_bf16(v0[2], v0[3]); w.z = cvt_pk_bf16(v1[0], v1[1]); w.w = cvt_pk_bf16(v1[2], v1[3]);
                    *(u32x4*)(rowp + bj * HALF) = w; } }
    }
};
struct EpiProj {
    static constexpr bool PERM = true, AFTER_DRAIN = false;
    bf16_t *Q, *Kp, *V, *G; const float* rot;
    __device__ __forceinline__ void operator()(const f32x4 (&acc)[2][2][4][2], const Unit& u, int wr, int wc, int fr, int fq) const {
        const int row0 = u.pm * BM + wr * 64 + fr, pn = u.pn, dd0 = wc * 32 + 8 * fq;
        if (pn < 16) {
            bf16_t* base = (pn < 8 ? Q : Kp) + (pn & 7) * 256 + dd0; const float sc = pn < 8 ? 1.0f : 0.0625f;
#pragma unroll
            for (int ai = 0; ai < 2; ++ai)
#pragma unroll
                for (int m = 0; m < 4; ++m) { const int r = row0 + ai * HALF + m * 16; const float* rt = rot + (size_t)(r & (4096 - 1)) * 256 + dd0;
                    f32x4 o1[2], o2[2];
#pragma unroll
                    for (int n = 0; n < 2; ++n) { const f32x4 cs = *(const f32x4*)(rt + 4 * n), sn = *(const f32x4*)(rt + 128 + 4 * n); const f32x4 t1 = acc[ai][0][m][n], t2 = acc[ai][1][m][n];
                        o1[n] = (t1 * cs - t2 * sn) * sc; o2[n] = (t1 * sn + t2 * cs) * sc; }
                    u32x4 w1, w2;
                    w1.x = cvt_pk_bf16(o1[0][0], o1[0][1]); w1.y = cvt_pk_bf16(o1[0][2], o1[0][3]); w1.z = cvt_pk_bf16(o1[1][0], o1[1][1]); w1.w = cvt_pk_bf16(o1[1][2], o1[1][3]);
                    w2.x = cvt_pk_bf16(o2[0][0], o2[0][1]); w2.y = cvt_pk_bf16(o2[0][2], o2[0][3]); w2.z = cvt_pk_bf16(o2[1][0], o2[1][1]); w2.w = cvt_pk_bf16(o2[1][2], o2[1][3]);
                    bf16_t* rowp = base + (size_t)r * 2048; *(u32x4*)rowp = w1; *(u32x4*)(rowp + 128) = w2; }
        } else {
            bf16_t* base = (pn < 32 ? V : G) + ((pn - 16) & 15) * 256 + dd0;
#pragma unroll
            for (int ai = 0; ai < 2; ++ai)
#pragma unroll
                for (int m = 0; m < 4; ++m) { bf16_t* rowp = base + (size_t)(row0 + ai * HALF + m * 16) * 4096;
#pragma unroll
                    for (int bj = 0; bj < 2; ++bj) { const f32x4 v0 = acc[ai][bj][m][0], v1 = acc[ai][bj][m][1];
                        u32x4 w; w.x = cvt_pk_bf16(v0[0], v0[1]); w.y = cvt_pk_bf16(v0[2], v0[3]); w.z = cvt_pk_bf16(v1[0], v1[1]); w.w = cvt_pk_bf16(v1[2], v1[3]);
                        *(u32x4*)(rowp + bj * HALF) = w; } }
        }
    }
};
template <class Epi, class Sched, bool STAMP = false>
__device__ __forceinline__ void gemm_phase(PG8_LAS unsigned char* lds, const Gemm g, const Sched& S, const Epi& E, unsigned long long* stamps) {
    int tid_ = threadIdx.x; asm volatile("" : "+v"(tid_));
    const int tid = tid_, wid = __builtin_amdgcn_readfirstlane(tid >> 6), lane = tid & 63, wr = wid >> 2, wc = wid & 3, fr = lane & 15, fq = lane >> 4;
    const int K = g.K, nt = K / BK;
    int ts_lo = 0, ts_hi = 0, nts = 0; const unsigned long long rt_entry = STAMP ? (unsigned long long)wall_clock64() : 0ull;
#define PG8_STAMP() do { if (STAMP && wid == 0 && nts < 64) { const unsigned long long _c = (unsigned long long)clock64(); \
        ts_lo = (lane == nts) ? (int)(unsigned)_c : ts_lo; ts_hi = (lane == nts) ? (int)(unsigned)(_c >> 32) : ts_hi; ++nts; } } while (0)
    PG8_STAMP();
    unsigned voffA[2], voffB[2];
#pragma unroll
    for (int i = 0; i < 2; ++i) { int R, C; stage_rc(tid * 16 + i * 8192, R, C); const int Rb = Epi::PERM ? ((R & ~31) + perm32(R & 31)) : R;
        voffA[i] = (unsigned)(R * K + C) * 2u; voffB[i] = (unsigned)(Rb * K + C) * 2u; }
    const size_t kstep = (size_t)(BK * 2);
    const size_t hstep = (size_t)HALF * K * 2;
    const size_t tstep = 2 * hstep;
    const unsigned ldsw = (unsigned)wid * 1024u;
    const int aoff = lds_byte(wr * 64 + fr, fq * 8), boff = lds_byte(wc * 32 + fr, fq * 8);
#define PG8_SA(b, h) (((b) * 2 + (h)) * HTB)
#define PG8_SB(b, h) ((4 + (b) * 2 + (h)) * HTB)
#define PG8_STAGE(bufoff, gbase, voff) do { _Pragma("unroll") for (int _i = 0; _i < 2; ++_i) \
        __builtin_amdgcn_global_load_lds((const unsigned*)((const char*)(gbase) + (voff)[_i]), (PG8_LAS unsigned*)(lds + (bufoff) + ldsw + _i * 8192), 16, 0, 0); } while (0)
#define PG8_LDA(dst, b, h) do { _Pragma("unroll") for (int m = 0; m < 4; ++m) _Pragma("unroll") for (int k = 0; k < 2; ++k) dst[m][k] = *(const PG8_LAS bf16x8*)(lds + PG8_SA(b, h) + aoff + m * 2048 + k * 1024); } while (0)
#define PG8_LDB(dst, b, h) do { _Pragma("unroll") for (int n = 0; n < 2; ++n) _Pragma("unroll") for (int k = 0; k < 2; ++k) dst[n][k] = *(const PG8_LAS bf16x8*)(lds + PG8_SB(b, h) + boff + n * 2048 + k * 1024); } while (0)
#define PG8_MMA(ai, bj, At, Bt) do { __builtin_amdgcn_s_setprio(1); _Pragma("unroll") for (int m = 0; m < 4; ++m) _Pragma("unroll") for (int n = 0; n < 2; ++n) _Pragma("unroll") for (int k = 0; k < 2; ++k) \
        acc[ai][bj][m][n] = __builtin_amdgcn_mfma_f32_16x16x32_bf16(Bt[n][k], At[m][k], acc[ai][bj][m][n], 0, 0, 0); __builtin_amdgcn_s_setprio(0); } while (0)
#define PG8_WAIT_V(n) asm volatile("s_waitcnt vmcnt(" #n ")" ::: "memory")
#define PG8_WAIT_L(n) asm volatile("s_waitcnt lgkmcnt(" #n ")" ::: "memory")
#define PG8_BAR __builtin_amdgcn_s_barrier()
#define PG8_SCHED __builtin_amdgcn_sched_barrier(0)
    Unit cur, nxt; int ui = 0;
    if (!S.next(0, cur)) return;
    f32x4 acc[2][2][4][2];
#pragma unroll
    for (int a = 0; a < 2; ++a)
#pragma unroll
        for (int b = 0; b < 2; ++b)
#pragma unroll
            for (int m = 0; m < 4; ++m)
#pragma unroll
                for (int n = 0; n < 2; ++n) acc[a][b][m][n] = (f32x4){0.f, 0.f, 0.f, 0.f};
    bf16x8 At[4][2], B0[2][2], B1[2][2];
    const char* cA = (const char*)g.A + (size_t)cur.pm * tstep; const char* cB = (const char*)g.Bt + (size_t)cur.pn * tstep;
    S.a_ready(cur);
    PG8_STAGE(PG8_SB(0, 0), cB, voffB); PG8_STAGE(PG8_SA(0, 0), cA, voffA); PG8_STAGE(PG8_SB(0, 1), cB + hstep, voffB); PG8_STAGE(PG8_SA(0, 1), cA + hstep, voffA);
    if (wr == 1) PG8_BAR;
    PG8_WAIT_V(4); PG8_BAR;
    PG8_STAGE(PG8_SB(1, 0), cB + kstep, voffB); PG8_STAGE(PG8_SA(1, 0), cA + kstep, voffA); PG8_STAGE(PG8_SB(1, 1), cB + hstep + kstep, voffB);
    PG8_WAIT_V(6); PG8_BAR;
    PG8_STAMP();
    for (;;) {
        const bool has_next = S.next(ui + 1, nxt);
        const char* nA = has_next ? (const char*)g.A + (size_t)nxt.pm * tstep : cA; const char* nB = has_next ? (const char*)g.Bt + (size_t)nxt.pn * tstep : cB;
        for (int t = 0; t < nt; t += 2) {
            const bool last = (t == nt - 2);
            const char* a1 = cA + (size_t)(t + 1) * kstep;
            const char* a2 = last ? nA : cA + (size_t)(t + 2) * kstep; const char* b2 = last ? nB : cB + (size_t)(t + 2) * kstep;
            const char* a3 = a2 + kstep; const char* b3 = b2 + kstep;
            if (last && has_next) S.a_ready(nxt);
            PG8_LDB(B0, 0, 0); PG8_SCHED; PG8_LDA(At, 0, 0); PG8_STAGE(PG8_SA(1, 1), a1 + hstep, voffA);
            PG8_WAIT_L(8); PG8_BAR; PG8_WAIT_L(0); PG8_MMA(0, 0, At, B0); PG8_BAR; PG8_SCHED;
            PG8_LDB(B1, 0, 1); PG8_STAGE(PG8_SB(0, 0), b2, voffB);
            PG8_BAR; PG8_WAIT_L(0); PG8_MMA(0, 1, At, B1); PG8_BAR;
            PG8_LDA(At, 0, 1); PG8_STAGE(PG8_SA(0, 0), a2, voffA);
            PG8_BAR; PG8_WAIT_L(0); PG8_MMA(1, 0, At, B0); PG8_BAR; PG8_SCHED;
            PG8_STAGE(PG8_SB(0, 1), b2 + hstep, voffB);
            PG8_WAIT_V(6); PG8_BAR; PG8_MMA(1, 1, At, B1); PG8_BAR;
            PG8_LDB(B0, 1, 0); PG8_SCHED; PG8_LDA(At, 1, 0); PG8_STAGE(PG8_SA(0, 1), a2 + hstep, voffA);
            PG8_WAIT_L(8); PG8_BAR; PG8_WAIT_L(0); PG8_MMA(0, 0, At, B0); PG8_BAR; PG8_SCHED;
            PG8_LDB(B1, 1, 1); PG8_STAGE(PG8_SB(1, 0), b3, voffB);
            PG8_BAR; PG8_WAIT_L(0); PG8_MMA(0, 1, At, B1); PG8_BAR;
            PG8_LDA(At, 1, 1); PG8_STAGE(PG8_SA(1, 0), a3, voffA);
            PG8_BAR; PG8_WAIT_L(0); PG8_MMA(1, 0, At, B0); PG8_BAR; PG8_SCHED;
            PG8_STAGE(PG8_SB(1, 1), b3 + hstep, voffB);
            PG8_WAIT_V(6); PG8_BAR; PG8_MMA(1, 1, At, B1); PG8_BAR;
        }
        PG8_STAMP();
        if constexpr (!Epi::AFTER_DRAIN) { E(acc, cur, wr, wc, fr, fq); S.done(cur); }
        PG8_STAMP();
        if (!has_next) break;
#pragma unroll
        for (int a = 0; a < 2; ++a)
#pragma unroll
            for (int b = 0; b < 2; ++b)
#pragma unroll
                for (int m = 0; m < 4; ++m)
#pragma unroll
                    for (int n = 0; n < 2; ++n) acc[a][b][m][n] = (f32x4){0.f, 0.f, 0.f, 0.f};
        cur = nxt; cA = nA; cB = nB; ++ui;
    }
    PG8_WAIT_V(0);
    if (wr == 0) PG8_BAR;
    PG8_BAR;
    if constexpr (Epi::AFTER_DRAIN) { E.fused(acc, cur, wr, wc, fr, fq, lds, wid, lane); S.done(cur); }
    PG8_STAMP();
    if (STAMP && wid == 0) { stamps[lane] = lane < nts ? (((unsigned long long)(unsigned)ts_hi << 32) | (unsigned)ts_lo) : 0ull;
        if (lane == 62) stamps[62] = rt_entry; if (lane == 63) stamps[63] = (unsigned long long)wall_clock64(); }
#undef PG8_STAMP
#undef PG8_SA
#undef PG8_SB
#undef PG8_STAGE
#undef PG8_LDA
#undef PG8_LDB
#undef PG8_MMA
#undef PG8_WAIT_V
#undef PG8_WAIT_L
#undef PG8_BAR
#undef PG8_SCHED
}
}

using pg8::bf16x8; using pg8::f32x4; using pg8::u32x4;
typedef short s16x4 __attribute__((ext_vector_type(4)));
typedef __bf16 bfx2 __attribute__((ext_vector_type(2)));

struct Params {
    const float *x, *ln_mix, *ln_ffn, *ret_w_in, *ret_w_out, *ret_gn, *kv_norm, *w_kv, *att_w_q, *att_w_o, *att_rel_bias, *peer_w_q, *peer_sub_keys, *peer_u, *peer_v, *ln_final;
    float* out; unsigned char* ws; int lo, hi;
};
struct Ctx { LAS unsigned char* lds; int tid, lane, wave, bx, G, gw, ngw; };

__device__ __forceinline__ float dot2bf(unsigned a, unsigned b, float c) { return __builtin_amdgcn_fdot2_f32_bf16(__builtin_bit_cast(bfx2, a), __builtin_bit_cast(bfx2, b), c, false); }
__device__ __forceinline__ bf16x8 lds128(LAS const unsigned char* p) { return *(LAS const bf16x8*)p; }
__device__ __forceinline__ bf16x8 tr_frag(unsigned a0, unsigned a1) {
    s16x4 lo, hi;
    asm volatile("ds_read_b64_tr_b16 %0, %2\n\tds_read_b64_tr_b16 %1, %3\n\ts_waitcnt lgkmcnt(0)" : "=&v"(lo), "=&v"(hi) : "v"(a0), "v"(a1) : "memory");
    bf16x8 r; r[0] = lo[0]; r[1] = lo[1]; r[2] = lo[2]; r[3] = lo[3]; r[4] = hi[0]; r[5] = hi[1]; r[6] = hi[2]; r[7] = hi[3]; return r;
}
#define MFMA16(a, b, c) __builtin_amdgcn_mfma_f32_16x16x32_bf16((a), (b), (c), 0, 0, 0)

__device__ __forceinline__ void load_row(const float* xrow, int lane, f32x4 (&v)[8]) {
    const f32x4* xr = (const f32x4*)xrow + lane;
#pragma unroll
    for (int j = 0; j < 8; ++j) v[j] = xr[64 * j];
}
__device__ __forceinline__ float row_rstd(const f32x4 (&v)[8]) {
    float s = 0.f;
#pragma unroll
    for (int j = 0; j < 8; ++j) s += (v[j][0] * v[j][0] + v[j][1] * v[j][1]) + (v[j][2] * v[j][2] + v[j][3] * v[j][3]);
    return 1.0f / sqrtf(wave_sum(s) * (1.0f / DM) + EPS);
}
__device__ __forceinline__ void store_norm_bf16(const f32x4 (&v)[8], float rstd, const float* g, bf16* orow, int lane) {
    const f32x4* gr = (const f32x4*)g + lane; u32x2* o8 = (u32x2*)orow + lane;
#pragma unroll
    for (int j = 0; j < 8; ++j) { const f32x4 gv = gr[64 * j]; u32x2 w; w.x = pk2(v[j][0] * rstd * gv[0], v[j][1] * rstd * gv[1]); w.y = pk2(v[j][2] * rstd * gv[2], v[j][3] * rstd * gv[3]); o8[64 * j] = w; }
}
__device__ __forceinline__ void load_g(const float* g, int lane, f32x4 (&gv)[8]) {
    const f32x4* gr = (const f32x4*)g + lane;
#pragma unroll
    for (int j = 0; j < 8; ++j) gv[j] = gr[64 * j];
}
__device__ __forceinline__ void store_norm_bf16_r(const f32x4 (&v)[8], float rstd, const f32x4 (&gv)[8], bf16* orow, int lane) {
    u32x2* o8 = (u32x2*)orow + lane;
#pragma unroll
    for (int j = 0; j < 8; ++j) { u32x2 w; w.x = pk2(v[j][0] * rstd * gv[j][0], v[j][1] * rstd * gv[j][1]); w.y = pk2(v[j][2] * rstd * gv[j][2], v[j][3] * rstd * gv[j][3]); o8[64 * j] = w; }
}
__device__ __forceinline__ unsigned q8pack(float a, float b, float c, float d) {
    const unsigned ua = __builtin_bit_cast(unsigned, a + 12582912.0f), ub = __builtin_bit_cast(unsigned, b + 12582912.0f), uc = __builtin_bit_cast(unsigned, c + 12582912.0f), ud = __builtin_bit_cast(unsigned, d + 12582912.0f);
    return (ua & 255u) | ((ub & 255u) << 8) | ((uc & 255u) << 16) | (ud << 24);
}

__device__ __forceinline__ void p0_transpose_item(const float* W, int K, int N, bf16* WT, LAS float* scr, int item, int lane) {
    const int nblk = N / 32, kb = item / nblk, nb = item % nblk, k0 = 64 * kb, n0 = 32 * nb;
    float tv[32];
#pragma unroll
    for (int i = 0; i < 32; ++i) { const int kk = 2 * i + (lane >> 5); tv[i] = W[(size_t)(k0 + kk) * N + n0 + (lane & 31)]; }
#pragma unroll
    for (int i = 0; i < 32; ++i) { const int kk = 2 * i + (lane >> 5); scr[kk * 33 + (lane & 31)] = tv[i]; }
    LDS_WAIT(); asm volatile("" ::: "memory");
    const int c = lane & 7;
#pragma unroll
    for (int j = 0; j < 4; ++j) { const int n = (lane >> 3) + 8 * j; const LAS float* s = scr + (8 * c) * 33 + n;
        u32x4 o; o.x = pk2(s[0 * 33], s[1 * 33]); o.y = pk2(s[2 * 33], s[3 * 33]); o.z = pk2(s[4 * 33], s[5 * 33]); o.w = pk2(s[6 * 33], s[7 * 33]);
        *(u32x4*)(WT + (size_t)(n0 + n) * K + k0 + 8 * c) = o; }
    LDS_WAIT(); asm volatile("" ::: "memory");
}
__device__ __forceinline__ void p0_fold_tile(const Params& p, const Ctx& c, int tl) {
    const int l = tl >> 9, hp = (tl >> 5) & 15, j0 = (tl & 31) * 64;
    LAS float* As = (LAS float*)c.lds;
    LAS float* Bs = (LAS float*)c.lds + 64 * 132;
    const float* Wq = p.peer_w_q + (size_t)l * DM * DM; const float* sk = p.peer_sub_keys + ((size_t)l * 2 + (hp & 1)) * PNK * 128;
    __syncthreads();
    for (int i = c.tid; i < 64 * 32; i += 512) { const int jj = i >> 5, d4 = i & 31; *(LAS f32x4*)(As + jj * 132 + d4 * 4) = *(const f32x4*)(Wq + (size_t)(j0 + jj) * DM + hp * 128 + d4 * 4); }
    for (int i = c.tid; i < 128 * 32; i += 512) { const int k = i >> 5, d4 = i & 31; *(LAS f32x4*)(Bs + k * 132 + d4 * 4) = *(const f32x4*)(sk + (size_t)k * 128 + d4 * 4); }
    __syncthreads();
    const int tj = c.tid & 15, tk = c.tid >> 4;
    float acc[4][4];
#pragma unroll
    for (int b = 0; b < 4; ++b)
#pragma unroll
        for (int a = 0; a < 4; ++a) acc[b][a] = 0.f;
    for (int d4 = 0; d4 < 32; ++d4) {
        f32x4 av[4], bv[4];
#pragma unroll
        for (int a = 0; a < 4; ++a) av[a] = *(LAS const f32x4*)(As + (tj + 16 * a) * 132 + d4 * 4);
#pragma unroll
        for (int b = 0; b < 4; ++b) bv[b] = *(LAS const f32x4*)(Bs + (tk * 4 + b) * 132 + d4 * 4);
#pragma unroll
        for (int b = 0; b < 4; ++b)
#pragma unroll
            for (int a = 0; a < 4; ++a) acc[b][a] += (av[a][0] * bv[b][0] + av[a][1] * bv[b][1]) + (av[a][2] * bv[b][2] + av[a][3] * bv[b][3]);
    }
    bf16* WcT = (bf16*)(p.ws + WS_WC) + (size_t)l * DM * DM;
#pragma unroll
    for (int b = 0; b < 4; ++b)
#pragma unroll
        for (int a = 0; a < 4; ++a) WcT[(size_t)(hp * 128 + tk * 4 + b) * DM + j0 + tj + 16 * a] = (bf16)f2bf(acc[b][a]);
}
__device__ __forceinline__ void p0_prologue(const Params& p, const Ctx& c) {
#ifndef PROREP
#define PROREP 0
#endif
    const bool fold_last = (c.bx & 1) != 0;
    if (!fold_last) {
    for (int tl = c.bx; tl < DEPTH * 16 * 32; tl += c.G) p0_fold_tile(p, c, tl);
    __syncthreads();
    }
    for (int rp_ = ((PROREP >> 1) & 1) ? 0 : 1; rp_ < 2; ++rp_)
    {
        LAS float* scr = (LAS float*)(c.lds + c.wave * 16384);
        constexpr int I_IN = (DM / 64) * (RIN / 32), I_OUT = (RVW / 64) * (DM / 32), I_KV = (DM / 64) * (2 * DM / 32), I_SQ = (DM / 64) * (DM / 32);
        constexpr int NITEMS = 2 * I_IN + 2 * I_OUT + I_KV + 4 * I_SQ;
        for (int it = c.gw; it < NITEMS; it += c.ngw) {
            int r = it;
            if (r < 2 * I_IN) { const int l = r / I_IN; p0_transpose_item(p.ret_w_in + (size_t)l * DM * RIN, DM, RIN, (bf16*)(p.ws + WS_WIN) + (size_t)l * RIN * DM, scr, r % I_IN, c.lane); continue; } r -= 2 * I_IN;
            if (r < 2 * I_OUT) { const int l = r / I_OUT; p0_transpose_item(p.ret_w_out + (size_t)l * RVW * DM, RVW, DM, (bf16*)(p.ws + WS_WOUT) + (size_t)l * DM * RVW, scr, r % I_OUT, c.lane); continue; } r -= 2 * I_OUT;
            if (r < I_KV) { p0_transpose_item(p.w_kv, DM, 2 * DM, (bf16*)(p.ws + WS_WKV), scr, r, c.lane); continue; } r -= I_KV;
            if (r < 2 * I_SQ) { const int l = r / I_SQ; p0_transpose_item(p.att_w_q + (size_t)l * DM * DM, DM, DM, (bf16*)(p.ws + WS_WQ) + (size_t)l * DM * DM, scr, r % I_SQ, c.lane); continue; } r -= 2 * I_SQ;
            { const int l = r / I_SQ; p0_transpose_item(p.att_w_o + (size_t)l * DM * DM, DM, DM, (bf16*)(p.ws + WS_WO) + (size_t)l * DM * DM, scr, r % I_SQ, c.lane); }
        }
    }
    for (int rp_ = ((PROREP >> 2) & 1) ? 0 : 1; rp_ < 2; ++rp_)
    {
        float* rs = (float*)(p.ws + WS_RS);
        for (int row = c.gw; row < 2 * DEPTH * PE; row += c.ngw) {
            const int which = row >= DEPTH * PE, r = row - which * DEPTH * PE;
            f32x4 v[8]; load_row((which ? p.peer_v : p.peer_u) + (size_t)r * DM, c.lane, v);
            float am = 0.f;
#pragma unroll
            for (int j = 0; j < 8; ++j) am = fmaxf(fmaxf(am, fmaxf(fabsf(v[j][0]), fabsf(v[j][1]))), fmaxf(fabsf(v[j][2]), fabsf(v[j][3])));
#pragma unroll
            for (int o = 1; o < 64; o <<= 1) am = fmaxf(am, __shfl_xor(am, o));
            int e = (int)((__builtin_bit_cast(unsigned, am) >> 23) & 0xffu) - 127; if (am == 0.f) e = 7;
            int k = 7 - e; k = k < -100 ? -100 : (k > 100 ? 100 : k);
            const float sc = __builtin_bit_cast(float, (unsigned)(k + 127) << 23), rsc = __builtin_bit_cast(float, (unsigned)(127 - k) << 23);
            const int lyr = r / PE, re = r % PE;
            unsigned char* dstb = p.ws + (which ? WS_PV : WS_PU) + (size_t)lyr * PE * DM + (size_t)re * 128;
            if (which) {
#pragma unroll
                for (int j = 0; j < 8; ++j) { int w = 0; w = __builtin_amdgcn_cvt_pk_fp8_f32(v[j][0] * sc, v[j][1] * sc, w, false); w = __builtin_amdgcn_cvt_pk_fp8_f32(v[j][2] * sc, v[j][3] * sc, w, true); { const int col = 4 * c.lane + 256 * j; *(unsigned*)(dstb + (size_t)(col >> 7) * PE * 128 + (col & 127)) = (unsigned)w; } }
                if (c.lane == 0) rs[row] = rsc;
            } else {
                const float s8 = am > 0.f ? 127.0f / am : 0.f;
#pragma unroll
                for (int j = 0; j < 8; ++j) { const unsigned w = q8pack(v[j][0] * s8, v[j][1] * s8, v[j][2] * s8, v[j][3] * s8); const int col = 4 * c.lane + 256 * j; *(unsigned*)(dstb + (size_t)(col >> 7) * PE * 128 + (col & 127)) = w; }
                if (c.lane == 0) rs[row] = am * (1.0f / 127.0f);
            }
        }
    }
    for (int rp_ = ((PROREP >> 3) & 1) ? 0 : 1; rp_ < 2; ++rp_)
    {
        float* rot = (float*)(p.ws + WS_ROT);
        for (int i = c.bx * 512 + c.tid; i < SEQ * 128; i += c.G * 512) { const int pos = i >> 7, d = i & 127;
            const float inv = (float)(1.0 / pow(10000.0, (double)d / 128.0)); const float ang = (float)pos * inv;
            rot[(size_t)pos * 256 + d] = (float)cos((double)ang); rot[(size_t)pos * 256 + 128 + d] = (float)sin((double)ang); }
    }
    for (int rp_ = ((PROREP >> 4) & 1) ? 0 : 1; rp_ < 2; ++rp_)
    { f32x4 gv[8]; load_g(p.ln_mix, c.lane, gv);
      for (int m = c.gw; m < NTOK; m += c.ngw) {
        f32x4 v[8]; load_row(p.x + (size_t)m * DM, c.lane, v);
        f32x4* xo = (f32x4*)(p.out + (size_t)m * DM) + c.lane;
#pragma unroll
        for (int j = 0; j < 8; ++j) xo[64 * j] = v[j];
        store_norm_bf16_r(v, row_rstd(v), gv, (bf16*)(p.ws + WS_H) + (size_t)m * DM, c.lane);
      } }
    if (fold_last) {
    __syncthreads();
    for (int tl = c.bx; tl < DEPTH * 16 * 32; tl += c.G) p0_fold_tile(p, c, tl);
    __syncthreads();
    }
}

constexpr int RS_QS = 0, RS_KS = 33792, RS_VS = 67584, RS_VZ = 76800, RS_PS = 86016, RS_RS = 95232, RS_END = 129024, QK_STR = 528, V_STR = 144;
__device__ __forceinline__ void ret_scan_unit(const Ctx& c, const bf16* Qg, const bf16* Kg, const bf16* Vg, bf16* Og, int unit) {
    const int xg = unit & 7, slot = unit >> 3, pair = xg * 4 + (slot >> 3), es = slot & 7, b = pair >> 3, h = pair & 7;
    const int tid = c.tid, lane = c.lane, w = c.wave, fr = lane & 15, fq = lane >> 4, tq = (lane & 15) >> 2, tp = lane & 3;
    LAS unsigned char* lds = c.lds;
    const float lgam = log1pf(-exp2f(-5.0f - (float)h));
    const float cdec = expf(lgam * 64.0f);
    const int lrow = tid >> 3, lch = tid & 7;
    const size_t tok0 = (size_t)b * SEQ;
    const bf16* qrow = Qg + (tok0 + lrow) * RQKW + h * RQK + lch * 8;
    const bf16* krow = Kg + (tok0 + lrow) * RQKW + h * RQK + lch * 8;
    const bf16* vrow = Vg + (tok0 + lrow) * RVW + h * RV + es * 64 + lch * 8;
    const float zeta = expf(lgam * (float)(63 - lrow));
    u32x4 pq[4], pk[4], pv;
#pragma unroll
    for (int cc = 0; cc < 4; ++cc) { pq[cc] = *(const u32x4*)(qrow + cc * 64); pk[cc] = *(const u32x4*)(krow + cc * 64); }
    pv = *(const u32x4*)vrow;
    __syncthreads();
    for (int i = tid; i < (RS_END - RS_RS) / 16; i += 512) *(LAS u32x4*)(lds + RS_RS + i * 16) = (u32x4){0u, 0u, 0u, 0u};
    f32x4 Racc[2][4];
#pragma unroll
    for (int x = 0; x < 2; ++x)
#pragma unroll
        for (int y = 0; y < 4; ++y) Racc[x][y] = (f32x4){0.f, 0.f, 0.f, 0.f};
    const int jt = w & 3, it0 = 2 * (w >> 2);
    const int it = w & 3, et0 = 2 * (w >> 2);
    float xi[4];
#pragma unroll
    for (int r = 0; r < 4; ++r) xi[r] = expf(lgam * (float)(16 * it + 4 * fq + r + 1));
    const unsigned ldsb = (unsigned)(size_t)lds;
    float dmask[2][4];
#pragma unroll
    for (int x = 0; x < 2; ++x)
#pragma unroll
        for (int r = 0; r < 4; ++r) { const int i = 16 * (it0 + x) + fr, j = 16 * jt + 4 * fq + r; dmask[x][r] = (i >= j) ? expf(lgam * (float)(i - j)) : 0.f; }
    asm volatile("" : "+v"(dmask[0][0]), "+v"(dmask[0][1]), "+v"(dmask[0][2]), "+v"(dmask[0][3]), "+v"(dmask[1][0]), "+v"(dmask[1][1]), "+v"(dmask[1][2]), "+v"(dmask[1][3]));
    for (int n = 0; n < NCHUNK; ++n) {
        __syncthreads();
#pragma unroll
        for (int cc = 0; cc < 4; ++cc) { *(LAS u32x4*)(lds + RS_QS + lrow * QK_STR + (lch + 8 * cc) * 16) = pq[cc]; *(LAS u32x4*)(lds + RS_KS + lrow * QK_STR + (lch + 8 * cc) * 16) = pk[cc]; }
        *(LAS u32x4*)(lds + RS_VS + lrow * V_STR + lch * 16) = pv;
        { u32x4 z; z.x = pk2(bflo(pv.x) * zeta, bfhi(pv.x) * zeta); z.y = pk2(bflo(pv.y) * zeta, bfhi(pv.y) * zeta); z.z = pk2(bflo(pv.z) * zeta, bfhi(pv.z) * zeta); z.w = pk2(bflo(pv.w) * zeta, bfhi(pv.w) * zeta);
          *(LAS u32x4*)(lds + RS_VZ + lrow * V_STR + lch * 16) = z; }
        __syncthreads();
        if (n + 1 < NCHUNK) {
            const size_t adv = (size_t)(n + 1) * CHUNK;
#pragma unroll
            for (int cc = 0; cc < 4; ++cc) { pq[cc] = *(const u32x4*)(qrow + adv * RQKW + cc * 64); pk[cc] = *(const u32x4*)(krow + adv * RQKW + cc * 64); }
            pv = *(const u32x4*)(vrow + adv * RVW);
        }
        {
            f32x4 s0 = (f32x4){0.f, 0.f, 0.f, 0.f}, s1 = s0;
#pragma unroll
            for (int kh = 0; kh < 2; ++kh) {
                bf16x8 fa[4], fb0[4], fb1[4];
#pragma unroll
                for (int k4 = 0; k4 < 4; ++k4) { const int ks = 4 * kh + k4;
                    fa[k4] = lds128(lds + RS_KS + (16 * jt + fr) * QK_STR + (4 * ks + fq) * 16);
                    fb0[k4] = lds128(lds + RS_QS + (16 * it0 + fr) * QK_STR + (4 * ks + fq) * 16);
                    fb1[k4] = lds128(lds + RS_QS + (16 * (it0 + 1) + fr) * QK_STR + (4 * ks + fq) * 16); }
                __builtin_amdgcn_sched_barrier(0);
#pragma unroll
                for (int k4 = 0; k4 < 4; ++k4) { s0 = MFMA16(fa[k4], fb0[k4], s0); s1 = MFMA16(fa[k4], fb1[k4], s1); }
            }
#pragma unroll
            for (int x = 0; x < 2; ++x) { const f32x4 s = x ? s1 : s0; const int i = 16 * (it0 + x) + fr; float pr[4];
#pragma unroll
                for (int r = 0; r < 4; ++r) pr[r] = s[r] * dmask[x][r];
                u32x2 pw; pw.x = pk2(pr[0], pr[1]); pw.y = pk2(pr[2], pr[3]);
                *(LAS u32x2*)(lds + RS_PS + i * V_STR + (16 * jt + 4 * fq) * 2) = pw; }
        }
        f32x4 o0 = (f32x4){0.f, 0.f, 0.f, 0.f}, o1 = o0;
        {
#pragma unroll
            for (int kh = 0; kh < 2; ++kh) {
                bf16x8 fa[4], fb0[4], fb1[4];
#pragma unroll
                for (int k4 = 0; k4 < 4; ++k4) { const int ks = 4 * kh + k4;
                    fa[k4] = lds128(lds + RS_QS + (16 * it + fr) * QK_STR + (4 * ks + fq) * 16);
                    fb0[k4] = lds128(lds + RS_RS + (16 * et0 + fr) * QK_STR + (4 * ks + fq) * 16);
                    fb1[k4] = lds128(lds + RS_RS + (16 * (et0 + 1) + fr) * QK_STR + (4 * ks + fq) * 16); }
                __builtin_amdgcn_sched_barrier(0);
#pragma unroll
                for (int k4 = 0; k4 < 4; ++k4) { o0 = MFMA16(fa[k4], fb0[k4], o0); o1 = MFMA16(fa[k4], fb1[k4], o1); }
            }
        }
#pragma unroll
        for (int r = 0; r < 4; ++r) { o0[r] *= xi[r]; o1[r] *= xi[r]; }
        __syncthreads();
#pragma unroll
        for (int ks = 0; ks < 2; ++ks) {
            const bf16x8 a = lds128(lds + RS_PS + (16 * it + fr) * V_STR + (4 * ks + fq) * 16);
            const unsigned va = ldsb + RS_VS + (32 * ks + 8 * fq + tq) * V_STR + 8 * tp;
            const bf16x8 b0 = tr_frag(va + 32 * et0, va + 4 * V_STR + 32 * et0);
            const bf16x8 b1 = tr_frag(va + 32 * (et0 + 1), va + 4 * V_STR + 32 * (et0 + 1));
            __builtin_amdgcn_sched_barrier(0);
            o0 = MFMA16(a, b0, o0); o1 = MFMA16(a, b1, o1);
        }
        {
            bf16* op = Og + (tok0 + (size_t)n * CHUNK + 16 * it + 4 * fq) * RVW + h * RV + es * 64 + 16 * et0 + fr;
#pragma unroll
            for (int r = 0; r < 4; ++r) { op[(size_t)r * RVW] = (bf16)f2bf(o0[r]); op[(size_t)r * RVW + 16] = (bf16)f2bf(o1[r]); }
        }
#pragma unroll
        for (int x = 0; x < 2; ++x)
#pragma unroll
            for (int y = 0; y < 4; ++y) Racc[x][y] *= cdec;
#pragma unroll
        for (int ks = 0; ks < 2; ++ks) {
            const unsigned ka = ldsb + RS_KS + (32 * ks + 8 * fq + tq) * QK_STR + 8 * tp;
            const unsigned za = ldsb + RS_VZ + (32 * ks + 8 * fq + tq) * V_STR + 8 * tp;
            bf16x8 ak[2], bz[4];
#pragma unroll
            for (int x = 0; x < 2; ++x) ak[x] = tr_frag(ka + 32 * (2 * w + x), ka + 4 * QK_STR + 32 * (2 * w + x));
#pragma unroll
            for (int y = 0; y < 4; ++y) bz[y] = tr_frag(za + 32 * y, za + 4 * V_STR + 32 * y);
            __builtin_amdgcn_sched_barrier(0);
#pragma unroll
            for (int x = 0; x < 2; ++x)
#pragma unroll
                for (int y = 0; y < 4; ++y) Racc[x][y] = MFMA16(ak[x], bz[y], Racc[x][y]);
        }
#pragma unroll
        for (int x = 0; x < 2; ++x)
#pragma unroll
            for (int y = 0; y < 4; ++y) { u32x2 rw; rw.x = pk2(Racc[x][y][0], Racc[x][y][1]); rw.y = pk2(Racc[x][y][2], Racc[x][y][3]);
                *(LAS u32x2*)(lds + RS_RS + (16 * y + fr) * QK_STR + (16 * (2 * w + x) + 4 * fq) * 2) = rw; }
    }
}

__device__ __forceinline__ unsigned lq_issue(LAS unsigned* cnt, int lane) { unsigned v = 0u; if (lane == 0) v = __hip_atomic_fetch_add(cnt, 1u, __ATOMIC_RELAXED, __HIP_MEMORY_SCOPE_WORKGROUP); return v; }
__device__ __forceinline__ unsigned lq_take(unsigned v) { return (unsigned)__builtin_amdgcn_readfirstlane((int)v); }
template <int CTRL> __device__ __forceinline__ float dpp_f(float x) { return __builtin_bit_cast(float, __builtin_amdgcn_mov_dpp(__builtin_bit_cast(int, x), CTRL, 0xF, 0xF, true)); }
__device__ __forceinline__ float sum8(float x) { x += dpp_f<0xB1>(x); x += dpp_f<0x4E>(x); x += dpp_f<0x141>(x); return x; }
__device__ __forceinline__ void ret_gate_phase(const Ctx& c, const bf16* Og, bf16* Gg, const float* gn, bf16* Zout = nullptr) {
    const int col0 = 512 * (c.lane >> 3) + 8 * (c.lane & 7);
    f32x4 gw[16];
#pragma unroll
    for (int j = 0; j < 8; ++j) { gw[2 * j] = *(const f32x4*)(gn + col0 + 64 * j); gw[2 * j + 1] = *(const f32x4*)(gn + col0 + 64 * j + 4); }
    LAS unsigned* LQ = (LAS unsigned*)(c.lds + LDS_MISC) + 11;
    __syncthreads(); if (c.tid == 0) LQ[0] = 0u; __syncthreads();
#define GQ_ROW(i) (8 * c.bx + (int)((i) & 7u) + 2048 * (int)((i) >> 3))
    unsigned cur = lq_take(lq_issue(LQ, c.lane)), nxt = lq_take(lq_issue(LQ, c.lane));
    u32x4 ovn[8];
    { const bf16* orow = Og + (size_t)(cur < 64u ? GQ_ROW(cur) : 8 * c.bx) * RVW + col0;
#pragma unroll
        for (int j = 0; j < 8; ++j) ovn[j] = *(const u32x4*)(orow + 64 * j); }
    while (cur < 64u) {
        const unsigned vnn = lq_issue(LQ, c.lane);
        const int m = GQ_ROW(cur);
        u32x4 gv[8], ov[8];
        { const bf16* grow = Gg + (size_t)m * RVW + col0;
#pragma unroll
          for (int j = 0; j < 8; ++j) { gv[j] = *(const u32x4*)(grow + 64 * j); ov[j] = ovn[j]; } }
        { const int mn = nxt < 64u ? GQ_ROW(nxt) : m; const bf16* orow = Og + (size_t)mn * RVW + col0;
#pragma unroll
          for (int j = 0; j < 8; ++j) ovn[j] = *(const u32x4*)(orow + 64 * j); }
        float s1 = 0.f;
#pragma unroll
        for (int j = 0; j < 8; ++j) { const u32x4 t = ov[j];
            s1 += ((bflo(t.x) + bfhi(t.x)) + (bflo(t.y) + bfhi(t.y))) + ((bflo(t.z) + bfhi(t.z)) + (bflo(t.w) + bfhi(t.w))); }
        const float mu = sum8(s1) * (1.0f / RV);
        asm volatile("" : "+v"(ov[0]), "+v"(ov[1]), "+v"(ov[2]), "+v"(ov[3]), "+v"(ov[4]), "+v"(ov[5]), "+v"(ov[6]), "+v"(ov[7]));
        float s2 = 0.f;
#pragma unroll
        for (int j = 0; j < 8; ++j) { const u32x4 t = ov[j];
            const float d[8] = {bflo(t.x) - mu, bfhi(t.x) - mu, bflo(t.y) - mu, bfhi(t.y) - mu, bflo(t.z) - mu, bfhi(t.z) - mu, bflo(t.w) - mu, bfhi(t.w) - mu};
            float q = 0.f;
#pragma unroll
            for (int k = 0; k < 8; ++k) q += d[k] * d[k];
            s2 += q; }
        const float rstd = 1.0f / sqrtf(sum8(s2) * (1.0f / RV) + EPS);
        asm volatile("" : "+v"(ov[0]), "+v"(ov[1]), "+v"(ov[2]), "+v"(ov[3]), "+v"(ov[4]), "+v"(ov[5]), "+v"(ov[6]), "+v"(ov[7]));
        bf16* zrow = (Zout ? Zout : Gg) + (size_t)m * RVW + col0;
#pragma unroll
        for (int j = 0; j < 8; ++j) {
            const float gg[8] = {gw[2 * j][0], gw[2 * j][1], gw[2 * j][2], gw[2 * j][3], gw[2 * j + 1][0], gw[2 * j + 1][1], gw[2 * j + 1][2], gw[2 * j + 1][3]};
            const u32x4 t = gv[j], u = ov[j];
            const float g[8] = {bflo(t.x), bfhi(t.x), bflo(t.y), bfhi(t.y), bflo(t.z), bfhi(t.z), bflo(t.w), bfhi(t.w)};
            const float o[8] = {bflo(u.x), bfhi(u.x), bflo(u.y), bfhi(u.y), bflo(u.z), bfhi(u.z), bflo(u.w), bfhi(u.w)};
            float z[8];
#pragma unroll
            for (int k = 0; k < 8; ++k) { const float y = (o[k] - mu) * rstd * gg[k]; z[k] = g[k] * __builtin_amdgcn_rcpf(1.0f + __builtin_amdgcn_exp2f(-1.4426950408889634f * g[k])) * y; }
            u32x4 zw; zw.x = pk2(z[0], z[1]); zw.y = pk2(z[2], z[3]); zw.z = pk2(z[4], z[5]); zw.w = pk2(z[6], z[7]);
            *(u32x4*)(zrow + 64 * j) = zw;
        }
        cur = nxt; nxt = lq_take(vnn);
    }
#undef GQ_ROW
}

__device__ __forceinline__ void rms_phase(const Ctx& c, const float* X, const float* g, bf16* H) {
    for (int m = c.gw; m < NTOK; m += c.ngw) { f32x4 v[8]; load_row(X + (size_t)m * DM, c.lane, v); store_norm_bf16(v, row_rstd(v), g, H + (size_t)m * DM, c.lane); }
}

__device__ __forceinline__ int fkey(float f) { const int i = __builtin_bit_cast(int, f); return i ^ ((i >> 31) & 0x7fffffff); }
__device__ __forceinline__ float kval(int k) { return __builtin_bit_cast(float, k ^ ((k >> 31) & 0x7fffffff)); }
__device__ __forceinline__ int med3i(int a, int b, int c) { int r; asm("v_med3_i32 %0, %1, %2, %3" : "=v"(r) : "v"(a), "v"(b), "v"(c)); return r; }
#define INS16(L, key) do { const int _k = (key); _Pragma("unroll") for (int _q = 15; _q >= 1; --_q) L[_q] = med3i(L[_q - 1], L[_q], _k); L[0] = max(L[0], _k); } while (0)
constexpr int TK_LIST = 544, TK_HALF = 272, TK_KEYS = 256 * TK_LIST;
__device__ __forceinline__ void peer_topk_phase(const Ctx& c, const float* SC, int* IDX, float* WGT, const float* SQP, float* RSTD) {
    LAS unsigned char* lds = c.lds;
    u32x4 pre[16];
    if (c.bx < NTOK / 16) { const u32x4* src = (const u32x4*)(SC + (size_t)c.bx * 16 * DM);
#pragma unroll
        for (int i = 0; i < 16; ++i) pre[i] = src[c.tid + 512 * i]; }
    for (int tile = c.bx; tile < NTOK / 16; tile += c.G) {
        __syncthreads();
#pragma unroll
        for (int i = 0; i < 16; ++i) { const int g = c.tid + 512 * i; *(LAS u32x4*)(lds + (g >> 5) * TK_LIST + ((g >> 4) & 1) * TK_HALF + (g & 15) * 16) = pre[i]; }
        if (tile + c.G < NTOK / 16) { const u32x4* src = (const u32x4*)(SC + (size_t)(tile + c.G) * 16 * DM);
#pragma unroll
            for (int i = 0; i < 16; ++i) pre[i] = src[c.tid + 512 * i]; }
        __syncthreads();
        {
            const int lst = c.tid >> 1, hf = c.tid & 1;
            int L[16];
#pragma unroll
            for (int q = 0; q < 16; ++q) L[q] = (int)0x80000000;
            LAS unsigned char* lp = lds + lst * TK_LIST + hf * TK_HALF;
#pragma unroll 2
            for (int g = 0; g < 16; ++g) { const f32x4 v = *(LAS const f32x4*)(lp + g * 16);
#pragma unroll
                for (int e = 0; e < 4; ++e) INS16(L, (fkey(v[e]) & ~127) | (hf * 64 + g * 4 + e)); }
            if (hf) {
#pragma unroll
                for (int q = 0; q < 16; ++q) ((LAS int*)lp)[q] = L[q]; }
            __syncthreads();
            if (!hf) { LAS const int* op = (LAS const int*)(lp + TK_HALF);
#pragma unroll
                for (int q = 0; q < 16; ++q) INS16(L, op[q]);
                LAS int* kp = (LAS int*)(lds + TK_KEYS) + lst * 16;
#pragma unroll
                for (int q = 0; q < 16; ++q) kp[q] = L[q]; }
        }
        __syncthreads();
        if (c.tid < 128) {
            LAS const int* k1 = (LAS const int*)(lds + TK_KEYS) + (c.tid * 2) * 16; LAS const int* k2 = k1 + 16;
            float v1[16], v2[16];
#pragma unroll
            for (int q = 0; q < 16; ++q) { v1[q] = kval(k1[q] & ~127); v2[q] = kval(k2[q] & ~127); }
            int L[16];
#pragma unroll
            for (int q = 0; q < 16; ++q) L[q] = (fkey(v1[0] + v2[q]) & ~255) | q;
#pragma unroll
            for (int i = 1; i < 16; ++i)
#pragma unroll
                for (int j = 0; j < 16; ++j) if ((i + 1) * (j + 1) <= 16) INS16(L, (fkey(v1[i] + v2[j]) & ~255) | (i * 16 + j));
            const int tt = c.tid >> 3, hh = c.tid & 7; const size_t ob0 = ((size_t)tile * 16 + tt) * 128;
            float rstd; { const f32x4* sp = (const f32x4*)(SQP + ((size_t)tile * 16 + tt) * 32); f32x4 a4 = sp[0];
#pragma unroll
              for (int q = 1; q < 8; ++q) a4 += sp[q];
              rstd = 1.0f / sqrtf(((a4[0] + a4[1]) + (a4[2] + a4[3])) * (1.0f / DM) + EPS); }
            if (hh == 0) RSTD[(size_t)tile * 16 + tt] = rstd;
            const float m0 = kval(L[0] & ~255); float ex[16], se = 0.f;
#pragma unroll
            for (int q = 0; q < 16; ++q) { ex[q] = __builtin_amdgcn_exp2f((kval(L[q] & ~255) - m0) * (rstd * 1.4426950408889634f)); se += ex[q]; }
            const float inv = 1.0f / se;
#pragma unroll
            for (int q = 0; q < 16; ++q) { const int cid = L[q] & 255; const int es = hh * 16 + q, pos = (es & 7) * 16 + (es >> 3);
                IDX[ob0 + pos] = (k1[cid >> 4] & 127) * PNK + (k2[cid & 15] & 127); WGT[ob0 + pos] = ex[q] * inv; }
        }
    }
}

template <int NSTAGE> __device__ __forceinline__ void xreduce_stage(float (&p)[64], int lane) {
    constexpr int S = NSTAGE;
    if constexpr (S == 32) {
#pragma unroll
        for (int k = 0; k < S; ++k) { float xa = p[k], xb = p[k + S]; asm("s_nop 1\n\tv_permlane32_swap_b32 %0, %1" : "+v"(xa), "+v"(xb)); p[k] = xa + xb; }
    } else if constexpr (S == 16) {
#pragma unroll
        for (int k = 0; k < S; ++k) { float xa = p[k], xb = p[k + S]; asm("s_nop 1\n\tv_permlane16_swap_b32 %0, %1" : "+v"(xa), "+v"(xb)); p[k] = xa + xb; }
    } else {
        const bool up = (lane & S) != 0;
#pragma unroll
        for (int k = 0; k < S; ++k) { const float keep = up ? p[k + S] : p[k], send = up ? p[k] : p[k + S];
            p[k] = keep + __builtin_bit_cast(float, __builtin_amdgcn_ds_swizzle(__builtin_bit_cast(int, send), (S << 10) | 0x1F)); }
    }
}
__device__ __forceinline__ float gelu_erf(float v) { return 0.5f * v * (1.0f + erff(v * 0.70710678118654752f)); }
typedef float f32x2 __attribute__((ext_vector_type(2)));
__device__ __forceinline__ float peer_dots64(const unsigned char* U, int idxv, const f32x2 (&h2)[16], int lane) {
    float p[64];
#pragma unroll
    for (int e = 0; e < 64; ++e) {
        const int row = __builtin_amdgcn_readlane(idxv, e);
        const u32x4* up = (const u32x4*)(U + (size_t)row * DM) + lane;
        f32x2 a = {0.f, 0.f};
#pragma unroll
        for (int cc = 0; cc < 2; ++cc) { const u32x4 u = up[64 * cc];
#pragma unroll
            for (int q = 0; q < 4; ++q) { const int w = (int)u[q];
                a = __builtin_elementwise_fma(__builtin_amdgcn_cvt_pk_f32_fp8(w, false), h2[8 * cc + 2 * q], a);
                a = __builtin_elementwise_fma(__builtin_amdgcn_cvt_pk_f32_fp8(w, true), h2[8 * cc + 2 * q + 1], a); } }
        p[e] = a.x + a.y;
    }
    xreduce_stage<32>(p, lane); xreduce_stage<16>(p, lane); xreduce_stage<8>(p, lane); xreduce_stage<4>(p, lane); xreduce_stage<2>(p, lane); xreduce_stage<1>(p, lane);
    return p[0];
}
__device__ __forceinline__ void peer_accum64(const unsigned char* Vt, int idxv, float av, f32x2 (&acc)[16], int lane) {
#pragma unroll 8
    for (int e = 0; e < 64; ++e) {
        const int row = __builtin_amdgcn_readlane(idxv, e); const float a = __builtin_bit_cast(float, __builtin_amdgcn_readlane(__builtin_bit_cast(int, av), e));
        const f32x2 a2 = {a, a};
        const u32x4* vp = (const u32x4*)(Vt + (size_t)row * DM) + lane;
#pragma unroll
        for (int cc = 0; cc < 2; ++cc) { const u32x4 v = vp[64 * cc];
#pragma unroll
            for (int q = 0; q < 4; ++q) { const int w = (int)v[q];
                acc[8 * cc + 2 * q] = __builtin_elementwise_fma(__builtin_amdgcn_cvt_pk_f32_fp8(w, false), a2, acc[8 * cc + 2 * q]);
                acc[8 * cc + 2 * q + 1] = __builtin_elementwise_fma(__builtin_amdgcn_cvt_pk_f32_fp8(w, true), a2, acc[8 * cc + 2 * q + 1]); } }
    }
}
constexpr int GD = 8;
#define PG_ISSUE(vv) do { const int row_ = __builtin_amdgcn_readlane((((vv) >> 6) & 1) ? i1 : i0, (vv) & 63); \
        const u32x4* bp_ = (const u32x4*)((((vv) >> 6) < 2 ? U : Vt) + (size_t)row_ * DM) + lane; ring[(vv) % GD][0] = bp_[0]; ring[(vv) % GD][1] = bp_[64]; } while (0)
template <int SEG> __device__ __forceinline__ void peer_seg(const unsigned char* U, const unsigned char* Vt, int i0, int i1, u32x4 (&ring)[GD][2], float (&p)[64], float aseg, const f32x2 (&h2)[16], f32x2 (&acc)[16], int lane) {
#pragma unroll
    for (int e = 0; e < 64; ++e) {
        const int v = SEG * 64 + e;
        const u32x4 r0 = ring[v % GD][0], r1 = ring[v % GD][1];
        if (SEG < 2) {
            f32x2 a = {0.f, 0.f};
#pragma unroll
            for (int q = 0; q < 4; ++q) { const int wa = (int)r0[q], wb = (int)r1[q];
                a = __builtin_elementwise_fma(__builtin_amdgcn_cvt_pk_f32_fp8(wa, false), h2[2 * q], a); a = __builtin_elementwise_fma(__builtin_amdgcn_cvt_pk_f32_fp8(wa, true), h2[2 * q + 1], a);
                a = __builtin_elementwise_fma(__builtin_amdgcn_cvt_pk_f32_fp8(wb, false), h2[8 + 2 * q], a); a = __builtin_elementwise_fma(__builtin_amdgcn_cvt_pk_f32_fp8(wb, true), h2[8 + 2 * q + 1], a); }
            { float hs_; asm("v_add_f32 %0, %1, %2" : "=v"(hs_) : "v"(a.x), "v"(a.y)); p[e] = hs_; }
        } else {
            const float av = __builtin_bit_cast(float, __builtin_amdgcn_readlane(__builtin_bit_cast(int, aseg), e)); const f32x2 a2 = {av, av};
#pragma unroll
            for (int q = 0; q < 4; ++q) { const int wa = (int)r0[q], wb = (int)r1[q];
                acc[2 * q] = __builtin_elementwise_fma(__builtin_amdgcn_cvt_pk_f32_fp8(wa, false), a2, acc[2 * q]); acc[2 * q + 1] = __builtin_elementwise_fma(__builtin_amdgcn_cvt_pk_f32_fp8(wa, true), a2, acc[2 * q + 1]);
                acc[8 + 2 * q] = __builtin_elementwise_fma(__builtin_amdgcn_cvt_pk_f32_fp8(wb, false), a2, acc[8 + 2 * q]); acc[8 + 2 * q + 1] = __builtin_elementwise_fma(__builtin_amdgcn_cvt_pk_f32_fp8(wb, true), a2, acc[8 + 2 * q + 1]); }
            asm volatile("" : "+v"(acc[0]), "+v"(acc[1]), "+v"(acc[2]), "+v"(acc[3]), "+v"(acc[4]), "+v"(acc[5]), "+v"(acc[6]), "+v"(acc[7]), "+v"(acc[8]), "+v"(acc[9]), "+v"(acc[10]), "+v"(acc[11]), "+v"(acc[12]), "+v"(acc[13]), "+v"(acc[14]), "+v"(acc[15]));
        }
        if (v + GD < 256) PG_ISSUE(v + GD);
        __builtin_amdgcn_sched_barrier(0);
    }
}
__device__ __forceinline__ void peer_token_pipe(const unsigned char* U, const unsigned char* Vt, int i0, int i1, float su0, float su1, float w0, float w1, const f32x2 (&h2)[16], f32x2 (&acc)[16], int lane) {
    u32x4 ring[GD][2];
    float p[64];
#pragma unroll
    for (int v = 0; v < GD; ++v) PG_ISSUE(v);
    peer_seg<0>(U, Vt, i0, i1, ring, p, 0.f, h2, acc, lane);
    xreduce_stage<32>(p, lane); xreduce_stage<16>(p, lane); xreduce_stage<8>(p, lane); xreduce_stage<4>(p, lane); xreduce_stage<2>(p, lane); xreduce_stage<1>(p, lane);
    const float a0 = gelu_erf(p[0] * su0) * w0;
    __builtin_amdgcn_sched_barrier(0);
    peer_seg<1>(U, Vt, i0, i1, ring, p, 0.f, h2, acc, lane);
    xreduce_stage<32>(p, lane); xreduce_stage<16>(p, lane); xreduce_stage<8>(p, lane); xreduce_stage<4>(p, lane); xreduce_stage<2>(p, lane); xreduce_stage<1>(p, lane);
    const float a1 = gelu_erf(p[0] * su1) * w1;
    __builtin_amdgcn_sched_barrier(0);
    peer_seg<2>(U, Vt, i0, i1, ring, p, a0, h2, acc, lane);
    peer_seg<3>(U, Vt, i0, i1, ring, p, a1, h2, acc, lane);
}
#undef PG_ISSUE
__device__ __forceinline__ void peer_gather_phase(const Ctx& c, const bf16* Hn, const unsigned char* U, const unsigned char* Vt, const float* rsU, const float* rsV, const int* IDX, const float* WGT, const float* Xr, float* X, int mode,
                                                  const float* g1, const float* g2, bf16* Hout, bf16* HKVout) {
    for (int m = c.gw; m < NTOK; m += c.ngw) {
        int lane_ = c.lane; asm volatile("" : "+v"(lane_));
#ifdef DRYIDXMASK
        const int imask_ = (X != Xr) ? DRYIDXMASK : 0xffff;
        const int i0 = IDX[(size_t)m * 128 + lane_] & imask_, i1 = IDX[(size_t)m * 128 + 64 + lane_] & imask_;
#else
        const int i0 = IDX[(size_t)m * 128 + lane_], i1 = IDX[(size_t)m * 128 + 64 + lane_];
#endif
        const float w0 = WGT[(size_t)m * 128 + lane_] * rsV[i0], w1 = WGT[(size_t)m * 128 + 64 + lane_] * rsV[i1];
        const float su0 = rsU[i0], su1 = rsU[i1];
        f32x2 h2[16];
#pragma unroll
        for (int cc = 0; cc < 2; ++cc) { const u32x4* hp = (const u32x4*)(Hn + (size_t)m * DM + 1024 * cc + 16 * lane_); const u32x4 ha = hp[0], hb = hp[1];
#pragma unroll
            for (int q = 0; q < 4; ++q) { h2[8 * cc + q] = (f32x2){bflo(ha[q]), bfhi(ha[q])}; h2[8 * cc + 4 + q] = (f32x2){bflo(hb[q]), bfhi(hb[q])}; } }
        f32x2 acc[16];
#pragma unroll
        for (int k = 0; k < 16; ++k) acc[k] = (f32x2){0.f, 0.f};
        peer_token_pipe(U, Vt, i0, i1, su0, su1, w0, w1, h2, acc, lane_);
        float* xr = X + (size_t)m * DM; const float* xrr = Xr + (size_t)m * DM; float ss = 0.f;
#pragma unroll
        for (int cc = 0; cc < 2; ++cc) {
            f32x4* xp = (f32x4*)(xr + 1024 * cc + 16 * lane_); const f32x4* xq = (const f32x4*)(xrr + 1024 * cc + 16 * lane_);
#pragma unroll
            for (int q = 0; q < 4; ++q) { f32x4 xa = xq[q]; xa[0] += acc[8 * cc + 2 * q].x; xa[1] += acc[8 * cc + 2 * q].y; xa[2] += acc[8 * cc + 2 * q + 1].x; xa[3] += acc[8 * cc + 2 * q + 1].y;
                acc[8 * cc + 2 * q] = (f32x2){xa[0], xa[1]}; acc[8 * cc + 2 * q + 1] = (f32x2){xa[2], xa[3]}; ss += (xa[0] * xa[0] + xa[1] * xa[1]) + (xa[2] * xa[2] + xa[3] * xa[3]);
                if (mode != 2) xp[q] = xa; }
        }
        const float rstd = 1.0f / sqrtf(wave_sum(ss) * (1.0f / DM) + EPS);
#pragma unroll
        for (int cc = 0; cc < 2; ++cc) {
            const f32x4* gp = (const f32x4*)(g1 + 1024 * cc + 16 * lane_);
            if (mode == 2) {
                f32x4* xp = (f32x4*)(xr + 1024 * cc + 16 * lane_);
#pragma unroll
                for (int q = 0; q < 4; ++q) { const f32x4 gv = gp[q]; f32x4 y; y[0] = acc[8 * cc + 2 * q].x * rstd * gv[0]; y[1] = acc[8 * cc + 2 * q].y * rstd * gv[1]; y[2] = acc[8 * cc + 2 * q + 1].x * rstd * gv[2]; y[3] = acc[8 * cc + 2 * q + 1].y * rstd * gv[3]; xp[q] = y; }
            } else {
                u32x4 hw[2];
#pragma unroll
                for (int q = 0; q < 4; ++q) { const f32x4 gv = gp[q]; hw[q >> 1][2 * (q & 1)] = pk2(acc[8 * cc + 2 * q].x * rstd * gv[0], acc[8 * cc + 2 * q].y * rstd * gv[1]); hw[q >> 1][2 * (q & 1) + 1] = pk2(acc[8 * cc + 2 * q + 1].x * rstd * gv[2], acc[8 * cc + 2 * q + 1].y * rstd * gv[3]); }
                u32x4* ho = (u32x4*)(Hout + (size_t)m * DM + 1024 * cc + 16 * lane_); ho[0] = hw[0]; ho[1] = hw[1];
                if (mode == 1) {
                    const f32x4* kp = (const f32x4*)(g2 + 1024 * cc + 16 * lane_); u32x4 kw[2];
#pragma unroll
                    for (int q = 0; q < 4; ++q) { const f32x4 gv = kp[q]; kw[q >> 1][2 * (q & 1)] = pk2(acc[8 * cc + 2 * q].x * rstd * gv[0], acc[8 * cc + 2 * q].y * rstd * gv[1]); kw[q >> 1][2 * (q & 1) + 1] = pk2(acc[8 * cc + 2 * q + 1].x * rstd * gv[2], acc[8 * cc + 2 * q + 1].y * rstd * gv[3]); }
                    u32x4* ko = (u32x4*)(HKVout + (size_t)m * DM + 1024 * cc + 16 * lane_); ko[0] = kw[0]; ko[1] = kw[1];
                }
            }
        }
    }
}

template <int PAT> __device__ __forceinline__ float swz_xor(float v) { return __builtin_bit_cast(float, __builtin_amdgcn_ds_swizzle(__builtin_bit_cast(int, v), PAT)); }
template <int PAT> __device__ __forceinline__ int swz_xor_i(int v) { return __builtin_amdgcn_ds_swizzle(v, PAT); }
template <int C> __device__ __forceinline__ unsigned bc8(unsigned v) { return (unsigned)__builtin_amdgcn_ds_swizzle((int)v, (C << 5) | 0x18); }
__device__ __forceinline__ void bcast16(unsigned x0, unsigned x1, unsigned (&o)[16]) {
    o[0] = bc8<0>(x0); o[1] = bc8<0>(x1); o[2] = bc8<1>(x0); o[3] = bc8<1>(x1); o[4] = bc8<2>(x0); o[5] = bc8<2>(x1); o[6] = bc8<3>(x0); o[7] = bc8<3>(x1);
    o[8] = bc8<4>(x0); o[9] = bc8<4>(x1); o[10] = bc8<5>(x0); o[11] = bc8<5>(x1); o[12] = bc8<6>(x0); o[13] = bc8<6>(x1); o[14] = bc8<7>(x0); o[15] = bc8<7>(x1);
}
__device__ __forceinline__ void peer_u_phase(const Ctx& c, const bf16* Hn, const unsigned char* U, const int* IDXT, float* PD, unsigned imask = 0xffffffffu) {
    const int xg = c.bx & 7, tb = (c.bx >> 3) * 8, g = c.lane >> 3, sub = c.lane & 7;
    LAS unsigned* LQ = (LAS unsigned*)(c.lds + LDS_MISC) + 8;
#define LQ_TOK(i) (tb + (int)((i) & 7u) + 256 * (int)((i) >> 3))
    for (int pass = 0; pass < 2; ++pass) {
        __syncthreads(); if (c.tid == 0) LQ[pass] = 0u; __syncthreads();
        unsigned cur = lq_take(lq_issue(LQ + pass, c.lane)), nxt = lq_take(lq_issue(LQ + pass, c.lane));
        const int s = xg + 8 * pass, col0 = 128 * s + 16 * sub;
        const unsigned char* Us = U + (size_t)s * PE * 128 + 16 * sub;
        u32x4 wv[8];
        { const u32x4* wp = (const u32x4*)(U + (size_t)s * PE * 128 + (size_t)(c.bx >> 3) * 65536) + c.tid;
#pragma unroll
          for (int q = 0; q < 8; ++q) wv[q] = wp[q * 512]; }
        u32x2 ii; unsigned hw;
        { const int t0 = cur < 512u ? LQ_TOK(cur) : tb;
          ii = *(const u32x2*)(IDXT + (size_t)t0 * 128 + g * 16 + 2 * sub);
          hw = *((const unsigned*)(Hn + (size_t)t0 * DM + 128 * s) + c.lane); }
        bool first = true;
        while (cur < 512u) {
            const unsigned vnn = lq_issue(LQ + pass, c.lane);
            const int t = LQ_TOK(cur), tn = nxt < 512u ? LQ_TOK(nxt) : t;
            u32x4 r[16]; unsigned rj[16];
            bcast16(ii.x, ii.y, rj);
#pragma unroll
            for (int j = 0; j < 16; ++j) r[j] = *(const u32x4*)(Us + (size_t)(rj[j] & imask) * 128);
            float hf[16];
#pragma unroll
            for (int q = 0; q < 8; ++q) { const unsigned hd = (unsigned)__builtin_amdgcn_ds_bpermute(32 * sub + 4 * q, (int)hw); hf[2 * q] = bflo(hd); hf[2 * q + 1] = bfhi(hd); }
            { ii = *(const u32x2*)(IDXT + (size_t)tn * 128 + g * 16 + 2 * sub);
                hw = *((const unsigned*)(Hn + (size_t)tn * DM + 128 * s) + c.lane); }
            float am = 0.f;
#pragma unroll
            for (int q = 0; q < 16; ++q) am = fmaxf(am, fabsf(hf[q]));
            am = fmaxf(am, dpp_f<0xB1>(am)); am = fmaxf(am, dpp_f<0x4E>(am)); am = fmaxf(am, dpp_f<0x141>(am));
            const float hsc = am > 0.f ? 127.0f / am : 0.f, hinv = am * (1.0f / 127.0f);
            unsigned hq[4];
#pragma unroll
            for (int q = 0; q < 4; ++q) hq[q] = q8pack(hf[4 * q] * hsc, hf[4 * q + 1] * hsc, hf[4 * q + 2] * hsc, hf[4 * q + 3] * hsc);
            int p[16];
#pragma unroll
            for (int j = 0; j < 16; ++j) { int a = __builtin_amdgcn_sdot4((int)r[j].x, (int)hq[0], 0, false); a = __builtin_amdgcn_sdot4((int)r[j].y, (int)hq[1], a, false);
                a = __builtin_amdgcn_sdot4((int)r[j].z, (int)hq[2], a, false); p[j] = __builtin_amdgcn_sdot4((int)r[j].w, (int)hq[3], a, false); }
            { const bool up = (sub & 4) != 0;
#pragma unroll
              for (int q = 0; q < 8; ++q) { const int keep = up ? p[q + 8] : p[q], send = up ? p[q] : p[q + 8]; p[q] = keep + swz_xor_i<(4 << 10) | 0x1F>(send); } }
            { const bool up = (sub & 2) != 0;
#pragma unroll
              for (int q = 0; q < 4; ++q) { const int keep = up ? p[q + 4] : p[q], send = up ? p[q] : p[q + 4]; p[q] = keep + swz_xor_i<(2 << 10) | 0x1F>(send); } }
            { const bool up = (sub & 1) != 0;
#pragma unroll
              for (int q = 0; q < 2; ++q) { const int keep = up ? p[q + 2] : p[q], send = up ? p[q] : p[q + 2]; p[q] = keep + swz_xor_i<(1 << 10) | 0x1F>(send); } }
            f32x2 o = {(float)p[0] * hinv, (float)p[1] * hinv};
            *(f32x2*)(PD + ((size_t)t * 16 + s) * 128 + g * 16 + 2 * sub) = o;
            if (first) { asm volatile("" :: "v"(wv[0]), "v"(wv[1]), "v"(wv[2]), "v"(wv[3]), "v"(wv[4]), "v"(wv[5]), "v"(wv[6]), "v"(wv[7])); first = false; }
            cur = nxt; nxt = lq_take(vnn);
        }
    }
#undef LQ_TOK
}
__device__ __forceinline__ void peer_a_phase(const Ctx& c, const float* PD, const int* IDXT, float* WA, const float* rsU, const float* rsV, const float* RSTD) {
    const int i0 = c.bx * 512 + c.tid, step = c.G * 512;
    f32x4 vn[16];
    if (i0 < NTOK * 32) { const f32x4* pp = (const f32x4*)(PD + (size_t)(i0 >> 5) * 2048) + (i0 & 31);
#pragma unroll
        for (int s = 0; s < 16; ++s) vn[s] = pp[s * 32]; }
    for (int i4 = i0; i4 < NTOK * 32; i4 += step) {
        const int t = i4 >> 5;
        f32x4 v[16];
#pragma unroll
        for (int s = 0; s < 16; ++s) v[s] = vn[s];
        const u32x4 e = *((const u32x4*)IDXT + i4); const f32x4 w = *((const f32x4*)WA + i4); const float rs = RSTD[t];
        { const int i5 = i4 + step < NTOK * 32 ? i4 + step : i4; const f32x4* pp = (const f32x4*)(PD + (size_t)(i5 >> 5) * 2048) + (i5 & 31);
#pragma unroll
          for (int s = 0; s < 16; ++s) vn[s] = pp[s * 32]; }
        float ru[4], rv[4];
#pragma unroll
        for (int q = 0; q < 4; ++q) { const unsigned eq = e[q]; ru[q] = rsU[eq]; rv[q] = rsV[eq]; }
        f32x4 sm = v[0];
#pragma unroll
        for (int s = 1; s < 16; ++s) sm += v[s];
        asm volatile("" :: "v"(ru[0]), "v"(ru[1]), "v"(ru[2]), "v"(ru[3]), "v"(rv[0]), "v"(rv[1]), "v"(rv[2]), "v"(rv[3]));
        f32x4 o;
#pragma unroll
        for (int q = 0; q < 4; ++q) o[q] = gelu_erf(sm[q] * ru[q] * rs) * w[q] * rv[q];
        *((f32x4*)WA + i4) = o;
    }
}
__device__ __forceinline__ void peer_v_phase(const Ctx& c, const unsigned char* Vt, const int* IDXT, const float* WA, float* X) {
    const int xg = c.bx & 7, tb = (c.bx >> 3) * 8, g = c.lane >> 3, sub = c.lane & 7;
    LAS unsigned* LQ = (LAS unsigned*)(c.lds + LDS_MISC) + 8;
#define LQ_TOK(i) (tb + (int)((i) & 7u) + 256 * (int)((i) >> 3))
    for (int pass = 0; pass < 2; ++pass) {
        __syncthreads(); if (c.tid == 0) LQ[pass] = 0u; __syncthreads();
        unsigned cur = lq_take(lq_issue(LQ + pass, c.lane)), nxt = lq_take(lq_issue(LQ + pass, c.lane));
        const int s = xg + 8 * pass, col0 = 128 * s + 16 * sub;
        const unsigned char* Vs = Vt + (size_t)s * PE * 128 + 16 * sub;
        u32x4 wv[8];
        { const u32x4* wp = (const u32x4*)(Vt + (size_t)s * PE * 128 + (size_t)(c.bx >> 3) * 65536) + c.tid;
#pragma unroll
          for (int q = 0; q < 8; ++q) wv[q] = wp[q * 512]; }
        u32x2 ii, aa;
        { const int t0 = cur < 512u ? LQ_TOK(cur) : tb; ii = *(const u32x2*)(IDXT + (size_t)t0 * 128 + g * 16 + 2 * sub); aa = *(const u32x2*)(WA + (size_t)t0 * 128 + g * 16 + 2 * sub); }
        bool first = true;
        while (cur < 512u) {
            const unsigned vnn = lq_issue(LQ + pass, c.lane);
            const int t = LQ_TOK(cur), tn = nxt < 512u ? LQ_TOK(nxt) : t;
            u32x4 r[16]; float av[16]; unsigned rj[16], aj[16];
            bcast16(ii.x, ii.y, rj);
#pragma unroll
            for (int j = 0; j < 16; ++j) r[j] = *(const u32x4*)(Vs + (size_t)rj[j] * 128);
            bcast16(aa.x, aa.y, aj);
#pragma unroll
            for (int j = 0; j < 16; ++j) av[j] = __builtin_bit_cast(float, aj[j]);
            f32x2* xp = (f32x2*)(X + (size_t)t * DM + col0 + 2 * g);
            const f32x2 xold = *xp;
            { ii = *(const u32x2*)(IDXT + (size_t)tn * 128 + g * 16 + 2 * sub); aa = *(const u32x2*)(WA + (size_t)tn * 128 + g * 16 + 2 * sub); }
            f32x2 acc[8];
#pragma unroll
            for (int q = 0; q < 8; ++q) acc[q] = (f32x2){0.f, 0.f};
#pragma unroll
            for (int j = 0; j < 16; ++j) { float aj_ = av[j]; asm("" : "+v"(aj_));
                const f32x2 a2 = {aj_, aj_};
#pragma unroll
                for (int q = 0; q < 4; ++q) { const int w = (int)r[j][q]; acc[2 * q] = __builtin_elementwise_fma(__builtin_amdgcn_cvt_pk_f32_fp8(w, false), a2, acc[2 * q]); acc[2 * q + 1] = __builtin_elementwise_fma(__builtin_amdgcn_cvt_pk_f32_fp8(w, true), a2, acc[2 * q + 1]); } }
            float af[16];
#pragma unroll
            for (int q = 0; q < 8; ++q) { af[2 * q] = acc[q].x; af[2 * q + 1] = acc[q].y; }
#ifdef VDBG
#pragma unroll
            for (int q = 0; q < 16; ++q) { af[q] += __shfl_xor(af[q], 8); af[q] += __shfl_xor(af[q], 16); af[q] += __shfl_xor(af[q], 32); }
            { float s0 = af[0], s1 = af[1];
#pragma unroll
              for (int gg = 1; gg < 8; ++gg) { s0 = (g == gg) ? af[2 * gg] : s0; s1 = (g == gg) ? af[2 * gg + 1] : s1; }
              af[0] = s0; af[1] = s1; }
#else
#pragma unroll
            for (int q = 0; q < 8; ++q) { float xa = af[q], xb = af[q + 8]; asm("s_nop 1\n\tv_permlane32_swap_b32 %0, %1" : "+v"(xa), "+v"(xb)); af[q] = xa + xb; }
#pragma unroll
            for (int q = 0; q < 4; ++q) { float xa = af[q], xb = af[q + 4]; asm("s_nop 1\n\tv_permlane16_swap_b32 %0, %1" : "+v"(xa), "+v"(xb)); af[q] = xa + xb; }
            { const bool up = (c.lane & 8) != 0;
#pragma unroll
              for (int q = 0; q < 2; ++q) { const float keep = up ? af[q + 2] : af[q], send = up ? af[q] : af[q + 2]; af[q] = keep + swz_xor<(8 << 10) | 0x1F>(send); } }
#endif
            const f32x2 xn = {xold.x + af[0], xold.y + af[1]};
            *xp = xn;
            if (first) { asm volatile("" :: "v"(wv[0]), "v"(wv[1]), "v"(wv[2]), "v"(wv[3]), "v"(wv[4]), "v"(wv[5]), "v"(wv[6]), "v"(wv[7])); first = false; }
            cur = nxt; nxt = lq_take(vnn);
        }
    }
#undef LQ_TOK
}
#ifdef VREF
__device__ __forceinline__ void peer_v_ref_phase(const Ctx& c, const unsigned char* Vt, const int* IDXT, const float* WA, float* X) {
    for (int m = c.gw; m < NTOK; m += c.ngw) {
        const int i0 = IDXT[(size_t)m * 128 + c.lane], i1 = IDXT[(size_t)m * 128 + 64 + c.lane];
        const float a0 = WA[(size_t)m * 128 + c.lane], a1 = WA[(size_t)m * 128 + 64 + c.lane];
        f32x2 acc[16];
#pragma unroll
        for (int k = 0; k < 16; ++k) acc[k] = (f32x2){0.f, 0.f};
        for (int e = 0; e < 128; ++e) {
            const int row = __shfl(e < 64 ? i0 : i1, e & 63); const float a = __shfl(e < 64 ? a0 : a1, e & 63); const f32x2 a2 = {a, a};
            const u32x4* vp = (const u32x4*)(Vt + (size_t)row * DM) + c.lane;
#pragma unroll
            for (int cc = 0; cc < 2; ++cc) { const u32x4 v = vp[64 * cc];
#pragma unroll
                for (int q = 0; q < 4; ++q) { const int w = (int)v[q];
                    acc[8 * cc + 2 * q] = __builtin_elementwise_fma(__builtin_amdgcn_cvt_pk_f32_fp8(w, false), a2, acc[8 * cc + 2 * q]);
                    acc[8 * cc + 2 * q + 1] = __builtin_elementwise_fma(__builtin_amdgcn_cvt_pk_f32_fp8(w, true), a2, acc[8 * cc + 2 * q + 1]); } }
        }
        float* xr = X + (size_t)m * DM;
#pragma unroll
        for (int cc = 0; cc < 2; ++cc) { f32x4* xp = (f32x4*)(xr + 1024 * cc + 16 * c.lane);
#pragma unroll
            for (int q = 0; q < 4; ++q) { f32x4 xa = xp[q]; xa[0] += acc[8 * cc + 2 * q].x; xa[1] += acc[8 * cc + 2 * q].y; xa[2] += acc[8 * cc + 2 * q + 1].x; xa[3] += acc[8 * cc + 2 * q + 1].y; xp[q] = xa; } }
    }
}
#endif
__device__ __forceinline__ void norm_phase(const Ctx& c, float* X, int mode, const float* g1, const float* g2, bf16* H, bf16* HKV) {
    f32x4 ga[8], gb[8]; load_g(g1, c.lane, ga); load_g(mode == 1 ? g2 : g1, c.lane, gb);
    LAS unsigned* LQ = (LAS unsigned*)(c.lds + LDS_MISC) + 10;
    __syncthreads(); if (c.tid == 0) LQ[0] = 0u; __syncthreads();
#define NQ_ROW(i) (8 * c.bx + (int)((i) & 7u) + 2048 * (int)((i) >> 3))
    unsigned cur = lq_take(lq_issue(LQ, c.lane)), nxt = lq_take(lq_issue(LQ, c.lane));
    f32x4 v[8]; load_row(X + (size_t)(cur < 64u ? NQ_ROW(cur) : 8 * c.bx) * DM, c.lane, v);
    while (cur < 64u) {
        const unsigned vnn = lq_issue(LQ, c.lane);
        const int m = NQ_ROW(cur), mn = nxt < 64u ? NQ_ROW(nxt) : m;
        f32x4 nx[8]; load_row(X + (size_t)mn * DM, c.lane, nx);
        const float rstd = row_rstd(v);
        if (mode == 2) { f32x4* xo = (f32x4*)(X + (size_t)m * DM) + c.lane;
#pragma unroll
            for (int j = 0; j < 8; ++j) { f32x4 y; y[0] = v[j][0] * rstd * ga[j][0]; y[1] = v[j][1] * rstd * ga[j][1]; y[2] = v[j][2] * rstd * ga[j][2]; y[3] = v[j][3] * rstd * ga[j][3]; xo[64 * j] = y; }
        } else { store_norm_bf16_r(v, rstd, ga, H + (size_t)m * DM, c.lane); if (mode == 1) store_norm_bf16_r(v, rstd, gb, HKV + (size_t)m * DM, c.lane); }
#pragma unroll
        for (int j = 0; j < 8; ++j) v[j] = nx[j];
        cur = nxt; nxt = lq_take(vnn);
    }
#undef NQ_ROW
}

__device__ __forceinline__ void rms_final_phase(const Ctx& c, float* X, const float* g) {
    for (int m = c.gw; m < NTOK; m += c.ngw) { f32x4 v[8]; load_row(X + (size_t)m * DM, c.lane, v); const float rstd = row_rstd(v);
        const f32x4* gr = (const f32x4*)g + c.lane; f32x4* xo = (f32x4*)(X + (size_t)m * DM) + c.lane;
#pragma unroll
        for (int j = 0; j < 8; ++j) { const f32x4 gv = gr[64 * j]; f32x4 y; for (int k = 0; k < 4; ++k) { y[k] = v[j][k] * rstd * gv[k]; if (!(fabsf(y[k]) < 1e30f)) y[k] = 0.f; } xo[64 * j] = y; } }
}

#ifdef DIAGBUF
__device__ __forceinline__ void diag_copy_phase(const Ctx& c, float* X, const unsigned char* ws) {
    const bf16* src = (const bf16*)(ws + (size_t)DIAGBUF);
    for (size_t i = (size_t)c.bx * 512 + c.tid; i < (size_t)NTOK * DM; i += (size_t)c.G * 512) { const size_t t = i / DM, col = i % DM; float v = bflo((unsigned)src[t * DIAGLD + col]); if (!(fabsf(v) < 1e30f)) v = 0.f; X[i] = v; }
}
#endif

__device__ __forceinline__ unsigned off_b(unsigned row, unsigned ch) { return 256u * row + 16u * (ch ^ (((row & 3u) << 2) | ((row >> 2) & 3u))); }
__device__ __forceinline__ float rowmax4(float x) {
    float a = x, b = x; asm("s_nop 1\n\tv_permlane16_swap_b32 %0, %1" : "+v"(a), "+v"(b)); x = fmaxf(a, b);
    a = x; b = x; asm("s_nop 1\n\tv_permlane32_swap_b32 %0, %1" : "+v"(a), "+v"(b)); return fmaxf(a, b);
}
constexpr int AT_K = 0, AT_V = 32768, AT_BUF = 65536, AT_BIAS = 131072, AT_HEADB = 16384;
__device__ __forceinline__ void attn_phase(const Ctx& c, const bf16* Qg, const bf16* KVg, bf16* AOg, const float* relb, int dryvar = 0) {
    LAS unsigned char* lds = c.lds; const unsigned ldsb = (unsigned)(size_t)lds;
    const int tid = c.tid, lane = c.lane, w = c.wave, hg = w >> 2, wq = w & 3, fr = lane & 15, fq = lane >> 4, tq = (lane & 15) >> 2, tp = lane & 3;
    const int tl = tid & 255, lrow = tl >> 2, lc = tl & 3;
    unsigned vadr[8];
#pragma unroll
    for (int d = 0; d < 8; ++d) vadr[d] = ldsb + AT_V + hg * AT_HEADB + off_b(4 * fq + tq, 2 * d + (tp >> 1)) + 8 * (tp & 1);
    unsigned kadr[4];
#pragma unroll
    for (int s4 = 0; s4 < 4; ++s4) kadr[s4] = ldsb + AT_K + hg * AT_HEADB + 256 * fr + 16 * (fq ^ ((fr >> 2) & 3)) + 64 * (s4 ^ (fr & 3));
    for (int u = c.bx; u < NBATCH * NCHUNK * (AH / 2); u += c.G) {
        const int hp = u & 7, ch = (u >> 3) & 63, b = u >> 9, h = 2 * hp + hg;
        const size_t tq0 = (size_t)b * SEQ + (size_t)ch * CHUNK;
        __syncthreads();
        for (int i = tid; i < 2 * 272; i += 512) { const int hh = i / 272, k = i % 272; ((LAS float*)(lds + AT_BIAS))[i] = (k < NREL) ? relb[(size_t)(2 * hp + hh) * NREL + k] * 1.4426950408889634f : 0.f; }
        bf16x8 qf[4];
        { const bf16* qp = Qg + (tq0 + 16 * wq + fr) * DM + h * AHD + 8 * fq;
#pragma unroll
          for (int s = 0; s < 4; ++s) qf[s] = *(const bf16x8*)(qp + 32 * s); }
        f32x4 O[8];
#pragma unroll
        for (int d = 0; d < 8; ++d) O[d] = (f32x4){0.f, 0.f, 0.f, 0.f};
        float mrun = -1e30f, lrun = 0.f;
        const int t0 = ch >= LEFT ? 0 : LEFT - ch;
        u32x4 pk[4], pv[4];
        { const bf16* kp = KVg + ((size_t)b * SEQ + (size_t)(ch - LEFT + t0) * CHUNK + lrow) * (2 * DM) + h * AHD;
#pragma unroll
          for (int cc = 0; cc < 4; ++cc) { pk[cc] = *(const u32x4*)(kp + (lc + 4 * cc) * 8); pv[cc] = *(const u32x4*)(kp + DM + (lc + 4 * cc) * 8); } }
        const LAS float* bias = (const LAS float*)(lds + AT_BIAS) + hg * 272;
        const float bc = relb[(size_t)h * NREL + 256] * 1.4426950408889634f;
        for (int t = t0; t <= LEFT; ++t) {
            const int pb = ((t - t0) & 1) * AT_BUF;
#pragma unroll
            for (int cc = 0; cc < 4; ++cc) { *(LAS u32x4*)(lds + pb + AT_K + hg * AT_HEADB + off_b(lrow, lc + 4 * cc)) = pk[cc]; *(LAS u32x4*)(lds + pb + AT_V + hg * AT_HEADB + off_b(lrow, lc + 4 * cc)) = pv[cc]; }
            __syncthreads();
            if (t < LEFT && dryvar != 1) { const bf16* kp = KVg + ((size_t)b * SEQ + (size_t)(ch - LEFT + t + 1) * CHUNK + lrow) * (2 * DM) + h * AHD;
#pragma unroll
                for (int cc = 0; cc < 4; ++cc) { pk[cc] = *(const u32x4*)(kp + (lc + 4 * cc) * 8); pv[cc] = *(const u32x4*)(kp + DM + (lc + 4 * cc) * 8); } }
            f32x4 sT[4];
            {
                bf16x8 kf[16];
                const unsigned k0 = kadr[0] + pb, k1 = kadr[1] + pb, k2 = kadr[2] + pb, k3 = kadr[3] + pb;
                asm volatile("ds_read_b128 %0, %16\n\tds_read_b128 %1, %17\n\tds_read_b128 %2, %18\n\tds_read_b128 %3, %19\n\t"
                             "ds_read_b128 %4, %16 offset:4096\n\tds_read_b128 %5, %17 offset:4096\n\tds_read_b128 %6, %18 offset:4096\n\tds_read_b128 %7, %19 offset:4096\n\t"
                             "ds_read_b128 %8, %16 offset:8192\n\tds_read_b128 %9, %17 offset:8192\n\tds_read_b128 %10, %18 offset:8192\n\tds_read_b128 %11, %19 offset:8192\n\t"
                             "ds_read_b128 %12, %16 offset:12288\n\tds_read_b128 %13, %17 offset:12288\n\tds_read_b128 %14, %18 offset:12288\n\tds_read_b128 %15, %19 offset:12288"
                             : "=&v"(kf[0]), "=&v"(kf[1]), "=&v"(kf[2]), "=&v"(kf[3]), "=&v"(kf[4]), "=&v"(kf[5]), "=&v"(kf[6]), "=&v"(kf[7]),
                               "=&v"(kf[8]), "=&v"(kf[9]), "=&v"(kf[10]), "=&v"(kf[11]), "=&v"(kf[12]), "=&v"(kf[13]), "=&v"(kf[14]), "=&v"(kf[15])
                             : "v"(k0), "v"(k1), "v"(k2), "v"(k3) : "memory");
                asm volatile("s_waitcnt lgkmcnt(8)" : "+v"(kf[0]), "+v"(kf[1]), "+v"(kf[2]), "+v"(kf[3]), "+v"(kf[4]), "+v"(kf[5]), "+v"(kf[6]), "+v"(kf[7]) :: "memory");
#pragma unroll
                for (int kt = 0; kt < 2; ++kt) { sT[kt] = (f32x4){0.f, 0.f, 0.f, 0.f};
#pragma unroll
                    for (int s = 0; s < 4; ++s) sT[kt] = MFMA16(kf[4 * kt + s], qf[s], sT[kt]); }
                asm volatile("s_waitcnt lgkmcnt(0)" : "+v"(kf[8]), "+v"(kf[9]), "+v"(kf[10]), "+v"(kf[11]), "+v"(kf[12]), "+v"(kf[13]), "+v"(kf[14]), "+v"(kf[15]) :: "memory");
#pragma unroll
                for (int kt = 2; kt < 4; ++kt) { sT[kt] = (f32x4){0.f, 0.f, 0.f, 0.f};
#pragma unroll
                    for (int s = 0; s < 4; ++s) sT[kt] = MFMA16(kf[4 * kt + s], qf[s], sT[kt]); }
            }
            const int dbase = (LEFT - t) * CHUNK + (16 * wq + fr);
            if (t > LEFT - 3) {
#pragma unroll
                for (int kt = 0; kt < 4; ++kt)
#pragma unroll
                    for (int r = 0; r < 4; ++r) { const int dist = dbase - (16 * kt + 4 * fq + r); sT[kt][r] += bias[min(dist, 128) + 128]; }
            }
            s16x4 vlo[2][8], vhi[2][8];
            unsigned vcur[8];
#pragma unroll
            for (int d = 0; d < 8; ++d) vcur[d] = vadr[d] + pb;
#define TR8(dst, OFF) asm volatile("ds_read_b64_tr_b16 %0, %8 offset:" #OFF "\n\tds_read_b64_tr_b16 %1, %9 offset:" #OFF "\n\tds_read_b64_tr_b16 %2, %10 offset:" #OFF "\n\tds_read_b64_tr_b16 %3, %11 offset:" #OFF "\n\t" \
                "ds_read_b64_tr_b16 %4, %12 offset:" #OFF "\n\tds_read_b64_tr_b16 %5, %13 offset:" #OFF "\n\tds_read_b64_tr_b16 %6, %14 offset:" #OFF "\n\tds_read_b64_tr_b16 %7, %15 offset:" #OFF \
                : "=&v"(dst[0]), "=&v"(dst[1]), "=&v"(dst[2]), "=&v"(dst[3]), "=&v"(dst[4]), "=&v"(dst[5]), "=&v"(dst[6]), "=&v"(dst[7]) \
                : "v"(vcur[0]), "v"(vcur[1]), "v"(vcur[2]), "v"(vcur[3]), "v"(vcur[4]), "v"(vcur[5]), "v"(vcur[6]), "v"(vcur[7]) : "memory")
            TR8(vlo[0], 0); TR8(vhi[0], 4096); TR8(vlo[1], 8192); TR8(vhi[1], 12288);
#undef TR8
            float mx = -1e30f;
            const float badd = t <= LEFT - 3 ? bc : 0.f;
#pragma unroll
            for (int kt = 0; kt < 4; ++kt)
#pragma unroll
                for (int r = 0; r < 4; ++r) { sT[kt][r] += badd; mx = fmaxf(mx, sT[kt][r]); }
            mx = rowmax4(mx);
            const float mnew = fmaxf(mrun, mx), alpha = __builtin_amdgcn_exp2f(mrun - mnew); mrun = mnew;
            float ps = 0.f;
#pragma unroll
            for (int kt = 0; kt < 4; ++kt)
#pragma unroll
                for (int r = 0; r < 4; ++r) { sT[kt][r] = __builtin_amdgcn_exp2f(sT[kt][r] - mnew); ps += sT[kt][r]; }
            lrun = lrun * alpha + ps;
#pragma unroll
            for (int d = 0; d < 8; ++d) O[d] *= alpha;
            asm volatile("s_waitcnt lgkmcnt(0)" : "+v"(vlo[0][0]), "+v"(vlo[0][1]), "+v"(vlo[0][2]), "+v"(vlo[0][3]), "+v"(vlo[0][4]), "+v"(vlo[0][5]), "+v"(vlo[0][6]), "+v"(vlo[0][7]),
                         "+v"(vhi[0][0]), "+v"(vhi[0][1]), "+v"(vhi[0][2]), "+v"(vhi[0][3]), "+v"(vhi[0][4]), "+v"(vhi[0][5]), "+v"(vhi[0][6]), "+v"(vhi[0][7]) :: "memory");
            asm volatile("" : "+v"(vlo[1][0]), "+v"(vlo[1][1]), "+v"(vlo[1][2]), "+v"(vlo[1][3]), "+v"(vlo[1][4]), "+v"(vlo[1][5]), "+v"(vlo[1][6]), "+v"(vlo[1][7]),
                         "+v"(vhi[1][0]), "+v"(vhi[1][1]), "+v"(vhi[1][2]), "+v"(vhi[1][3]), "+v"(vhi[1][4]), "+v"(vhi[1][5]), "+v"(vhi[1][6]), "+v"(vhi[1][7]) :: "memory");
            __builtin_amdgcn_sched_barrier(0);
#pragma unroll
            for (int ks = 0; ks < 2; ++ks) {
                bf16x8 pb; { const unsigned p0 = pk2(sT[2 * ks][0], sT[2 * ks][1]), p1 = pk2(sT[2 * ks][2], sT[2 * ks][3]), p2 = pk2(sT[2 * ks + 1][0], sT[2 * ks + 1][1]), p3 = pk2(sT[2 * ks + 1][2], sT[2 * ks + 1][3]);
                    const u32x4 pw = (u32x4){p0, p1, p2, p3}; pb = __builtin_bit_cast(bf16x8, pw); }
#pragma unroll
                for (int d = 0; d < 8; ++d) { bf16x8 va; va[0] = vlo[ks][d][0]; va[1] = vlo[ks][d][1]; va[2] = vlo[ks][d][2]; va[3] = vlo[ks][d][3]; va[4] = vhi[ks][d][0]; va[5] = vhi[ks][d][1]; va[6] = vhi[ks][d][2]; va[7] = vhi[ks][d][3];
                    O[d] = MFMA16(va, pb, O[d]); }
            }
        }
        float lt = lrun; lt += __shfl_xor(lt, 16); lt += __shfl_xor(lt, 32);
        const float inv = 1.0f / lt;
        bf16* op = AOg + (tq0 + 16 * wq + fr) * DM + h * AHD + 4 * fq;
#pragma unroll
        for (int d = 0; d < 8; ++d) { u32x2 ow; ow.x = pk2(O[d][0] * inv, O[d][1] * inv); ow.y = pk2(O[d][2] * inv, O[d][3] * inv); *(u32x2*)(op + 16 * d) = ow; }
    }
}

namespace at2 {
typedef float f32x16 __attribute__((ext_vector_type(16)));
constexpr int SHM_V = 64 * 128 * 2, SHM_K = 64 * 128 * 2, OFF_K = 2 * SHM_V, OFF_WS = 2 * SHM_V + 2 * SHM_K, OFF_BIAS = OFF_WS + 8 * 64 * 4, OFF_Q = OFF_BIAS + 2048;
constexpr float THRL = 8.0f * 1.4426950408889634f;
#define A2_KSWZ(row, colB) ((row) * 256 + ((colB) ^ (((row) & 7) << 4)))
#define A2_SBAR() __builtin_amdgcn_sched_barrier(0)
__device__ __forceinline__ int crow(int r, int hi) { return (r & 3) + 8 * (r >> 2) + 4 * hi; }
__device__ __forceinline__ float pl32max(float x) { auto rr = __builtin_amdgcn_permlane32_swap(__builtin_bit_cast(unsigned, x), __builtin_bit_cast(unsigned, x), false, false);
    const unsigned a = rr[0], b = rr[1]; return fmaxf(__builtin_bit_cast(float, a), __builtin_bit_cast(float, b)); }
__device__ __forceinline__ float pl32sum(float x) { auto rr = __builtin_amdgcn_permlane32_swap(__builtin_bit_cast(unsigned, x), __builtin_bit_cast(unsigned, x), false, false);
    const unsigned a = rr[0], b = rr[1]; return __builtin_bit_cast(float, a) + __builtin_bit_cast(float, b); }
__device__ __forceinline__ void partialSM(f32x16& p0, f32x16& p1, float& m_reg, float& mn, float& alpha) {
    float pmax = p0[0];
#pragma unroll
    for (int r = 1; r < 16; ++r) pmax = fmaxf(pmax, p0[r]);
#pragma unroll
    for (int r = 0; r < 16; ++r) pmax = fmaxf(pmax, p1[r]);
    pmax = pl32max(pmax);
    if (__builtin_expect(__all(pmax - m_reg <= THRL), 1)) { mn = m_reg; alpha = 1.f; }
    else { mn = fmaxf(m_reg, pmax); alpha = __builtin_amdgcn_exp2f(m_reg - mn); m_reg = mn; }
#pragma unroll
    for (int r = 0; r < 16; ++r) { p0[r] -= mn; p1[r] -= mn; }
#pragma unroll
    for (int r = 0; r < 16; ++r) p0[r] = __builtin_amdgcn_exp2f(p0[r]);
}
__device__ __forceinline__ void finishSM(f32x16& p0, f32x16& p1, float alpha, float& l_reg, bf16x8& pa0, bf16x8& pa1, bf16x8& pa2, bf16x8& pa3) {
#pragma unroll
    for (int r = 0; r < 16; ++r) p1[r] = __builtin_amdgcn_exp2f(p1[r]);
    float ps = 0.f;
#pragma unroll
    for (int r = 0; r < 16; ++r) ps += p0[r];
#pragma unroll
    for (int r = 0; r < 16; ++r) ps += p1[r];
    ps = pl32sum(ps);
    l_reg = l_reg * alpha + ps;
#define A2_PK4(P, BASE, OUT) do { const unsigned a0 = pk2(P[BASE + 0], P[BASE + 1]), a1 = pk2(P[BASE + 2], P[BASE + 3]), b0 = pk2(P[BASE + 4], P[BASE + 5]), b1 = pk2(P[BASE + 6], P[BASE + 7]); \
        auto r0 = __builtin_amdgcn_permlane32_swap(a0, b0, false, false); auto r1 = __builtin_amdgcn_permlane32_swap(a1, b1, false, false); \
        const unsigned w0 = r0[0], w1 = r1[0], w2 = r0[1], w3 = r1[1]; const u32x4 w = {w0, w1, w2, w3}; OUT = __builtin_bit_cast(bf16x8, w); } while (0)
    A2_PK4(p0, 0, pa0); A2_PK4(p0, 8, pa1); A2_PK4(p1, 0, pa2); A2_PK4(p1, 8, pa3);
#undef A2_PK4
}
__device__ __forceinline__ void qkt(f32x16& p0, f32x16& p1, LAS const unsigned char* Ks, LAS const unsigned char* qr_l, int r32, int hi) {
    asm volatile("" : "+v"(r32));
#pragma unroll
    for (int r = 0; r < 16; ++r) { p0[r] = 0.f; p1[r] = 0.f; }
#pragma unroll
    for (int d0 = 0; d0 < 8; ++d0) { const int cb = (d0 * 16 + hi * 8) * 2;
        const bf16x8 b0 = *(LAS const bf16x8*)(Ks + A2_KSWZ(r32, cb));
        const bf16x8 b1 = *(LAS const bf16x8*)(Ks + A2_KSWZ(32 + r32, cb));
        const bf16x8 q8 = *(LAS const bf16x8*)(qr_l + d0 * 1024);
        p0 = __builtin_amdgcn_mfma_f32_32x32x16_bf16(b0, q8, p0, 0, 0, 0);
        p1 = __builtin_amdgcn_mfma_f32_32x32x16_bf16(b1, q8, p1, 0, 0, 0); }
}
__device__ __forceinline__ int v_st(int k, int c) { const int kk = (k & ~0xC) | ((k & 4) << 1) | ((k & 8) >> 1); return ((kk >> 3) * 4 + (c >> 5)) * 512 + ((kk & 7) * 32 + (c & 31)) * 2; }
__device__ __forceinline__ int v_rd_base(int lane) { return ((lane & 3) << 3) | (((lane >> 2) & 3) << 6) | (((lane >> 4) & 1) << 5) | (((lane >> 5) & 1) << 8); }
constexpr int v_rd_off(int d0, int ks, int half) { return d0 * 512 + ks * 4096 + half * 2048; }
template <int OFF> __device__ __forceinline__ s16x4 tr_read(int vb) { s16x4 r; asm volatile("ds_read_b64_tr_b16 %0, %1 offset:%2" : "=&v"(r) : "v"(vb), "i"(OFF) : "memory"); return r; }
template <int D0> __device__ __forceinline__ void pv_one(f32x16& od, int vb, bf16x8 pa0, bf16x8 pa1, bf16x8 pa2, bf16x8 pa3) {
    const s16x4 l0 = tr_read<v_rd_off(D0, 0, 0)>(vb), h0 = tr_read<v_rd_off(D0, 0, 1)>(vb), l1 = tr_read<v_rd_off(D0, 1, 0)>(vb), h1 = tr_read<v_rd_off(D0, 1, 1)>(vb);
    const s16x4 l2 = tr_read<v_rd_off(D0, 2, 0)>(vb), h2 = tr_read<v_rd_off(D0, 2, 1)>(vb), l3 = tr_read<v_rd_off(D0, 3, 0)>(vb), h3 = tr_read<v_rd_off(D0, 3, 1)>(vb);
    asm volatile("s_waitcnt lgkmcnt(0)" ::: "memory"); A2_SBAR();
#define A2_PK(L, H) (bf16x8){L[0], L[1], L[2], L[3], H[0], H[1], H[2], H[3]}
    od = __builtin_amdgcn_mfma_f32_32x32x16_bf16(pa0, A2_PK(l0, h0), od, 0, 0, 0);
    od = __builtin_amdgcn_mfma_f32_32x32x16_bf16(pa1, A2_PK(l1, h1), od, 0, 0, 0);
    od = __builtin_amdgcn_mfma_f32_32x32x16_bf16(pa2, A2_PK(l2, h2), od, 0, 0, 0);
    od = __builtin_amdgcn_mfma_f32_32x32x16_bf16(pa3, A2_PK(l3, h3), od, 0, 0, 0);
#undef A2_PK
}
__device__ __forceinline__ void pv_d0(f32x16 (&o)[4], int vb, bf16x8 pa0, bf16x8 pa1, bf16x8 pa2, bf16x8 pa3) {
    pv_one<0>(o[0], vb, pa0, pa1, pa2, pa3); pv_one<1>(o[1], vb, pa0, pa1, pa2, pa3); pv_one<2>(o[2], vb, pa0, pa1, pa2, pa3); pv_one<3>(o[3], vb, pa0, pa1, pa2, pa3);
}
__device__ __forceinline__ void bias_mask(f32x16& p0, f32x16& p1, int dc, LAS const float* bias, float bc, int qrow, int hi) {
    if (dc < 0 || dc > 8) {
#pragma unroll
        for (int r = 0; r < 16; ++r) { p0[r] = -__builtin_inff(); p1[r] = -__builtin_inff(); }
    } else if (dc >= 3) {
#pragma unroll
        for (int r = 0; r < 16; ++r) { p0[r] += bc; p1[r] += bc; }
    } else {
        int db = 64 * dc + qrow + 128 - 4 * hi; asm volatile("" : "+v"(db));
#pragma unroll
        for (int r = 0; r < 16; ++r) { const int k0 = (r & 3) + 8 * (r >> 2); p0[r] += bias[min(db - k0, 256)]; p1[r] += bias[min(db - 32 - k0, 256)]; }
    }
}
__device__ __forceinline__ void block(const bf16* Qb, const bf16* Kh, const bf16* Vh, bf16* Ob, int NT, int dc0, LAS const float* bias, float bc, LAS unsigned char* lds, int tid) {
    constexpr int LDQ = DM, LDK = 2 * DM, LDO = DM;
    const int wid = tid >> 6, lane = tid & 63, r32 = lane & 31, hi = lane >> 5;
    LAS unsigned char* V_lds = lds; LAS unsigned char* K_lds = lds + OFF_K;
    LAS float* ws = (LAS float*)(lds + OFF_WS) + wid * 64; LAS float* li_l = ws; LAS float* al_l = ws + 32;
    float m_reg = -1e30f, l_reg = 0.f; f32x16 o[4];
    LAS unsigned char* qr = lds + OFF_Q + wid * 8192 + lane * 16;
#pragma unroll
    for (int d = 0; d < 4; ++d)
#pragma unroll
        for (int r = 0; r < 16; ++r) o[d][r] = 0.f;
    const bf16* Qw = Qb + (size_t)(wid * 32 + r32) * LDQ + hi * 8;
#pragma unroll
    for (int d0 = 0; d0 < 8; ++d0) *(LAS bf16x8*)(qr + d0 * 1024) = *(const bf16x8*)(Qw + d0 * 16);
    const int sr = tid >> 4, sc = (tid & 15) * 8, vst0 = v_st(sr, sc), vst1 = v_st(32 + sr, sc);
    const int vb0 = (int)(unsigned)(size_t)V_lds + v_rd_base(lane);
    const int qrow = (wid & 1) * 32 + r32, dcw = dc0 + (wid >> 1);
    bf16x8 sv0[1], sv1[1], sk0[1], sk1[1];
#define A2_SLOAD(i, k0) do { sv0[i] = *(const bf16x8*)(Vh + (size_t)((k0) + sr) * LDK + sc); sv1[i] = *(const bf16x8*)(Vh + (size_t)((k0) + 32 + sr) * LDK + sc); \
        sk0[i] = *(const bf16x8*)(Kh + (size_t)((k0) + sr) * LDK + sc); sk1[i] = *(const bf16x8*)(Kh + (size_t)((k0) + 32 + sr) * LDK + sc); } while (0)
#define A2_SWRITE(b, i) do { *(LAS bf16x8*)(V_lds + (b) * SHM_V + vst0) = sv0[i]; *(LAS bf16x8*)(V_lds + (b) * SHM_V + vst1) = sv1[i]; const int kc = sc * 2; \
        *(LAS bf16x8*)(K_lds + (b) * SHM_K + A2_KSWZ(sr, kc)) = sk0[i]; *(LAS bf16x8*)(K_lds + (b) * SHM_K + A2_KSWZ(32 + sr, kc)) = sk1[i]; } while (0)
#define A2_SWAIT() asm volatile("s_waitcnt vmcnt(0)" ::: "memory")
#define A2_RESC(a) do { if (__any((a) < 1.f)) { if (hi == 0) al_l[r32] = (a); asm volatile("s_waitcnt lgkmcnt(0)" ::: "memory"); \
        _Pragma("unroll") for (int d = 0; d < 4; ++d) _Pragma("unroll") for (int r = 0; r < 16; ++r) o[d][r] *= al_l[crow(r, hi)]; } } while (0)
    f32x16 pA0, pA1, pB0, pB1; float mnA, mnB, alA = 1.f, alB = 1.f; bf16x8 pa0, pa1, pa2, pa3;
#define A2_VIS(jj) ((unsigned)(dcw - (jj)) <= 8u)
    A2_SLOAD(0, 0); asm volatile("s_waitcnt vmcnt(0)" ::: "memory"); A2_SWRITE(0, 0); __syncthreads();
    bool vA = A2_VIS(0), vB = false;
    if (vA) { qkt(pA0, pA1, K_lds, qr, r32, hi); bias_mask(pA0, pA1, dcw - 0, bias, bc, qrow, hi); partialSM(pA0, pA1, m_reg, mnA, alA); }
    A2_SLOAD(0, 64);
    A2_SWAIT(); A2_SWRITE(1, 0); __syncthreads();
    for (int j = 1; j + 1 < NT; j += 2) {
        vB = A2_VIS(j);
        A2_SBAR(); if (vB) { qkt(pB0, pB1, K_lds + SHM_K, qr, r32, hi); bias_mask(pB0, pB1, dcw - j, bias, bc, qrow, hi); }
        if (vA) finishSM(pA0, pA1, alA, l_reg, pa0, pa1, pa2, pa3);
        A2_SBAR();
        A2_SLOAD(0, (j + 1) * 64); A2_SBAR();
        if (vA) pv_d0(o, vb0, pa0, pa1, pa2, pa3);
        alB = 1.f; if (vB) partialSM(pB0, pB1, m_reg, mnB, alB);
        __syncthreads(); A2_SWAIT(); A2_SWRITE(0, 0);
        A2_RESC(alB); __syncthreads();
        vA = A2_VIS(j + 1);
        A2_SBAR(); if (vA) { qkt(pA0, pA1, K_lds, qr, r32, hi); bias_mask(pA0, pA1, dcw - (j + 1), bias, bc, qrow, hi); }
        if (vB) finishSM(pB0, pB1, alB, l_reg, pa0, pa1, pa2, pa3);
        A2_SBAR();
        A2_SLOAD(0, (j + 2) * 64);
        A2_SBAR();
        if (vB) pv_d0(o, vb0 + SHM_V, pa0, pa1, pa2, pa3);
        alA = 1.f; if (vA) partialSM(pA0, pA1, m_reg, mnA, alA);
        __syncthreads(); A2_SWAIT(); A2_SWRITE(1, 0);
        A2_RESC(alA); __syncthreads();
    }
    vB = A2_VIS(NT - 1);
    A2_SBAR(); if (vB) { qkt(pB0, pB1, K_lds + SHM_K, qr, r32, hi); bias_mask(pB0, pB1, dcw - (NT - 1), bias, bc, qrow, hi); }
    if (vA) finishSM(pA0, pA1, alA, l_reg, pa0, pa1, pa2, pa3);
    A2_SBAR();
    if (vA) pv_d0(o, vb0, pa0, pa1, pa2, pa3);
    alB = 1.f; if (vB) partialSM(pB0, pB1, m_reg, mnB, alB);
    __syncthreads(); A2_RESC(alB);
    if (vB) { finishSM(pB0, pB1, alB, l_reg, pa0, pa1, pa2, pa3); A2_SBAR();
        pv_d0(o, vb0 + SHM_V, pa0, pa1, pa2, pa3); }
#undef A2_VIS
    if (hi == 0) li_l[r32] = l_reg; asm volatile("s_waitcnt lgkmcnt(0)" ::: "memory");
    float rli[16];
#pragma unroll
    for (int r = 0; r < 16; ++r) rli[r] = __builtin_amdgcn_rcpf(li_l[crow(r, hi)]);
    bf16* Ow = Ob + (size_t)(wid * 32) * LDO;
#pragma unroll
    for (int r = 0; r < 16; ++r) { const int orow = crow(r, hi);
#pragma unroll
        for (int d0 = 0; d0 < 4; ++d0) Ow[(size_t)orow * LDO + d0 * 32 + r32] = (bf16)f2bf(o[d0][r] * rli[r]); }
#undef A2_SLOAD
#undef A2_SWRITE
#undef A2_SWAIT
#undef A2_RESC
}
}
__device__ __forceinline__ void attn_phase2(const Ctx& c, const bf16* Qg, const bf16* KVg, bf16* AOg, const float* relb) {
    LAS unsigned char* lds = c.lds;
    for (int u = c.bx; u < NBATCH * AH * 16; u += c.G) {
        const int h = u & 15, b = (u >> 4) & 3, qb = u >> 6;
        const int c0 = 4 * qb, kb = c0 >= LEFT ? c0 - LEFT : 0, NT = c0 + 4 - kb;
        __syncthreads();
        { int i = c.tid; asm volatile("" : "+v"(i));
          if (i < 272) ((LAS float*)(lds + at2::OFF_BIAS))[i] = (i < NREL) ? relb[(size_t)h * NREL + i] * 1.4426950408889634f : 0.f; }
        const float bc = relb[(size_t)h * NREL + 256] * 1.4426950408889634f;
        __syncthreads();
        const size_t tq0 = (size_t)b * SEQ + (size_t)c0 * CHUNK, tk0 = (size_t)b * SEQ + (size_t)kb * CHUNK;
        at2::block(Qg + tq0 * DM + h * AHD, KVg + tk0 * (2 * DM) + h * AHD, KVg + tk0 * (2 * DM) + DM + h * AHD, AOg + tq0 * DM + h * AHD, NT, c0 - kb, (const LAS float*)(lds + at2::OFF_BIAS), bc, lds, c.tid);
    }
}

constexpr int NSTEPS = 1 + 2 * 10 + 2 * 9;
template <int MASK> __global__ void __launch_bounds__(512, 2) yoco_fwd(Params p) {
    extern __shared__ __attribute__((aligned(16))) unsigned char lds_raw[];
#define MK_CTX() Ctx c; { int t_ = threadIdx.x; asm volatile("" : "+v"(t_)); c.lds = (LAS unsigned char*)lds_raw; c.tid = t_; c.lane = t_ & 63; c.wave = __builtin_amdgcn_readfirstlane(t_ >> 6); \
        { int b_ = blockIdx.x, g_ = gridDim.x; asm volatile("" : "+s"(b_), "+s"(g_)); c.bx = b_; c.G = g_; } c.gw = c.bx * 8 + c.wave; c.ngw = c.G * 8; }
    volatile LAS unsigned* MISC = (volatile LAS unsigned*)((LAS unsigned char*)lds_raw + LDS_MISC);
    if (threadIdx.x < 4) MISC[threadIdx.x] = 0u;
    __syncthreads();
    XcdBarrier bar; bar.bar = (unsigned*)(p.ws + WS_CTL); bar.x = 0; bar.st = MISC;
    if (p.hi - p.lo > 1) bar = xcd_barrier_post((unsigned*)(p.ws + WS_CTL), MISC);
    unsigned char* ws = p.ws;
    bf16* const H = (bf16*)(ws + WS_H); bf16* const HKV = (bf16*)(ws + WS_HKV);
    float* const X = p.out;
    int s = 0;
#ifndef REPMASK
#define REPMASK 0
#endif
#define KF_(f) p.f = kq_->f;
#define MK_P() Params p; { unsigned long long ka_ = (unsigned long long)__builtin_amdgcn_kernarg_segment_ptr(); asm volatile("" : "+s"(ka_)); const __attribute__((address_space(4))) Params* kq_ = (const __attribute__((address_space(4))) Params*)ka_; \
        KF_(x) KF_(ln_mix) KF_(ln_ffn) KF_(ret_w_in) KF_(ret_w_out) KF_(ret_gn) KF_(kv_norm) KF_(w_kv) KF_(att_w_q) KF_(att_w_o) KF_(att_rel_bias) KF_(peer_w_q) KF_(peer_sub_keys) KF_(peer_u) KF_(peer_v) KF_(ln_final) \
        KF_(out) KF_(ws) KF_(lo) KF_(hi) } \
        unsigned char* const ws = p.ws; bf16* const H = (bf16*)(ws + WS_H); bf16* const HKV = (bf16*)(ws + WS_HKV); float* const X = p.out; (void)H; (void)HKV; (void)X;
#define BEGIN_STEP(k) if (((MASK >> (k)) & 1) && s >= p.lo && s < p.hi) { for (int rep_ = ((REPMASK >> (k)) & 1) ? 0 : 1; rep_ < 2; ++rep_) { MK_CTX(); MK_P();
#define END_STEP   if (rep_ == 0 || s + 1 < p.hi) xcd_barrier(bar); } } ++s;

    BEGIN_STEP(0) p0_prologue(p, c); END_STEP

    for (int l = 0; l < DEPTH; ++l) {
        if (l < 2) {
            BEGIN_STEP(1)
                pg8::Gemm g{H, (const bf16*)(ws + WS_WIN) + (size_t)l * RIN * DM, NTOK, RIN, DM}; pg8::StaticOrder S; S.init(NTOK, RIN, c.G, c.bx);
                pg8::EpiProj E{(bf16*)(ws + WS_Q), (bf16*)(ws + WS_K), (bf16*)(ws + WS_V), (bf16*)(ws + WS_G), (const float*)(ws + WS_ROT)};
                pg8::gemm_phase<pg8::EpiProj, pg8::StaticOrder>(c.lds, g, S, E, nullptr);
            END_STEP
            BEGIN_STEP(2)
                for (int u = c.bx; u < 256; u += c.G) ret_scan_unit(c, (const bf16*)(ws + WS_Q), (const bf16*)(ws + WS_K), (const bf16*)(ws + WS_V), (bf16*)(ws + WS_O), u);
            END_STEP
            BEGIN_STEP(3)
                ret_gate_phase(c, (const bf16*)(ws + WS_O), (bf16*)(ws + WS_G), p.ret_gn + (size_t)l * RVW, rep_ == 0 ? (bf16*)(ws + WS_SC) : nullptr);
            END_STEP
        } else {
            BEGIN_STEP(4)
                for (int pass = (l == 2 ? 0 : 1); pass < 2; ++pass) {
                    const int N = pass ? DM : 2 * DM;
                    pg8::Gemm g{pass ? H : HKV, pass ? (const bf16*)(ws + WS_WQ) + (size_t)(l - 2) * DM * DM : (const bf16*)(ws + WS_WKV), NTOK, N, DM}; pg8::StaticOrder S; S.init(NTOK, N, c.G, c.bx);
                    pg8::EpiBf16S E{pass ? (bf16*)(ws + WS_Q) : (bf16*)(ws + WS_KV), N, pass ? 0.12751743082459868f : 1.0f};
                    pg8::gemm_phase<pg8::EpiBf16S, pg8::StaticOrder>(c.lds, g, S, E, nullptr);
                }
            END_STEP
            BEGIN_STEP(5)
#ifdef ATTNDRY
                attn_phase(c, (const bf16*)(ws + WS_Q), (const bf16*)(ws + WS_KV), rep_ == 0 ? (bf16*)(ws + WS_O) : (bf16*)(ws + WS_AO), p.att_rel_bias + (size_t)(l - 2) * AH * NREL, rep_ == 0 ? ATTNDRY : 0);
#else
                attn_phase2(c, (const bf16*)(ws + WS_Q), (const bf16*)(ws + WS_KV), (bf16*)(ws + WS_AO), p.att_rel_bias + (size_t)(l - 2) * AH * NREL);
#endif
            END_STEP
        }
        BEGIN_STEP(6)
            const int K = l < 2 ? RVW : DM;
            pg8::Gemm g{l < 2 ? (const bf16*)(ws + WS_G) : (const bf16*)(ws + WS_AO), l < 2 ? (const bf16*)(ws + WS_WOUT) + (size_t)l * DM * RVW : (const bf16*)(ws + WS_WO) + (size_t)(l - 2) * DM * DM, NTOK, DM, K};
            pg8::StaticOrder S; S.init(NTOK, DM, c.G, c.bx);
            pg8::EpiRes E{X, DM, H, p.ln_ffn + (size_t)l * DM, (float*)(ws + WS_SQP)};
            pg8::gemm_phase<pg8::EpiRes, pg8::StaticOrder>(c.lds, g, S, E, nullptr);
        END_STEP
        BEGIN_STEP(8)
            pg8::Gemm g{H, (const bf16*)(ws + WS_WC) + (size_t)l * DM * DM, NTOK, DM, DM}; pg8::StaticOrder S; S.init(NTOK, DM, c.G, c.bx);
            pg8::EpiF32 E{(float*)(ws + WS_SC), DM};
            pg8::gemm_phase<pg8::EpiF32, pg8::StaticOrder>(c.lds, g, S, E, nullptr);
        END_STEP
        BEGIN_STEP(9)
            peer_topk_phase(c, (const float*)(ws + WS_SC), (int*)(ws + WS_IDX), (float*)(ws + WS_WGT), (const float*)(ws + WS_SQP), (float*)(ws + WS_RSTD));
        END_STEP
        BEGIN_STEP(10)
#ifdef DRYIDXMASK
            peer_u_phase(c, H, ws + WS_PU + (size_t)l * PE * DM, (const int*)(ws + WS_IDX), (float*)(ws + WS_SC), rep_ == 0 ? DRYIDXMASK : 0xffffffffu);
#else
            peer_u_phase(c, H, ws + WS_PU + (size_t)l * PE * DM, (const int*)(ws + WS_IDX), (float*)(ws + WS_SC));
#endif
        END_STEP
        BEGIN_STEP(11)
            peer_a_phase(c, (const float*)(ws + WS_SC), (const int*)(ws + WS_IDX), (float*)(ws + WS_WGT), (const float*)(ws + WS_RS) + (size_t)l * PE, (const float*)(ws + WS_RS) + (size_t)(DEPTH + l) * PE, (const float*)(ws + WS_RSTD));
        END_STEP
        BEGIN_STEP(12)
#ifdef VREF
            peer_v_ref_phase(c, ws + WS_PV + (size_t)l * PE * DM, (const int*)(ws + WS_IDX), (const float*)(ws + WS_WGT), X);
#else
            peer_v_phase(c, ws + WS_PV + (size_t)l * PE * DM, (const int*)(ws + WS_IDX), (const float*)(ws + WS_WGT), X);
#endif
        END_STEP
        BEGIN_STEP(13)
            const int mode = (l == DEPTH - 1) ? 2 : (l == 1 ? 1 : 0);
            norm_phase(c, X, mode, mode == 2 ? p.ln_final : p.ln_mix + (size_t)(l + 1) * DM, p.kv_norm, H, HKV);
        END_STEP
    }
#ifdef DIAGBUF
    if ((MASK >> 14) & 1) { MK_CTX(); diag_copy_phase(c, X, ws); }
#else
    if ((MASK >> 14) & 1) { MK_CTX(); MK_P(); rms_final_phase(c, X, p.ln_final); }
#endif
#undef BEGIN_STEP
#undef END_STEP
}

#ifndef N_LAUNCH_CUT
#define N_LAUNCH_CUT 1
#endif
typedef void (*kern_t)(Params);
template <int SITE> static void launch_site(const Params& p, hipStream_t stream) {
    static bool attr = false;
    if (!attr) { (void)hipFuncSetAttribute((const void*)yoco_fwd<(1 << SITE)>, hipFuncAttributeMaxDynamicSharedMemorySize, LDS_BYTES); attr = true; }
    hipLaunchKernelGGL((yoco_fwd<(1 << SITE)>), dim3(256), dim3(512), LDS_BYTES, stream, p);
}
#ifndef MEGASITES
#define MEGASITES 0
#endif
static void launch_step_site(int site, const Params& p, hipStream_t stream) {
    if ((MEGASITES >> site) & 1) { hipLaunchKernelGGL((yoco_fwd<0x3FFF>), dim3(256), dim3(512), LDS_BYTES, stream, p); return; }
    switch (site) {
        case 0: launch_site<0>(p, stream); break; case 1: launch_site<1>(p, stream); break; case 2: launch_site<2>(p, stream); break; case 3: launch_site<3>(p, stream); break;
        case 4: launch_site<4>(p, stream); break; case 5: launch_site<5>(p, stream); break; case 6: launch_site<6>(p, stream); break; case 7: launch_site<7>(p, stream); break;
        case 8: launch_site<8>(p, stream); break; case 9: launch_site<9>(p, stream); break; case 10: launch_site<10>(p, stream); break; case 11: launch_site<11>(p, stream); break; case 12: launch_site<12>(p, stream); break; case 13: launch_site<13>(p, stream); break; default: launch_site<14>(p, stream); break;
    }
}
extern "C" void kernel_launch(void* const* d_in, const int* in_sizes, int n_in, void* d_out, int out_size, void* d_ws, size_t ws_size, hipStream_t stream) {
    static int ready = 0;
    if (ready == 0) {
        if (n_in != 16 || out_size != NTOK * DM || ws_size < WS_END) { fprintf(stderr, "kernel_launch: unexpected sizes (n_in %d out %d ws %zu, need %zu)\n", n_in, out_size, ws_size, (size_t)WS_END); ready = -1; return; }
#if N_LAUNCH_CUT || MEGASITES
        if (hipFuncSetAttribute((const void*)yoco_fwd<0x3FFF>, hipFuncAttributeMaxDynamicSharedMemorySize, LDS_BYTES) != hipSuccess) { fprintf(stderr, "kernel_launch: hipFuncSetAttribute failed\n"); ready = -1; return; }
#endif
        ready = 1;
    }
    if (ready < 0) return;
    (void)hipMemsetAsync(d_ws, 0, 16384, stream);
    Params p{};
    p.x = (const float*)d_in[0]; p.ln_mix = (const float*)d_in[1]; p.ln_ffn = (const float*)d_in[2]; p.ret_w_in = (const float*)d_in[3]; p.ret_w_out = (const float*)d_in[4]; p.ret_gn = (const float*)d_in[5];
    p.kv_norm = (const float*)d_in[6]; p.w_kv = (const float*)d_in[7]; p.att_w_q = (const float*)d_in[8]; p.att_w_o = (const float*)d_in[9]; p.att_rel_bias = (const float*)d_in[10];
    p.peer_w_q = (const float*)d_in[11]; p.peer_sub_keys = (const float*)d_in[12]; p.peer_u = (const float*)d_in[13]; p.peer_v = (const float*)d_in[14]; p.ln_final = (const float*)d_in[15];
    p.out = (float*)d_out; p.ws = (unsigned char*)d_ws;
#if N_LAUNCH_CUT == 2
    for (int s2 = 0; s2 < NSTEPS; ++s2) { p.lo = s2; p.hi = s2 + 1; hipLaunchKernelGGL((yoco_fwd<0x3FFF>), dim3(256), dim3(512), LDS_BYTES, stream, p); }
#elif N_LAUNCH_CUT
    p.lo = 0; p.hi = NSTEPS;
    hipLaunchKernelGGL((yoco_fwd<0x3FFF>), dim3(256), dim3(512), LDS_BYTES, stream, p);
#else
    static const int siteA[10] = {1, 2, 3, 6, 8, 9, 10, 11, 12, 13}, siteB[9] = {4, 5, 6, 8, 9, 10, 11, 12, 13};
    int s = 0;
#ifndef NSTOP
#define NSTOP 1000
#endif
    p.lo = s; p.hi = s + 1; launch_step_site(0, p, stream); ++s;
    for (int l = 0; l < DEPTH; ++l) { const int n = l < 2 ? 10 : 9; for (int k = 0; k < n; ++k) { p.lo = s; p.hi = s + 1; if (s < NSTOP) launch_step_site(l < 2 ? siteA[k] : siteB[k], p, stream); ++s; } }
    if (NSTOP < NSTEPS) { p.lo = -1; p.hi = -1; launch_step_site(14, p, stream); }
#endif
}
```
